# Optimizing an MI355X kernel written in HIP

```python
import jax, jax.numpy as jnp
from jax import lax
import numpy as np


D_MODEL = 2048
BATCH = 1
SEQ = 16384
DEPTH = 2
DEC_BATCH = 4
DEC_SEQ = 8192
PAST_LEN = 128

GLA_HEADS = 4
GLA_WIDTH = D_MODEL // 2
GLA_DV = GLA_WIDTH // GLA_HEADS
GLA_DK = GLA_DV // 2
GLA_KWIDTH = GLA_HEADS * GLA_DK
GLA_RANK = 16
GLA_TAU = 16.0
HG_DIM = 128
HG_WIDTH = D_MODEL - GLA_WIDTH
HG_HEADS = HG_WIDTH // HG_DIM
MIX_WIDTH = GLA_WIDTH + HG_WIDTH
D_FF = 4 * D_MODEL
CHUNK = 64
LN_EPS = 1e-5
RMS_EPS = 1e-6
ALPHA = (2.0 * DEPTH) ** 0.25
BETA = (8.0 * DEPTH) ** -0.25
SPLIT_WIDTHS = (GLA_KWIDTH, GLA_KWIDTH, GLA_WIDTH, GLA_WIDTH, 2 * GLA_RANK,
                HG_WIDTH, HG_WIDTH, HG_WIDTH, HG_WIDTH, HG_WIDTH)
IN_WIDTH = sum(SPLIT_WIDTHS)
SPLIT_IDX = tuple(sum(SPLIT_WIDTHS[:i + 1]) for i in range(len(SPLIT_WIDTHS) - 1))

kernel_name = 'hymba_gla_hgrn2_bidir_encoder'


def _heads(a, n_heads):
    B, T, W = a.shape
    return a.reshape(B, T, n_heads, W // n_heads).transpose(0, 2, 1, 3)


def _merge(a):
    B, H, T, d = a.shape
    return a.transpose(0, 2, 1, 3).reshape(B, T, H * d)


def _rmsnorm(a, g):
    a = a.astype(jnp.float32)
    return a * lax.rsqrt(jnp.mean(a * a, axis=-1, keepdims=True) + RMS_EPS) * g.astype(jnp.float32)


def _layernorm(a, g, b):
    a = a.astype(jnp.float32)
    mu = jnp.mean(a, axis=-1, keepdims=True)
    var = jnp.mean(jnp.square(a - mu), axis=-1, keepdims=True)
    return (a - mu) * lax.rsqrt(var + LN_EPS) * g.astype(jnp.float32) + b.astype(jnp.float32)


def _chunk_gated_linear(q, k, v, g):
    B, H, T, dk = q.shape
    dv = v.shape[-1]
    n = T // CHUNK

    def to_chunks(a):
        return a.reshape(B, H, n, CHUNK, a.shape[-1]).transpose(2, 0, 1, 3, 4)

    mask = jnp.tril(jnp.ones((CHUNK, CHUNK), dtype=bool))[:, :, None]

    def step(S, inp):
        qc, kc, vc, gc = inp
        b = jnp.cumsum(gc, axis=2)
        o_inter = jnp.einsum('bhid,bhde->bhie', qc * jnp.exp(b), S)
        diff = b[:, :, :, None, :] - b[:, :, None, :, :]
        decay = jnp.where(mask, jnp.exp(jnp.where(mask, diff, 0.0)), 0.0)
        scores = jnp.einsum('bhid,bhjd,bhijd->bhij', qc, kc, decay)
        o = o_inter + jnp.einsum('bhij,bhje->bhie', scores, vc)
        b_last = b[:, :, -1:, :]
        S = jnp.exp(b_last[:, :, 0, :])[..., None] * S + jnp.einsum(
            'bhjd,bhje->bhde', kc * jnp.exp(b_last - b), vc)
        return S, o

    S0 = jnp.zeros((B, H, dk, dv), jnp.float32)
    _, o = lax.scan(step, S0, (to_chunks(q), to_chunks(k), to_chunks(v), to_chunks(g)))
    return o.transpose(1, 2, 0, 3, 4).reshape(B, H, T, dv)


def _bidirectional(q, k_f, k_b, v, g_f, g_b):
    flip = lambda a: jnp.flip(a, axis=2)
    fwd = _chunk_gated_linear(q, k_f, v, g_f)
    bwd = flip(_chunk_gated_linear(flip(q), flip(k_b), flip(v), flip(g_b)))
    return fwd + bwd


def _hgrn_gate(z, lb):
    log_f = jnp.logaddexp(jnp.log(lb), jnp.log1p(-lb) + jax.nn.log_sigmoid(z))
    one_minus_f = (1.0 - lb) * jax.nn.sigmoid(-z)
    return log_f, one_minus_f


def _lower_bounds(p):
    c = jnp.cumsum(jax.nn.softmax(p.astype(jnp.float32), axis=0), axis=0)
    return c - c[0:1]


def _mixer(x, w_in, w_lr2, b_lr, gla_g, hg_g, lb_f, lb_b, w_out):
    z = jnp.einsum('btd,de->bte', x, w_in).astype(jnp.float32)
    gq, gk, gv, gog, glr, hq, hff, hfb, hi, hog = jnp.split(z, SPLIT_IDX, axis=-1)
    w_lr2 = w_lr2.astype(jnp.float32)
    b_lr = b_lr.astype(jnp.float32)
    ga_f = jax.nn.log_sigmoid(glr[..., :GLA_RANK] @ w_lr2[0] + b_lr[0]) / GLA_TAU
    ga_b = jax.nn.log_sigmoid(glr[..., GLA_RANK:] @ w_lr2[1] + b_lr[1]) / GLA_TAU
    q = _heads(gq * (GLA_DK ** -0.5), GLA_HEADS)
    k = _heads(gk, GLA_HEADS)
    v = _heads(gv, GLA_HEADS)
    o_gla = _bidirectional(q, k, k, v, _heads(ga_f, GLA_HEADS), _heads(ga_b, GLA_HEADS))
    o_gla = _merge(_rmsnorm(o_gla, gla_g)) * jax.nn.silu(gog)
    logf_f, kf = _hgrn_gate(hff, lb_f)
    logf_b, kb = _hgrn_gate(hfb, lb_b)
    o_hg = _bidirectional(_heads(hq, HG_HEADS), _heads(kf, HG_HEADS), _heads(kb, HG_HEADS),
                          _heads(hi, HG_HEADS), _heads(logf_f, HG_HEADS), _heads(logf_b, HG_HEADS))
    o_hg = _merge(_rmsnorm(o_hg, hg_g)) * jax.nn.silu(hog)
    o = jnp.concatenate([o_gla, o_hg], axis=-1)
    return jnp.einsum('bte,ed->btd', o, w_out)


def _mlp(x, w_up, w_down):
    h = jnp.square(jax.nn.relu(jnp.einsum('btd,df->btf', x, w_up)))
    return jnp.einsum('btf,fd->btd', h, w_down)


def _trunk(x, w_in, gla_w_lr2, gla_b_lr, gla_norm_g, hg_norm_g, lbs_f, lbs_b,
           w_out, ln1_g, ln1_b, w_up, w_down, ln2_g, ln2_b):
    dt = x.dtype
    h = x.astype(jnp.float32)
    for l in range(DEPTH):
        m = _mixer(h, w_in[l], gla_w_lr2[l], gla_b_lr[l], gla_norm_g[l], hg_norm_g[l],
                   lbs_f[l], lbs_b[l], w_out[l])
        h = _layernorm(ALPHA * h + m, ln1_g[l], ln1_b[l])
        f = _mlp(h, w_up[l], w_down[l])
        h = _layernorm(ALPHA * h + f, ln2_g[l], ln2_b[l])
    return h.astype(dt)


def setup_inputs(seed: int = 0) -> dict:
    key = jax.random.key(seed)
    ks = jax.random.split(key, 16)
    f32 = jnp.float32
    nrm = lambda k, s, sc: jax.random.normal(k, s, f32) * sc
    return {
        'x_prompt': nrm(ks[0], (BATCH, SEQ, D_MODEL), 1.0),
        'x_sample': nrm(ks[1], (DEC_BATCH, DEC_SEQ, D_MODEL), 1.0),
        'w_in': nrm(ks[2], (DEPTH, D_MODEL, IN_WIDTH), D_MODEL ** -0.5),
        'gla_w_lr2': nrm(ks[3], (DEPTH, 2, GLA_RANK, GLA_KWIDTH), GLA_RANK ** -0.5),
        'gla_b_lr': nrm(ks[4], (DEPTH, 2, GLA_KWIDTH), 0.1),
        'gla_norm_g': 1.0 + nrm(ks[5], (DEPTH, GLA_DV), 0.02),
        'hg_norm_g': 1.0 + nrm(ks[6], (DEPTH, HG_DIM), 0.02),
        'lower_bounds': nrm(ks[7], (2, DEPTH, HG_WIDTH), 0.1),
        'w_out': nrm(ks[8], (DEPTH, MIX_WIDTH, D_MODEL), BETA * MIX_WIDTH ** -0.5),
        'ln1_g': 1.0 + nrm(ks[9], (DEPTH, D_MODEL), 0.02),
        'ln1_b': nrm(ks[10], (DEPTH, D_MODEL), 0.02),
        'w_up': nrm(ks[11], (DEPTH, D_MODEL, D_FF), D_MODEL ** -0.5),
        'w_down': nrm(ks[12], (DEPTH, D_FF, D_MODEL), BETA * D_FF ** -0.5),
        'ln2_g': 1.0 + nrm(ks[13], (DEPTH, D_MODEL), 0.02),
        'ln2_b': nrm(ks[14], (DEPTH, D_MODEL), 0.02),
    }


def reference(x_prompt, x_sample, w_in, gla_w_lr2, gla_b_lr, gla_norm_g, hg_norm_g,
              lower_bounds, w_out, ln1_g, ln1_b, w_up, w_down, ln2_g, ln2_b):
    lbs_f = _lower_bounds(lower_bounds[0])
    lbs_b = _lower_bounds(lower_bounds[1])
    y_prompt = _trunk(x_prompt, w_in, gla_w_lr2, gla_b_lr, gla_norm_g, hg_norm_g, lbs_f, lbs_b,
                      w_out, ln1_g, ln1_b, w_up, w_down, ln2_g, ln2_b)
    y_sample = _trunk(x_sample, w_in, gla_w_lr2, gla_b_lr, gla_norm_g, hg_norm_g, lbs_f, lbs_b,
                      w_out, ln1_g, ln1_b, w_up, w_down, ln2_g, ln2_b)
    return (y_prompt, y_sample)
```

```cpp
#include <hip/hip_runtime.h>
#include <cstdio>
#include <cstdint>
#ifndef KMODE
#define KMODE 0
#endif
namespace pg8 {
#define PG8_LAS __attribute__((address_space(3)))
typedef unsigned short bf16_t;
typedef short bf16x8 __attribute__((ext_vector_type(8)));
typedef float f32x4 __attribute__((ext_vector_type(4)));
typedef unsigned u32x4 __attribute__((ext_vector_type(4)));
constexpr int BM = 256, BK = 64, HALF = 128, HTB = HALF * BK * 2  , STAGE_BYTES = 8 * HTB, NXCD = 8, WGM = 8;

__host__ __device__ __forceinline__ int lds_byte(int r, int c) { const int st = (r >> 4) * 2 + (c >> 5), rr = r & 15, cc = c & 31, ob = rr * 64 + cc * 2; return st * 1024 + (ob ^ (((ob >> 9) & 1) << 5)); }
__host__ __device__ __forceinline__ void stage_rc(int b, int& R, int& C) { const int st = b / 1024, sb = b % 1024, swz = sb ^ (((sb >> 9) & 1) << 5); R = (st >> 1) * 16 + swz / 64; C = (st & 1) * 32 + (swz % 64) / 2; }
__host__ __device__ __forceinline__ int perm32(int rho) { const int n = rho >> 4, i = rho & 15; return 8 * (i >> 2) + 4 * n + (i & 3); }

struct Unit { int pm, pn; };
struct Gemm { const bf16_t* A; const bf16_t* Bt; int M, N, K; };

struct StaticOrder {
    int nM, nN, nwg, G, c;
    __host__ __device__ void init(int M, int N, int G_, int c_) { nM = M / BM; nN = N / BM; nwg = nM * nN; G = G_; c = c_; }
    __host__ __device__ bool next(int i, Unit& u) const {
        const long L = (long)i * G + c; if (L >= nwg) return false;
        int wgid = (int)L; { const int q = nwg / NXCD, r = nwg % NXCD, xcd = wgid % NXCD, off = wgid / NXCD; wgid = (xcd < r ? xcd * (q + 1) : r * (q + 1) + (xcd - r) * q) + off; }
        const int nig = WGM * nN, gid = wgid / nig, fm = gid * WGM, gsz = (nM - fm) < WGM ? (nM - fm) : WGM;
        u.pm = fm + ((wgid % nig) % gsz); u.pn = (wgid % nig) / gsz; return true;
    }
    __device__ __forceinline__ void a_ready(const Unit&) const {}
    __device__ __forceinline__ void done(const Unit&) const {}
};


__device__ __forceinline__ unsigned cvt_pk_bf16(float lo, float hi) { unsigned r; asm volatile("v_cvt_pk_bf16_f32 %0, %1, %2" : "=v"(r) : "v"(lo), "v"(hi)); return r; }

template <int ACT  > struct EpiBf16 {
    static constexpr bool PERM = true, AFTER_DRAIN = false;
    bf16_t* O; int ldc;
    __device__ __forceinline__ void operator()(const f32x4 (&acc)[2][2][4][2], const Unit& u, int wr, int wc, int fr, int fq) const {
        const int row0 = u.pm * BM + wr * 64 + fr; const int col0 = u.pn * BM + wc * 32 + 8 * fq;
#pragma unroll
        for (int ai = 0; ai < 2; ++ai)
#pragma unroll
            for (int m = 0; m < 4; ++m) { bf16_t* rowp = O + (size_t)(row0 + ai * HALF + m * 16) * ldc + col0;
#pragma unroll
                for (int bj = 0; bj < 2; ++bj) { f32x4 v0 = acc[ai][bj][m][0], v1 = acc[ai][bj][m][1];
                    if (ACT == 1) {
#pragma unroll
                        for (int j = 0; j < 4; ++j) { const float a = fmaxf(v0[j], 0.f), b = fmaxf(v1[j], 0.f); v0[j] = a * a; v1[j] = b * b; } }
                    u32x4 w; w.x = cvt_pk_bf16(v0[0], v0[1]); w.y = cvt_pk_bf16(v0[2], v0[3]); w.z = cvt_pk_bf16(v1[0], v1[1]); w.w = cvt_pk_bf16(v1[2], v1[3]);
                    *(u32x4*)(rowp + bj * HALF) = w; } }
    }
};
struct EpiF32 {
    static constexpr bool PERM = false, AFTER_DRAIN = false;
    float* C; int ldc;
    __device__ __forceinline__ void operator()(const f32x4 (&acc)[2][2][4][2], const Unit& u, int wr, int wc, int fr, int fq) const {
        const int row0 = u.pm * BM + wr * 64 + fr, col0 = u.pn * BM + wc * 32 + 4 * fq;
#pragma unroll
        for (int ai = 0; ai < 2; ++ai)
#pragma unroll
            for (int m = 0; m < 4; ++m) { float* rowp = C + (size_t)(row0 + ai * HALF + m * 16) * ldc + col0;
#pragma unroll
                for (int bj = 0; bj < 2; ++bj)
#pragma unroll
                    for (int n = 0; n < 2; ++n) *(f32x4*)(rowp + bj * HALF + n * 16) = acc[ai][bj][m][n]; }
    }
};

template <class Epi, class Sched, bool ALIGN_EPI = false, bool SP2 = false>
__device__ __forceinline__ void gemm_phase(PG8_LAS unsigned char* lds, const Gemm g, const Sched& S, const Epi& E) {
    int tid_o = threadIdx.x; asm volatile("" : "+v"(tid_o));
    const int tid = tid_o, wid = __builtin_amdgcn_readfirstlane(tid >> 6), lane = tid & 63, wr = wid >> 2, wc = wid & 3, fr = lane & 15, fq = lane >> 4;
    const int K = g.K, nt = K / BK;
    unsigned voffA[2], voffB[2];
#pragma unroll
    for (int i = 0; i < 2; ++i) { int R, C; stage_rc(tid * 16 + i * 8192, R, C); const int Rb = Epi::PERM ? ((R & ~31) + perm32(R & 31)) : R;
        voffA[i] = (unsigned)(R * K + C) * 2u; voffB[i] = (unsigned)(Rb * K + C) * 2u; }
    const size_t kstep = (size_t)(BK * 2);
    const size_t hstep = (size_t)HALF * K * 2;
    const size_t tstep = 2 * hstep;
    const unsigned ldsw = (unsigned)wid * 1024u;
    const int aoff = lds_byte(wr * 64 + fr, fq * 8), boff = lds_byte(wc * 32 + fr, fq * 8);
#define PG8_SA(b, h) (((b) * 2 + (h)) * HTB)
#define PG8_SB(b, h) ((4 + (b) * 2 + (h)) * HTB)
#define PG8_STAGE(bufoff, gbase, voff) do { _Pragma("unroll") for (int _i = 0; _i < 2; ++_i) \
        __builtin_amdgcn_global_load_lds((const unsigned*)((const char*)(gbase) + (voff)[_i]), (PG8_LAS unsigned*)(lds + (bufoff) + ldsw + _i * 8192), 16, 0, 0); } while (0)
#define PG8_LDA(dst, b, h) do { _Pragma("unroll") for (int m = 0; m < 4; ++m) _Pragma("unroll") for (int k = 0; k < 2; ++k) dst[m][k] = *(const PG8_LAS bf16x8*)(lds + PG8_SA(b, h) + aoff + m * 2048 + k * 1024); } while (0)
#define PG8_LDB(dst, b, h) do { _Pragma("unroll") for (int n = 0; n < 2; ++n) _Pragma("unroll") for (int k = 0; k < 2; ++k) dst[n][k] = *(const PG8_LAS bf16x8*)(lds + PG8_SB(b, h) + boff + n * 2048 + k * 1024); } while (0)
#define PG8_MMA(ai, bj, At, Bt) do { __builtin_amdgcn_s_setprio(1); _Pragma("unroll") for (int m = 0; m < 4; ++m) _Pragma("unroll") for (int n = 0; n < 2; ++n) _Pragma("unroll") for (int k = 0; k < 2; ++k) \
        acc[ai][bj][m][n] = __builtin_amdgcn_mfma_f32_16x16x32_bf16(Bt[n][k], At[m][k], acc[ai][bj][m][n], 0, 0, 0); __builtin_amdgcn_s_setprio(0); } while (0)
#define PG8_WAIT_V(n) asm volatile("s_waitcnt vmcnt(" #n ")" ::: "memory")
#define PG8_WAIT_L(n) asm volatile("s_waitcnt lgkmcnt(" #n ")" ::: "memory")
#define PG8_BAR __builtin_amdgcn_s_barrier()
#define PG8_SCHED __builtin_amdgcn_sched_barrier(0)
    Unit cur, nxt; int ui = 0;
    if (!S.next(0, cur)) return;
    f32x4 acc[2][2][4][2];
#pragma unroll
    for (int a = 0; a < 2; ++a)
#pragma unroll
        for (int b = 0; b < 2; ++b)
#pragma unroll
            for (int m = 0; m < 4; ++m)
#pragma unroll
                for (int n = 0; n < 2; ++n) acc[a][b][m][n] = (f32x4){0.f, 0.f, 0.f, 0.f};
    bf16x8 At[4][2], B0[2][2], B1[2][2];
    const char* cA = (const char*)g.A + (size_t)cur.pm * tstep; const char* cB = (const char*)g.Bt + (size_t)cur.pn * tstep;
    S.a_ready(cur);
    if constexpr (SP2) {
        PG8_STAGE(PG8_SB(0, 0), cB, voffB); PG8_STAGE(PG8_SB(0, 1), cB + hstep, voffB); PG8_STAGE(PG8_SA(0, 0), cA, voffA); PG8_STAGE(PG8_SA(0, 1), cA + hstep, voffA);
        if (wr == 1) PG8_BAR;
        PG8_WAIT_V(2); PG8_BAR;
        PG8_STAGE(PG8_SB(1, 0), cB + kstep, voffB); PG8_STAGE(PG8_SA(1, 0), cA + kstep, voffA); PG8_STAGE(PG8_SB(1, 1), cB + hstep + kstep, voffB);
        PG8_WAIT_V(6); PG8_BAR;
    } else {
        PG8_STAGE(PG8_SB(0, 0), cB, voffB); PG8_STAGE(PG8_SA(0, 0), cA, voffA); PG8_STAGE(PG8_SB(0, 1), cB + hstep, voffB); PG8_STAGE(PG8_SA(0, 1), cA + hstep, voffA);
        if (wr == 1) PG8_BAR;
        PG8_WAIT_V(4); PG8_BAR;
        PG8_STAGE(PG8_SB(1, 0), cB + kstep, voffB); PG8_STAGE(PG8_SA(1, 0), cA + kstep, voffA); PG8_STAGE(PG8_SB(1, 1), cB + hstep + kstep, voffB);
        PG8_WAIT_V(6); PG8_BAR;
    }
    for (;;) {
        const bool has_next = S.next(ui + 1, nxt);
        const char* nA = has_next ? (const char*)g.A + (size_t)nxt.pm * tstep : cA; const char* nB = has_next ? (const char*)g.Bt + (size_t)nxt.pn * tstep : cB;
        for (int t = 0; t < nt; t += 2) {
            const bool last = (t == nt - 2);
            const char* a1 = cA + (size_t)(t + 1) * kstep;
            const char* a2 = last ? nA : cA + (size_t)(t + 2) * kstep; const char* b2 = last ? nB : cB + (size_t)(t + 2) * kstep;
            const char* a3 = a2 + kstep; const char* b3 = b2 + kstep;
            if (last && has_next) S.a_ready(nxt);
            if constexpr (SP2) {
            PG8_LDB(B0, 0, 0); PG8_LDB(B1, 0, 1); PG8_SCHED; PG8_LDA(At, 0, 0); PG8_STAGE(PG8_SA(1, 1), a1 + hstep, voffA);
            PG8_WAIT_V(8); PG8_WAIT_L(0); PG8_BAR; PG8_MMA(0, 0, At, B0); PG8_MMA(0, 1, At, B1); PG8_BAR; PG8_SCHED;
            PG8_LDA(At, 0, 1); PG8_STAGE(PG8_SB(0, 0), b2, voffB); PG8_STAGE(PG8_SB(0, 1), b2 + hstep, voffB); PG8_STAGE(PG8_SA(0, 0), a2, voffA);
            PG8_WAIT_V(8); PG8_WAIT_L(0); PG8_BAR; PG8_MMA(1, 0, At, B0); PG8_MMA(1, 1, At, B1); PG8_BAR; PG8_SCHED;
            PG8_LDB(B0, 1, 0); PG8_LDB(B1, 1, 1); PG8_SCHED; PG8_LDA(At, 1, 0); PG8_STAGE(PG8_SA(0, 1), a2 + hstep, voffA);
            PG8_WAIT_V(8); PG8_WAIT_L(0); PG8_BAR; PG8_MMA(0, 0, At, B0); PG8_MMA(0, 1, At, B1); PG8_BAR; PG8_SCHED;
            PG8_LDA(At, 1, 1); PG8_STAGE(PG8_SB(1, 0), b3, voffB); PG8_STAGE(PG8_SB(1, 1), b3 + hstep, voffB); PG8_STAGE(PG8_SA(1, 0), a3, voffA);
            PG8_WAIT_V(8); PG8_WAIT_L(0); PG8_BAR; PG8_MMA(1, 0, At, B0); PG8_MMA(1, 1, At, B1); PG8_BAR; PG8_SCHED;
            } else {
            PG8_LDB(B0, 0, 0); PG8_SCHED; PG8_LDA(At, 0, 0); PG8_STAGE(PG8_SA(1, 1), a1 + hstep, voffA);
            PG8_WAIT_L(8); PG8_BAR; PG8_WAIT_L(0); PG8_MMA(0, 0, At, B0); PG8_BAR; PG8_SCHED;
            PG8_LDB(B1, 0, 1); PG8_STAGE(PG8_SB(0, 0), b2, voffB);
            PG8_BAR; PG8_WAIT_L(0); PG8_MMA(0, 1, At, B1); PG8_BAR;
            PG8_LDA(At, 0, 1); PG8_STAGE(PG8_SA(0, 0), a2, voffA);
            PG8_BAR; PG8_WAIT_L(0); PG8_MMA(1, 0, At, B0); PG8_BAR; PG8_SCHED;
            PG8_STAGE(PG8_SB(0, 1), b2 + hstep, voffB);
            PG8_WAIT_V(6); PG8_BAR; PG8_MMA(1, 1, At, B1); PG8_BAR;
            PG8_LDB(B0, 1, 0); PG8_SCHED; PG8_LDA(At, 1, 0); PG8_STAGE(PG8_SA(0, 1), a2 + hstep, voffA);
            PG8_WAIT_L(8); PG8_BAR; PG8_WAIT_L(0); PG8_MMA(0, 0, At, B0); PG8_BAR; PG8_SCHED;
            PG8_LDB(B1, 1, 1); PG8_STAGE(PG8_SB(1, 0), b3, voffB);
            PG8_BAR; PG8_WAIT_L(0); PG8_MMA(0, 1, At, B1); PG8_BAR;
            PG8_LDA(At, 1, 1); PG8_STAGE(PG8_SA(1, 0), a3, voffA);
            PG8_BAR; PG8_WAIT_L(0); PG8_MMA(1, 0, At, B0); PG8_BAR; PG8_SCHED;
            PG8_STAGE(PG8_SB(1, 1), b3 + hstep, voffB);
            PG8_WAIT_V(6); PG8_BAR; PG8_MMA(1, 1, At, B1); PG8_BAR;
            }
        }
        if constexpr (ALIGN_EPI) { if (wr == 0) PG8_BAR; }
        if constexpr (!Epi::AFTER_DRAIN) { E(acc, cur, wr, wc, fr, fq); S.done(cur); }
        if (!has_next) break;
#pragma unroll
        for (int a = 0; a < 2; ++a)
#pragma unroll
            for (int b = 0; b < 2; ++b)
#pragma unroll
                for (int m = 0; m < 4; ++m)
#pragma unroll
                    for (int n = 0; n < 2; ++n) acc[a][b][m][n] = (f32x4){0.f, 0.f, 0.f, 0.f};
        cur = nxt; cA = nA; cB = nB; ++ui;
        if constexpr (ALIGN_EPI) { if (wr == 1) PG8_BAR; }
    }
    PG8_WAIT_V(0);
    if constexpr (!ALIGN_EPI) { if (wr == 0) PG8_BAR; }
    PG8_BAR;
    if constexpr (Epi::AFTER_DRAIN) { E.fused(acc, cur, wr, wc, fr, fq, lds, wid, lane); S.done(cur); }
#undef PG8_SA
#undef PG8_SB
#undef PG8_STAGE
#undef PG8_LDA
#undef PG8_LDB
#undef PG8_MMA
#undef PG8_WAIT_V
#undef PG8_WAIT_L
#undef PG8_BAR
#undef PG8_SCHED
}
}

constexpr int NWAVES = 8;
constexpr int DM = 2048, DFF = 8192, NTOK = 49152, GM = 16384, NGRP = 3, NLAYER = 2, INW = 8224, ZW = 8192;
constexpr int ZC_GQ = 0, ZC_GK = 512, ZC_GV = 1024, ZC_GOG = 2048, ZC_HQ = 3072, ZC_HFF = 4096, ZC_HFB = 5120, ZC_HI = 6144, ZC_HOG = 7168;
constexpr float LN_EPS = 1e-5f, RMS_EPS = 1e-6f, ALPHA = 1.41421356237f, LOG2E = 1.44269504089f;
constexpr int NCHUNK = GM / 64;
constexpr int ST_CHUNK = 524288;
constexpr size_t MiB = 1u << 20;
constexpr size_t WS_CTL = 0, CTL_ZERO_BYTES = 1 * MiB;
constexpr size_t WS_WIN = 2 * MiB, WS_WOUT = 66 * MiB, WS_WUP = 82 * MiB, WS_WDN = 146 * MiB, WS_WGLR = 210 * MiB;
constexpr size_t WS_HB = 212 * MiB;
constexpr size_t WS_Z = 276 * MiB;
constexpr size_t WS_BG = 532 * MiB;
constexpr size_t WS_O = 596 * MiB;
constexpr size_t WS_ST = 660 * MiB;
constexpr size_t WS_TOT = 916 * MiB;
constexpr size_t WS_END = 920 * MiB;
constexpr int CW_BAR = 4096;
constexpr int RING_BYTES = 131072;
constexpr int LDS_BYTES = 160 * 1024, MISC_OFF = LDS_BYTES - 256;
constexpr int L_B32 = 0, L_KR = 33792, L_QR = 51200, L_QH = 68608, L_V = 86016, L_P = 119808, L_RED = 129024;
constexpr int B32_STR = 528, K_STR = 272, P_STR = 144, KT_STR = 144;

#define GAS __attribute__((address_space(1)))
#define LAS __attribute__((address_space(3)))
typedef unsigned short bf16;
typedef unsigned v4u __attribute__((ext_vector_type(4)));
typedef float f32x4 __attribute__((ext_vector_type(4)));
typedef short bf16x8 __attribute__((ext_vector_type(8)));
typedef GAS unsigned gu32;
typedef GAS unsigned long long gu64;
#define RLX_AGENT __ATOMIC_RELAXED, __HIP_MEMORY_SCOPE_AGENT
#define LDS_WAIT() asm volatile("s_waitcnt lgkmcnt(0)" ::: "memory")
#define VM_WAIT() asm volatile("s_waitcnt vmcnt(0)" ::: "memory")
__device__ __forceinline__ unsigned long long rt() { return __builtin_amdgcn_s_memrealtime(); }
__device__ __forceinline__ unsigned f2bf(float f) { unsigned u = __builtin_bit_cast(unsigned, f); return (u + 0x7fffu + ((u >> 16) & 1u)) >> 16; }
__device__ __forceinline__ unsigned pk2(float lo, float hi) { return f2bf(lo) | (f2bf(hi) << 16); }

#define XB_TMO      128
#define XB_XCNT(j)  (256  + 64 * (j))
#define XB_XSUB(j)  (1280 + 64 * (j))
#define XB_XGEN(j)  (2304 + 64 * (j))
#define XB_TOP      3328
#define XB_TOPGEN   3392
#define XCD_BAR_WORDS 3456
#define XB_SPIN_CAP (1u << 18)

__device__ __forceinline__ unsigned xb_ld(unsigned* p)              { return __hip_atomic_load(p, __ATOMIC_RELAXED, __HIP_MEMORY_SCOPE_AGENT); }
__device__ __forceinline__ unsigned xb_add(unsigned* p, unsigned v) { return __hip_atomic_fetch_add(p, v, __ATOMIC_RELAXED, __HIP_MEMORY_SCOPE_AGENT); }
__device__ __forceinline__ unsigned xb_xcc_id() { return (unsigned)__builtin_amdgcn_s_getreg((3 << 11) | 20) & 0xFu; }
#define XB_SPIN(cond, bar) do { unsigned _sp = 0; while (cond) { __builtin_amdgcn_s_sleep(1); \
    if ((++_sp & 255u) == 0u) { if (xb_ld(&(bar)[XB_TMO])) break; if (_sp > XB_SPIN_CAP) { atomicAdd(&(bar)[XB_TMO], 1u); break; } } } } while (0)

struct XcdBarrier {
    unsigned* bar; unsigned x;
    volatile LAS unsigned* st;
};

__device__ __forceinline__ XcdBarrier xcd_barrier_post(unsigned* bar, volatile LAS unsigned* st) {
    XcdBarrier b; b.bar = bar; b.x = xb_xcc_id(); b.st = st;
    if (threadIdx.x == 0) (void)xb_add(&bar[XB_XCNT(b.x)], 1u);
    return b;
}
__device__ __forceinline__ void xcd_barrier_complete(unsigned* bar, unsigned x, unsigned& nloc, unsigned& nx) {
    const unsigned G = gridDim.x * gridDim.y * gridDim.z;
    unsigned sum, cnt, mine, sp = 0u;
    for (;;) {
        sum = 0u; cnt = 0u; mine = 0u;
#pragma unroll
        for (unsigned j = 0; j < 16; ++j) { const unsigned c = xb_ld(&bar[XB_XCNT(j)]); sum += c; cnt += (c > 0u) ? 1u : 0u; mine = (j == x) ? c : mine; }
        if (sum == G) break;
        __builtin_amdgcn_s_sleep(1);
        if ((++sp & 255u) == 0u) { if (xb_ld(&bar[XB_TMO])) break; if (sp > XB_SPIN_CAP) { atomicAdd(&bar[XB_TMO], 1u); break; } }
    }
    nloc = mine > 0u ? mine : 1u; nx = cnt > 0u ? cnt : 1u;
}

__device__ __forceinline__ void xcd_barrier(const XcdBarrier& b) {
    asm volatile("s_waitcnt vmcnt(0)" ::: "memory");
    __syncthreads();
    if (threadIdx.x == 0) {
        unsigned* bar = b.bar;
        __builtin_amdgcn_s_waitcnt(0);
        unsigned nloc = b.st[0], nx = b.st[1];
        if (nloc == 0u) { xcd_barrier_complete(bar, b.x, nloc, nx); b.st[0] = nloc; b.st[1] = nx; }
        const unsigned old = xb_add(&bar[XB_XSUB(b.x)], 1u);
        const unsigned gen = old / nloc;
        if (old + 1u == (gen + 1u) * nloc) {
            __builtin_amdgcn_fence(__ATOMIC_RELEASE, "agent");
            asm volatile("s_waitcnt vmcnt(0)" ::: "memory");
            const unsigned og = xb_add(&bar[XB_TOP], 1u);
            const unsigned tg = og / nx;
            if (og + 1u == (tg + 1u) * nx) xb_add(&bar[XB_TOPGEN], 1u);
            else XB_SPIN(xb_ld(&bar[XB_TOPGEN]) == tg, bar);
            __builtin_amdgcn_fence(__ATOMIC_ACQUIRE, "agent");
            xb_add(&bar[XB_XGEN(b.x)], 1u);
            asm volatile("s_waitcnt vmcnt(0)" ::: "memory");
        } else {
            XB_SPIN(xb_ld(&bar[XB_XGEN(b.x)]) == gen, bar);
            __builtin_amdgcn_fence(__ATOMIC_ACQUIRE, "agent");
            asm volatile("s_waitcnt vmcnt(0)" ::: "memory");
        }
    }
    __syncthreads();
}

typedef short s16x4 __attribute__((ext_vector_type(4)));
typedef float f32x2 __attribute__((ext_vector_type(2)));
typedef unsigned v2u __attribute__((ext_vector_type(2)));
__device__ __forceinline__ unsigned pkbf(float lo, float hi) { return pg8::cvt_pk_bf16(lo, hi); }
__device__ __forceinline__ float wave_sum(float v) {
#pragma unroll
    for (int o = 1; o < 64; o <<= 1) v += __shfl_xor(v, o);
    return v;
}
__device__ __forceinline__ float wave_scan_incl(float v, int lane) {
#pragma unroll
    for (int d = 1; d < 64; d <<= 1) { const float t = __shfl_up(v, d); if (lane >= d) v += t; }
    return v;
}
__device__ __forceinline__ void unpack8(const v4u v, float* f) {
    f[0] = __uint_as_float(v.x << 16); f[1] = __uint_as_float(v.x & 0xffff0000u); f[2] = __uint_as_float(v.y << 16); f[3] = __uint_as_float(v.y & 0xffff0000u);
    f[4] = __uint_as_float(v.z << 16); f[5] = __uint_as_float(v.z & 0xffff0000u); f[6] = __uint_as_float(v.w << 16); f[7] = __uint_as_float(v.w & 0xffff0000u);
}
__device__ __forceinline__ v4u pack8(const float* f) { v4u o; o.x = pkbf(f[0], f[1]); o.y = pkbf(f[2], f[3]); o.z = pkbf(f[4], f[5]); o.w = pkbf(f[6], f[7]); return o; }
__device__ __forceinline__ s16x4 lds_tr(LAS const unsigned char* p) { return __builtin_bit_cast(s16x4, __builtin_amdgcn_ds_read_tr16_b64_v4i16((LAS s16x4*)p)); }
__device__ __forceinline__ bf16x8 tr_pair(LAS const unsigned char* p0, LAS const unsigned char* p1) {
    const s16x4 a = lds_tr(p0), b = lds_tr(p1); return __builtin_shufflevector(a, b, 0, 1, 2, 3, 4, 5, 6, 7);
}
__device__ __forceinline__ float fexp2(float x) { return __builtin_amdgcn_exp2f(x); }
__device__ __forceinline__ float flog2(float x) { return __builtin_amdgcn_logf(x); }

struct Ctx {
    const float *x_prompt, *x_sample, *w_in, *w_lr2, *b_lr, *gla_g, *hg_g, *lowb, *w_out, *ln1_g, *ln1_b, *w_up, *w_down, *ln2_g, *ln2_b;
    float* out;
    bf16 *Win_t, *Wout_t, *Wup_t, *Wdn_t, *Wglr_t, *HB, *Z, *O, *ST;
    float *BG, *MF, *TOT;
};

__device__ __forceinline__ void transpose_item(const float* W, int N, int kb, int nb, bf16* dst, int K, LAS float* scr, int lane) {
    const int k0 = 64 * kb, n0 = 32 * nb;
#pragma unroll 8
    for (int i = 0; i < 32; ++i) { const int kk = 2 * i + (lane >> 5); scr[kk * 33 + (lane & 31)] = W[(size_t)(k0 + kk) * N + n0 + (lane & 31)]; }
    LDS_WAIT(); asm volatile("" ::: "memory");
    const int c = lane & 7;
#pragma unroll
    for (int j = 0; j < 4; ++j) { const int n = (lane >> 3) + 8 * j; const LAS float* s = scr + (8 * c) * 33 + n;
        v4u o; o.x = pkbf(s[0 * 33], s[1 * 33]); o.y = pkbf(s[2 * 33], s[3 * 33]); o.z = pkbf(s[4 * 33], s[5 * 33]); o.w = pkbf(s[6 * 33], s[7 * 33]);
        *(GAS v4u*)(dst + (size_t)n * K + k0 + 8 * c) = o; }
    LDS_WAIT(); asm volatile("" ::: "memory");
}
__device__ __forceinline__ void prologue_weights(const Ctx& X, LAS unsigned char* lds, int gw, int NGW, int wave, int lane) {
    LAS float* scr = (LAS float*)(lds + wave * 16384);
    constexpr int I_IN = 32 * 257, I_OUT = 32 * 64, I_UP = 32 * 256, I_DN = 128 * 64, I_L = I_IN + I_OUT + I_UP + I_DN;
    for (int it = gw; it < NLAYER * I_L; it += NGW) {
        const int l = it / I_L; int r = it % I_L;
        if (r < I_IN) { const int kb = r / 257, nb = r % 257;
            bf16* dst = (nb < 96) ? X.Win_t + ((size_t)l * ZW + 32 * nb) * DM : (nb == 96) ? X.Wglr_t + (size_t)l * 32 * DM : X.Win_t + ((size_t)l * ZW + 32 * (nb - 1)) * DM;
            transpose_item(X.w_in + (size_t)l * DM * INW, INW, kb, nb, dst, DM, scr, lane); continue; }
        r -= I_IN;
        if (r < I_OUT) { const int kb = r / 64, nb = r % 64; transpose_item(X.w_out + (size_t)l * DM * DM, DM, kb, nb, X.Wout_t + ((size_t)l * DM + 32 * nb) * DM, DM, scr, lane); continue; }
        r -= I_OUT;
        if (r < I_UP) { const int kb = r / 256, nb = r % 256; transpose_item(X.w_up + (size_t)l * DM * DFF, DFF, kb, nb, X.Wup_t + ((size_t)l * DFF + 32 * nb) * DM, DM, scr, lane); continue; }
        r -= I_UP;
        { const int kb = r / 64, nb = r % 64; transpose_item(X.w_down + (size_t)l * DFF * DM, DM, kb, nb, X.Wdn_t + ((size_t)l * DM + 32 * nb) * DFF, DFF, scr, lane); }
    }
}
__device__ __forceinline__ void cvt_group(const float* xg, bf16* HB, int gtid, int NT) {
    for (int i = gtid; i < GM * DM / 8; i += NT) {
        const f32x4 a = ((const GAS f32x4*)xg)[2 * i], b = ((const GAS f32x4*)xg)[2 * i + 1];
        v4u o; o.x = pkbf(a.x, a.y); o.y = pkbf(a.z, a.w); o.z = pkbf(b.x, b.y); o.w = pkbf(b.z, b.w);
        ((GAS v4u*)HB)[i] = o; }
}
__device__ __forceinline__ void ln_phase(const float* res, const float* mf, const float* gam, const float* bet, float* H, bf16* HB, int gw, int NGW, int lane) {
    for (int m = gw; m < GM; m += NGW) {
        const GAS f32x4* rr = (const GAS f32x4*)(res + (size_t)m * DM) + lane; const GAS f32x4* mr = (const GAS f32x4*)(mf + (size_t)m * DM) + lane;
        f32x4 v[8]; float s = 0.f;
#pragma unroll
        for (int j = 0; j < 8; ++j) { v[j] = rr[64 * j] * ALPHA + mr[64 * j]; s += (v[j].x + v[j].y) + (v[j].z + v[j].w); }
        const float mean = wave_sum(s) * (1.f / DM); float s2 = 0.f;
#pragma unroll
        for (int j = 0; j < 8; ++j) { v[j] = v[j] - mean; s2 += (v[j].x * v[j].x + v[j].y * v[j].y) + (v[j].z * v[j].z + v[j].w * v[j].w); }
        const float rstd = 1.f / sqrtf(wave_sum(s2) * (1.f / DM) + LN_EPS);
        GAS f32x4* ho = (GAS f32x4*)(H + (size_t)m * DM) + lane; GAS v2u* hb = (GAS v2u*)(HB + (size_t)m * DM) + lane;
#pragma unroll
        for (int j = 0; j < 8; ++j) { const f32x4 g4 = ((const GAS f32x4*)gam)[lane + 64 * j], b4 = ((const GAS f32x4*)bet)[lane + 64 * j];
            const f32x4 o = v[j] * rstd * g4 + b4; ho[64 * j] = o; v2u w; w.x = pkbf(o.x, o.y); w.y = pkbf(o.z, o.w); hb[64 * j] = w; }
    }
}

__device__ __forceinline__ void gate_unit(const Ctx& X, int l, int chunk, LAS unsigned char* lds, int tid, int lane, int wave) {
    const int fr = lane & 15, fq = lane >> 4;
    const bf16* A = X.HB + (size_t)chunk * 64 * DM; const bf16* Bw = X.Wglr_t + (size_t)l * 32 * DM;
    f32x4 acc[4][2];
#pragma unroll
    for (int m = 0; m < 4; ++m)
#pragma unroll
        for (int n = 0; n < 2; ++n) acc[m][n] = (f32x4){0.f, 0.f, 0.f, 0.f};
#pragma unroll 2
    for (int ks = 0; ks < 8; ++ks) { const int k0 = 256 * wave + 32 * ks + 8 * fq;
        bf16x8 a[4], b[2];
#pragma unroll
        for (int m = 0; m < 4; ++m) a[m] = *(const GAS bf16x8*)(A + (size_t)(16 * m + fr) * DM + k0);
#pragma unroll
        for (int n = 0; n < 2; ++n) b[n] = *(const GAS bf16x8*)(Bw + (size_t)(16 * n + fr) * DM + k0);
#pragma unroll
        for (int m = 0; m < 4; ++m)
#pragma unroll
            for (int n = 0; n < 2; ++n) acc[m][n] = __builtin_amdgcn_mfma_f32_16x16x32_bf16(a[m], b[n], acc[m][n], 0, 0, 0); }
    LAS float* part = (LAS float*)lds;
#pragma unroll
    for (int m = 0; m < 4; ++m)
#pragma unroll
        for (int n = 0; n < 2; ++n)
#pragma unroll
            for (int j = 0; j < 4; ++j) part[(wave * 64 + 16 * m + 4 * fq + j) * 33 + 16 * n + fr] = acc[m][n][j];
    __syncthreads();
    LAS float* glr = (LAS float*)(lds + 8 * 64 * 33 * 4);
#pragma unroll
    for (int k = 0; k < 4; ++k) { const int idx = tid + 512 * k, t = idx >> 5, n = idx & 31; float s = 0.f;
#pragma unroll
        for (int w = 0; w < 8; ++w) s += part[(w * 64 + t) * 33 + n];
        glr[t * 33 + n] = s; }
    __syncthreads();
    const int dir = wave >> 2, cbase = 128 * (wave & 3);
    float gl[16];
#pragma unroll
    for (int r = 0; r < 16; ++r) gl[r] = glr[lane * 33 + dir * 16 + r];
    const float* w2 = X.w_lr2 + (size_t)(l * 2 + dir) * 16 * 512; const float* bl = X.b_lr + (size_t)(l * 2 + dir) * 512;
    float* bgrow = X.BG + (size_t)(chunk * 64 + lane) * 1024 + dir * 512;
    for (int c4 = 0; c4 < 32; ++c4) { const int c = cbase + 4 * c4; f32x4 o;
#pragma unroll
        for (int u = 0; u < 4; ++u) { float pre = bl[c + u];
#pragma unroll
            for (int r = 0; r < 16; ++r) pre += gl[r] * w2[r * 512 + c + u];
            const float g = (fminf(pre, 0.f) - __logf(1.f + __expf(-fabsf(pre)))) * (LOG2E / 16.f);
            const float p = wave_scan_incl(g, lane);
            const float tot = __shfl(p, 63);
            o[u] = dir ? (tot - p + g) : p; }
        *(GAS f32x4*)(bgrow + c) = o; }
    __syncthreads();
}

template <bool HGT, bool PC>
__device__ __forceinline__ void scan_stage(const Ctx& X, int l, int chunk, int h, int dir, LAS unsigned char* lds, int lane, int wave, float* tot_out) {
    const int r = lane, tok = chunk * 64 + (dir ? 63 - r : r), c0 = 16 * wave;
    const bf16* zrow = X.Z + (size_t)tok * ZW;
    float bc[16], kr[16], qv[16];
    if (!HGT) {
        const GAS f32x4* bg = (const GAS f32x4*)(X.BG + (size_t)tok * 1024 + dir * 512 + h * 128 + c0);
#pragma unroll
        for (int i = 0; i < 4; ++i) { const f32x4 t = bg[i]; bc[4 * i] = t.x; bc[4 * i + 1] = t.y; bc[4 * i + 2] = t.z; bc[4 * i + 3] = t.w; }
        const GAS v4u* kp = (const GAS v4u*)(zrow + ZC_GK + h * 128 + c0); unpack8(kp[0], kr); unpack8(kp[1], kr + 8);
        if (PC) { const GAS v4u* qp = (const GAS v4u*)(zrow + ZC_GQ + h * 128 + c0); unpack8(qp[0], qv); unpack8(qp[1], qv + 8);
#pragma unroll
            for (int i = 0; i < 16; ++i) qv[i] *= 0.08838834764831845f; }
    } else {
        float zf[16];
        const GAS v4u* zp = (const GAS v4u*)(zrow + (dir ? ZC_HFB : ZC_HFF) + h * 128 + c0); unpack8(zp[0], zf); unpack8(zp[1], zf + 8);
        const float* lp = X.lowb + (size_t)dir * 2 * 1024 + h * 128 + c0;
#pragma unroll
        for (int i = 0; i < 16; ++i) {
            const float lb = (l == 0) ? 0.f : 1.f / (1.f + __expf(lp[i] - lp[1024 + i]));
            const float z = fminf(fmaxf(zf[i], -80.f), 80.f), e = __expf(-z), sig = 1.f / (1.f + e);
            const float f = lb + (1.f - lb) * sig;
            kr[i] = (1.f - lb) * e * sig;
            bc[i] = wave_scan_incl(flog2(f), lane); }
        if (PC) { const GAS v4u* qp = (const GAS v4u*)(zrow + ZC_HQ + h * 128 + c0); unpack8(qp[0], qv); unpack8(qp[1], qv + 8); }
    }
    LAS unsigned char* kdst = lds + L_KR + r * K_STR + c0 * 2;
    if (PC) {
        LAS f32x4* bdst = (LAS f32x4*)(lds + L_B32 + r * B32_STR + c0 * 4);
#pragma unroll
        for (int i = 0; i < 4; ++i) bdst[i] = (f32x4){bc[4 * i], bc[4 * i + 1], bc[4 * i + 2], bc[4 * i + 3]};
        ((LAS v4u*)kdst)[0] = pack8(kr); ((LAS v4u*)kdst)[1] = pack8(kr + 8);
        LAS unsigned char* qdst = lds + L_QR + r * K_STR + c0 * 2;
        ((LAS v4u*)qdst)[0] = pack8(qv); ((LAS v4u*)qdst)[1] = pack8(qv + 8);
        float qh[16];
#pragma unroll
        for (int i = 0; i < 16; ++i) qh[i] = qv[i] * fexp2(bc[i]);
        LAS unsigned char* hdst = lds + L_QH + r * K_STR + c0 * 2;
        ((LAS v4u*)hdst)[0] = pack8(qh); ((LAS v4u*)hdst)[1] = pack8(qh + 8);
    } else {
        float kh[16];
#pragma unroll
        for (int i = 0; i < 16; ++i) { const float bl = __shfl(bc[i], 63); kh[i] = (KMODE == 10) ? kr[i] : kr[i] * fexp2(bl - bc[i]); }
        { const v4u k0 = pack8(kh), k1 = pack8(kh + 8); const unsigned kw[8] = {k0.x, k0.y, k0.z, k0.w, k1.x, k1.y, k1.z, k1.w};
#pragma unroll
          for (int i = 0; i < 16; ++i) *(LAS unsigned short*)(lds + L_KR + (c0 + i) * KT_STR + r * 2) = (unsigned short)((i & 1) ? (kw[i >> 1] >> 16) : (kw[i >> 1] & 0xffffu)); }
        if (lane == 63) {
#pragma unroll
            for (int i = 0; i < 4; ++i) ((GAS f32x4*)(tot_out + c0))[i] = (f32x4){bc[4 * i], bc[4 * i + 1], bc[4 * i + 2], bc[4 * i + 3]}; }
    }
}
template <int DV>
__device__ __forceinline__ void stage_v(const Ctx& X, int chunk, int vcol, LAS unsigned char* lds, int tid) {
    constexpr int PPR = DV / 8, VSTR = DV * 2 + 16;
#pragma unroll
    for (int k = 0; k < 64 * PPR / 512; ++k) { const int idx = tid + 512 * k, row = idx / PPR, pc = idx % PPR;
        const v4u v = *(const GAS v4u*)(X.Z + (size_t)(chunk * 64 + row) * ZW + vcol + pc * 8);
        *(LAS v4u*)(lds + L_V + row * VSTR + pc * 16) = v; }
}
__device__ __forceinline__ size_t st_slot(int chunk, bool hgt, int h, int dir) { return (size_t)chunk * ST_CHUNK + (hgt ? 262144 + (h * 2 + dir) * 16384 : (h * 2 + dir) * 32768); }

template <bool HGT>
__device__ __forceinline__ void pass_a_unit(const Ctx& X, int l, int chunk, int h, LAS unsigned char* lds, int tid, int lane, int wave) {
    constexpr int DV = HGT ? 128 : 256, VSTR = DV * 2 + 16, NET = DV / 128;
    const int fr = lane & 15, fq = lane >> 4, qq = fr >> 2, p4 = fr & 3;
    stage_v<DV>(X, chunk, HGT ? ZC_HI + h * 128 : ZC_GV + h * 256, lds, tid);
    for (int dir = 0; dir < 2; ++dir) {
        const int hd = HGT ? 8 + h * 2 + dir : h * 2 + dir;
        scan_stage<HGT, false>(X, l, chunk, h, dir, lds, lane, wave, X.TOT + ((size_t)chunk * 24 + hd) * 128);
        __syncthreads();
        f32x4 acc[8][NET];
#pragma unroll
        for (int dt = 0; dt < 8; ++dt)
#pragma unroll
            for (int et = 0; et < NET; ++et) acc[dt][et] = (f32x4){0.f, 0.f, 0.f, 0.f};
#pragma unroll
        for (int ks = 0; ks < 2; ++ks) {
            const int r0 = 32 * ks + 8 * fq + qq, r1 = r0 + 4;
            const int v0 = dir ? 63 - r0 : r0, v1 = dir ? 63 - r1 : r1;
            bf16x8 bfr[NET];
#pragma unroll
            for (int et = 0; et < NET; ++et) { const int col = (16 * (wave * NET + et) + 4 * p4) * 2;
                bfr[et] = tr_pair(lds + L_V + v0 * VSTR + col, lds + L_V + v1 * VSTR + col); }
#pragma unroll
            for (int dt = 0; dt < 8; ++dt) { const int col = (16 * dt + 4 * p4) * 2;
                const bf16x8 afr = *(const LAS bf16x8*)(lds + L_KR + (16 * dt + fr) * KT_STR + (32 * ks + 8 * fq) * 2); (void)col;
#pragma unroll
                for (int et = 0; et < NET; ++et) acc[dt][et] = __builtin_amdgcn_mfma_f32_16x16x32_bf16(afr, bfr[et], acc[dt][et], 0, 0, 0); }
        }
        bf16* slot = X.ST + st_slot(chunk, HGT, h, dir);
#pragma unroll
        for (int dt = 0; dt < 8; ++dt)
#pragma unroll
            for (int et = 0; et < NET; ++et) { const int e = 16 * (wave * NET + et) + fr, d = 16 * dt + 4 * fq;
                v2u w; w.x = pkbf(acc[dt][et][0], acc[dt][et][1]); w.y = pkbf(acc[dt][et][2], acc[dt][et][3]);
                if (KMODE == 6) { w.x = 0x3c003c00u; w.y = 0x3c003c00u; }
                if (KMODE == 9) { const float p0 = (float)(((e * 131 + d * 17 + chunk * 7 + dir * 3) & 255) - 128) * (1.f / 16.f); w.x = pkbf(p0, -p0 * 0.5f); w.y = pkbf(p0 * 0.25f, p0 + 1.f); }
                *(GAS v2u*)(slot + e * 128 + d) = w; }
        __syncthreads();
    }
}

__device__ __forceinline__ void pass_b(const Ctx& X, int g, int gtid, int NT) {
    const int ns = (g == 0) ? 1 : 2, nc = NCHUNK / ns;
    for (int v = gtid; v < ns * (ST_CHUNK / 8); v += NT) {
        const int s = v / (ST_CHUNK / 8), idx = (v % (ST_CHUNK / 8)) * 8;
        const int hd = idx < 262144 ? idx / 32768 : 8 + (idx - 262144) / 16384, db = hd & 1, d0 = idx & 127;
        float S[8];
#pragma unroll
        for (int i = 0; i < 8; ++i) S[i] = 0.f;
        for (int cc = 0; cc < nc; cc += 4) {
            v4u x[4]; f32x4 t0[4], t1[4];
#pragma unroll
            for (int u = 0; u < 4; ++u) { const int c = s * nc + (db ? nc - 1 - (cc + u) : cc + u);
                x[u] = *(const GAS v4u*)(X.ST + (size_t)c * ST_CHUNK + idx);
                const GAS f32x4* tp = (const GAS f32x4*)(X.TOT + ((size_t)c * 24 + hd) * 128 + d0); t0[u] = tp[0]; t1[u] = tp[1]; }
#pragma unroll
            for (int u = 0; u < 4; ++u) { const int c = s * nc + (db ? nc - 1 - (cc + u) : cc + u);
                *(GAS v4u*)(X.ST + (size_t)c * ST_CHUNK + idx) = pack8(S);
                float dx[8]; unpack8(x[u], dx);
                const float dec[8] = {fexp2(t0[u].x), fexp2(t0[u].y), fexp2(t0[u].z), fexp2(t0[u].w), fexp2(t1[u].x), fexp2(t1[u].y), fexp2(t1[u].z), fexp2(t1[u].w)};
#pragma unroll
                for (int i = 0; i < 8; ++i) S[i] = dec[i] * S[i] + dx[i]; }
        }
    }
}

template <bool HGT>
__device__ __forceinline__ void pass_c_unit(const Ctx& X, int l, int chunk, int h, LAS unsigned char* lds, int tid, int lane, int wave) {
    constexpr int DV = HGT ? 128 : 256, VSTR = DV * 2 + 16, NET = DV / 128;
    const int fr = lane & 15, fq = lane >> 4, qq = fr >> 2, p4 = fr & 3;
    stage_v<DV>(X, chunk, HGT ? ZC_HI + h * 128 : ZC_GV + h * 256, lds, tid);
    f32x4 oacc[NET][4];
#pragma unroll
    for (int et = 0; et < NET; ++et)
#pragma unroll
        for (int it = 0; it < 4; ++it) oacc[et][it] = (f32x4){0.f, 0.f, 0.f, 0.f};
    for (int dir = 0; dir < 2; ++dir) {
        scan_stage<HGT, true>(X, l, chunk, h, dir, lds, lane, wave, nullptr);
        const bf16* slot = X.ST + st_slot(chunk, HGT, h, dir);
        bf16x8 sfr[NET][4];
#pragma unroll
        for (int et = 0; et < NET; ++et)
#pragma unroll
            for (int ks = 0; ks < 4; ++ks) sfr[et][ks] = (KMODE == 3 || KMODE == 7) ? (bf16x8){0, 0, 0, 0, 0, 0, 0, 0} : *(const GAS bf16x8*)(slot + (size_t)(16 * (wave * NET + et) + fr) * 128 + 32 * ks + 8 * fq);
        __syncthreads();
        { const int I = wave & 3, par = wave >> 2;
#pragma unroll
          for (int jt = 0; jt < 2; ++jt) { const int J = par + 2 * jt;
            LAS unsigned char* pdst = lds + L_P + (16 * I + fr) * P_STR + (16 * J + 4 * fq) * 2;
            if (J > I) { *(LAS v2u*)pdst = (v2u){0u, 0u}; }
            else {
                const int rho = (J == I) ? 16 * I + 8 : 16 * I - 1, ri = 16 * I + fr, rj = 16 * J + fr;
                f32x4 sc = (f32x4){0.f, 0.f, 0.f, 0.f};
#pragma unroll
                for (int ks = 0; ks < 4; ++ks) { const int dc = 32 * ks + 8 * fq;
                    float br[8], bi[8], bj[8], qf[8], kf[8];
                    { const LAS f32x4* t = (const LAS f32x4*)(lds + L_B32 + rho * B32_STR + dc * 4); const f32x4 a = t[0], b = t[1]; br[0] = a.x; br[1] = a.y; br[2] = a.z; br[3] = a.w; br[4] = b.x; br[5] = b.y; br[6] = b.z; br[7] = b.w; }
                    { const LAS f32x4* t = (const LAS f32x4*)(lds + L_B32 + ri * B32_STR + dc * 4); const f32x4 a = t[0], b = t[1]; bi[0] = a.x; bi[1] = a.y; bi[2] = a.z; bi[3] = a.w; bi[4] = b.x; bi[5] = b.y; bi[6] = b.z; bi[7] = b.w; }
                    { const LAS f32x4* t = (const LAS f32x4*)(lds + L_B32 + rj * B32_STR + dc * 4); const f32x4 a = t[0], b = t[1]; bj[0] = a.x; bj[1] = a.y; bj[2] = a.z; bj[3] = a.w; bj[4] = b.x; bj[5] = b.y; bj[6] = b.z; bj[7] = b.w; }
                    unpack8(*(const LAS v4u*)(lds + L_QR + ri * K_STR + dc * 2), qf);
                    unpack8(*(const LAS v4u*)(lds + L_KR + rj * K_STR + dc * 2), kf);
#pragma unroll
                    for (int i = 0; i < 8; ++i) { qf[i] *= fexp2(fminf(bi[i] - br[i], 80.f)); kf[i] *= fexp2(fminf(br[i] - bj[i], 80.f)); }
                    const v4u qa = pack8(qf), ka = pack8(kf);
                    sc = __builtin_amdgcn_mfma_f32_16x16x32_bf16(__builtin_bit_cast(bf16x8, ka), __builtin_bit_cast(bf16x8, qa), sc, 0, 0, 0); }
                if (J == I) {
#pragma unroll
                    for (int t = 0; t < 4; ++t) if (4 * fq + t > fr) sc[t] = 0.f; }
                v2u w; w.x = pkbf(sc[0], sc[1]); w.y = pkbf(sc[2], sc[3]); *(LAS v2u*)pdst = w; }
          } }
        __syncthreads();
        bf16x8 vfr[NET][2];
#pragma unroll
        for (int ks = 0; ks < 2; ++ks) { const int r0 = 32 * ks + 8 * fq + qq, r1 = r0 + 4, v0 = dir ? 63 - r0 : r0, v1 = dir ? 63 - r1 : r1;
#pragma unroll
            for (int et = 0; et < NET; ++et) { const int col = (16 * (wave * NET + et) + 4 * p4) * 2;
                vfr[et][ks] = tr_pair(lds + L_V + v0 * VSTR + col, lds + L_V + v1 * VSTR + col); } }
#pragma unroll
        for (int it = 0; it < 4; ++it) { const int trow = 16 * it + fr, ip = dir ? 63 - trow : trow;
#pragma unroll
            for (int ks = 0; ks < 4; ++ks) { const bf16x8 bq = *(const LAS bf16x8*)(lds + L_QH + ip * K_STR + (32 * ks + 8 * fq) * 2);
#pragma unroll
                for (int et = 0; et < NET; ++et) oacc[et][it] = __builtin_amdgcn_mfma_f32_16x16x32_bf16(sfr[et][ks], bq, oacc[et][it], 0, 0, 0); }
#pragma unroll
            for (int ks = 0; ks < 2; ++ks) { const bf16x8 bp = *(const LAS bf16x8*)(lds + L_P + ip * P_STR + (32 * ks + 8 * fq) * 2);
#pragma unroll
                for (int et = 0; et < NET; ++et) oacc[et][it] = __builtin_amdgcn_mfma_f32_16x16x32_bf16(vfr[et][ks], bp, oacc[et][it], 0, 0, 0); } }
        __syncthreads();
    }
    LAS float* red = (LAS float*)(lds + L_RED);
#pragma unroll
    for (int it = 0; it < 4; ++it) { float s = 0.f;
#pragma unroll
        for (int et = 0; et < NET; ++et) { const f32x4 o = oacc[et][it]; s += (o.x * o.x + o.y * o.y) + (o.z * o.z + o.w * o.w); }
        s += __shfl_xor(s, 16); s += __shfl_xor(s, 32);
        if (fq == 0) red[wave * 64 + 16 * it + fr] = s; }
    __syncthreads();
    const float* ng = (HGT ? X.hg_g + (size_t)l * 128 : X.gla_g + (size_t)l * 256);
    const int ogcol = HGT ? ZC_HOG + h * 128 : ZC_GOG + h * 256, ocol = HGT ? 1024 + h * 128 : h * 256;
#pragma unroll
    for (int it = 0; it < 4; ++it) { float tot = 0.f;
#pragma unroll
        for (int w = 0; w < 8; ++w) tot += red[w * 64 + 16 * it + fr];
        const float rstd = 1.f / sqrtf(tot * (1.f / DV) + RMS_EPS);
        const int tok = chunk * 64 + 16 * it + fr;
#pragma unroll
        for (int et = 0; et < NET; ++et) { const int e0 = 16 * (wave * NET + et) + 4 * fq;
            const v2u ogp = *(const GAS v2u*)(X.Z + (size_t)tok * ZW + ogcol + e0);
            const float og[4] = {__uint_as_float(ogp.x << 16), __uint_as_float(ogp.x & 0xffff0000u), __uint_as_float(ogp.y << 16), __uint_as_float(ogp.y & 0xffff0000u)};
            const f32x4 g4 = *(const GAS f32x4*)(ng + e0); float r[4];
#pragma unroll
            for (int t = 0; t < 4; ++t) { const float z = fminf(fmaxf(og[t], -80.f), 80.f); r[t] = oacc[et][it][t] * rstd * g4[t] * (z / (1.f + __expf(-z))); }
            v2u w; w.x = pkbf(r[0], r[1]); w.y = pkbf(r[2], r[3]);
            *(GAS v2u*)(X.O + (size_t)tok * DM + ocol + e0) = w; } }
    __syncthreads();
}

struct Args { const float* in[15]; float* out; unsigned char* ws; int mode, pad; };
#define PHASE_IDS() int tid = threadIdx.x; asm volatile("" : "+v"(tid)); const int lane = tid & 63, wave = __builtin_amdgcn_readfirstlane(tid >> 6); \
    const int gw = bx * NWAVES + wave, NGW = G * NWAVES, gtid = bx * (NWAVES * 64) + tid, NT = G * NWAVES * 64; (void)lane; (void)wave; (void)gw; (void)NGW; (void)gtid; (void)NT
__device__ __forceinline__ Ctx make_ctx(const Args& args) {
    Ctx X; unsigned char* ws = args.ws;
    X.x_prompt = args.in[0]; X.x_sample = args.in[1]; X.w_in = args.in[2]; X.w_lr2 = args.in[3]; X.b_lr = args.in[4]; X.gla_g = args.in[5]; X.hg_g = args.in[6]; X.lowb = args.in[7];
    X.w_out = args.in[8]; X.ln1_g = args.in[9]; X.ln1_b = args.in[10]; X.w_up = args.in[11]; X.w_down = args.in[12]; X.ln2_g = args.in[13]; X.ln2_b = args.in[14]; X.out = args.out;
    X.Win_t = (bf16*)(ws + WS_WIN); X.Wout_t = (bf16*)(ws + WS_WOUT); X.Wup_t = (bf16*)(ws + WS_WUP); X.Wdn_t = (bf16*)(ws + WS_WDN); X.Wglr_t = (bf16*)(ws + WS_WGLR);
    X.HB = (bf16*)(ws + WS_HB); X.Z = (bf16*)(ws + WS_Z); X.O = (bf16*)(ws + WS_O); X.ST = (bf16*)(ws + WS_ST);
    X.BG = (float*)(ws + WS_BG); X.MF = (float*)(ws + WS_ST); X.TOT = (float*)(ws + WS_TOT);
    return X;
}
__global__ void __launch_bounds__(NWAVES * 64, 2) fwd_kernel(Args args) {
    extern __shared__ __attribute__((aligned(16))) unsigned char lds_raw[];
    LAS unsigned char* lds = (LAS unsigned char*)lds_raw;
    const int G = gridDim.x, bx = blockIdx.x;
    volatile LAS unsigned* MISC = (volatile LAS unsigned*)(lds + MISC_OFF);
    if (threadIdx.x < 32) MISC[threadIdx.x] = 0u;
    __syncthreads();
    XcdBarrier bar = xcd_barrier_post((unsigned*)(args.ws + WS_CTL) + CW_BAR, MISC + 8);

    { PHASE_IDS(); const Ctx X = make_ctx(args); prologue_weights(X, lds, gw, NGW, wave, lane); }
    for (int g = 0; g < NGRP; ++g) {
        { PHASE_IDS(); const Ctx X = make_ctx(args); cvt_group((g == 0) ? X.x_prompt : X.x_sample + (size_t)(g - 1) * GM * DM, X.HB, gtid, NT); }
        xcd_barrier(bar);
        for (int l = 0; l < NLAYER; ++l) {
            { PHASE_IDS(); const Ctx X = make_ctx(args); for (int c = bx; c < NCHUNK; c += G) gate_unit(X, l, c, lds, tid, lane, wave); }
            { const Ctx X = make_ctx(args); pg8::Gemm gm{X.HB, X.Win_t + (size_t)l * ZW * DM, GM, ZW, DM}; pg8::StaticOrder S; S.init(GM, ZW, G, bx);
              pg8::EpiBf16<0> E{X.Z, ZW};
              pg8::gemm_phase<pg8::EpiBf16<0>, pg8::StaticOrder, true, true>(lds, gm, S, E); }
            xcd_barrier(bar);
            if (KMODE != 1) {
            if (KMODE != 3) { PHASE_IDS(); const Ctx X = make_ctx(args);
              for (int u = bx; u < NCHUNK * 12; u += G) { const int c = u / 12, hh = u % 12;
                if (hh < 4) pass_a_unit<false>(X, l, c, hh, lds, tid, lane, wave); else pass_a_unit<true>(X, l, c, hh - 4, lds, tid, lane, wave); } }
            xcd_barrier(bar);
            if (KMODE == 0 || KMODE == 11) { PHASE_IDS(); const Ctx X = make_ctx(args); pass_b(X, g, gtid, NT); }
            xcd_barrier(bar);
            { PHASE_IDS(); const Ctx X = make_ctx(args);
              for (int u = bx; u < NCHUNK * 12; u += G) { const int c = u / 12, hh = u % 12;
                if (hh < 4) pass_c_unit<false>(X, l, c, hh, lds, tid, lane, wave); else pass_c_unit<true>(X, l, c, hh - 4, lds, tid, lane, wave); } }
            xcd_barrier(bar);
            } else {
                { PHASE_IDS(); const Ctx X = make_ctx(args); for (int i = gtid; i < GM * DM / 8; i += NT) ((GAS v4u*)X.O)[i] = (v4u){0u, 0u, 0u, 0u}; }
                xcd_barrier(bar);
            }
            { const Ctx X = make_ctx(args); pg8::Gemm gm{X.O, X.Wout_t + (size_t)l * DM * DM, GM, DM, DM}; pg8::StaticOrder S; S.init(GM, DM, G, bx);
              pg8::EpiF32 E{X.MF, DM};
              pg8::gemm_phase<pg8::EpiF32, pg8::StaticOrder, true, true>(lds, gm, S, E); }
            xcd_barrier(bar);
            { PHASE_IDS(); const Ctx X = make_ctx(args); float* Hg = X.out + (size_t)g * GM * DM;
              const float* xg = (g == 0) ? X.x_prompt : X.x_sample + (size_t)(g - 1) * GM * DM;
              ln_phase(l == 0 ? xg : Hg, X.MF, X.ln1_g + (size_t)l * DM, X.ln1_b + (size_t)l * DM, Hg, X.HB, gw, NGW, lane); }
            xcd_barrier(bar);
            { const Ctx X = make_ctx(args); pg8::Gemm gm{X.HB, X.Wup_t + (size_t)l * DFF * DM, GM, DFF, DM}; pg8::StaticOrder S; S.init(GM, DFF, G, bx);
              pg8::EpiBf16<1> E{X.Z, DFF};
              pg8::gemm_phase<pg8::EpiBf16<1>, pg8::StaticOrder, true, true>(lds, gm, S, E); }
            xcd_barrier(bar);
            { const Ctx X = make_ctx(args); pg8::Gemm gm{X.Z, X.Wdn_t + (size_t)l * DM * DFF, GM, DM, DFF}; pg8::StaticOrder S; S.init(GM, DM, G, bx);
              pg8::EpiF32 E{X.MF, DM};
              pg8::gemm_phase<pg8::EpiF32, pg8::StaticOrder, true, true>(lds, gm, S, E); }
            xcd_barrier(bar);
            { PHASE_IDS(); const Ctx X = make_ctx(args); float* Hg = X.out + (size_t)g * GM * DM;
              ln_phase(Hg, X.MF, X.ln2_g + (size_t)l * DM, X.ln2_b + (size_t)l * DM, Hg, X.HB, gw, NGW, lane); }
            xcd_barrier(bar);
        }
    }
}

extern "C" void kernel_launch(void* const* d_in, const int* in_sizes, int n_in, void* d_out, int out_size, void* d_ws, size_t ws_size, hipStream_t stream) {
    static int grid = 0;
    if (grid == 0) {
        if (n_in != 15 || out_size != NTOK * DM || ws_size < WS_END) { fprintf(stderr, "kernel_launch: unexpected shapes (n_in %d, out %d, ws %zu)\n", n_in, out_size, ws_size); grid = -1; return; }
        int dev = 0, cus = 0;
        if (hipGetDevice(&dev) != hipSuccess || hipDeviceGetAttribute(&cus, hipDeviceAttributeMultiprocessorCount, dev) != hipSuccess) { grid = -1; return; }
        if (hipFuncSetAttribute((const void*)fwd_kernel, hipFuncAttributeMaxDynamicSharedMemorySize, LDS_BYTES) != hipSuccess) { fprintf(stderr, "kernel_launch: hipFuncSetAttribute failed\n"); grid = -1; return; }
        int per_cu = 0;
        if (hipOccupancyMaxActiveBlocksPerMultiprocessor(&per_cu, (const void*)fwd_kernel, NWAVES * 64, LDS_BYTES) != hipSuccess || per_cu < 1) { fprintf(stderr, "kernel_launch: occupancy query says %d\n", per_cu); }
        (void)hipGetLastError();
        grid = cus;
    }
    if (grid < 0) return;
    if (hipMemsetAsync((char*)d_ws + WS_CTL, 0, CTL_ZERO_BYTES, stream) != hipSuccess) return;
    Args a{};
    for (int i = 0; i < 15; ++i) a.in[i] = (const float*)d_in[i];
    a.out = (float*)d_out; a.ws = (unsigned char*)d_ws; a.mode = KMODE; a.pad = 0;
    hipLaunchKernelGGL(fwd_kernel, dim3(grid), dim3(NWAVES * 64), LDS_BYTES, stream, a);
}
```

```cpp
#include <hip/hip_runtime.h>
#include <cstdio>
#include <cstdint>
#ifndef KMODE
#define KMODE 0
#endif
namespace pg8 {
#define PG8_LAS __attribute__((address_space(3)))
typedef unsigned short bf16_t;
typedef short bf16x8 __attribute__((ext_vector_type(8)));
typedef float f32x4 __attribute__((ext_vector_type(4)));
typedef unsigned u32x4 __attribute__((ext_vector_type(4)));
constexpr int BM = 256, BK = 64, HALF = 128, HTB = HALF * BK * 2  , STAGE_BYTES = 8 * HTB, NXCD = 8, WGM = 8;

__host__ __device__ __forceinline__ int lds_byte(int r, int c) { const int st = (r >> 4) * 2 + (c >> 5), rr = r & 15, cc = c & 31, ob = rr * 64 + cc * 2; return st * 1024 + (ob ^ (((ob >> 9) & 1) << 5)); }
__host__ __device__ __forceinline__ void stage_rc(int b, int& R, int& C) { const int st = b / 1024, sb = b % 1024, swz = sb ^ (((sb >> 9) & 1) << 5); R = (st >> 1) * 16 + swz / 64; C = (st & 1) * 32 + (swz % 64) / 2; }
__host__ __device__ __forceinline__ int perm32(int rho) { const int n = rho >> 4, i = rho & 15; return 8 * (i >> 2) + 4 * n + (i & 3); }

struct Unit { int pm, pn; };
struct Gemm { const bf16_t* A; const bf16_t* Bt; int M, N, K; };

struct StaticOrder {
    int nM, nN, nwg, G, c;
    __host__ __device__ void init(int M, int N, int G_, int c_) { nM = M / BM; nN = N / BM; nwg = nM * nN; G = G_; c = c_; }
    __host__ __device__ bool next(int i, Unit& u) const {
        const long L = (long)i * G + c; if (L >= nwg) return false;
        int wgid = (int)L; { const int q = nwg / NXCD, r = nwg % NXCD, xcd = wgid % NXCD, off = wgid / NXCD; wgid = (xcd < r ? xcd * (q + 1) : r * (q + 1) + (xcd - r) * q) + off; }
        const int nig = WGM * nN, gid = wgid / nig, fm = gid * WGM, gsz = (nM - fm) < WGM ? (nM - fm) : WGM;
        u.pm = fm + ((wgid % nig) % gsz); u.pn = (wgid % nig) / gsz; return true;
    }
    __device__ __forceinline__ void a_ready(const Unit&) const {}
    __device__ __forceinline__ void done(const Unit&) const {}
};


__device__ __forceinline__ unsigned cvt_pk_bf16(float lo, float hi) { unsigned r; asm volatile("v_cvt_pk_bf16_f32 %0, %1, %2" : "=v"(r) : "v"(lo), "v"(hi)); return r; }

template <int ACT  > struct EpiBf16 {
    static constexpr bool PERM = true, AFTER_DRAIN = false;
    bf16_t* O; int ldc;
    __device__ __forceinline__ void operator()(const f32x4 (&acc)[2][2][4][2], const Unit& u, int wr, int wc, int fr, int fq) const {
        const int row0 = u.pm * BM + wr * 64 + fr; const int col0 = u.pn * BM + wc * 32 + 8 * fq;
#pragma unroll
        for (int ai = 0; ai < 2; ++ai)
#pragma unroll
            for (int m = 0; m < 4; ++m) { bf16_t* rowp = O + (size_t)(row0 + ai * HALF + m * 16) * ldc + col0;
#pragma unroll
                for (int bj = 0; bj < 2; ++bj) { f32x4 v0 = acc[ai][bj][m][0], v1 = acc[ai][bj][m][1];
                    if (ACT == 1) {
#pragma unroll
                        for (int j = 0; j < 4; ++j) { const float a = fmaxf(v0[j], 0.f), b = fmaxf(v1[j], 0.f); v0[j] = a * a; v1[j] = b * b; } }
                    u32x4 w; w.x = cvt_pk_bf16(v0[0], v0[1]); w.y = cvt_pk_bf16(v0[2], v0[3]); w.z = cvt_pk_bf16(v1[0], v1[1]); w.w = cvt_pk_bf16(v1[2], v1[3]);
                    *(u32x4*)(rowp + bj * HALF) = w; } }
    }
};
struct EpiF32 {
    static constexpr bool PERM = false, AFTER_DRAIN = false;
    float* C; int ldc;
    __device__ __forceinline__ void operator()(const f32x4 (&acc)[2][2][4][2], const Unit& u, int wr, int wc, int fr, int fq) const {
        const int row0 = u.pm * BM + wr * 64 + fr, col0 = u.pn * BM + wc * 32 + 4 * fq;
#pragma unroll
        for (int ai = 0; ai < 2; ++ai)
#pragma unroll
            for (int m = 0; m < 4; ++m) { float* rowp = C + (size_t)(row0 + ai * HALF + m * 16) * ldc + col0;
#pragma unroll
                for (int bj = 0; bj < 2; ++bj)
#pragma unroll
                    for (int n = 0; n < 2; ++n) *(f32x4*)(rowp + bj * HALF + n * 16) = acc[ai][bj][m][n]; }
    }
};

template <class Epi, class Sched, bool ALIGN_EPI = false, bool SP2 = false>
__device__ __forceinline__ void gemm_phase(PG8_LAS unsigned char* lds, const Gemm g, const Sched& S, const Epi& E) {
    int tid_o = threadIdx.x; asm volatile("" : "+v"(tid_o));
    const int tid = tid_o, wid = __builtin_amdgcn_readfirstlane(tid >> 6), lane = tid & 63, wr = wid >> 2, wc = wid & 3, fr = lane & 15, fq = lane >> 4;
    const int K = g.K, nt = K / BK;
    unsigned voffA[2], voffB[2];
#pragma unroll
    for (int i = 0; i < 2; ++i) { int R, C; stage_rc(tid * 16 + i * 8192, R, C); const int Rb = Epi::PERM ? ((R & ~31) + perm32(R & 31)) : R;
        voffA[i] = (unsigned)(R * K + C) * 2u; voffB[i] = (unsigned)(Rb * K + C) * 2u; }
    const size_t kstep = (size_t)(BK * 2);
    const size_t hstep = (size_t)HALF * K * 2;
    const size_t tstep = 2 * hstep;
    const unsigned ldsw = (unsigned)wid * 1024u;
    const int aoff = lds_byte(wr * 64 + fr, fq * 8), boff = lds_byte(wc * 32 + fr, fq * 8);
#define PG8_SA(b, h) (((b) * 2 + (h)) * HTB)
#define PG8_SB(b, h) ((4 + (b) * 2 + (h)) * HTB)
#define PG8_STAGE(bufoff, gbase, voff) do { _Pragma("unroll") for (int _i = 0; _i < 2; ++_i) \
        __builtin_amdgcn_global_load_lds((const unsigned*)((const char*)(gbase) + (voff)[_i]), (PG8_LAS unsigned*)(lds + (bufoff) + ldsw + _i * 8192), 16, 0, 0); } while (0)
#define PG8_LDA(dst, b, h) do { _Pragma("unroll") for (int m = 0; m < 4; ++m) _Pragma("unroll") for (int k = 0; k < 2; ++k) dst[m][k] = *(const PG8_LAS bf16x8*)(lds + PG8_SA(b, h) + aoff + m * 2048 + k * 1024); } while (0)
#define PG8_LDB(dst, b, h) do { _Pragma("unroll") for (int n = 0; n < 2; ++n) _Pragma("unroll") for (int k = 0; k < 2; ++k) dst[n][k] = *(const PG8_LAS bf16x8*)(lds + PG8_SB(b, h) + boff + n * 2048 + k * 1024); } while (0)
#define PG8_MMA(ai, bj, At, Bt) do { __builtin_amdgcn_s_setprio(1); _Pragma("unroll") for (int m = 0; m < 4; ++m) _Pragma("unroll") for (int n = 0; n < 2; ++n) _Pragma("unroll") for (int k = 0; k < 2; ++k) \
        acc[ai][bj][m][n] = __builtin_amdgcn_mfma_f32_16x16x32_bf16(Bt[n][k], At[m][k], acc[ai][bj][m][n], 0, 0, 0); __builtin_amdgcn_s_setprio(0); } while (0)
#define PG8_WAIT_V(n) asm volatile("s_waitcnt vmcnt(" #n ")" ::: "memory")
#define PG8_WAIT_L(n) asm volatile("s_waitcnt lgkmcnt(" #n ")" ::: "memory")
#define PG8_BAR __builtin_amdgcn_s_barrier()
#define PG8_SCHED __builtin_amdgcn_sched_barrier(0)
    Unit cur, nxt; int ui = 0;
    if (!S.next(0, cur)) return;
    f32x4 acc[2][2][4][2];
#pragma unroll
    for (int a = 0; a < 2; ++a)
#pragma unroll
        for (int b = 0; b < 2; ++b)
#pragma unroll
            for (int m = 0; m < 4; ++m)
#pragma unroll
                for (int n = 0; n < 2; ++n) acc[a][b][m][n] = (f32x4){0.f, 0.f, 0.f, 0.f};
    bf16x8 At[4][2], B0[2][2], B1[2][2];
    const char* cA = (const char*)g.A + (size_t)cur.pm * tstep; const char* cB = (const char*)g.Bt + (size_t)cur.pn * tstep;
    S.a_ready(cur);
    if constexpr (SP2) {
        PG8_STAGE(PG8_SB(0, 0), cB, voffB); PG8_STAGE(PG8_SB(0, 1), cB + hstep, voffB); PG8_STAGE(PG8_SA(0, 0), cA, voffA); PG8_STAGE(PG8_SA(0, 1), cA + hstep, voffA);
        if (wr == 1) PG8_BAR;
        PG8_WAIT_V(2); PG8_BAR;
        PG8_STAGE(PG8_SB(1, 0), cB + kstep, voffB); PG8_STAGE(PG8_SA(1, 0), cA + kstep, voffA); PG8_STAGE(PG8_SB(1, 1), cB + hstep + kstep, voffB);
        PG8_WAIT_V(6); PG8_BAR;
    } else {
        PG8_STAGE(PG8_SB(0, 0), cB, voffB); PG8_STAGE(PG8_SA(0, 0), cA, voffA); PG8_STAGE(PG8_SB(0, 1), cB + hstep, voffB); PG8_STAGE(PG8_SA(0, 1), cA + hstep, voffA);
        if (wr == 1) PG8_BAR;
        PG8_WAIT_V(4); PG8_BAR;
        PG8_STAGE(PG8_SB(1, 0), cB + kstep, voffB); PG8_STAGE(PG8_SA(1, 0), cA + kstep, voffA); PG8_STAGE(PG8_SB(1, 1), cB + hstep + kstep, voffB);
        PG8_WAIT_V(6); PG8_BAR;
    }
    for (;;) {
        const bool has_next = S.next(ui + 1, nxt);
        const char* nA = has_next ? (const char*)g.A + (size_t)nxt.pm * tstep : cA; const char* nB = has_next ? (const char*)g.Bt + (size_t)nxt.pn * tstep : cB;
        for (int t = 0; t < nt; t += 2) {
            const bool last = (t == nt - 2);
            const char* a1 = cA + (size_t)(t + 1) * kstep;
            const char* a2 = last ? nA : cA + (size_t)(t + 2) * kstep; const char* b2 = last ? nB : cB + (size_t)(t + 2) * kstep;
            const char* a3 = a2 + kstep; const char* b3 = b2 + kstep;
            if (last && has_next) S.a_ready(nxt);
            if constexpr (SP2) {
            PG8_LDB(B0, 0, 0); PG8_LDB(B1, 0, 1); PG8_SCHED; PG8_LDA(At, 0, 0); PG8_STAGE(PG8_SA(1, 1), a1 + hstep, voffA);
            PG8_WAIT_V(8); PG8_WAIT_L(0); PG8_BAR; PG8_MMA(0, 0, At, B0); PG8_MMA(0, 1, At, B1); PG8_BAR; PG8_SCHED;
            PG8_LDA(At, 0, 1); PG8_STAGE(PG8_SB(0, 0), b2, voffB); PG8_STAGE(PG8_SB(0, 1), b2 + hstep, voffB); PG8_STAGE(PG8_SA(0, 0), a2, voffA);
            PG8_WAIT_V(8); PG8_WAIT_L(0); PG8_BAR; PG8_MMA(1, 0, At, B0); PG8_MMA(1, 1, At, B1); PG8_BAR; PG8_SCHED;
            PG8_LDB(B0, 1, 0); PG8_LDB(B1, 1, 1); PG8_SCHED; PG8_LDA(At, 1, 0); PG8_STAGE(PG8_SA(0, 1), a2 + hstep, voffA);
            PG8_WAIT_V(8); PG8_WAIT_L(0); PG8_BAR; PG8_MMA(0, 0, At, B0); PG8_MMA(0, 1, At, B1); PG8_BAR; PG8_SCHED;
            PG8_LDA(At, 1, 1); PG8_STAGE(PG8_SB(1, 0), b3, voffB); PG8_STAGE(PG8_SB(1, 1), b3 + hstep, voffB); PG8_STAGE(PG8_SA(1, 0), a3, voffA);
            PG8_WAIT_V(8); PG8_WAIT_L(0); PG8_BAR; PG8_MMA(1, 0, At, B0); PG8_MMA(1, 1, At, B1); PG8_BAR; PG8_SCHED;
            } else {
            PG8_LDB(B0, 0, 0); PG8_SCHED; PG8_LDA(At, 0, 0); PG8_STAGE(PG8_SA(1, 1), a1 + hstep, voffA);
            PG8_WAIT_L(8); PG8_BAR; PG8_WAIT_L(0); PG8_MMA(0, 0, At, B0); PG8_BAR; PG8_SCHED;
            PG8_LDB(B1, 0, 1); PG8_STAGE(PG8_SB(0, 0), b2, voffB);
            PG8_BAR; PG8_WAIT_L(0); PG8_MMA(0, 1, At, B1); PG8_BAR;
            PG8_LDA(At, 0, 1); PG8_STAGE(PG8_SA(0, 0), a2, voffA);
            PG8_BAR; PG8_WAIT_L(0); PG8_MMA(1, 0, At, B0); PG8_BAR; PG8_SCHED;
            PG8_STAGE(PG8_SB(0, 1), b2 + hstep, voffB);
            PG8_WAIT_V(6); PG8_BAR; PG8_MMA(1, 1, At, B1); PG8_BAR;
            PG8_LDB(B0, 1, 0); PG8_SCHED; PG8_LDA(At, 1, 0); PG8_STAGE(PG8_SA(0, 1), a2 + hstep, voffA);
            PG8_WAIT_L(8); PG8_BAR; PG8_WAIT_L(0); PG8_MMA(0, 0, At, B0); PG8_BAR; PG8_SCHED;
            PG8_LDB(B1, 1, 1); PG8_STAGE(PG8_SB(1, 0), b3, voffB);
            PG8_BAR; PG8_WAIT_L(0); PG8_MMA(0, 1, At, B1); PG8_BAR;
            PG8_LDA(At, 1, 1); PG8_STAGE(PG8_SA(1, 0), a3, voffA);
            PG8_BAR; PG8_WAIT_L(0); PG8_MMA(1, 0, At, B0); PG8_BAR; PG8_SCHED;
            PG8_STAGE(PG8_SB(1, 1), b3 + hstep, voffB);
            PG8_WAIT_V(6); PG8_BAR; PG8_MMA(1, 1, At, B1); PG8_BAR;
            }
        }
        if constexpr (ALIGN_EPI) { if (wr == 0) PG8_BAR; }
        if constexpr (!Epi::AFTER_DRAIN) { E(acc, cur, wr, wc, fr, fq); S.done(cur); }
        if (!has_next) break;
#pragma unroll
        for (int a = 0; a < 2; ++a)
#pragma unroll
            for (int b = 0; b < 2; ++b)
#pragma unroll
                for (int m = 0; m < 4; ++m)
#pragma unroll
                    for (int n = 0; n < 2; ++n) acc[a][b][m][n] = (f32x4){0.f, 0.f, 0.f, 0.f};
        cur = nxt; cA = nA; cB = nB; ++ui;
        if constexpr (ALIGN_EPI) { if (wr == 1) PG8_BAR; }
    }
    PG8_WAIT_V(0);
    if constexpr (!ALIGN_EPI) { if (wr == 0) PG8_BAR; }
    PG8_BAR;
    if constexpr (Epi::AFTER_DRAIN) { E.fused(acc, cur, wr, wc, fr, fq, lds, wid, lane); S.done(cur); }
#undef PG8_SA
#undef PG8_SB
#undef PG8_STAGE
#undef PG8_LDA
#undef PG8_LDB
#undef PG8_MMA
#undef PG8_WAIT_V
#undef PG8_WAIT_L
#undef PG8_BAR
#undef PG8_SCHED
}
}

constexpr int NWAVES = 8;
constexpr int DM = 2048, DFF = 8192, NTOK = 49152, GM = 16384, NGRP = 3, NLAYER = 2, INW = 8224, ZW = 8192;
constexpr int ZC_GQ = 0, ZC_GK = 512, ZC_GV = 1024, ZC_GOG = 2048, ZC_HQ = 3072, ZC_HFF = 4096, ZC_HFB = 5120, ZC_HI = 6144, ZC_HOG = 7168;
constexpr float LN_EPS = 1e-5f, RMS_EPS = 1e-6f, ALPHA = 1.41421356237f, LOG2E = 1.44269504089f;
constexpr int NCHUNK = GM / 64;
constexpr int ST_CHUNK = 524288;
constexpr size_t MiB = 1u << 20;
constexpr size_t WS_CTL = 0, CTL_ZERO_BYTES = 1 * MiB;
constexpr size_t WS_WIN = 2 * MiB, WS_WOUT = 66 * MiB, WS_WUP = 82 * MiB, WS_WDN = 146 * MiB, WS_WGLR = 210 * MiB;
constexpr size_t WS_HB = 212 * MiB;
constexpr size_t WS_Z = 276 * MiB;
constexpr size_t WS_BG = 532 * MiB;
constexpr size_t WS_O = 596 * MiB;
constexpr size_t WS_ST = 660 * MiB;
constexpr size_t WS_TOT = 916 * MiB;
constexpr size_t WS_STS = 920 * MiB;
constexpr size_t WS_TOTS = 984 * MiB;
constexpr size_t WS_END = 985 * MiB;
constexpr int CW_BAR = 4096;
constexpr int RING_BYTES = 131072;
constexpr int LDS_BYTES = 160 * 1024, MISC_OFF = LDS_BYTES - 256;
constexpr int L_B32 = 0, L_KR = 33792, L_QR = 51200, L_QH = 68608, L_V = 86016, L_P = 119808, L_RED = 129024;
constexpr int B32_STR = 528, K_STR = 272, P_STR = 144, KT_STR = 144;
constexpr int NSC = GM / 256;
constexpr int SV_KT = 135168, KTW_BYTES = 2560;

#define GAS __attribute__((address_space(1)))
#define LAS __attribute__((address_space(3)))
typedef unsigned short bf16;
typedef unsigned v4u __attribute__((ext_vector_type(4)));
typedef float f32x4 __attribute__((ext_vector_type(4)));
typedef short bf16x8 __attribute__((ext_vector_type(8)));
typedef GAS unsigned gu32;
typedef GAS unsigned long long gu64;
#define RLX_AGENT __ATOMIC_RELAXED, __HIP_MEMORY_SCOPE_AGENT
#define LDS_WAIT() asm volatile("s_waitcnt lgkmcnt(0)" ::: "memory")
#define VM_WAIT() asm volatile("s_waitcnt vmcnt(0)" ::: "memory")
__device__ __forceinline__ unsigned long long rt() { return __builtin_amdgcn_s_memrealtime(); }
__device__ __forceinline__ unsigned f2bf(float f) { unsigned u = __builtin_bit_cast(unsigned, f); return (u + 0x7fffu + ((u >> 16) & 1u)) >> 16; }
__device__ __forceinline__ unsigned pk2(float lo, float hi) { return f2bf(lo) | (f2bf(hi) << 16); }

#define XB_TMO      128
#define XB_XCNT(j)  (256  + 64 * (j))
#define XB_XSUB(j)  (1280 + 64 * (j))
#define XB_XGEN(j)  (2304 + 64 * (j))
#define XB_TOP      3328
#define XB_TOPGEN   3392
#define XCD_BAR_WORDS 3456
#define XB_SPIN_CAP (1u << 18)

__device__ __forceinline__ unsigned xb_ld(unsigned* p)              { return __hip_atomic_load(p, __ATOMIC_RELAXED, __HIP_MEMORY_SCOPE_AGENT); }
__device__ __forceinline__ unsigned xb_add(unsigned* p, unsigned v) { return __hip_atomic_fetch_add(p, v, __ATOMIC_RELAXED, __HIP_MEMORY_SCOPE_AGENT); }
__device__ __forceinline__ unsigned xb_xcc_id() { return (unsigned)__builtin_amdgcn_s_getreg((3 << 11) | 20) & 0xFu; }
#define XB_SPIN(cond, bar) do { unsigned _sp = 0; while (cond) { __builtin_amdgcn_s_sleep(1); \
    if ((++_sp & 255u) == 0u) { if (xb_ld(&(bar)[XB_TMO])) break; if (_sp > XB_SPIN_CAP) { atomicAdd(&(bar)[XB_TMO], 1u); break; } } } } while (0)

struct XcdBarrier {
    unsigned* bar; unsigned x;
    volatile LAS unsigned* st;
};

__device__ __forceinline__ XcdBarrier xcd_barrier_post(unsigned* bar, volatile LAS unsigned* st) {
    XcdBarrier b; b.bar = bar; b.x = xb_xcc_id(); b.st = st;
    if (threadIdx.x == 0) (void)xb_add(&bar[XB_XCNT(b.x)], 1u);
    return b;
}
__device__ __forceinline__ void xcd_barrier_complete(unsigned* bar, unsigned x, unsigned& nloc, unsigned& nx) {
    const unsigned G = gridDim.x * gridDim.y * gridDim.z;
    unsigned sum, cnt, mine, sp = 0u;
    for (;;) {
        sum = 0u; cnt = 0u; mine = 0u;
#pragma unroll
        for (unsigned j = 0; j < 16; ++j) { const unsigned c = xb_ld(&bar[XB_XCNT(j)]); sum += c; cnt += (c > 0u) ? 1u : 0u; mine = (j == x) ? c : mine; }
        if (sum == G) break;
        __builtin_amdgcn_s_sleep(1);
        if ((++sp & 255u) == 0u) { if (xb_ld(&bar[XB_TMO])) break; if (sp > XB_SPIN_CAP) { atomicAdd(&bar[XB_TMO], 1u); break; } }
    }
    nloc = mine > 0u ? mine : 1u; nx = cnt > 0u ? cnt : 1u;
}

__device__ __forceinline__ void xcd_barrier(const XcdBarrier& b) {
    asm volatile("s_waitcnt vmcnt(0)" ::: "memory");
    __syncthreads();
    if (threadIdx.x == 0) {
        unsigned* bar = b.bar;
        __builtin_amdgcn_s_waitcnt(0);
        unsigned nloc = b.st[0], nx = b.st[1];
        if (nloc == 0u) { xcd_barrier_complete(bar, b.x, nloc, nx); b.st[0] = nloc; b.st[1] = nx; }
        const unsigned old = xb_add(&bar[XB_XSUB(b.x)], 1u);
        const unsigned gen = old / nloc;
        if (old + 1u == (gen + 1u) * nloc) {
            __builtin_amdgcn_fence(__ATOMIC_RELEASE, "agent");
            asm volatile("s_waitcnt vmcnt(0)" ::: "memory");
            const unsigned og = xb_add(&bar[XB_TOP], 1u);
            const unsigned tg = og / nx;
            if (og + 1u == (tg + 1u) * nx) xb_add(&bar[XB_TOPGEN], 1u);
            else XB_SPIN(xb_ld(&bar[XB_TOPGEN]) == tg, bar);
            __builtin_amdgcn_fence(__ATOMIC_ACQUIRE, "agent");
            xb_add(&bar[XB_XGEN(b.x)], 1u);
            asm volatile("s_waitcnt vmcnt(0)" ::: "memory");
        } else {
            XB_SPIN(xb_ld(&bar[XB_XGEN(b.x)]) == gen, bar);
            __builtin_amdgcn_fence(__ATOMIC_ACQUIRE, "agent");
            asm volatile("s_waitcnt vmcnt(0)" ::: "memory");
        }
    }
    __syncthreads();
}

typedef short s16x4 __attribute__((ext_vector_type(4)));
typedef float f32x2 __attribute__((ext_vector_type(2)));
typedef unsigned v2u __attribute__((ext_vector_type(2)));
__device__ __forceinline__ unsigned pkbf(float lo, float hi) { return pg8::cvt_pk_bf16(lo, hi); }
__device__ __forceinline__ float wave_sum(float v) {
#pragma unroll
    for (int o = 1; o < 64; o <<= 1) v += __shfl_xor(v, o);
    return v;
}
template <int CTRL, int RM> __device__ __forceinline__ float dpp_add(float v) {
    return v + __builtin_bit_cast(float, __builtin_amdgcn_update_dpp(0, __builtin_bit_cast(int, v), CTRL, RM, 0xf, true));
}
__device__ __forceinline__ float wave_scan_incl(float v, int) {
    v = dpp_add<0x111, 0xf>(v); v = dpp_add<0x112, 0xf>(v); v = dpp_add<0x114, 0xf>(v); v = dpp_add<0x118, 0xf>(v);
    v = dpp_add<0x142, 0xa>(v); v = dpp_add<0x143, 0xc>(v); return v;
}
__device__ __forceinline__ void unpack8(const v4u v, float* f) {
    f[0] = __uint_as_float(v.x << 16); f[1] = __uint_as_float(v.x & 0xffff0000u); f[2] = __uint_as_float(v.y << 16); f[3] = __uint_as_float(v.y & 0xffff0000u);
    f[4] = __uint_as_float(v.z << 16); f[5] = __uint_as_float(v.z & 0xffff0000u); f[6] = __uint_as_float(v.w << 16); f[7] = __uint_as_float(v.w & 0xffff0000u);
}
__device__ __forceinline__ v4u pack8(const float* f) { v4u o; o.x = pkbf(f[0], f[1]); o.y = pkbf(f[2], f[3]); o.z = pkbf(f[4], f[5]); o.w = pkbf(f[6], f[7]); return o; }
__device__ __forceinline__ s16x4 lds_tr(LAS const unsigned char* p) { return __builtin_bit_cast(s16x4, __builtin_amdgcn_ds_read_tr16_b64_v4i16((LAS s16x4*)p)); }
__device__ __forceinline__ bf16x8 tr_pair(LAS const unsigned char* p0, LAS const unsigned char* p1) {
    const s16x4 a = lds_tr(p0), b = lds_tr(p1); return __builtin_shufflevector(a, b, 0, 1, 2, 3, 4, 5, 6, 7);
}
__device__ __forceinline__ float fexp2(float x) { return __builtin_amdgcn_exp2f(x); }
__device__ __forceinline__ float flog2(float x) { return __builtin_amdgcn_logf(x); }

struct Ctx {
    const float *x_prompt, *x_sample, *w_in, *w_lr2, *b_lr, *gla_g, *hg_g, *lowb, *w_out, *ln1_g, *ln1_b, *w_up, *w_down, *ln2_g, *ln2_b;
    float* out;
    bf16 *Win_t, *Wout_t, *Wup_t, *Wdn_t, *Wglr_t, *HB, *Z, *O, *ST;
    float *BG, *TOT, *TOTS; bf16 *STS, *MF;
};

__device__ __forceinline__ void transpose_item(const float* W, int N, int kb, int nb, bf16* dst, int K, LAS float* scr, int lane) {
    const int k0 = 64 * kb, n0 = 32 * nb;
#pragma unroll 8
    for (int i = 0; i < 32; ++i) { const int kk = 2 * i + (lane >> 5); scr[kk * 33 + (lane & 31)] = W[(size_t)(k0 + kk) * N + n0 + (lane & 31)]; }
    LDS_WAIT(); asm volatile("" ::: "memory");
    const int c = lane & 7;
#pragma unroll
    for (int j = 0; j < 4; ++j) { const int n = (lane >> 3) + 8 * j; const LAS float* s = scr + (8 * c) * 33 + n;
        v4u o; o.x = pkbf(s[0 * 33], s[1 * 33]); o.y = pkbf(s[2 * 33], s[3 * 33]); o.z = pkbf(s[4 * 33], s[5 * 33]); o.w = pkbf(s[6 * 33], s[7 * 33]);
        *(GAS v4u*)(dst + (size_t)n * K + k0 + 8 * c) = o; }
    LDS_WAIT(); asm volatile("" ::: "memory");
}
__device__ __forceinline__ void prologue_weights(const Ctx& X, LAS unsigned char* lds, int gw, int NGW, int wave, int lane) {
    LAS float* scr = (LAS float*)(lds + wave * 16384);
    constexpr int I_IN = 32 * 257, I_OUT = 32 * 64, I_UP = 32 * 256, I_DN = 128 * 64, I_L = I_IN + I_OUT + I_UP + I_DN;
    for (int it = gw; it < NLAYER * I_L; it += NGW) {
        const int l = it / I_L; int r = it % I_L;
        if (r < I_IN) { const int kb = r / 257, nb = r % 257;
            bf16* dst = (nb < 96) ? X.Win_t + ((size_t)l * ZW + 32 * nb) * DM : (nb == 96) ? X.Wglr_t + (size_t)l * 32 * DM : X.Win_t + ((size_t)l * ZW + 32 * (nb - 1)) * DM;
            transpose_item(X.w_in + (size_t)l * DM * INW, INW, kb, nb, dst, DM, scr, lane); continue; }
        r -= I_IN;
        if (r < I_OUT) { const int kb = r / 64, nb = r % 64; transpose_item(X.w_out + (size_t)l * DM * DM, DM, kb, nb, X.Wout_t + ((size_t)l * DM + 32 * nb) * DM, DM, scr, lane); continue; }
        r -= I_OUT;
        if (r < I_UP) { const int kb = r / 256, nb = r % 256; transpose_item(X.w_up + (size_t)l * DM * DFF, DFF, kb, nb, X.Wup_t + ((size_t)l * DFF + 32 * nb) * DM, DM, scr, lane); continue; }
        r -= I_UP;
        { const int kb = r / 64, nb = r % 64; transpose_item(X.w_down + (size_t)l * DFF * DM, DM, kb, nb, X.Wdn_t + ((size_t)l * DM + 32 * nb) * DFF, DFF, scr, lane); }
    }
}
__device__ __forceinline__ void cvt_group(const float* xg, bf16* HB, int gtid, int NT) {
    for (int i = gtid; i < GM * DM / 8; i += NT) {
        const f32x4 a = ((const GAS f32x4*)xg)[2 * i], b = ((const GAS f32x4*)xg)[2 * i + 1];
        v4u o; o.x = pkbf(a.x, a.y); o.y = pkbf(a.z, a.w); o.z = pkbf(b.x, b.y); o.w = pkbf(b.z, b.w);
        ((GAS v4u*)HB)[i] = o; }
}
template <bool RES_F32, bool OUT_F32>
__device__ __forceinline__ void ln_phase(const void* res, const bf16* mf, const float* gam, const float* bet, float* H, bf16* HB, int gw, int NGW, int lane) {
    for (int m = gw; m < GM; m += NGW) {
        f32x4 v[8]; float s = 0.f;
        const GAS v2u* mr = (const GAS v2u*)(mf + (size_t)m * DM) + lane;
#pragma unroll
        for (int j = 0; j < 8; ++j) { f32x4 r;
            if (RES_F32) r = ((const GAS f32x4*)((const float*)res + (size_t)m * DM) + lane)[64 * j];
            else { const v2u w = ((const GAS v2u*)((const bf16*)res + (size_t)m * DM) + lane)[64 * j];
                r = (f32x4){__uint_as_float(w.x << 16), __uint_as_float(w.x & 0xffff0000u), __uint_as_float(w.y << 16), __uint_as_float(w.y & 0xffff0000u)}; }
            const v2u w = mr[64 * j];
            const f32x4 f = (f32x4){__uint_as_float(w.x << 16), __uint_as_float(w.x & 0xffff0000u), __uint_as_float(w.y << 16), __uint_as_float(w.y & 0xffff0000u)};
            v[j] = r * ALPHA + f; s += (v[j].x + v[j].y) + (v[j].z + v[j].w); }
        const float mean = wave_sum(s) * (1.f / DM); float s2 = 0.f;
#pragma unroll
        for (int j = 0; j < 8; ++j) { v[j] = v[j] - mean; s2 += (v[j].x * v[j].x + v[j].y * v[j].y) + (v[j].z * v[j].z + v[j].w * v[j].w); }
        const float rstd = 1.f / sqrtf(wave_sum(s2) * (1.f / DM) + LN_EPS);
#pragma unroll
        for (int j = 0; j < 8; ++j) { const f32x4 g4 = ((const GAS f32x4*)gam)[lane + 64 * j], b4 = ((const GAS f32x4*)bet)[lane + 64 * j];
            const f32x4 o = v[j] * rstd * g4 + b4;
            if (OUT_F32) ((GAS f32x4*)(H + (size_t)m * DM) + lane)[64 * j] = o;
            else { v2u w; w.x = pkbf(o.x, o.y); w.y = pkbf(o.z, o.w); ((GAS v2u*)(HB + (size_t)m * DM) + lane)[64 * j] = w; } }
    }
}

__device__ __forceinline__ void gate_unit(const Ctx& X, int l, int chunk, LAS unsigned char* lds, int tid, int lane, int wave) {
    const int fr = lane & 15, fq = lane >> 4;
    const bf16* A = X.HB + (size_t)chunk * 64 * DM; const bf16* Bw = X.Wglr_t + (size_t)l * 32 * DM;
    f32x4 acc[4][2];
#pragma unroll
    for (int m = 0; m < 4; ++m)
#pragma unroll
        for (int n = 0; n < 2; ++n) acc[m][n] = (f32x4){0.f, 0.f, 0.f, 0.f};
#pragma unroll 2
    for (int ks = 0; ks < 8; ++ks) { const int k0 = 256 * wave + 32 * ks + 8 * fq;
        bf16x8 a[4], b[2];
#pragma unroll
        for (int m = 0; m < 4; ++m) a[m] = *(const GAS bf16x8*)(A + (size_t)(16 * m + fr) * DM + k0);
#pragma unroll
        for (int n = 0; n < 2; ++n) b[n] = *(const GAS bf16x8*)(Bw + (size_t)(16 * n + fr) * DM + k0);
#pragma unroll
        for (int m = 0; m < 4; ++m)
#pragma unroll
            for (int n = 0; n < 2; ++n) acc[m][n] = __builtin_amdgcn_mfma_f32_16x16x32_bf16(a[m], b[n], acc[m][n], 0, 0, 0); }
    LAS float* part = (LAS float*)lds;
#pragma unroll
    for (int m = 0; m < 4; ++m)
#pragma unroll
        for (int n = 0; n < 2; ++n)
#pragma unroll
            for (int j = 0; j < 4; ++j) part[(wave * 64 + 16 * m + 4 * fq + j) * 33 + 16 * n + fr] = acc[m][n][j];
    __syncthreads();
    LAS float* glr = (LAS float*)(lds + 8 * 64 * 33 * 4);
#pragma unroll
    for (int k = 0; k < 4; ++k) { const int idx = tid + 512 * k, t = idx >> 5, n = idx & 31; float s = 0.f;
#pragma unroll
        for (int w = 0; w < 8; ++w) s += part[(w * 64 + t) * 33 + n];
        glr[t * 36 + n] = s; }
    __syncthreads();
    const int dir = wave >> 2;
    const float* w2 = X.w_lr2 + (size_t)(l * 2 + dir) * 16 * 512; const float* bl = X.b_lr + (size_t)(l * 2 + dir) * 512;
    for (int cb = 0; cb < 2; ++cb) { const int c = 128 * (wave & 3) + 64 * cb + lane;
        float w[16];
#pragma unroll
        for (int r = 0; r < 16; ++r) w[r] = w2[r * 512 + c];
        const float bias = bl[c]; float run = 0.f;
        float* bgcol = X.BG + (size_t)chunk * 64 * 1024 + dir * 512 + c;
#pragma unroll 4
        for (int tt = 0; tt < 64; ++tt) { const int t = dir ? 63 - tt : tt;
            const LAS f32x4* gr = (const LAS f32x4*)(glr + t * 36 + dir * 16); const f32x4 g0 = gr[0], g1 = gr[1], g2 = gr[2], g3 = gr[3];
            float pre = bias;
            pre += g0.x * w[0] + g0.y * w[1] + g0.z * w[2] + g0.w * w[3]; pre += g1.x * w[4] + g1.y * w[5] + g1.z * w[6] + g1.w * w[7];
            pre += g2.x * w[8] + g2.y * w[9] + g2.z * w[10] + g2.w * w[11]; pre += g3.x * w[12] + g3.y * w[13] + g3.z * w[14] + g3.w * w[15];
            run += (fminf(pre, 0.f) - __logf(1.f + __expf(-fabsf(pre)))) * (LOG2E / 16.f);
            bgcol[(size_t)t * 1024] = run; } }
    __syncthreads();
}

template <bool HGT, bool PC>
__device__ __forceinline__ void scan_stage(const Ctx& X, int l, int chunk, int h, int dir, LAS unsigned char* lds, int lane, int wave, float* tot_out) {
    const int r = lane, tok = chunk * 64 + (dir ? 63 - r : r), c0 = 16 * wave;
    const bf16* zrow = X.Z + (size_t)tok * ZW;
    float bc[16], kr[16], qv[16];
    if (!HGT) {
        const GAS f32x4* bg = (const GAS f32x4*)(X.BG + (size_t)tok * 1024 + dir * 512 + h * 128 + c0);
#pragma unroll
        for (int i = 0; i < 4; ++i) { const f32x4 t = bg[i]; bc[4 * i] = t.x; bc[4 * i + 1] = t.y; bc[4 * i + 2] = t.z; bc[4 * i + 3] = t.w; }
        const GAS v4u* kp = (const GAS v4u*)(zrow + ZC_GK + h * 128 + c0); unpack8(kp[0], kr); unpack8(kp[1], kr + 8);
        if (PC) { const GAS v4u* qp = (const GAS v4u*)(zrow + ZC_GQ + h * 128 + c0); unpack8(qp[0], qv); unpack8(qp[1], qv + 8);
#pragma unroll
            for (int i = 0; i < 16; ++i) qv[i] *= 0.08838834764831845f; }
    } else {
        float zf[16];
        const GAS v4u* zp = (const GAS v4u*)(zrow + (dir ? ZC_HFB : ZC_HFF) + h * 128 + c0); unpack8(zp[0], zf); unpack8(zp[1], zf + 8);
        const float* lp = X.lowb + (size_t)dir * 2 * 1024 + h * 128 + c0;
#pragma unroll
        for (int i = 0; i < 16; ++i) {
            const float lb = (l == 0) ? 0.f : 1.f / (1.f + __expf(lp[i] - lp[1024 + i]));
            const float z = fminf(fmaxf(zf[i], -80.f), 80.f), e = __expf(-z), sig = 1.f / (1.f + e);
            const float f = lb + (1.f - lb) * sig;
            kr[i] = (1.f - lb) * e * sig;
            bc[i] = wave_scan_incl(flog2(f), lane); }
        if (PC) { const GAS v4u* qp = (const GAS v4u*)(zrow + ZC_HQ + h * 128 + c0); unpack8(qp[0], qv); unpack8(qp[1], qv + 8); }
    }
    LAS unsigned char* kdst = lds + L_KR + r * K_STR + c0 * 2;
    if (PC) {
        LAS f32x4* bdst = (LAS f32x4*)(lds + L_B32 + r * B32_STR + c0 * 4);
#pragma unroll
        for (int i = 0; i < 4; ++i) bdst[i] = (f32x4){bc[4 * i], bc[4 * i + 1], bc[4 * i + 2], bc[4 * i + 3]};
        ((LAS v4u*)kdst)[0] = pack8(kr); ((LAS v4u*)kdst)[1] = pack8(kr + 8);
        LAS unsigned char* qdst = lds + L_QR + r * K_STR + c0 * 2;
        ((LAS v4u*)qdst)[0] = pack8(qv); ((LAS v4u*)qdst)[1] = pack8(qv + 8);
        float qh[16];
#pragma unroll
        for (int i = 0; i < 16; ++i) qh[i] = qv[i] * fexp2(bc[i]);
        LAS unsigned char* hdst = lds + L_QH + r * K_STR + c0 * 2;
        ((LAS v4u*)hdst)[0] = pack8(qh); ((LAS v4u*)hdst)[1] = pack8(qh + 8);
    } else {
        float kh[16];
#pragma unroll
        for (int i = 0; i < 16; ++i) { const float bl = __shfl(bc[i], 63); kh[i] = kr[i] * fexp2(bl - bc[i]); }
        { const v4u k0 = pack8(kh), k1 = pack8(kh + 8); const unsigned kw[8] = {k0.x, k0.y, k0.z, k0.w, k1.x, k1.y, k1.z, k1.w};
#pragma unroll
          for (int i = 0; i < 16; ++i) *(LAS unsigned short*)(lds + L_KR + (c0 + i) * KT_STR + r * 2) = (unsigned short)((i & 1) ? (kw[i >> 1] >> 16) : (kw[i >> 1] & 0xffffu)); }
        if (lane == 63) {
#pragma unroll
            for (int i = 0; i < 4; ++i) ((GAS f32x4*)(tot_out + c0))[i] = (f32x4){bc[4 * i], bc[4 * i + 1], bc[4 * i + 2], bc[4 * i + 3]}; }
    }
}
template <int DV>
__device__ __forceinline__ void stage_v(const Ctx& X, int chunk, int vcol, LAS unsigned char* lds, int tid) {
    constexpr int PPR = DV / 8, VSTR = DV * 2 + 16;
#pragma unroll
    for (int k = 0; k < 64 * PPR / 512; ++k) { const int idx = tid + 512 * k, row = idx / PPR, pc = idx % PPR;
        const v4u v = *(const GAS v4u*)(X.Z + (size_t)(chunk * 64 + row) * ZW + vcol + pc * 8);
        *(LAS v4u*)(lds + L_V + row * VSTR + pc * 16) = v; }
}
__device__ __forceinline__ size_t st_slot(int chunk, bool hgt, int h, int dir) { return (size_t)chunk * ST_CHUNK + (hgt ? 262144 + (h * 2 + dir) * 16384 : (h * 2 + dir) * 32768); }

template <bool HGT>
__device__ __forceinline__ void pass_a_unit(const Ctx& X, int l, int chunk, int h, LAS unsigned char* lds, int tid, int lane, int wave) {
    constexpr int DV = HGT ? 128 : 256, VSTR = DV * 2 + 16, NET = DV / 128;
    const int fr = lane & 15, fq = lane >> 4, qq = fr >> 2, p4 = fr & 3;
    stage_v<DV>(X, chunk, HGT ? ZC_HI + h * 128 : ZC_GV + h * 256, lds, tid);
    for (int dir = 0; dir < 2; ++dir) {
        const int hd = HGT ? 8 + h * 2 + dir : h * 2 + dir;
        scan_stage<HGT, false>(X, l, chunk, h, dir, lds, lane, wave, X.TOT + ((size_t)chunk * 24 + hd) * 128);
        __syncthreads();
        f32x4 acc[8][NET];
#pragma unroll
        for (int dt = 0; dt < 8; ++dt)
#pragma unroll
            for (int et = 0; et < NET; ++et) acc[dt][et] = (f32x4){0.f, 0.f, 0.f, 0.f};
#pragma unroll
        for (int ks = 0; ks < 2; ++ks) {
            const int r0 = 32 * ks + 8 * fq + qq, r1 = r0 + 4;
            const int v0 = dir ? 63 - r0 : r0, v1 = dir ? 63 - r1 : r1;
            bf16x8 bfr[NET];
#pragma unroll
            for (int et = 0; et < NET; ++et) { const int col = (16 * (wave * NET + et) + 4 * p4) * 2;
                bfr[et] = tr_pair(lds + L_V + v0 * VSTR + col, lds + L_V + v1 * VSTR + col); }
#pragma unroll
            for (int dt = 0; dt < 8; ++dt) { const int col = (16 * dt + 4 * p4) * 2;
                const bf16x8 afr = *(const LAS bf16x8*)(lds + L_KR + (16 * dt + fr) * KT_STR + (32 * ks + 8 * fq) * 2); (void)col;
#pragma unroll
                for (int et = 0; et < NET; ++et) acc[dt][et] = __builtin_amdgcn_mfma_f32_16x16x32_bf16(afr, bfr[et], acc[dt][et], 0, 0, 0); }
        }
        bf16* slot = X.ST + st_slot(chunk, HGT, h, dir);
#pragma unroll
        for (int dt = 0; dt < 8; ++dt)
#pragma unroll
            for (int et = 0; et < NET; ++et) { const int e = 16 * (wave * NET + et) + fr, d = 16 * dt + 4 * fq;
                v2u w; w.x = pkbf(acc[dt][et][0], acc[dt][et][1]); w.y = pkbf(acc[dt][et][2], acc[dt][et][3]);
                *(GAS v2u*)(slot + e * 128 + d) = w; }
        __syncthreads();
    }
}

__device__ __forceinline__ void pass_b(const Ctx& X, int g, int gtid, int NT) {
    const int ns = (g == 0) ? 1 : 2, nc = NCHUNK / ns;
    for (int v = gtid; v < ns * (ST_CHUNK / 8); v += NT) {
        const int s = v / (ST_CHUNK / 8), idx = (v % (ST_CHUNK / 8)) * 8;
        const int hd = idx < 262144 ? idx / 32768 : 8 + (idx - 262144) / 16384, db = hd & 1, d0 = idx & 127;
        float S[8];
#pragma unroll
        for (int i = 0; i < 8; ++i) S[i] = 0.f;
        for (int cc = 0; cc < nc; cc += 4) {
            v4u x[4]; f32x4 t0[4], t1[4];
#pragma unroll
            for (int u = 0; u < 4; ++u) { const int c = s * nc + (db ? nc - 1 - (cc + u) : cc + u);
                x[u] = *(const GAS v4u*)(X.ST + (size_t)c * ST_CHUNK + idx);
                const GAS f32x4* tp = (const GAS f32x4*)(X.TOT + ((size_t)c * 24 + hd) * 128 + d0); t0[u] = tp[0]; t1[u] = tp[1]; }
#pragma unroll
            for (int u = 0; u < 4; ++u) { const int c = s * nc + (db ? nc - 1 - (cc + u) : cc + u);
                *(GAS v4u*)(X.ST + (size_t)c * ST_CHUNK + idx) = pack8(S);
                float dx[8]; unpack8(x[u], dx);
                const float dec[8] = {fexp2(t0[u].x), fexp2(t0[u].y), fexp2(t0[u].z), fexp2(t0[u].w), fexp2(t1[u].x), fexp2(t1[u].y), fexp2(t1[u].z), fexp2(t1[u].w)};
#pragma unroll
                for (int i = 0; i < 8; ++i) S[i] = dec[i] * S[i] + dx[i]; }
        }
    }
}

template <bool HGT> struct RawIn { f32x4 b[4]; v4u k[2]; };
template <> struct RawIn<true> { v4u k[2]; };
template <bool HGT>
__device__ __forceinline__ RawIn<HGT> pass_s_load(const Ctx& X, int chunk, int h, int dir, int lane, int c0) {
    RawIn<HGT> r; const int tok = chunk * 64 + (dir ? 63 - lane : lane); const bf16* zrow = X.Z + (size_t)tok * ZW;
    if constexpr (!HGT) { const GAS f32x4* bg = (const GAS f32x4*)(X.BG + (size_t)tok * 1024 + dir * 512 + h * 128 + c0);
#pragma unroll
        for (int i = 0; i < 4; ++i) r.b[i] = bg[i];
        const GAS v4u* kp = (const GAS v4u*)(zrow + ZC_GK + h * 128 + c0); r.k[0] = kp[0]; r.k[1] = kp[1];
    } else { const GAS v4u* zp = (const GAS v4u*)(zrow + (dir ? ZC_HFB : ZC_HFF) + h * 128 + c0); r.k[0] = zp[0]; r.k[1] = zp[1]; }
    return r;
}
template <bool HGT, bool STORE>
__device__ __forceinline__ void pass_s_unit(const Ctx& X, int l, int sc, int h, LAS unsigned char* lds, int tid, int lane, int wave) {
    constexpr int DV = HGT ? 128 : 256, VSTR = DV * 2 + 16, NE = DV / 16, PPR = DV / 8;
    const int fr = lane & 15, fq = lane >> 4, qq = fr >> 2, p4 = fr & 3, c0 = 16 * wave;
    RawIn<HGT> cur = pass_s_load<HGT>(X, sc * 4, h, 0, lane, c0);
    { const int vcol = HGT ? ZC_HI + h * 128 : ZC_GV + h * 256;
#pragma unroll 4
      for (int k = 0; k < 256 * PPR / 512; ++k) { const int idx = tid + 512 * k, row = idx / PPR, pc = idx % PPR;
        const v4u v = *(const GAS v4u*)(X.Z + (size_t)(sc * 256 + row) * ZW + vcol + pc * 8);
        *(LAS v4u*)(lds + row * VSTR + pc * 16) = v; } }
    __syncthreads();
    LAS unsigned char* kt = lds + SV_KT + wave * KTW_BYTES;
    for (int dir = 0; dir < 2; ++dir) {
        const int hd = HGT ? 8 + h * 2 + dir : h * 2 + dir;
        float lbv[16];
        if (HGT) { const float* lp = X.lowb + (size_t)dir * 2 * 1024 + h * 128 + c0;
#pragma unroll
            for (int i = 0; i < 16; ++i) lbv[i] = (l == 0) ? 0.f : 1.f / (1.f + __expf(lp[i] - lp[1024 + i])); }
        f32x4 acc[NE];
        if (STORE) { const bf16* sin = X.STS + st_slot(sc, HGT, h, dir);
#pragma unroll
            for (int et = 0; et < NE; ++et) { const v2u w = *(const GAS v2u*)(sin + (size_t)(16 * et + fr) * 128 + c0 + 4 * fq);
                acc[et] = (f32x4){__uint_as_float(w.x << 16), __uint_as_float(w.x & 0xffff0000u), __uint_as_float(w.y << 16), __uint_as_float(w.y & 0xffff0000u)}; }
        } else {
#pragma unroll
            for (int et = 0; et < NE; ++et) acc[et] = (f32x4){0.f, 0.f, 0.f, 0.f}; }
        float run[16];
#pragma unroll
        for (int i = 0; i < 16; ++i) run[i] = 0.f;
        for (int cc = 0; cc < 4; ++cc) { const int ci = dir ? 3 - cc : cc, chunk = sc * 4 + ci;
            RawIn<HGT> nxt = cur;
            if (cc < 3) nxt = pass_s_load<HGT>(X, sc * 4 + (dir ? 2 - cc : cc + 1), h, dir, lane, c0);
            else if (dir == 0) nxt = pass_s_load<HGT>(X, sc * 4 + 3, h, 1, lane, c0);
            float bc[16], kr[16];
            if constexpr (!HGT) {
#pragma unroll
                for (int i = 0; i < 4; ++i) { bc[4 * i] = cur.b[i].x; bc[4 * i + 1] = cur.b[i].y; bc[4 * i + 2] = cur.b[i].z; bc[4 * i + 3] = cur.b[i].w; }
                unpack8(cur.k[0], kr); unpack8(cur.k[1], kr + 8);
            } else {
                float zf[16]; unpack8(cur.k[0], zf); unpack8(cur.k[1], zf + 8);
#pragma unroll
                for (int i = 0; i < 16; ++i) {
                    const float z = fminf(fmaxf(zf[i], -80.f), 80.f), e = __expf(-z), sig = 1.f / (1.f + e);
                    const float f = lbv[i] + (1.f - lbv[i]) * sig;
                    kr[i] = (1.f - lbv[i]) * e * sig;
                    bc[i] = wave_scan_incl(flog2(f), lane); }
            }
            if (STORE) { bf16* slot = X.ST + st_slot(chunk, HGT, h, dir);
#pragma unroll
                for (int et = 0; et < NE; ++et) { v2u w; w.x = pkbf(acc[et][0], acc[et][1]); w.y = pkbf(acc[et][2], acc[et][3]);
                    *(GAS v2u*)(slot + (size_t)(16 * et + fr) * 128 + c0 + 4 * fq) = w; } }
            float kh[16];
#pragma unroll
            for (int i = 0; i < 16; ++i) { const float bl = __shfl(bc[i], 63); kh[i] = kr[i] * fexp2(bl - bc[i]); run[i] += bl; }
            { const v4u k0 = pack8(kh), k1 = pack8(kh + 8); const unsigned kw[8] = {k0.x, k0.y, k0.z, k0.w, k1.x, k1.y, k1.z, k1.w};
#pragma unroll
              for (int i = 0; i < 16; ++i) *(LAS unsigned short*)(kt + i * KT_STR + lane * 2) = (unsigned short)((i & 1) ? (kw[i >> 1] >> 16) : (kw[i >> 1] & 0xffffu)); }
            if (lane == 63) {
#pragma unroll
                for (int i = 0; i < 4; ++i) ((LAS f32x4*)(kt + 2304))[i] = (f32x4){bc[4 * i], bc[4 * i + 1], bc[4 * i + 2], bc[4 * i + 3]}; }
            asm volatile("s_waitcnt lgkmcnt(0)" ::: "memory");
            const f32x4 dl = *(const LAS f32x4*)(kt + 2304 + 16 * fq);
            const f32x4 dec = (f32x4){fexp2(dl.x), fexp2(dl.y), fexp2(dl.z), fexp2(dl.w)};
            bf16x8 afr[2];
#pragma unroll
            for (int ks = 0; ks < 2; ++ks) afr[ks] = *(const LAS bf16x8*)(kt + fr * KT_STR + (32 * ks + 8 * fq) * 2);
#pragma unroll
            for (int et = 0; et < NE; ++et) acc[et] = acc[et] * dec;
            { constexpr int NB = 2 * NE / 4;
              LAS const unsigned char* vb[2][2];
#pragma unroll
              for (int ks = 0; ks < 2; ++ks) { const int r0 = 32 * ks + 8 * fq + qq, r1 = r0 + 4;
                  vb[ks][0] = lds + (ci * 64 + (dir ? 63 - r0 : r0)) * VSTR + 8 * p4; vb[ks][1] = lds + (ci * 64 + (dir ? 63 - r1 : r1)) * VSTR + 8 * p4; }
              bf16x8 bb[2][4];
#pragma unroll
              for (int j = 0; j < 4; ++j) bb[0][j] = tr_pair(vb[0][0] + 32 * j, vb[0][1] + 32 * j);
#pragma unroll
              for (int b = 0; b < NB; ++b) {
                  if (b + 1 < NB) { const int ks1 = (b + 1) / (NE / 4), e1 = 4 * ((b + 1) % (NE / 4));
#pragma unroll
                      for (int j = 0; j < 4; ++j) bb[(b + 1) & 1][j] = tr_pair(vb[ks1][0] + 32 * (e1 + j), vb[ks1][1] + 32 * (e1 + j)); }
                  const int ks0 = b / (NE / 4), e0 = 4 * (b % (NE / 4));
#pragma unroll
                  for (int j = 0; j < 4; ++j) acc[e0 + j] = __builtin_amdgcn_mfma_f32_16x16x32_bf16(afr[ks0], bb[b & 1][j], acc[e0 + j], 0, 0, 0);
                  __builtin_amdgcn_sched_group_barrier(0x100, 8, 0); __builtin_amdgcn_sched_group_barrier(0x008, 4, 0); } }
            asm volatile("s_waitcnt lgkmcnt(0)" ::: "memory");
            cur = nxt;
        }
        if (!STORE) { bf16* sout = X.STS + st_slot(sc, HGT, h, dir);
#pragma unroll
            for (int et = 0; et < NE; ++et) { v2u w; w.x = pkbf(acc[et][0], acc[et][1]); w.y = pkbf(acc[et][2], acc[et][3]);
                *(GAS v2u*)(sout + (size_t)(16 * et + fr) * 128 + c0 + 4 * fq) = w; }
            if (lane == 0) { float* tp = X.TOTS + ((size_t)sc * 24 + hd) * 128 + c0;
#pragma unroll
                for (int i = 0; i < 4; ++i) ((GAS f32x4*)tp)[i] = (f32x4){run[4 * i], run[4 * i + 1], run[4 * i + 2], run[4 * i + 3]}; } }
    }
    __syncthreads();
}
__device__ __forceinline__ void pass_b_super(const Ctx& X, int g, int gtid, int NT) {
    const int ns = (g == 0) ? 1 : 2, nc = NSC / ns;
    for (int v = gtid; v < ns * (ST_CHUNK / 8); v += NT) {
        const int s = v / (ST_CHUNK / 8), idx = (v % (ST_CHUNK / 8)) * 8;
        const int hd = idx < 262144 ? idx / 32768 : 8 + (idx - 262144) / 16384, db = hd & 1, d0 = idx & 127;
        float S[8];
#pragma unroll
        for (int i = 0; i < 8; ++i) S[i] = 0.f;
        for (int cc = 0; cc < nc; cc += 4) {
            v4u x[4]; f32x4 t0[4], t1[4];
#pragma unroll
            for (int u = 0; u < 4; ++u) { const int c = s * nc + (db ? nc - 1 - (cc + u) : cc + u);
                x[u] = *(const GAS v4u*)(X.STS + (size_t)c * ST_CHUNK + idx);
                const GAS f32x4* tp = (const GAS f32x4*)(X.TOTS + ((size_t)c * 24 + hd) * 128 + d0); t0[u] = tp[0]; t1[u] = tp[1]; }
#pragma unroll
            for (int u = 0; u < 4; ++u) { const int c = s * nc + (db ? nc - 1 - (cc + u) : cc + u);
                *(GAS v4u*)(X.STS + (size_t)c * ST_CHUNK + idx) = pack8(S);
                float dx[8]; unpack8(x[u], dx);
                const float dec[8] = {fexp2(t0[u].x), fexp2(t0[u].y), fexp2(t0[u].z), fexp2(t0[u].w), fexp2(t1[u].x), fexp2(t1[u].y), fexp2(t1[u].z), fexp2(t1[u].w)};
#pragma unroll
                for (int i = 0; i < 8; ++i) S[i] = dec[i] * S[i] + dx[i]; }
        }
    }
}

template <bool HGT>
__device__ __forceinline__ void pass_c_unit(const Ctx& X, int l, int chunk, int h, LAS unsigned char* lds, int tid, int lane, int wave) {
    constexpr int DV = HGT ? 128 : 256, VSTR = DV * 2 + 16, NET = DV / 128;
    const int fr = lane & 15, fq = lane >> 4, qq = fr >> 2, p4 = fr & 3;
    stage_v<DV>(X, chunk, HGT ? ZC_HI + h * 128 : ZC_GV + h * 256, lds, tid);
    f32x4 oacc[NET][4];
#pragma unroll
    for (int et = 0; et < NET; ++et)
#pragma unroll
        for (int it = 0; it < 4; ++it) oacc[et][it] = (f32x4){0.f, 0.f, 0.f, 0.f};
    for (int dir = 0; dir < 2; ++dir) {
        scan_stage<HGT, true>(X, l, chunk, h, dir, lds, lane, wave, nullptr);
        const bf16* slot = X.ST + st_slot(chunk, HGT, h, dir);
        bf16x8 sfr[NET][4];
#pragma unroll
        for (int et = 0; et < NET; ++et)
#pragma unroll
            for (int ks = 0; ks < 4; ++ks) sfr[et][ks] = *(const GAS bf16x8*)(slot + (size_t)(16 * (wave * NET + et) + fr) * 128 + 32 * ks + 8 * fq);
        __syncthreads();
        { const int I = wave & 3, par = wave >> 2;
#pragma unroll
          for (int jt = 0; jt < 2; ++jt) { const int J = par + 2 * jt;
            LAS unsigned char* pdst = lds + L_P + (16 * I + fr) * P_STR + (16 * J + 4 * fq) * 2;
            if (J > I) { *(LAS v2u*)pdst = (v2u){0u, 0u}; }
            else {
                const int rho = (J == I) ? 16 * I + 8 : 16 * I - 1, ri = 16 * I + fr, rj = 16 * J + fr;
                f32x4 sc = (f32x4){0.f, 0.f, 0.f, 0.f};
#pragma unroll
                for (int ks = 0; ks < 4; ++ks) { const int dc = 32 * ks + 8 * fq;
                    float br[8], bi[8], bj[8], qf[8], kf[8];
                    { const LAS f32x4* t = (const LAS f32x4*)(lds + L_B32 + rho * B32_STR + dc * 4); const f32x4 a = t[0], b = t[1]; br[0] = a.x; br[1] = a.y; br[2] = a.z; br[3] = a.w; br[4] = b.x; br[5] = b.y; br[6] = b.z; br[7] = b.w; }
                    { const LAS f32x4* t = (const LAS f32x4*)(lds + L_B32 + ri * B32_STR + dc * 4); const f32x4 a = t[0], b = t[1]; bi[0] = a.x; bi[1] = a.y; bi[2] = a.z; bi[3] = a.w; bi[4] = b.x; bi[5] = b.y; bi[6] = b.z; bi[7] = b.w; }
                    { const LAS f32x4* t = (const LAS f32x4*)(lds + L_B32 + rj * B32_STR + dc * 4); const f32x4 a = t[0], b = t[1]; bj[0] = a.x; bj[1] = a.y; bj[2] = a.z; bj[3] = a.w; bj[4] = b.x; bj[5] = b.y; bj[6] = b.z; bj[7] = b.w; }
                    unpack8(*(const LAS v4u*)(lds + L_QR + ri * K_STR + dc * 2), qf);
                    unpack8(*(const LAS v4u*)(lds + L_KR + rj * K_STR + dc * 2), kf);
#pragma unroll
                    for (int i = 0; i < 8; ++i) { qf[i] *= fexp2(fminf(bi[i] - br[i], 80.f)); kf[i] *= fexp2(fminf(br[i] - bj[i], 80.f)); }
                    const v4u qa = pack8(qf), ka = pack8(kf);
                    sc = __builtin_amdgcn_mfma_f32_16x16x32_bf16(__builtin_bit_cast(bf16x8, ka), __builtin_bit_cast(bf16x8, qa), sc, 0, 0, 0); }
                if (J == I) {
#pragma unroll
                    for (int t = 0; t < 4; ++t) if (4 * fq + t > fr) sc[t] = 0.f; }
                v2u w; w.x = pkbf(sc[0], sc[1]); w.y = pkbf(sc[2], sc[3]); *(LAS v2u*)pdst = w; }
          } }
        __syncthreads();
        bf16x8 vfr[NET][2];
#pragma unroll
        for (int ks = 0; ks < 2; ++ks) { const int r0 = 32 * ks + 8 * fq + qq, r1 = r0 + 4, v0 = dir ? 63 - r0 : r0, v1 = dir ? 63 - r1 : r1;
#pragma unroll
            for (int et = 0; et < NET; ++et) { const int col = (16 * (wave * NET + et) + 4 * p4) * 2;
                vfr[et][ks] = tr_pair(lds + L_V + v0 * VSTR + col, lds + L_V + v1 * VSTR + col); } }
        { bf16x8 bo[2][6];
#pragma unroll
          for (int it = 0; it <= 4; ++it) {
            if (it < 4) { const int trow = 16 * it + fr, ip = dir ? 63 - trow : trow;
#pragma unroll
                for (int ks = 0; ks < 4; ++ks) bo[it & 1][ks] = *(const LAS bf16x8*)(lds + L_QH + ip * K_STR + (32 * ks + 8 * fq) * 2);
#pragma unroll
                for (int ks = 0; ks < 2; ++ks) bo[it & 1][4 + ks] = *(const LAS bf16x8*)(lds + L_P + ip * P_STR + (32 * ks + 8 * fq) * 2); }
            if (it > 0) { const int jt = it - 1;
#pragma unroll
                for (int ks = 0; ks < 4; ++ks)
#pragma unroll
                    for (int et = 0; et < NET; ++et) oacc[et][jt] = __builtin_amdgcn_mfma_f32_16x16x32_bf16(sfr[et][ks], bo[jt & 1][ks], oacc[et][jt], 0, 0, 0);
#pragma unroll
                for (int ks = 0; ks < 2; ++ks)
#pragma unroll
                    for (int et = 0; et < NET; ++et) oacc[et][jt] = __builtin_amdgcn_mfma_f32_16x16x32_bf16(vfr[et][ks], bo[jt & 1][4 + ks], oacc[et][jt], 0, 0, 0); }
            __builtin_amdgcn_sched_group_barrier(0x100, 6, 0); __builtin_amdgcn_sched_group_barrier(0x008, 6 * NET, 0); } }
        __syncthreads();
    }
    LAS float* red = (LAS float*)(lds + L_RED);
#pragma unroll
    for (int it = 0; it < 4; ++it) { float s = 0.f;
#pragma unroll
        for (int et = 0; et < NET; ++et) { const f32x4 o = oacc[et][it]; s += (o.x * o.x + o.y * o.y) + (o.z * o.z + o.w * o.w); }
        s += __shfl_xor(s, 16); s += __shfl_xor(s, 32);
        if (fq == 0) red[wave * 64 + 16 * it + fr] = s; }
    __syncthreads();
    const float* ng = (HGT ? X.hg_g + (size_t)l * 128 : X.gla_g + (size_t)l * 256);
    const int ogcol = HGT ? ZC_HOG + h * 128 : ZC_GOG + h * 256, ocol = HGT ? 1024 + h * 128 : h * 256;
#pragma unroll
    for (int it = 0; it < 4; ++it) { float tot = 0.f;
#pragma unroll
        for (int w = 0; w < 8; ++w) tot += red[w * 64 + 16 * it + fr];
        const float rstd = 1.f / sqrtf(tot * (1.f / DV) + RMS_EPS);
        const int tok = chunk * 64 + 16 * it + fr;
#pragma unroll
        for (int et = 0; et < NET; ++et) { const int e0 = 16 * (wave * NET + et) + 4 * fq;
            const v2u ogp = *(const GAS v2u*)(X.Z + (size_t)tok * ZW + ogcol + e0);
            const float og[4] = {__uint_as_float(ogp.x << 16), __uint_as_float(ogp.x & 0xffff0000u), __uint_as_float(ogp.y << 16), __uint_as_float(ogp.y & 0xffff0000u)};
            const f32x4 g4 = *(const GAS f32x4*)(ng + e0); float r[4];
#pragma unroll
            for (int t = 0; t < 4; ++t) { const float z = fminf(fmaxf(og[t], -80.f), 80.f); r[t] = oacc[et][it][t] * rstd * g4[t] * (z / (1.f + __expf(-z))); }
            v2u w; w.x = pkbf(r[0], r[1]); w.y = pkbf(r[2], r[3]);
            *(GAS v2u*)(X.O + (size_t)tok * DM + ocol + e0) = w; } }
    __syncthreads();
}

struct Args { const float* in[15]; float* out; unsigned char* ws; int mode, pad; };
#define PHASE_IDS() int tid = threadIdx.x; asm volatile("" : "+v"(tid)); const int lane = tid & 63, wave = __builtin_amdgcn_readfirstlane(tid >> 6); \
    const int gw = bx * NWAVES + wave, NGW = G * NWAVES, gtid = bx * (NWAVES * 64) + tid, NT = G * NWAVES * 64; (void)lane; (void)wave; (void)gw; (void)NGW; (void)gtid; (void)NT
__device__ __forceinline__ Ctx make_ctx(const Args& args) {
    Ctx X; unsigned char* ws = args.ws;
    X.x_prompt = args.in[0]; X.x_sample = args.in[1]; X.w_in = args.in[2]; X.w_lr2 = args.in[3]; X.b_lr = args.in[4]; X.gla_g = args.in[5]; X.hg_g = args.in[6]; X.lowb = args.in[7];
    X.w_out = args.in[8]; X.ln1_g = args.in[9]; X.ln1_b = args.in[10]; X.w_up = args.in[11]; X.w_down = args.in[12]; X.ln2_g = args.in[13]; X.ln2_b = args.in[14]; X.out = args.out;
    X.Win_t = (bf16*)(ws + WS_WIN); X.Wout_t = (bf16*)(ws + WS_WOUT); X.Wup_t = (bf16*)(ws + WS_WUP); X.Wdn_t = (bf16*)(ws + WS_WDN); X.Wglr_t = (bf16*)(ws + WS_WGLR);
    X.HB = (bf16*)(ws + WS_HB); X.Z = (bf16*)(ws + WS_Z); X.O = (bf16*)(ws + WS_O); X.ST = (bf16*)(ws + WS_ST);
    X.BG = (float*)(ws + WS_BG); X.MF = (bf16*)(ws + WS_ST); X.TOT = (float*)(ws + WS_TOT); X.TOTS = (float*)(ws + WS_TOTS); X.STS = (bf16*)(ws + WS_STS);
    return X;
}
__global__ void __launch_bounds__(NWAVES * 64, 2) fwd_kernel(Args args) {
    extern __shared__ __attribute__((aligned(16))) unsigned char lds_raw[];
    LAS unsigned char* lds = (LAS unsigned char*)lds_raw;
    const int G = gridDim.x, bx = blockIdx.x;
    volatile LAS unsigned* MISC = (volatile LAS unsigned*)(lds + MISC_OFF);
    if (threadIdx.x < 32) MISC[threadIdx.x] = 0u;
    __syncthreads();
    XcdBarrier bar = xcd_barrier_post((unsigned*)(args.ws + WS_CTL) + CW_BAR, MISC + 8);

    { PHASE_IDS(); const Ctx X = make_ctx(args); prologue_weights(X, lds, gw, NGW, wave, lane); }
    for (int g = 0; g < NGRP; ++g) {
        { PHASE_IDS(); const Ctx X = make_ctx(args); cvt_group((g == 0) ? X.x_prompt : X.x_sample + (size_t)(g - 1) * GM * DM, X.HB, gtid, NT); }
        xcd_barrier(bar);
        for (int l = 0; l < NLAYER; ++l) {
            { PHASE_IDS(); const Ctx X = make_ctx(args); for (int c = bx; c < NCHUNK; c += G) gate_unit(X, l, c, lds, tid, lane, wave); }
            { const Ctx X = make_ctx(args); pg8::Gemm gm{X.HB, X.Win_t + (size_t)l * ZW * DM, GM, ZW, DM}; pg8::StaticOrder S; S.init(GM, ZW, G, bx);
              pg8::EpiBf16<0> E{X.Z, ZW};
              pg8::gemm_phase<pg8::EpiBf16<0>, pg8::StaticOrder, true, true>(lds, gm, S, E); }
            xcd_barrier(bar);
            {
            { PHASE_IDS(); const Ctx X = make_ctx(args);
              for (int u = bx; u < NSC * 12; u += G) { const int sc = u / 12, hh = u % 12;
                if (hh < 4) pass_s_unit<false, false>(X, l, sc, hh, lds, tid, lane, wave); else pass_s_unit<true, false>(X, l, sc, hh - 4, lds, tid, lane, wave); } }
            xcd_barrier(bar);
            { PHASE_IDS(); const Ctx X = make_ctx(args); pass_b_super(X, g, gtid, NT); }
            xcd_barrier(bar);
            { PHASE_IDS(); const Ctx X = make_ctx(args);
              for (int u = bx; u < NSC * 12; u += G) { const int sc = u / 12, hh = u % 12;
                if (hh < 4) pass_s_unit<false, true>(X, l, sc, hh, lds, tid, lane, wave); else pass_s_unit<true, true>(X, l, sc, hh - 4, lds, tid, lane, wave); } }
            xcd_barrier(bar);
            { PHASE_IDS(); const Ctx X = make_ctx(args);
              for (int u = bx; u < NCHUNK * 12; u += G) { const int c = u / 12, hh = u % 12;
                if (hh < 4) pass_c_unit<false>(X, l, c, hh, lds, tid, lane, wave); else pass_c_unit<true>(X, l, c, hh - 4, lds, tid, lane, wave); } }
            xcd_barrier(bar);
            }
            { const Ctx X = make_ctx(args); pg8::Gemm gm{X.O, X.Wout_t + (size_t)l * DM * DM, GM, DM, DM}; pg8::StaticOrder S; S.init(GM, DM, G, bx);
              pg8::EpiBf16<0> E{X.MF, DM};
              pg8::gemm_phase<pg8::EpiBf16<0>, pg8::StaticOrder, true, true>(lds, gm, S, E); }
            xcd_barrier(bar);
            { PHASE_IDS(); const Ctx X = make_ctx(args);
              if (l == 0) ln_phase<true, false>((g == 0) ? X.x_prompt : X.x_sample + (size_t)(g - 1) * GM * DM, X.MF, X.ln1_g, X.ln1_b, nullptr, X.HB, gw, NGW, lane);
              else ln_phase<false, false>(X.HB, X.MF, X.ln1_g + (size_t)l * DM, X.ln1_b + (size_t)l * DM, nullptr, X.HB, gw, NGW, lane); }
            xcd_barrier(bar);
            { const Ctx X = make_ctx(args); pg8::Gemm gm{X.HB, X.Wup_t + (size_t)l * DFF * DM, GM, DFF, DM}; pg8::StaticOrder S; S.init(GM, DFF, G, bx);
              pg8::EpiBf16<1> E{X.Z, DFF};
              pg8::gemm_phase<pg8::EpiBf16<1>, pg8::StaticOrder, true, true>(lds, gm, S, E); }
            xcd_barrier(bar);
            { const Ctx X = make_ctx(args); pg8::Gemm gm{X.Z, X.Wdn_t + (size_t)l * DM * DFF, GM, DM, DFF}; pg8::StaticOrder S; S.init(GM, DM, G, bx);
              pg8::EpiBf16<0> E{X.MF, DM};
              pg8::gemm_phase<pg8::EpiBf16<0>, pg8::StaticOrder, true, true>(lds, gm, S, E); }
            xcd_barrier(bar);
            { PHASE_IDS(); const Ctx X = make_ctx(args);
              if (l == NLAYER - 1) ln_phase<false, true>(X.HB, X.MF, X.ln2_g + (size_t)l * DM, X.ln2_b + (size_t)l * DM, X.out + (size_t)g * GM * DM, nullptr, gw, NGW, lane);
              else ln_phase<false, false>(X.HB, X.MF, X.ln2_g + (size_t)l * DM, X.ln2_b + (size_t)l * DM, nullptr, X.HB, gw, NGW, lane); }
            xcd_barrier(bar);
        }
    }
}

extern "C" void kernel_launch(void* const* d_in, const int* in_sizes, int n_in, void* d_out, int out_size, void* d_ws, size_t ws_size, hipStream_t stream) {
    static int grid = 0;
    if (grid == 0) {
        if (n_in != 15 || out_size != NTOK * DM || ws_size < WS_END) { fprintf(stderr, "kernel_launch: unexpected shapes (n_in %d, out %d, ws %zu)\n", n_in, out_size, ws_size); grid = -1; return; }
        int dev = 0, cus = 0;
        if (hipGetDevice(&dev) != hipSuccess || hipDeviceGetAttribute(&cus, hipDeviceAttributeMultiprocessorCount, dev) != hipSuccess) { grid = -1; return; }
        if (hipFuncSetAttribute((const void*)fwd_kernel, hipFuncAttributeMaxDynamicSharedMemorySize, LDS_BYTES) != hipSuccess) { fprintf(stderr, "kernel_launch: hipFuncSetAttribute failed\n"); grid = -1; return; }
        int per_cu = 0;
        if (hipOccupancyMaxActiveBlocksPerMultiprocessor(&per_cu, (const void*)fwd_kernel, NWAVES * 64, LDS_BYTES) != hipSuccess || per_cu < 1) { fprintf(stderr, "kernel_launch: occupancy query says %d\n", per_cu); }
        (void)hipGetLastError();
        grid = cus;
    }
    if (grid < 0) return;
    if (hipMemsetAsync((char*)d_ws + WS_CTL, 0, CTL_ZERO_BYTES, stream) != hipSuccess) return;
    Args a{};
    for (int i = 0; i < 15; ++i) a.in[i] = (const float*)d_in[i];
    a.out = (float*)d_out; a.ws = (unsigned char*)d_ws; a.mode = KMODE; a.pad = 0;
    hipLaunchKernelGGL(fwd_kernel, dim3(grid), dim3(NWAVES * 64), LDS_BYTES, stream, a);
}
```

```cpp
#include <hip/hip_runtime.h>
#include <cstdio>
#include <cstdint>
#ifndef KMODE
#define KMODE 0
#endif
namespace pg8 {
#define PG8_LAS __attribute__((address_space(3)))
typedef unsigned short bf16_t;
typedef short bf16x8 __attribute__((ext_vector_type(8)));
typedef float f32x4 __attribute__((ext_vector_type(4)));
typedef unsigned u32x4 __attribute__((ext_vector_type(4)));
constexpr int BM = 256, BK = 64, HALF = 128, HTB = HALF * BK * 2  , STAGE_BYTES = 8 * HTB, NXCD = 8, WGM = 8;

__host__ __device__ __forceinline__ int lds_byte(int r, int c) { const int st = (r >> 4) * 2 + (c >> 5), rr = r & 15, cc = c & 31, ob = rr * 64 + cc * 2; return st * 1024 + (ob ^ (((ob >> 9) & 1) << 5)); }
__host__ __device__ __forceinline__ void stage_rc(int b, int& R, int& C) { const int st = b / 1024, sb = b % 1024, swz = sb ^ (((sb >> 9) & 1) << 5); R = (st >> 1) * 16 + swz / 64; C = (st & 1) * 32 + (swz % 64) / 2; }
__host__ __device__ __forceinline__ int perm32(int rho) { const int n = rho >> 4, i = rho & 15; return 8 * (i >> 2) + 4 * n + (i & 3); }

struct Unit { int pm, pn; };
struct Gemm { const bf16_t* A; const bf16_t* Bt; int M, N, K; };

struct StaticOrder {
    int nM, nN, nwg, G, c;
    __host__ __device__ void init(int M, int N, int G_, int c_) { nM = M / BM; nN = N / BM; nwg = nM * nN; G = G_; c = c_; }
    __host__ __device__ bool next(int i, Unit& u) const {
        const long L = (long)i * G + c; if (L >= nwg) return false;
        int wgid = (int)L; { const int q = nwg / NXCD, r = nwg % NXCD, xcd = wgid % NXCD, off = wgid / NXCD; wgid = (xcd < r ? xcd * (q + 1) : r * (q + 1) + (xcd - r) * q) + off; }
        const int nig = WGM * nN, gid = wgid / nig, fm = gid * WGM, gsz = (nM - fm) < WGM ? (nM - fm) : WGM;
        u.pm = fm + ((wgid % nig) % gsz); u.pn = (wgid % nig) / gsz; return true;
    }
    __device__ __forceinline__ void a_ready(const Unit&) const {}
    __device__ __forceinline__ void done(const Unit&) const {}
};


__device__ __forceinline__ unsigned cvt_pk_bf16(float lo, float hi) { unsigned r; asm volatile("v_cvt_pk_bf16_f32 %0, %1, %2" : "=v"(r) : "v"(lo), "v"(hi)); return r; }

template <int ACT  > struct EpiBf16 {
    static constexpr bool PERM = true, AFTER_DRAIN = false;
    bf16_t* O; int ldc;
    __device__ __forceinline__ void operator()(const f32x4 (&acc)[2][2][4][2], const Unit& u, int wr, int wc, int fr, int fq) const {
        const int row0 = u.pm * BM + wr * 64 + fr; const int col0 = u.pn * BM + wc * 32 + 8 * fq;
#pragma unroll
        for (int ai = 0; ai < 2; ++ai)
#pragma unroll
            for (int m = 0; m < 4; ++m) { bf16_t* rowp = O + (size_t)(row0 + ai * HALF + m * 16) * ldc + col0;
#pragma unroll
                for (int bj = 0; bj < 2; ++bj) { f32x4 v0 = acc[ai][bj][m][0], v1 = acc[ai][bj][m][1];
                    if (ACT == 1) {
#pragma unroll
                        for (int j = 0; j < 4; ++j) { const float a = fmaxf(v0[j], 0.f), b = fmaxf(v1[j], 0.f); v0[j] = a * a; v1[j] = b * b; } }
                    u32x4 w; w.x = cvt_pk_bf16(v0[0], v0[1]); w.y = cvt_pk_bf16(v0[2], v0[3]); w.z = cvt_pk_bf16(v1[0], v1[1]); w.w = cvt_pk_bf16(v1[2], v1[3]);
                    *(u32x4*)(rowp + bj * HALF) = w; } }
    }
};
struct EpiF32 {
    static constexpr bool PERM = false, AFTER_DRAIN = false;
    float* C; int ldc;
    __device__ __forceinline__ void operator()(const f32x4 (&acc)[2][2][4][2], const Unit& u, int wr, int wc, int fr, int fq) const {
        const int row0 = u.pm * BM + wr * 64 + fr, col0 = u.pn * BM + wc * 32 + 4 * fq;
#pragma unroll
        for (int ai = 0; ai < 2; ++ai)
#pragma unroll
            for (int m = 0; m < 4; ++m) { float* rowp = C + (size_t)(row0 + ai * HALF + m * 16) * ldc + col0;
#pragma unroll
                for (int bj = 0; bj < 2; ++bj)
#pragma unroll
                    for (int n = 0; n < 2; ++n) *(f32x4*)(rowp + bj * HALF + n * 16) = acc[ai][bj][m][n]; }
    }
};

template <class Epi, class Sched, bool ALIGN_EPI = false, bool SP2 = false>
__device__ __forceinline__ void gemm_phase(PG8_LAS unsigned char* lds, const Gemm g, const Sched& S, const Epi& E) {
    int tid_o = threadIdx.x; asm volatile("" : "+v"(tid_o));
    const int tid = tid_o, wid = __builtin_amdgcn_readfirstlane(tid >> 6), lane = tid & 63, wr = wid >> 2, wc = wid & 3, fr = lane & 15, fq = lane >> 4;
    const int K = g.K, nt = K / BK;
    unsigned voffA[2], voffB[2];
#pragma unroll
    for (int i = 0; i < 2; ++i) { int R, C; stage_rc(tid * 16 + i * 8192, R, C); const int Rb = Epi::PERM ? ((R & ~31) + perm32(R & 31)) : R;
        voffA[i] = (unsigned)(R * K + C) * 2u; voffB[i] = (unsigned)(Rb * K + C) * 2u; }
    const size_t kstep = (size_t)(BK * 2);
    const size_t hstep = (size_t)HALF * K * 2;
    const size_t tstep = 2 * hstep;
    const unsigned ldsw = (unsigned)wid * 1024u;
    const int aoff = lds_byte(wr * 64 + fr, fq * 8), boff = lds_byte(wc * 32 + fr, fq * 8);
#define PG8_SA(b, h) (((b) * 2 + (h)) * HTB)
#define PG8_SB(b, h) ((4 + (b) * 2 + (h)) * HTB)
#define PG8_STAGE(bufoff, gbase, voff) do { _Pragma("unroll") for (int _i = 0; _i < 2; ++_i) \
        __builtin_amdgcn_global_load_lds((const unsigned*)((const char*)(gbase) + (voff)[_i]), (PG8_LAS unsigned*)(lds + (bufoff) + ldsw + _i * 8192), 16, 0, 0); } while (0)
#define PG8_LDA(dst, b, h) do { _Pragma("unroll") for (int m = 0; m < 4; ++m) _Pragma("unroll") for (int k = 0; k < 2; ++k) dst[m][k] = *(const PG8_LAS bf16x8*)(lds + PG8_SA(b, h) + aoff + m * 2048 + k * 1024); } while (0)
#define PG8_LDB(dst, b, h) do { _Pragma("unroll") for (int n = 0; n < 2; ++n) _Pragma("unroll") for (int k = 0; k < 2; ++k) dst[n][k] = *(const PG8_LAS bf16x8*)(lds + PG8_SB(b, h) + boff + n * 2048 + k * 1024); } while (0)
#define PG8_MMA(ai, bj, At, Bt) do { __builtin_amdgcn_s_setprio(1); _Pragma("unroll") for (int m = 0; m < 4; ++m) _Pragma("unroll") for (int n = 0; n < 2; ++n) _Pragma("unroll") for (int k = 0; k < 2; ++k) \
        acc[ai][bj][m][n] = __builtin_amdgcn_mfma_f32_16x16x32_bf16(Bt[n][k], At[m][k], acc[ai][bj][m][n], 0, 0, 0); __builtin_amdgcn_s_setprio(0); } while (0)
#define PG8_WAIT_V(n) asm volatile("s_waitcnt vmcnt(" #n ")" ::: "memory")
#define PG8_WAIT_L(n) asm volatile("s_waitcnt lgkmcnt(" #n ")" ::: "memory")
#define PG8_BAR __builtin_amdgcn_s_barrier()
#define PG8_SCHED __builtin_amdgcn_sched_barrier(0)
    Unit cur, nxt; int ui = 0;
    if (!S.next(0, cur)) return;
    f32x4 acc[2][2][4][2];
#pragma unroll
    for (int a = 0; a < 2; ++a)
#pragma unroll
        for (int b = 0; b < 2; ++b)
#pragma unroll
            for (int m = 0; m < 4; ++m)
#pragma unroll
                for (int n = 0; n < 2; ++n) acc[a][b][m][n] = (f32x4){0.f, 0.f, 0.f, 0.f};
    bf16x8 At[4][2], B0[2][2], B1[2][2];
    const char* cA = (const char*)g.A + (size_t)cur.pm * tstep; const char* cB = (const char*)g.Bt + (size_t)cur.pn * tstep;
    S.a_ready(cur);
    if constexpr (SP2) {
        PG8_STAGE(PG8_SB(0, 0), cB, voffB); PG8_STAGE(PG8_SB(0, 1), cB + hstep, voffB); PG8_STAGE(PG8_SA(0, 0), cA, voffA); PG8_STAGE(PG8_SA(0, 1), cA + hstep, voffA);
        if (wr == 1) PG8_BAR;
        PG8_WAIT_V(2); PG8_BAR;
        PG8_STAGE(PG8_SB(1, 0), cB + kstep, voffB); PG8_STAGE(PG8_SA(1, 0), cA + kstep, voffA); PG8_STAGE(PG8_SB(1, 1), cB + hstep + kstep, voffB);
        PG8_WAIT_V(6); PG8_BAR;
    } else {
        PG8_STAGE(PG8_SB(0, 0), cB, voffB); PG8_STAGE(PG8_SA(0, 0), cA, voffA); PG8_STAGE(PG8_SB(0, 1), cB + hstep, voffB); PG8_STAGE(PG8_SA(0, 1), cA + hstep, voffA);
        if (wr == 1) PG8_BAR;
        PG8_WAIT_V(4); PG8_BAR;
        PG8_STAGE(PG8_SB(1, 0), cB + kstep, voffB); PG8_STAGE(PG8_SA(1, 0), cA + kstep, voffA); PG8_STAGE(PG8_SB(1, 1), cB + hstep + kstep, voffB);
        PG8_WAIT_V(6); PG8_BAR;
    }
    for (;;) {
        const bool has_next = S.next(ui + 1, nxt);
        const char* nA = has_next ? (const char*)g.A + (size_t)nxt.pm * tstep : cA; const char* nB = has_next ? (const char*)g.Bt + (size_t)nxt.pn * tstep : cB;
        for (int t = 0; t < nt; t += 2) {
            const bool last = (t == nt - 2);
            const char* a1 = cA + (size_t)(t + 1) * kstep;
            const char* a2 = last ? nA : cA + (size_t)(t + 2) * kstep; const char* b2 = last ? nB : cB + (size_t)(t + 2) * kstep;
            const char* a3 = a2 + kstep; const char* b3 = b2 + kstep;
            if (last && has_next) S.a_ready(nxt);
            if constexpr (SP2) {
            PG8_LDB(B0, 0, 0); PG8_LDB(B1, 0, 1); PG8_SCHED; PG8_LDA(At, 0, 0); PG8_STAGE(PG8_SA(1, 1), a1 + hstep, voffA);
            PG8_WAIT_V(8); PG8_WAIT_L(0); PG8_BAR; PG8_MMA(0, 0, At, B0); PG8_MMA(0, 1, At, B1); PG8_BAR; PG8_SCHED;
            PG8_LDA(At, 0, 1); PG8_STAGE(PG8_SB(0, 0), b2, voffB); PG8_STAGE(PG8_SB(0, 1), b2 + hstep, voffB); PG8_STAGE(PG8_SA(0, 0), a2, voffA);
            PG8_WAIT_V(8); PG8_WAIT_L(0); PG8_BAR; PG8_MMA(1, 0, At, B0); PG8_MMA(1, 1, At, B1); PG8_BAR; PG8_SCHED;
            PG8_LDB(B0, 1, 0); PG8_LDB(B1, 1, 1); PG8_SCHED; PG8_LDA(At, 1, 0); PG8_STAGE(PG8_SA(0, 1), a2 + hstep, voffA);
            PG8_WAIT_V(8); PG8_WAIT_L(0); PG8_BAR; PG8_MMA(0, 0, At, B0); PG8_MMA(0, 1, At, B1); PG8_BAR; PG8_SCHED;
            PG8_LDA(At, 1, 1); PG8_STAGE(PG8_SB(1, 0), b3, voffB); PG8_STAGE(PG8_SB(1, 1), b3 + hstep, voffB); PG8_STAGE(PG8_SA(1, 0), a3, voffA);
            PG8_WAIT_V(8); PG8_WAIT_L(0); PG8_BAR; PG8_MMA(1, 0, At, B0); PG8_MMA(1, 1, At, B1); PG8_BAR; PG8_SCHED;
            } else {
            PG8_LDB(B0, 0, 0); PG8_SCHED; PG8_LDA(At, 0, 0); PG8_STAGE(PG8_SA(1, 1), a1 + hstep, voffA);
            PG8_WAIT_L(8); PG8_BAR; PG8_WAIT_L(0); PG8_MMA(0, 0, At, B0); PG8_BAR; PG8_SCHED;
            PG8_LDB(B1, 0, 1); PG8_STAGE(PG8_SB(0, 0), b2, voffB);
            PG8_BAR; PG8_WAIT_L(0); PG8_MMA(0, 1, At, B1); PG8_BAR;
            PG8_LDA(At, 0, 1); PG8_STAGE(PG8_SA(0, 0), a2, voffA);
            PG8_BAR; PG8_WAIT_L(0); PG8_MMA(1, 0, At, B0); PG8_BAR; PG8_SCHED;
            PG8_STAGE(PG8_SB(0, 1), b2 + hstep, voffB);
            PG8_WAIT_V(6); PG8_BAR; PG8_MMA(1, 1, At, B1); PG8_BAR;
            PG8_LDB(B0, 1, 0); PG8_SCHED; PG8_LDA(At, 1, 0); PG8_STAGE(PG8_SA(0, 1), a2 + hstep, voffA);
            PG8_WAIT_L(8); PG8_BAR; PG8_WAIT_L(0); PG8_MMA(0, 0, At, B0); PG8_BAR; PG8_SCHED;
            PG8_LDB(B1, 1, 1); PG8_STAGE(PG8_SB(1, 0), b3, voffB);
            PG8_BAR; PG8_WAIT_L(0); PG8_MMA(0, 1, At, B1); PG8_BAR;
            PG8_LDA(At, 1, 1); PG8_STAGE(PG8_SA(1, 0), a3, voffA);
            PG8_BAR; PG8_WAIT_L(0); PG8_MMA(1, 0, At, B0); PG8_BAR; PG8_SCHED;
            PG8_STAGE(PG8_SB(1, 1), b3 + hstep, voffB);
            PG8_WAIT_V(6); PG8_BAR; PG8_MMA(1, 1, At, B1); PG8_BAR;
            }
        }
        if constexpr (ALIGN_EPI) { if (wr == 0) PG8_BAR; }
        if constexpr (!Epi::AFTER_DRAIN) { E(acc, cur, wr, wc, fr, fq); S.done(cur); }
        if (!has_next) break;
#pragma unroll
        for (int a = 0; a < 2; ++a)
#pragma unroll
            for (int b = 0; b < 2; ++b)
#pragma unroll
                for (int m = 0; m < 4; ++m)
#pragma unroll
                    for (int n = 0; n < 2; ++n) acc[a][b][m][n] = (f32x4){0.f, 0.f, 0.f, 0.f};
        cur = nxt; cA = nA; cB = nB; ++ui;
        if constexpr (ALIGN_EPI) { if (wr == 1) PG8_BAR; }
    }
    PG8_WAIT_V(0);
    if constexpr (!ALIGN_EPI) { if (wr == 0) PG8_BAR; }
    PG8_BAR;
    if constexpr (Epi::AFTER_DRAIN) { E.fused(acc, cur, wr, wc, fr, fq, lds, wid, lane); S.done(cur); }
#undef PG8_SA
#undef PG8_SB
#undef PG8_STAGE
#undef PG8_LDA
#undef PG8_LDB
#undef PG8_MMA
#undef PG8_WAIT_V
#undef PG8_WAIT_L
#undef PG8_BAR
#undef PG8_SCHED
}
}

constexpr int NWAVES = 8;
constexpr int DM = 2048, DFF = 8192, NTOK = 49152, GM = 16384, NGRP = 3, NLAYER = 2, INW = 8224, ZW = 8192;
constexpr int ZC_GQ = 0, ZC_GK = 512, ZC_GV = 1024, ZC_GOG = 2048, ZC_HQ = 3072, ZC_HFF = 4096, ZC_HFB = 5120, ZC_HI = 6144, ZC_HOG = 7168;
constexpr float LN_EPS = 1e-5f, RMS_EPS = 1e-6f, ALPHA = 1.41421356237f, LOG2E = 1.44269504089f;
constexpr int NCHUNK = GM / 64;
constexpr int ST_CHUNK = 524288;
constexpr size_t MiB = 1u << 20;
constexpr size_t WS_CTL = 0, CTL_ZERO_BYTES = 1 * MiB;
constexpr size_t WS_WIN = 2 * MiB, WS_WOUT = 66 * MiB, WS_WUP = 82 * MiB, WS_WDN = 146 * MiB, WS_WGLR = 210 * MiB;
constexpr size_t WS_HB = 212 * MiB;
constexpr size_t WS_Z = 276 * MiB;
constexpr size_t WS_BG = 532 * MiB;
constexpr size_t WS_O = 596 * MiB;
constexpr size_t WS_ST = 660 * MiB;
constexpr size_t WS_TOT = 916 * MiB;
constexpr size_t WS_STS = 920 * MiB;
constexpr size_t WS_TOTS = 984 * MiB;
constexpr size_t WS_END = 985 * MiB;
constexpr int CW_BAR = 4096;
constexpr int RING_BYTES = 131072;
constexpr int LDS_BYTES = 160 * 1024, MISC_OFF = LDS_BYTES - 256;
constexpr int L_B32 = 0, L_KR = 33792, L_QR = 51200, L_QH = 68608, L_V = 86016, L_P = 119808, L_RED = 129024;
constexpr int B32_STR = 528, K_STR = 272, P_STR = 144, KT_STR = 144;
constexpr int NSC = GM / 256;
constexpr int SV_KT = 135168, KTW_BYTES = 2560;

#define GAS __attribute__((address_space(1)))
#define LAS __attribute__((address_space(3)))
typedef unsigned short bf16;
typedef unsigned v4u __attribute__((ext_vector_type(4)));
typedef float f32x4 __attribute__((ext_vector_type(4)));
typedef short bf16x8 __attribute__((ext_vector_type(8)));
typedef GAS unsigned gu32;
typedef GAS unsigned long long gu64;
#define RLX_AGENT __ATOMIC_RELAXED, __HIP_MEMORY_SCOPE_AGENT
#define LDS_WAIT() asm volatile("s_waitcnt lgkmcnt(0)" ::: "memory")
#define VM_WAIT() asm volatile("s_waitcnt vmcnt(0)" ::: "memory")
__device__ __forceinline__ unsigned long long rt() { return __builtin_amdgcn_s_memrealtime(); }
__device__ __forceinline__ unsigned f2bf(float f) { unsigned u = __builtin_bit_cast(unsigned, f); return (u + 0x7fffu + ((u >> 16) & 1u)) >> 16; }
__device__ __forceinline__ unsigned pk2(float lo, float hi) { return f2bf(lo) | (f2bf(hi) << 16); }

#define XB_TMO      128
#define XB_XCNT(j)  (256  + 64 * (j))
#define XB_XSUB(j)  (1280 + 64 * (j))
#define XB_XGEN(j)  (2304 + 64 * (j))
#define XB_TOP      3328
#define XB_TOPGEN   3392
#define XCD_BAR_WORDS 3456
#define XB_SPIN_CAP (1u << 18)

__device__ __forceinline__ unsigned xb_ld(unsigned* p)              { return __hip_atomic_load(p, __ATOMIC_RELAXED, __HIP_MEMORY_SCOPE_AGENT); }
__device__ __forceinline__ unsigned xb_add(unsigned* p, unsigned v) { return __hip_atomic_fetch_add(p, v, __ATOMIC_RELAXED, __HIP_MEMORY_SCOPE_AGENT); }
__device__ __forceinline__ unsigned xb_xcc_id() { return (unsigned)__builtin_amdgcn_s_getreg((3 << 11) | 20) & 0xFu; }
#define XB_SPIN(cond, bar) do { unsigned _sp = 0; while (cond) { __builtin_amdgcn_s_sleep(1); \
    if ((++_sp & 255u) == 0u) { if (xb_ld(&(bar)[XB_TMO])) break; if (_sp > XB_SPIN_CAP) { atomicAdd(&(bar)[XB_TMO], 1u); break; } } } } while (0)

struct XcdBarrier {
    unsigned* bar; unsigned x;
    volatile LAS unsigned* st;
};

__device__ __forceinline__ XcdBarrier xcd_barrier_post(unsigned* bar, volatile LAS unsigned* st) {
    XcdBarrier b; b.bar = bar; b.x = xb_xcc_id(); b.st = st;
    if (threadIdx.x == 0) (void)xb_add(&bar[XB_XCNT(b.x)], 1u);
    return b;
}
__device__ __forceinline__ void xcd_barrier_complete(unsigned* bar, unsigned x, unsigned& nloc, unsigned& nx) {
    const unsigned G = gridDim.x * gridDim.y * gridDim.z;
    unsigned sum, cnt, mine, sp = 0u;
    for (;;) {
        sum = 0u; cnt = 0u; mine = 0u;
#pragma unroll
        for (unsigned j = 0; j < 16; ++j) { const unsigned c = xb_ld(&bar[XB_XCNT(j)]); sum += c; cnt += (c > 0u) ? 1u : 0u; mine = (j == x) ? c : mine; }
        if (sum == G) break;
        __builtin_amdgcn_s_sleep(1);
        if ((++sp & 255u) == 0u) { if (xb_ld(&bar[XB_TMO])) break; if (sp > XB_SPIN_CAP) { atomicAdd(&bar[XB_TMO], 1u); break; } }
    }
    nloc = mine > 0u ? mine : 1u; nx = cnt > 0u ? cnt : 1u;
}

__device__ __forceinline__ void xcd_barrier(const XcdBarrier& b) {
    asm volatile("s_waitcnt vmcnt(0)" ::: "memory");
    __syncthreads();
    if (threadIdx.x == 0) {
        unsigned* bar = b.bar;
        __builtin_amdgcn_s_waitcnt(0);
        unsigned nloc = b.st[0], nx = b.st[1];
        if (nloc == 0u) { xcd_barrier_complete(bar, b.x, nloc, nx); b.st[0] = nloc; b.st[1] = nx; }
        const unsigned old = xb_add(&bar[XB_XSUB(b.x)], 1u);
        const unsigned gen = old / nloc;
        if (old + 1u == (gen + 1u) * nloc) {
            __builtin_amdgcn_fence(__ATOMIC_RELEASE, "agent");
            asm volatile("s_waitcnt vmcnt(0)" ::: "memory");
            const unsigned og = xb_add(&bar[XB_TOP], 1u);
            const unsigned tg = og / nx;
            if (og + 1u == (tg + 1u) * nx) xb_add(&bar[XB_TOPGEN], 1u);
            else XB_SPIN(xb_ld(&bar[XB_TOPGEN]) == tg, bar);
            __builtin_amdgcn_fence(__ATOMIC_ACQUIRE, "agent");
            xb_add(&bar[XB_XGEN(b.x)], 1u);
            asm volatile("s_waitcnt vmcnt(0)" ::: "memory");
        } else {
            XB_SPIN(xb_ld(&bar[XB_XGEN(b.x)]) == gen, bar);
            __builtin_amdgcn_fence(__ATOMIC_ACQUIRE, "agent");
            asm volatile("s_waitcnt vmcnt(0)" ::: "memory");
        }
    }
    __syncthreads();
}

typedef short s16x4 __attribute__((ext_vector_type(4)));
typedef float f32x2 __attribute__((ext_vector_type(2)));
typedef unsigned v2u __attribute__((ext_vector_type(2)));
__device__ __forceinline__ unsigned pkbf(float lo, float hi) { return pg8::cvt_pk_bf16(lo, hi); }
__device__ __forceinline__ float wave_sum(float v) {
#pragma unroll
    for (int o = 1; o < 64; o <<= 1) v += __shfl_xor(v, o);
    return v;
}
template <int CTRL, int RM> __device__ __forceinline__ float dpp_add(float v) {
    return v + __builtin_bit_cast(float, __builtin_amdgcn_update_dpp(0, __builtin_bit_cast(int, v), CTRL, RM, 0xf, true));
}
__device__ __forceinline__ float wave_scan_incl(float v, int) {
    v = dpp_add<0x111, 0xf>(v); v = dpp_add<0x112, 0xf>(v); v = dpp_add<0x114, 0xf>(v); v = dpp_add<0x118, 0xf>(v);
    v = dpp_add<0x142, 0xa>(v); v = dpp_add<0x143, 0xc>(v); return v;
}
__device__ __forceinline__ void unpack8(const v4u v, float* f) {
    f[0] = __uint_as_float(v.x << 16); f[1] = __uint_as_float(v.x & 0xffff0000u); f[2] = __uint_as_float(v.y << 16); f[3] = __uint_as_float(v.y & 0xffff0000u);
    f[4] = __uint_as_float(v.z << 16); f[5] = __uint_as_float(v.z & 0xffff0000u); f[6] = __uint_as_float(v.w << 16); f[7] = __uint_as_float(v.w & 0xffff0000u);
}
__device__ __forceinline__ v4u pack8(const float* f) { v4u o; o.x = pkbf(f[0], f[1]); o.y = pkbf(f[2], f[3]); o.z = pkbf(f[4], f[5]); o.w = pkbf(f[6], f[7]); return o; }
__device__ __forceinline__ s16x4 lds_tr(LAS const unsigned char* p) { return __builtin_bit_cast(s16x4, __builtin_amdgcn_ds_read_tr16_b64_v4i16((LAS s16x4*)p)); }
__device__ __forceinline__ bf16x8 tr_pair(LAS const unsigned char* p0, LAS const unsigned char* p1) {
    const s16x4 a = lds_tr(p0), b = lds_tr(p1); return __builtin_shufflevector(a, b, 0, 1, 2, 3, 4, 5, 6, 7);
}
__device__ __forceinline__ float fexp2(float x) { return __builtin_amdgcn_exp2f(x); }
__device__ __forceinline__ float flog2(float x) { return __builtin_amdgcn_logf(x); }

struct Ctx {
    const float *x_prompt, *x_sample, *w_in, *w_lr2, *b_lr, *gla_g, *hg_g, *lowb, *w_out, *ln1_g, *ln1_b, *w_up, *w_down, *ln2_g, *ln2_b;
    float* out;
    bf16 *Win_t, *Wout_t, *Wup_t, *Wdn_t, *Wglr_t, *HB, *Z, *O, *ST;
    float *BG, *TOT, *TOTS; bf16 *STS, *MF;
};

__device__ __forceinline__ void transpose_item(const float* W, int N, int kb, int nb, bf16* dst, int K, LAS float* scr, int lane) {
    const int k0 = 64 * kb, n0 = 32 * nb;
#pragma unroll 8
    for (int i = 0; i < 32; ++i) { const int kk = 2 * i + (lane >> 5); scr[kk * 33 + (lane & 31)] = W[(size_t)(k0 + kk) * N + n0 + (lane & 31)]; }
    LDS_WAIT(); asm volatile("" ::: "memory");
    const int c = lane & 7;
#pragma unroll
    for (int j = 0; j < 4; ++j) { const int n = (lane >> 3) + 8 * j; const LAS float* s = scr + (8 * c) * 33 + n;
        v4u o; o.x = pkbf(s[0 * 33], s[1 * 33]); o.y = pkbf(s[2 * 33], s[3 * 33]); o.z = pkbf(s[4 * 33], s[5 * 33]); o.w = pkbf(s[6 * 33], s[7 * 33]);
        *(GAS v4u*)(dst + (size_t)n * K + k0 + 8 * c) = o; }
    LDS_WAIT(); asm volatile("" ::: "memory");
}
__device__ __forceinline__ void prologue_weights(const Ctx& X, LAS unsigned char* lds, int gw, int NGW, int wave, int lane) {
    LAS float* scr = (LAS float*)(lds + wave * 16384);
    constexpr int I_IN = 32 * 257, I_OUT = 32 * 64, I_UP = 32 * 256, I_DN = 128 * 64, I_L = I_IN + I_OUT + I_UP + I_DN;
    for (int it = gw; it < NLAYER * I_L; it += NGW) {
        const int l = it / I_L; int r = it % I_L;
        if (r < I_IN) { const int kb = r / 257, nb = r % 257;
            bf16* dst = (nb < 96) ? X.Win_t + ((size_t)l * ZW + 32 * nb) * DM : (nb == 96) ? X.Wglr_t + (size_t)l * 32 * DM : X.Win_t + ((size_t)l * ZW + 32 * (nb - 1)) * DM;
            transpose_item(X.w_in + (size_t)l * DM * INW, INW, kb, nb, dst, DM, scr, lane); continue; }
        r -= I_IN;
        if (r < I_OUT) { const int kb = r / 64, nb = r % 64; transpose_item(X.w_out + (size_t)l * DM * DM, DM, kb, nb, X.Wout_t + ((size_t)l * DM + 32 * nb) * DM, DM, scr, lane); continue; }
        r -= I_OUT;
        if (r < I_UP) { const int kb = r / 256, nb = r % 256; transpose_item(X.w_up + (size_t)l * DM * DFF, DFF, kb, nb, X.Wup_t + ((size_t)l * DFF + 32 * nb) * DM, DM, scr, lane); continue; }
        r -= I_UP;
        { const int kb = r / 64, nb = r % 64; transpose_item(X.w_down + (size_t)l * DFF * DM, DM, kb, nb, X.Wdn_t + ((size_t)l * DM + 32 * nb) * DFF, DFF, scr, lane); }
    }
}
__device__ __forceinline__ void cvt_group(const float* xg, bf16* HB, int gtid, int NT) {
    for (int i = gtid; i < GM * DM / 8; i += NT) {
        const f32x4 a = ((const GAS f32x4*)xg)[2 * i], b = ((const GAS f32x4*)xg)[2 * i + 1];
        v4u o; o.x = pkbf(a.x, a.y); o.y = pkbf(a.z, a.w); o.z = pkbf(b.x, b.y); o.w = pkbf(b.z, b.w);
        ((GAS v4u*)HB)[i] = o; }
}
template <bool RES_F32, bool OUT_F32>
__device__ __forceinline__ void ln_phase(const void* res, const bf16* mf, const float* gam, const float* bet, float* H, bf16* HB, int gw, int NGW, int lane) {
    for (int m = gw; m < GM; m += NGW) {
        f32x4 v[8]; float s = 0.f;
        const GAS v2u* mr = (const GAS v2u*)(mf + (size_t)m * DM) + lane;
#pragma unroll
        for (int j = 0; j < 8; ++j) { f32x4 r;
            if (RES_F32) r = ((const GAS f32x4*)((const float*)res + (size_t)m * DM) + lane)[64 * j];
            else { const v2u w = ((const GAS v2u*)((const bf16*)res + (size_t)m * DM) + lane)[64 * j];
                r = (f32x4){__uint_as_float(w.x << 16), __uint_as_float(w.x & 0xffff0000u), __uint_as_float(w.y << 16), __uint_as_float(w.y & 0xffff0000u)}; }
            const v2u w = mr[64 * j];
            const f32x4 f = (f32x4){__uint_as_float(w.x << 16), __uint_as_float(w.x & 0xffff0000u), __uint_as_float(w.y << 16), __uint_as_float(w.y & 0xffff0000u)};
            v[j] = r * ALPHA + f; s += (v[j].x + v[j].y) + (v[j].z + v[j].w); }
        const float mean = wave_sum(s) * (1.f / DM); float s2 = 0.f;
#pragma unroll
        for (int j = 0; j < 8; ++j) { v[j] = v[j] - mean; s2 += (v[j].x * v[j].x + v[j].y * v[j].y) + (v[j].z * v[j].z + v[j].w * v[j].w); }
        const float rstd = 1.f / sqrtf(wave_sum(s2) * (1.f / DM) + LN_EPS);
#pragma unroll
        for (int j = 0; j < 8; ++j) { const f32x4 g4 = ((const GAS f32x4*)gam)[lane + 64 * j], b4 = ((const GAS f32x4*)bet)[lane + 64 * j];
            const f32x4 o = v[j] * rstd * g4 + b4;
            if (OUT_F32) ((GAS f32x4*)(H + (size_t)m * DM) + lane)[64 * j] = o;
            else { v2u w; w.x = pkbf(o.x, o.y); w.y = pkbf(o.z, o.w); ((GAS v2u*)(HB + (size_t)m * DM) + lane)[64 * j] = w; } }
    }
}

__device__ __forceinline__ void gate_unit(const Ctx& X, int l, int chunk, LAS unsigned char* lds, int tid, int lane, int wave) {
    const int fr = lane & 15, fq = lane >> 4;
    const bf16* A = X.HB + (size_t)chunk * 64 * DM; const bf16* Bw = X.Wglr_t + (size_t)l * 32 * DM;
    f32x4 acc[4][2];
#pragma unroll
    for (int m = 0; m < 4; ++m)
#pragma unroll
        for (int n = 0; n < 2; ++n) acc[m][n] = (f32x4){0.f, 0.f, 0.f, 0.f};
#pragma unroll 2
    for (int ks = 0; ks < 8; ++ks) { const int k0 = 256 * wave + 32 * ks + 8 * fq;
        bf16x8 a[4], b[2];
#pragma unroll
        for (int m = 0; m < 4; ++m) a[m] = *(const GAS bf16x8*)(A + (size_t)(16 * m + fr) * DM + k0);
#pragma unroll
        for (int n = 0; n < 2; ++n) b[n] = *(const GAS bf16x8*)(Bw + (size_t)(16 * n + fr) * DM + k0);
#pragma unroll
        for (int m = 0; m < 4; ++m)
#pragma unroll
            for (int n = 0; n < 2; ++n) acc[m][n] = __builtin_amdgcn_mfma_f32_16x16x32_bf16(a[m], b[n], acc[m][n], 0, 0, 0); }
    LAS float* part = (LAS float*)lds;
#pragma unroll
    for (int m = 0; m < 4; ++m)
#pragma unroll
        for (int n = 0; n < 2; ++n)
#pragma unroll
            for (int j = 0; j < 4; ++j) part[(wave * 64 + 16 * m + 4 * fq + j) * 33 + 16 * n + fr] = acc[m][n][j];
    __syncthreads();
    LAS float* glr = (LAS float*)(lds + 8 * 64 * 33 * 4);
#pragma unroll
    for (int k = 0; k < 4; ++k) { const int idx = tid + 512 * k, t = idx >> 5, n = idx & 31; float s = 0.f;
#pragma unroll
        for (int w = 0; w < 8; ++w) s += part[(w * 64 + t) * 33 + n];
        glr[t * 36 + n] = s; }
    __syncthreads();
    const int dir = wave >> 2;
    const float* w2 = X.w_lr2 + (size_t)(l * 2 + dir) * 16 * 512; const float* bl = X.b_lr + (size_t)(l * 2 + dir) * 512;
    for (int cb = 0; cb < 2; ++cb) { const int c = 128 * (wave & 3) + 64 * cb + lane;
        float w[16];
#pragma unroll
        for (int r = 0; r < 16; ++r) w[r] = w2[r * 512 + c];
        const float bias = bl[c]; float run = 0.f;
        float* bgcol = X.BG + (size_t)chunk * 64 * 1024 + dir * 512 + c;
#pragma unroll 4
        for (int tt = 0; tt < 64; ++tt) { const int t = dir ? 63 - tt : tt;
            const LAS f32x4* gr = (const LAS f32x4*)(glr + t * 36 + dir * 16); const f32x4 g0 = gr[0], g1 = gr[1], g2 = gr[2], g3 = gr[3];
            float pre = bias;
            pre += g0.x * w[0] + g0.y * w[1] + g0.z * w[2] + g0.w * w[3]; pre += g1.x * w[4] + g1.y * w[5] + g1.z * w[6] + g1.w * w[7];
            pre += g2.x * w[8] + g2.y * w[9] + g2.z * w[10] + g2.w * w[11]; pre += g3.x * w[12] + g3.y * w[13] + g3.z * w[14] + g3.w * w[15];
            run += (fminf(pre, 0.f) - __logf(1.f + __expf(-fabsf(pre)))) * (LOG2E / 16.f);
            bgcol[(size_t)t * 1024] = run; } }
    __syncthreads();
}

template <bool HGT, bool PC>
__device__ __forceinline__ void scan_stage(const Ctx& X, int l, int chunk, int h, int dir, LAS unsigned char* lds, int lane, int wave, float* tot_out) {
    const int r = lane, tok = chunk * 64 + (dir ? 63 - r : r), c0 = 16 * wave;
    const bf16* zrow = X.Z + (size_t)tok * ZW;
    float bc[16], kr[16], qv[16];
    if (!HGT) {
        const GAS f32x4* bg = (const GAS f32x4*)(X.BG + (size_t)tok * 1024 + dir * 512 + h * 128 + c0);
#pragma unroll
        for (int i = 0; i < 4; ++i) { const f32x4 t = bg[i]; bc[4 * i] = t.x; bc[4 * i + 1] = t.y; bc[4 * i + 2] = t.z; bc[4 * i + 3] = t.w; }
        const GAS v4u* kp = (const GAS v4u*)(zrow + ZC_GK + h * 128 + c0); unpack8(kp[0], kr); unpack8(kp[1], kr + 8);
        if (PC) { const GAS v4u* qp = (const GAS v4u*)(zrow + ZC_GQ + h * 128 + c0); unpack8(qp[0], qv); unpack8(qp[1], qv + 8);
#pragma unroll
            for (int i = 0; i < 16; ++i) qv[i] *= 0.08838834764831845f; }
    } else {
        float zf[16];
        const GAS v4u* zp = (const GAS v4u*)(zrow + (dir ? ZC_HFB : ZC_HFF) + h * 128 + c0); unpack8(zp[0], zf); unpack8(zp[1], zf + 8);
        const float* lp = X.lowb + (size_t)dir * 2 * 1024 + h * 128 + c0;
#pragma unroll
        for (int i = 0; i < 16; ++i) {
            const float lb = (l == 0) ? 0.f : 1.f / (1.f + __expf(lp[i] - lp[1024 + i]));
            const float z = fminf(fmaxf(zf[i], -80.f), 80.f), e = __expf(-z), sig = 1.f / (1.f + e);
            const float f = lb + (1.f - lb) * sig;
            kr[i] = (1.f - lb) * e * sig;
            bc[i] = wave_scan_incl(flog2(f), lane); }
        if (PC) { const GAS v4u* qp = (const GAS v4u*)(zrow + ZC_HQ + h * 128 + c0); unpack8(qp[0], qv); unpack8(qp[1], qv + 8); }
    }
    LAS unsigned char* kdst = lds + L_KR + r * K_STR + c0 * 2;
    if (PC) {
        LAS f32x4* bdst = (LAS f32x4*)(lds + L_B32 + r * B32_STR + c0 * 4);
#pragma unroll
        for (int i = 0; i < 4; ++i) bdst[i] = (f32x4){bc[4 * i], bc[4 * i + 1], bc[4 * i + 2], bc[4 * i + 3]};
        ((LAS v4u*)kdst)[0] = pack8(kr); ((LAS v4u*)kdst)[1] = pack8(kr + 8);
        LAS unsigned char* qdst = lds + L_QR + r * K_STR + c0 * 2;
        ((LAS v4u*)qdst)[0] = pack8(qv); ((LAS v4u*)qdst)[1] = pack8(qv + 8);
        float qh[16];
#pragma unroll
        for (int i = 0; i < 16; ++i) qh[i] = qv[i] * fexp2(bc[i]);
        LAS unsigned char* hdst = lds + L_QH + r * K_STR + c0 * 2;
        ((LAS v4u*)hdst)[0] = pack8(qh); ((LAS v4u*)hdst)[1] = pack8(qh + 8);
    } else {
        float kh[16];
#pragma unroll
        for (int i = 0; i < 16; ++i) { const float bl = __shfl(bc[i], 63); kh[i] = kr[i] * fexp2(bl - bc[i]); }
        { const v4u k0 = pack8(kh), k1 = pack8(kh + 8); const unsigned kw[8] = {k0.x, k0.y, k0.z, k0.w, k1.x, k1.y, k1.z, k1.w};
#pragma unroll
          for (int i = 0; i < 16; ++i) *(LAS unsigned short*)(lds + L_KR + (c0 + i) * KT_STR + r * 2) = (unsigned short)((i & 1) ? (kw[i >> 1] >> 16) : (kw[i >> 1] & 0xffffu)); }
        if (lane == 63) {
#pragma unroll
            for (int i = 0; i < 4; ++i) ((GAS f32x4*)(tot_out + c0))[i] = (f32x4){bc[4 * i], bc[4 * i + 1], bc[4 * i + 2], bc[4 * i + 3]}; }
    }
}
template <int DV>
__device__ __forceinline__ void stage_v(const Ctx& X, int chunk, int vcol, LAS unsigned char* lds, int tid) {
    constexpr int PPR = DV / 8, VSTR = DV * 2 + 16;
#pragma unroll
    for (int k = 0; k < 64 * PPR / 512; ++k) { const int idx = tid + 512 * k, row = idx / PPR, pc = idx % PPR;
        const v4u v = *(const GAS v4u*)(X.Z + (size_t)(chunk * 64 + row) * ZW + vcol + pc * 8);
        *(LAS v4u*)(lds + L_V + row * VSTR + pc * 16) = v; }
}
__device__ __forceinline__ size_t st_slot(int chunk, bool hgt, int h, int dir) { return (size_t)chunk * ST_CHUNK + (hgt ? 262144 + (h * 2 + dir) * 16384 : (h * 2 + dir) * 32768); }

template <bool HGT>
__device__ __forceinline__ void pass_a_unit(const Ctx& X, int l, int chunk, int h, LAS unsigned char* lds, int tid, int lane, int wave) {
    constexpr int DV = HGT ? 128 : 256, VSTR = DV * 2 + 16, NET = DV / 128;
    const int fr = lane & 15, fq = lane >> 4, qq = fr >> 2, p4 = fr & 3;
    stage_v<DV>(X, chunk, HGT ? ZC_HI + h * 128 : ZC_GV + h * 256, lds, tid);
    for (int dir = 0; dir < 2; ++dir) {
        const int hd = HGT ? 8 + h * 2 + dir : h * 2 + dir;
        scan_stage<HGT, false>(X, l, chunk, h, dir, lds, lane, wave, X.TOT + ((size_t)chunk * 24 + hd) * 128);
        __syncthreads();
        f32x4 acc[8][NET];
#pragma unroll
        for (int dt = 0; dt < 8; ++dt)
#pragma unroll
            for (int et = 0; et < NET; ++et) acc[dt][et] = (f32x4){0.f, 0.f, 0.f, 0.f};
#pragma unroll
        for (int ks = 0; ks < 2; ++ks) {
            const int r0 = 32 * ks + 8 * fq + qq, r1 = r0 + 4;
            const int v0 = dir ? 63 - r0 : r0, v1 = dir ? 63 - r1 : r1;
            bf16x8 bfr[NET];
#pragma unroll
            for (int et = 0; et < NET; ++et) { const int col = (16 * (wave * NET + et) + 4 * p4) * 2;
                bfr[et] = tr_pair(lds + L_V + v0 * VSTR + col, lds + L_V + v1 * VSTR + col); }
#pragma unroll
            for (int dt = 0; dt < 8; ++dt) { const int col = (16 * dt + 4 * p4) * 2;
                const bf16x8 afr = *(const LAS bf16x8*)(lds + L_KR + (16 * dt + fr) * KT_STR + (32 * ks + 8 * fq) * 2); (void)col;
#pragma unroll
                for (int et = 0; et < NET; ++et) acc[dt][et] = __builtin_amdgcn_mfma_f32_16x16x32_bf16(afr, bfr[et], acc[dt][et], 0, 0, 0); }
        }
        bf16* slot = X.ST + st_slot(chunk, HGT, h, dir);
#pragma unroll
        for (int dt = 0; dt < 8; ++dt)
#pragma unroll
            for (int et = 0; et < NET; ++et) { const int e = 16 * (wave * NET + et) + fr, d = 16 * dt + 4 * fq;
                v2u w; w.x = pkbf(acc[dt][et][0], acc[dt][et][1]); w.y = pkbf(acc[dt][et][2], acc[dt][et][3]);
                *(GAS v2u*)(slot + e * 128 + d) = w; }
        __syncthreads();
    }
}

__device__ __forceinline__ void pass_b(const Ctx& X, int g, int gtid, int NT) {
    const int ns = (g == 0) ? 1 : 2, nc = NCHUNK / ns;
    for (int v = gtid; v < ns * (ST_CHUNK / 8); v += NT) {
        const int s = v / (ST_CHUNK / 8), idx = (v % (ST_CHUNK / 8)) * 8;
        const int hd = idx < 262144 ? idx / 32768 : 8 + (idx - 262144) / 16384, db = hd & 1, d0 = idx & 127;
        float S[8];
#pragma unroll
        for (int i = 0; i < 8; ++i) S[i] = 0.f;
        for (int cc = 0; cc < nc; cc += 4) {
            v4u x[4]; f32x4 t0[4], t1[4];
#pragma unroll
            for (int u = 0; u < 4; ++u) { const int c = s * nc + (db ? nc - 1 - (cc + u) : cc + u);
                x[u] = *(const GAS v4u*)(X.ST + (size_t)c * ST_CHUNK + idx);
                const GAS f32x4* tp = (const GAS f32x4*)(X.TOT + ((size_t)c * 24 + hd) * 128 + d0); t0[u] = tp[0]; t1[u] = tp[1]; }
#pragma unroll
            for (int u = 0; u < 4; ++u) { const int c = s * nc + (db ? nc - 1 - (cc + u) : cc + u);
                *(GAS v4u*)(X.ST + (size_t)c * ST_CHUNK + idx) = pack8(S);
                float dx[8]; unpack8(x[u], dx);
                const float dec[8] = {fexp2(t0[u].x), fexp2(t0[u].y), fexp2(t0[u].z), fexp2(t0[u].w), fexp2(t1[u].x), fexp2(t1[u].y), fexp2(t1[u].z), fexp2(t1[u].w)};
#pragma unroll
                for (int i = 0; i < 8; ++i) S[i] = dec[i] * S[i] + dx[i]; }
        }
    }
}

template <bool HGT> struct RawIn { f32x4 b[4]; v4u k[2]; };
template <> struct RawIn<true> { v4u k[2]; };
template <bool HGT>
__device__ __forceinline__ RawIn<HGT> pass_s_load(const Ctx& X, int chunk, int h, int dir, int lane, int c0) {
    RawIn<HGT> r; const int tok = chunk * 64 + (dir ? 63 - lane : lane); const bf16* zrow = X.Z + (size_t)tok * ZW;
    if constexpr (!HGT) { const GAS f32x4* bg = (const GAS f32x4*)(X.BG + (size_t)tok * 1024 + dir * 512 + h * 128 + c0);
#pragma unroll
        for (int i = 0; i < 4; ++i) r.b[i] = bg[i];
        const GAS v4u* kp = (const GAS v4u*)(zrow + ZC_GK + h * 128 + c0); r.k[0] = kp[0]; r.k[1] = kp[1];
    } else { const GAS v4u* zp = (const GAS v4u*)(zrow + (dir ? ZC_HFB : ZC_HFF) + h * 128 + c0); r.k[0] = zp[0]; r.k[1] = zp[1]; }
    return r;
}
template <bool HGT, bool STORE>
__device__ __forceinline__ void pass_s_unit(const Ctx& X, int l, int sc, int h, LAS unsigned char* lds, int tid, int lane, int wave) {
    constexpr int DV = HGT ? 128 : 256, VSTR = DV * 2 + 16, NE = DV / 16, PPR = DV / 8;
    const int fr = lane & 15, fq = lane >> 4, qq = fr >> 2, p4 = fr & 3, c0 = 16 * wave;
    RawIn<HGT> cur = pass_s_load<HGT>(X, sc * 4, h, 0, lane, c0);
    { const int vcol = HGT ? ZC_HI + h * 128 : ZC_GV + h * 256;
#pragma unroll 4
      for (int k = 0; k < 256 * PPR / 512; ++k) { const int idx = tid + 512 * k, row = idx / PPR, pc = idx % PPR;
        const v4u v = *(const GAS v4u*)(X.Z + (size_t)(sc * 256 + row) * ZW + vcol + pc * 8);
        *(LAS v4u*)(lds + row * VSTR + pc * 16) = v; } }
    __syncthreads();
    LAS unsigned char* kt = lds + SV_KT + wave * KTW_BYTES;
    for (int dir = 0; dir < 2; ++dir) {
        const int hd = HGT ? 8 + h * 2 + dir : h * 2 + dir;
        float lbv[16];
        if (HGT) { const float* lp = X.lowb + (size_t)dir * 2 * 1024 + h * 128 + c0;
#pragma unroll
            for (int i = 0; i < 16; ++i) lbv[i] = (l == 0) ? 0.f : 1.f / (1.f + __expf(lp[i] - lp[1024 + i])); }
        f32x4 acc[NE];
        if (STORE) { const bf16* sin = X.STS + st_slot(sc, HGT, h, dir);
#pragma unroll
            for (int et = 0; et < NE; ++et) { const v2u w = *(const GAS v2u*)(sin + (size_t)(16 * et + fr) * 128 + c0 + 4 * fq);
                acc[et] = (f32x4){__uint_as_float(w.x << 16), __uint_as_float(w.x & 0xffff0000u), __uint_as_float(w.y << 16), __uint_as_float(w.y & 0xffff0000u)}; }
        } else {
#pragma unroll
            for (int et = 0; et < NE; ++et) acc[et] = (f32x4){0.f, 0.f, 0.f, 0.f}; }
        float run[16];
#pragma unroll
        for (int i = 0; i < 16; ++i) run[i] = 0.f;
        for (int cc = 0; cc < 4; ++cc) { const int ci = dir ? 3 - cc : cc, chunk = sc * 4 + ci;
            RawIn<HGT> nxt = cur;
            if (cc < 3) nxt = pass_s_load<HGT>(X, sc * 4 + (dir ? 2 - cc : cc + 1), h, dir, lane, c0);
            else if (dir == 0) nxt = pass_s_load<HGT>(X, sc * 4 + 3, h, 1, lane, c0);
            float bc[16], kr[16];
            if constexpr (!HGT) {
#pragma unroll
                for (int i = 0; i < 4; ++i) { bc[4 * i] = cur.b[i].x; bc[4 * i + 1] = cur.b[i].y; bc[4 * i + 2] = cur.b[i].z; bc[4 * i + 3] = cur.b[i].w; }
                unpack8(cur.k[0], kr); unpack8(cur.k[1], kr + 8);
            } else {
                float zf[16]; unpack8(cur.k[0], zf); unpack8(cur.k[1], zf + 8);
#pragma unroll
                for (int i = 0; i < 16; ++i) {
                    const float z = fminf(fmaxf(zf[i], -80.f), 80.f), e = __expf(-z), sig = 1.f / (1.f + e);
                    const float f = lbv[i] + (1.f - lbv[i]) * sig;
                    kr[i] = (1.f - lbv[i]) * e * sig;
                    bc[i] = wave_scan_incl(flog2(f), lane); }
            }
            if (STORE) { bf16* slot = X.ST + st_slot(chunk, HGT, h, dir);
#pragma unroll
                for (int et = 0; et < NE; ++et) { v2u w; w.x = pkbf(acc[et][0], acc[et][1]); w.y = pkbf(acc[et][2], acc[et][3]);
                    *(GAS v2u*)(slot + (size_t)(16 * et + fr) * 128 + c0 + 4 * fq) = w; } }
            float kh[16];
#pragma unroll
            for (int i = 0; i < 16; ++i) { const float bl = __shfl(bc[i], 63); kh[i] = kr[i] * fexp2(bl - bc[i]); run[i] += bl; }
            { const v4u k0 = pack8(kh), k1 = pack8(kh + 8); const unsigned kw[8] = {k0.x, k0.y, k0.z, k0.w, k1.x, k1.y, k1.z, k1.w};
#pragma unroll
              for (int i = 0; i < 16; ++i) *(LAS unsigned short*)(kt + i * KT_STR + lane * 2) = (unsigned short)((i & 1) ? (kw[i >> 1] >> 16) : (kw[i >> 1] & 0xffffu)); }
            if (lane == 63) {
#pragma unroll
                for (int i = 0; i < 4; ++i) ((LAS f32x4*)(kt + 2304))[i] = (f32x4){bc[4 * i], bc[4 * i + 1], bc[4 * i + 2], bc[4 * i + 3]}; }
            asm volatile("s_waitcnt lgkmcnt(0)" ::: "memory");
            const f32x4 dl = *(const LAS f32x4*)(kt + 2304 + 16 * fq);
            const f32x4 dec = (f32x4){fexp2(dl.x), fexp2(dl.y), fexp2(dl.z), fexp2(dl.w)};
            bf16x8 afr[2];
#pragma unroll
            for (int ks = 0; ks < 2; ++ks) afr[ks] = *(const LAS bf16x8*)(kt + fr * KT_STR + (32 * ks + 8 * fq) * 2);
#pragma unroll
            for (int et = 0; et < NE; ++et) acc[et] = acc[et] * dec;
            { constexpr int NB = 2 * NE / 4;
              LAS const unsigned char* vb[2][2];
#pragma unroll
              for (int ks = 0; ks < 2; ++ks) { const int r0 = 32 * ks + 8 * fq + qq, r1 = r0 + 4;
                  vb[ks][0] = lds + (ci * 64 + (dir ? 63 - r0 : r0)) * VSTR + 8 * p4; vb[ks][1] = lds + (ci * 64 + (dir ? 63 - r1 : r1)) * VSTR + 8 * p4; }
              bf16x8 bb[2][4];
#pragma unroll
              for (int j = 0; j < 4; ++j) bb[0][j] = tr_pair(vb[0][0] + 32 * j, vb[0][1] + 32 * j);
#pragma unroll
              for (int b = 0; b < NB; ++b) {
                  if (b + 1 < NB) { const int ks1 = (b + 1) / (NE / 4), e1 = 4 * ((b + 1) % (NE / 4));
#pragma unroll
                      for (int j = 0; j < 4; ++j) bb[(b + 1) & 1][j] = tr_pair(vb[ks1][0] + 32 * (e1 + j), vb[ks1][1] + 32 * (e1 + j)); }
                  const int ks0 = b / (NE / 4), e0 = 4 * (b % (NE / 4));
#pragma unroll
                  for (int j = 0; j < 4; ++j) acc[e0 + j] = __builtin_amdgcn_mfma_f32_16x16x32_bf16(afr[ks0], bb[b & 1][j], acc[e0 + j], 0, 0, 0);
                  __builtin_amdgcn_sched_group_barrier(0x100, 8, 0); __builtin_amdgcn_sched_group_barrier(0x008, 4, 0); } }
            asm volatile("s_waitcnt lgkmcnt(0)" ::: "memory");
            cur = nxt;
        }
        if (!STORE) { bf16* sout = X.STS + st_slot(sc, HGT, h, dir);
#pragma unroll
            for (int et = 0; et < NE; ++et) { v2u w; w.x = pkbf(acc[et][0], acc[et][1]); w.y = pkbf(acc[et][2], acc[et][3]);
                *(GAS v2u*)(sout + (size_t)(16 * et + fr) * 128 + c0 + 4 * fq) = w; }
            if (lane == 0) { float* tp = X.TOTS + ((size_t)sc * 24 + hd) * 128 + c0;
#pragma unroll
                for (int i = 0; i < 4; ++i) ((GAS f32x4*)tp)[i] = (f32x4){run[4 * i], run[4 * i + 1], run[4 * i + 2], run[4 * i + 3]}; } }
    }
    __syncthreads();
}
__device__ __forceinline__ void pass_b_super(const Ctx& X, int g, int gtid, int NT) {
    const int ns = (g == 0) ? 1 : 2, nc = NSC / ns;
    for (int v = gtid; v < ns * (ST_CHUNK / 8); v += NT) {
        const int s = v / (ST_CHUNK / 8), idx = (v % (ST_CHUNK / 8)) * 8;
        const int hd = idx < 262144 ? idx / 32768 : 8 + (idx - 262144) / 16384, db = hd & 1, d0 = idx & 127;
        float S[8];
#pragma unroll
        for (int i = 0; i < 8; ++i) S[i] = 0.f;
        for (int cc = 0; cc < nc; cc += 4) {
            v4u x[4]; f32x4 t0[4], t1[4];
#pragma unroll
            for (int u = 0; u < 4; ++u) { const int c = s * nc + (db ? nc - 1 - (cc + u) : cc + u);
                x[u] = *(const GAS v4u*)(X.STS + (size_t)c * ST_CHUNK + idx);
                const GAS f32x4* tp = (const GAS f32x4*)(X.TOTS + ((size_t)c * 24 + hd) * 128 + d0); t0[u] = tp[0]; t1[u] = tp[1]; }
#pragma unroll
            for (int u = 0; u < 4; ++u) { const int c = s * nc + (db ? nc - 1 - (cc + u) : cc + u);
                *(GAS v4u*)(X.STS + (size_t)c * ST_CHUNK + idx) = pack8(S);
                float dx[8]; unpack8(x[u], dx);
                const float dec[8] = {fexp2(t0[u].x), fexp2(t0[u].y), fexp2(t0[u].z), fexp2(t0[u].w), fexp2(t1[u].x), fexp2(t1[u].y), fexp2(t1[u].z), fexp2(t1[u].w)};
#pragma unroll
                for (int i = 0; i < 8; ++i) S[i] = dec[i] * S[i] + dx[i]; }
        }
    }
}

template <bool HGT>
__device__ __forceinline__ void pass_c_unit(const Ctx& X, int l, int chunk, int h, LAS unsigned char* lds, int tid, int lane, int wave) {
    constexpr int DV = HGT ? 128 : 256, VSTR = DV * 2 + 16, NET = DV / 128;
    const int fr = lane & 15, fq = lane >> 4, qq = fr >> 2, p4 = fr & 3;
    stage_v<DV>(X, chunk, HGT ? ZC_HI + h * 128 : ZC_GV + h * 256, lds, tid);
    f32x4 oacc[NET][4];
#pragma unroll
    for (int et = 0; et < NET; ++et)
#pragma unroll
        for (int it = 0; it < 4; ++it) oacc[et][it] = (f32x4){0.f, 0.f, 0.f, 0.f};
    for (int dir = 0; dir < 2; ++dir) {
        scan_stage<HGT, true>(X, l, chunk, h, dir, lds, lane, wave, nullptr);
        const bf16* slot = X.ST + st_slot(chunk, HGT, h, dir);
        bf16x8 sfr[NET][4];
#pragma unroll
        for (int et = 0; et < NET; ++et)
#pragma unroll
            for (int ks = 0; ks < 4; ++ks) sfr[et][ks] = *(const GAS bf16x8*)(slot + (size_t)(16 * (wave * NET + et) + fr) * 128 + 32 * ks + 8 * fq);
        __syncthreads();
        { const int I = wave & 3, par = wave >> 2;
#pragma unroll
          for (int jt = 0; jt < 2; ++jt) { const int J = par + 2 * jt;
            LAS unsigned char* pdst = lds + L_P + (16 * I + fr) * P_STR + (16 * J + 4 * fq) * 2;
            if (J > I) { *(LAS v2u*)pdst = (v2u){0u, 0u}; }
            else {
                const int rho = (J == I) ? 16 * I + 8 : 16 * I - 1, ri = 16 * I + fr, rj = 16 * J + fr;
                f32x4 sc = (f32x4){0.f, 0.f, 0.f, 0.f};
#pragma unroll
                for (int ks = 0; ks < 4; ++ks) { const int dc = 32 * ks + 8 * fq;
                    float br[8], bi[8], bj[8], qf[8], kf[8];
                    { const LAS f32x4* t = (const LAS f32x4*)(lds + L_B32 + rho * B32_STR + dc * 4); const f32x4 a = t[0], b = t[1]; br[0] = a.x; br[1] = a.y; br[2] = a.z; br[3] = a.w; br[4] = b.x; br[5] = b.y; br[6] = b.z; br[7] = b.w; }
                    { const LAS f32x4* t = (const LAS f32x4*)(lds + L_B32 + ri * B32_STR + dc * 4); const f32x4 a = t[0], b = t[1]; bi[0] = a.x; bi[1] = a.y; bi[2] = a.z; bi[3] = a.w; bi[4] = b.x; bi[5] = b.y; bi[6] = b.z; bi[7] = b.w; }
                    { const LAS f32x4* t = (const LAS f32x4*)(lds + L_B32 + rj * B32_STR + dc * 4); const f32x4 a = t[0], b = t[1]; bj[0] = a.x; bj[1] = a.y; bj[2] = a.z; bj[3] = a.w; bj[4] = b.x; bj[5] = b.y; bj[6] = b.z; bj[7] = b.w; }
                    unpack8(*(const LAS v4u*)(lds + L_QR + ri * K_STR + dc * 2), qf);
                    unpack8(*(const LAS v4u*)(lds + L_KR + rj * K_STR + dc * 2), kf);
#pragma unroll
                    for (int i = 0; i < 8; ++i) { qf[i] *= fexp2(fminf(bi[i] - br[i], 80.f)); kf[i] *= fexp2(fminf(br[i] - bj[i], 80.f)); }
                    const v4u qa = pack8(qf), ka = pack8(kf);
                    sc = __builtin_amdgcn_mfma_f32_16x16x32_bf16(__builtin_bit_cast(bf16x8, ka), __builtin_bit_cast(bf16x8, qa), sc, 0, 0, 0); }
                if (J == I) {
#pragma unroll
                    for (int t = 0; t < 4; ++t) if (4 * fq + t > fr) sc[t] = 0.f; }
                v2u w; w.x = pkbf(sc[0], sc[1]); w.y = pkbf(sc[2], sc[3]); *(LAS v2u*)pdst = w; }
          } }
        __syncthreads();
        bf16x8 vfr[NET][2];
#pragma unroll
        for (int ks = 0; ks < 2; ++ks) { const int r0 = 32 * ks + 8 * fq + qq, r1 = r0 + 4, v0 = dir ? 63 - r0 : r0, v1 = dir ? 63 - r1 : r1;
#pragma unroll
            for (int et = 0; et < NET; ++et) { const int col = (16 * (wave * NET + et) + 4 * p4) * 2;
                vfr[et][ks] = tr_pair(lds + L_V + v0 * VSTR + col, lds + L_V + v1 * VSTR + col); } }
        { bf16x8 bo[2][6];
#pragma unroll
          for (int it = 0; it <= 4; ++it) {
            if (it < 4) { const int trow = 16 * it + fr, ip = dir ? 63 - trow : trow;
#pragma unroll
                for (int ks = 0; ks < 4; ++ks) bo[it & 1][ks] = *(const LAS bf16x8*)(lds + L_QH + ip * K_STR + (32 * ks + 8 * fq) * 2);
#pragma unroll
                for (int ks = 0; ks < 2; ++ks) bo[it & 1][4 + ks] = *(const LAS bf16x8*)(lds + L_P + ip * P_STR + (32 * ks + 8 * fq) * 2); }
            if (it > 0) { const int jt = it - 1;
#pragma unroll
                for (int ks = 0; ks < 4; ++ks)
#pragma unroll
                    for (int et = 0; et < NET; ++et) oacc[et][jt] = __builtin_amdgcn_mfma_f32_16x16x32_bf16(sfr[et][ks], bo[jt & 1][ks], oacc[et][jt], 0, 0, 0);
#pragma unroll
                for (int ks = 0; ks < 2; ++ks)
#pragma unroll
                    for (int et = 0; et < NET; ++et) oacc[et][jt] = __builtin_amdgcn_mfma_f32_16x16x32_bf16(vfr[et][ks], bo[jt & 1][4 + ks], oacc[et][jt], 0, 0, 0); }
            __builtin_amdgcn_sched_group_barrier(0x100, 6, 0); __builtin_amdgcn_sched_group_barrier(0x008, 6 * NET, 0); } }
        __syncthreads();
    }
    LAS float* red = (LAS float*)(lds + L_RED);
#pragma unroll
    for (int it = 0; it < 4; ++it) { float s = 0.f;
#pragma unroll
        for (int et = 0; et < NET; ++et) { const f32x4 o = oacc[et][it]; s += (o.x * o.x + o.y * o.y) + (o.z * o.z + o.w * o.w); }
        s += __shfl_xor(s, 16); s += __shfl_xor(s, 32);
        if (fq == 0) red[wave * 64 + 16 * it + fr] = s; }
    __syncthreads();
    const float* ng = (HGT ? X.hg_g + (size_t)l * 128 : X.gla_g + (size_t)l * 256);
    const int ogcol = HGT ? ZC_HOG + h * 128 : ZC_GOG + h * 256, ocol = HGT ? 1024 + h * 128 : h * 256;
#pragma unroll
    for (int it = 0; it < 4; ++it) { float tot = 0.f;
#pragma unroll
        for (int w = 0; w < 8; ++w) tot += red[w * 64 + 16 * it + fr];
        const float rstd = 1.f / sqrtf(tot * (1.f / DV) + RMS_EPS);
        const int tok = chunk * 64 + 16 * it + fr;
#pragma unroll
        for (int et = 0; et < NET; ++et) { const int e0 = 16 * (wave * NET + et) + 4 * fq;
            const v2u ogp = *(const GAS v2u*)(X.Z + (size_t)tok * ZW + ogcol + e0);
            const float og[4] = {__uint_as_float(ogp.x << 16), __uint_as_float(ogp.x & 0xffff0000u), __uint_as_float(ogp.y << 16), __uint_as_float(ogp.y & 0xffff0000u)};
            const f32x4 g4 = *(const GAS f32x4*)(ng + e0); float r[4];
#pragma unroll
            for (int t = 0; t < 4; ++t) { const float z = fminf(fmaxf(og[t], -80.f), 80.f); r[t] = oacc[et][it][t] * rstd * g4[t] * (z / (1.f + __expf(-z))); }
            v2u w; w.x = pkbf(r[0], r[1]); w.y = pkbf(r[2], r[3]);
            *(GAS v2u*)(X.O + (size_t)tok * DM + ocol + e0) = w; } }
    __syncthreads();
}

constexpr int C2_DIR = 63488, C2_QD = 0, C2_KD = 17408, C2_QH = 34816, C2_P = 52224, C2_BT = 61440, C2_V = 126976, C2_RED = 160768;
template <bool HGT>
__device__ __forceinline__ void c2_stage(const Ctx& X, int l, int chunk, int h, int dir, LAS unsigned char* ld, int lane, int wave) {
    const int r = lane, tok = chunk * 64 + (dir ? 63 - r : r), c0 = 16 * wave;
    const bf16* zrow = X.Z + (size_t)tok * ZW;
    float bc[16], kr[16], qv[16];
    if (!HGT) {
        const GAS f32x4* bg = (const GAS f32x4*)(X.BG + (size_t)tok * 1024 + dir * 512 + h * 128 + c0);
#pragma unroll
        for (int i = 0; i < 4; ++i) { const f32x4 t = bg[i]; bc[4 * i] = t.x; bc[4 * i + 1] = t.y; bc[4 * i + 2] = t.z; bc[4 * i + 3] = t.w; }
        const GAS v4u* kp = (const GAS v4u*)(zrow + ZC_GK + h * 128 + c0); unpack8(kp[0], kr); unpack8(kp[1], kr + 8);
        const GAS v4u* qp = (const GAS v4u*)(zrow + ZC_GQ + h * 128 + c0); unpack8(qp[0], qv); unpack8(qp[1], qv + 8);
#pragma unroll
        for (int i = 0; i < 16; ++i) qv[i] *= 0.08838834764831845f;
    } else {
        float zf[16];
        const GAS v4u* zp = (const GAS v4u*)(zrow + (dir ? ZC_HFB : ZC_HFF) + h * 128 + c0); unpack8(zp[0], zf); unpack8(zp[1], zf + 8);
        const GAS v4u* qp = (const GAS v4u*)(zrow + ZC_HQ + h * 128 + c0); unpack8(qp[0], qv); unpack8(qp[1], qv + 8);
        const float* lp = X.lowb + (size_t)dir * 2 * 1024 + h * 128 + c0;
#pragma unroll
        for (int i = 0; i < 16; ++i) {
            const float lb = (l == 0) ? 0.f : 1.f / (1.f + __expf(lp[i] - lp[1024 + i]));
            const float z = fminf(fmaxf(zf[i], -80.f), 80.f), e = __expf(-z), sig = 1.f / (1.f + e);
            const float f = lb + (1.f - lb) * sig;
            kr[i] = (1.f - lb) * e * sig;
            bc[i] = wave_scan_incl(flog2(f), lane); }
    }
    float qd[16], kd[16], qh[16];
#pragma unroll
    for (int i = 0; i < 16; ++i) {
        const float beta = __builtin_bit_cast(float, __builtin_amdgcn_update_dpp(0, __builtin_bit_cast(int, bc[i]), 0x142, 0xe, 0xf, false));
        qd[i] = qv[i] * fexp2(bc[i] - beta); kd[i] = kr[i] * fexp2(fminf(beta - bc[i], 80.f)); qh[i] = qv[i] * fexp2(bc[i]); }
    LAS unsigned char* p = ld + r * K_STR + c0 * 2;
    ((LAS v4u*)(p + C2_QD))[0] = pack8(qd); ((LAS v4u*)(p + C2_QD))[1] = pack8(qd + 8);
    ((LAS v4u*)(p + C2_KD))[0] = pack8(kd); ((LAS v4u*)(p + C2_KD))[1] = pack8(kd + 8);
    ((LAS v4u*)(p + C2_QH))[0] = pack8(qh); ((LAS v4u*)(p + C2_QH))[1] = pack8(qh + 8);
    if ((lane & 15) == 15) { LAS f32x4* bt = (LAS f32x4*)(ld + C2_BT + (((lane >> 4) + 1) & 3) * 512 + c0 * 4);
        const bool z = lane == 63;
#pragma unroll
        for (int i = 0; i < 4; ++i) bt[i] = z ? (f32x4){0.f, 0.f, 0.f, 0.f} : (f32x4){bc[4 * i], bc[4 * i + 1], bc[4 * i + 2], bc[4 * i + 3]}; }
}
template <bool HGT>
__device__ __forceinline__ void pass_c2_unit(const Ctx& X, int l, int chunk, int h, LAS unsigned char* lds, int tid, int lane, int wave) {
    constexpr int DV = HGT ? 128 : 256, VSTR = DV * 2 + 16, NET = DV / 128, PPR = DV / 8;
    const int fr = lane & 15, fq = lane >> 4, qq = fr >> 2, p4 = fr & 3;
    { const int vcol = HGT ? ZC_HI + h * 128 : ZC_GV + h * 256;
#pragma unroll
      for (int k = 0; k < 64 * PPR / 512; ++k) { const int idx = tid + 512 * k, row = idx / PPR, pc = idx % PPR;
        const v4u v = *(const GAS v4u*)(X.Z + (size_t)(chunk * 64 + row) * ZW + vcol + pc * 8);
        *(LAS v4u*)(lds + C2_V + row * VSTR + pc * 16) = v; } }
    c2_stage<HGT>(X, l, chunk, h, 0, lds, lane, wave);
    c2_stage<HGT>(X, l, chunk, h, 1, lds + C2_DIR, lane, wave);
    bf16x8 sfr[2][NET][4];
#pragma unroll
    for (int dir = 0; dir < 2; ++dir) { const bf16* slot = X.ST + st_slot(chunk, HGT, h, dir);
#pragma unroll
        for (int et = 0; et < NET; ++et)
#pragma unroll
            for (int ks = 0; ks < 4; ++ks) sfr[dir][et][ks] = *(const GAS bf16x8*)(slot + (size_t)(16 * (wave * NET + et) + fr) * 128 + 32 * ks + 8 * fq); }
    __syncthreads();
    { const int a = wave & 3; LAS unsigned char* ld = lds + (wave >> 2) * C2_DIR;
      const unsigned lst = (a == 0) ? 0xff002010u : (a == 1) ? 0xff113021u : (a == 2) ? 0xffff2231u : 0xffff3332u;
      const unsigned zls = (a == 0) ? 0xffff0201u : (a == 1) ? 0xffff1203u : (a == 2) ? 0xffffff13u : 0xffffff23u;
      for (int t = 0; t < 3; ++t) { const unsigned code = (lst >> (8 * t)) & 0xffu; if (code == 0xffu) break;
          const int I = (int)(code >> 4), J = (int)(code & 15u);
          f32x4 sc = (f32x4){0.f, 0.f, 0.f, 0.f};
#pragma unroll
          for (int ks = 0; ks < 4; ++ks) { const int dc = 32 * ks + 8 * fq;
              v4u ka = *(const LAS v4u*)(ld + C2_KD + (16 * J + fr) * K_STR + dc * 2);
              const bf16x8 qb = *(const LAS bf16x8*)(ld + C2_QD + (16 * I + fr) * K_STR + dc * 2);
              if (J < I) { const LAS f32x4* bi = (const LAS f32x4*)(ld + C2_BT + I * 512 + dc * 4); const LAS f32x4* bj = (const LAS f32x4*)(ld + C2_BT + J * 512 + dc * 4);
                  const f32x4 d0 = bi[0] - bj[0], d1 = bi[1] - bj[1]; float kf[8]; unpack8(ka, kf);
                  kf[0] *= fexp2(d0.x); kf[1] *= fexp2(d0.y); kf[2] *= fexp2(d0.z); kf[3] *= fexp2(d0.w); kf[4] *= fexp2(d1.x); kf[5] *= fexp2(d1.y); kf[6] *= fexp2(d1.z); kf[7] *= fexp2(d1.w);
                  ka = pack8(kf); }
              sc = __builtin_amdgcn_mfma_f32_16x16x32_bf16(__builtin_bit_cast(bf16x8, ka), qb, sc, 0, 0, 0); }
          if (J == I) {
#pragma unroll
              for (int u = 0; u < 4; ++u) if (4 * fq + u > fr) sc[u] = 0.f; }
          v2u w; w.x = pkbf(sc[0], sc[1]); w.y = pkbf(sc[2], sc[3]);
          *(LAS v2u*)(ld + C2_P + (16 * I + fr) * P_STR + (16 * J + 4 * fq) * 2) = w; }
      for (int t = 0; t < 2; ++t) { const unsigned code = (zls >> (8 * t)) & 0xffu; if (code == 0xffu) break;
          const int I = (int)(code >> 4), J = (int)(code & 15u);
          *(LAS v2u*)(ld + C2_P + (16 * I + fr) * P_STR + (16 * J + 4 * fq) * 2) = (v2u){0u, 0u}; } }
    __syncthreads();
    f32x4 oacc[NET][4];
#pragma unroll
    for (int et = 0; et < NET; ++et)
#pragma unroll
        for (int it = 0; it < 4; ++it) oacc[et][it] = (f32x4){0.f, 0.f, 0.f, 0.f};
#pragma unroll
    for (int dir = 0; dir < 2; ++dir) { LAS const unsigned char* ld = lds + dir * C2_DIR;
        bf16x8 vfr[NET][2];
#pragma unroll
        for (int ks = 0; ks < 2; ++ks) { const int r0 = 32 * ks + 8 * fq + qq, r1 = r0 + 4, v0 = dir ? 63 - r0 : r0, v1 = dir ? 63 - r1 : r1;
#pragma unroll
            for (int et = 0; et < NET; ++et) { const int col = (16 * (wave * NET + et) + 4 * p4) * 2;
                vfr[et][ks] = tr_pair(lds + C2_V + v0 * VSTR + col, lds + C2_V + v1 * VSTR + col); } }
#pragma unroll
        for (int it = 0; it < 4; ++it) { const int trow = 16 * it + fr, ip = dir ? 63 - trow : trow;
            bf16x8 bo[6];
#pragma unroll
            for (int ks = 0; ks < 4; ++ks) bo[ks] = *(const LAS bf16x8*)(ld + C2_QH + ip * K_STR + (32 * ks + 8 * fq) * 2);
#pragma unroll
            for (int ks = 0; ks < 2; ++ks) bo[4 + ks] = *(const LAS bf16x8*)(ld + C2_P + ip * P_STR + (32 * ks + 8 * fq) * 2);
#pragma unroll
            for (int ks = 0; ks < 4; ++ks)
#pragma unroll
                for (int et = 0; et < NET; ++et) oacc[et][it] = __builtin_amdgcn_mfma_f32_16x16x32_bf16(sfr[dir][et][ks], bo[ks], oacc[et][it], 0, 0, 0);
#pragma unroll
            for (int ks = 0; ks < 2; ++ks)
#pragma unroll
                for (int et = 0; et < NET; ++et) oacc[et][it] = __builtin_amdgcn_mfma_f32_16x16x32_bf16(vfr[et][ks], bo[4 + ks], oacc[et][it], 0, 0, 0); } }
    LAS float* red = (LAS float*)(lds + C2_RED);
#pragma unroll
    for (int it = 0; it < 4; ++it) { float sq = 0.f;
#pragma unroll
        for (int et = 0; et < NET; ++et) { const f32x4 o = oacc[et][it]; sq += (o.x * o.x + o.y * o.y) + (o.z * o.z + o.w * o.w); }
        sq += __shfl_xor(sq, 16); sq += __shfl_xor(sq, 32);
        if (fq == 0) red[wave * 64 + 16 * it + fr] = sq; }
    __syncthreads();
    const float* ng = (HGT ? X.hg_g + (size_t)l * 128 : X.gla_g + (size_t)l * 256);
    const int ogcol = HGT ? ZC_HOG + h * 128 : ZC_GOG + h * 256, ocol = HGT ? 1024 + h * 128 : h * 256;
#pragma unroll
    for (int it = 0; it < 4; ++it) { float tot = 0.f;
#pragma unroll
        for (int w = 0; w < 8; ++w) tot += red[w * 64 + 16 * it + fr];
        const float rstd = 1.f / sqrtf(tot * (1.f / DV) + RMS_EPS);
        const int tok = chunk * 64 + 16 * it + fr;
#pragma unroll
        for (int et = 0; et < NET; ++et) { const int e0 = 16 * (wave * NET + et) + 4 * fq;
            const v2u ogp = *(const GAS v2u*)(X.Z + (size_t)tok * ZW + ogcol + e0);
            const float og[4] = {__uint_as_float(ogp.x << 16), __uint_as_float(ogp.x & 0xffff0000u), __uint_as_float(ogp.y << 16), __uint_as_float(ogp.y & 0xffff0000u)};
            const f32x4 g4 = *(const GAS f32x4*)(ng + e0); float rr[4];
#pragma unroll
            for (int u = 0; u < 4; ++u) { const float z = fminf(fmaxf(og[u], -80.f), 80.f); rr[u] = oacc[et][it][u] * rstd * g4[u] * (z / (1.f + __expf(-z))); }
            v2u w; w.x = pkbf(rr[0], rr[1]); w.y = pkbf(rr[2], rr[3]);
            *(GAS v2u*)(X.O + (size_t)tok * DM + ocol + e0) = w; } }
}

struct Args { const float* in[15]; float* out; unsigned char* ws; int mode, pad; };
#define PHASE_IDS() int tid = threadIdx.x; asm volatile("" : "+v"(tid)); const int lane = tid & 63, wave = __builtin_amdgcn_readfirstlane(tid >> 6); \
    const int gw = bx * NWAVES + wave, NGW = G * NWAVES, gtid = bx * (NWAVES * 64) + tid, NT = G * NWAVES * 64; (void)lane; (void)wave; (void)gw; (void)NGW; (void)gtid; (void)NT
__device__ __forceinline__ Ctx make_ctx(const Args& args) {
    Ctx X; unsigned char* ws = args.ws;
    X.x_prompt = args.in[0]; X.x_sample = args.in[1]; X.w_in = args.in[2]; X.w_lr2 = args.in[3]; X.b_lr = args.in[4]; X.gla_g = args.in[5]; X.hg_g = args.in[6]; X.lowb = args.in[7];
    X.w_out = args.in[8]; X.ln1_g = args.in[9]; X.ln1_b = args.in[10]; X.w_up = args.in[11]; X.w_down = args.in[12]; X.ln2_g = args.in[13]; X.ln2_b = args.in[14]; X.out = args.out;
    X.Win_t = (bf16*)(ws + WS_WIN); X.Wout_t = (bf16*)(ws + WS_WOUT); X.Wup_t = (bf16*)(ws + WS_WUP); X.Wdn_t = (bf16*)(ws + WS_WDN); X.Wglr_t = (bf16*)(ws + WS_WGLR);
    X.HB = (bf16*)(ws + WS_HB); X.Z = (bf16*)(ws + WS_Z); X.O = (bf16*)(ws + WS_O); X.ST = (bf16*)(ws + WS_ST);
    X.BG = (float*)(ws + WS_BG); X.MF = (bf16*)(ws + WS_ST); X.TOT = (float*)(ws + WS_TOT); X.TOTS = (float*)(ws + WS_TOTS); X.STS = (bf16*)(ws + WS_STS);
    return X;
}
__global__ void __launch_bounds__(NWAVES * 64, 2) fwd_kernel(Args args) {
    extern __shared__ __attribute__((aligned(16))) unsigned char lds_raw[];
    LAS unsigned char* lds = (LAS unsigned char*)lds_raw;
    const int G = gridDim.x, bx = blockIdx.x;
    volatile LAS unsigned* MISC = (volatile LAS unsigned*)(lds + MISC_OFF);
    if (threadIdx.x < 32) MISC[threadIdx.x] = 0u;
    __syncthreads();
    XcdBarrier bar = xcd_barrier_post((unsigned*)(args.ws + WS_CTL) + CW_BAR, MISC + 8);

    { PHASE_IDS(); const Ctx X = make_ctx(args); prologue_weights(X, lds, gw, NGW, wave, lane); }
    for (int g = 0; g < NGRP; ++g) {
        { PHASE_IDS(); const Ctx X = make_ctx(args); cvt_group((g == 0) ? X.x_prompt : X.x_sample + (size_t)(g - 1) * GM * DM, X.HB, gtid, NT); }
        xcd_barrier(bar);
        for (int l = 0; l < NLAYER; ++l) {
            { PHASE_IDS(); const Ctx X = make_ctx(args); for (int c = bx; c < NCHUNK; c += G) gate_unit(X, l, c, lds, tid, lane, wave); }
            { const Ctx X = make_ctx(args); pg8::Gemm gm{X.HB, X.Win_t + (size_t)l * ZW * DM, GM, ZW, DM}; pg8::StaticOrder S; S.init(GM, ZW, G, bx);
              pg8::EpiBf16<0> E{X.Z, ZW};
              pg8::gemm_phase<pg8::EpiBf16<0>, pg8::StaticOrder, false, true>(lds, gm, S, E); }
            xcd_barrier(bar);
            {
            { PHASE_IDS(); const Ctx X = make_ctx(args);
              for (int u = bx; u < NSC * 12; u += G) { const int sc = u / 12, hh = u % 12;
                if (hh < 4) pass_s_unit<false, false>(X, l, sc, hh, lds, tid, lane, wave); else pass_s_unit<true, false>(X, l, sc, hh - 4, lds, tid, lane, wave); } }
            xcd_barrier(bar);
            { PHASE_IDS(); const Ctx X = make_ctx(args); pass_b_super(X, g, gtid, NT); }
            xcd_barrier(bar);
            { PHASE_IDS(); const Ctx X = make_ctx(args);
              for (int u = bx; u < NSC * 12; u += G) { const int sc = u / 12, hh = u % 12;
                if (hh < 4) pass_s_unit<false, true>(X, l, sc, hh, lds, tid, lane, wave); else pass_s_unit<true, true>(X, l, sc, hh - 4, lds, tid, lane, wave); } }
            xcd_barrier(bar);
            { PHASE_IDS(); const Ctx X = make_ctx(args);
              for (int u = bx; u < NCHUNK * 12; u += G) { const int c = u / 12, hh = u % 12;
                if (hh < 4) pass_c2_unit<false>(X, l, c, hh, lds, tid, lane, wave); else pass_c2_unit<true>(X, l, c, hh - 4, lds, tid, lane, wave); } }
            xcd_barrier(bar);
            }
            { const Ctx X = make_ctx(args); pg8::Gemm gm{X.O, X.Wout_t + (size_t)l * DM * DM, GM, DM, DM}; pg8::StaticOrder S; S.init(GM, DM, G, bx);
              pg8::EpiBf16<0> E{X.MF, DM};
              pg8::gemm_phase<pg8::EpiBf16<0>, pg8::StaticOrder, false, true>(lds, gm, S, E); }
            xcd_barrier(bar);
            { PHASE_IDS(); const Ctx X = make_ctx(args);
              if (l == 0) ln_phase<true, false>((g == 0) ? X.x_prompt : X.x_sample + (size_t)(g - 1) * GM * DM, X.MF, X.ln1_g, X.ln1_b, nullptr, X.HB, gw, NGW, lane);
              else ln_phase<false, false>(X.HB, X.MF, X.ln1_g + (size_t)l * DM, X.ln1_b + (size_t)l * DM, nullptr, X.HB, gw, NGW, lane); }
            xcd_barrier(bar);
            { const Ctx X = make_ctx(args); pg8::Gemm gm{X.HB, X.Wup_t + (size_t)l * DFF * DM, GM, DFF, DM}; pg8::StaticOrder S; S.init(GM, DFF, G, bx);
              pg8::EpiBf16<1> E{X.Z, DFF};
              pg8::gemm_phase<pg8::EpiBf16<1>, pg8::StaticOrder, false, true>(lds, gm, S, E); }
            xcd_barrier(bar);
            { const Ctx X = make_ctx(args); pg8::Gemm gm{X.Z, X.Wdn_t + (size_t)l * DM * DFF, GM, DM, DFF}; pg8::StaticOrder S; S.init(GM, DM, G, bx);
              pg8::EpiBf16<0> E{X.MF, DM};
              pg8::gemm_phase<pg8::EpiBf16<0>, pg8::StaticOrder, false, true>(lds, gm, S, E); }
            xcd_barrier(bar);
            { PHASE_IDS(); const Ctx X = make_ctx(args);
              if (l == NLAYER - 1) ln_phase<false, true>(X.HB, X.MF, X.ln2_g + (size_t)l * DM, X.ln2_b + (size_t)l * DM, X.out + (size_t)g * GM * DM, nullptr, gw, NGW, lane);
              else ln_phase<false, false>(X.HB, X.MF, X.ln2_g + (size_t)l * DM, X.ln2_b + (size_t)l * DM, nullptr, X.HB, gw, NGW, lane); }
            xcd_barrier(bar);
        }
    }
}

extern "C" void kernel_launch(void* const* d_in, const int* in_sizes, int n_in, void* d_out, int out_size, void* d_ws, size_t ws_size, hipStream_t stream) {
    static int grid = 0;
    if (grid == 0) {
        if (n_in != 15 || out_size != NTOK * DM || ws_size < WS_END) { fprintf(stderr, "kernel_launch: unexpected shapes (n_in %d, out %d, ws %zu)\n", n_in, out_size, ws_size); grid = -1; return; }
        int dev = 0, cus = 0;
        if (hipGetDevice(&dev) != hipSuccess || hipDeviceGetAttribute(&cus, hipDeviceAttributeMultiprocessorCount, dev) != hipSuccess) { grid = -1; return; }
        if (hipFuncSetAttribute((const void*)fwd_kernel, hipFuncAttributeMaxDynamicSharedMemorySize, LDS_BYTES) != hipSuccess) { fprintf(stderr, "kernel_launch: hipFuncSetAttribute failed\n"); grid = -1; return; }
        int per_cu = 0;
        if (hipOccupancyMaxActiveBlocksPerMultiprocessor(&per_cu, (const void*)fwd_kernel, NWAVES * 64, LDS_BYTES) != hipSuccess || per_cu < 1) { fprintf(stderr, "kernel_launch: occupancy query says %d\n", per_cu); }
        (void)hipGetLastError();
        grid = cus;
    }
    if (grid < 0) return;
    if (hipMemsetAsync((char*)d_ws + WS_CTL, 0, CTL_ZERO_BYTES, stream) != hipSuccess) return;
    Args a{};
    for (int i = 0; i < 15; ++i) a.in[i] = (const float*)d_in[i];
    a.out = (float*)d_out; a.ws = (unsigned char*)d_ws; a.mode = KMODE; a.pad = 0;
    hipLaunchKernelGGL(fwd_kernel, dim3(grid), dim3(NWAVES * 64), LDS_BYTES, stream, a);
}
```

```cpp
#include <hip/hip_runtime.h>
#include <cstdio>
#include <cstdint>
#ifndef KMODE
#define KMODE 0
#endif
namespace pg8 {
#define PG8_LAS __attribute__((address_space(3)))
typedef unsigned short bf16_t;
typedef short bf16x8 __attribute__((ext_vector_type(8)));
typedef float f32x4 __attribute__((ext_vector_type(4)));
typedef unsigned u32x4 __attribute__((ext_vector_type(4)));
constexpr int BM = 256, BK = 64, HALF = 128, HTB = HALF * BK * 2  , STAGE_BYTES = 8 * HTB, NXCD = 8, WGM = 8;

__host__ __device__ __forceinline__ int lds_byte(int r, int c) { const int st = (r >> 4) * 2 + (c >> 5), rr = r & 15, cc = c & 31, ob = rr * 64 + cc * 2; return st * 1024 + (ob ^ (((ob >> 9) & 1) << 5)); }
__host__ __device__ __forceinline__ void stage_rc(int b, int& R, int& C) { const int st = b / 1024, sb = b % 1024, swz = sb ^ (((sb >> 9) & 1) << 5); R = (st >> 1) * 16 + swz / 64; C = (st & 1) * 32 + (swz % 64) / 2; }
__host__ __device__ __forceinline__ int perm32(int rho) { const int n = rho >> 4, i = rho & 15; return 8 * (i >> 2) + 4 * n + (i & 3); }

struct Unit { int pm, pn; };
struct Gemm { const bf16_t* A; const bf16_t* Bt; int M, N, K; };

struct StaticOrder {
    int nM, nN, nwg, G, c;
    __host__ __device__ void init(int M, int N, int G_, int c_) { nM = M / BM; nN = N / BM; nwg = nM * nN; G = G_; c = c_; }
    __host__ __device__ bool next(int i, Unit& u) const {
        const long L = (long)i * G + c; if (L >= nwg) return false;
        int wgid = (int)L; { const int q = nwg / NXCD, r = nwg % NXCD, xcd = wgid % NXCD, off = wgid / NXCD; wgid = (xcd < r ? xcd * (q + 1) : r * (q + 1) + (xcd - r) * q) + off; }
        const int nig = WGM * nN, gid = wgid / nig, fm = gid * WGM, gsz = (nM - fm) < WGM ? (nM - fm) : WGM;
        u.pm = fm + ((wgid % nig) % gsz); u.pn = (wgid % nig) / gsz; return true;
    }
    __device__ __forceinline__ void a_ready(const Unit&) const {}
    __device__ __forceinline__ void done(const Unit&) const {}
};


__device__ __forceinline__ unsigned cvt_pk_bf16(float lo, float hi) { unsigned r; asm volatile("v_cvt_pk_bf16_f32 %0, %1, %2" : "=v"(r) : "v"(lo), "v"(hi)); return r; }

template <int ACT  > struct EpiBf16 {
    static constexpr bool PERM = true, AFTER_DRAIN = false;
    bf16_t* O; int ldc;
    __device__ __forceinline__ void operator()(const f32x4 (&acc)[2][2][4][2], const Unit& u, int wr, int wc, int fr, int fq) const {
        const int row0 = u.pm * BM + wr * 64 + fr; const int col0 = u.pn * BM + wc * 32 + 8 * fq;
#pragma unroll
        for (int ai = 0; ai < 2; ++ai)
#pragma unroll
            for (int m = 0; m < 4; ++m) { bf16_t* rowp = O + (size_t)(row0 + ai * HALF + m * 16) * ldc + col0;
#pragma unroll
                for (int bj = 0; bj < 2; ++bj) { f32x4 v0 = acc[ai][bj][m][0], v1 = acc[ai][bj][m][1];
                    if (ACT == 1) {
#pragma unroll
                        for (int j = 0; j < 4; ++j) { const float a = fmaxf(v0[j], 0.f), b = fmaxf(v1[j], 0.f); v0[j] = a * a; v1[j] = b * b; } }
                    u32x4 w; w.x = cvt_pk_bf16(v0[0], v0[1]); w.y = cvt_pk_bf16(v0[2], v0[3]); w.z = cvt_pk_bf16(v1[0], v1[1]); w.w = cvt_pk_bf16(v1[2], v1[3]);
                    *(u32x4*)(rowp + bj * HALF) = w; } }
    }
};
struct EpiF32 {
    static constexpr bool PERM = false, AFTER_DRAIN = false;
    float* C; int ldc;
    __device__ __forceinline__ void operator()(const f32x4 (&acc)[2][2][4][2], const Unit& u, int wr, int wc, int fr, int fq) const {
        const int row0 = u.pm * BM + wr * 64 + fr, col0 = u.pn * BM + wc * 32 + 4 * fq;
#pragma unroll
        for (int ai = 0; ai < 2; ++ai)
#pragma unroll
            for (int m = 0; m < 4; ++m) { float* rowp = C + (size_t)(row0 + ai * HALF + m * 16) * ldc + col0;
#pragma unroll
                for (int bj = 0; bj < 2; ++bj)
#pragma unroll
                    for (int n = 0; n < 2; ++n) *(f32x4*)(rowp + bj * HALF + n * 16) = acc[ai][bj][m][n]; }
    }
};

struct EpiZ {
    static constexpr bool PERM = true, AFTER_DRAIN = false;
    bf16_t* Z;
    __device__ __forceinline__ void operator()(const f32x4 (&acc)[2][2][4][2], const Unit& u, int wr, int wc, int fr, int fq) const {
        const int pn = u.pn; const size_t Mr = 16384;
        bool blocked; int H = 4, c0; bf16_t* base;
        if (pn < 2) { blocked = true; H = 4; base = Z + Mr * 4096; c0 = pn * 256; }
        else if (pn < 4) { blocked = true; H = 4; base = Z + Mr * 4096 + Mr * 512; c0 = (pn - 2) * 256; }
        else if (pn < 8) { blocked = false; base = Z; c0 = (pn - 4) * 256; }
        else if (pn < 12) { blocked = false; base = Z; c0 = 1024 + (pn - 8) * 256; }
        else if (pn < 24) { blocked = true; H = 8; base = Z + Mr * 4096 + Mr * 1024 + (size_t)((pn - 12) >> 2) * Mr * 1024; c0 = ((pn - 12) & 3) * 256; }
        else if (pn < 28) { blocked = false; base = Z; c0 = 2048 + (pn - 24) * 256; }
        else { blocked = false; base = Z; c0 = 3072 + (pn - 28) * 256; }
        const int row0 = u.pm * BM + wr * 64 + fr, cl = c0 + wc * 32 + 8 * fq;
#pragma unroll
        for (int ai = 0; ai < 2; ++ai)
#pragma unroll
            for (int m = 0; m < 4; ++m) { const int row = row0 + ai * HALF + m * 16;
#pragma unroll
                for (int bj = 0; bj < 2; ++bj) { const f32x4 v0 = acc[ai][bj][m][0], v1 = acc[ai][bj][m][1]; const int c = cl + bj * HALF;
                    u32x4 w; w.x = cvt_pk_bf16(v0[0], v0[1]); w.y = cvt_pk_bf16(v0[2], v0[3]); w.z = cvt_pk_bf16(v1[0], v1[1]); w.w = cvt_pk_bf16(v1[2], v1[3]);
                    bf16_t* p = blocked ? base + ((size_t)((((row >> 6) * H + (c >> 7)) * 8 + ((c >> 4) & 7)) * 64 + (row & 63))) * 16 + (c & 15)
                                        : base + (size_t)row * 4096 + c;
                    *(u32x4*)p = w; } }
    }
};

template <class Epi, class Sched, bool ALIGN_EPI = false, bool SP2 = false>
__device__ __forceinline__ void gemm_phase(PG8_LAS unsigned char* lds, const Gemm g, const Sched& S, const Epi& E) {
    int tid_o = threadIdx.x; asm volatile("" : "+v"(tid_o));
    const int tid = tid_o, wid = __builtin_amdgcn_readfirstlane(tid >> 6), lane = tid & 63, wr = wid >> 2, wc = wid & 3, fr = lane & 15, fq = lane >> 4;
    const int K = g.K, nt = K / BK;
    unsigned voffA[2], voffB[2];
#pragma unroll
    for (int i = 0; i < 2; ++i) { int R, C; stage_rc(tid * 16 + i * 8192, R, C); const int Rb = Epi::PERM ? ((R & ~31) + perm32(R & 31)) : R;
        voffA[i] = (unsigned)(R * K + C) * 2u; voffB[i] = (unsigned)(Rb * K + C) * 2u; }
    const size_t kstep = (size_t)(BK * 2);
    const size_t hstep = (size_t)HALF * K * 2;
    const size_t tstep = 2 * hstep;
    const unsigned ldsw = (unsigned)wid * 1024u;
    const int aoff = lds_byte(wr * 64 + fr, fq * 8), boff = lds_byte(wc * 32 + fr, fq * 8);
#define PG8_SA(b, h) (((b) * 2 + (h)) * HTB)
#define PG8_SB(b, h) ((4 + (b) * 2 + (h)) * HTB)
#define PG8_STAGE(bufoff, gbase, voff) do { _Pragma("unroll") for (int _i = 0; _i < 2; ++_i) \
        __builtin_amdgcn_global_load_lds((const unsigned*)((const char*)(gbase) + (voff)[_i]), (PG8_LAS unsigned*)(lds + (bufoff) + ldsw + _i * 8192), 16, 0, 0); } while (0)
#define PG8_LDA(dst, b, h) do { _Pragma("unroll") for (int m = 0; m < 4; ++m) _Pragma("unroll") for (int k = 0; k < 2; ++k) dst[m][k] = *(const PG8_LAS bf16x8*)(lds + PG8_SA(b, h) + aoff + m * 2048 + k * 1024); } while (0)
#define PG8_LDB(dst, b, h) do { _Pragma("unroll") for (int n = 0; n < 2; ++n) _Pragma("unroll") for (int k = 0; k < 2; ++k) dst[n][k] = *(const PG8_LAS bf16x8*)(lds + PG8_SB(b, h) + boff + n * 2048 + k * 1024); } while (0)
#define PG8_MMA(ai, bj, At, Bt) do { __builtin_amdgcn_s_setprio(1); _Pragma("unroll") for (int m = 0; m < 4; ++m) _Pragma("unroll") for (int n = 0; n < 2; ++n) _Pragma("unroll") for (int k = 0; k < 2; ++k) \
        acc[ai][bj][m][n] = __builtin_amdgcn_mfma_f32_16x16x32_bf16(Bt[n][k], At[m][k], acc[ai][bj][m][n], 0, 0, 0); __builtin_amdgcn_s_setprio(0); } while (0)
#define PG8_WAIT_V(n) asm volatile("s_waitcnt vmcnt(" #n ")" ::: "memory")
#define PG8_WAIT_L(n) asm volatile("s_waitcnt lgkmcnt(" #n ")" ::: "memory")
#define PG8_BAR __builtin_amdgcn_s_barrier()
#define PG8_SCHED __builtin_amdgcn_sched_barrier(0)
    Unit cur, nxt; int ui = 0;
    if (!S.next(0, cur)) return;
    f32x4 acc[2][2][4][2];
#pragma unroll
    for (int a = 0; a < 2; ++a)
#pragma unroll
        for (int b = 0; b < 2; ++b)
#pragma unroll
            for (int m = 0; m < 4; ++m)
#pragma unroll
                for (int n = 0; n < 2; ++n) acc[a][b][m][n] = (f32x4){0.f, 0.f, 0.f, 0.f};
    bf16x8 At[4][2], B0[2][2], B1[2][2];
    const char* cA = (const char*)g.A + (size_t)cur.pm * tstep; const char* cB = (const char*)g.Bt + (size_t)cur.pn * tstep;
    S.a_ready(cur);
    if constexpr (SP2) {
        PG8_STAGE(PG8_SB(0, 0), cB, voffB); PG8_STAGE(PG8_SB(0, 1), cB + hstep, voffB); PG8_STAGE(PG8_SA(0, 0), cA, voffA); PG8_STAGE(PG8_SA(0, 1), cA + hstep, voffA);
        if (wr == 1) PG8_BAR;
        PG8_WAIT_V(2); PG8_BAR;
        PG8_STAGE(PG8_SB(1, 0), cB + kstep, voffB); PG8_STAGE(PG8_SA(1, 0), cA + kstep, voffA); PG8_STAGE(PG8_SB(1, 1), cB + hstep + kstep, voffB);
        PG8_WAIT_V(6); PG8_BAR;
    } else {
        PG8_STAGE(PG8_SB(0, 0), cB, voffB); PG8_STAGE(PG8_SA(0, 0), cA, voffA); PG8_STAGE(PG8_SB(0, 1), cB + hstep, voffB); PG8_STAGE(PG8_SA(0, 1), cA + hstep, voffA);
        if (wr == 1) PG8_BAR;
        PG8_WAIT_V(4); PG8_BAR;
        PG8_STAGE(PG8_SB(1, 0), cB + kstep, voffB); PG8_STAGE(PG8_SA(1, 0), cA + kstep, voffA); PG8_STAGE(PG8_SB(1, 1), cB + hstep + kstep, voffB);
        PG8_WAIT_V(6); PG8_BAR;
    }
    for (;;) {
        const bool has_next = S.next(ui + 1, nxt);
        const char* nA = has_next ? (const char*)g.A + (size_t)nxt.pm * tstep : cA; const char* nB = has_next ? (const char*)g.Bt + (size_t)nxt.pn * tstep : cB;
        for (int t = 0; t < nt; t += 2) {
            const bool last = (t == nt - 2);
            const char* a1 = cA + (size_t)(t + 1) * kstep;
            const char* a2 = last ? nA : cA + (size_t)(t + 2) * kstep; const char* b2 = last ? nB : cB + (size_t)(t + 2) * kstep;
            const char* a3 = a2 + kstep; const char* b3 = b2 + kstep;
            if (last && has_next) S.a_ready(nxt);
            if constexpr (SP2) {
            PG8_LDB(B0, 0, 0); PG8_LDB(B1, 0, 1); PG8_SCHED; PG8_LDA(At, 0, 0); PG8_STAGE(PG8_SA(1, 1), a1 + hstep, voffA);
            PG8_WAIT_V(8); PG8_WAIT_L(0); PG8_BAR; PG8_MMA(0, 0, At, B0); PG8_MMA(0, 1, At, B1); PG8_BAR; PG8_SCHED;
            PG8_LDA(At, 0, 1); PG8_STAGE(PG8_SB(0, 0), b2, voffB); PG8_STAGE(PG8_SB(0, 1), b2 + hstep, voffB); PG8_STAGE(PG8_SA(0, 0), a2, voffA);
            PG8_WAIT_V(8); PG8_WAIT_L(0); PG8_BAR; PG8_MMA(1, 0, At, B0); PG8_MMA(1, 1, At, B1); PG8_BAR; PG8_SCHED;
            PG8_LDB(B0, 1, 0); PG8_LDB(B1, 1, 1); PG8_SCHED; PG8_LDA(At, 1, 0); PG8_STAGE(PG8_SA(0, 1), a2 + hstep, voffA);
            PG8_WAIT_V(8); PG8_WAIT_L(0); PG8_BAR; PG8_MMA(0, 0, At, B0); PG8_MMA(0, 1, At, B1); PG8_BAR; PG8_SCHED;
            PG8_LDA(At, 1, 1); PG8_STAGE(PG8_SB(1, 0), b3, voffB); PG8_STAGE(PG8_SB(1, 1), b3 + hstep, voffB); PG8_STAGE(PG8_SA(1, 0), a3, voffA);
            PG8_WAIT_V(8); PG8_WAIT_L(0); PG8_BAR; PG8_MMA(1, 0, At, B0); PG8_MMA(1, 1, At, B1); PG8_BAR; PG8_SCHED;
            } else {
            PG8_LDB(B0, 0, 0); PG8_SCHED; PG8_LDA(At, 0, 0); PG8_STAGE(PG8_SA(1, 1), a1 + hstep, voffA);
            PG8_WAIT_L(8); PG8_BAR; PG8_WAIT_L(0); PG8_MMA(0, 0, At, B0); PG8_BAR; PG8_SCHED;
            PG8_LDB(B1, 0, 1); PG8_STAGE(PG8_SB(0, 0), b2, voffB);
            PG8_BAR; PG8_WAIT_L(0); PG8_MMA(0, 1, At, B1); PG8_BAR;
            PG8_LDA(At, 0, 1); PG8_STAGE(PG8_SA(0, 0), a2, voffA);
            PG8_BAR; PG8_WAIT_L(0); PG8_MMA(1, 0, At, B0); PG8_BAR; PG8_SCHED;
            PG8_STAGE(PG8_SB(0, 1), b2 + hstep, voffB);
            PG8_WAIT_V(6); PG8_BAR; PG8_MMA(1, 1, At, B1); PG8_BAR;
            PG8_LDB(B0, 1, 0); PG8_SCHED; PG8_LDA(At, 1, 0); PG8_STAGE(PG8_SA(0, 1), a2 + hstep, voffA);
            PG8_WAIT_L(8); PG8_BAR; PG8_WAIT_L(0); PG8_MMA(0, 0, At, B0); PG8_BAR; PG8_SCHED;
            PG8_LDB(B1, 1, 1); PG8_STAGE(PG8_SB(1, 0), b3, voffB);
            PG8_BAR; PG8_WAIT_L(0); PG8_MMA(0, 1, At, B1); PG8_BAR;
            PG8_LDA(At, 1, 1); PG8_STAGE(PG8_SA(1, 0), a3, voffA);
            PG8_BAR; PG8_WAIT_L(0); PG8_MMA(1, 0, At, B0); PG8_BAR; PG8_SCHED;
            PG8_STAGE(PG8_SB(1, 1), b3 + hstep, voffB);
            PG8_WAIT_V(6); PG8_BAR; PG8_MMA(1, 1, At, B1); PG8_BAR;
            }
        }
        if constexpr (ALIGN_EPI) { if (wr == 0) PG8_BAR; }
        if constexpr (!Epi::AFTER_DRAIN) { E(acc, cur, wr, wc, fr, fq); S.done(cur); }
        if (!has_next) break;
#pragma unroll
        for (int a = 0; a < 2; ++a)
#pragma unroll
            for (int b = 0; b < 2; ++b)
#pragma unroll
                for (int m = 0; m < 4; ++m)
#pragma unroll
                    for (int n = 0; n < 2; ++n) acc[a][b][m][n] = (f32x4){0.f, 0.f, 0.f, 0.f};
        cur = nxt; cA = nA; cB = nB; ++ui;
        if constexpr (ALIGN_EPI) { if (wr == 1) PG8_BAR; }
    }
    PG8_WAIT_V(0);
    if constexpr (!ALIGN_EPI) { if (wr == 0) PG8_BAR; }
    PG8_BAR;
    if constexpr (Epi::AFTER_DRAIN) { E.fused(acc, cur, wr, wc, fr, fq, lds, wid, lane); S.done(cur); }
#undef PG8_SA
#undef PG8_SB
#undef PG8_STAGE
#undef PG8_LDA
#undef PG8_LDB
#undef PG8_MMA
#undef PG8_WAIT_V
#undef PG8_WAIT_L
#undef PG8_BAR
#undef PG8_SCHED
}
}

constexpr int NWAVES = 8;
constexpr int DM = 2048, DFF = 8192, NTOK = 49152, GM = 16384, NGRP = 3, NLAYER = 2, INW = 8224, ZW = 8192;
constexpr int ZC_GQ = 0, ZC_GK = 512, ZC_GV = 1024, ZC_GOG = 2048, ZC_HQ = 3072, ZC_HFF = 4096, ZC_HFB = 5120, ZC_HI = 6144, ZC_HOG = 7168;
constexpr float LN_EPS = 1e-5f, RMS_EPS = 1e-6f, ALPHA = 1.41421356237f, LOG2E = 1.44269504089f;
constexpr int NCHUNK = GM / 64;
constexpr int ST_CHUNK = 524288;
constexpr size_t MiB = 1u << 20;
constexpr size_t WS_CTL = 0, CTL_ZERO_BYTES = 1 * MiB;
constexpr size_t WS_WIN = 2 * MiB, WS_WOUT = 66 * MiB, WS_WUP = 82 * MiB, WS_WDN = 146 * MiB, WS_WGLR = 210 * MiB;
constexpr size_t WS_HB = 212 * MiB;
constexpr size_t WS_Z = 276 * MiB;
constexpr size_t WS_BG = 532 * MiB;
constexpr size_t WS_O = 596 * MiB;
constexpr size_t WS_ST = 660 * MiB;
constexpr size_t WS_TOT = 916 * MiB;
constexpr size_t WS_STS = 920 * MiB;
constexpr size_t WS_TOTS = 984 * MiB;
constexpr size_t WS_END = 985 * MiB;
constexpr int CW_BAR = 4096;
constexpr int RING_BYTES = 131072;
constexpr int LDS_BYTES = 160 * 1024, MISC_OFF = LDS_BYTES - 256;
constexpr int L_B32 = 0, L_KR = 33792, L_QR = 51200, L_QH = 68608, L_V = 86016, L_P = 119808, L_RED = 129024;
constexpr int B32_STR = 528, K_STR = 272, P_STR = 144, KT_STR = 144;
constexpr int NSC = GM / 256;
constexpr int SV_KT = 135168, KTW_BYTES = 2560;

#define GAS __attribute__((address_space(1)))
#define LAS __attribute__((address_space(3)))
typedef unsigned short bf16;
typedef unsigned v4u __attribute__((ext_vector_type(4)));
typedef float f32x4 __attribute__((ext_vector_type(4)));
typedef short bf16x8 __attribute__((ext_vector_type(8)));
typedef GAS unsigned gu32;
typedef GAS unsigned long long gu64;
#define RLX_AGENT __ATOMIC_RELAXED, __HIP_MEMORY_SCOPE_AGENT
#define LDS_WAIT() asm volatile("s_waitcnt lgkmcnt(0)" ::: "memory")
#define VM_WAIT() asm volatile("s_waitcnt vmcnt(0)" ::: "memory")
__device__ __forceinline__ unsigned long long rt() { return __builtin_amdgcn_s_memrealtime(); }
__device__ __forceinline__ unsigned f2bf(float f) { unsigned u = __builtin_bit_cast(unsigned, f); return (u + 0x7fffu + ((u >> 16) & 1u)) >> 16; }
__device__ __forceinline__ unsigned pk2(float lo, float hi) { return f2bf(lo) | (f2bf(hi) << 16); }

#define XB_TMO      128
#define XB_XCNT(j)  (256  + 64 * (j))
#define XB_XSUB(j)  (1280 + 64 * (j))
#define XB_XGEN(j)  (2304 + 64 * (j))
#define XB_TOP      3328
#define XB_TOPGEN   3392
#define XCD_BAR_WORDS 3456
#define XB_SPIN_CAP (1u << 18)

__device__ __forceinline__ unsigned xb_ld(unsigned* p)              { return __hip_atomic_load(p, __ATOMIC_RELAXED, __HIP_MEMORY_SCOPE_AGENT); }
__device__ __forceinline__ unsigned xb_add(unsigned* p, unsigned v) { return __hip_atomic_fetch_add(p, v, __ATOMIC_RELAXED, __HIP_MEMORY_SCOPE_AGENT); }
__device__ __forceinline__ unsigned xb_xcc_id() { return (unsigned)__builtin_amdgcn_s_getreg((3 << 11) | 20) & 0xFu; }
#define XB_SPIN(cond, bar) do { unsigned _sp = 0; while (cond) { __builtin_amdgcn_s_sleep(1); \
    if ((++_sp & 255u) == 0u) { if (xb_ld(&(bar)[XB_TMO])) break; if (_sp > XB_SPIN_CAP) { atomicAdd(&(bar)[XB_TMO], 1u); break; } } } } while (0)

struct XcdBarrier {
    unsigned* bar; unsigned x;
    volatile LAS unsigned* st;
};

__device__ __forceinline__ XcdBarrier xcd_barrier_post(unsigned* bar, volatile LAS unsigned* st) {
    XcdBarrier b; b.bar = bar; b.x = xb_xcc_id(); b.st = st;
    if (threadIdx.x == 0) (void)xb_add(&bar[XB_XCNT(b.x)], 1u);
    return b;
}
__device__ __forceinline__ void xcd_barrier_complete(unsigned* bar, unsigned x, unsigned& nloc, unsigned& nx) {
    const unsigned G = gridDim.x * gridDim.y * gridDim.z;
    unsigned sum, cnt, mine, sp = 0u;
    for (;;) {
        sum = 0u; cnt = 0u; mine = 0u;
#pragma unroll
        for (unsigned j = 0; j < 16; ++j) { const unsigned c = xb_ld(&bar[XB_XCNT(j)]); sum += c; cnt += (c > 0u) ? 1u : 0u; mine = (j == x) ? c : mine; }
        if (sum == G) break;
        __builtin_amdgcn_s_sleep(1);
        if ((++sp & 255u) == 0u) { if (xb_ld(&bar[XB_TMO])) break; if (sp > XB_SPIN_CAP) { atomicAdd(&bar[XB_TMO], 1u); break; } }
    }
    nloc = mine > 0u ? mine : 1u; nx = cnt > 0u ? cnt : 1u;
}

__device__ __forceinline__ void xcd_barrier(const XcdBarrier& b) {
    asm volatile("s_waitcnt vmcnt(0)" ::: "memory");
    __syncthreads();
    if (threadIdx.x == 0) {
        unsigned* bar = b.bar;
        __builtin_amdgcn_s_waitcnt(0);
        unsigned nloc = b.st[0], nx = b.st[1];
        if (nloc == 0u) { xcd_barrier_complete(bar, b.x, nloc, nx); b.st[0] = nloc; b.st[1] = nx; }
        const unsigned old = xb_add(&bar[XB_XSUB(b.x)], 1u);
        const unsigned gen = old / nloc;
        if (old + 1u == (gen + 1u) * nloc) {
            __builtin_amdgcn_fence(__ATOMIC_RELEASE, "agent");
            asm volatile("s_waitcnt vmcnt(0)" ::: "memory");
            const unsigned og = xb_add(&bar[XB_TOP], 1u);
            const unsigned tg = og / nx;
            if (og + 1u == (tg + 1u) * nx) xb_add(&bar[XB_TOPGEN], 1u);
            else XB_SPIN(xb_ld(&bar[XB_TOPGEN]) == tg, bar);
            __builtin_amdgcn_fence(__ATOMIC_ACQUIRE, "agent");
            xb_add(&bar[XB_XGEN(b.x)], 1u);
            asm volatile("s_waitcnt vmcnt(0)" ::: "memory");
        } else {
            XB_SPIN(xb_ld(&bar[XB_XGEN(b.x)]) == gen, bar);
            __builtin_amdgcn_fence(__ATOMIC_ACQUIRE, "agent");
            asm volatile("s_waitcnt vmcnt(0)" ::: "memory");
        }
    }
    __syncthreads();
}

typedef short s16x4 __attribute__((ext_vector_type(4)));
typedef float f32x2 __attribute__((ext_vector_type(2)));
typedef unsigned v2u __attribute__((ext_vector_type(2)));
__device__ __forceinline__ unsigned pkbf(float lo, float hi) { return pg8::cvt_pk_bf16(lo, hi); }
__device__ __forceinline__ float wave_sum(float v) {
#pragma unroll
    for (int o = 1; o < 64; o <<= 1) v += __shfl_xor(v, o);
    return v;
}
template <int CTRL, int RM> __device__ __forceinline__ float dpp_add(float v) {
    return v + __builtin_bit_cast(float, __builtin_amdgcn_update_dpp(0, __builtin_bit_cast(int, v), CTRL, RM, 0xf, true));
}
__device__ __forceinline__ float wave_scan_incl(float v, int) {
    v = dpp_add<0x111, 0xf>(v); v = dpp_add<0x112, 0xf>(v); v = dpp_add<0x114, 0xf>(v); v = dpp_add<0x118, 0xf>(v);
    v = dpp_add<0x142, 0xa>(v); v = dpp_add<0x143, 0xc>(v); return v;
}
template <int CTRL, int RM> __device__ __forceinline__ void dpp_add16(float* v) {
#pragma unroll
    for (int i = 0; i < 16; ++i) v[i] = dpp_add<CTRL, RM>(v[i]);
}
__device__ __forceinline__ void wave_scan16(float* v) {
    dpp_add16<0x111, 0xf>(v); dpp_add16<0x112, 0xf>(v); dpp_add16<0x114, 0xf>(v); dpp_add16<0x118, 0xf>(v); dpp_add16<0x142, 0xa>(v); dpp_add16<0x143, 0xc>(v);
}
__device__ __forceinline__ void unpack8(const v4u v, float* f) {
    f[0] = __uint_as_float(v.x << 16); f[1] = __uint_as_float(v.x & 0xffff0000u); f[2] = __uint_as_float(v.y << 16); f[3] = __uint_as_float(v.y & 0xffff0000u);
    f[4] = __uint_as_float(v.z << 16); f[5] = __uint_as_float(v.z & 0xffff0000u); f[6] = __uint_as_float(v.w << 16); f[7] = __uint_as_float(v.w & 0xffff0000u);
}
__device__ __forceinline__ v4u pack8(const float* f) { v4u o; o.x = pkbf(f[0], f[1]); o.y = pkbf(f[2], f[3]); o.z = pkbf(f[4], f[5]); o.w = pkbf(f[6], f[7]); return o; }
__device__ __forceinline__ s16x4 lds_tr(LAS const unsigned char* p) { return __builtin_bit_cast(s16x4, __builtin_amdgcn_ds_read_tr16_b64_v4i16((LAS s16x4*)p)); }
__device__ __forceinline__ bf16x8 tr_pair(LAS const unsigned char* p0, LAS const unsigned char* p1) {
    const s16x4 a = lds_tr(p0), b = lds_tr(p1); return __builtin_shufflevector(a, b, 0, 1, 2, 3, 4, 5, 6, 7);
}
__device__ __forceinline__ float fexp2(float x) { return __builtin_amdgcn_exp2f(x); }
__device__ __forceinline__ float flog2(float x) { return __builtin_amdgcn_logf(x); }

constexpr size_t ZB_GQ = (size_t)GM * 4096, ZB_GK = ZB_GQ + (size_t)GM * 512, ZB_HQ = ZB_GK + (size_t)GM * 512, ZB_HFF = ZB_HQ + (size_t)GM * 1024, ZB_HFB = ZB_HFF + (size_t)GM * 1024;
constexpr int ZRW = 4096, ZR_GV = 0, ZR_GOG = 1024, ZR_HI = 2048, ZR_HOG = 3072;
__device__ __forceinline__ size_t blk_off(int chunk, int H, int hh, int w) { return (size_t)((chunk * H + hh) * 8 + w) * 1024; }
struct Ctx {
    const float *x_prompt, *x_sample, *w_in, *w_lr2, *b_lr, *gla_g, *hg_g, *lowb, *w_out, *ln1_g, *ln1_b, *w_up, *w_down, *ln2_g, *ln2_b;
    float* out;
    bf16 *Win_t, *Wout_t, *Wup_t, *Wdn_t, *Wglr_t, *HB, *Z, *O, *ST;
    float *BG, *TOT, *TOTS; bf16 *STS, *MF;
};

__device__ __forceinline__ void transpose_item(const float* W, int N, int kb, int nb, bf16* dst, int K, LAS float* scr, int lane) {
    const int k0 = 64 * kb, n0 = 32 * nb;
#pragma unroll 8
    for (int i = 0; i < 32; ++i) { const int kk = 2 * i + (lane >> 5); scr[kk * 33 + (lane & 31)] = W[(size_t)(k0 + kk) * N + n0 + (lane & 31)]; }
    LDS_WAIT(); asm volatile("" ::: "memory");
    const int c = lane & 7;
#pragma unroll
    for (int j = 0; j < 4; ++j) { const int n = (lane >> 3) + 8 * j; const LAS float* s = scr + (8 * c) * 33 + n;
        v4u o; o.x = pkbf(s[0 * 33], s[1 * 33]); o.y = pkbf(s[2 * 33], s[3 * 33]); o.z = pkbf(s[4 * 33], s[5 * 33]); o.w = pkbf(s[6 * 33], s[7 * 33]);
        *(GAS v4u*)(dst + (size_t)n * K + k0 + 8 * c) = o; }
    LDS_WAIT(); asm volatile("" ::: "memory");
}
__device__ __forceinline__ void prologue_weights(const Ctx& X, LAS unsigned char* lds, int gw, int NGW, int wave, int lane) {
    LAS float* scr = (LAS float*)(lds + wave * 16384);
    constexpr int I_IN = 32 * 257, I_OUT = 32 * 64, I_UP = 32 * 256, I_DN = 128 * 64, I_L = I_IN + I_OUT + I_UP + I_DN;
    for (int it = gw; it < NLAYER * I_L; it += NGW) {
        const int l = it / I_L; int r = it % I_L;
        if (r < I_IN) { const int kb = r / 257, nb = r % 257;
            bf16* dst = (nb < 96) ? X.Win_t + ((size_t)l * ZW + 32 * nb) * DM : (nb == 96) ? X.Wglr_t + (size_t)l * 32 * DM : X.Win_t + ((size_t)l * ZW + 32 * (nb - 1)) * DM;
            transpose_item(X.w_in + (size_t)l * DM * INW, INW, kb, nb, dst, DM, scr, lane); continue; }
        r -= I_IN;
        if (r < I_OUT) { const int kb = r / 64, nb = r % 64; transpose_item(X.w_out + (size_t)l * DM * DM, DM, kb, nb, X.Wout_t + ((size_t)l * DM + 32 * nb) * DM, DM, scr, lane); continue; }
        r -= I_OUT;
        if (r < I_UP) { const int kb = r / 256, nb = r % 256; transpose_item(X.w_up + (size_t)l * DM * DFF, DFF, kb, nb, X.Wup_t + ((size_t)l * DFF + 32 * nb) * DM, DM, scr, lane); continue; }
        r -= I_UP;
        { const int kb = r / 64, nb = r % 64; transpose_item(X.w_down + (size_t)l * DFF * DM, DM, kb, nb, X.Wdn_t + ((size_t)l * DM + 32 * nb) * DFF, DFF, scr, lane); }
    }
}
__device__ __forceinline__ void cvt_group(const float* xg, bf16* HB, int gtid, int NT) {
    for (int i = gtid; i < GM * DM / 8; i += NT) {
        const f32x4 a = ((const GAS f32x4*)xg)[2 * i], b = ((const GAS f32x4*)xg)[2 * i + 1];
        v4u o; o.x = pkbf(a.x, a.y); o.y = pkbf(a.z, a.w); o.z = pkbf(b.x, b.y); o.w = pkbf(b.z, b.w);
        ((GAS v4u*)HB)[i] = o; }
}
template <bool RES_F32, bool OUT_F32>
__device__ __forceinline__ void ln_phase(const void* res, const bf16* mf, const float* gam, const float* bet, float* H, bf16* HB, int gw, int NGW, int lane) {
    for (int m = gw; m < GM; m += NGW) {
        f32x4 v[8]; float s = 0.f;
        const GAS v2u* mr = (const GAS v2u*)(mf + (size_t)m * DM) + lane;
#pragma unroll
        for (int j = 0; j < 8; ++j) { f32x4 r;
            if (RES_F32) r = ((const GAS f32x4*)((const float*)res + (size_t)m * DM) + lane)[64 * j];
            else { const v2u w = ((const GAS v2u*)((const bf16*)res + (size_t)m * DM) + lane)[64 * j];
                r = (f32x4){__uint_as_float(w.x << 16), __uint_as_float(w.x & 0xffff0000u), __uint_as_float(w.y << 16), __uint_as_float(w.y & 0xffff0000u)}; }
            const v2u w = mr[64 * j];
            const f32x4 f = (f32x4){__uint_as_float(w.x << 16), __uint_as_float(w.x & 0xffff0000u), __uint_as_float(w.y << 16), __uint_as_float(w.y & 0xffff0000u)};
            v[j] = r * ALPHA + f; s += (v[j].x + v[j].y) + (v[j].z + v[j].w); }
        const float mean = wave_sum(s) * (1.f / DM); float s2 = 0.f;
#pragma unroll
        for (int j = 0; j < 8; ++j) { v[j] = v[j] - mean; s2 += (v[j].x * v[j].x + v[j].y * v[j].y) + (v[j].z * v[j].z + v[j].w * v[j].w); }
        const float rstd = 1.f / sqrtf(wave_sum(s2) * (1.f / DM) + LN_EPS);
#pragma unroll
        for (int j = 0; j < 8; ++j) { const f32x4 g4 = ((const GAS f32x4*)gam)[lane + 64 * j], b4 = ((const GAS f32x4*)bet)[lane + 64 * j];
            const f32x4 o = v[j] * rstd * g4 + b4;
            if (OUT_F32) ((GAS f32x4*)(H + (size_t)m * DM) + lane)[64 * j] = o;
            else { v2u w; w.x = pkbf(o.x, o.y); w.y = pkbf(o.z, o.w); ((GAS v2u*)(HB + (size_t)m * DM) + lane)[64 * j] = w; } }
    }
}

__device__ __forceinline__ void gate_unit(const Ctx& X, int l, int chunk, LAS unsigned char* lds, int tid, int lane, int wave) {
    const int fr = lane & 15, fq = lane >> 4;
    const bf16* A = X.HB + (size_t)chunk * 64 * DM; const bf16* Bw = X.Wglr_t + (size_t)l * 32 * DM;
    f32x4 acc[4][2];
#pragma unroll
    for (int m = 0; m < 4; ++m)
#pragma unroll
        for (int n = 0; n < 2; ++n) acc[m][n] = (f32x4){0.f, 0.f, 0.f, 0.f};
#pragma unroll 2
    for (int ks = 0; ks < 8; ++ks) { const int k0 = 256 * wave + 32 * ks + 8 * fq;
        bf16x8 a[4], b[2];
#pragma unroll
        for (int m = 0; m < 4; ++m) a[m] = *(const GAS bf16x8*)(A + (size_t)(16 * m + fr) * DM + k0);
#pragma unroll
        for (int n = 0; n < 2; ++n) b[n] = *(const GAS bf16x8*)(Bw + (size_t)(16 * n + fr) * DM + k0);
#pragma unroll
        for (int m = 0; m < 4; ++m)
#pragma unroll
            for (int n = 0; n < 2; ++n) acc[m][n] = __builtin_amdgcn_mfma_f32_16x16x32_bf16(a[m], b[n], acc[m][n], 0, 0, 0); }
    LAS float* part = (LAS float*)lds;
#pragma unroll
    for (int m = 0; m < 4; ++m)
#pragma unroll
        for (int n = 0; n < 2; ++n)
#pragma unroll
            for (int j = 0; j < 4; ++j) part[(wave * 64 + 16 * m + 4 * fq + j) * 33 + 16 * n + fr] = acc[m][n][j];
    __syncthreads();
    LAS float* glr = (LAS float*)(lds + 8 * 64 * 33 * 4);
#pragma unroll
    for (int k = 0; k < 4; ++k) { const int idx = tid + 512 * k, t = idx >> 5, n = idx & 31; float s = 0.f;
#pragma unroll
        for (int w = 0; w < 8; ++w) s += part[(w * 64 + t) * 33 + n];
        glr[t * 36 + n] = s; }
    __syncthreads();
    const int dir = wave >> 2;
    const float* w2 = X.w_lr2 + (size_t)(l * 2 + dir) * 16 * 512; const float* bl = X.b_lr + (size_t)(l * 2 + dir) * 512;
    for (int cb = 0; cb < 2; ++cb) { const int c = 128 * (wave & 3) + 64 * cb + lane;
        float w[16];
#pragma unroll
        for (int r = 0; r < 16; ++r) w[r] = w2[r * 512 + c];
        const float bias = bl[c]; float run = 0.f;
        float* bgcol = X.BG + ((size_t)(((chunk * 4 + (c >> 7)) * 8 + ((c & 127) >> 4)) * 2 + dir) * 64) * 16 + (c & 15);
#pragma unroll 4
        for (int tt = 0; tt < 64; ++tt) { const int t = dir ? 63 - tt : tt;
            const LAS f32x4* gr = (const LAS f32x4*)(glr + t * 36 + dir * 16); const f32x4 g0 = gr[0], g1 = gr[1], g2 = gr[2], g3 = gr[3];
            float pre = bias;
            pre += g0.x * w[0] + g0.y * w[1] + g0.z * w[2] + g0.w * w[3]; pre += g1.x * w[4] + g1.y * w[5] + g1.z * w[6] + g1.w * w[7];
            pre += g2.x * w[8] + g2.y * w[9] + g2.z * w[10] + g2.w * w[11]; pre += g3.x * w[12] + g3.y * w[13] + g3.z * w[14] + g3.w * w[15];
            run += (fminf(pre, 0.f) - __logf(1.f + __expf(-fabsf(pre)))) * (LOG2E / 16.f);
            bgcol[(size_t)t * 16] = run; } }
    __syncthreads();
}

__device__ __forceinline__ size_t st_slot(int chunk, bool hgt, int h, int dir) { return (size_t)chunk * ST_CHUNK + (hgt ? 262144 + (h * 2 + dir) * 16384 : (h * 2 + dir) * 32768); }

template <bool HGT> struct RawIn { f32x4 b[4]; v4u k[2]; };
template <> struct RawIn<true> { v4u k[2]; };
template <bool HGT>
__device__ __forceinline__ RawIn<HGT> pass_s_load(const Ctx& X, int chunk, int h, int dir, int lane, int c0) {
    RawIn<HGT> r; const int rt = dir ? 63 - lane : lane, w = c0 >> 4;
    if constexpr (!HGT) { const GAS f32x4* bg = (const GAS f32x4*)(X.BG + ((size_t)(((chunk * 4 + h) * 8 + w) * 2 + dir) * 64 + rt) * 16);
#pragma unroll
        for (int i = 0; i < 4; ++i) r.b[i] = bg[i];
        const GAS v4u* kp = (const GAS v4u*)(X.Z + ZB_GK + blk_off(chunk, 4, h, w) + rt * 16); r.k[0] = kp[0]; r.k[1] = kp[1];
    } else { const GAS v4u* zp = (const GAS v4u*)(X.Z + (dir ? ZB_HFB : ZB_HFF) + blk_off(chunk, 8, h, w) + rt * 16); r.k[0] = zp[0]; r.k[1] = zp[1]; }
    return r;
}
template <bool HGT, bool STORE>
__device__ __forceinline__ void pass_s_unit(const Ctx& X, int l, int sc, int h, LAS unsigned char* lds, int tid, int lane, int wave) {
    constexpr int DV = HGT ? 128 : 256, VSTR = DV * 2 + 16, NE = DV / 16, PPR = DV / 8;
    const int fr = lane & 15, fq = lane >> 4, qq = fr >> 2, p4 = fr & 3, c0 = 16 * wave;
    RawIn<HGT> cur = pass_s_load<HGT>(X, sc * 4, h, 0, lane, c0);
    { const int vcol = HGT ? ZR_HI + h * 128 : ZR_GV + h * 256;
#pragma unroll 4
      for (int k = 0; k < 256 * PPR / 512; ++k) { const int idx = tid + 512 * k, row = idx / PPR, pc = idx % PPR;
        const v4u v = *(const GAS v4u*)(X.Z + (size_t)(sc * 256 + row) * ZRW + vcol + pc * 8);
        *(LAS v4u*)(lds + row * VSTR + pc * 16) = v; } }
    __syncthreads();
    LAS unsigned char* kt = lds + SV_KT + wave * KTW_BYTES;
    for (int dir = 0; dir < 2; ++dir) {
        const int hd = HGT ? 8 + h * 2 + dir : h * 2 + dir;
        float lbv[16];
        if (HGT) {
#pragma unroll
            for (int i = 0; i < 16; ++i) lbv[i] = 0.f;
            if (l != 0) { const float* lp = X.lowb + (size_t)dir * 2 * 1024 + h * 128 + c0;
#pragma unroll
                for (int i = 0; i < 16; ++i) lbv[i] = 1.f / (1.f + __expf(lp[i] - lp[1024 + i])); } }
        f32x4 acc[NE];
        if (STORE) { const bf16* sin = X.STS + st_slot(sc, HGT, h, dir);
#pragma unroll
            for (int et = 0; et < NE; ++et) { const v2u w = *(const GAS v2u*)(sin + (size_t)(16 * et + fr) * 128 + c0 + 4 * fq);
                acc[et] = (f32x4){__uint_as_float(w.x << 16), __uint_as_float(w.x & 0xffff0000u), __uint_as_float(w.y << 16), __uint_as_float(w.y & 0xffff0000u)}; }
        } else {
#pragma unroll
            for (int et = 0; et < NE; ++et) acc[et] = (f32x4){0.f, 0.f, 0.f, 0.f}; }
        float run[16];
#pragma unroll
        for (int i = 0; i < 16; ++i) run[i] = 0.f;
        for (int cc = 0; cc < 4; ++cc) { const int ci = dir ? 3 - cc : cc, chunk = sc * 4 + ci;
            RawIn<HGT> nxt = cur;
            if (cc < 3) nxt = pass_s_load<HGT>(X, sc * 4 + (dir ? 2 - cc : cc + 1), h, dir, lane, c0);
            else if (dir == 0) nxt = pass_s_load<HGT>(X, sc * 4 + 3, h, 1, lane, c0);
            float bc[16], kr[16];
            if constexpr (!HGT) {
#pragma unroll
                for (int i = 0; i < 4; ++i) { bc[4 * i] = cur.b[i].x; bc[4 * i + 1] = cur.b[i].y; bc[4 * i + 2] = cur.b[i].z; bc[4 * i + 3] = cur.b[i].w; }
                unpack8(cur.k[0], kr); unpack8(cur.k[1], kr + 8);
            } else {
                float zf[16]; unpack8(cur.k[0], zf); unpack8(cur.k[1], zf + 8);
#pragma unroll
                for (int i = 0; i < 16; ++i) {
                    const float z = fmaxf(zf[i], -80.f), e = __expf(-z), sig = 1.f / (1.f + e), oml = 1.f - lbv[i];
                    kr[i] = oml * e * sig;
                    bc[i] = flog2(lbv[i] + oml * sig); }
                wave_scan16(bc);
            }
            if (STORE) { bf16* slot = X.ST + st_slot(chunk, HGT, h, dir);
#pragma unroll
                for (int et = 0; et < NE; ++et) { v2u w; w.x = pkbf(acc[et][0], acc[et][1]); w.y = pkbf(acc[et][2], acc[et][3]);
                    *(GAS v2u*)(slot + (size_t)((et * 4 + (wave >> 1)) * 64 + fr + 16 * (2 * (wave & 1) + (fq >> 1))) * 8 + 4 * (fq & 1)) = w; }
                if (cc == 3) { cur = nxt; break; } }
            float kh[16];
#pragma unroll
            for (int i = 0; i < 16; ++i) { const float bl = __shfl(bc[i], 63); kh[i] = kr[i] * fexp2(bl - bc[i]); run[i] += bl; }
            { const v4u k0 = pack8(kh), k1 = pack8(kh + 8); const unsigned kw[8] = {k0.x, k0.y, k0.z, k0.w, k1.x, k1.y, k1.z, k1.w};
#pragma unroll
              for (int i = 0; i < 16; ++i) *(LAS unsigned short*)(kt + i * KT_STR + lane * 2) = (unsigned short)((i & 1) ? (kw[i >> 1] >> 16) : (kw[i >> 1] & 0xffffu)); }
            if (lane == 63) {
#pragma unroll
                for (int i = 0; i < 4; ++i) ((LAS f32x4*)(kt + 2304))[i] = (f32x4){bc[4 * i], bc[4 * i + 1], bc[4 * i + 2], bc[4 * i + 3]}; }
            asm volatile("s_waitcnt lgkmcnt(0)" ::: "memory");
            const f32x4 dl = *(const LAS f32x4*)(kt + 2304 + 16 * fq);
            const f32x4 dec = (f32x4){fexp2(dl.x), fexp2(dl.y), fexp2(dl.z), fexp2(dl.w)};
            bf16x8 afr[2];
#pragma unroll
            for (int ks = 0; ks < 2; ++ks) afr[ks] = *(const LAS bf16x8*)(kt + fr * KT_STR + (32 * ks + 8 * fq) * 2);
#pragma unroll
            for (int et = 0; et < NE; ++et) acc[et] = acc[et] * dec;
            { constexpr int NB = 2 * NE / 4;
              LAS const unsigned char* vb[2][2];
#pragma unroll
              for (int ks = 0; ks < 2; ++ks) { const int r0 = 32 * ks + 8 * fq + qq, r1 = r0 + 4;
                  vb[ks][0] = lds + (ci * 64 + (dir ? 63 - r0 : r0)) * VSTR + 8 * p4; vb[ks][1] = lds + (ci * 64 + (dir ? 63 - r1 : r1)) * VSTR + 8 * p4; }
              bf16x8 bb[2][4];
#pragma unroll
              for (int j = 0; j < 4; ++j) bb[0][j] = tr_pair(vb[0][0] + 32 * j, vb[0][1] + 32 * j);
#pragma unroll
              for (int b = 0; b < NB; ++b) {
                  if (b + 1 < NB) { const int ks1 = (b + 1) / (NE / 4), e1 = 4 * ((b + 1) % (NE / 4));
#pragma unroll
                      for (int j = 0; j < 4; ++j) bb[(b + 1) & 1][j] = tr_pair(vb[ks1][0] + 32 * (e1 + j), vb[ks1][1] + 32 * (e1 + j)); }
                  const int ks0 = b / (NE / 4), e0 = 4 * (b % (NE / 4));
#pragma unroll
                  for (int j = 0; j < 4; ++j) acc[e0 + j] = __builtin_amdgcn_mfma_f32_16x16x32_bf16(afr[ks0], bb[b & 1][j], acc[e0 + j], 0, 0, 0);
                  __builtin_amdgcn_sched_group_barrier(0x100, 8, 0); __builtin_amdgcn_sched_group_barrier(0x008, 4, 0); } }
            asm volatile("s_waitcnt lgkmcnt(0)" ::: "memory");
            cur = nxt;
        }
        if (!STORE) { bf16* sout = X.STS + st_slot(sc, HGT, h, dir);
#pragma unroll
            for (int et = 0; et < NE; ++et) { v2u w; w.x = pkbf(acc[et][0], acc[et][1]); w.y = pkbf(acc[et][2], acc[et][3]);
                *(GAS v2u*)(sout + (size_t)(16 * et + fr) * 128 + c0 + 4 * fq) = w; }
            if (lane == 0) { float* tp = X.TOTS + ((size_t)sc * 24 + hd) * 128 + c0;
#pragma unroll
                for (int i = 0; i < 4; ++i) ((GAS f32x4*)tp)[i] = (f32x4){run[4 * i], run[4 * i + 1], run[4 * i + 2], run[4 * i + 3]}; } }
    }
    __syncthreads();
}
__device__ __forceinline__ void pass_b_super(const Ctx& X, int g, int gtid, int NT) {
    const int ns = (g == 0) ? 1 : 2, nc = NSC / ns;
    for (int v = gtid; v < ns * (ST_CHUNK / 8); v += NT) {
        const int s = v / (ST_CHUNK / 8), idx = (v % (ST_CHUNK / 8)) * 8;
        const int hd = idx < 262144 ? idx / 32768 : 8 + (idx - 262144) / 16384, db = hd & 1, d0 = idx & 127;
        float S[8];
#pragma unroll
        for (int i = 0; i < 8; ++i) S[i] = 0.f;
        for (int cc = 0; cc < nc; cc += 4) {
            v4u x[4]; f32x4 t0[4], t1[4];
#pragma unroll
            for (int u = 0; u < 4; ++u) { const int c = s * nc + (db ? nc - 1 - (cc + u) : cc + u);
                x[u] = *(const GAS v4u*)(X.STS + (size_t)c * ST_CHUNK + idx);
                const GAS f32x4* tp = (const GAS f32x4*)(X.TOTS + ((size_t)c * 24 + hd) * 128 + d0); t0[u] = tp[0]; t1[u] = tp[1]; }
#pragma unroll
            for (int u = 0; u < 4; ++u) { const int c = s * nc + (db ? nc - 1 - (cc + u) : cc + u);
                *(GAS v4u*)(X.STS + (size_t)c * ST_CHUNK + idx) = pack8(S);
                float dx[8]; unpack8(x[u], dx);
                const float dec[8] = {fexp2(t0[u].x), fexp2(t0[u].y), fexp2(t0[u].z), fexp2(t0[u].w), fexp2(t1[u].x), fexp2(t1[u].y), fexp2(t1[u].z), fexp2(t1[u].w)};
#pragma unroll
                for (int i = 0; i < 8; ++i) S[i] = dec[i] * S[i] + dx[i]; }
        }
    }
}

constexpr int C2_DIR = 63488, C2_QD = 0, C2_KD = 17408, C2_QH = 34816, C2_P = 52224, C2_BT = 61440, C2_V = 126976, C2_RED = 160768;
template <bool HGT>
__device__ __forceinline__ void c2_stage(const Ctx& X, int l, int chunk, int h, int dir, LAS unsigned char* ld, int lane, int wave) {
    const int r = lane, rt = dir ? 63 - r : r, c0 = 16 * wave;
    float bc[16], kr[16], qv[16];
    if (!HGT) {
        const GAS f32x4* bg = (const GAS f32x4*)(X.BG + ((size_t)(((chunk * 4 + h) * 8 + wave) * 2 + dir) * 64 + rt) * 16);
#pragma unroll
        for (int i = 0; i < 4; ++i) { const f32x4 t = bg[i]; bc[4 * i] = t.x; bc[4 * i + 1] = t.y; bc[4 * i + 2] = t.z; bc[4 * i + 3] = t.w; }
        const GAS v4u* kp = (const GAS v4u*)(X.Z + ZB_GK + blk_off(chunk, 4, h, wave) + rt * 16); unpack8(kp[0], kr); unpack8(kp[1], kr + 8);
        const GAS v4u* qp = (const GAS v4u*)(X.Z + ZB_GQ + blk_off(chunk, 4, h, wave) + rt * 16); unpack8(qp[0], qv); unpack8(qp[1], qv + 8);
#pragma unroll
        for (int i = 0; i < 16; ++i) qv[i] *= 0.08838834764831845f;
    } else {
        float zf[16];
        const GAS v4u* zp = (const GAS v4u*)(X.Z + (dir ? ZB_HFB : ZB_HFF) + blk_off(chunk, 8, h, wave) + rt * 16); unpack8(zp[0], zf); unpack8(zp[1], zf + 8);
        const GAS v4u* qp = (const GAS v4u*)(X.Z + ZB_HQ + blk_off(chunk, 8, h, wave) + rt * 16); unpack8(qp[0], qv); unpack8(qp[1], qv + 8);
        float lbv[16];
        if (l == 0) {
#pragma unroll
            for (int i = 0; i < 16; ++i) lbv[i] = 0.f;
        } else { const float* lp = X.lowb + (size_t)dir * 2 * 1024 + h * 128 + c0;
#pragma unroll
            for (int i = 0; i < 16; ++i) lbv[i] = 1.f / (1.f + __expf(lp[i] - lp[1024 + i])); }
#pragma unroll
        for (int i = 0; i < 16; ++i) {
            const float z = fmaxf(zf[i], -80.f), e = __expf(-z), sig = 1.f / (1.f + e), oml = 1.f - lbv[i];
            kr[i] = oml * e * sig;
            bc[i] = flog2(lbv[i] + oml * sig); }
        wave_scan16(bc);
    }
    float qd[16], kd[16], qh[16];
#pragma unroll
    for (int i = 0; i < 16; ++i) {
        const float beta = __builtin_bit_cast(float, __builtin_amdgcn_update_dpp(0, __builtin_bit_cast(int, bc[i]), 0x142, 0xe, 0xf, false));
        qd[i] = qv[i] * fexp2(bc[i] - beta); kd[i] = kr[i] * fexp2(fminf(beta - bc[i], 80.f)); qh[i] = qv[i] * fexp2(bc[i]); }
    LAS unsigned char* p = ld + r * K_STR + c0 * 2;
    ((LAS v4u*)(p + C2_QD))[0] = pack8(qd); ((LAS v4u*)(p + C2_QD))[1] = pack8(qd + 8);
    ((LAS v4u*)(p + C2_KD))[0] = pack8(kd); ((LAS v4u*)(p + C2_KD))[1] = pack8(kd + 8);
    ((LAS v4u*)(p + C2_QH))[0] = pack8(qh); ((LAS v4u*)(p + C2_QH))[1] = pack8(qh + 8);
    if ((lane & 15) == 15) { LAS f32x4* bt = (LAS f32x4*)(ld + C2_BT + (((lane >> 4) + 1) & 3) * 512 + c0 * 4);
        const bool z = lane == 63;
#pragma unroll
        for (int i = 0; i < 4; ++i) bt[i] = z ? (f32x4){0.f, 0.f, 0.f, 0.f} : (f32x4){bc[4 * i], bc[4 * i + 1], bc[4 * i + 2], bc[4 * i + 3]}; }
}
template <bool HGT>
__device__ __forceinline__ void pass_c2_unit(const Ctx& X, int l, int chunk, int h, LAS unsigned char* lds, int tid, int lane, int wave) {
    constexpr int DV = HGT ? 128 : 256, VSTR = DV * 2 + 16, NET = DV / 128, PPR = DV / 8;
    const int fr = lane & 15, fq = lane >> 4, qq = fr >> 2, p4 = fr & 3;
    { const int vcol = HGT ? ZR_HI + h * 128 : ZR_GV + h * 256;
#pragma unroll
      for (int k = 0; k < 64 * PPR / 512; ++k) { const int idx = tid + 512 * k, row = idx / PPR, pc = idx % PPR;
        const v4u v = *(const GAS v4u*)(X.Z + (size_t)(chunk * 64 + row) * ZRW + vcol + pc * 8);
        *(LAS v4u*)(lds + C2_V + row * VSTR + pc * 16) = v; } }
    c2_stage<HGT>(X, l, chunk, h, 0, lds, lane, wave);
    c2_stage<HGT>(X, l, chunk, h, 1, lds + C2_DIR, lane, wave);
    bf16x8 sfr[2][NET][4];
#pragma unroll
    for (int dir = 0; dir < 2; ++dir) { const bf16* slot = X.ST + st_slot(chunk, HGT, h, dir);
#pragma unroll
        for (int et = 0; et < NET; ++et)
#pragma unroll
            for (int ks = 0; ks < 4; ++ks) sfr[dir][et][ks] = *(const GAS bf16x8*)(slot + (size_t)(((wave * NET + et) * 4 + ks) * 64 + lane) * 8); }
    __syncthreads();
    { const int a = wave & 3; LAS unsigned char* ld = lds + (wave >> 2) * C2_DIR;
      const unsigned lst = (a == 0) ? 0xff002010u : (a == 1) ? 0xff113021u : (a == 2) ? 0xffff2231u : 0xffff3332u;
      const unsigned zls = (a == 0) ? 0xffff0201u : (a == 1) ? 0xffff1203u : (a == 2) ? 0xffffff13u : 0xffffff23u;
      for (int t = 0; t < 3; ++t) { const unsigned code = (lst >> (8 * t)) & 0xffu; if (code == 0xffu) break;
          const int I = (int)(code >> 4), J = (int)(code & 15u);
          f32x4 sc = (f32x4){0.f, 0.f, 0.f, 0.f};
#pragma unroll
          for (int ks = 0; ks < 4; ++ks) { const int dc = 32 * ks + 8 * fq;
              v4u ka = *(const LAS v4u*)(ld + C2_KD + (16 * J + fr) * K_STR + dc * 2);
              const bf16x8 qb = *(const LAS bf16x8*)(ld + C2_QD + (16 * I + fr) * K_STR + dc * 2);
              if (J < I) { const LAS f32x4* bi = (const LAS f32x4*)(ld + C2_BT + I * 512 + dc * 4); const LAS f32x4* bj = (const LAS f32x4*)(ld + C2_BT + J * 512 + dc * 4);
                  const f32x4 d0 = bi[0] - bj[0], d1 = bi[1] - bj[1]; float kf[8]; unpack8(ka, kf);
                  kf[0] *= fexp2(d0.x); kf[1] *= fexp2(d0.y); kf[2] *= fexp2(d0.z); kf[3] *= fexp2(d0.w); kf[4] *= fexp2(d1.x); kf[5] *= fexp2(d1.y); kf[6] *= fexp2(d1.z); kf[7] *= fexp2(d1.w);
                  ka = pack8(kf); }
              sc = __builtin_amdgcn_mfma_f32_16x16x32_bf16(__builtin_bit_cast(bf16x8, ka), qb, sc, 0, 0, 0); }
          if (J == I) {
#pragma unroll
              for (int u = 0; u < 4; ++u) if (4 * fq + u > fr) sc[u] = 0.f; }
          v2u w; w.x = pkbf(sc[0], sc[1]); w.y = pkbf(sc[2], sc[3]);
          *(LAS v2u*)(ld + C2_P + (16 * I + fr) * P_STR + (16 * J + 4 * fq) * 2) = w; }
      for (int t = 0; t < 2; ++t) { const unsigned code = (zls >> (8 * t)) & 0xffu; if (code == 0xffu) break;
          const int I = (int)(code >> 4), J = (int)(code & 15u);
          *(LAS v2u*)(ld + C2_P + (16 * I + fr) * P_STR + (16 * J + 4 * fq) * 2) = (v2u){0u, 0u}; } }
    __syncthreads();
    f32x4 oacc[NET][4];
#pragma unroll
    for (int et = 0; et < NET; ++et)
#pragma unroll
        for (int it = 0; it < 4; ++it) oacc[et][it] = (f32x4){0.f, 0.f, 0.f, 0.f};
#pragma unroll
    for (int dir = 0; dir < 2; ++dir) { LAS const unsigned char* ld = lds + dir * C2_DIR;
        bf16x8 vfr[NET][2];
#pragma unroll
        for (int ks = 0; ks < 2; ++ks) { const int r0 = 32 * ks + 8 * fq + qq, r1 = r0 + 4, v0 = dir ? 63 - r0 : r0, v1 = dir ? 63 - r1 : r1;
#pragma unroll
            for (int et = 0; et < NET; ++et) { const int col = (16 * (wave * NET + et) + 4 * p4) * 2;
                vfr[et][ks] = tr_pair(lds + C2_V + v0 * VSTR + col, lds + C2_V + v1 * VSTR + col); } }
#pragma unroll
        for (int it = 0; it < 4; ++it) { const int trow = 16 * it + fr, ip = dir ? 63 - trow : trow;
            bf16x8 bo[6];
#pragma unroll
            for (int ks = 0; ks < 4; ++ks) bo[ks] = *(const LAS bf16x8*)(ld + C2_QH + ip * K_STR + (32 * ks + 8 * fq) * 2);
#pragma unroll
            for (int ks = 0; ks < 2; ++ks) bo[4 + ks] = *(const LAS bf16x8*)(ld + C2_P + ip * P_STR + (32 * ks + 8 * fq) * 2);
#pragma unroll
            for (int ks = 0; ks < 4; ++ks)
#pragma unroll
                for (int et = 0; et < NET; ++et) oacc[et][it] = __builtin_amdgcn_mfma_f32_16x16x32_bf16(sfr[dir][et][ks], bo[ks], oacc[et][it], 0, 0, 0);
#pragma unroll
            for (int ks = 0; ks < 2; ++ks)
#pragma unroll
                for (int et = 0; et < NET; ++et) oacc[et][it] = __builtin_amdgcn_mfma_f32_16x16x32_bf16(vfr[et][ks], bo[4 + ks], oacc[et][it], 0, 0, 0); } }
    LAS float* red = (LAS float*)(lds + C2_RED);
#pragma unroll
    for (int it = 0; it < 4; ++it) { float sq = 0.f;
#pragma unroll
        for (int et = 0; et < NET; ++et) { const f32x4 o = oacc[et][it]; sq += (o.x * o.x + o.y * o.y) + (o.z * o.z + o.w * o.w); }
        sq += __shfl_xor(sq, 16); sq += __shfl_xor(sq, 32);
        if (fq == 0) red[wave * 64 + 16 * it + fr] = sq; }
    __syncthreads();
    const float* ng = (HGT ? X.hg_g + (size_t)l * 128 : X.gla_g + (size_t)l * 256);
    const int ogcol = HGT ? ZR_HOG + h * 128 : ZR_GOG + h * 256, ocol = HGT ? 1024 + h * 128 : h * 256;
#pragma unroll
    for (int it = 0; it < 4; ++it) { float tot = 0.f;
#pragma unroll
        for (int w = 0; w < 8; ++w) tot += red[w * 64 + 16 * it + fr];
        const float rstd = 1.f / sqrtf(tot * (1.f / DV) + RMS_EPS);
        const int tok = chunk * 64 + 16 * it + fr;
#pragma unroll
        for (int et = 0; et < NET; ++et) { const int e0 = 16 * (wave * NET + et) + 4 * fq;
            const v2u ogp = *(const GAS v2u*)(X.Z + (size_t)tok * ZRW + ogcol + e0);
            const float og[4] = {__uint_as_float(ogp.x << 16), __uint_as_float(ogp.x & 0xffff0000u), __uint_as_float(ogp.y << 16), __uint_as_float(ogp.y & 0xffff0000u)};
            const f32x4 g4 = *(const GAS f32x4*)(ng + e0); float rr[4];
#pragma unroll
            for (int u = 0; u < 4; ++u) { const float z = fminf(fmaxf(og[u], -80.f), 80.f); rr[u] = oacc[et][it][u] * rstd * g4[u] * (z / (1.f + __expf(-z))); }
            v2u w; w.x = pkbf(rr[0], rr[1]); w.y = pkbf(rr[2], rr[3]);
            *(GAS v2u*)(X.O + (size_t)tok * DM + ocol + e0) = w; } }
}

struct Args { const float* in[15]; float* out; unsigned char* ws; int mode, pad; };
#define PHASE_IDS() int tid = threadIdx.x; asm volatile("" : "+v"(tid)); const int lane = tid & 63, wave = __builtin_amdgcn_readfirstlane(tid >> 6); \
    const int gw = bx * NWAVES + wave, NGW = G * NWAVES, gtid = bx * (NWAVES * 64) + tid, NT = G * NWAVES * 64; (void)lane; (void)wave; (void)gw; (void)NGW; (void)gtid; (void)NT
__device__ __forceinline__ Ctx make_ctx(const Args& args) {
    Ctx X; unsigned char* ws = args.ws;
    X.x_prompt = args.in[0]; X.x_sample = args.in[1]; X.w_in = args.in[2]; X.w_lr2 = args.in[3]; X.b_lr = args.in[4]; X.gla_g = args.in[5]; X.hg_g = args.in[6]; X.lowb = args.in[7];
    X.w_out = args.in[8]; X.ln1_g = args.in[9]; X.ln1_b = args.in[10]; X.w_up = args.in[11]; X.w_down = args.in[12]; X.ln2_g = args.in[13]; X.ln2_b = args.in[14]; X.out = args.out;
    X.Win_t = (bf16*)(ws + WS_WIN); X.Wout_t = (bf16*)(ws + WS_WOUT); X.Wup_t = (bf16*)(ws + WS_WUP); X.Wdn_t = (bf16*)(ws + WS_WDN); X.Wglr_t = (bf16*)(ws + WS_WGLR);
    X.HB = (bf16*)(ws + WS_HB); X.Z = (bf16*)(ws + WS_Z); X.O = (bf16*)(ws + WS_O); X.ST = (bf16*)(ws + WS_ST);
    X.BG = (float*)(ws + WS_BG); X.MF = (bf16*)(ws + WS_ST); X.TOT = (float*)(ws + WS_TOT); X.TOTS = (float*)(ws + WS_TOTS); X.STS = (bf16*)(ws + WS_STS);
    return X;
}
__global__ void __launch_bounds__(NWAVES * 64, 2) fwd_kernel(Args args) {
    extern __shared__ __attribute__((aligned(16))) unsigned char lds_raw[];
    LAS unsigned char* lds = (LAS unsigned char*)lds_raw;
    const int G = gridDim.x, bx = blockIdx.x;
    volatile LAS unsigned* MISC = (volatile LAS unsigned*)(lds + MISC_OFF);
    if (threadIdx.x < 32) MISC[threadIdx.x] = 0u;
    __syncthreads();
    XcdBarrier bar = xcd_barrier_post((unsigned*)(args.ws + WS_CTL) + CW_BAR, MISC + 8);

    { PHASE_IDS(); const Ctx X = make_ctx(args); prologue_weights(X, lds, gw, NGW, wave, lane); }
    for (int g = 0; g < NGRP; ++g) {
        { PHASE_IDS(); const Ctx X = make_ctx(args); cvt_group((g == 0) ? X.x_prompt : X.x_sample + (size_t)(g - 1) * GM * DM, X.HB, gtid, NT); }
        xcd_barrier(bar);
        for (int l = 0; l < NLAYER; ++l) {
            { PHASE_IDS(); const Ctx X = make_ctx(args); for (int c = bx; c < NCHUNK; c += G) gate_unit(X, l, c, lds, tid, lane, wave); }
            { const Ctx X = make_ctx(args); pg8::Gemm gm{X.HB, X.Win_t + (size_t)l * ZW * DM, GM, ZW, DM}; pg8::StaticOrder S; S.init(GM, ZW, G, bx);
              pg8::EpiZ E{X.Z};
              pg8::gemm_phase<pg8::EpiZ, pg8::StaticOrder, false, true>(lds, gm, S, E); }
            xcd_barrier(bar);
            {
            { PHASE_IDS(); const Ctx X = make_ctx(args);
              for (int u = bx; u < NSC * 12; u += G) { const int sc = u / 12, hh = u % 12;
                if (hh < 4) pass_s_unit<false, false>(X, l, sc, hh, lds, tid, lane, wave); else pass_s_unit<true, false>(X, l, sc, hh - 4, lds, tid, lane, wave); } }
            xcd_barrier(bar);
            { PHASE_IDS(); const Ctx X = make_ctx(args); pass_b_super(X, g, gtid, NT); }
            xcd_barrier(bar);
            { PHASE_IDS(); const Ctx X = make_ctx(args);
              for (int u = bx; u < NSC * 12; u += G) { const int sc = u / 12, hh = u % 12;
                if (hh < 4) pass_s_unit<false, true>(X, l, sc, hh, lds, tid, lane, wave); else pass_s_unit<true, true>(X, l, sc, hh - 4, lds, tid, lane, wave); } }
            xcd_barrier(bar);
            { PHASE_IDS(); const Ctx X = make_ctx(args);
              for (int u = bx; u < NCHUNK * 12; u += G) { const int c = u / 12, hh = u % 12;
                if (hh < 4) pass_c2_unit<false>(X, l, c, hh, lds, tid, lane, wave); else pass_c2_unit<true>(X, l, c, hh - 4, lds, tid, lane, wave); } }
            xcd_barrier(bar);
            }
            { const Ctx X = make_ctx(args); pg8::Gemm gm{X.O, X.Wout_t + (size_t)l * DM * DM, GM, DM, DM}; pg8::StaticOrder S; S.init(GM, DM, G, bx);
              pg8::EpiBf16<0> E{X.MF, DM};
              pg8::gemm_phase<pg8::EpiBf16<0>, pg8::StaticOrder, false, true>(lds, gm, S, E); }
            xcd_barrier(bar);
            { PHASE_IDS(); const Ctx X = make_ctx(args);
              if (l == 0) ln_phase<true, false>((g == 0) ? X.x_prompt : X.x_sample + (size_t)(g - 1) * GM * DM, X.MF, X.ln1_g, X.ln1_b, nullptr, X.HB, gw, NGW, lane);
              else ln_phase<false, false>(X.HB, X.MF, X.ln1_g + (size_t)l * DM, X.ln1_b + (size_t)l * DM, nullptr, X.HB, gw, NGW, lane); }
            xcd_barrier(bar);
            { const Ctx X = make_ctx(args); pg8::Gemm gm{X.HB, X.Wup_t + (size_t)l * DFF * DM, GM, DFF, DM}; pg8::StaticOrder S; S.init(GM, DFF, G, bx);
              pg8::EpiBf16<1> E{X.Z, DFF};
              pg8::gemm_phase<pg8::EpiBf16<1>, pg8::StaticOrder, false, true>(lds, gm, S, E); }
            xcd_barrier(bar);
            { const Ctx X = make_ctx(args); pg8::Gemm gm{X.Z, X.Wdn_t + (size_t)l * DM * DFF, GM, DM, DFF}; pg8::StaticOrder S; S.init(GM, DM, G, bx);
              pg8::EpiBf16<0> E{X.MF, DM};
              pg8::gemm_phase<pg8::EpiBf16<0>, pg8::StaticOrder, false, true>(lds, gm, S, E); }
            xcd_barrier(bar);
            { PHASE_IDS(); const Ctx X = make_ctx(args);
              if (l == NLAYER - 1) ln_phase<false, true>(X.HB, X.MF, X.ln2_g + (size_t)l * DM, X.ln2_b + (size_t)l * DM, X.out + (size_t)g * GM * DM, nullptr, gw, NGW, lane);
              else ln_phase<false, false>(X.HB, X.MF, X.ln2_g + (size_t)l * DM, X.ln2_b + (size_t)l * DM, nullptr, X.HB, gw, NGW, lane); }
            xcd_barrier(bar);
        }
    }
}

extern "C" void kernel_launch(void* const* d_in, const int* in_sizes, int n_in, void* d_out, int out_size, void* d_ws, size_t ws_size, hipStream_t stream) {
    static int grid = 0;
    if (grid == 0) {
        if (n_in != 15 || out_size != NTOK * DM || ws_size < WS_END) { fprintf(stderr, "kernel_launch: unexpected shapes (n_in %d, out %d, ws %zu)\n", n_in, out_size, ws_size); grid = -1; return; }
        int dev = 0, cus = 0;
        if (hipGetDevice(&dev) != hipSuccess || hipDeviceGetAttribute(&cus, hipDeviceAttributeMultiprocessorCount, dev) != hipSuccess) { grid = -1; return; }
        if (hipFuncSetAttribute((const void*)fwd_kernel, hipFuncAttributeMaxDynamicSharedMemorySize, LDS_BYTES) != hipSuccess) { fprintf(stderr, "kernel_launch: hipFuncSetAttribute failed\n"); grid = -1; return; }
        int per_cu = 0;
        if (hipOccupancyMaxActiveBlocksPerMultiprocessor(&per_cu, (const void*)fwd_kernel, NWAVES * 64, LDS_BYTES) != hipSuccess || per_cu < 1) { fprintf(stderr, "kernel_launch: occupancy query says %d\n", per_cu); }
        (void)hipGetLastError();
        grid = cus;
    }
    if (grid < 0) return;
    if (hipMemsetAsync((char*)d_ws + WS_CTL, 0, CTL_ZERO_BYTES, stream) != hipSuccess) return;
    Args a{};
    for (int i = 0; i < 15; ++i) a.in[i] = (const float*)d_in[i];
    a.out = (float*)d_out; a.ws = (unsigned char*)d_ws; a.mode = KMODE; a.pad = 0;
    hipLaunchKernelGGL(fwd_kernel, dim3(grid), dim3(NWAVES * 64), LDS_BYTES, stream, a);
}
```

```cpp
#include <hip/hip_runtime.h>
#include <cstdio>
#include <cstdint>
#ifndef KMODE
#define KMODE 0
#endif
namespace pg8 {
#define PG8_LAS __attribute__((address_space(3)))
typedef unsigned short bf16_t;
typedef short bf16x8 __attribute__((ext_vector_type(8)));
typedef float f32x4 __attribute__((ext_vector_type(4)));
typedef unsigned u32x4 __attribute__((ext_vector_type(4)));
constexpr int BM = 256, BK = 64, HALF = 128, HTB = HALF * BK * 2  , STAGE_BYTES = 8 * HTB, NXCD = 8, WGM = 8;

__host__ __device__ __forceinline__ int lds_byte(int r, int c) { const int st = (r >> 4) * 2 + (c >> 5), rr = r & 15, cc = c & 31, ob = rr * 64 + cc * 2; return st * 1024 + (ob ^ (((ob >> 9) & 1) << 5)); }
__host__ __device__ __forceinline__ void stage_rc(int b, int& R, int& C) { const int st = b / 1024, sb = b % 1024, swz = sb ^ (((sb >> 9) & 1) << 5); R = (st >> 1) * 16 + swz / 64; C = (st & 1) * 32 + (swz % 64) / 2; }
__host__ __device__ __forceinline__ int perm32(int rho) { const int n = rho >> 4, i = rho & 15; return 8 * (i >> 2) + 4 * n + (i & 3); }

struct Unit { int pm, pn; };
struct Gemm { const bf16_t* A; const bf16_t* Bt; int M, N, K; };

struct StaticOrder {
    int nM, nN, nwg, G, c;
    __host__ __device__ void init(int M, int N, int G_, int c_) { nM = M / BM; nN = N / BM; nwg = nM * nN; G = G_; c = c_; }
    __host__ __device__ bool next(int i, Unit& u) const {
        const long L = (long)i * G + c; if (L >= nwg) return false;
        int wgid = (int)L; { const int q = nwg / NXCD, r = nwg % NXCD, xcd = wgid % NXCD, off = wgid / NXCD; wgid = (xcd < r ? xcd * (q + 1) : r * (q + 1) + (xcd - r) * q) + off; }
        const int nig = WGM * nN, gid = wgid / nig, fm = gid * WGM, gsz = (nM - fm) < WGM ? (nM - fm) : WGM;
        u.pm = fm + ((wgid % nig) % gsz); u.pn = (wgid % nig) / gsz; return true;
    }
    __device__ __forceinline__ void a_ready(const Unit&) const {}
    __device__ __forceinline__ void done(const Unit&) const {}
};


__device__ __forceinline__ unsigned cvt_pk_bf16(float lo, float hi) { unsigned r; asm volatile("v_cvt_pk_bf16_f32 %0, %1, %2" : "=v"(r) : "v"(lo), "v"(hi)); return r; }

template <int ACT  > struct EpiBf16 {
    static constexpr bool PERM = true, AFTER_DRAIN = false;
    bf16_t* O; int ldc;
    __device__ __forceinline__ void operator()(const f32x4 (&acc)[2][2][4][2], const Unit& u, int wr, int wc, int fr, int fq) const {
        const int row0 = u.pm * BM + wr * 64 + fr; const int col0 = u.pn * BM + wc * 32 + 8 * fq;
#pragma unroll
        for (int ai = 0; ai < 2; ++ai)
#pragma unroll
            for (int m = 0; m < 4; ++m) { bf16_t* rowp = O + (size_t)(row0 + ai * HALF + m * 16) * ldc + col0;
#pragma unroll
                for (int bj = 0; bj < 2; ++bj) { f32x4 v0 = acc[ai][bj][m][0], v1 = acc[ai][bj][m][1];
                    if (ACT == 1) {
#pragma unroll
                        for (int j = 0; j < 4; ++j) { const float a = fmaxf(v0[j], 0.f), b = fmaxf(v1[j], 0.f); v0[j] = a * a; v1[j] = b * b; } }
                    u32x4 w; w.x = cvt_pk_bf16(v0[0], v0[1]); w.y = cvt_pk_bf16(v0[2], v0[3]); w.z = cvt_pk_bf16(v1[0], v1[1]); w.w = cvt_pk_bf16(v1[2], v1[3]);
                    *(u32x4*)(rowp + bj * HALF) = w; } }
    }
};
struct EpiF32 {
    static constexpr bool PERM = false, AFTER_DRAIN = false;
    float* C; int ldc;
    __device__ __forceinline__ void operator()(const f32x4 (&acc)[2][2][4][2], const Unit& u, int wr, int wc, int fr, int fq) const {
        const int row0 = u.pm * BM + wr * 64 + fr, col0 = u.pn * BM + wc * 32 + 4 * fq;
#pragma unroll
        for (int ai = 0; ai < 2; ++ai)
#pragma unroll
            for (int m = 0; m < 4; ++m) { float* rowp = C + (size_t)(row0 + ai * HALF + m * 16) * ldc + col0;
#pragma unroll
                for (int bj = 0; bj < 2; ++bj)
#pragma unroll
                    for (int n = 0; n < 2; ++n) *(f32x4*)(rowp + bj * HALF + n * 16) = acc[ai][bj][m][n]; }
    }
};

struct EpiZ {
    static constexpr bool PERM = true, AFTER_DRAIN = false;
    bf16_t* Z;
    __device__ __forceinline__ void operator()(const f32x4 (&acc)[2][2][4][2], const Unit& u, int wr, int wc, int fr, int fq) const {
        const int pn = u.pn; const size_t Mr = 16384;
        bool blocked; int H = 4, c0; bf16_t* base;
        if (pn < 2) { blocked = true; H = 4; base = Z + Mr * 4096; c0 = pn * 256; }
        else if (pn < 4) { blocked = true; H = 4; base = Z + Mr * 4096 + Mr * 512; c0 = (pn - 2) * 256; }
        else if (pn < 8) { blocked = false; base = Z; c0 = (pn - 4) * 256; }
        else if (pn < 12) { blocked = false; base = Z; c0 = 1024 + (pn - 8) * 256; }
        else if (pn < 24) { blocked = true; H = 8; base = Z + Mr * 4096 + Mr * 1024 + (size_t)((pn - 12) >> 2) * Mr * 1024; c0 = ((pn - 12) & 3) * 256; }
        else if (pn < 28) { blocked = false; base = Z; c0 = 2048 + (pn - 24) * 256; }
        else { blocked = false; base = Z; c0 = 3072 + (pn - 28) * 256; }
        const int row0 = u.pm * BM + wr * 64 + fr, cl = c0 + wc * 32 + 8 * fq;
#pragma unroll
        for (int ai = 0; ai < 2; ++ai)
#pragma unroll
            for (int m = 0; m < 4; ++m) { const int row = row0 + ai * HALF + m * 16;
#pragma unroll
                for (int bj = 0; bj < 2; ++bj) { const f32x4 v0 = acc[ai][bj][m][0], v1 = acc[ai][bj][m][1]; const int c = cl + bj * HALF;
                    u32x4 w; w.x = cvt_pk_bf16(v0[0], v0[1]); w.y = cvt_pk_bf16(v0[2], v0[3]); w.z = cvt_pk_bf16(v1[0], v1[1]); w.w = cvt_pk_bf16(v1[2], v1[3]);
                    bf16_t* p = blocked ? base + ((size_t)((((row >> 6) * H + (c >> 7)) * 8 + ((c >> 4) & 7)) * 64 + (row & 63))) * 16 + (c & 15)
                                        : base + (size_t)row * 4096 + c;
                    *(u32x4*)p = w; } }
    }
};

template <class Epi, class Sched, bool ALIGN_EPI = false, bool SP2 = false>
__device__ __forceinline__ void gemm_phase(PG8_LAS unsigned char* lds, const Gemm g, const Sched& S, const Epi& E) {
    int tid_o = threadIdx.x; asm volatile("" : "+v"(tid_o));
    const int tid = tid_o, wid = __builtin_amdgcn_readfirstlane(tid >> 6), lane = tid & 63, wr = wid >> 2, wc = wid & 3, fr = lane & 15, fq = lane >> 4;
    const int K = g.K, nt = K / BK;
    unsigned voffA[2], voffB[2];
#pragma unroll
    for (int i = 0; i < 2; ++i) { int R, C; stage_rc(tid * 16 + i * 8192, R, C); const int Rb = Epi::PERM ? ((R & ~31) + perm32(R & 31)) : R;
        voffA[i] = (unsigned)(R * K + C) * 2u; voffB[i] = (unsigned)(Rb * K + C) * 2u; }
    const size_t kstep = (size_t)(BK * 2);
    const size_t hstep = (size_t)HALF * K * 2;
    const size_t tstep = 2 * hstep;
    const unsigned ldsw = (unsigned)wid * 1024u;
    const int aoff = lds_byte(wr * 64 + fr, fq * 8), boff = lds_byte(wc * 32 + fr, fq * 8);
#define PG8_SA(b, h) (((b) * 2 + (h)) * HTB)
#define PG8_SB(b, h) ((4 + (b) * 2 + (h)) * HTB)
#define PG8_STAGE(bufoff, gbase, voff) do { _Pragma("unroll") for (int _i = 0; _i < 2; ++_i) \
        __builtin_amdgcn_global_load_lds((const unsigned*)((const char*)(gbase) + (voff)[_i]), (PG8_LAS unsigned*)(lds + (bufoff) + ldsw + _i * 8192), 16, 0, 0); } while (0)
#define PG8_LDA(dst, b, h) do { _Pragma("unroll") for (int m = 0; m < 4; ++m) _Pragma("unroll") for (int k = 0; k < 2; ++k) dst[m][k] = *(const PG8_LAS bf16x8*)(lds + PG8_SA(b, h) + aoff + m * 2048 + k * 1024); } while (0)
#define PG8_LDB(dst, b, h) do { _Pragma("unroll") for (int n = 0; n < 2; ++n) _Pragma("unroll") for (int k = 0; k < 2; ++k) dst[n][k] = *(const PG8_LAS bf16x8*)(lds + PG8_SB(b, h) + boff + n * 2048 + k * 1024); } while (0)
#define PG8_MMA(ai, bj, At, Bt) do { __builtin_amdgcn_s_setprio(1); _Pragma("unroll") for (int m = 0; m < 4; ++m) _Pragma("unroll") for (int n = 0; n < 2; ++n) _Pragma("unroll") for (int k = 0; k < 2; ++k) \
        acc[ai][bj][m][n] = __builtin_amdgcn_mfma_f32_16x16x32_bf16(Bt[n][k], At[m][k], acc[ai][bj][m][n], 0, 0, 0); __builtin_amdgcn_s_setprio(0); } while (0)
#define PG8_WAIT_V(n) asm volatile("s_waitcnt vmcnt(" #n ")" ::: "memory")
#define PG8_WAIT_L(n) asm volatile("s_waitcnt lgkmcnt(" #n ")" ::: "memory")
#define PG8_BAR __builtin_amdgcn_s_barrier()
#define PG8_SCHED __builtin_amdgcn_sched_barrier(0)
    Unit cur, nxt; int ui = 0;
    if (!S.next(0, cur)) return;
    f32x4 acc[2][2][4][2];
#pragma unroll
    for (int a = 0; a < 2; ++a)
#pragma unroll
        for (int b = 0; b < 2; ++b)
#pragma unroll
            for (int m = 0; m < 4; ++m)
#pragma unroll
                for (int n = 0; n < 2; ++n) acc[a][b][m][n] = (f32x4){0.f, 0.f, 0.f, 0.f};
    bf16x8 At[4][2], B0[2][2], B1[2][2];
    const char* cA = (const char*)g.A + (size_t)cur.pm * tstep; const char* cB = (const char*)g.Bt + (size_t)cur.pn * tstep;
    S.a_ready(cur);
    if constexpr (SP2) {
        PG8_STAGE(PG8_SB(0, 0), cB, voffB); PG8_STAGE(PG8_SB(0, 1), cB + hstep, voffB); PG8_STAGE(PG8_SA(0, 0), cA, voffA); PG8_STAGE(PG8_SA(0, 1), cA + hstep, voffA);
        if (wr == 1) PG8_BAR;
        PG8_WAIT_V(2); PG8_BAR;
        PG8_STAGE(PG8_SB(1, 0), cB + kstep, voffB); PG8_STAGE(PG8_SA(1, 0), cA + kstep, voffA); PG8_STAGE(PG8_SB(1, 1), cB + hstep + kstep, voffB);
        PG8_WAIT_V(6); PG8_BAR;
    } else {
        PG8_STAGE(PG8_SB(0, 0), cB, voffB); PG8_STAGE(PG8_SA(0, 0), cA, voffA); PG8_STAGE(PG8_SB(0, 1), cB + hstep, voffB); PG8_STAGE(PG8_SA(0, 1), cA + hstep, voffA);
        if (wr == 1) PG8_BAR;
        PG8_WAIT_V(4); PG8_BAR;
        PG8_STAGE(PG8_SB(1, 0), cB + kstep, voffB); PG8_STAGE(PG8_SA(1, 0), cA + kstep, voffA); PG8_STAGE(PG8_SB(1, 1), cB + hstep + kstep, voffB);
        PG8_WAIT_V(6); PG8_BAR;
    }
    for (;;) {
        const bool has_next = S.next(ui + 1, nxt);
        const char* nA = has_next ? (const char*)g.A + (size_t)nxt.pm * tstep : cA; const char* nB = has_next ? (const char*)g.Bt + (size_t)nxt.pn * tstep : cB;
        for (int t = 0; t < nt; t += 2) {
            const bool last = (t == nt - 2);
            const char* a1 = cA + (size_t)(t + 1) * kstep;
            const char* a2 = last ? nA : cA + (size_t)(t + 2) * kstep; const char* b2 = last ? nB : cB + (size_t)(t + 2) * kstep;
            const char* a3 = a2 + kstep; const char* b3 = b2 + kstep;
            if (last && has_next) S.a_ready(nxt);
            if constexpr (SP2) {
            PG8_LDB(B0, 0, 0); PG8_LDB(B1, 0, 1); PG8_SCHED; PG8_LDA(At, 0, 0); PG8_STAGE(PG8_SA(1, 1), a1 + hstep, voffA);
            PG8_WAIT_V(8); PG8_WAIT_L(0); PG8_BAR; PG8_MMA(0, 0, At, B0); PG8_MMA(0, 1, At, B1); PG8_BAR; PG8_SCHED;
            PG8_LDA(At, 0, 1); PG8_STAGE(PG8_SB(0, 0), b2, voffB); PG8_STAGE(PG8_SB(0, 1), b2 + hstep, voffB); PG8_STAGE(PG8_SA(0, 0), a2, voffA);
            PG8_WAIT_V(8); PG8_WAIT_L(0); PG8_BAR; PG8_MMA(1, 0, At, B0); PG8_MMA(1, 1, At, B1); PG8_BAR; PG8_SCHED;
            PG8_LDB(B0, 1, 0); PG8_LDB(B1, 1, 1); PG8_SCHED; PG8_LDA(At, 1, 0); PG8_STAGE(PG8_SA(0, 1), a2 + hstep, voffA);
            PG8_WAIT_V(8); PG8_WAIT_L(0); PG8_BAR; PG8_MMA(0, 0, At, B0); PG8_MMA(0, 1, At, B1); PG8_BAR; PG8_SCHED;
            PG8_LDA(At, 1, 1); PG8_STAGE(PG8_SB(1, 0), b3, voffB); PG8_STAGE(PG8_SB(1, 1), b3 + hstep, voffB); PG8_STAGE(PG8_SA(1, 0), a3, voffA);
            PG8_WAIT_V(8); PG8_WAIT_L(0); PG8_BAR; PG8_MMA(1, 0, At, B0); PG8_MMA(1, 1, At, B1); PG8_BAR; PG8_SCHED;
            } else {
            PG8_LDB(B0, 0, 0); PG8_SCHED; PG8_LDA(At, 0, 0); PG8_STAGE(PG8_SA(1, 1), a1 + hstep, voffA);
            PG8_WAIT_L(8); PG8_BAR; PG8_WAIT_L(0); PG8_MMA(0, 0, At, B0); PG8_BAR; PG8_SCHED;
            PG8_LDB(B1, 0, 1); PG8_STAGE(PG8_SB(0, 0), b2, voffB);
            PG8_BAR; PG8_WAIT_L(0); PG8_MMA(0, 1, At, B1); PG8_BAR;
            PG8_LDA(At, 0, 1); PG8_STAGE(PG8_SA(0, 0), a2, voffA);
            PG8_BAR; PG8_WAIT_L(0); PG8_MMA(1, 0, At, B0); PG8_BAR; PG8_SCHED;
            PG8_STAGE(PG8_SB(0, 1), b2 + hstep, voffB);
            PG8_WAIT_V(6); PG8_BAR; PG8_MMA(1, 1, At, B1); PG8_BAR;
            PG8_LDB(B0, 1, 0); PG8_SCHED; PG8_LDA(At, 1, 0); PG8_STAGE(PG8_SA(0, 1), a2 + hstep, voffA);
            PG8_WAIT_L(8); PG8_BAR; PG8_WAIT_L(0); PG8_MMA(0, 0, At, B0); PG8_BAR; PG8_SCHED;
            PG8_LDB(B1, 1, 1); PG8_STAGE(PG8_SB(1, 0), b3, voffB);
            PG8_BAR; PG8_WAIT_L(0); PG8_MMA(0, 1, At, B1); PG8_BAR;
            PG8_LDA(At, 1, 1); PG8_STAGE(PG8_SA(1, 0), a3, voffA);
            PG8_BAR; PG8_WAIT_L(0); PG8_MMA(1, 0, At, B0); PG8_BAR; PG8_SCHED;
            PG8_STAGE(PG8_SB(1, 1), b3 + hstep, voffB);
            PG8_WAIT_V(6); PG8_BAR; PG8_MMA(1, 1, At, B1); PG8_BAR;
            }
        }
        if constexpr (ALIGN_EPI) { if (wr == 0) PG8_BAR; }
        if constexpr (!Epi::AFTER_DRAIN) { E(acc, cur, wr, wc, fr, fq); S.done(cur); }
        if (!has_next) break;
#pragma unroll
        for (int a = 0; a < 2; ++a)
#pragma unroll
            for (int b = 0; b < 2; ++b)
#pragma unroll
                for (int m = 0; m < 4; ++m)
#pragma unroll
                    for (int n = 0; n < 2; ++n) acc[a][b][m][n] = (f32x4){0.f, 0.f, 0.f, 0.f};
        cur = nxt; cA = nA; cB = nB; ++ui;
        if constexpr (ALIGN_EPI) { if (wr == 1) PG8_BAR; }
    }
    PG8_WAIT_V(0);
    if constexpr (!ALIGN_EPI) { if (wr == 0) PG8_BAR; }
    PG8_BAR;
    if constexpr (Epi::AFTER_DRAIN) { E.fused(acc, cur, wr, wc, fr, fq, lds, wid, lane); S.done(cur); }
#undef PG8_SA
#undef PG8_SB
#undef PG8_STAGE
#undef PG8_LDA
#undef PG8_LDB
#undef PG8_MMA
#undef PG8_WAIT_V
#undef PG8_WAIT_L
#undef PG8_BAR
#undef PG8_SCHED
}
}

constexpr int NWAVES = 8;
constexpr int DM = 2048, DFF = 8192, NTOK = 49152, GM = 16384, NGRP = 3, NLAYER = 2, INW = 8224, ZW = 8192;
constexpr int ZC_GQ = 0, ZC_GK = 512, ZC_GV = 1024, ZC_GOG = 2048, ZC_HQ = 3072, ZC_HFF = 4096, ZC_HFB = 5120, ZC_HI = 6144, ZC_HOG = 7168;
constexpr float LN_EPS = 1e-5f, RMS_EPS = 1e-6f, ALPHA = 1.41421356237f, LOG2E = 1.44269504089f;
constexpr int NCHUNK = GM / 64;
constexpr int ST_CHUNK = 524288;
constexpr size_t MiB = 1u << 20;
constexpr size_t WS_CTL = 0, CTL_ZERO_BYTES = 1 * MiB;
constexpr size_t WS_WIN = 2 * MiB, WS_WOUT = 66 * MiB, WS_WUP = 82 * MiB, WS_WDN = 146 * MiB, WS_WGLR = 210 * MiB;
constexpr size_t WS_HB = 212 * MiB;
constexpr size_t WS_Z = 276 * MiB;
constexpr size_t WS_BG = 532 * MiB;
constexpr size_t WS_O = 596 * MiB;
constexpr size_t WS_ST = 660 * MiB;
constexpr size_t WS_TOT = 916 * MiB;
constexpr size_t WS_STS = 920 * MiB;
constexpr size_t WS_TOTS = 984 * MiB;
constexpr size_t WS_END = 985 * MiB;
constexpr int CW_BAR = 4096;
constexpr int RING_BYTES = 131072;
constexpr int LDS_BYTES = 160 * 1024, MISC_OFF = LDS_BYTES - 256;
constexpr int L_B32 = 0, L_KR = 33792, L_QR = 51200, L_QH = 68608, L_V = 86016, L_P = 119808, L_RED = 129024;
constexpr int B32_STR = 528, K_STR = 272, P_STR = 144, KT_STR = 144;
constexpr int NSC = GM / 256;
constexpr int SV_KT = 135168, KTW_BYTES = 2560;

#define GAS __attribute__((address_space(1)))
#define LAS __attribute__((address_space(3)))
typedef unsigned short bf16;
typedef unsigned v4u __attribute__((ext_vector_type(4)));
typedef float f32x4 __attribute__((ext_vector_type(4)));
typedef short bf16x8 __attribute__((ext_vector_type(8)));
typedef GAS unsigned gu32;
typedef GAS unsigned long long gu64;
#define RLX_AGENT __ATOMIC_RELAXED, __HIP_MEMORY_SCOPE_AGENT
#define LDS_WAIT() asm volatile("s_waitcnt lgkmcnt(0)" ::: "memory")
#define VM_WAIT() asm volatile("s_waitcnt vmcnt(0)" ::: "memory")
__device__ __forceinline__ unsigned long long rt() { return __builtin_amdgcn_s_memrealtime(); }
__device__ __forceinline__ unsigned f2bf(float f) { unsigned u = __builtin_bit_cast(unsigned, f); return (u + 0x7fffu + ((u >> 16) & 1u)) >> 16; }
__device__ __forceinline__ unsigned pk2(float lo, float hi) { return f2bf(lo) | (f2bf(hi) << 16); }

#define XB_TMO      128
#define XB_XCNT(j)  (256  + 64 * (j))
#define XB_XSUB(j)  (1280 + 64 * (j))
#define XB_XGEN(j)  (2304 + 64 * (j))
#define XB_TOP      3328
#define XB_TOPGEN   3392
#define XCD_BAR_WORDS 3456
#define XB_SPIN_CAP (1u << 18)

__device__ __forceinline__ unsigned xb_ld(unsigned* p)              { return __hip_atomic_load(p, __ATOMIC_RELAXED, __HIP_MEMORY_SCOPE_AGENT); }
__device__ __forceinline__ unsigned xb_add(unsigned* p, unsigned v) { return __hip_atomic_fetch_add(p, v, __ATOMIC_RELAXED, __HIP_MEMORY_SCOPE_AGENT); }
__device__ __forceinline__ unsigned xb_xcc_id() { return (unsigned)__builtin_amdgcn_s_getreg((3 << 11) | 20) & 0xFu; }
#define XB_SPIN(cond, bar) do { unsigned _sp = 0; while (cond) { __builtin_amdgcn_s_sleep(1); \
    if ((++_sp & 255u) == 0u) { if (xb_ld(&(bar)[XB_TMO])) break; if (_sp > XB_SPIN_CAP) { atomicAdd(&(bar)[XB_TMO], 1u); break; } } } } while (0)

struct XcdBarrier {
    unsigned* bar; unsigned x;
    volatile LAS unsigned* st;
};

__device__ __forceinline__ XcdBarrier xcd_barrier_post(unsigned* bar, volatile LAS unsigned* st) {
    XcdBarrier b; b.bar = bar; b.x = xb_xcc_id(); b.st = st;
    if (threadIdx.x == 0) (void)xb_add(&bar[XB_XCNT(b.x)], 1u);
    return b;
}
__device__ __forceinline__ void xcd_barrier_complete(unsigned* bar, unsigned x, unsigned& nloc, unsigned& nx) {
    const unsigned G = gridDim.x * gridDim.y * gridDim.z;
    unsigned sum, cnt, mine, sp = 0u;
    for (;;) {
        sum = 0u; cnt = 0u; mine = 0u;
#pragma unroll
        for (unsigned j = 0; j < 16; ++j) { const unsigned c = xb_ld(&bar[XB_XCNT(j)]); sum += c; cnt += (c > 0u) ? 1u : 0u; mine = (j == x) ? c : mine; }
        if (sum == G) break;
        __builtin_amdgcn_s_sleep(1);
        if ((++sp & 255u) == 0u) { if (xb_ld(&bar[XB_TMO])) break; if (sp > XB_SPIN_CAP) { atomicAdd(&bar[XB_TMO], 1u); break; } }
    }
    nloc = mine > 0u ? mine : 1u; nx = cnt > 0u ? cnt : 1u;
}

__device__ __forceinline__ void xcd_barrier(const XcdBarrier& b) {
    asm volatile("s_waitcnt vmcnt(0)" ::: "memory");
    __syncthreads();
    if (threadIdx.x == 0) {
        unsigned* bar = b.bar;
        __builtin_amdgcn_s_waitcnt(0);
        unsigned nloc = b.st[0], nx = b.st[1];
        if (nloc == 0u) { xcd_barrier_complete(bar, b.x, nloc, nx); b.st[0] = nloc; b.st[1] = nx; }
        const unsigned old = xb_add(&bar[XB_XSUB(b.x)], 1u);
        const unsigned gen = old / nloc;
        if (old + 1u == (gen + 1u) * nloc) {
            __builtin_amdgcn_fence(__ATOMIC_RELEASE, "agent");
            asm volatile("s_waitcnt vmcnt(0)" ::: "memory");
            const unsigned og = xb_add(&bar[XB_TOP], 1u);
            const unsigned tg = og / nx;
            if (og + 1u == (tg + 1u) * nx) xb_add(&bar[XB_TOPGEN], 1u);
            else XB_SPIN(xb_ld(&bar[XB_TOPGEN]) == tg, bar);
            __builtin_amdgcn_fence(__ATOMIC_ACQUIRE, "agent");
            xb_add(&bar[XB_XGEN(b.x)], 1u);
            asm volatile("s_waitcnt vmcnt(0)" ::: "memory");
        } else {
            XB_SPIN(xb_ld(&bar[XB_XGEN(b.x)]) == gen, bar);
            __builtin_amdgcn_fence(__ATOMIC_ACQUIRE, "agent");
            asm volatile("s_waitcnt vmcnt(0)" ::: "memory");
        }
    }
    __syncthreads();
}

typedef short s16x4 __attribute__((ext_vector_type(4)));
typedef float f32x2 __attribute__((ext_vector_type(2)));
typedef unsigned v2u __attribute__((ext_vector_type(2)));
__device__ __forceinline__ unsigned pkbf(float lo, float hi) { return pg8::cvt_pk_bf16(lo, hi); }
__device__ __forceinline__ float wave_sum(float v) {
#pragma unroll
    for (int o = 1; o < 64; o <<= 1) v += __shfl_xor(v, o);
    return v;
}
template <int CTRL, int RM> __device__ __forceinline__ float dpp_add(float v) {
    return v + __builtin_bit_cast(float, __builtin_amdgcn_update_dpp(0, __builtin_bit_cast(int, v), CTRL, RM, 0xf, true));
}
__device__ __forceinline__ float wave_scan_incl(float v, int) {
    v = dpp_add<0x111, 0xf>(v); v = dpp_add<0x112, 0xf>(v); v = dpp_add<0x114, 0xf>(v); v = dpp_add<0x118, 0xf>(v);
    v = dpp_add<0x142, 0xa>(v); v = dpp_add<0x143, 0xc>(v); return v;
}
template <int CTRL, int RM> __device__ __forceinline__ void dpp_add16(float* v) {
#pragma unroll
    for (int i = 0; i < 16; ++i) v[i] = dpp_add<CTRL, RM>(v[i]);
}
__device__ __forceinline__ void wave_scan16(float* v) {
    dpp_add16<0x111, 0xf>(v); dpp_add16<0x112, 0xf>(v); dpp_add16<0x114, 0xf>(v); dpp_add16<0x118, 0xf>(v); dpp_add16<0x142, 0xa>(v); dpp_add16<0x143, 0xc>(v);
}
__device__ __forceinline__ void unpack8(const v4u v, float* f) {
    f[0] = __uint_as_float(v.x << 16); f[1] = __uint_as_float(v.x & 0xffff0000u); f[2] = __uint_as_float(v.y << 16); f[3] = __uint_as_float(v.y & 0xffff0000u);
    f[4] = __uint_as_float(v.z << 16); f[5] = __uint_as_float(v.z & 0xffff0000u); f[6] = __uint_as_float(v.w << 16); f[7] = __uint_as_float(v.w & 0xffff0000u);
}
__device__ __forceinline__ v4u pack8(const float* f) { v4u o; o.x = pkbf(f[0], f[1]); o.y = pkbf(f[2], f[3]); o.z = pkbf(f[4], f[5]); o.w = pkbf(f[6], f[7]); return o; }
__device__ __forceinline__ s16x4 lds_tr(LAS const unsigned char* p) { return __builtin_bit_cast(s16x4, __builtin_amdgcn_ds_read_tr16_b64_v4i16((LAS s16x4*)p)); }
__device__ __forceinline__ bf16x8 tr_pair(LAS const unsigned char* p0, LAS const unsigned char* p1) {
    const s16x4 a = lds_tr(p0), b = lds_tr(p1); return __builtin_shufflevector(a, b, 0, 1, 2, 3, 4, 5, 6, 7);
}
__device__ __forceinline__ float fexp2(float x) { return __builtin_amdgcn_exp2f(x); }
__device__ __forceinline__ float flog2(float x) { return __builtin_amdgcn_logf(x); }

constexpr size_t ZB_GQ = (size_t)GM * 4096, ZB_GK = ZB_GQ + (size_t)GM * 512, ZB_HQ = ZB_GK + (size_t)GM * 512, ZB_HFF = ZB_HQ + (size_t)GM * 1024, ZB_HFB = ZB_HFF + (size_t)GM * 1024;
constexpr int ZRW = 4096, ZR_GV = 0, ZR_GOG = 1024, ZR_HI = 2048, ZR_HOG = 3072;
__device__ __forceinline__ size_t blk_off(int chunk, int H, int hh, int w) { return (size_t)((chunk * H + hh) * 8 + w) * 1024; }
struct Ctx {
    const float *x_prompt, *x_sample, *w_in, *w_lr2, *b_lr, *gla_g, *hg_g, *lowb, *w_out, *ln1_g, *ln1_b, *w_up, *w_down, *ln2_g, *ln2_b;
    float* out;
    bf16 *Win_t, *Wout_t, *Wup_t, *Wdn_t, *Wglr_t, *HB, *Z, *O, *ST;
    float *BG, *TOT, *TOTS; bf16 *STS, *MF;
};

__device__ __forceinline__ void transpose_item(const float* W, int N, int kb, int nb, bf16* dst, int K, LAS float* scr, int lane) {
    const int k0 = 64 * kb, n0 = 32 * nb;
#pragma unroll 8
    for (int i = 0; i < 32; ++i) { const int kk = 2 * i + (lane >> 5); scr[kk * 33 + (lane & 31)] = W[(size_t)(k0 + kk) * N + n0 + (lane & 31)]; }
    LDS_WAIT(); asm volatile("" ::: "memory");
    const int c = lane & 7;
#pragma unroll
    for (int j = 0; j < 4; ++j) { const int n = (lane >> 3) + 8 * j; const LAS float* s = scr + (8 * c) * 33 + n;
        v4u o; o.x = pkbf(s[0 * 33], s[1 * 33]); o.y = pkbf(s[2 * 33], s[3 * 33]); o.z = pkbf(s[4 * 33], s[5 * 33]); o.w = pkbf(s[6 * 33], s[7 * 33]);
        *(GAS v4u*)(dst + (size_t)n * K + k0 + 8 * c) = o; }
    LDS_WAIT(); asm volatile("" ::: "memory");
}
__device__ __forceinline__ void prologue_weights(const Ctx& X, LAS unsigned char* lds, int gw, int NGW, int wave, int lane) {
    LAS float* scr = (LAS float*)(lds + wave * 16384);
    constexpr int I_IN = 32 * 257, I_OUT = 32 * 64, I_UP = 32 * 256, I_DN = 128 * 64, I_L = I_IN + I_OUT + I_UP + I_DN;
    for (int it = gw; it < NLAYER * I_L; it += NGW) {
        const int l = it / I_L; int r = it % I_L;
        if (r < I_IN) { const int kb = r / 257, nb = r % 257;
            bf16* dst = (nb < 96) ? X.Win_t + ((size_t)l * ZW + 32 * nb) * DM : (nb == 96) ? X.Wglr_t + (size_t)l * 32 * DM : X.Win_t + ((size_t)l * ZW + 32 * (nb - 1)) * DM;
            transpose_item(X.w_in + (size_t)l * DM * INW, INW, kb, nb, dst, DM, scr, lane); continue; }
        r -= I_IN;
        if (r < I_OUT) { const int kb = r / 64, nb = r % 64; transpose_item(X.w_out + (size_t)l * DM * DM, DM, kb, nb, X.Wout_t + ((size_t)l * DM + 32 * nb) * DM, DM, scr, lane); continue; }
        r -= I_OUT;
        if (r < I_UP) { const int kb = r / 256, nb = r % 256; transpose_item(X.w_up + (size_t)l * DM * DFF, DFF, kb, nb, X.Wup_t + ((size_t)l * DFF + 32 * nb) * DM, DM, scr, lane); continue; }
        r -= I_UP;
        { const int kb = r / 64, nb = r % 64; transpose_item(X.w_down + (size_t)l * DFF * DM, DM, kb, nb, X.Wdn_t + ((size_t)l * DM + 32 * nb) * DFF, DFF, scr, lane); }
    }
}
__device__ __forceinline__ void cvt_group(const float* xg, bf16* HB, int gtid, int NT) {
    for (int i = gtid; i < GM * DM / 8; i += NT) {
        const f32x4 a = ((const GAS f32x4*)xg)[2 * i], b = ((const GAS f32x4*)xg)[2 * i + 1];
        v4u o; o.x = pkbf(a.x, a.y); o.y = pkbf(a.z, a.w); o.z = pkbf(b.x, b.y); o.w = pkbf(b.z, b.w);
        ((GAS v4u*)HB)[i] = o; }
}
template <bool RES_F32, bool OUT_F32>
__device__ __forceinline__ void ln_phase(const void* res, const bf16* mf, const float* gam, const float* bet, float* H, bf16* HB, int gw, int NGW, int lane) {
    for (int m = gw; m < GM; m += NGW) {
        f32x4 v[8]; float s = 0.f;
        const GAS v2u* mr = (const GAS v2u*)(mf + (size_t)m * DM) + lane;
#pragma unroll
        for (int j = 0; j < 8; ++j) { f32x4 r;
            if (RES_F32) r = ((const GAS f32x4*)((const float*)res + (size_t)m * DM) + lane)[64 * j];
            else { const v2u w = ((const GAS v2u*)((const bf16*)res + (size_t)m * DM) + lane)[64 * j];
                r = (f32x4){__uint_as_float(w.x << 16), __uint_as_float(w.x & 0xffff0000u), __uint_as_float(w.y << 16), __uint_as_float(w.y & 0xffff0000u)}; }
            const v2u w = mr[64 * j];
            const f32x4 f = (f32x4){__uint_as_float(w.x << 16), __uint_as_float(w.x & 0xffff0000u), __uint_as_float(w.y << 16), __uint_as_float(w.y & 0xffff0000u)};
            v[j] = r * ALPHA + f; s += (v[j].x + v[j].y) + (v[j].z + v[j].w); }
        const float mean = wave_sum(s) * (1.f / DM); float s2 = 0.f;
#pragma unroll
        for (int j = 0; j < 8; ++j) { v[j] = v[j] - mean; s2 += (v[j].x * v[j].x + v[j].y * v[j].y) + (v[j].z * v[j].z + v[j].w * v[j].w); }
        const float rstd = 1.f / sqrtf(wave_sum(s2) * (1.f / DM) + LN_EPS);
#pragma unroll
        for (int j = 0; j < 8; ++j) { const f32x4 g4 = ((const GAS f32x4*)gam)[lane + 64 * j], b4 = ((const GAS f32x4*)bet)[lane + 64 * j];
            const f32x4 o = v[j] * rstd * g4 + b4;
            if (OUT_F32) ((GAS f32x4*)(H + (size_t)m * DM) + lane)[64 * j] = o;
            else { v2u w; w.x = pkbf(o.x, o.y); w.y = pkbf(o.z, o.w); ((GAS v2u*)(HB + (size_t)m * DM) + lane)[64 * j] = w; } }
    }
}

__device__ __forceinline__ void gate_unit(const Ctx& X, int l, int chunk, LAS unsigned char* lds, int tid, int lane, int wave) {
    const int fr = lane & 15, fq = lane >> 4;
    const bf16* A = X.HB + (size_t)chunk * 64 * DM; const bf16* Bw = X.Wglr_t + (size_t)l * 32 * DM;
    f32x4 acc[4][2];
#pragma unroll
    for (int m = 0; m < 4; ++m)
#pragma unroll
        for (int n = 0; n < 2; ++n) acc[m][n] = (f32x4){0.f, 0.f, 0.f, 0.f};
#pragma unroll 2
    for (int ks = 0; ks < 8; ++ks) { const int k0 = 256 * wave + 32 * ks + 8 * fq;
        bf16x8 a[4], b[2];
#pragma unroll
        for (int m = 0; m < 4; ++m) a[m] = *(const GAS bf16x8*)(A + (size_t)(16 * m + fr) * DM + k0);
#pragma unroll
        for (int n = 0; n < 2; ++n) b[n] = *(const GAS bf16x8*)(Bw + (size_t)(16 * n + fr) * DM + k0);
#pragma unroll
        for (int m = 0; m < 4; ++m)
#pragma unroll
            for (int n = 0; n < 2; ++n) acc[m][n] = __builtin_amdgcn_mfma_f32_16x16x32_bf16(a[m], b[n], acc[m][n], 0, 0, 0); }
    LAS float* part = (LAS float*)lds;
#pragma unroll
    for (int m = 0; m < 4; ++m)
#pragma unroll
        for (int n = 0; n < 2; ++n)
#pragma unroll
            for (int j = 0; j < 4; ++j) part[(wave * 64 + 16 * m + 4 * fq + j) * 33 + 16 * n + fr] = acc[m][n][j];
    __syncthreads();
    LAS float* glr = (LAS float*)(lds + 8 * 64 * 33 * 4);
#pragma unroll
    for (int k = 0; k < 4; ++k) { const int idx = tid + 512 * k, t = idx >> 5, n = idx & 31; float s = 0.f;
#pragma unroll
        for (int w = 0; w < 8; ++w) s += part[(w * 64 + t) * 33 + n];
        glr[t * 36 + n] = s; }
    __syncthreads();
    const int dir = wave >> 2;
    const float* w2 = X.w_lr2 + (size_t)(l * 2 + dir) * 16 * 512; const float* bl = X.b_lr + (size_t)(l * 2 + dir) * 512;
    for (int cb = 0; cb < 2; ++cb) { const int c = 128 * (wave & 3) + 64 * cb + lane;
        float w[16];
#pragma unroll
        for (int r = 0; r < 16; ++r) w[r] = w2[r * 512 + c];
        const float bias = bl[c]; float run = 0.f;
        float* bgcol = X.BG + ((size_t)(((chunk * 4 + (c >> 7)) * 8 + ((c & 127) >> 4)) * 2 + dir) * 64) * 16 + (c & 15);
#pragma unroll 4
        for (int tt = 0; tt < 64; ++tt) { const int t = dir ? 63 - tt : tt;
            const LAS f32x4* gr = (const LAS f32x4*)(glr + t * 36 + dir * 16); const f32x4 g0 = gr[0], g1 = gr[1], g2 = gr[2], g3 = gr[3];
            float pre = bias;
            pre += g0.x * w[0] + g0.y * w[1] + g0.z * w[2] + g0.w * w[3]; pre += g1.x * w[4] + g1.y * w[5] + g1.z * w[6] + g1.w * w[7];
            pre += g2.x * w[8] + g2.y * w[9] + g2.z * w[10] + g2.w * w[11]; pre += g3.x * w[12] + g3.y * w[13] + g3.z * w[14] + g3.w * w[15];
            run += (fminf(pre, 0.f) - __logf(1.f + __expf(-fabsf(pre)))) * (LOG2E / 16.f);
            bgcol[(size_t)t * 16] = run; } }
    __syncthreads();
}

__device__ __forceinline__ size_t st_slot(int chunk, bool hgt, int h, int dir) { return (size_t)chunk * ST_CHUNK + (hgt ? 262144 + (h * 2 + dir) * 16384 : (h * 2 + dir) * 32768); }

template <bool HGT> struct RawIn { f32x4 b[4]; v4u k[2]; };
template <> struct RawIn<true> { v4u k[2]; };
template <bool HGT>
__device__ __forceinline__ RawIn<HGT> pass_s_load(const Ctx& X, int chunk, int h, int dir, int lane, int c0) {
    RawIn<HGT> r; const int rt = dir ? 63 - lane : lane, w = c0 >> 4;
    if constexpr (!HGT) { const GAS f32x4* bg = (const GAS f32x4*)(X.BG + ((size_t)(((chunk * 4 + h) * 8 + w) * 2 + dir) * 64 + rt) * 16);
#pragma unroll
        for (int i = 0; i < 4; ++i) r.b[i] = bg[i];
        const GAS v4u* kp = (const GAS v4u*)(X.Z + ZB_GK + blk_off(chunk, 4, h, w) + rt * 16); r.k[0] = kp[0]; r.k[1] = kp[1];
    } else { const GAS v4u* zp = (const GAS v4u*)(X.Z + (dir ? ZB_HFB : ZB_HFF) + blk_off(chunk, 8, h, w) + rt * 16); r.k[0] = zp[0]; r.k[1] = zp[1]; }
    return r;
}
template <bool HGT, bool STORE>
__device__ __forceinline__ void pass_s_unit(const Ctx& X, int l, int sc, int h, LAS unsigned char* lds, int tid, int lane, int wave) {
    constexpr int DV = HGT ? 128 : 256, VSTR = DV * 2 + 16, NE = DV / 16, PPR = DV / 8, UNR_D = HGT ? 2 : 1, UNR_C = HGT ? 4 : 1;
    const int fr = lane & 15, fq = lane >> 4, qq = fr >> 2, p4 = fr & 3, c0 = 16 * wave;
    RawIn<HGT> cur = pass_s_load<HGT>(X, sc * 4, h, 0, lane, c0);
    RawIn<HGT> rq[HGT ? 4 : 1];
    { const int vcol = HGT ? ZR_HI + h * 128 : ZR_GV + h * 256;
#pragma unroll 4
      for (int k = 0; k < 256 * PPR / 512; ++k) { const int idx = tid + 512 * k, row = idx / PPR, pc = idx % PPR;
        const v4u v = *(const GAS v4u*)(X.Z + (size_t)(sc * 256 + row) * ZRW + vcol + pc * 8);
        *(LAS v4u*)(lds + row * VSTR + pc * 16) = v; } }
    __syncthreads();
    LAS unsigned char* kt = lds + SV_KT + wave * KTW_BYTES;
    for (int dir = 0; dir < 2; ++dir) {
        const int hd = HGT ? 8 + h * 2 + dir : h * 2 + dir;
        if constexpr (HGT) {
#pragma unroll
            for (int q4 = 0; q4 < 4; ++q4) rq[q4] = pass_s_load<HGT>(X, sc * 4 + (dir ? 3 - q4 : q4), h, dir, lane, c0); }
        float lbv[16];
        if (HGT) {
#pragma unroll
            for (int i = 0; i < 16; ++i) lbv[i] = 0.f;
            if (l != 0) { const float* lp = X.lowb + (size_t)dir * 2 * 1024 + h * 128 + c0;
#pragma unroll
                for (int i = 0; i < 16; ++i) lbv[i] = 1.f / (1.f + __expf(lp[i] - lp[1024 + i])); } }
        f32x4 acc[NE];
        if (STORE) { const bf16* sin = X.STS + st_slot(sc, HGT, h, dir);
#pragma unroll
            for (int et = 0; et < NE; ++et) { const v2u w = *(const GAS v2u*)(sin + (size_t)((et * 4 + (wave >> 1)) * 64 + fr + 16 * (2 * (wave & 1) + (fq >> 1))) * 8 + 4 * (fq & 1));
                acc[et] = (f32x4){__uint_as_float(w.x << 16), __uint_as_float(w.x & 0xffff0000u), __uint_as_float(w.y << 16), __uint_as_float(w.y & 0xffff0000u)}; }
        } else {
#pragma unroll
            for (int et = 0; et < NE; ++et) acc[et] = (f32x4){0.f, 0.f, 0.f, 0.f}; }
        float run[16];
#pragma unroll
        for (int i = 0; i < 16; ++i) run[i] = 0.f;
#pragma unroll UNR_C
        for (int cc = 0; cc < 4; ++cc) { const int ci = dir ? 3 - cc : cc, chunk = sc * 4 + ci;
            RawIn<HGT> nxt = cur;
            if constexpr (HGT) cur = rq[cc];
            else { if (cc < 3) nxt = pass_s_load<HGT>(X, sc * 4 + (dir ? 2 - cc : cc + 1), h, dir, lane, c0);
                   else if (dir == 0) nxt = pass_s_load<HGT>(X, sc * 4 + 3, h, 1, lane, c0); }
            float bc[16], kr[16];
            if constexpr (!HGT) {
#pragma unroll
                for (int i = 0; i < 4; ++i) { bc[4 * i] = cur.b[i].x; bc[4 * i + 1] = cur.b[i].y; bc[4 * i + 2] = cur.b[i].z; bc[4 * i + 3] = cur.b[i].w; }
                unpack8(cur.k[0], kr); unpack8(cur.k[1], kr + 8);
            } else {
                float zf[16]; unpack8(cur.k[0], zf); unpack8(cur.k[1], zf + 8);
#pragma unroll
                for (int i = 0; i < 16; ++i) {
                    const float z = fmaxf(zf[i], -80.f), e = __expf(-z), sig = 1.f / (1.f + e), oml = 1.f - lbv[i];
                    kr[i] = oml * e * sig;
                    bc[i] = flog2(lbv[i] + oml * sig); }
                wave_scan16(bc);
            }
            if (STORE) { bf16* slot = X.ST + st_slot(chunk, HGT, h, dir);
#pragma unroll
                for (int et = 0; et < NE; ++et) { v2u w; w.x = pkbf(acc[et][0], acc[et][1]); w.y = pkbf(acc[et][2], acc[et][3]);
                    *(GAS v2u*)(slot + (size_t)((et * 4 + (wave >> 1)) * 64 + fr + 16 * (2 * (wave & 1) + (fq >> 1))) * 8 + 4 * (fq & 1)) = w; }
                if (cc == 3) { cur = nxt; break; } }
            float kh[16];
#pragma unroll
            for (int i = 0; i < 16; ++i) { const float bl = __shfl(bc[i], 63); kh[i] = kr[i] * fexp2(bl - bc[i]); run[i] += bl; }
            { const v4u k0 = pack8(kh), k1 = pack8(kh + 8); const unsigned kw[8] = {k0.x, k0.y, k0.z, k0.w, k1.x, k1.y, k1.z, k1.w};
#pragma unroll
              for (int i = 0; i < 16; ++i) *(LAS unsigned short*)(kt + i * KT_STR + lane * 2) = (unsigned short)((i & 1) ? (kw[i >> 1] >> 16) : (kw[i >> 1] & 0xffffu)); }
            if (lane == 63) {
#pragma unroll
                for (int i = 0; i < 4; ++i) ((LAS f32x4*)(kt + 2304))[i] = (f32x4){bc[4 * i], bc[4 * i + 1], bc[4 * i + 2], bc[4 * i + 3]}; }
            asm volatile("s_waitcnt lgkmcnt(0)" ::: "memory");
            const f32x4 dl = *(const LAS f32x4*)(kt + 2304 + 16 * fq);
            const f32x4 dec = (f32x4){fexp2(dl.x), fexp2(dl.y), fexp2(dl.z), fexp2(dl.w)};
            bf16x8 afr[2];
#pragma unroll
            for (int ks = 0; ks < 2; ++ks) afr[ks] = *(const LAS bf16x8*)(kt + fr * KT_STR + (32 * ks + 8 * fq) * 2);
#pragma unroll
            for (int et = 0; et < NE; ++et) acc[et] = acc[et] * dec;
            { constexpr int NB = 2 * NE / 4;
              LAS const unsigned char* vb[2][2];
#pragma unroll
              for (int ks = 0; ks < 2; ++ks) { const int r0 = 32 * ks + 8 * fq + qq, r1 = r0 + 4;
                  vb[ks][0] = lds + (ci * 64 + (dir ? 63 - r0 : r0)) * VSTR + 8 * p4; vb[ks][1] = lds + (ci * 64 + (dir ? 63 - r1 : r1)) * VSTR + 8 * p4; }
              bf16x8 bb[2][4];
#pragma unroll
              for (int j = 0; j < 4; ++j) bb[0][j] = tr_pair(vb[0][0] + 32 * j, vb[0][1] + 32 * j);
#pragma unroll
              for (int b = 0; b < NB; ++b) {
                  if (b + 1 < NB) { const int ks1 = (b + 1) / (NE / 4), e1 = 4 * ((b + 1) % (NE / 4));
#pragma unroll
                      for (int j = 0; j < 4; ++j) bb[(b + 1) & 1][j] = tr_pair(vb[ks1][0] + 32 * (e1 + j), vb[ks1][1] + 32 * (e1 + j)); }
                  const int ks0 = b / (NE / 4), e0 = 4 * (b % (NE / 4));
#pragma unroll
                  for (int j = 0; j < 4; ++j) acc[e0 + j] = __builtin_amdgcn_mfma_f32_16x16x32_bf16(afr[ks0], bb[b & 1][j], acc[e0 + j], 0, 0, 0);
                  __builtin_amdgcn_sched_group_barrier(0x100, 8, 0); __builtin_amdgcn_sched_group_barrier(0x008, 4, 0); } }
            asm volatile("s_waitcnt lgkmcnt(0)" ::: "memory");
            cur = nxt;
        }
        if (!STORE) { bf16* sout = X.STS + st_slot(sc, HGT, h, dir);
#pragma unroll
            for (int et = 0; et < NE; ++et) { v2u w; w.x = pkbf(acc[et][0], acc[et][1]); w.y = pkbf(acc[et][2], acc[et][3]);
                *(GAS v2u*)(sout + (size_t)((et * 4 + (wave >> 1)) * 64 + fr + 16 * (2 * (wave & 1) + (fq >> 1))) * 8 + 4 * (fq & 1)) = w; }
            if (lane == 0) { float* tp = X.TOTS + ((size_t)sc * 24 + hd) * 128 + c0;
#pragma unroll
                for (int i = 0; i < 4; ++i) ((GAS f32x4*)tp)[i] = (f32x4){run[4 * i], run[4 * i + 1], run[4 * i + 2], run[4 * i + 3]}; } }
    }
    __syncthreads();
}
__device__ __forceinline__ void pass_b_super(const Ctx& X, int g, int gtid, int NT) {
    const int ns = (g == 0) ? 1 : 2, nc = NSC / ns;
    for (int v = gtid; v < ns * (ST_CHUNK / 8); v += NT) {
        const int s = v / (ST_CHUNK / 8), idx = (v % (ST_CHUNK / 8)) * 8;
        const int hd = idx < 262144 ? idx / 32768 : 8 + (idx - 262144) / 16384, db = hd & 1;
        const int d0 = 32 * ((idx >> 9) & 3) + 8 * ((idx >> 7) & 3);
        float S[8];
#pragma unroll
        for (int i = 0; i < 8; ++i) S[i] = 0.f;
        for (int cc = 0; cc < nc; cc += 8) {
            v4u x[8]; f32x4 t0[8], t1[8];
#pragma unroll
            for (int u = 0; u < 8; ++u) { const int c = s * nc + (db ? nc - 1 - (cc + u) : cc + u);
                x[u] = *(const GAS v4u*)(X.STS + (size_t)c * ST_CHUNK + idx);
                const GAS f32x4* tp = (const GAS f32x4*)(X.TOTS + ((size_t)c * 24 + hd) * 128 + d0); t0[u] = tp[0]; t1[u] = tp[1]; }
#pragma unroll
            for (int u = 0; u < 8; ++u) { const int c = s * nc + (db ? nc - 1 - (cc + u) : cc + u);
                *(GAS v4u*)(X.STS + (size_t)c * ST_CHUNK + idx) = pack8(S);
                float dx[8]; unpack8(x[u], dx);
                const float dec[8] = {fexp2(t0[u].x), fexp2(t0[u].y), fexp2(t0[u].z), fexp2(t0[u].w), fexp2(t1[u].x), fexp2(t1[u].y), fexp2(t1[u].z), fexp2(t1[u].w)};
#pragma unroll
                for (int i = 0; i < 8; ++i) S[i] = dec[i] * S[i] + dx[i]; }
        }
    }
}

constexpr int C2_DIR = 63488, C2_QD = 0, C2_KD = 17408, C2_QH = 34816, C2_P = 52224, C2_BT = 61440, C2_V = 126976, C2_RED = 160768;
template <bool HGT>
__device__ __forceinline__ void c2_stage(const Ctx& X, int l, int chunk, int h, int dir, LAS unsigned char* ld, int lane, int wave) {
    const int r = lane, rt = dir ? 63 - r : r, c0 = 16 * wave;
    float bc[16], kr[16], qv[16];
    if (!HGT) {
        const GAS f32x4* bg = (const GAS f32x4*)(X.BG + ((size_t)(((chunk * 4 + h) * 8 + wave) * 2 + dir) * 64 + rt) * 16);
#pragma unroll
        for (int i = 0; i < 4; ++i) { const f32x4 t = bg[i]; bc[4 * i] = t.x; bc[4 * i + 1] = t.y; bc[4 * i + 2] = t.z; bc[4 * i + 3] = t.w; }
        const GAS v4u* kp = (const GAS v4u*)(X.Z + ZB_GK + blk_off(chunk, 4, h, wave) + rt * 16); unpack8(kp[0], kr); unpack8(kp[1], kr + 8);
        const GAS v4u* qp = (const GAS v4u*)(X.Z + ZB_GQ + blk_off(chunk, 4, h, wave) + rt * 16); unpack8(qp[0], qv); unpack8(qp[1], qv + 8);
#pragma unroll
        for (int i = 0; i < 16; ++i) qv[i] *= 0.08838834764831845f;
    } else {
        float zf[16];
        const GAS v4u* zp = (const GAS v4u*)(X.Z + (dir ? ZB_HFB : ZB_HFF) + blk_off(chunk, 8, h, wave) + rt * 16); unpack8(zp[0], zf); unpack8(zp[1], zf + 8);
        const GAS v4u* qp = (const GAS v4u*)(X.Z + ZB_HQ + blk_off(chunk, 8, h, wave) + rt * 16); unpack8(qp[0], qv); unpack8(qp[1], qv + 8);
        float lbv[16];
        if (l == 0) {
#pragma unroll
            for (int i = 0; i < 16; ++i) lbv[i] = 0.f;
        } else { const float* lp = X.lowb + (size_t)dir * 2 * 1024 + h * 128 + c0;
#pragma unroll
            for (int i = 0; i < 16; ++i) lbv[i] = 1.f / (1.f + __expf(lp[i] - lp[1024 + i])); }
#pragma unroll
        for (int i = 0; i < 16; ++i) {
            const float z = fmaxf(zf[i], -80.f), e = __expf(-z), sig = 1.f / (1.f + e), oml = 1.f - lbv[i];
            kr[i] = oml * e * sig;
            bc[i] = flog2(lbv[i] + oml * sig); }
        wave_scan16(bc);
    }
    float qd[16], kd[16], qh[16];
#pragma unroll
    for (int i = 0; i < 16; ++i) {
        const float beta = __builtin_bit_cast(float, __builtin_amdgcn_update_dpp(0, __builtin_bit_cast(int, bc[i]), 0x142, 0xe, 0xf, false));
        qd[i] = qv[i] * fexp2(bc[i] - beta); kd[i] = kr[i] * fexp2(fminf(beta - bc[i], 80.f)); qh[i] = qv[i] * fexp2(bc[i]); }
    LAS unsigned char* p = ld + r * K_STR + c0 * 2;
    ((LAS v4u*)(p + C2_QD))[0] = pack8(qd); ((LAS v4u*)(p + C2_QD))[1] = pack8(qd + 8);
    ((LAS v4u*)(p + C2_KD))[0] = pack8(kd); ((LAS v4u*)(p + C2_KD))[1] = pack8(kd + 8);
    ((LAS v4u*)(p + C2_QH))[0] = pack8(qh); ((LAS v4u*)(p + C2_QH))[1] = pack8(qh + 8);
    if ((lane & 15) == 15) { LAS f32x4* bt = (LAS f32x4*)(ld + C2_BT + (((lane >> 4) + 1) & 3) * 512 + c0 * 4);
        const bool z = lane == 63;
#pragma unroll
        for (int i = 0; i < 4; ++i) bt[i] = z ? (f32x4){0.f, 0.f, 0.f, 0.f} : (f32x4){bc[4 * i], bc[4 * i + 1], bc[4 * i + 2], bc[4 * i + 3]}; }
}
template <bool HGT>
__device__ __forceinline__ void pass_c2_unit(const Ctx& X, int l, int chunk, int h, LAS unsigned char* lds, int tid, int lane, int wave) {
    constexpr int DV = HGT ? 128 : 256, VSTR = DV * 2 + 16, NET = DV / 128, PPR = DV / 8;
    const int fr = lane & 15, fq = lane >> 4, qq = fr >> 2, p4 = fr & 3;
    { const int vcol = HGT ? ZR_HI + h * 128 : ZR_GV + h * 256;
#pragma unroll
      for (int k = 0; k < 64 * PPR / 512; ++k) { const int idx = tid + 512 * k, row = idx / PPR, pc = idx % PPR;
        const v4u v = *(const GAS v4u*)(X.Z + (size_t)(chunk * 64 + row) * ZRW + vcol + pc * 8);
        *(LAS v4u*)(lds + C2_V + row * VSTR + pc * 16) = v; } }
    c2_stage<HGT>(X, l, chunk, h, 0, lds, lane, wave);
    c2_stage<HGT>(X, l, chunk, h, 1, lds + C2_DIR, lane, wave);
    bf16x8 sfr[2][NET][4];
#pragma unroll
    for (int dir = 0; dir < 2; ++dir) { const bf16* slot = X.ST + st_slot(chunk, HGT, h, dir);
#pragma unroll
        for (int et = 0; et < NET; ++et)
#pragma unroll
            for (int ks = 0; ks < 4; ++ks) sfr[dir][et][ks] = *(const GAS bf16x8*)(slot + (size_t)(((wave * NET + et) * 4 + ks) * 64 + lane) * 8); }
    __syncthreads();
    { const int a = wave & 3; LAS unsigned char* ld = lds + (wave >> 2) * C2_DIR;
      const unsigned lst = (a == 0) ? 0xff002010u : (a == 1) ? 0xff113021u : (a == 2) ? 0xffff2231u : 0xffff3332u;
      const unsigned zls = (a == 0) ? 0xffff0201u : (a == 1) ? 0xffff1203u : (a == 2) ? 0xffffff13u : 0xffffff23u;
      for (int t = 0; t < 3; ++t) { const unsigned code = (lst >> (8 * t)) & 0xffu; if (code == 0xffu) break;
          const int I = (int)(code >> 4), J = (int)(code & 15u);
          f32x4 sc = (f32x4){0.f, 0.f, 0.f, 0.f};
#pragma unroll
          for (int ks = 0; ks < 4; ++ks) { const int dc = 32 * ks + 8 * fq;
              v4u ka = *(const LAS v4u*)(ld + C2_KD + (16 * J + fr) * K_STR + dc * 2);
              const bf16x8 qb = *(const LAS bf16x8*)(ld + C2_QD + (16 * I + fr) * K_STR + dc * 2);
              if (J < I) { const LAS f32x4* bi = (const LAS f32x4*)(ld + C2_BT + I * 512 + dc * 4); const LAS f32x4* bj = (const LAS f32x4*)(ld + C2_BT + J * 512 + dc * 4);
                  const f32x4 d0 = bi[0] - bj[0], d1 = bi[1] - bj[1]; float kf[8]; unpack8(ka, kf);
                  kf[0] *= fexp2(d0.x); kf[1] *= fexp2(d0.y); kf[2] *= fexp2(d0.z); kf[3] *= fexp2(d0.w); kf[4] *= fexp2(d1.x); kf[5] *= fexp2(d1.y); kf[6] *= fexp2(d1.z); kf[7] *= fexp2(d1.w);
                  ka = pack8(kf); }
              sc = __builtin_amdgcn_mfma_f32_16x16x32_bf16(__builtin_bit_cast(bf16x8, ka), qb, sc, 0, 0, 0); }
          if (J == I) {
#pragma unroll
              for (int u = 0; u < 4; ++u) if (4 * fq + u > fr) sc[u] = 0.f; }
          v2u w; w.x = pkbf(sc[0], sc[1]); w.y = pkbf(sc[2], sc[3]);
          *(LAS v2u*)(ld + C2_P + (16 * I + fr) * P_STR + (16 * J + 4 * fq) * 2) = w; }
      for (int t = 0; t < 2; ++t) { const unsigned code = (zls >> (8 * t)) & 0xffu; if (code == 0xffu) break;
          const int I = (int)(code >> 4), J = (int)(code & 15u);
          *(LAS v2u*)(ld + C2_P + (16 * I + fr) * P_STR + (16 * J + 4 * fq) * 2) = (v2u){0u, 0u}; } }
    __syncthreads();
    f32x4 oacc[NET][4];
#pragma unroll
    for (int et = 0; et < NET; ++et)
#pragma unroll
        for (int it = 0; it < 4; ++it) oacc[et][it] = (f32x4){0.f, 0.f, 0.f, 0.f};
#pragma unroll
    for (int dir = 0; dir < 2; ++dir) { LAS const unsigned char* ld = lds + dir * C2_DIR;
        bf16x8 vfr[NET][2];
#pragma unroll
        for (int ks = 0; ks < 2; ++ks) { const int r0 = 32 * ks + 8 * fq + qq, r1 = r0 + 4, v0 = dir ? 63 - r0 : r0, v1 = dir ? 63 - r1 : r1;
#pragma unroll
            for (int et = 0; et < NET; ++et) { const int col = (16 * (wave * NET + et) + 4 * p4) * 2;
                vfr[et][ks] = tr_pair(lds + C2_V + v0 * VSTR + col, lds + C2_V + v1 * VSTR + col); } }
#pragma unroll
        for (int it = 0; it < 4; ++it) { const int trow = 16 * it + fr, ip = dir ? 63 - trow : trow;
            bf16x8 bo[6];
#pragma unroll
            for (int ks = 0; ks < 4; ++ks) bo[ks] = *(const LAS bf16x8*)(ld + C2_QH + ip * K_STR + (32 * ks + 8 * fq) * 2);
#pragma unroll
            for (int ks = 0; ks < 2; ++ks) bo[4 + ks] = *(const LAS bf16x8*)(ld + C2_P + ip * P_STR + (32 * ks + 8 * fq) * 2);
#pragma unroll
            for (int ks = 0; ks < 4; ++ks)
#pragma unroll
                for (int et = 0; et < NET; ++et) oacc[et][it] = __builtin_amdgcn_mfma_f32_16x16x32_bf16(sfr[dir][et][ks], bo[ks], oacc[et][it], 0, 0, 0);
#pragma unroll
            for (int ks = 0; ks < 2; ++ks)
#pragma unroll
                for (int et = 0; et < NET; ++et) oacc[et][it] = __builtin_amdgcn_mfma_f32_16x16x32_bf16(vfr[et][ks], bo[4 + ks], oacc[et][it], 0, 0, 0); } }
    LAS float* red = (LAS float*)(lds + C2_RED);
#pragma unroll
    for (int it = 0; it < 4; ++it) { float sq = 0.f;
#pragma unroll
        for (int et = 0; et < NET; ++et) { const f32x4 o = oacc[et][it]; sq += (o.x * o.x + o.y * o.y) + (o.z * o.z + o.w * o.w); }
        sq += __shfl_xor(sq, 16); sq += __shfl_xor(sq, 32);
        if (fq == 0) red[wave * 64 + 16 * it + fr] = sq; }
    __syncthreads();
    const float* ng = (HGT ? X.hg_g + (size_t)l * 128 : X.gla_g + (size_t)l * 256);
    const int ogcol = HGT ? ZR_HOG + h * 128 : ZR_GOG + h * 256, ocol = HGT ? 1024 + h * 128 : h * 256;
#pragma unroll
    for (int it = 0; it < 4; ++it) { float tot = 0.f;
#pragma unroll
        for (int w = 0; w < 8; ++w) tot += red[w * 64 + 16 * it + fr];
        const float rstd = 1.f / sqrtf(tot * (1.f / DV) + RMS_EPS);
        const int tok = chunk * 64 + 16 * it + fr;
#pragma unroll
        for (int et = 0; et < NET; ++et) { const int e0 = 16 * (wave * NET + et) + 4 * fq;
            const v2u ogp = *(const GAS v2u*)(X.Z + (size_t)tok * ZRW + ogcol + e0);
            const float og[4] = {__uint_as_float(ogp.x << 16), __uint_as_float(ogp.x & 0xffff0000u), __uint_as_float(ogp.y << 16), __uint_as_float(ogp.y & 0xffff0000u)};
            const f32x4 g4 = *(const GAS f32x4*)(ng + e0); float rr[4];
#pragma unroll
            for (int u = 0; u < 4; ++u) { const float z = fminf(fmaxf(og[u], -80.f), 80.f); rr[u] = oacc[et][it][u] * rstd * g4[u] * (z / (1.f + __expf(-z))); }
            v2u w; w.x = pkbf(rr[0], rr[1]); w.y = pkbf(rr[2], rr[3]);
            *(GAS v2u*)(X.O + (size_t)tok * DM + ocol + e0) = w; } }
}

struct Args { const float* in[15]; float* out; unsigned char* ws; int mode, pad; };
#define PHASE_IDS() int tid = threadIdx.x; asm volatile("" : "+v"(tid)); const int lane = tid & 63, wave = __builtin_amdgcn_readfirstlane(tid >> 6); \
    const int gw = bx * NWAVES + wave, NGW = G * NWAVES, gtid = bx * (NWAVES * 64) + tid, NT = G * NWAVES * 64; (void)lane; (void)wave; (void)gw; (void)NGW; (void)gtid; (void)NT
__device__ __forceinline__ Ctx make_ctx(const Args& args) {
    Ctx X; unsigned char* ws = args.ws;
    X.x_prompt = args.in[0]; X.x_sample = args.in[1]; X.w_in = args.in[2]; X.w_lr2 = args.in[3]; X.b_lr = args.in[4]; X.gla_g = args.in[5]; X.hg_g = args.in[6]; X.lowb = args.in[7];
    X.w_out = args.in[8]; X.ln1_g = args.in[9]; X.ln1_b = args.in[10]; X.w_up = args.in[11]; X.w_down = args.in[12]; X.ln2_g = args.in[13]; X.ln2_b = args.in[14]; X.out = args.out;
    X.Win_t = (bf16*)(ws + WS_WIN); X.Wout_t = (bf16*)(ws + WS_WOUT); X.Wup_t = (bf16*)(ws + WS_WUP); X.Wdn_t = (bf16*)(ws + WS_WDN); X.Wglr_t = (bf16*)(ws + WS_WGLR);
    X.HB = (bf16*)(ws + WS_HB); X.Z = (bf16*)(ws + WS_Z); X.O = (bf16*)(ws + WS_O); X.ST = (bf16*)(ws + WS_ST);
    X.BG = (float*)(ws + WS_BG); X.MF = (bf16*)(ws + WS_ST); X.TOT = (float*)(ws + WS_TOT); X.TOTS = (float*)(ws + WS_TOTS); X.STS = (bf16*)(ws + WS_STS);
    return X;
}
__global__ void __launch_bounds__(NWAVES * 64, 2) fwd_kernel(Args args) {
    extern __shared__ __attribute__((aligned(16))) unsigned char lds_raw[];
    LAS unsigned char* lds = (LAS unsigned char*)lds_raw;
    const int G = gridDim.x, bx = blockIdx.x;
    volatile LAS unsigned* MISC = (volatile LAS unsigned*)(lds + MISC_OFF);
    if (threadIdx.x < 32) MISC[threadIdx.x] = 0u;
    __syncthreads();
    XcdBarrier bar = xcd_barrier_post((unsigned*)(args.ws + WS_CTL) + CW_BAR, MISC + 8);

    { PHASE_IDS(); const Ctx X = make_ctx(args); prologue_weights(X, lds, gw, NGW, wave, lane); }
    for (int g = 0; g < NGRP; ++g) {
        { PHASE_IDS(); const Ctx X = make_ctx(args); cvt_group((g == 0) ? X.x_prompt : X.x_sample + (size_t)(g - 1) * GM * DM, X.HB, gtid, NT); }
        xcd_barrier(bar);
        for (int l = 0; l < NLAYER; ++l) {
            { PHASE_IDS(); const Ctx X = make_ctx(args); for (int c = bx; c < NCHUNK; c += G) gate_unit(X, l, c, lds, tid, lane, wave); }
            { const Ctx X = make_ctx(args); pg8::Gemm gm{X.HB, X.Win_t + (size_t)l * ZW * DM, GM, ZW, DM}; pg8::StaticOrder S; S.init(GM, ZW, G, bx);
              pg8::EpiZ E{X.Z};
              pg8::gemm_phase<pg8::EpiZ, pg8::StaticOrder, false, true>(lds, gm, S, E); }
            xcd_barrier(bar);
            {
            { PHASE_IDS(); const Ctx X = make_ctx(args);
              for (int u = bx; u < NSC * 12; u += G) { const int sc = u / 12, hh = u % 12;
                if (hh < 4) pass_s_unit<false, false>(X, l, sc, hh, lds, tid, lane, wave); else pass_s_unit<true, false>(X, l, sc, hh - 4, lds, tid, lane, wave); } }
            xcd_barrier(bar);
            { PHASE_IDS(); const Ctx X = make_ctx(args); pass_b_super(X, g, gtid, NT); }
            xcd_barrier(bar);
            { PHASE_IDS(); const Ctx X = make_ctx(args);
              for (int u = bx; u < NSC * 12; u += G) { const int sc = u / 12, hh = u % 12;
                if (hh < 4) pass_s_unit<false, true>(X, l, sc, hh, lds, tid, lane, wave); else pass_s_unit<true, true>(X, l, sc, hh - 4, lds, tid, lane, wave); } }
            xcd_barrier(bar);
            { PHASE_IDS(); const Ctx X = make_ctx(args);
              for (int u = bx; u < NCHUNK * 12; u += G) { const int c = u / 12, hh = u % 12;
                if (hh < 4) pass_c2_unit<false>(X, l, c, hh, lds, tid, lane, wave); else pass_c2_unit<true>(X, l, c, hh - 4, lds, tid, lane, wave); } }
            xcd_barrier(bar);
            }
            { const Ctx X = make_ctx(args); pg8::Gemm gm{X.O, X.Wout_t + (size_t)l * DM * DM, GM, DM, DM}; pg8::StaticOrder S; S.init(GM, DM, G, bx);
              pg8::EpiBf16<0> E{X.MF, DM};
              pg8::gemm_phase<pg8::EpiBf16<0>, pg8::StaticOrder, false, true>(lds, gm, S, E); }
            xcd_barrier(bar);
            { PHASE_IDS(); const Ctx X = make_ctx(args);
              if (l == 0) ln_phase<true, false>((g == 0) ? X.x_prompt : X.x_sample + (size_t)(g - 1) * GM * DM, X.MF, X.ln1_g, X.ln1_b, nullptr, X.HB, gw, NGW, lane);
              else ln_phase<false, false>(X.HB, X.MF, X.ln1_g + (size_t)l * DM, X.ln1_b + (size_t)l * DM, nullptr, X.HB, gw, NGW, lane); }
            xcd_barrier(bar);
            { const Ctx X = make_ctx(args); pg8::Gemm gm{X.HB, X.Wup_t + (size_t)l * DFF * DM, GM, DFF, DM}; pg8::StaticOrder S; S.init(GM, DFF, G, bx);
              pg8::EpiBf16<1> E{X.Z, DFF};
              pg8::gemm_phase<pg8::EpiBf16<1>, pg8::StaticOrder, false, true>(lds, gm, S, E); }
            xcd_barrier(bar);
            { const Ctx X = make_ctx(args); pg8::Gemm gm{X.Z, X.Wdn_t + (size_t)l * DM * DFF, GM, DM, DFF}; pg8::StaticOrder S; S.init(GM, DM, G, bx);
              pg8::EpiBf16<0> E{X.MF, DM};
              pg8::gemm_phase<pg8::EpiBf16<0>, pg8::StaticOrder, false, true>(lds, gm, S, E); }
            xcd_barrier(bar);
            { PHASE_IDS(); const Ctx X = make_ctx(args);
              if (l == NLAYER - 1) ln_phase<false, true>(X.HB, X.MF, X.ln2_g + (size_t)l * DM, X.ln2_b + (size_t)l * DM, X.out + (size_t)g * GM * DM, nullptr, gw, NGW, lane);
              else ln_phase<false, false>(X.HB, X.MF, X.ln2_g + (size_t)l * DM, X.ln2_b + (size_t)l * DM, nullptr, X.HB, gw, NGW, lane); }
            xcd_barrier(bar);
        }
    }
}

extern "C" void kernel_launch(void* const* d_in, const int* in_sizes, int n_in, void* d_out, int out_size, void* d_ws, size_t ws_size, hipStream_t stream) {
    static int grid = 0;
    if (grid == 0) {
        if (n_in != 15 || out_size != NTOK * DM || ws_size < WS_END) { fprintf(stderr, "kernel_launch: unexpected shapes (n_in %d, out %d, ws %zu)\n", n_in, out_size, ws_size); grid = -1; return; }
        int dev = 0, cus = 0;
        if (hipGetDevice(&dev) != hipSuccess || hipDeviceGetAttribute(&cus, hipDeviceAttributeMultiprocessorCount, dev) != hipSuccess) { grid = -1; return; }
        if (hipFuncSetAttribute((const void*)fwd_kernel, hipFuncAttributeMaxDynamicSharedMemorySize, LDS_BYTES) != hipSuccess) { fprintf(stderr, "kernel_launch: hipFuncSetAttribute failed\n"); grid = -1; return; }
        int per_cu = 0;
        if (hipOccupancyMaxActiveBlocksPerMultiprocessor(&per_cu, (const void*)fwd_kernel, NWAVES * 64, LDS_BYTES) != hipSuccess || per_cu < 1) { fprintf(stderr, "kernel_launch: occupancy query says %d\n", per_cu); }
        (void)hipGetLastError();
        grid = cus;
    }
    if (grid < 0) return;
    if (hipMemsetAsync((char*)d_ws + WS_CTL, 0, CTL_ZERO_BYTES, stream) != hipSuccess) return;
    Args a{};
    for (int i = 0; i < 15; ++i) a.in[i] = (const float*)d_in[i];
    a.out = (float*)d_out; a.ws = (unsigned char*)d_ws; a.mode = KMODE; a.pad = 0;
    hipLaunchKernelGGL(fwd_kernel, dim3(grid), dim3(NWAVES * 64), LDS_BYTES, stream, a);
}
```

```cpp
#include <hip/hip_runtime.h>
#include <cstdio>
#include <cstdint>
#ifndef KMODE
#define KMODE 0
#endif
namespace pg8 {
#define PG8_LAS __attribute__((address_space(3)))
typedef unsigned short bf16_t;
typedef short bf16x8 __attribute__((ext_vector_type(8)));
typedef float f32x4 __attribute__((ext_vector_type(4)));
typedef unsigned u32x4 __attribute__((ext_vector_type(4)));
constexpr int BM = 256, BK = 64, HALF = 128, HTB = HALF * BK * 2  , STAGE_BYTES = 8 * HTB, NXCD = 8, WGM = 4;

__host__ __device__ __forceinline__ int lds_byte(int r, int c) { const int st = (r >> 4) * 2 + (c >> 5), rr = r & 15, cc = c & 31, ob = rr * 64 + cc * 2; return st * 1024 + (ob ^ (((ob >> 9) & 1) << 5)); }
__host__ __device__ __forceinline__ void stage_rc(int b, int& R, int& C) { const int st = b / 1024, sb = b % 1024, swz = sb ^ (((sb >> 9) & 1) << 5); R = (st >> 1) * 16 + swz / 64; C = (st & 1) * 32 + (swz % 64) / 2; }
__host__ __device__ __forceinline__ int perm32(int rho) { const int n = rho >> 4, i = rho & 15; return 8 * (i >> 2) + 4 * n + (i & 3); }

struct Unit { int pm, pn; };
struct Gemm { const bf16_t* A; const bf16_t* Bt; int M, N, K; };

struct StaticOrder {
    int nM, nN, nwg, G, c;
    __host__ __device__ void init(int M, int N, int G_, int c_) { nM = M / BM; nN = N / BM; nwg = nM * nN; G = G_; c = c_; }
    __host__ __device__ bool next(int i, Unit& u) const {
        const long L = (long)i * G + c; if (L >= nwg) return false;
        int wgid = (int)L; { const int q = nwg / NXCD, r = nwg % NXCD, xcd = wgid % NXCD, off = wgid / NXCD; wgid = (xcd < r ? xcd * (q + 1) : r * (q + 1) + (xcd - r) * q) + off; }
        const int nig = WGM * nN, gid = wgid / nig, fm = gid * WGM, gsz = (nM - fm) < WGM ? (nM - fm) : WGM;
        u.pm = fm + ((wgid % nig) % gsz); u.pn = (wgid % nig) / gsz; return true;
    }
    __device__ __forceinline__ void a_ready(const Unit&) const {}
    __device__ __forceinline__ void done(const Unit&) const {}
};


__device__ __forceinline__ unsigned cvt_pk_bf16(float lo, float hi) { unsigned r; asm volatile("v_cvt_pk_bf16_f32 %0, %1, %2" : "=v"(r) : "v"(lo), "v"(hi)); return r; }

template <int ACT  > struct EpiBf16 {
    static constexpr bool PERM = true, AFTER_DRAIN = false;
    bf16_t* O; int ldc;
    __device__ __forceinline__ void operator()(const f32x4 (&acc)[2][2][4][2], const Unit& u, int wr, int wc, int fr, int fq) const {
        const int row0 = u.pm * BM + wr * 64 + fr; const int col0 = u.pn * BM + wc * 32 + 8 * fq;
#pragma unroll
        for (int ai = 0; ai < 2; ++ai)
#pragma unroll
            for (int m = 0; m < 4; ++m) { bf16_t* rowp = O + (size_t)(row0 + ai * HALF + m * 16) * ldc + col0;
#pragma unroll
                for (int bj = 0; bj < 2; ++bj) { f32x4 v0 = acc[ai][bj][m][0], v1 = acc[ai][bj][m][1];
                    if (ACT == 1) {
#pragma unroll
                        for (int j = 0; j < 4; ++j) { const float a = fmaxf(v0[j], 0.f), b = fmaxf(v1[j], 0.f); v0[j] = a * a; v1[j] = b * b; } }
                    u32x4 w; w.x = cvt_pk_bf16(v0[0], v0[1]); w.y = cvt_pk_bf16(v0[2], v0[3]); w.z = cvt_pk_bf16(v1[0], v1[1]); w.w = cvt_pk_bf16(v1[2], v1[3]);
                    *(u32x4*)(rowp + bj * HALF) = w; } }
    }
};
struct EpiF32 {
    static constexpr bool PERM = false, AFTER_DRAIN = false;
    float* C; int ldc;
    __device__ __forceinline__ void operator()(const f32x4 (&acc)[2][2][4][2], const Unit& u, int wr, int wc, int fr, int fq) const {
        const int row0 = u.pm * BM + wr * 64 + fr, col0 = u.pn * BM + wc * 32 + 4 * fq;
#pragma unroll
        for (int ai = 0; ai < 2; ++ai)
#pragma unroll
            for (int m = 0; m < 4; ++m) { float* rowp = C + (size_t)(row0 + ai * HALF + m * 16) * ldc + col0;
#pragma unroll
                for (int bj = 0; bj < 2; ++bj)
#pragma unroll
                    for (int n = 0; n < 2; ++n) *(f32x4*)(rowp + bj * HALF + n * 16) = acc[ai][bj][m][n]; }
    }
};

struct EpiZ {
    static constexpr bool PERM = true, AFTER_DRAIN = false;
    bf16_t* Z;
    __device__ __forceinline__ void operator()(const f32x4 (&acc)[2][2][4][2], const Unit& u, int wr, int wc, int fr, int fq) const {
        const int pn = u.pn; const size_t Mr = 16384;
        bool blocked; int H = 4, c0; bf16_t* base;
        if (pn < 2) { blocked = true; H = 4; base = Z + Mr * 4096; c0 = pn * 256; }
        else if (pn < 4) { blocked = true; H = 4; base = Z + Mr * 4096 + Mr * 512; c0 = (pn - 2) * 256; }
        else if (pn < 8) { blocked = false; base = Z; c0 = (pn - 4) * 256; }
        else if (pn < 12) { blocked = false; base = Z; c0 = 1024 + (pn - 8) * 256; }
        else if (pn < 24) { blocked = true; H = 8; base = Z + Mr * 4096 + Mr * 1024 + (size_t)((pn - 12) >> 2) * Mr * 1024; c0 = ((pn - 12) & 3) * 256; }
        else if (pn < 28) { blocked = false; base = Z; c0 = 2048 + (pn - 24) * 256; }
        else { blocked = false; base = Z; c0 = 3072 + (pn - 28) * 256; }
        const int row0 = u.pm * BM + wr * 64 + fr, cl = c0 + wc * 32 + 8 * fq;
#pragma unroll
        for (int ai = 0; ai < 2; ++ai)
#pragma unroll
            for (int m = 0; m < 4; ++m) { const int row = row0 + ai * HALF + m * 16;
#pragma unroll
                for (int bj = 0; bj < 2; ++bj) { const f32x4 v0 = acc[ai][bj][m][0], v1 = acc[ai][bj][m][1]; const int c = cl + bj * HALF;
                    u32x4 w; w.x = cvt_pk_bf16(v0[0], v0[1]); w.y = cvt_pk_bf16(v0[2], v0[3]); w.z = cvt_pk_bf16(v1[0], v1[1]); w.w = cvt_pk_bf16(v1[2], v1[3]);
                    bf16_t* p = blocked ? base + ((size_t)((((row >> 6) * H + (c >> 7)) * 8 + ((c >> 4) & 7)) * 64 + (row & 63))) * 16 + (c & 15)
                                        : base + (size_t)row * 4096 + c;
                    *(u32x4*)p = w; } }
    }
};

template <class Epi, class Sched, bool ALIGN_EPI = false, bool SP2 = false>
__device__ __forceinline__ void gemm_phase(PG8_LAS unsigned char* lds, const Gemm g, const Sched& S, const Epi& E) {
    int tid_o = threadIdx.x; asm volatile("" : "+v"(tid_o));
    const int tid = tid_o, wid = __builtin_amdgcn_readfirstlane(tid >> 6), lane = tid & 63, wr = wid >> 2, wc = wid & 3, fr = lane & 15, fq = lane >> 4;
    const int K = g.K, nt = K / BK;
    unsigned voffA[2], voffB[2];
#pragma unroll
    for (int i = 0; i < 2; ++i) { int R, C; stage_rc(tid * 16 + i * 8192, R, C); const int Rb = Epi::PERM ? ((R & ~31) + perm32(R & 31)) : R;
        voffA[i] = (unsigned)(R * K + C) * 2u; voffB[i] = (unsigned)(Rb * K + C) * 2u; }
    const size_t kstep = (size_t)(BK * 2);
    const size_t hstep = (size_t)HALF * K * 2;
    const size_t tstep = 2 * hstep;
    const unsigned ldsw = (unsigned)wid * 1024u;
    const int aoff = lds_byte(wr * 64 + fr, fq * 8), boff = lds_byte(wc * 32 + fr, fq * 8);
#define PG8_SA(b, h) (((b) * 2 + (h)) * HTB)
#define PG8_SB(b, h) ((4 + (b) * 2 + (h)) * HTB)
#define PG8_STAGE(bufoff, gbase, voff) do { _Pragma("unroll") for (int _i = 0; _i < 2; ++_i) \
        __builtin_amdgcn_global_load_lds((const unsigned*)((const char*)(gbase) + (voff)[_i]), (PG8_LAS unsigned*)(lds + (bufoff) + ldsw + _i * 8192), 16, 0, 0); } while (0)
#define PG8_LDA(dst, b, h) do { _Pragma("unroll") for (int m = 0; m < 4; ++m) _Pragma("unroll") for (int k = 0; k < 2; ++k) dst[m][k] = *(const PG8_LAS bf16x8*)(lds + PG8_SA(b, h) + aoff + m * 2048 + k * 1024); } while (0)
#define PG8_LDB(dst, b, h) do { _Pragma("unroll") for (int n = 0; n < 2; ++n) _Pragma("unroll") for (int k = 0; k < 2; ++k) dst[n][k] = *(const PG8_LAS bf16x8*)(lds + PG8_SB(b, h) + boff + n * 2048 + k * 1024); } while (0)
#define PG8_MMA(ai, bj, At, Bt) do { __builtin_amdgcn_s_setprio(1); _Pragma("unroll") for (int m = 0; m < 4; ++m) _Pragma("unroll") for (int n = 0; n < 2; ++n) _Pragma("unroll") for (int k = 0; k < 2; ++k) \
        acc[ai][bj][m][n] = __builtin_amdgcn_mfma_f32_16x16x32_bf16(Bt[n][k], At[m][k], acc[ai][bj][m][n], 0, 0, 0); __builtin_amdgcn_s_setprio(0); } while (0)
#define PG8_WAIT_V(n) asm volatile("s_waitcnt vmcnt(" #n ")" ::: "memory")
#define PG8_WAIT_L(n) asm volatile("s_waitcnt lgkmcnt(" #n ")" ::: "memory")
#define PG8_BAR __builtin_amdgcn_s_barrier()
#define PG8_SCHED __builtin_amdgcn_sched_barrier(0)
    Unit cur, nxt; int ui = 0;
    if (!S.next(0, cur)) return;
    f32x4 acc[2][2][4][2];
#pragma unroll
    for (int a = 0; a < 2; ++a)
#pragma unroll
        for (int b = 0; b < 2; ++b)
#pragma unroll
            for (int m = 0; m < 4; ++m)
#pragma unroll
                for (int n = 0; n < 2; ++n) acc[a][b][m][n] = (f32x4){0.f, 0.f, 0.f, 0.f};
    bf16x8 At[4][2], B0[2][2], B1[2][2];
    const char* cA = (const char*)g.A + (size_t)cur.pm * tstep; const char* cB = (const char*)g.Bt + (size_t)cur.pn * tstep;
    S.a_ready(cur);
    if constexpr (SP2) {
        PG8_STAGE(PG8_SB(0, 0), cB, voffB); PG8_STAGE(PG8_SB(0, 1), cB + hstep, voffB); PG8_STAGE(PG8_SA(0, 0), cA, voffA); PG8_STAGE(PG8_SA(0, 1), cA + hstep, voffA);
        if (wr == 1) PG8_BAR;
        PG8_WAIT_V(2); PG8_BAR;
        PG8_STAGE(PG8_SB(1, 0), cB + kstep, voffB); PG8_STAGE(PG8_SA(1, 0), cA + kstep, voffA); PG8_STAGE(PG8_SB(1, 1), cB + hstep + kstep, voffB);
        PG8_WAIT_V(6); PG8_BAR;
    } else {
        PG8_STAGE(PG8_SB(0, 0), cB, voffB); PG8_STAGE(PG8_SA(0, 0), cA, voffA); PG8_STAGE(PG8_SB(0, 1), cB + hstep, voffB); PG8_STAGE(PG8_SA(0, 1), cA + hstep, voffA);
        if (wr == 1) PG8_BAR;
        PG8_WAIT_V(4); PG8_BAR;
        PG8_STAGE(PG8_SB(1, 0), cB + kstep, voffB); PG8_STAGE(PG8_SA(1, 0), cA + kstep, voffA); PG8_STAGE(PG8_SB(1, 1), cB + hstep + kstep, voffB);
        PG8_WAIT_V(6); PG8_BAR;
    }
    for (;;) {
        const bool has_next = S.next(ui + 1, nxt);
        const char* nA = has_next ? (const char*)g.A + (size_t)nxt.pm * tstep : cA; const char* nB = has_next ? (const char*)g.Bt + (size_t)nxt.pn * tstep : cB;
        for (int t = 0; t < nt; t += 2) {
            const bool last = (t == nt - 2);
            const char* a1 = cA + (size_t)(t + 1) * kstep;
            const char* a2 = last ? nA : cA + (size_t)(t + 2) * kstep; const char* b2 = last ? nB : cB + (size_t)(t + 2) * kstep;
            const char* a3 = a2 + kstep; const char* b3 = b2 + kstep;
            if (last && has_next) S.a_ready(nxt);
            if constexpr (SP2) {
            PG8_LDB(B0, 0, 0); PG8_LDB(B1, 0, 1); PG8_SCHED; PG8_LDA(At, 0, 0); PG8_STAGE(PG8_SA(1, 1), a1 + hstep, voffA);
            PG8_WAIT_V(8); PG8_WAIT_L(0); PG8_BAR; PG8_MMA(0, 0, At, B0); PG8_MMA(0, 1, At, B1); PG8_BAR; PG8_SCHED;
            PG8_LDA(At, 0, 1); PG8_STAGE(PG8_SB(0, 0), b2, voffB); PG8_STAGE(PG8_SB(0, 1), b2 + hstep, voffB); PG8_STAGE(PG8_SA(0, 0), a2, voffA);
            PG8_WAIT_V(8); PG8_WAIT_L(0); PG8_BAR; PG8_MMA(1, 0, At, B0); PG8_MMA(1, 1, At, B1); PG8_BAR; PG8_SCHED;
            PG8_LDB(B0, 1, 0); PG8_LDB(B1, 1, 1); PG8_SCHED; PG8_LDA(At, 1, 0); PG8_STAGE(PG8_SA(0, 1), a2 + hstep, voffA);
            PG8_WAIT_V(8); PG8_WAIT_L(0); PG8_BAR; PG8_MMA(0, 0, At, B0); PG8_MMA(0, 1, At, B1); PG8_BAR; PG8_SCHED;
            PG8_LDA(At, 1, 1); PG8_STAGE(PG8_SB(1, 0), b3, voffB); PG8_STAGE(PG8_SB(1, 1), b3 + hstep, voffB); PG8_STAGE(PG8_SA(1, 0), a3, voffA);
            PG8_WAIT_V(8); PG8_WAIT_L(0); PG8_BAR; PG8_MMA(1, 0, At, B0); PG8_MMA(1, 1, At, B1); PG8_BAR; PG8_SCHED;
            } else {
            PG8_LDB(B0, 0, 0); PG8_SCHED; PG8_LDA(At, 0, 0); PG8_STAGE(PG8_SA(1, 1), a1 + hstep, voffA);
            PG8_WAIT_L(8); PG8_BAR; PG8_WAIT_L(0); PG8_MMA(0, 0, At, B0); PG8_BAR; PG8_SCHED;
            PG8_LDB(B1, 0, 1); PG8_STAGE(PG8_SB(0, 0), b2, voffB);
            PG8_BAR; PG8_WAIT_L(0); PG8_MMA(0, 1, At, B1); PG8_BAR;
            PG8_LDA(At, 0, 1); PG8_STAGE(PG8_SA(0, 0), a2, voffA);
            PG8_BAR; PG8_WAIT_L(0); PG8_MMA(1, 0, At, B0); PG8_BAR; PG8_SCHED;
            PG8_STAGE(PG8_SB(0, 1), b2 + hstep, voffB);
            PG8_WAIT_V(6); PG8_BAR; PG8_MMA(1, 1, At, B1); PG8_BAR;
            PG8_LDB(B0, 1, 0); PG8_SCHED; PG8_LDA(At, 1, 0); PG8_STAGE(PG8_SA(0, 1), a2 + hstep, voffA);
            PG8_WAIT_L(8); PG8_BAR; PG8_WAIT_L(0); PG8_MMA(0, 0, At, B0); PG8_BAR; PG8_SCHED;
            PG8_LDB(B1, 1, 1); PG8_STAGE(PG8_SB(1, 0), b3, voffB);
            PG8_BAR; PG8_WAIT_L(0); PG8_MMA(0, 1, At, B1); PG8_BAR;
            PG8_LDA(At, 1, 1); PG8_STAGE(PG8_SA(1, 0), a3, voffA);
            PG8_BAR; PG8_WAIT_L(0); PG8_MMA(1, 0, At, B0); PG8_BAR; PG8_SCHED;
            PG8_STAGE(PG8_SB(1, 1), b3 + hstep, voffB);
            PG8_WAIT_V(6); PG8_BAR; PG8_MMA(1, 1, At, B1); PG8_BAR;
            }
        }
        if constexpr (ALIGN_EPI) { if (wr == 0) PG8_BAR; }
        if constexpr (!Epi::AFTER_DRAIN) { E(acc, cur, wr, wc, fr, fq); S.done(cur); }
        if (!has_next) break;
#pragma unroll
        for (int a = 0; a < 2; ++a)
#pragma unroll
            for (int b = 0; b < 2; ++b)
#pragma unroll
                for (int m = 0; m < 4; ++m)
#pragma unroll
                    for (int n = 0; n < 2; ++n) acc[a][b][m][n] = (f32x4){0.f, 0.f, 0.f, 0.f};
        cur = nxt; cA = nA; cB = nB; ++ui;
        if constexpr (ALIGN_EPI) { if (wr == 1) PG8_BAR; }
    }
    PG8_WAIT_V(0);
    if constexpr (!ALIGN_EPI) { if (wr == 0) PG8_BAR; }
    PG8_BAR;
    if constexpr (Epi::AFTER_DRAIN) { E.fused(acc, cur, wr, wc, fr, fq, lds, wid, lane); S.done(cur); }
#undef PG8_SA
#undef PG8_SB
#undef PG8_STAGE
#undef PG8_LDA
#undef PG8_LDB
#undef PG8_MMA
#undef PG8_WAIT_V
#undef PG8_WAIT_L
#undef PG8_BAR
#undef PG8_SCHED
}
}

constexpr int NWAVES = 8;
constexpr int DM = 2048, DFF = 8192, NTOK = 49152, GM = 16384, NGRP = 3, NLAYER = 2, INW = 8224, ZW = 8192;
constexpr int ZC_GQ = 0, ZC_GK = 512, ZC_GV = 1024, ZC_GOG = 2048, ZC_HQ = 3072, ZC_HFF = 4096, ZC_HFB = 5120, ZC_HI = 6144, ZC_HOG = 7168;
constexpr float LN_EPS = 1e-5f, RMS_EPS = 1e-6f, ALPHA = 1.41421356237f, LOG2E = 1.44269504089f;
constexpr int NCHUNK = GM / 64;
constexpr int ST_CHUNK = 524288;
constexpr size_t MiB = 1u << 20;
constexpr size_t WS_CTL = 0, CTL_ZERO_BYTES = 1 * MiB;
constexpr size_t WS_WIN = 2 * MiB, WS_WOUT = 66 * MiB, WS_WUP = 82 * MiB, WS_WDN = 146 * MiB, WS_WGLR = 210 * MiB;
constexpr size_t WS_HB = 212 * MiB;
constexpr size_t WS_Z = 276 * MiB;
constexpr size_t WS_BG = 532 * MiB;
constexpr size_t WS_O = 596 * MiB;
constexpr size_t WS_ST = 660 * MiB;
constexpr size_t WS_TOT = 916 * MiB;
constexpr size_t WS_STS = 920 * MiB;
constexpr size_t WS_TOTS = 984 * MiB;
constexpr size_t WS_END = 985 * MiB;
constexpr int CW_BAR = 4096;
constexpr int RING_BYTES = 131072;
constexpr int LDS_BYTES = 160 * 1024, MISC_OFF = LDS_BYTES - 256;
constexpr int L_B32 = 0, L_KR = 33792, L_QR = 51200, L_QH = 68608, L_V = 86016, L_P = 119808, L_RED = 129024;
constexpr int B32_STR = 528, K_STR = 272, P_STR = 144, KT_STR = 144;
constexpr int NSC = GM / 256;
constexpr int SV_KT = 135168, KTW_BYTES = 2560;

#define GAS __attribute__((address_space(1)))
#define LAS __attribute__((address_space(3)))
typedef unsigned short bf16;
typedef unsigned v4u __attribute__((ext_vector_type(4)));
typedef float f32x4 __attribute__((ext_vector_type(4)));
typedef short bf16x8 __attribute__((ext_vector_type(8)));
typedef GAS unsigned gu32;
typedef GAS unsigned long long gu64;
#define RLX_AGENT __ATOMIC_RELAXED, __HIP_MEMORY_SCOPE_AGENT
#define LDS_WAIT() asm volatile("s_waitcnt lgkmcnt(0)" ::: "memory")
#define VM_WAIT() asm volatile("s_waitcnt vmcnt(0)" ::: "memory")
__device__ __forceinline__ unsigned long long rt() { return __builtin_amdgcn_s_memrealtime(); }
__device__ __forceinline__ unsigned f2bf(float f) { unsigned u = __builtin_bit_cast(unsigned, f); return (u + 0x7fffu + ((u >> 16) & 1u)) >> 16; }
__device__ __forceinline__ unsigned pk2(float lo, float hi) { return f2bf(lo) | (f2bf(hi) << 16); }

#define XB_TMO      128
#define XB_XCNT(j)  (256  + 64 * (j))
#define XB_XSUB(j)  (1280 + 64 * (j))
#define XB_XGEN(j)  (2304 + 64 * (j))
#define XB_TOP      3328
#define XB_TOPGEN   3392
#define XCD_BAR_WORDS 3456
#define XB_SPIN_CAP (1u << 18)

__device__ __forceinline__ unsigned xb_ld(unsigned* p)              { return __hip_atomic_load(p, __ATOMIC_RELAXED, __HIP_MEMORY_SCOPE_AGENT); }
__device__ __forceinline__ unsigned xb_add(unsigned* p, unsigned v) { return __hip_atomic_fetch_add(p, v, __ATOMIC_RELAXED, __HIP_MEMORY_SCOPE_AGENT); }
__device__ __forceinline__ unsigned xb_xcc_id() { return (unsigned)__builtin_amdgcn_s_getreg((3 << 11) | 20) & 0xFu; }
#define XB_SPIN(cond, bar) do { unsigned _sp = 0; while (cond) { __builtin_amdgcn_s_sleep(1); \
    if ((++_sp & 255u) == 0u) { if (xb_ld(&(bar)[XB_TMO])) break; if (_sp > XB_SPIN_CAP) { atomicAdd(&(bar)[XB_TMO], 1u); break; } } } } while (0)

struct XcdBarrier {
    unsigned* bar; unsigned x;
    volatile LAS unsigned* st;
};

__device__ __forceinline__ XcdBarrier xcd_barrier_post(unsigned* bar, volatile LAS unsigned* st) {
    XcdBarrier b; b.bar = bar; b.x = xb_xcc_id(); b.st = st;
    if (threadIdx.x == 0) (void)xb_add(&bar[XB_XCNT(b.x)], 1u);
    return b;
}
__device__ __forceinline__ void xcd_barrier_complete(unsigned* bar, unsigned x, unsigned& nloc, unsigned& nx) {
    const unsigned G = gridDim.x * gridDim.y * gridDim.z;
    unsigned sum, cnt, mine, sp = 0u;
    for (;;) {
        sum = 0u; cnt = 0u; mine = 0u;
#pragma unroll
        for (unsigned j = 0; j < 16; ++j) { const unsigned c = xb_ld(&bar[XB_XCNT(j)]); sum += c; cnt += (c > 0u) ? 1u : 0u; mine = (j == x) ? c : mine; }
        if (sum == G) break;
        __builtin_amdgcn_s_sleep(1);
        if ((++sp & 255u) == 0u) { if (xb_ld(&bar[XB_TMO])) break; if (sp > XB_SPIN_CAP) { atomicAdd(&bar[XB_TMO], 1u); break; } }
    }
    nloc = mine > 0u ? mine : 1u; nx = cnt > 0u ? cnt : 1u;
}

__device__ __forceinline__ void xcd_barrier(const XcdBarrier& b) {
    asm volatile("s_waitcnt vmcnt(0)" ::: "memory");
    __syncthreads();
    if (threadIdx.x == 0) {
        unsigned* bar = b.bar;
        __builtin_amdgcn_s_waitcnt(0);
        unsigned nloc = b.st[0], nx = b.st[1];
        if (nloc == 0u) { xcd_barrier_complete(bar, b.x, nloc, nx); b.st[0] = nloc; b.st[1] = nx; }
        const unsigned old = xb_add(&bar[XB_XSUB(b.x)], 1u);
        const unsigned gen = old / nloc;
        if (old + 1u == (gen + 1u) * nloc) {
            __builtin_amdgcn_fence(__ATOMIC_RELEASE, "agent");
            asm volatile("s_waitcnt vmcnt(0)" ::: "memory");
            const unsigned og = xb_add(&bar[XB_TOP], 1u);
            const unsigned tg = og / nx;
            if (og + 1u == (tg + 1u) * nx) xb_add(&bar[XB_TOPGEN], 1u);
            else XB_SPIN(xb_ld(&bar[XB_TOPGEN]) == tg, bar);
            __builtin_amdgcn_fence(__ATOMIC_ACQUIRE, "agent");
            xb_add(&bar[XB_XGEN(b.x)], 1u);
            asm volatile("s_waitcnt vmcnt(0)" ::: "memory");
        } else {
            XB_SPIN(xb_ld(&bar[XB_XGEN(b.x)]) == gen, bar);
            __builtin_amdgcn_fence(__ATOMIC_ACQUIRE, "agent");
            asm volatile("s_waitcnt vmcnt(0)" ::: "memory");
        }
    }
    __syncthreads();
}

typedef short s16x4 __attribute__((ext_vector_type(4)));
typedef float f32x2 __attribute__((ext_vector_type(2)));
typedef unsigned v2u __attribute__((ext_vector_type(2)));
__device__ __forceinline__ unsigned pkbf(float lo, float hi) { return pg8::cvt_pk_bf16(lo, hi); }
__device__ __forceinline__ float wave_sum(float v) {
#pragma unroll
    for (int o = 1; o < 64; o <<= 1) v += __shfl_xor(v, o);
    return v;
}
template <int CTRL, int RM> __device__ __forceinline__ float dpp_add(float v) {
    return v + __builtin_bit_cast(float, __builtin_amdgcn_update_dpp(0, __builtin_bit_cast(int, v), CTRL, RM, 0xf, true));
}
__device__ __forceinline__ float wave_scan_incl(float v, int) {
    v = dpp_add<0x111, 0xf>(v); v = dpp_add<0x112, 0xf>(v); v = dpp_add<0x114, 0xf>(v); v = dpp_add<0x118, 0xf>(v);
    v = dpp_add<0x142, 0xa>(v); v = dpp_add<0x143, 0xc>(v); return v;
}
template <int CTRL, int RM> __device__ __forceinline__ void dpp_add16(float* v) {
#pragma unroll
    for (int i = 0; i < 16; ++i) v[i] = dpp_add<CTRL, RM>(v[i]);
}
__device__ __forceinline__ void wave_scan16(float* v) {
    dpp_add16<0x111, 0xf>(v); dpp_add16<0x112, 0xf>(v); dpp_add16<0x114, 0xf>(v); dpp_add16<0x118, 0xf>(v); dpp_add16<0x142, 0xa>(v); dpp_add16<0x143, 0xc>(v);
}
__device__ __forceinline__ void unpack8(const v4u v, float* f) {
    f[0] = __uint_as_float(v.x << 16); f[1] = __uint_as_float(v.x & 0xffff0000u); f[2] = __uint_as_float(v.y << 16); f[3] = __uint_as_float(v.y & 0xffff0000u);
    f[4] = __uint_as_float(v.z << 16); f[5] = __uint_as_float(v.z & 0xffff0000u); f[6] = __uint_as_float(v.w << 16); f[7] = __uint_as_float(v.w & 0xffff0000u);
}
__device__ __forceinline__ v4u pack8(const float* f) { v4u o; o.x = pkbf(f[0], f[1]); o.y = pkbf(f[2], f[3]); o.z = pkbf(f[4], f[5]); o.w = pkbf(f[6], f[7]); return o; }
__device__ __forceinline__ s16x4 lds_tr(LAS const unsigned char* p) { return __builtin_bit_cast(s16x4, __builtin_amdgcn_ds_read_tr16_b64_v4i16((LAS s16x4*)p)); }
__device__ __forceinline__ bf16x8 tr_pair(LAS const unsigned char* p0, LAS const unsigned char* p1) {
    const s16x4 a = lds_tr(p0), b = lds_tr(p1); return __builtin_shufflevector(a, b, 0, 1, 2, 3, 4, 5, 6, 7);
}
__device__ __forceinline__ float fexp2(float x) { return __builtin_amdgcn_exp2f(x); }
__device__ __forceinline__ float flog2(float x) { return __builtin_amdgcn_logf(x); }

constexpr size_t ZB_GQ = (size_t)GM * 4096, ZB_GK = ZB_GQ + (size_t)GM * 512, ZB_HQ = ZB_GK + (size_t)GM * 512, ZB_HFF = ZB_HQ + (size_t)GM * 1024, ZB_HFB = ZB_HFF + (size_t)GM * 1024;
constexpr int ZRW = 4096, ZR_GV = 0, ZR_GOG = 1024, ZR_HI = 2048, ZR_HOG = 3072;
__device__ __forceinline__ size_t blk_off(int chunk, int H, int hh, int w) { return (size_t)((chunk * H + hh) * 8 + w) * 1024; }
struct Ctx {
    const float *x_prompt, *x_sample, *w_in, *w_lr2, *b_lr, *gla_g, *hg_g, *lowb, *w_out, *ln1_g, *ln1_b, *w_up, *w_down, *ln2_g, *ln2_b;
    float* out;
    bf16 *Win_t, *Wout_t, *Wup_t, *Wdn_t, *Wglr_t, *HB, *Z, *O, *ST;
    float *BG, *TOT, *TOTS; bf16 *STS, *MF;
};

__device__ __forceinline__ void transpose_item(const float* W, int N, int kb, int nb, bf16* dst, int K, LAS float* scr, int lane) {
    const int k0 = 64 * kb, n0 = 32 * nb;
#pragma unroll 8
    for (int i = 0; i < 32; ++i) { const int kk = 2 * i + (lane >> 5); scr[kk * 33 + (lane & 31)] = W[(size_t)(k0 + kk) * N + n0 + (lane & 31)]; }
    LDS_WAIT(); asm volatile("" ::: "memory");
    const int c = lane & 7;
#pragma unroll
    for (int j = 0; j < 4; ++j) { const int n = (lane >> 3) + 8 * j; const LAS float* s = scr + (8 * c) * 33 + n;
        v4u o; o.x = pkbf(s[0 * 33], s[1 * 33]); o.y = pkbf(s[2 * 33], s[3 * 33]); o.z = pkbf(s[4 * 33], s[5 * 33]); o.w = pkbf(s[6 * 33], s[7 * 33]);
        *(GAS v4u*)(dst + (size_t)n * K + k0 + 8 * c) = o; }
    LDS_WAIT(); asm volatile("" ::: "memory");
}
__device__ __forceinline__ void prologue_weights(const Ctx& X, LAS unsigned char* lds, int gw, int NGW, int wave, int lane) {
    LAS float* scr = (LAS float*)(lds + wave * 16384);
    constexpr int I_IN = 32 * 257, I_OUT = 32 * 64, I_UP = 32 * 256, I_DN = 128 * 64, I_L = I_IN + I_OUT + I_UP + I_DN;
    for (int it = gw; it < NLAYER * I_L; it += NGW) {
        const int l = it / I_L; int r = it % I_L;
        if (r < I_IN) { const int kb = r / 257, nb = r % 257;
            bf16* dst = (nb < 96) ? X.Win_t + ((size_t)l * ZW + 32 * nb) * DM : (nb == 96) ? X.Wglr_t + (size_t)l * 32 * DM : X.Win_t + ((size_t)l * ZW + 32 * (nb - 1)) * DM;
            transpose_item(X.w_in + (size_t)l * DM * INW, INW, kb, nb, dst, DM, scr, lane); continue; }
        r -= I_IN;
        if (r < I_OUT) { const int kb = r / 64, nb = r % 64; transpose_item(X.w_out + (size_t)l * DM * DM, DM, kb, nb, X.Wout_t + ((size_t)l * DM + 32 * nb) * DM, DM, scr, lane); continue; }
        r -= I_OUT;
        if (r < I_UP) { const int kb = r / 256, nb = r % 256; transpose_item(X.w_up + (size_t)l * DM * DFF, DFF, kb, nb, X.Wup_t + ((size_t)l * DFF + 32 * nb) * DM, DM, scr, lane); continue; }
        r -= I_UP;
        { const int kb = r / 64, nb = r % 64; transpose_item(X.w_down + (size_t)l * DFF * DM, DM, kb, nb, X.Wdn_t + ((size_t)l * DM + 32 * nb) * DFF, DFF, scr, lane); }
    }
}
__device__ __forceinline__ void cvt_group(const float* xg, bf16* HB, int gtid, int NT) {
    for (int i = gtid; i < GM * DM / 8; i += NT) {
        const f32x4 a = ((const GAS f32x4*)xg)[2 * i], b = ((const GAS f32x4*)xg)[2 * i + 1];
        v4u o; o.x = pkbf(a.x, a.y); o.y = pkbf(a.z, a.w); o.z = pkbf(b.x, b.y); o.w = pkbf(b.z, b.w);
        ((GAS v4u*)HB)[i] = o; }
}
template <bool RES_F32, bool OUT_F32>
__device__ __forceinline__ void ln_phase(const void* res, const bf16* mf, const float* gam, const float* bet, float* H, bf16* HB, int gw, int NGW, int lane) {
    for (int m = gw; m < GM; m += NGW) {
        f32x4 v[8]; float s = 0.f;
        const GAS v2u* mr = (const GAS v2u*)(mf + (size_t)m * DM) + lane;
#pragma unroll
        for (int j = 0; j < 8; ++j) { f32x4 r;
            if (RES_F32) r = ((const GAS f32x4*)((const float*)res + (size_t)m * DM) + lane)[64 * j];
            else { const v2u w = ((const GAS v2u*)((const bf16*)res + (size_t)m * DM) + lane)[64 * j];
                r = (f32x4){__uint_as_float(w.x << 16), __uint_as_float(w.x & 0xffff0000u), __uint_as_float(w.y << 16), __uint_as_float(w.y & 0xffff0000u)}; }
            const v2u w = mr[64 * j];
            const f32x4 f = (f32x4){__uint_as_float(w.x << 16), __uint_as_float(w.x & 0xffff0000u), __uint_as_float(w.y << 16), __uint_as_float(w.y & 0xffff0000u)};
            v[j] = r * ALPHA + f; s += (v[j].x + v[j].y) + (v[j].z + v[j].w); }
        const float mean = wave_sum(s) * (1.f / DM); float s2 = 0.f;
#pragma unroll
        for (int j = 0; j < 8; ++j) { v[j] = v[j] - mean; s2 += (v[j].x * v[j].x + v[j].y * v[j].y) + (v[j].z * v[j].z + v[j].w * v[j].w); }
        const float rstd = 1.f / sqrtf(wave_sum(s2) * (1.f / DM) + LN_EPS);
#pragma unroll
        for (int j = 0; j < 8; ++j) { const f32x4 g4 = ((const GAS f32x4*)gam)[lane + 64 * j], b4 = ((const GAS f32x4*)bet)[lane + 64 * j];
            const f32x4 o = v[j] * rstd * g4 + b4;
            if (OUT_F32) ((GAS f32x4*)(H + (size_t)m * DM) + lane)[64 * j] = o;
            else { v2u w; w.x = pkbf(o.x, o.y); w.y = pkbf(o.z, o.w); ((GAS v2u*)(HB + (size_t)m * DM) + lane)[64 * j] = w; } }
    }
}

__device__ __forceinline__ void gate_unit(const Ctx& X, int l, int chunk, LAS unsigned char* lds, int tid, int lane, int wave) {
    const int fr = lane & 15, fq = lane >> 4;
    const bf16* A = X.HB + (size_t)chunk * 64 * DM; const bf16* Bw = X.Wglr_t + (size_t)l * 32 * DM;
    f32x4 acc[4][2];
#pragma unroll
    for (int m = 0; m < 4; ++m)
#pragma unroll
        for (int n = 0; n < 2; ++n) acc[m][n] = (f32x4){0.f, 0.f, 0.f, 0.f};
#pragma unroll 2
    for (int ks = 0; ks < 8; ++ks) { const int k0 = 256 * wave + 32 * ks + 8 * fq;
        bf16x8 a[4], b[2];
#pragma unroll
        for (int m = 0; m < 4; ++m) a[m] = *(const GAS bf16x8*)(A + (size_t)(16 * m + fr) * DM + k0);
#pragma unroll
        for (int n = 0; n < 2; ++n) b[n] = *(const GAS bf16x8*)(Bw + (size_t)(16 * n + fr) * DM + k0);
#pragma unroll
        for (int m = 0; m < 4; ++m)
#pragma unroll
            for (int n = 0; n < 2; ++n) acc[m][n] = __builtin_amdgcn_mfma_f32_16x16x32_bf16(a[m], b[n], acc[m][n], 0, 0, 0); }
    LAS float* part = (LAS float*)lds;
#pragma unroll
    for (int m = 0; m < 4; ++m)
#pragma unroll
        for (int n = 0; n < 2; ++n)
#pragma unroll
            for (int j = 0; j < 4; ++j) part[(wave * 64 + 16 * m + 4 * fq + j) * 33 + 16 * n + fr] = acc[m][n][j];
    __syncthreads();
    LAS float* glr = (LAS float*)(lds + 8 * 64 * 33 * 4);
#pragma unroll
    for (int k = 0; k < 4; ++k) { const int idx = tid + 512 * k, t = idx >> 5, n = idx & 31; float s = 0.f;
#pragma unroll
        for (int w = 0; w < 8; ++w) s += part[(w * 64 + t) * 33 + n];
        glr[t * 36 + n] = s; }
    __syncthreads();
    const int dir = wave >> 2;
    const float* w2 = X.w_lr2 + (size_t)(l * 2 + dir) * 16 * 512; const float* bl = X.b_lr + (size_t)(l * 2 + dir) * 512;
    for (int cb = 0; cb < 2; ++cb) { const int c = 128 * (wave & 3) + 64 * cb + lane;
        float w[16];
#pragma unroll
        for (int r = 0; r < 16; ++r) w[r] = w2[r * 512 + c];
        const float bias = bl[c]; float run = 0.f;
        float* bgcol = X.BG + ((size_t)(((chunk * 4 + (c >> 7)) * 8 + ((c & 127) >> 4)) * 2 + dir) * 64) * 16 + (c & 15);
#pragma unroll 4
        for (int tt = 0; tt < 64; ++tt) { const int t = dir ? 63 - tt : tt;
            const LAS f32x4* gr = (const LAS f32x4*)(glr + t * 36 + dir * 16); const f32x4 g0 = gr[0], g1 = gr[1], g2 = gr[2], g3 = gr[3];
            float pre = bias;
            pre += g0.x * w[0] + g0.y * w[1] + g0.z * w[2] + g0.w * w[3]; pre += g1.x * w[4] + g1.y * w[5] + g1.z * w[6] + g1.w * w[7];
            pre += g2.x * w[8] + g2.y * w[9] + g2.z * w[10] + g2.w * w[11]; pre += g3.x * w[12] + g3.y * w[13] + g3.z * w[14] + g3.w * w[15];
            run += (fminf(pre, 0.f) - __logf(1.f + __expf(-fabsf(pre)))) * (LOG2E / 16.f);
            bgcol[(size_t)t * 16] = run; } }
    __syncthreads();
}

__device__ __forceinline__ size_t st_slot(int chunk, bool hgt, int h, int dir) { return (size_t)chunk * ST_CHUNK + (hgt ? 262144 + (h * 2 + dir) * 16384 : (h * 2 + dir) * 32768); }

template <bool HGT> struct RawIn { f32x4 b[4]; v4u k[2]; };
template <> struct RawIn<true> { v4u k[2]; };
template <bool HGT>
__device__ __forceinline__ RawIn<HGT> pass_s_load(const Ctx& X, int chunk, int h, int dir, int lane, int c0) {
    RawIn<HGT> r; const int rt = dir ? 63 - lane : lane, w = c0 >> 4;
    if constexpr (!HGT) { const GAS f32x4* bg = (const GAS f32x4*)(X.BG + ((size_t)(((chunk * 4 + h) * 8 + w) * 2 + dir) * 64 + rt) * 16);
#pragma unroll
        for (int i = 0; i < 4; ++i) r.b[i] = bg[i];
        const GAS v4u* kp = (const GAS v4u*)(X.Z + ZB_GK + blk_off(chunk, 4, h, w) + rt * 16); r.k[0] = kp[0]; r.k[1] = kp[1];
    } else { const GAS v4u* zp = (const GAS v4u*)(X.Z + (dir ? ZB_HFB : ZB_HFF) + blk_off(chunk, 8, h, w) + rt * 16); r.k[0] = zp[0]; r.k[1] = zp[1]; }
    return r;
}
template <bool HGT, bool STORE>
__device__ __forceinline__ void pass_s_unit(const Ctx& X, int l, int sc, int h, LAS unsigned char* lds, int tid, int lane, int wave) {
    constexpr int DV = HGT ? 128 : 256, VSTR = DV * 2 + 16, NE = DV / 16, PPR = DV / 8, UNR_D = HGT ? 2 : 1, UNR_C = HGT ? 4 : 1;
    const int fr = lane & 15, fq = lane >> 4, qq = fr >> 2, p4 = fr & 3, c0 = 16 * wave;
    RawIn<HGT> cur = pass_s_load<HGT>(X, sc * 4, h, 0, lane, c0);
    RawIn<HGT> rq[HGT ? 4 : 1];
    { const int vcol = HGT ? ZR_HI + h * 128 : ZR_GV + h * 256;
#pragma unroll 4
      for (int k = 0; k < 256 * PPR / 512; ++k) { const int idx = tid + 512 * k, row = idx / PPR, pc = idx % PPR;
        const v4u v = *(const GAS v4u*)(X.Z + (size_t)(sc * 256 + row) * ZRW + vcol + pc * 8);
        *(LAS v4u*)(lds + row * VSTR + pc * 16) = v; } }
    __syncthreads();
    LAS unsigned char* kt = lds + SV_KT + wave * KTW_BYTES;
    for (int dir = 0; dir < 2; ++dir) {
        const int hd = HGT ? 8 + h * 2 + dir : h * 2 + dir;
        if constexpr (HGT) {
#pragma unroll
            for (int q4 = 0; q4 < 4; ++q4) rq[q4] = pass_s_load<HGT>(X, sc * 4 + (dir ? 3 - q4 : q4), h, dir, lane, c0); }
        float lbv[16];
        if (HGT) {
#pragma unroll
            for (int i = 0; i < 16; ++i) lbv[i] = 0.f;
            if (l != 0) { const float* lp = X.lowb + (size_t)dir * 2 * 1024 + h * 128 + c0;
#pragma unroll
                for (int i = 0; i < 16; ++i) lbv[i] = 1.f / (1.f + __expf(lp[i] - lp[1024 + i])); } }
        f32x4 acc[NE];
        if (STORE) { const bf16* sin = X.STS + st_slot(sc, HGT, h, dir);
#pragma unroll
            for (int et = 0; et < NE; ++et) { const v2u w = *(const GAS v2u*)(sin + (size_t)((et * 4 + (wave >> 1)) * 64 + fr + 16 * (2 * (wave & 1) + (fq >> 1))) * 8 + 4 * (fq & 1));
                acc[et] = (f32x4){__uint_as_float(w.x << 16), __uint_as_float(w.x & 0xffff0000u), __uint_as_float(w.y << 16), __uint_as_float(w.y & 0xffff0000u)}; }
        } else {
#pragma unroll
            for (int et = 0; et < NE; ++et) acc[et] = (f32x4){0.f, 0.f, 0.f, 0.f}; }
        float run[16];
#pragma unroll
        for (int i = 0; i < 16; ++i) run[i] = 0.f;
#pragma unroll UNR_C
        for (int cc = 0; cc < 4; ++cc) { const int ci = dir ? 3 - cc : cc, chunk = sc * 4 + ci;
            RawIn<HGT> nxt = cur;
            if constexpr (HGT) cur = rq[cc];
            else { if (cc < 3) nxt = pass_s_load<HGT>(X, sc * 4 + (dir ? 2 - cc : cc + 1), h, dir, lane, c0);
                   else if (dir == 0) nxt = pass_s_load<HGT>(X, sc * 4 + 3, h, 1, lane, c0); }
            float bc[16], kr[16];
            if constexpr (!HGT) {
#pragma unroll
                for (int i = 0; i < 4; ++i) { bc[4 * i] = cur.b[i].x; bc[4 * i + 1] = cur.b[i].y; bc[4 * i + 2] = cur.b[i].z; bc[4 * i + 3] = cur.b[i].w; }
                unpack8(cur.k[0], kr); unpack8(cur.k[1], kr + 8);
            } else {
                float zf[16]; unpack8(cur.k[0], zf); unpack8(cur.k[1], zf + 8);
#pragma unroll
                for (int i = 0; i < 16; ++i) {
                    const float z = fmaxf(zf[i], -80.f), e = __expf(-z), sig = 1.f / (1.f + e), oml = 1.f - lbv[i];
                    kr[i] = oml * e * sig;
                    bc[i] = flog2(lbv[i] + oml * sig); }
                wave_scan16(bc);
            }
            if (STORE) { bf16* slot = X.ST + st_slot(chunk, HGT, h, dir);
#pragma unroll
                for (int et = 0; et < NE; ++et) { v2u w; w.x = pkbf(acc[et][0], acc[et][1]); w.y = pkbf(acc[et][2], acc[et][3]);
                    *(GAS v2u*)(slot + (size_t)((et * 4 + (wave >> 1)) * 64 + fr + 16 * (2 * (wave & 1) + (fq >> 1))) * 8 + 4 * (fq & 1)) = w; }
                if (cc == 3) { cur = nxt; break; } }
            float kh[16];
#pragma unroll
            for (int i = 0; i < 16; ++i) { const float bl = __shfl(bc[i], 63); kh[i] = kr[i] * fexp2(bl - bc[i]); run[i] += bl; }
            { const v4u k0 = pack8(kh), k1 = pack8(kh + 8); const unsigned kw[8] = {k0.x, k0.y, k0.z, k0.w, k1.x, k1.y, k1.z, k1.w};
#pragma unroll
              for (int i = 0; i < 16; ++i) *(LAS unsigned short*)(kt + i * KT_STR + lane * 2) = (unsigned short)((i & 1) ? (kw[i >> 1] >> 16) : (kw[i >> 1] & 0xffffu)); }
            if (lane == 63) {
#pragma unroll
                for (int i = 0; i < 4; ++i) ((LAS f32x4*)(kt + 2304))[i] = (f32x4){bc[4 * i], bc[4 * i + 1], bc[4 * i + 2], bc[4 * i + 3]}; }
            asm volatile("s_waitcnt lgkmcnt(0)" ::: "memory");
            const f32x4 dl = *(const LAS f32x4*)(kt + 2304 + 16 * fq);
            const f32x4 dec = (f32x4){fexp2(dl.x), fexp2(dl.y), fexp2(dl.z), fexp2(dl.w)};
            bf16x8 afr[2];
#pragma unroll
            for (int ks = 0; ks < 2; ++ks) afr[ks] = *(const LAS bf16x8*)(kt + fr * KT_STR + (32 * ks + 8 * fq) * 2);
#pragma unroll
            for (int et = 0; et < NE; ++et) acc[et] = acc[et] * dec;
            { constexpr int NB = 2 * NE / 4;
              LAS const unsigned char* vb[2][2];
#pragma unroll
              for (int ks = 0; ks < 2; ++ks) { const int r0 = 32 * ks + 8 * fq + qq, r1 = r0 + 4;
                  vb[ks][0] = lds + (ci * 64 + (dir ? 63 - r0 : r0)) * VSTR + 8 * p4; vb[ks][1] = lds + (ci * 64 + (dir ? 63 - r1 : r1)) * VSTR + 8 * p4; }
              bf16x8 bb[2][4];
#pragma unroll
              for (int j = 0; j < 4; ++j) bb[0][j] = tr_pair(vb[0][0] + 32 * j, vb[0][1] + 32 * j);
#pragma unroll
              for (int b = 0; b < NB; ++b) {
                  if (b + 1 < NB) { const int ks1 = (b + 1) / (NE / 4), e1 = 4 * ((b + 1) % (NE / 4));
#pragma unroll
                      for (int j = 0; j < 4; ++j) bb[(b + 1) & 1][j] = tr_pair(vb[ks1][0] + 32 * (e1 + j), vb[ks1][1] + 32 * (e1 + j)); }
                  const int ks0 = b / (NE / 4), e0 = 4 * (b % (NE / 4));
#pragma unroll
                  for (int j = 0; j < 4; ++j) acc[e0 + j] = __builtin_amdgcn_mfma_f32_16x16x32_bf16(afr[ks0], bb[b & 1][j], acc[e0 + j], 0, 0, 0);
                  __builtin_amdgcn_sched_group_barrier(0x100, 8, 0); __builtin_amdgcn_sched_group_barrier(0x008, 4, 0); } }
            asm volatile("s_waitcnt lgkmcnt(0)" ::: "memory");
            cur = nxt;
        }
        if (!STORE) { bf16* sout = X.STS + st_slot(sc, HGT, h, dir);
#pragma unroll
            for (int et = 0; et < NE; ++et) { v2u w; w.x = pkbf(acc[et][0], acc[et][1]); w.y = pkbf(acc[et][2], acc[et][3]);
                *(GAS v2u*)(sout + (size_t)((et * 4 + (wave >> 1)) * 64 + fr + 16 * (2 * (wave & 1) + (fq >> 1))) * 8 + 4 * (fq & 1)) = w; }
            if (lane == 0) { float* tp = X.TOTS + ((size_t)sc * 24 + hd) * 128 + c0;
#pragma unroll
                for (int i = 0; i < 4; ++i) ((GAS f32x4*)tp)[i] = (f32x4){run[4 * i], run[4 * i + 1], run[4 * i + 2], run[4 * i + 3]}; } }
    }
    __syncthreads();
}
__device__ __forceinline__ void pass_b_super(const Ctx& X, int g, int gtid, int NT) {
    const int ns = (g == 0) ? 1 : 2, nc = NSC / ns;
    for (int v = gtid; v < ns * (ST_CHUNK / 8); v += NT) {
        const int s = v / (ST_CHUNK / 8), idx = (v % (ST_CHUNK / 8)) * 8;
        const int hd = idx < 262144 ? idx / 32768 : 8 + (idx - 262144) / 16384, db = hd & 1;
        const int d0 = 32 * ((idx >> 9) & 3) + 8 * ((idx >> 7) & 3);
        float S[8];
#pragma unroll
        for (int i = 0; i < 8; ++i) S[i] = 0.f;
        for (int cc = 0; cc < nc; cc += 8) {
            v4u x[8]; f32x4 t0[8], t1[8];
#pragma unroll
            for (int u = 0; u < 8; ++u) { const int c = s * nc + (db ? nc - 1 - (cc + u) : cc + u);
                x[u] = *(const GAS v4u*)(X.STS + (size_t)c * ST_CHUNK + idx);
                const GAS f32x4* tp = (const GAS f32x4*)(X.TOTS + ((size_t)c * 24 + hd) * 128 + d0); t0[u] = tp[0]; t1[u] = tp[1]; }
#pragma unroll
            for (int u = 0; u < 8; ++u) { const int c = s * nc + (db ? nc - 1 - (cc + u) : cc + u);
                *(GAS v4u*)(X.STS + (size_t)c * ST_CHUNK + idx) = pack8(S);
                float dx[8]; unpack8(x[u], dx);
                const float dec[8] = {fexp2(t0[u].x), fexp2(t0[u].y), fexp2(t0[u].z), fexp2(t0[u].w), fexp2(t1[u].x), fexp2(t1[u].y), fexp2(t1[u].z), fexp2(t1[u].w)};
#pragma unroll
                for (int i = 0; i < 8; ++i) S[i] = dec[i] * S[i] + dx[i]; }
        }
    }
}

constexpr int C2_DIR = 63488, C2_QD = 0, C2_KD = 17408, C2_QH = 34816, C2_P = 52224, C2_BT = 61440, C2_V = 126976, C2_RED = 160768;
template <bool HGT>
__device__ __forceinline__ void c2_stage(const Ctx& X, int l, int chunk, int h, int dir, LAS unsigned char* ld, int lane, int wave) {
    const int r = lane, rt = dir ? 63 - r : r, c0 = 16 * wave;
    float bc[16], kr[16], qv[16];
    if (!HGT) {
        const GAS f32x4* bg = (const GAS f32x4*)(X.BG + ((size_t)(((chunk * 4 + h) * 8 + wave) * 2 + dir) * 64 + rt) * 16);
#pragma unroll
        for (int i = 0; i < 4; ++i) { const f32x4 t = bg[i]; bc[4 * i] = t.x; bc[4 * i + 1] = t.y; bc[4 * i + 2] = t.z; bc[4 * i + 3] = t.w; }
        const GAS v4u* kp = (const GAS v4u*)(X.Z + ZB_GK + blk_off(chunk, 4, h, wave) + rt * 16); unpack8(kp[0], kr); unpack8(kp[1], kr + 8);
        const GAS v4u* qp = (const GAS v4u*)(X.Z + ZB_GQ + blk_off(chunk, 4, h, wave) + rt * 16); unpack8(qp[0], qv); unpack8(qp[1], qv + 8);
#pragma unroll
        for (int i = 0; i < 16; ++i) qv[i] *= 0.08838834764831845f;
    } else {
        float zf[16];
        const GAS v4u* zp = (const GAS v4u*)(X.Z + (dir ? ZB_HFB : ZB_HFF) + blk_off(chunk, 8, h, wave) + rt * 16); unpack8(zp[0], zf); unpack8(zp[1], zf + 8);
        const GAS v4u* qp = (const GAS v4u*)(X.Z + ZB_HQ + blk_off(chunk, 8, h, wave) + rt * 16); unpack8(qp[0], qv); unpack8(qp[1], qv + 8);
        float lbv[16];
        if (l == 0) {
#pragma unroll
            for (int i = 0; i < 16; ++i) lbv[i] = 0.f;
        } else { const float* lp = X.lowb + (size_t)dir * 2 * 1024 + h * 128 + c0;
#pragma unroll
            for (int i = 0; i < 16; ++i) lbv[i] = 1.f / (1.f + __expf(lp[i] - lp[1024 + i])); }
#pragma unroll
        for (int i = 0; i < 16; ++i) {
            const float z = fmaxf(zf[i], -80.f), e = __expf(-z), sig = 1.f / (1.f + e), oml = 1.f - lbv[i];
            kr[i] = oml * e * sig;
            bc[i] = flog2(lbv[i] + oml * sig); }
        wave_scan16(bc);
    }
    float qd[16], kd[16], qh[16];
#pragma unroll
    for (int i = 0; i < 16; ++i) {
        const float beta = __builtin_bit_cast(float, __builtin_amdgcn_update_dpp(0, __builtin_bit_cast(int, bc[i]), 0x142, 0xe, 0xf, false));
        qd[i] = qv[i] * fexp2(bc[i] - beta); kd[i] = kr[i] * fexp2(fminf(beta - bc[i], 80.f)); qh[i] = qv[i] * fexp2(bc[i]); }
    LAS unsigned char* p = ld + r * K_STR + c0 * 2;
    ((LAS v4u*)(p + C2_QD))[0] = pack8(qd); ((LAS v4u*)(p + C2_QD))[1] = pack8(qd + 8);
    ((LAS v4u*)(p + C2_KD))[0] = pack8(kd); ((LAS v4u*)(p + C2_KD))[1] = pack8(kd + 8);
    ((LAS v4u*)(p + C2_QH))[0] = pack8(qh); ((LAS v4u*)(p + C2_QH))[1] = pack8(qh + 8);
    if ((lane & 15) == 15) { LAS f32x4* bt = (LAS f32x4*)(ld + C2_BT + (((lane >> 4) + 1) & 3) * 512 + c0 * 4);
        const bool z = lane == 63;
#pragma unroll
        for (int i = 0; i < 4; ++i) bt[i] = z ? (f32x4){0.f, 0.f, 0.f, 0.f} : (f32x4){bc[4 * i], bc[4 * i + 1], bc[4 * i + 2], bc[4 * i + 3]}; }
}
template <bool HGT>
__device__ __forceinline__ void pass_c2_unit(const Ctx& X, int l, int chunk, int h, LAS unsigned char* lds, int tid, int lane, int wave) {
    constexpr int DV = HGT ? 128 : 256, VSTR = DV * 2 + 16, NET = DV / 128, PPR = DV / 8;
    const int fr = lane & 15, fq = lane >> 4, qq = fr >> 2, p4 = fr & 3;
    { const int vcol = HGT ? ZR_HI + h * 128 : ZR_GV + h * 256;
#pragma unroll
      for (int k = 0; k < 64 * PPR / 512; ++k) { const int idx = tid + 512 * k, row = idx / PPR, pc = idx % PPR;
        const v4u v = *(const GAS v4u*)(X.Z + (size_t)(chunk * 64 + row) * ZRW + vcol + pc * 8);
        *(LAS v4u*)(lds + C2_V + row * VSTR + pc * 16) = v; } }
    c2_stage<HGT>(X, l, chunk, h, 0, lds, lane, wave);
    c2_stage<HGT>(X, l, chunk, h, 1, lds + C2_DIR, lane, wave);
    bf16x8 sfr[2][NET][4];
#pragma unroll
    for (int dir = 0; dir < 2; ++dir) { const bf16* slot = X.ST + st_slot(chunk, HGT, h, dir);
#pragma unroll
        for (int et = 0; et < NET; ++et)
#pragma unroll
            for (int ks = 0; ks < 4; ++ks) sfr[dir][et][ks] = *(const GAS bf16x8*)(slot + (size_t)(((wave * NET + et) * 4 + ks) * 64 + lane) * 8); }
    __syncthreads();
    { const int a = wave & 3; LAS unsigned char* ld = lds + (wave >> 2) * C2_DIR;
      const unsigned lst = (a == 0) ? 0xff002010u : (a == 1) ? 0xff113021u : (a == 2) ? 0xffff2231u : 0xffff3332u;
      const unsigned zls = (a == 0) ? 0xffff0201u : (a == 1) ? 0xffff1203u : (a == 2) ? 0xffffff13u : 0xffffff23u;
      for (int t = 0; t < 3; ++t) { const unsigned code = (lst >> (8 * t)) & 0xffu; if (code == 0xffu) break;
          const int I = (int)(code >> 4), J = (int)(code & 15u);
          f32x4 sc = (f32x4){0.f, 0.f, 0.f, 0.f};
#pragma unroll
          for (int ks = 0; ks < 4; ++ks) { const int dc = 32 * ks + 8 * fq;
              v4u ka = *(const LAS v4u*)(ld + C2_KD + (16 * J + fr) * K_STR + dc * 2);
              const bf16x8 qb = *(const LAS bf16x8*)(ld + C2_QD + (16 * I + fr) * K_STR + dc * 2);
              if (J < I) { const LAS f32x4* bi = (const LAS f32x4*)(ld + C2_BT + I * 512 + dc * 4); const LAS f32x4* bj = (const LAS f32x4*)(ld + C2_BT + J * 512 + dc * 4);
                  const f32x4 d0 = bi[0] - bj[0], d1 = bi[1] - bj[1]; float kf[8]; unpack8(ka, kf);
                  kf[0] *= fexp2(d0.x); kf[1] *= fexp2(d0.y); kf[2] *= fexp2(d0.z); kf[3] *= fexp2(d0.w); kf[4] *= fexp2(d1.x); kf[5] *= fexp2(d1.y); kf[6] *= fexp2(d1.z); kf[7] *= fexp2(d1.w);
                  ka = pack8(kf); }
              sc = __builtin_amdgcn_mfma_f32_16x16x32_bf16(__builtin_bit_cast(bf16x8, ka), qb, sc, 0, 0, 0); }
          if (J == I) {
#pragma unroll
              for (int u = 0; u < 4; ++u) if (4 * fq + u > fr) sc[u] = 0.f; }
          v2u w; w.x = pkbf(sc[0], sc[1]); w.y = pkbf(sc[2], sc[3]);
          *(LAS v2u*)(ld + C2_P + (16 * I + fr) * P_STR + (16 * J + 4 * fq) * 2) = w; }
      for (int t = 0; t < 2; ++t) { const unsigned code = (zls >> (8 * t)) & 0xffu; if (code == 0xffu) break;
          const int I = (int)(code >> 4), J = (int)(code & 15u);
          *(LAS v2u*)(ld + C2_P + (16 * I + fr) * P_STR + (16 * J + 4 * fq) * 2) = (v2u){0u, 0u}; } }
    __syncthreads();
    f32x4 oacc[NET][4];
#pragma unroll
    for (int et = 0; et < NET; ++et)
#pragma unroll
        for (int it = 0; it < 4; ++it) oacc[et][it] = (f32x4){0.f, 0.f, 0.f, 0.f};
#pragma unroll
    for (int dir = 0; dir < 2; ++dir) { LAS const unsigned char* ld = lds + dir * C2_DIR;
        bf16x8 vfr[NET][2];
#pragma unroll
        for (int ks = 0; ks < 2; ++ks) { const int r0 = 32 * ks + 8 * fq + qq, r1 = r0 + 4, v0 = dir ? 63 - r0 : r0, v1 = dir ? 63 - r1 : r1;
#pragma unroll
            for (int et = 0; et < NET; ++et) { const int col = (16 * (wave * NET + et) + 4 * p4) * 2;
                vfr[et][ks] = tr_pair(lds + C2_V + v0 * VSTR + col, lds + C2_V + v1 * VSTR + col); } }
#pragma unroll
        for (int it = 0; it < 4; ++it) { const int trow = 16 * it + fr, ip = dir ? 63 - trow : trow;
            bf16x8 bo[6];
#pragma unroll
            for (int ks = 0; ks < 4; ++ks) bo[ks] = *(const LAS bf16x8*)(ld + C2_QH + ip * K_STR + (32 * ks + 8 * fq) * 2);
#pragma unroll
            for (int ks = 0; ks < 2; ++ks) bo[4 + ks] = *(const LAS bf16x8*)(ld + C2_P + ip * P_STR + (32 * ks + 8 * fq) * 2);
#pragma unroll
            for (int ks = 0; ks < 4; ++ks)
#pragma unroll
                for (int et = 0; et < NET; ++et) oacc[et][it] = __builtin_amdgcn_mfma_f32_16x16x32_bf16(sfr[dir][et][ks], bo[ks], oacc[et][it], 0, 0, 0);
#pragma unroll
            for (int ks = 0; ks < 2; ++ks)
#pragma unroll
                for (int et = 0; et < NET; ++et) oacc[et][it] = __builtin_amdgcn_mfma_f32_16x16x32_bf16(vfr[et][ks], bo[4 + ks], oacc[et][it], 0, 0, 0); } }
    LAS float* red = (LAS float*)(lds + C2_RED);
#pragma unroll
    for (int it = 0; it < 4; ++it) { float sq = 0.f;
#pragma unroll
        for (int et = 0; et < NET; ++et) { const f32x4 o = oacc[et][it]; sq += (o.x * o.x + o.y * o.y) + (o.z * o.z + o.w * o.w); }
        sq += __shfl_xor(sq, 16); sq += __shfl_xor(sq, 32);
        if (fq == 0) red[wave * 64 + 16 * it + fr] = sq; }
    __syncthreads();
    const float* ng = (HGT ? X.hg_g + (size_t)l * 128 : X.gla_g + (size_t)l * 256);
    const int ogcol = HGT ? ZR_HOG + h * 128 : ZR_GOG + h * 256, ocol = HGT ? 1024 + h * 128 : h * 256;
#pragma unroll
    for (int it = 0; it < 4; ++it) { float tot = 0.f;
#pragma unroll
        for (int w = 0; w < 8; ++w) tot += red[w * 64 + 16 * it + fr];
        const float rstd = 1.f / sqrtf(tot * (1.f / DV) + RMS_EPS);
        const int tok = chunk * 64 + 16 * it + fr;
#pragma unroll
        for (int et = 0; et < NET; ++et) { const int e0 = 16 * (wave * NET + et) + 4 * fq;
            const v2u ogp = *(const GAS v2u*)(X.Z + (size_t)tok * ZRW + ogcol + e0);
            const float og[4] = {__uint_as_float(ogp.x << 16), __uint_as_float(ogp.x & 0xffff0000u), __uint_as_float(ogp.y << 16), __uint_as_float(ogp.y & 0xffff0000u)};
            const f32x4 g4 = *(const GAS f32x4*)(ng + e0); float rr[4];
#pragma unroll
            for (int u = 0; u < 4; ++u) { const float z = fminf(fmaxf(og[u], -80.f), 80.f); rr[u] = oacc[et][it][u] * rstd * g4[u] * (z / (1.f + __expf(-z))); }
            v2u w; w.x = pkbf(rr[0], rr[1]); w.y = pkbf(rr[2], rr[3]);
            *(GAS v2u*)(X.O + (size_t)tok * DM + ocol + e0) = w; } }
}

struct Args { const float* in[15]; float* out; unsigned char* ws; int mode, pad; };
#define PHASE_IDS() int tid = threadIdx.x; asm volatile("" : "+v"(tid)); const int lane = tid & 63, wave = __builtin_amdgcn_readfirstlane(tid >> 6); \
    const int gw = bx * NWAVES + wave, NGW = G * NWAVES, gtid = bx * (NWAVES * 64) + tid, NT = G * NWAVES * 64; (void)lane; (void)wave; (void)gw; (void)NGW; (void)gtid; (void)NT
__device__ __forceinline__ Ctx make_ctx(const Args& args) {
    Ctx X; unsigned char* ws = args.ws;
    X.x_prompt = args.in[0]; X.x_sample = args.in[1]; X.w_in = args.in[2]; X.w_lr2 = args.in[3]; X.b_lr = args.in[4]; X.gla_g = args.in[5]; X.hg_g = args.in[6]; X.lowb = args.in[7];
    X.w_out = args.in[8]; X.ln1_g = args.in[9]; X.ln1_b = args.in[10]; X.w_up = args.in[11]; X.w_down = args.in[12]; X.ln2_g = args.in[13]; X.ln2_b = args.in[14]; X.out = args.out;
    X.Win_t = (bf16*)(ws + WS_WIN); X.Wout_t = (bf16*)(ws + WS_WOUT); X.Wup_t = (bf16*)(ws + WS_WUP); X.Wdn_t = (bf16*)(ws + WS_WDN); X.Wglr_t = (bf16*)(ws + WS_WGLR);
    X.HB = (bf16*)(ws + WS_HB); X.Z = (bf16*)(ws + WS_Z); X.O = (bf16*)(ws + WS_O); X.ST = (bf16*)(ws + WS_ST);
    X.BG = (float*)(ws + WS_BG); X.MF = (bf16*)(ws + WS_ST); X.TOT = (float*)(ws + WS_TOT); X.TOTS = (float*)(ws + WS_TOTS); X.STS = (bf16*)(ws + WS_STS);
    return X;
}
__global__ void __launch_bounds__(NWAVES * 64, 2) fwd_kernel(Args args) {
    extern __shared__ __attribute__((aligned(16))) unsigned char lds_raw[];
    LAS unsigned char* lds = (LAS unsigned char*)lds_raw;
    const int G = gridDim.x, bx = blockIdx.x;
    volatile LAS unsigned* MISC = (volatile LAS unsigned*)(lds + MISC_OFF);
    if (threadIdx.x < 32) MISC[threadIdx.x] = 0u;
    __syncthreads();
    XcdBarrier bar = xcd_barrier_post((unsigned*)(args.ws + WS_CTL) + CW_BAR, MISC + 8);

    { PHASE_IDS(); const Ctx X = make_ctx(args); prologue_weights(X, lds, gw, NGW, wave, lane); }
    for (int g = 0; g < NGRP; ++g) {
        { PHASE_IDS(); const Ctx X = make_ctx(args); cvt_group((g == 0) ? X.x_prompt : X.x_sample + (size_t)(g - 1) * GM * DM, X.HB, gtid, NT); }
        xcd_barrier(bar);
        for (int l = 0; l < NLAYER; ++l) {
            { PHASE_IDS(); const Ctx X = make_ctx(args); for (int c = bx; c < NCHUNK; c += G) gate_unit(X, l, c, lds, tid, lane, wave); }
            { const Ctx X = make_ctx(args); pg8::Gemm gm{X.HB, X.Win_t + (size_t)l * ZW * DM, GM, ZW, DM}; pg8::StaticOrder S; S.init(GM, ZW, G, bx);
              pg8::EpiZ E{X.Z};
              pg8::gemm_phase<pg8::EpiZ, pg8::StaticOrder, false, true>(lds, gm, S, E); }
            xcd_barrier(bar);
            {
            { PHASE_IDS(); const Ctx X = make_ctx(args);
              for (int u = bx; u < NSC * 12; u += G) { const int sc = u / 12, hh = u % 12;
                if (hh < 4) pass_s_unit<false, false>(X, l, sc, hh, lds, tid, lane, wave); else pass_s_unit<true, false>(X, l, sc, hh - 4, lds, tid, lane, wave); } }
            xcd_barrier(bar);
            { PHASE_IDS(); const Ctx X = make_ctx(args); pass_b_super(X, g, gtid, NT); }
            xcd_barrier(bar);
            { PHASE_IDS(); const Ctx X = make_ctx(args);
              for (int u = bx; u < NSC * 12; u += G) { const int sc = u / 12, hh = u % 12;
                if (hh < 4) pass_s_unit<false, true>(X, l, sc, hh, lds, tid, lane, wave); else pass_s_unit<true, true>(X, l, sc, hh - 4, lds, tid, lane, wave); } }
            xcd_barrier(bar);
            { PHASE_IDS(); const Ctx X = make_ctx(args);
              for (int u = bx; u < NCHUNK * 12; u += G) { const int c = u / 12, hh = u % 12;
                if (hh < 4) pass_c2_unit<false>(X, l, c, hh, lds, tid, lane, wave); else pass_c2_unit<true>(X, l, c, hh - 4, lds, tid, lane, wave); } }
            xcd_barrier(bar);
            }
            { const Ctx X = make_ctx(args); pg8::Gemm gm{X.O, X.Wout_t + (size_t)l * DM * DM, GM, DM, DM}; pg8::StaticOrder S; S.init(GM, DM, G, bx);
              pg8::EpiBf16<0> E{X.MF, DM};
              pg8::gemm_phase<pg8::EpiBf16<0>, pg8::StaticOrder, false, true>(lds, gm, S, E); }
            xcd_barrier(bar);
            { PHASE_IDS(); const Ctx X = make_ctx(args);
              if (l == 0) ln_phase<true, false>((g == 0) ? X.x_prompt : X.x_sample + (size_t)(g - 1) * GM * DM, X.MF, X.ln1_g, X.ln1_b, nullptr, X.HB, gw, NGW, lane);
              else ln_phase<false, false>(X.HB, X.MF, X.ln1_g + (size_t)l * DM, X.ln1_b + (size_t)l * DM, nullptr, X.HB, gw, NGW, lane); }
            xcd_barrier(bar);
            { const Ctx X = make_ctx(args); pg8::Gemm gm{X.HB, X.Wup_t + (size_t)l * DFF * DM, GM, DFF, DM}; pg8::StaticOrder S; S.init(GM, DFF, G, bx);
              pg8::EpiBf16<1> E{X.Z, DFF};
              pg8::gemm_phase<pg8::EpiBf16<1>, pg8::StaticOrder, false, true>(lds, gm, S, E); }
            xcd_barrier(bar);
            { const Ctx X = make_ctx(args); pg8::Gemm gm{X.Z, X.Wdn_t + (size_t)l * DM * DFF, GM, DM, DFF}; pg8::StaticOrder S; S.init(GM, DM, G, bx);
              pg8::EpiBf16<0> E{X.MF, DM};
              pg8::gemm_phase<pg8::EpiBf16<0>, pg8::StaticOrder, false, true>(lds, gm, S, E); }
            xcd_barrier(bar);
            { PHASE_IDS(); const Ctx X = make_ctx(args);
              if (l == NLAYER - 1) ln_phase<false, true>(X.HB, X.MF, X.ln2_g + (size_t)l * DM, X.ln2_b + (size_t)l * DM, X.out + (size_t)g * GM * DM, nullptr, gw, NGW, lane);
              else ln_phase<false, false>(X.HB, X.MF, X.ln2_g + (size_t)l * DM, X.ln2_b + (size_t)l * DM, nullptr, X.HB, gw, NGW, lane); }
            xcd_barrier(bar);
        }
    }
}

extern "C" void kernel_launch(void* const* d_in, const int* in_sizes, int n_in, void* d_out, int out_size, void* d_ws, size_t ws_size, hipStream_t stream) {
    static int grid = 0;
    if (grid == 0) {
        if (n_in != 15 || out_size != NTOK * DM || ws_size < WS_END) { fprintf(stderr, "kernel_launch: unexpected shapes (n_in %d, out %d, ws %zu)\n", n_in, out_size, ws_size); grid = -1; return; }
        int dev = 0, cus = 0;
        if (hipGetDevice(&dev) != hipSuccess || hipDeviceGetAttribute(&cus, hipDeviceAttributeMultiprocessorCount, dev) != hipSuccess) { grid = -1; return; }
        if (hipFuncSetAttribute((const void*)fwd_kernel, hipFuncAttributeMaxDynamicSharedMemorySize, LDS_BYTES) != hipSuccess) { fprintf(stderr, "kernel_launch: hipFuncSetAttribute failed\n"); grid = -1; return; }
        int per_cu = 0;
        if (hipOccupancyMaxActiveBlocksPerMultiprocessor(&per_cu, (const void*)fwd_kernel, NWAVES * 64, LDS_BYTES) != hipSuccess || per_cu < 1) { fprintf(stderr, "kernel_launch: occupancy query says %d\n", per_cu); }
        (void)hipGetLastError();
        grid = cus;
    }
    if (grid < 0) return;
    if (hipMemsetAsync((char*)d_ws + WS_CTL, 0, CTL_ZERO_BYTES, stream) != hipSuccess) return;
    Args a{};
    for (int i = 0; i < 15; ++i) a.in[i] = (const float*)d_in[i];
    a.out = (float*)d_out; a.ws = (unsigned char*)d_ws; a.mode = KMODE; a.pad = 0;
    hipLaunchKernelGGL(fwd_kernel, dim3(grid), dim3(NWAVES * 64), LDS_BYTES, stream, a);
}
```

```cpp
#include <hip/hip_runtime.h>
#include <cstdio>
#include <cstdint>
#ifndef KMODE
#define KMODE 0
#endif
namespace pg8 {
#define PG8_LAS __attribute__((address_space(3)))
typedef unsigned short bf16_t;
typedef short bf16x8 __attribute__((ext_vector_type(8)));
typedef float f32x4 __attribute__((ext_vector_type(4)));
typedef unsigned u32x4 __attribute__((ext_vector_type(4)));
constexpr int BM = 256, BK = 64, HALF = 128, HTB = HALF * BK * 2  , STAGE_BYTES = 8 * HTB, NXCD = 8, WGM = 4;

__host__ __device__ __forceinline__ int lds_byte(int r, int c) { const int st = (r >> 4) * 2 + (c >> 5), rr = r & 15, cc = c & 31, ob = rr * 64 + cc * 2; return st * 1024 + (ob ^ (((ob >> 9) & 1) << 5)); }
__host__ __device__ __forceinline__ void stage_rc(int b, int& R, int& C) { const int st = b / 1024, sb = b % 1024, swz = sb ^ (((sb >> 9) & 1) << 5); R = (st >> 1) * 16 + swz / 64; C = (st & 1) * 32 + (swz % 64) / 2; }
__host__ __device__ __forceinline__ int perm32(int rho) { const int n = rho >> 4, i = rho & 15; return 8 * (i >> 2) + 4 * n + (i & 3); }

struct Unit { int pm, pn; };
struct Gemm { const bf16_t* A; const bf16_t* Bt; int M, N, K; };

struct StaticOrder {
    int nM, nN, nwg, G, c;
    __host__ __device__ void init(int M, int N, int G_, int c_) { nM = M / BM; nN = N / BM; nwg = nM * nN; G = G_; c = c_; }
    __host__ __device__ bool next(int i, Unit& u) const {
        const long L = (long)i * G + c; if (L >= nwg) return false;
        int wgid = (int)L; { const int q = nwg / NXCD, r = nwg % NXCD, xcd = wgid % NXCD, off = wgid / NXCD; wgid = (xcd < r ? xcd * (q + 1) : r * (q + 1) + (xcd - r) * q) + off; }
        const int nig = WGM * nN, gid = wgid / nig, fm = gid * WGM, gsz = (nM - fm) < WGM ? (nM - fm) : WGM;
        u.pm = fm + ((wgid % nig) % gsz); u.pn = (wgid % nig) / gsz; return true;
    }
    __device__ __forceinline__ void a_ready(const Unit&) const {}
    __device__ __forceinline__ void done(const Unit&) const {}
};


__device__ __forceinline__ unsigned cvt_pk_bf16(float lo, float hi) { unsigned r; asm volatile("v_cvt_pk_bf16_f32 %0, %1, %2" : "=v"(r) : "v"(lo), "v"(hi)); return r; }

template <int ACT  > struct EpiBf16 {
    static constexpr bool PERM = true, AFTER_DRAIN = false;
    bf16_t* O; int ldc;
    __device__ __forceinline__ void operator()(const f32x4 (&acc)[2][2][4][2], const Unit& u, int wr, int wc, int fr, int fq) const {
        const int row0 = u.pm * BM + wr * 64 + fr; const int col0 = u.pn * BM + wc * 32 + 8 * fq;
#pragma unroll
        for (int ai = 0; ai < 2; ++ai)
#pragma unroll
            for (int m = 0; m < 4; ++m) { bf16_t* rowp = O + (size_t)(row0 + ai * HALF + m * 16) * ldc + col0;
#pragma unroll
                for (int bj = 0; bj < 2; ++bj) { f32x4 v0 = acc[ai][bj][m][0], v1 = acc[ai][bj][m][1];
                    if (ACT == 1) {
#pragma unroll
                        for (int j = 0; j < 4; ++j) { const float a = fmaxf(v0[j], 0.f), b = fmaxf(v1[j], 0.f); v0[j] = a * a; v1[j] = b * b; } }
                    u32x4 w; w.x = cvt_pk_bf16(v0[0], v0[1]); w.y = cvt_pk_bf16(v0[2], v0[3]); w.z = cvt_pk_bf16(v1[0], v1[1]); w.w = cvt_pk_bf16(v1[2], v1[3]);
                    *(u32x4*)(rowp + bj * HALF) = w; } }
    }
};
struct EpiF32 {
    static constexpr bool PERM = false, AFTER_DRAIN = false;
    float* C; int ldc;
    __device__ __forceinline__ void operator()(const f32x4 (&acc)[2][2][4][2], const Unit& u, int wr, int wc, int fr, int fq) const {
        const int row0 = u.pm * BM + wr * 64 + fr, col0 = u.pn * BM + wc * 32 + 4 * fq;
#pragma unroll
        for (int ai = 0; ai < 2; ++ai)
#pragma unroll
            for (int m = 0; m < 4; ++m) { float* rowp = C + (size_t)(row0 + ai * HALF + m * 16) * ldc + col0;
#pragma unroll
                for (int bj = 0; bj < 2; ++bj)
#pragma unroll
                    for (int n = 0; n < 2; ++n) *(f32x4*)(rowp + bj * HALF + n * 16) = acc[ai][bj][m][n]; }
    }
};

struct EpiZ {
    static constexpr bool PERM = true, AFTER_DRAIN = false;
    bf16_t* Z;
    __device__ __forceinline__ void operator()(const f32x4 (&acc)[2][2][4][2], const Unit& u, int wr, int wc, int fr, int fq) const {
        const int pn = u.pn; const size_t Mr = 16384;
        bool blocked; int H = 4, c0; bf16_t* base;
        if (pn < 2) { blocked = true; H = 4; base = Z + Mr * 4096; c0 = pn * 256; }
        else if (pn < 4) { blocked = true; H = 4; base = Z + Mr * 4096 + Mr * 512; c0 = (pn - 2) * 256; }
        else if (pn < 8) { blocked = false; base = Z; c0 = (pn - 4) * 256; }
        else if (pn < 12) { blocked = false; base = Z; c0 = 1024 + (pn - 8) * 256; }
        else if (pn < 24) { blocked = true; H = 8; base = Z + Mr * 4096 + Mr * 1024 + (size_t)((pn - 12) >> 2) * Mr * 1024; c0 = ((pn - 12) & 3) * 256; }
        else if (pn < 28) { blocked = false; base = Z; c0 = 2048 + (pn - 24) * 256; }
        else { blocked = false; base = Z; c0 = 3072 + (pn - 28) * 256; }
        const int row0 = u.pm * BM + wr * 64 + fr, cl = c0 + wc * 32 + 8 * fq;
#pragma unroll
        for (int ai = 0; ai < 2; ++ai)
#pragma unroll
            for (int m = 0; m < 4; ++m) { const int row = row0 + ai * HALF + m * 16;
#pragma unroll
                for (int bj = 0; bj < 2; ++bj) { const f32x4 v0 = acc[ai][bj][m][0], v1 = acc[ai][bj][m][1]; const int c = cl + bj * HALF;
                    u32x4 w; w.x = cvt_pk_bf16(v0[0], v0[1]); w.y = cvt_pk_bf16(v0[2], v0[3]); w.z = cvt_pk_bf16(v1[0], v1[1]); w.w = cvt_pk_bf16(v1[2], v1[3]);
                    bf16_t* p = blocked ? base + ((size_t)((((row >> 6) * H + (c >> 7)) * 8 + ((c >> 4) & 7)) * 64 + (row & 63))) * 16 + (c & 15)
                                        : base + (size_t)row * 4096 + c;
                    *(u32x4*)p = w; } }
    }
};

template <class Epi, class Sched, bool ALIGN_EPI = false, bool SP2 = false>
__device__ __forceinline__ void gemm_phase(PG8_LAS unsigned char* lds, const Gemm g, const Sched& S, const Epi& E) {
    int tid_o = threadIdx.x; asm volatile("" : "+v"(tid_o));
    const int tid = tid_o, wid = __builtin_amdgcn_readfirstlane(tid >> 6), lane = tid & 63, wr = wid >> 2, wc = wid & 3, fr = lane & 15, fq = lane >> 4;
    const int K = g.K, nt = K / BK;
    unsigned voffA[2], voffB[2];
#pragma unroll
    for (int i = 0; i < 2; ++i) { int R, C; stage_rc(tid * 16 + i * 8192, R, C); const int Rb = Epi::PERM ? ((R & ~31) + perm32(R & 31)) : R;
        voffA[i] = (unsigned)(R * K + C) * 2u; voffB[i] = (unsigned)(Rb * K + C) * 2u; }
    const size_t kstep = (size_t)(BK * 2);
    const size_t hstep = (size_t)HALF * K * 2;
    const size_t tstep = 2 * hstep;
    const unsigned ldsw = (unsigned)wid * 1024u;
    const int aoff = lds_byte(wr * 64 + fr, fq * 8), boff = lds_byte(wc * 32 + fr, fq * 8);
#define PG8_SA(b, h) (((b) * 2 + (h)) * HTB)
#define PG8_SB(b, h) ((4 + (b) * 2 + (h)) * HTB)
#define PG8_STAGE(bufoff, gbase, voff) do { _Pragma("unroll") for (int _i = 0; _i < 2; ++_i) \
        __builtin_amdgcn_global_load_lds((const unsigned*)((const char*)(gbase) + (voff)[_i]), (PG8_LAS unsigned*)(lds + (bufoff) + ldsw + _i * 8192), 16, 0, 0); } while (0)
#define PG8_LDA(dst, b, h) do { _Pragma("unroll") for (int m = 0; m < 4; ++m) _Pragma("unroll") for (int k = 0; k < 2; ++k) dst[m][k] = *(const PG8_LAS bf16x8*)(lds + PG8_SA(b, h) + aoff + m * 2048 + k * 1024); } while (0)
#define PG8_LDB(dst, b, h) do { _Pragma("unroll") for (int n = 0; n < 2; ++n) _Pragma("unroll") for (int k = 0; k < 2; ++k) dst[n][k] = *(const PG8_LAS bf16x8*)(lds + PG8_SB(b, h) + boff + n * 2048 + k * 1024); } while (0)
#define PG8_MMA(ai, bj, At, Bt) do { __builtin_amdgcn_s_setprio(1); _Pragma("unroll") for (int m = 0; m < 4; ++m) _Pragma("unroll") for (int n = 0; n < 2; ++n) _Pragma("unroll") for (int k = 0; k < 2; ++k) \
        acc[ai][bj][m][n] = __builtin_amdgcn_mfma_f32_16x16x32_bf16(Bt[n][k], At[m][k], acc[ai][bj][m][n], 0, 0, 0); __builtin_amdgcn_s_setprio(0); } while (0)
#define PG8_WAIT_V(n) asm volatile("s_waitcnt vmcnt(" #n ")" ::: "memory")
#define PG8_WAIT_L(n) asm volatile("s_waitcnt lgkmcnt(" #n ")" ::: "memory")
#define PG8_BAR __builtin_amdgcn_s_barrier()
#define PG8_SCHED __builtin_amdgcn_sched_barrier(0)
    Unit cur, nxt; int ui = 0;
    if (!S.next(0, cur)) return;
    f32x4 acc[2][2][4][2];
#pragma unroll
    for (int a = 0; a < 2; ++a)
#pragma unroll
        for (int b = 0; b < 2; ++b)
#pragma unroll
            for (int m = 0; m < 4; ++m)
#pragma unroll
                for (int n = 0; n < 2; ++n) acc[a][b][m][n] = (f32x4){0.f, 0.f, 0.f, 0.f};
    bf16x8 At[4][2], B0[2][2], B1[2][2];
    const char* cA = (const char*)g.A + (size_t)cur.pm * tstep; const char* cB = (const char*)g.Bt + (size_t)cur.pn * tstep;
    S.a_ready(cur);
    if constexpr (SP2) {
        PG8_STAGE(PG8_SB(0, 0), cB, voffB); PG8_STAGE(PG8_SB(0, 1), cB + hstep, voffB); PG8_STAGE(PG8_SA(0, 0), cA, voffA); PG8_STAGE(PG8_SA(0, 1), cA + hstep, voffA);
        if (wr == 1) PG8_BAR;
        PG8_WAIT_V(2); PG8_BAR;
        PG8_STAGE(PG8_SB(1, 0), cB + kstep, voffB); PG8_STAGE(PG8_SA(1, 0), cA + kstep, voffA); PG8_STAGE(PG8_SB(1, 1), cB + hstep + kstep, voffB);
        PG8_WAIT_V(6); PG8_BAR;
    } else {
        PG8_STAGE(PG8_SB(0, 0), cB, voffB); PG8_STAGE(PG8_SA(0, 0), cA, voffA); PG8_STAGE(PG8_SB(0, 1), cB + hstep, voffB); PG8_STAGE(PG8_SA(0, 1), cA + hstep, voffA);
        if (wr == 1) PG8_BAR;
        PG8_WAIT_V(4); PG8_BAR;
        PG8_STAGE(PG8_SB(1, 0), cB + kstep, voffB); PG8_STAGE(PG8_SA(1, 0), cA + kstep, voffA); PG8_STAGE(PG8_SB(1, 1), cB + hstep + kstep, voffB);
        PG8_WAIT_V(6); PG8_BAR;
    }
    for (;;) {
        const bool has_next = S.next(ui + 1, nxt);
        const char* nA = has_next ? (const char*)g.A + (size_t)nxt.pm * tstep : cA; const char* nB = has_next ? (const char*)g.Bt + (size_t)nxt.pn * tstep : cB;
        for (int t = 0; t < nt; t += 2) {
            const bool last = (t == nt - 2);
            const char* a1 = cA + (size_t)(t + 1) * kstep;
            const char* a2 = last ? nA : cA + (size_t)(t + 2) * kstep; const char* b2 = last ? nB : cB + (size_t)(t + 2) * kstep;
            const char* a3 = a2 + kstep; const char* b3 = b2 + kstep;
            if (last && has_next) S.a_ready(nxt);
            if constexpr (SP2) {
            PG8_LDB(B0, 0, 0); PG8_LDB(B1, 0, 1); PG8_SCHED; PG8_LDA(At, 0, 0); PG8_STAGE(PG8_SA(1, 1), a1 + hstep, voffA);
            PG8_WAIT_V(8); PG8_WAIT_L(0); PG8_BAR; PG8_MMA(0, 0, At, B0); PG8_MMA(0, 1, At, B1); PG8_BAR; PG8_SCHED;
            PG8_LDA(At, 0, 1); PG8_STAGE(PG8_SB(0, 0), b2, voffB); PG8_STAGE(PG8_SB(0, 1), b2 + hstep, voffB); PG8_STAGE(PG8_SA(0, 0), a2, voffA);
            PG8_WAIT_V(8); PG8_WAIT_L(0); PG8_BAR; PG8_MMA(1, 0, At, B0); PG8_MMA(1, 1, At, B1); PG8_BAR; PG8_SCHED;
            PG8_LDB(B0, 1, 0); PG8_LDB(B1, 1, 1); PG8_SCHED; PG8_LDA(At, 1, 0); PG8_STAGE(PG8_SA(0, 1), a2 + hstep, voffA);
            PG8_WAIT_V(8); PG8_WAIT_L(0); PG8_BAR; PG8_MMA(0, 0, At, B0); PG8_MMA(0, 1, At, B1); PG8_BAR; PG8_SCHED;
            PG8_LDA(At, 1, 1); PG8_STAGE(PG8_SB(1, 0), b3, voffB); PG8_STAGE(PG8_SB(1, 1), b3 + hstep, voffB); PG8_STAGE(PG8_SA(1, 0), a3, voffA);
            PG8_WAIT_V(8); PG8_WAIT_L(0); PG8_BAR; PG8_MMA(1, 0, At, B0); PG8_MMA(1, 1, At, B1); PG8_BAR; PG8_SCHED;
            } else {
            PG8_LDB(B0, 0, 0); PG8_SCHED; PG8_LDA(At, 0, 0); PG8_STAGE(PG8_SA(1, 1), a1 + hstep, voffA);
            PG8_WAIT_L(8); PG8_BAR; PG8_WAIT_L(0); PG8_MMA(0, 0, At, B0); PG8_BAR; PG8_SCHED;
            PG8_LDB(B1, 0, 1); PG8_STAGE(PG8_SB(0, 0), b2, voffB);
            PG8_BAR; PG8_WAIT_L(0); PG8_MMA(0, 1, At, B1); PG8_BAR;
            PG8_LDA(At, 0, 1); PG8_STAGE(PG8_SA(0, 0), a2, voffA);
            PG8_BAR; PG8_WAIT_L(0); PG8_MMA(1, 0, At, B0); PG8_BAR; PG8_SCHED;
            PG8_STAGE(PG8_SB(0, 1), b2 + hstep, voffB);
            PG8_WAIT_V(6); PG8_BAR; PG8_MMA(1, 1, At, B1); PG8_BAR;
            PG8_LDB(B0, 1, 0); PG8_SCHED; PG8_LDA(At, 1, 0); PG8_STAGE(PG8_SA(0, 1), a2 + hstep, voffA);
            PG8_WAIT_L(8); PG8_BAR; PG8_WAIT_L(0); PG8_MMA(0, 0, At, B0); PG8_BAR; PG8_SCHED;
            PG8_LDB(B1, 1, 1); PG8_STAGE(PG8_SB(1, 0), b3, voffB);
            PG8_BAR; PG8_WAIT_L(0); PG8_MMA(0, 1, At, B1); PG8_BAR;
            PG8_LDA(At, 1, 1); PG8_STAGE(PG8_SA(1, 0), a3, voffA);
            PG8_BAR; PG8_WAIT_L(0); PG8_MMA(1, 0, At, B0); PG8_BAR; PG8_SCHED;
            PG8_STAGE(PG8_SB(1, 1), b3 + hstep, voffB);
            PG8_WAIT_V(6); PG8_BAR; PG8_MMA(1, 1, At, B1); PG8_BAR;
            }
        }
        if constexpr (ALIGN_EPI) { if (wr == 0) PG8_BAR; }
        if constexpr (!Epi::AFTER_DRAIN) { E(acc, cur, wr, wc, fr, fq); S.done(cur); }
        if (!has_next) break;
#pragma unroll
        for (int a = 0; a < 2; ++a)
#pragma unroll
            for (int b = 0; b < 2; ++b)
#pragma unroll
                for (int m = 0; m < 4; ++m)
#pragma unroll
                    for (int n = 0; n < 2; ++n) acc[a][b][m][n] = (f32x4){0.f, 0.f, 0.f, 0.f};
        cur = nxt; cA = nA; cB = nB; ++ui;
        if constexpr (ALIGN_EPI) { if (wr == 1) PG8_BAR; }
    }
    PG8_WAIT_V(0);
    if constexpr (!ALIGN_EPI) { if (wr == 0) PG8_BAR; }
    PG8_BAR;
    if constexpr (Epi::AFTER_DRAIN) { E.fused(acc, cur, wr, wc, fr, fq, lds, wid, lane); S.done(cur); }
#undef PG8_SA
#undef PG8_SB
#undef PG8_STAGE
#undef PG8_LDA
#undef PG8_LDB
#undef PG8_MMA
#undef PG8_WAIT_V
#undef PG8_WAIT_L
#undef PG8_BAR
#undef PG8_SCHED
}
}

constexpr int NWAVES = 8;
constexpr int DM = 2048, DFF = 8192, NTOK = 49152, GM = 16384, NGRP = 3, NLAYER = 2, INW = 8224, ZW = 8192;
constexpr int ZC_GQ = 0, ZC_GK = 512, ZC_GV = 1024, ZC_GOG = 2048, ZC_HQ = 3072, ZC_HFF = 4096, ZC_HFB = 5120, ZC_HI = 6144, ZC_HOG = 7168;
constexpr float LN_EPS = 1e-5f, RMS_EPS = 1e-6f, ALPHA = 1.41421356237f, LOG2E = 1.44269504089f;
constexpr int NCHUNK = GM / 64;
constexpr int ST_CHUNK = 524288;
constexpr size_t MiB = 1u << 20;
constexpr size_t WS_CTL = 0, CTL_ZERO_BYTES = 1 * MiB;
constexpr size_t WS_WIN = 2 * MiB, WS_WOUT = 66 * MiB, WS_WUP = 82 * MiB, WS_WDN = 146 * MiB, WS_WGLR = 210 * MiB;
constexpr size_t WS_HB = 212 * MiB;
constexpr size_t WS_Z = 276 * MiB;
constexpr size_t WS_BG = 532 * MiB;
constexpr size_t WS_O = 596 * MiB;
constexpr size_t WS_ST = 660 * MiB;
constexpr size_t WS_TOT = 916 * MiB;
constexpr size_t WS_STS = 920 * MiB;
constexpr size_t WS_TOTS = 984 * MiB;
constexpr size_t WS_END = 985 * MiB;
constexpr int CW_BAR = 4096;
constexpr int RING_BYTES = 131072;
constexpr int LDS_BYTES = 160 * 1024, MISC_OFF = LDS_BYTES - 256;
constexpr int L_B32 = 0, L_KR = 33792, L_QR = 51200, L_QH = 68608, L_V = 86016, L_P = 119808, L_RED = 129024;
constexpr int B32_STR = 528, K_STR = 272, P_STR = 144, KT_STR = 144;
constexpr int NSC = GM / 256;
constexpr int SV_KT = 135168, KTW_BYTES = 2560;

#define GAS __attribute__((address_space(1)))
#define LAS __attribute__((address_space(3)))
typedef unsigned short bf16;
typedef unsigned v4u __attribute__((ext_vector_type(4)));
typedef float f32x4 __attribute__((ext_vector_type(4)));
typedef short bf16x8 __attribute__((ext_vector_type(8)));
typedef GAS unsigned gu32;
typedef GAS unsigned long long gu64;
#define RLX_AGENT __ATOMIC_RELAXED, __HIP_MEMORY_SCOPE_AGENT
#define LDS_WAIT() asm volatile("s_waitcnt lgkmcnt(0)" ::: "memory")
#define VM_WAIT() asm volatile("s_waitcnt vmcnt(0)" ::: "memory")
__device__ __forceinline__ unsigned long long rt() { return __builtin_amdgcn_s_memrealtime(); }
__device__ __forceinline__ unsigned f2bf(float f) { unsigned u = __builtin_bit_cast(unsigned, f); return (u + 0x7fffu + ((u >> 16) & 1u)) >> 16; }
__device__ __forceinline__ unsigned pk2(float lo, float hi) { return f2bf(lo) | (f2bf(hi) << 16); }

#define XB_TMO      128
#define XB_XCNT(j)  (256  + 64 * (j))
#define XB_XSUB(j)  (1280 + 64 * (j))
#define XB_XGEN(j)  (2304 + 64 * (j))
#define XB_TOP      3328
#define XB_TOPGEN   3392
#define XCD_BAR_WORDS 3456
#define XB_SPIN_CAP (1u << 18)

__device__ __forceinline__ unsigned xb_ld(unsigned* p)              { return __hip_atomic_load(p, __ATOMIC_RELAXED, __HIP_MEMORY_SCOPE_AGENT); }
__device__ __forceinline__ unsigned xb_add(unsigned* p, unsigned v) { return __hip_atomic_fetch_add(p, v, __ATOMIC_RELAXED, __HIP_MEMORY_SCOPE_AGENT); }
__device__ __forceinline__ unsigned xb_xcc_id() { return (unsigned)__builtin_amdgcn_s_getreg((3 << 11) | 20) & 0xFu; }
#define XB_SPIN(cond, bar) do { unsigned _sp = 0; while (cond) { __builtin_amdgcn_s_sleep(1); \
    if ((++_sp & 255u) == 0u) { if (xb_ld(&(bar)[XB_TMO])) break; if (_sp > XB_SPIN_CAP) { atomicAdd(&(bar)[XB_TMO], 1u); break; } } } } while (0)

struct XcdBarrier {
    unsigned* bar; unsigned x;
    volatile LAS unsigned* st;
};

__device__ __forceinline__ XcdBarrier xcd_barrier_post(unsigned* bar, volatile LAS unsigned* st) {
    XcdBarrier b; b.bar = bar; b.x = xb_xcc_id(); b.st = st;
    if (threadIdx.x == 0) (void)xb_add(&bar[XB_XCNT(b.x)], 1u);
    return b;
}
__device__ __forceinline__ void xcd_barrier_complete(unsigned* bar, unsigned x, unsigned& nloc, unsigned& nx) {
    const unsigned G = gridDim.x * gridDim.y * gridDim.z;
    unsigned sum, cnt, mine, sp = 0u;
    for (;;) {
        sum = 0u; cnt = 0u; mine = 0u;
#pragma unroll
        for (unsigned j = 0; j < 16; ++j) { const unsigned c = xb_ld(&bar[XB_XCNT(j)]); sum += c; cnt += (c > 0u) ? 1u : 0u; mine = (j == x) ? c : mine; }
        if (sum == G) break;
        __builtin_amdgcn_s_sleep(1);
        if ((++sp & 255u) == 0u) { if (xb_ld(&bar[XB_TMO])) break; if (sp > XB_SPIN_CAP) { atomicAdd(&bar[XB_TMO], 1u); break; } }
    }
    nloc = mine > 0u ? mine : 1u; nx = cnt > 0u ? cnt : 1u;
}

__device__ __forceinline__ void xcd_barrier(const XcdBarrier& b) {
    asm volatile("s_waitcnt vmcnt(0)" ::: "memory");
    __syncthreads();
    if (threadIdx.x == 0) {
        unsigned* bar = b.bar;
        __builtin_amdgcn_s_waitcnt(0);
        unsigned nloc = b.st[0], nx = b.st[1];
        if (nloc == 0u) { xcd_barrier_complete(bar, b.x, nloc, nx); b.st[0] = nloc; b.st[1] = nx; }
        const unsigned old = xb_add(&bar[XB_XSUB(b.x)], 1u);
        const unsigned gen = old / nloc;
        if (old + 1u == (gen + 1u) * nloc) {
            __builtin_amdgcn_fence(__ATOMIC_RELEASE, "agent");
            asm volatile("s_waitcnt vmcnt(0)" ::: "memory");
            const unsigned og = xb_add(&bar[XB_TOP], 1u);
            const unsigned tg = og / nx;
            if (og + 1u == (tg + 1u) * nx) xb_add(&bar[XB_TOPGEN], 1u);
            else XB_SPIN(xb_ld(&bar[XB_TOPGEN]) == tg, bar);
            __builtin_amdgcn_fence(__ATOMIC_ACQUIRE, "agent");
            xb_add(&bar[XB_XGEN(b.x)], 1u);
            asm volatile("s_waitcnt vmcnt(0)" ::: "memory");
        } else {
            XB_SPIN(xb_ld(&bar[XB_XGEN(b.x)]) == gen, bar);
            __builtin_amdgcn_fence(__ATOMIC_ACQUIRE, "agent");
            asm volatile("s_waitcnt vmcnt(0)" ::: "memory");
        }
    }
    __syncthreads();
}

typedef short s16x4 __attribute__((ext_vector_type(4)));
typedef float f32x2 __attribute__((ext_vector_type(2)));
typedef unsigned v2u __attribute__((ext_vector_type(2)));
__device__ __forceinline__ unsigned pkbf(float lo, float hi) { return pg8::cvt_pk_bf16(lo, hi); }
__device__ __forceinline__ float wave_sum(float v) {
#pragma unroll
    for (int o = 1; o < 64; o <<= 1) v += __shfl_xor(v, o);
    return v;
}
template <int CTRL, int RM> __device__ __forceinline__ float dpp_add(float v) {
    return v + __builtin_bit_cast(float, __builtin_amdgcn_update_dpp(0, __builtin_bit_cast(int, v), CTRL, RM, 0xf, true));
}
__device__ __forceinline__ float wave_scan_incl(float v, int) {
    v = dpp_add<0x111, 0xf>(v); v = dpp_add<0x112, 0xf>(v); v = dpp_add<0x114, 0xf>(v); v = dpp_add<0x118, 0xf>(v);
    v = dpp_add<0x142, 0xa>(v); v = dpp_add<0x143, 0xc>(v); return v;
}
template <int CTRL, int RM> __device__ __forceinline__ void dpp_add16(float* v) {
#pragma unroll
    for (int i = 0; i < 16; ++i) v[i] = dpp_add<CTRL, RM>(v[i]);
}
__device__ __forceinline__ void wave_scan16(float* v) {
    dpp_add16<0x111, 0xf>(v); dpp_add16<0x112, 0xf>(v); dpp_add16<0x114, 0xf>(v); dpp_add16<0x118, 0xf>(v); dpp_add16<0x142, 0xa>(v); dpp_add16<0x143, 0xc>(v);
}
__device__ __forceinline__ void unpack8(const v4u v, float* f) {
    f[0] = __uint_as_float(v.x << 16); f[1] = __uint_as_float(v.x & 0xffff0000u); f[2] = __uint_as_float(v.y << 16); f[3] = __uint_as_float(v.y & 0xffff0000u);
    f[4] = __uint_as_float(v.z << 16); f[5] = __uint_as_float(v.z & 0xffff0000u); f[6] = __uint_as_float(v.w << 16); f[7] = __uint_as_float(v.w & 0xffff0000u);
}
__device__ __forceinline__ v4u pack8(const float* f) { v4u o; o.x = pkbf(f[0], f[1]); o.y = pkbf(f[2], f[3]); o.z = pkbf(f[4], f[5]); o.w = pkbf(f[6], f[7]); return o; }
__device__ __forceinline__ s16x4 lds_tr(LAS const unsigned char* p) { return __builtin_bit_cast(s16x4, __builtin_amdgcn_ds_read_tr16_b64_v4i16((LAS s16x4*)p)); }
__device__ __forceinline__ bf16x8 tr_pair(LAS const unsigned char* p0, LAS const unsigned char* p1) {
    const s16x4 a = lds_tr(p0), b = lds_tr(p1); return __builtin_shufflevector(a, b, 0, 1, 2, 3, 4, 5, 6, 7);
}
__device__ __forceinline__ float fexp2(float x) { return __builtin_amdgcn_exp2f(x); }
__device__ __forceinline__ float frcp(float x) { return __builtin_amdgcn_rcpf(x); }
__device__ __forceinline__ float lane63(float v) { return __builtin_bit_cast(float, __builtin_amdgcn_readlane(__builtin_bit_cast(int, v), 63)); }
__device__ __forceinline__ float flog2(float x) { return __builtin_amdgcn_logf(x); }

constexpr size_t ZB_GQ = (size_t)GM * 4096, ZB_GK = ZB_GQ + (size_t)GM * 512, ZB_HQ = ZB_GK + (size_t)GM * 512, ZB_HFF = ZB_HQ + (size_t)GM * 1024, ZB_HFB = ZB_HFF + (size_t)GM * 1024;
constexpr int ZRW = 4096, ZR_GV = 0, ZR_GOG = 1024, ZR_HI = 2048, ZR_HOG = 3072;
__device__ __forceinline__ size_t blk_off(int chunk, int H, int hh, int w) { return (size_t)((chunk * H + hh) * 8 + w) * 1024; }
struct Ctx {
    const float *x_prompt, *x_sample, *w_in, *w_lr2, *b_lr, *gla_g, *hg_g, *lowb, *w_out, *ln1_g, *ln1_b, *w_up, *w_down, *ln2_g, *ln2_b;
    float* out;
    bf16 *Win_t, *Wout_t, *Wup_t, *Wdn_t, *Wglr_t, *HB, *Z, *O, *ST;
    float *BG, *TOT, *TOTS; bf16 *STS, *MF;
};

__device__ __forceinline__ void transpose_item(const float* W, int N, int kb, int nb, bf16* dst, int K, LAS float* scr, int lane) {
    const int k0 = 64 * kb, n0 = 32 * nb;
#pragma unroll 8
    for (int i = 0; i < 32; ++i) { const int kk = 2 * i + (lane >> 5); scr[kk * 33 + (lane & 31)] = W[(size_t)(k0 + kk) * N + n0 + (lane & 31)]; }
    LDS_WAIT(); asm volatile("" ::: "memory");
    const int c = lane & 7;
#pragma unroll
    for (int j = 0; j < 4; ++j) { const int n = (lane >> 3) + 8 * j; const LAS float* s = scr + (8 * c) * 33 + n;
        v4u o; o.x = pkbf(s[0 * 33], s[1 * 33]); o.y = pkbf(s[2 * 33], s[3 * 33]); o.z = pkbf(s[4 * 33], s[5 * 33]); o.w = pkbf(s[6 * 33], s[7 * 33]);
        *(GAS v4u*)(dst + (size_t)n * K + k0 + 8 * c) = o; }
    LDS_WAIT(); asm volatile("" ::: "memory");
}
__device__ __forceinline__ void prologue_weights(const Ctx& X, LAS unsigned char* lds, int gw, int NGW, int wave, int lane) {
    LAS float* scr = (LAS float*)(lds + wave * 16384);
    constexpr int I_IN = 32 * 257, I_OUT = 32 * 64, I_UP = 32 * 256, I_DN = 128 * 64, I_L = I_IN + I_OUT + I_UP + I_DN;
    for (int it = gw; it < NLAYER * I_L; it += NGW) {
        const int l = it / I_L; int r = it % I_L;
        if (r < I_IN) { const int kb = r / 257, nb = r % 257;
            bf16* dst = (nb < 96) ? X.Win_t + ((size_t)l * ZW + 32 * nb) * DM : (nb == 96) ? X.Wglr_t + (size_t)l * 32 * DM : X.Win_t + ((size_t)l * ZW + 32 * (nb - 1)) * DM;
            transpose_item(X.w_in + (size_t)l * DM * INW, INW, kb, nb, dst, DM, scr, lane); continue; }
        r -= I_IN;
        if (r < I_OUT) { const int kb = r / 64, nb = r % 64; transpose_item(X.w_out + (size_t)l * DM * DM, DM, kb, nb, X.Wout_t + ((size_t)l * DM + 32 * nb) * DM, DM, scr, lane); continue; }
        r -= I_OUT;
        if (r < I_UP) { const int kb = r / 256, nb = r % 256; transpose_item(X.w_up + (size_t)l * DM * DFF, DFF, kb, nb, X.Wup_t + ((size_t)l * DFF + 32 * nb) * DM, DM, scr, lane); continue; }
        r -= I_UP;
        { const int kb = r / 64, nb = r % 64; transpose_item(X.w_down + (size_t)l * DFF * DM, DM, kb, nb, X.Wdn_t + ((size_t)l * DM + 32 * nb) * DFF, DFF, scr, lane); }
    }
}
__device__ __forceinline__ void cvt_group(const float* xg, bf16* HB, int gtid, int NT) {
    for (int i = gtid; i < GM * DM / 8; i += NT) {
        const f32x4 a = ((const GAS f32x4*)xg)[2 * i], b = ((const GAS f32x4*)xg)[2 * i + 1];
        v4u o; o.x = pkbf(a.x, a.y); o.y = pkbf(a.z, a.w); o.z = pkbf(b.x, b.y); o.w = pkbf(b.z, b.w);
        ((GAS v4u*)HB)[i] = o; }
}
template <bool RES_F32, bool OUT_F32>
__device__ __forceinline__ void ln_phase(const void* res, const bf16* mf, const float* gam, const float* bet, float* H, bf16* HB, int gw, int NGW, int lane) {
    for (int m = gw; m < GM; m += NGW) {
        f32x4 v[8]; float s = 0.f;
        const GAS v2u* mr = (const GAS v2u*)(mf + (size_t)m * DM) + lane;
#pragma unroll
        for (int j = 0; j < 8; ++j) { f32x4 r;
            if (RES_F32) r = ((const GAS f32x4*)((const float*)res + (size_t)m * DM) + lane)[64 * j];
            else { const v2u w = ((const GAS v2u*)((const bf16*)res + (size_t)m * DM) + lane)[64 * j];
                r = (f32x4){__uint_as_float(w.x << 16), __uint_as_float(w.x & 0xffff0000u), __uint_as_float(w.y << 16), __uint_as_float(w.y & 0xffff0000u)}; }
            const v2u w = mr[64 * j];
            const f32x4 f = (f32x4){__uint_as_float(w.x << 16), __uint_as_float(w.x & 0xffff0000u), __uint_as_float(w.y << 16), __uint_as_float(w.y & 0xffff0000u)};
            v[j] = r * ALPHA + f; s += (v[j].x + v[j].y) + (v[j].z + v[j].w); }
        const float mean = wave_sum(s) * (1.f / DM); float s2 = 0.f;
#pragma unroll
        for (int j = 0; j < 8; ++j) { v[j] = v[j] - mean; s2 += (v[j].x * v[j].x + v[j].y * v[j].y) + (v[j].z * v[j].z + v[j].w * v[j].w); }
        const float rstd = 1.f / sqrtf(wave_sum(s2) * (1.f / DM) + LN_EPS);
#pragma unroll
        for (int j = 0; j < 8; ++j) { const f32x4 g4 = ((const GAS f32x4*)gam)[lane + 64 * j], b4 = ((const GAS f32x4*)bet)[lane + 64 * j];
            const f32x4 o = v[j] * rstd * g4 + b4;
            if (OUT_F32) ((GAS f32x4*)(H + (size_t)m * DM) + lane)[64 * j] = o;
            else { v2u w; w.x = pkbf(o.x, o.y); w.y = pkbf(o.z, o.w); ((GAS v2u*)(HB + (size_t)m * DM) + lane)[64 * j] = w; } }
    }
}

__device__ __forceinline__ void gate_unit(const Ctx& X, int l, int chunk, LAS unsigned char* lds, int tid, int lane, int wave) {
    const int fr = lane & 15, fq = lane >> 4;
    const bf16* A = X.HB + (size_t)chunk * 64 * DM; const bf16* Bw = X.Wglr_t + (size_t)l * 32 * DM;
    f32x4 acc[4][2];
#pragma unroll
    for (int m = 0; m < 4; ++m)
#pragma unroll
        for (int n = 0; n < 2; ++n) acc[m][n] = (f32x4){0.f, 0.f, 0.f, 0.f};
#pragma unroll 2
    for (int ks = 0; ks < 8; ++ks) { const int k0 = 256 * wave + 32 * ks + 8 * fq;
        bf16x8 a[4], b[2];
#pragma unroll
        for (int m = 0; m < 4; ++m) a[m] = *(const GAS bf16x8*)(A + (size_t)(16 * m + fr) * DM + k0);
#pragma unroll
        for (int n = 0; n < 2; ++n) b[n] = *(const GAS bf16x8*)(Bw + (size_t)(16 * n + fr) * DM + k0);
#pragma unroll
        for (int m = 0; m < 4; ++m)
#pragma unroll
            for (int n = 0; n < 2; ++n) acc[m][n] = __builtin_amdgcn_mfma_f32_16x16x32_bf16(a[m], b[n], acc[m][n], 0, 0, 0); }
    LAS float* part = (LAS float*)lds;
#pragma unroll
    for (int m = 0; m < 4; ++m)
#pragma unroll
        for (int n = 0; n < 2; ++n)
#pragma unroll
            for (int j = 0; j < 4; ++j) part[(wave * 64 + 16 * m + 4 * fq + j) * 33 + 16 * n + fr] = acc[m][n][j];
    __syncthreads();
    LAS float* glr = (LAS float*)(lds + 8 * 64 * 33 * 4);
#pragma unroll
    for (int k = 0; k < 4; ++k) { const int idx = tid + 512 * k, t = idx >> 5, n = idx & 31; float s = 0.f;
#pragma unroll
        for (int w = 0; w < 8; ++w) s += part[(w * 64 + t) * 33 + n];
        glr[t * 36 + n] = s; }
    __syncthreads();
    const int dir = wave >> 2;
    const float* w2 = X.w_lr2 + (size_t)(l * 2 + dir) * 16 * 512; const float* bl = X.b_lr + (size_t)(l * 2 + dir) * 512;
    for (int cb = 0; cb < 2; ++cb) { const int c = 128 * (wave & 3) + 64 * cb + lane;
        float w[16];
#pragma unroll
        for (int r = 0; r < 16; ++r) w[r] = w2[r * 512 + c];
        const float bias = bl[c]; float run = 0.f;
        float* bgcol = X.BG + ((size_t)(((chunk * 4 + (c >> 7)) * 8 + ((c & 127) >> 4)) * 2 + dir) * 64) * 16 + (c & 15);
#pragma unroll 4
        for (int tt = 0; tt < 64; ++tt) { const int t = dir ? 63 - tt : tt;
            const LAS f32x4* gr = (const LAS f32x4*)(glr + t * 36 + dir * 16); const f32x4 g0 = gr[0], g1 = gr[1], g2 = gr[2], g3 = gr[3];
            float pre = bias;
            pre += g0.x * w[0] + g0.y * w[1] + g0.z * w[2] + g0.w * w[3]; pre += g1.x * w[4] + g1.y * w[5] + g1.z * w[6] + g1.w * w[7];
            pre += g2.x * w[8] + g2.y * w[9] + g2.z * w[10] + g2.w * w[11]; pre += g3.x * w[12] + g3.y * w[13] + g3.z * w[14] + g3.w * w[15];
            run += (fminf(pre, 0.f) - __logf(1.f + __expf(-fabsf(pre)))) * (LOG2E / 16.f);
            bgcol[(size_t)t * 16] = run; } }
    __syncthreads();
}

__device__ __forceinline__ size_t st_slot(int chunk, bool hgt, int h, int dir) { return (size_t)chunk * ST_CHUNK + (hgt ? 262144 + (h * 2 + dir) * 16384 : (h * 2 + dir) * 32768); }

template <bool HGT> struct RawIn { f32x4 b[4]; v4u k[2]; };
template <> struct RawIn<true> { v4u k[2]; };
template <bool HGT>
__device__ __forceinline__ RawIn<HGT> pass_s_load(const Ctx& X, int chunk, int h, int dir, int lane, int c0) {
    RawIn<HGT> r; const int rt = dir ? 63 - lane : lane, w = c0 >> 4;
    if constexpr (!HGT) { const GAS f32x4* bg = (const GAS f32x4*)(X.BG + ((size_t)(((chunk * 4 + h) * 8 + w) * 2 + dir) * 64 + rt) * 16);
#pragma unroll
        for (int i = 0; i < 4; ++i) r.b[i] = bg[i];
        const GAS v4u* kp = (const GAS v4u*)(X.Z + ZB_GK + blk_off(chunk, 4, h, w) + rt * 16); r.k[0] = kp[0]; r.k[1] = kp[1];
    } else { const GAS v4u* zp = (const GAS v4u*)(X.Z + (dir ? ZB_HFB : ZB_HFF) + blk_off(chunk, 8, h, w) + rt * 16); r.k[0] = zp[0]; r.k[1] = zp[1]; }
    return r;
}
template <bool HGT, bool STORE>
__device__ __forceinline__ void pass_s_unit(const Ctx& X, int l, int sc, int h, LAS unsigned char* lds, int tid, int lane, int wave) {
    constexpr int DV = HGT ? 128 : 256, VSTR = DV * 2 + 16, NE = DV / 16, PPR = DV / 8, UNR_D = HGT ? 2 : 1, UNR_C = HGT ? 4 : 1;
    const int fr = lane & 15, fq = lane >> 4, qq = fr >> 2, p4 = fr & 3, c0 = 16 * wave;
    RawIn<HGT> cur = pass_s_load<HGT>(X, sc * 4, h, 0, lane, c0);
    RawIn<HGT> rq[HGT ? 4 : 1];
    { const int vcol = HGT ? ZR_HI + h * 128 : ZR_GV + h * 256;
#pragma unroll 4
      for (int k = 0; k < 256 * PPR / 512; ++k) { const int idx = tid + 512 * k, row = idx / PPR, pc = idx % PPR;
        const v4u v = *(const GAS v4u*)(X.Z + (size_t)(sc * 256 + row) * ZRW + vcol + pc * 8);
        *(LAS v4u*)(lds + row * VSTR + pc * 16) = v; } }
    __syncthreads();
    LAS unsigned char* kt = lds + SV_KT + wave * KTW_BYTES;
    for (int dir = 0; dir < 2; ++dir) {
        const int hd = HGT ? 8 + h * 2 + dir : h * 2 + dir;
        if constexpr (HGT) {
#pragma unroll
            for (int q4 = 0; q4 < 4; ++q4) rq[q4] = pass_s_load<HGT>(X, sc * 4 + (dir ? 3 - q4 : q4), h, dir, lane, c0); }
        float lbv[16];
        if (HGT) {
#pragma unroll
            for (int i = 0; i < 16; ++i) lbv[i] = 0.f;
            if (l != 0) { const float* lp = X.lowb + (size_t)dir * 2 * 1024 + h * 128 + c0;
#pragma unroll
                for (int i = 0; i < 16; ++i) lbv[i] = frcp(1.f + __expf(lp[i] - lp[1024 + i])); } }
        f32x4 acc[NE];
        if (STORE) { const bf16* sin = X.STS + st_slot(sc, HGT, h, dir);
#pragma unroll
            for (int et = 0; et < NE; ++et) { const v2u w = *(const GAS v2u*)(sin + (size_t)((et * 4 + (wave >> 1)) * 64 + fr + 16 * (2 * (wave & 1) + (fq >> 1))) * 8 + 4 * (fq & 1));
                acc[et] = (f32x4){__uint_as_float(w.x << 16), __uint_as_float(w.x & 0xffff0000u), __uint_as_float(w.y << 16), __uint_as_float(w.y & 0xffff0000u)}; }
        } else {
#pragma unroll
            for (int et = 0; et < NE; ++et) acc[et] = (f32x4){0.f, 0.f, 0.f, 0.f}; }
        float run[16];
#pragma unroll
        for (int i = 0; i < 16; ++i) run[i] = 0.f;
#pragma unroll UNR_C
        for (int cc = 0; cc < 4; ++cc) { const int ci = dir ? 3 - cc : cc, chunk = sc * 4 + ci;
            RawIn<HGT> nxt = cur;
            if constexpr (HGT) cur = rq[cc];
            else { if (cc < 3) nxt = pass_s_load<HGT>(X, sc * 4 + (dir ? 2 - cc : cc + 1), h, dir, lane, c0);
                   else if (dir == 0) nxt = pass_s_load<HGT>(X, sc * 4 + 3, h, 1, lane, c0); }
            float bc[16], kr[16];
            if constexpr (!HGT) {
#pragma unroll
                for (int i = 0; i < 4; ++i) { bc[4 * i] = cur.b[i].x; bc[4 * i + 1] = cur.b[i].y; bc[4 * i + 2] = cur.b[i].z; bc[4 * i + 3] = cur.b[i].w; }
                unpack8(cur.k[0], kr); unpack8(cur.k[1], kr + 8);
            } else {
                float zf[16]; unpack8(cur.k[0], zf); unpack8(cur.k[1], zf + 8);
#pragma unroll
                for (int i = 0; i < 16; ++i) {
                    const float z = fmaxf(zf[i], -80.f), e = __expf(-z), sig = frcp(1.f + e), oml = 1.f - lbv[i];
                    kr[i] = oml * e * sig;
                    bc[i] = flog2(lbv[i] + oml * sig); }
                wave_scan16(bc);
            }
            if (STORE) { bf16* slot = X.ST + st_slot(chunk, HGT, h, dir);
#pragma unroll
                for (int et = 0; et < NE; ++et) { v2u w; w.x = pkbf(acc[et][0], acc[et][1]); w.y = pkbf(acc[et][2], acc[et][3]);
                    *(GAS v2u*)(slot + (size_t)((et * 4 + (wave >> 1)) * 64 + fr + 16 * (2 * (wave & 1) + (fq >> 1))) * 8 + 4 * (fq & 1)) = w; }
                if (cc == 3) { cur = nxt; break; } }
            float kh[16];
#pragma unroll
            for (int i = 0; i < 16; ++i) { const float bl = lane63(bc[i]); kh[i] = kr[i] * fexp2(bl - bc[i]); run[i] += bl; }
            { const v4u k0 = pack8(kh), k1 = pack8(kh + 8); const unsigned kw[8] = {k0.x, k0.y, k0.z, k0.w, k1.x, k1.y, k1.z, k1.w};
#pragma unroll
              for (int i = 0; i < 16; ++i) *(LAS unsigned short*)(kt + i * KT_STR + lane * 2) = (unsigned short)((i & 1) ? (kw[i >> 1] >> 16) : (kw[i >> 1] & 0xffffu)); }
            if (lane == 63) {
#pragma unroll
                for (int i = 0; i < 4; ++i) ((LAS f32x4*)(kt + 2304))[i] = (f32x4){bc[4 * i], bc[4 * i + 1], bc[4 * i + 2], bc[4 * i + 3]}; }
            asm volatile("s_waitcnt lgkmcnt(0)" ::: "memory");
            const f32x4 dl = *(const LAS f32x4*)(kt + 2304 + 16 * fq);
            const f32x4 dec = (f32x4){fexp2(dl.x), fexp2(dl.y), fexp2(dl.z), fexp2(dl.w)};
            bf16x8 afr[2];
#pragma unroll
            for (int ks = 0; ks < 2; ++ks) afr[ks] = *(const LAS bf16x8*)(kt + fr * KT_STR + (32 * ks + 8 * fq) * 2);
#pragma unroll
            for (int et = 0; et < NE; ++et) acc[et] = acc[et] * dec;
            { constexpr int NB = 2 * NE / 4;
              LAS const unsigned char* vb[2][2];
#pragma unroll
              for (int ks = 0; ks < 2; ++ks) { const int r0 = 32 * ks + 8 * fq + qq, r1 = r0 + 4;
                  vb[ks][0] = lds + (ci * 64 + (dir ? 63 - r0 : r0)) * VSTR + 8 * p4; vb[ks][1] = lds + (ci * 64 + (dir ? 63 - r1 : r1)) * VSTR + 8 * p4; }
              bf16x8 bb[2][4];
#pragma unroll
              for (int j = 0; j < 4; ++j) bb[0][j] = tr_pair(vb[0][0] + 32 * j, vb[0][1] + 32 * j);
#pragma unroll
              for (int b = 0; b < NB; ++b) {
                  if (b + 1 < NB) { const int ks1 = (b + 1) / (NE / 4), e1 = 4 * ((b + 1) % (NE / 4));
#pragma unroll
                      for (int j = 0; j < 4; ++j) bb[(b + 1) & 1][j] = tr_pair(vb[ks1][0] + 32 * (e1 + j), vb[ks1][1] + 32 * (e1 + j)); }
                  const int ks0 = b / (NE / 4), e0 = 4 * (b % (NE / 4));
#pragma unroll
                  for (int j = 0; j < 4; ++j) acc[e0 + j] = __builtin_amdgcn_mfma_f32_16x16x32_bf16(afr[ks0], bb[b & 1][j], acc[e0 + j], 0, 0, 0);
                  __builtin_amdgcn_sched_group_barrier(0x100, 8, 0); __builtin_amdgcn_sched_group_barrier(0x008, 4, 0); } }
            asm volatile("s_waitcnt lgkmcnt(0)" ::: "memory");
            cur = nxt;
        }
        if (!STORE) { bf16* sout = X.STS + st_slot(sc, HGT, h, dir);
#pragma unroll
            for (int et = 0; et < NE; ++et) { v2u w; w.x = pkbf(acc[et][0], acc[et][1]); w.y = pkbf(acc[et][2], acc[et][3]);
                *(GAS v2u*)(sout + (size_t)((et * 4 + (wave >> 1)) * 64 + fr + 16 * (2 * (wave & 1) + (fq >> 1))) * 8 + 4 * (fq & 1)) = w; }
            if (lane == 0) { float* tp = X.TOTS + ((size_t)sc * 24 + hd) * 128 + c0;
#pragma unroll
                for (int i = 0; i < 4; ++i) ((GAS f32x4*)tp)[i] = (f32x4){run[4 * i], run[4 * i + 1], run[4 * i + 2], run[4 * i + 3]}; } }
    }
    __syncthreads();
}
__device__ __forceinline__ void pass_b_super(const Ctx& X, int g, int gtid, int NT) {
    const int ns = (g == 0) ? 1 : 2, nc = NSC / ns;
    for (int v = gtid; v < ns * (ST_CHUNK / 8); v += NT) {
        const int s = v / (ST_CHUNK / 8), idx = (v % (ST_CHUNK / 8)) * 8;
        const int hd = idx < 262144 ? idx / 32768 : 8 + (idx - 262144) / 16384, db = hd & 1;
        const int d0 = 32 * ((idx >> 9) & 3) + 8 * ((idx >> 7) & 3);
        float S[8];
#pragma unroll
        for (int i = 0; i < 8; ++i) S[i] = 0.f;
        for (int cc = 0; cc < nc; cc += 8) {
            v4u x[8]; f32x4 t0[8], t1[8];
#pragma unroll
            for (int u = 0; u < 8; ++u) { const int c = s * nc + (db ? nc - 1 - (cc + u) : cc + u);
                x[u] = *(const GAS v4u*)(X.STS + (size_t)c * ST_CHUNK + idx);
                const GAS f32x4* tp = (const GAS f32x4*)(X.TOTS + ((size_t)c * 24 + hd) * 128 + d0); t0[u] = tp[0]; t1[u] = tp[1]; }
#pragma unroll
            for (int u = 0; u < 8; ++u) { const int c = s * nc + (db ? nc - 1 - (cc + u) : cc + u);
                *(GAS v4u*)(X.STS + (size_t)c * ST_CHUNK + idx) = pack8(S);
                float dx[8]; unpack8(x[u], dx);
                const float dec[8] = {fexp2(t0[u].x), fexp2(t0[u].y), fexp2(t0[u].z), fexp2(t0[u].w), fexp2(t1[u].x), fexp2(t1[u].y), fexp2(t1[u].z), fexp2(t1[u].w)};
#pragma unroll
                for (int i = 0; i < 8; ++i) S[i] = dec[i] * S[i] + dx[i]; }
        }
    }
}

constexpr int C2_DIR = 63488, C2_QD = 0, C2_KD = 17408, C2_QH = 34816, C2_P = 52224, C2_BT = 61440, C2_V = 126976, C2_RED = 160768;
template <bool HGT>
__device__ __forceinline__ void c2_stage(const Ctx& X, int l, int chunk, int h, int dir, LAS unsigned char* ld, int lane, int wave) {
    const int r = lane, rt = dir ? 63 - r : r, c0 = 16 * wave;
    float bc[16], kr[16], qv[16];
    if (!HGT) {
        const GAS f32x4* bg = (const GAS f32x4*)(X.BG + ((size_t)(((chunk * 4 + h) * 8 + wave) * 2 + dir) * 64 + rt) * 16);
#pragma unroll
        for (int i = 0; i < 4; ++i) { const f32x4 t = bg[i]; bc[4 * i] = t.x; bc[4 * i + 1] = t.y; bc[4 * i + 2] = t.z; bc[4 * i + 3] = t.w; }
        const GAS v4u* kp = (const GAS v4u*)(X.Z + ZB_GK + blk_off(chunk, 4, h, wave) + rt * 16); unpack8(kp[0], kr); unpack8(kp[1], kr + 8);
        const GAS v4u* qp = (const GAS v4u*)(X.Z + ZB_GQ + blk_off(chunk, 4, h, wave) + rt * 16); unpack8(qp[0], qv); unpack8(qp[1], qv + 8);
#pragma unroll
        for (int i = 0; i < 16; ++i) qv[i] *= 0.08838834764831845f;
    } else {
        float zf[16];
        const GAS v4u* zp = (const GAS v4u*)(X.Z + (dir ? ZB_HFB : ZB_HFF) + blk_off(chunk, 8, h, wave) + rt * 16); unpack8(zp[0], zf); unpack8(zp[1], zf + 8);
        const GAS v4u* qp = (const GAS v4u*)(X.Z + ZB_HQ + blk_off(chunk, 8, h, wave) + rt * 16); unpack8(qp[0], qv); unpack8(qp[1], qv + 8);
        float lbv[16];
        if (l == 0) {
#pragma unroll
            for (int i = 0; i < 16; ++i) lbv[i] = 0.f;
        } else { const float* lp = X.lowb + (size_t)dir * 2 * 1024 + h * 128 + c0;
#pragma unroll
            for (int i = 0; i < 16; ++i) lbv[i] = frcp(1.f + __expf(lp[i] - lp[1024 + i])); }
#pragma unroll
        for (int i = 0; i < 16; ++i) {
            const float z = fmaxf(zf[i], -80.f), e = __expf(-z), sig = frcp(1.f + e), oml = 1.f - lbv[i];
            kr[i] = oml * e * sig;
            bc[i] = flog2(lbv[i] + oml * sig); }
        wave_scan16(bc);
    }
    float qd[16], kd[16], qh[16];
#pragma unroll
    for (int i = 0; i < 16; ++i) {
        const float beta = __builtin_bit_cast(float, __builtin_amdgcn_update_dpp(0, __builtin_bit_cast(int, bc[i]), 0x142, 0xe, 0xf, false));
        qd[i] = qv[i] * fexp2(bc[i] - beta); kd[i] = kr[i] * fexp2(fminf(beta - bc[i], 80.f)); qh[i] = qv[i] * fexp2(bc[i]); }
    LAS unsigned char* p = ld + r * K_STR + c0 * 2;
    ((LAS v4u*)(p + C2_QD))[0] = pack8(qd); ((LAS v4u*)(p + C2_QD))[1] = pack8(qd + 8);
    ((LAS v4u*)(p + C2_KD))[0] = pack8(kd); ((LAS v4u*)(p + C2_KD))[1] = pack8(kd + 8);
    ((LAS v4u*)(p + C2_QH))[0] = pack8(qh); ((LAS v4u*)(p + C2_QH))[1] = pack8(qh + 8);
    if ((lane & 15) == 15) { LAS f32x4* bt = (LAS f32x4*)(ld + C2_BT + (((lane >> 4) + 1) & 3) * 512 + c0 * 4);
        const bool z = lane == 63;
#pragma unroll
        for (int i = 0; i < 4; ++i) bt[i] = z ? (f32x4){0.f, 0.f, 0.f, 0.f} : (f32x4){bc[4 * i], bc[4 * i + 1], bc[4 * i + 2], bc[4 * i + 3]}; }
}
template <bool HGT>
__device__ __forceinline__ void pass_c2_unit(const Ctx& X, int l, int chunk, int h, LAS unsigned char* lds, int tid, int lane, int wave) {
    constexpr int DV = HGT ? 128 : 256, VSTR = DV * 2 + 16, NET = DV / 128, PPR = DV / 8;
    const int fr = lane & 15, fq = lane >> 4, qq = fr >> 2, p4 = fr & 3;
    { const int vcol = HGT ? ZR_HI + h * 128 : ZR_GV + h * 256;
#pragma unroll
      for (int k = 0; k < 64 * PPR / 512; ++k) { const int idx = tid + 512 * k, row = idx / PPR, pc = idx % PPR;
        const v4u v = *(const GAS v4u*)(X.Z + (size_t)(chunk * 64 + row) * ZRW + vcol + pc * 8);
        *(LAS v4u*)(lds + C2_V + row * VSTR + pc * 16) = v; } }
    c2_stage<HGT>(X, l, chunk, h, 0, lds, lane, wave);
    c2_stage<HGT>(X, l, chunk, h, 1, lds + C2_DIR, lane, wave);
    bf16x8 sfr[2][NET][4];
#pragma unroll
    for (int dir = 0; dir < 2; ++dir) { const bf16* slot = X.ST + st_slot(chunk, HGT, h, dir);
#pragma unroll
        for (int et = 0; et < NET; ++et)
#pragma unroll
            for (int ks = 0; ks < 4; ++ks) sfr[dir][et][ks] = *(const GAS bf16x8*)(slot + (size_t)(((wave * NET + et) * 4 + ks) * 64 + lane) * 8); }
    __syncthreads();
    { const int a = wave & 3; LAS unsigned char* ld = lds + (wave >> 2) * C2_DIR;
      const unsigned lst = (a == 0) ? 0xff002010u : (a == 1) ? 0xff113021u : (a == 2) ? 0xffff2231u : 0xffff3332u;
      const unsigned zls = (a == 0) ? 0xffff0201u : (a == 1) ? 0xffff1203u : (a == 2) ? 0xffffff13u : 0xffffff23u;
      for (int t = 0; t < 3; ++t) { const unsigned code = (lst >> (8 * t)) & 0xffu; if (code == 0xffu) break;
          const int I = (int)(code >> 4), J = (int)(code & 15u);
          f32x4 sc = (f32x4){0.f, 0.f, 0.f, 0.f};
#pragma unroll
          for (int ks = 0; ks < 4; ++ks) { const int dc = 32 * ks + 8 * fq;
              v4u ka = *(const LAS v4u*)(ld + C2_KD + (16 * J + fr) * K_STR + dc * 2);
              const bf16x8 qb = *(const LAS bf16x8*)(ld + C2_QD + (16 * I + fr) * K_STR + dc * 2);
              if (J < I) { const LAS f32x4* bi = (const LAS f32x4*)(ld + C2_BT + I * 512 + dc * 4); const LAS f32x4* bj = (const LAS f32x4*)(ld + C2_BT + J * 512 + dc * 4);
                  const f32x4 d0 = bi[0] - bj[0], d1 = bi[1] - bj[1]; float kf[8]; unpack8(ka, kf);
                  kf[0] *= fexp2(d0.x); kf[1] *= fexp2(d0.y); kf[2] *= fexp2(d0.z); kf[3] *= fexp2(d0.w); kf[4] *= fexp2(d1.x); kf[5] *= fexp2(d1.y); kf[6] *= fexp2(d1.z); kf[7] *= fexp2(d1.w);
                  ka = pack8(kf); }
              sc = __builtin_amdgcn_mfma_f32_16x16x32_bf16(__builtin_bit_cast(bf16x8, ka), qb, sc, 0, 0, 0); }
          if (J == I) {
#pragma unroll
              for (int u = 0; u < 4; ++u) if (4 * fq + u > fr) sc[u] = 0.f; }
          v2u w; w.x = pkbf(sc[0], sc[1]); w.y = pkbf(sc[2], sc[3]);
          *(LAS v2u*)(ld + C2_P + (16 * I + fr) * P_STR + (16 * J + 4 * fq) * 2) = w; }
      for (int t = 0; t < 2; ++t) { const unsigned code = (zls >> (8 * t)) & 0xffu; if (code == 0xffu) break;
          const int I = (int)(code >> 4), J = (int)(code & 15u);
          *(LAS v2u*)(ld + C2_P + (16 * I + fr) * P_STR + (16 * J + 4 * fq) * 2) = (v2u){0u, 0u}; } }
    __syncthreads();
    f32x4 oacc[NET][4];
#pragma unroll
    for (int et = 0; et < NET; ++et)
#pragma unroll
        for (int it = 0; it < 4; ++it) oacc[et][it] = (f32x4){0.f, 0.f, 0.f, 0.f};
#pragma unroll
    for (int dir = 0; dir < 2; ++dir) { LAS const unsigned char* ld = lds + dir * C2_DIR;
        bf16x8 vfr[NET][2];
#pragma unroll
        for (int ks = 0; ks < 2; ++ks) { const int r0 = 32 * ks + 8 * fq + qq, r1 = r0 + 4, v0 = dir ? 63 - r0 : r0, v1 = dir ? 63 - r1 : r1;
#pragma unroll
            for (int et = 0; et < NET; ++et) { const int col = (16 * (wave * NET + et) + 4 * p4) * 2;
                vfr[et][ks] = tr_pair(lds + C2_V + v0 * VSTR + col, lds + C2_V + v1 * VSTR + col); } }
#pragma unroll
        for (int it = 0; it < 4; ++it) { const int trow = 16 * it + fr, ip = dir ? 63 - trow : trow;
            bf16x8 bo[6];
#pragma unroll
            for (int ks = 0; ks < 4; ++ks) bo[ks] = *(const LAS bf16x8*)(ld + C2_QH + ip * K_STR + (32 * ks + 8 * fq) * 2);
#pragma unroll
            for (int ks = 0; ks < 2; ++ks) bo[4 + ks] = *(const LAS bf16x8*)(ld + C2_P + ip * P_STR + (32 * ks + 8 * fq) * 2);
#pragma unroll
            for (int ks = 0; ks < 4; ++ks)
#pragma unroll
                for (int et = 0; et < NET; ++et) oacc[et][it] = __builtin_amdgcn_mfma_f32_16x16x32_bf16(sfr[dir][et][ks], bo[ks], oacc[et][it], 0, 0, 0);
#pragma unroll
            for (int ks = 0; ks < 2; ++ks)
#pragma unroll
                for (int et = 0; et < NET; ++et) oacc[et][it] = __builtin_amdgcn_mfma_f32_16x16x32_bf16(vfr[et][ks], bo[4 + ks], oacc[et][it], 0, 0, 0); } }
    LAS float* red = (LAS float*)(lds + C2_RED);
#pragma unroll
    for (int it = 0; it < 4; ++it) { float sq = 0.f;
#pragma unroll
        for (int et = 0; et < NET; ++et) { const f32x4 o = oacc[et][it]; sq += (o.x * o.x + o.y * o.y) + (o.z * o.z + o.w * o.w); }
        sq += __shfl_xor(sq, 16); sq += __shfl_xor(sq, 32);
        if (fq == 0) red[wave * 64 + 16 * it + fr] = sq; }
    __syncthreads();
    const float* ng = (HGT ? X.hg_g + (size_t)l * 128 : X.gla_g + (size_t)l * 256);
    const int ogcol = HGT ? ZR_HOG + h * 128 : ZR_GOG + h * 256, ocol = HGT ? 1024 + h * 128 : h * 256;
#pragma unroll
    for (int it = 0; it < 4; ++it) { float tot = 0.f;
#pragma unroll
        for (int w = 0; w < 8; ++w) tot += red[w * 64 + 16 * it + fr];
        const float rstd = __builtin_amdgcn_rsqf(tot * (1.f / DV) + RMS_EPS);
        const int tok = chunk * 64 + 16 * it + fr;
#pragma unroll
        for (int et = 0; et < NET; ++et) { const int e0 = 16 * (wave * NET + et) + 4 * fq;
            const v2u ogp = *(const GAS v2u*)(X.Z + (size_t)tok * ZRW + ogcol + e0);
            const float og[4] = {__uint_as_float(ogp.x << 16), __uint_as_float(ogp.x & 0xffff0000u), __uint_as_float(ogp.y << 16), __uint_as_float(ogp.y & 0xffff0000u)};
            const f32x4 g4 = *(const GAS f32x4*)(ng + e0); float rr[4];
#pragma unroll
            for (int u = 0; u < 4; ++u) { const float z = fminf(fmaxf(og[u], -80.f), 80.f); rr[u] = oacc[et][it][u] * rstd * g4[u] * (z * frcp(1.f + __expf(-z))); }
            v2u w; w.x = pkbf(rr[0], rr[1]); w.y = pkbf(rr[2], rr[3]);
            *(GAS v2u*)(X.O + (size_t)tok * DM + ocol + e0) = w; } }
}

struct Args { const float* in[15]; float* out; unsigned char* ws; int mode, pad; };
#define PHASE_IDS() int tid = threadIdx.x; asm volatile("" : "+v"(tid)); const int lane = tid & 63, wave = __builtin_amdgcn_readfirstlane(tid >> 6); \
    const int gw = bx * NWAVES + wave, NGW = G * NWAVES, gtid = bx * (NWAVES * 64) + tid, NT = G * NWAVES * 64; (void)lane; (void)wave; (void)gw; (void)NGW; (void)gtid; (void)NT
__device__ __forceinline__ Ctx make_ctx(const Args& args) {
    Ctx X; unsigned char* ws = args.ws;
    X.x_prompt = args.in[0]; X.x_sample = args.in[1]; X.w_in = args.in[2]; X.w_lr2 = args.in[3]; X.b_lr = args.in[4]; X.gla_g = args.in[5]; X.hg_g = args.in[6]; X.lowb = args.in[7];
    X.w_out = args.in[8]; X.ln1_g = args.in[9]; X.ln1_b = args.in[10]; X.w_up = args.in[11]; X.w_down = args.in[12]; X.ln2_g = args.in[13]; X.ln2_b = args.in[14]; X.out = args.out;
    X.Win_t = (bf16*)(ws + WS_WIN); X.Wout_t = (bf16*)(ws + WS_WOUT); X.Wup_t = (bf16*)(ws + WS_WUP); X.Wdn_t = (bf16*)(ws + WS_WDN); X.Wglr_t = (bf16*)(ws + WS_WGLR);
    X.HB = (bf16*)(ws + WS_HB); X.Z = (bf16*)(ws + WS_Z); X.O = (bf16*)(ws + WS_O); X.ST = (bf16*)(ws + WS_ST);
    X.BG = (float*)(ws + WS_BG); X.MF = (bf16*)(ws + WS_ST); X.TOT = (float*)(ws + WS_TOT); X.TOTS = (float*)(ws + WS_TOTS); X.STS = (bf16*)(ws + WS_STS);
    return X;
}
__global__ void __launch_bounds__(NWAVES * 64, 2) fwd_kernel(Args args) {
    extern __shared__ __attribute__((aligned(16))) unsigned char lds_raw[];
    LAS unsigned char* lds = (LAS unsigned char*)lds_raw;
    const int G = gridDim.x, bx = blockIdx.x;
    volatile LAS unsigned* MISC = (volatile LAS unsigned*)(lds + MISC_OFF);
    if (threadIdx.x < 32) MISC[threadIdx.x] = 0u;
    __syncthreads();
    XcdBarrier bar = xcd_barrier_post((unsigned*)(args.ws + WS_CTL) + CW_BAR, MISC + 8);

    { PHASE_IDS(); const Ctx X = make_ctx(args); prologue_weights(X, lds, gw, NGW, wave, lane); }
    for (int g = 0; g < NGRP; ++g) {
        { PHASE_IDS(); const Ctx X = make_ctx(args); cvt_group((g == 0) ? X.x_prompt : X.x_sample + (size_t)(g - 1) * GM * DM, X.HB, gtid, NT); }
        xcd_barrier(bar);
        for (int l = 0; l < NLAYER; ++l) {
            { PHASE_IDS(); const Ctx X = make_ctx(args); for (int c = bx; c < NCHUNK; c += G) gate_unit(X, l, c, lds, tid, lane, wave); }
            { const Ctx X = make_ctx(args); pg8::Gemm gm{X.HB, X.Win_t + (size_t)l * ZW * DM, GM, ZW, DM}; pg8::StaticOrder S; S.init(GM, ZW, G, bx);
              pg8::EpiZ E{X.Z};
              pg8::gemm_phase<pg8::EpiZ, pg8::StaticOrder, false, true>(lds, gm, S, E); }
            xcd_barrier(bar);
            {
            { PHASE_IDS(); const Ctx X = make_ctx(args);
              for (int u = bx; u < NSC * 12; u += G) { const int sc = u / 12, hh = u % 12;
                if (hh < 4) pass_s_unit<false, false>(X, l, sc, hh, lds, tid, lane, wave); else pass_s_unit<true, false>(X, l, sc, hh - 4, lds, tid, lane, wave); } }
            xcd_barrier(bar);
            { PHASE_IDS(); const Ctx X = make_ctx(args); pass_b_super(X, g, gtid, NT); }
            xcd_barrier(bar);
            { PHASE_IDS(); const Ctx X = make_ctx(args);
              for (int u = bx; u < NSC * 12; u += G) { const int sc = u / 12, hh = u % 12;
                if (hh < 4) pass_s_unit<false, true>(X, l, sc, hh, lds, tid, lane, wave); else pass_s_unit<true, true>(X, l, sc, hh - 4, lds, tid, lane, wave); } }
            xcd_barrier(bar);
            { PHASE_IDS(); const Ctx X = make_ctx(args);
              for (int u = bx; u < NCHUNK * 12; u += G) { const int c = u / 12, hh = u % 12;
                if (hh < 4) pass_c2_unit<false>(X, l, c, hh, lds, tid, lane, wave); else pass_c2_unit<true>(X, l, c, hh - 4, lds, tid, lane, wave); } }
            xcd_barrier(bar);
            }
            { const Ctx X = make_ctx(args); pg8::Gemm gm{X.O, X.Wout_t + (size_t)l * DM * DM, GM, DM, DM}; pg8::StaticOrder S; S.init(GM, DM, G, bx);
              pg8::EpiBf16<0> E{X.MF, DM};
              pg8::gemm_phase<pg8::EpiBf16<0>, pg8::StaticOrder, false, true>(lds, gm, S, E); }
            xcd_barrier(bar);
            { PHASE_IDS(); const Ctx X = make_ctx(args);
              if (l == 0) ln_phase<true, false>((g == 0) ? X.x_prompt : X.x_sample + (size_t)(g - 1) * GM * DM, X.MF, X.ln1_g, X.ln1_b, nullptr, X.HB, gw, NGW, lane);
              else ln_phase<false, false>(X.HB, X.MF, X.ln1_g + (size_t)l * DM, X.ln1_b + (size_t)l * DM, nullptr, X.HB, gw, NGW, lane); }
            xcd_barrier(bar);
            { const Ctx X = make_ctx(args); pg8::Gemm gm{X.HB, X.Wup_t + (size_t)l * DFF * DM, GM, DFF, DM}; pg8::StaticOrder S; S.init(GM, DFF, G, bx);
              pg8::EpiBf16<1> E{X.Z, DFF};
              pg8::gemm_phase<pg8::EpiBf16<1>, pg8::StaticOrder, false, true>(lds, gm, S, E); }
            xcd_barrier(bar);
            { const Ctx X = make_ctx(args); pg8::Gemm gm{X.Z, X.Wdn_t + (size_t)l * DM * DFF, GM, DM, DFF}; pg8::StaticOrder S; S.init(GM, DM, G, bx);
              pg8::EpiBf16<0> E{X.MF, DM};
              pg8::gemm_phase<pg8::EpiBf16<0>, pg8::StaticOrder, false, true>(lds, gm, S, E); }
            xcd_barrier(bar);
            { PHASE_IDS(); const Ctx X = make_ctx(args);
              if (l == NLAYER - 1) ln_phase<false, true>(X.HB, X.MF, X.ln2_g + (size_t)l * DM, X.ln2_b + (size_t)l * DM, X.out + (size_t)g * GM * DM, nullptr, gw, NGW, lane);
              else ln_phase<false, false>(X.HB, X.MF, X.ln2_g + (size_t)l * DM, X.ln2_b + (size_t)l * DM, nullptr, X.HB, gw, NGW, lane); }
            xcd_barrier(bar);
        }
    }
}

extern "C" void kernel_launch(void* const* d_in, const int* in_sizes, int n_in, void* d_out, int out_size, void* d_ws, size_t ws_size, hipStream_t stream) {
    static int grid = 0;
    if (grid == 0) {
        if (n_in != 15 || out_size != NTOK * DM || ws_size < WS_END) { fprintf(stderr, "kernel_launch: unexpected shapes (n_in %d, out %d, ws %zu)\n", n_in, out_size, ws_size); grid = -1; return; }
        int dev = 0, cus = 0;
        if (hipGetDevice(&dev) != hipSuccess || hipDeviceGetAttribute(&cus, hipDeviceAttributeMultiprocessorCount, dev) != hipSuccess) { grid = -1; return; }
        if (hipFuncSetAttribute((const void*)fwd_kernel, hipFuncAttributeMaxDynamicSharedMemorySize, LDS_BYTES) != hipSuccess) { fprintf(stderr, "kernel_launch: hipFuncSetAttribute failed\n"); grid = -1; return; }
        int per_cu = 0;
        if (hipOccupancyMaxActiveBlocksPerMultiprocessor(&per_cu, (const void*)fwd_kernel, NWAVES * 64, LDS_BYTES) != hipSuccess || per_cu < 1) { fprintf(stderr, "kernel_launch: occupancy query says %d\n", per_cu); }
        (void)hipGetLastError();
        grid = cus;
    }
    if (grid < 0) return;
    if (hipMemsetAsync((char*)d_ws + WS_CTL, 0, CTL_ZERO_BYTES, stream) != hipSuccess) return;
    Args a{};
    for (int i = 0; i < 15; ++i) a.in[i] = (const float*)d_in[i];
    a.out = (float*)d_out; a.ws = (unsigned char*)d_ws; a.mode = KMODE; a.pad = 0;
    hipLaunchKernelGGL(fwd_kernel, dim3(grid), dim3(NWAVES * 64), LDS_BYTES, stream, a);
}
```

```cpp
#include <hip/hip_runtime.h>
#include <cstdio>
#include <cstdint>
#ifndef KMODE
#define KMODE 0
#endif
namespace pg8 {
#define PG8_LAS __attribute__((address_space(3)))
typedef unsigned short bf16_t;
typedef short bf16x8 __attribute__((ext_vector_type(8)));
typedef float f32x4 __attribute__((ext_vector_type(4)));
typedef unsigned u32x4 __attribute__((ext_vector_type(4)));
constexpr int BM = 256, BK = 64, HALF = 128, HTB = HALF * BK * 2  , STAGE_BYTES = 8 * HTB, NXCD = 8, WGM = 4;

__host__ __device__ __forceinline__ int lds_byte(int r, int c) { const int st = (r >> 4) * 2 + (c >> 5), rr = r & 15, cc = c & 31, ob = rr * 64 + cc * 2; return st * 1024 + (ob ^ (((ob >> 9) & 1) << 5)); }
__host__ __device__ __forceinline__ void stage_rc(int b, int& R, int& C) { const int st = b / 1024, sb = b % 1024, swz = sb ^ (((sb >> 9) & 1) << 5); R = (st >> 1) * 16 + swz / 64; C = (st & 1) * 32 + (swz % 64) / 2; }
__host__ __device__ __forceinline__ int perm32(int rho) { const int n = rho >> 4, i = rho & 15; return 8 * (i >> 2) + 4 * n + (i & 3); }

struct Unit { int pm, pn; };
struct Gemm { const bf16_t* A; const bf16_t* Bt; int M, N, K; };

struct StaticOrder {
    int nM, nN, nwg, G, c;
    __host__ __device__ void init(int M, int N, int G_, int c_) { nM = M / BM; nN = N / BM; nwg = nM * nN; G = G_; c = c_; }
    __host__ __device__ bool next(int i, Unit& u) const {
        const long L = (long)i * G + c; if (L >= nwg) return false;
        int wgid = (int)L; { const int q = nwg / NXCD, r = nwg % NXCD, xcd = wgid % NXCD, off = wgid / NXCD; wgid = (xcd < r ? xcd * (q + 1) : r * (q + 1) + (xcd - r) * q) + off; }
        const int nig = WGM * nN, gid = wgid / nig, fm = gid * WGM, gsz = (nM - fm) < WGM ? (nM - fm) : WGM;
        u.pm = fm + ((wgid % nig) % gsz); u.pn = (wgid % nig) / gsz; return true;
    }
    __device__ __forceinline__ void a_ready(const Unit&) const {}
    __device__ __forceinline__ void done(const Unit&) const {}
};


__device__ __forceinline__ unsigned cvt_pk_bf16(float lo, float hi) { unsigned r; asm volatile("v_cvt_pk_bf16_f32 %0, %1, %2" : "=v"(r) : "v"(lo), "v"(hi)); return r; }

template <int ACT  > struct EpiBf16 {
    static constexpr bool PERM = true, AFTER_DRAIN = false;
    bf16_t* O; int ldc;
    __device__ __forceinline__ void operator()(const f32x4 (&acc)[2][2][4][2], const Unit& u, int wr, int wc, int fr, int fq) const {
        const int row0 = u.pm * BM + wr * 64 + fr; const int col0 = u.pn * BM + wc * 32 + 8 * fq;
#pragma unroll
        for (int ai = 0; ai < 2; ++ai)
#pragma unroll
            for (int m = 0; m < 4; ++m) { bf16_t* rowp = O + (size_t)(row0 + ai * HALF + m * 16) * ldc + col0;
#pragma unroll
                for (int bj = 0; bj < 2; ++bj) { f32x4 v0 = acc[ai][bj][m][0], v1 = acc[ai][bj][m][1];
                    if (ACT == 1) {
#pragma unroll
                        for (int j = 0; j < 4; ++j) { const float a = fmaxf(v0[j], 0.f), b = fmaxf(v1[j], 0.f); v0[j] = a * a; v1[j] = b * b; } }
                    u32x4 w; w.x = cvt_pk_bf16(v0[0], v0[1]); w.y = cvt_pk_bf16(v0[2], v0[3]); w.z = cvt_pk_bf16(v1[0], v1[1]); w.w = cvt_pk_bf16(v1[2], v1[3]);
                    *(u32x4*)(rowp + bj * HALF) = w; } }
    }
};
struct EpiF32 {
    static constexpr bool PERM = false, AFTER_DRAIN = false;
    float* C; int ldc;
    __device__ __forceinline__ void operator()(const f32x4 (&acc)[2][2][4][2], const Unit& u, int wr, int wc, int fr, int fq) const {
        const int row0 = u.pm * BM + wr * 64 + fr, col0 = u.pn * BM + wc * 32 + 4 * fq;
#pragma unroll
        for (int ai = 0; ai < 2; ++ai)
#pragma unroll
            for (int m = 0; m < 4; ++m) { float* rowp = C + (size_t)(row0 + ai * HALF + m * 16) * ldc + col0;
#pragma unroll
                for (int bj = 0; bj < 2; ++bj)
#pragma unroll
                    for (int n = 0; n < 2; ++n) *(f32x4*)(rowp + bj * HALF + n * 16) = acc[ai][bj][m][n]; }
    }
};

struct EpiZ {
    static constexpr bool PERM = true, AFTER_DRAIN = false;
    bf16_t* Z;
    __device__ __forceinline__ void operator()(const f32x4 (&acc)[2][2][4][2], const Unit& u, int wr, int wc, int fr, int fq) const {
        const int pn = u.pn; const size_t Mr = 16384;
        bool blocked; int H = 4, c0; bf16_t* base;
        if (pn < 2) { blocked = true; H = 4; base = Z + Mr * 4096; c0 = pn * 256; }
        else if (pn < 4) { blocked = true; H = 4; base = Z + Mr * 4096 + Mr * 512; c0 = (pn - 2) * 256; }
        else if (pn < 8) { blocked = false; base = Z; c0 = (pn - 4) * 256; }
        else if (pn < 12) { blocked = false; base = Z; c0 = 1024 + (pn - 8) * 256; }
        else if (pn < 24) { blocked = true; H = 8; base = Z + Mr * 4096 + Mr * 1024 + (size_t)((pn - 12) >> 2) * Mr * 1024; c0 = ((pn - 12) & 3) * 256; }
        else if (pn < 28) { blocked = false; base = Z; c0 = 2048 + (pn - 24) * 256; }
        else { blocked = false; base = Z; c0 = 3072 + (pn - 28) * 256; }
        const int row0 = u.pm * BM + wr * 64 + fr, cl = c0 + wc * 32 + 8 * fq;
#pragma unroll
        for (int ai = 0; ai < 2; ++ai)
#pragma unroll
            for (int m = 0; m < 4; ++m) { const int row = row0 + ai * HALF + m * 16;
#pragma unroll
                for (int bj = 0; bj < 2; ++bj) { const f32x4 v0 = acc[ai][bj][m][0], v1 = acc[ai][bj][m][1]; const int c = cl + bj * HALF;
                    u32x4 w; w.x = cvt_pk_bf16(v0[0], v0[1]); w.y = cvt_pk_bf16(v0[2], v0[3]); w.z = cvt_pk_bf16(v1[0], v1[1]); w.w = cvt_pk_bf16(v1[2], v1[3]);
                    bf16_t* p = blocked ? base + ((size_t)((((row >> 6) * H + (c >> 7)) * 8 + ((c >> 4) & 7)) * 64 + (row & 63))) * 16 + (c & 15)
                                        : base + (size_t)row * 4096 + c;
                    *(u32x4*)p = w; } }
    }
};

template <class Epi, class Sched, bool ALIGN_EPI = false, bool SP2 = false>
__device__ __forceinline__ void gemm_phase(PG8_LAS unsigned char* lds, const Gemm g, const Sched& S, const Epi& E) {
    int tid_o = threadIdx.x; asm volatile("" : "+v"(tid_o));
    const int tid = tid_o, wid = __builtin_amdgcn_readfirstlane(tid >> 6), lane = tid & 63, wr = wid >> 2, wc = wid & 3, fr = lane & 15, fq = lane >> 4;
    const int K = g.K, nt = K / BK;
    unsigned voffA[2], voffB[2];
#pragma unroll
    for (int i = 0; i < 2; ++i) { int R, C; stage_rc(tid * 16 + i * 8192, R, C); const int Rb = Epi::PERM ? ((R & ~31) + perm32(R & 31)) : R;
        voffA[i] = (unsigned)(R * K + C) * 2u; voffB[i] = (unsigned)(Rb * K + C) * 2u; }
    const size_t kstep = (size_t)(BK * 2);
    const size_t hstep = (size_t)HALF * K * 2;
    const size_t tstep = 2 * hstep;
    const unsigned ldsw = (unsigned)wid * 1024u;
    const int aoff = lds_byte(wr * 64 + fr, fq * 8), boff = lds_byte(wc * 32 + fr, fq * 8);
#define PG8_SA(b, h) (((b) * 2 + (h)) * HTB)
#define PG8_SB(b, h) ((4 + (b) * 2 + (h)) * HTB)
#define PG8_STAGE(bufoff, gbase, voff) do { _Pragma("unroll") for (int _i = 0; _i < 2; ++_i) \
        __builtin_amdgcn_global_load_lds((const unsigned*)((const char*)(gbase) + (voff)[_i]), (PG8_LAS unsigned*)(lds + (bufoff) + ldsw + _i * 8192), 16, 0, 0); } while (0)
#define PG8_LDA(dst, b, h) do { _Pragma("unroll") for (int m = 0; m < 4; ++m) _Pragma("unroll") for (int k = 0; k < 2; ++k) dst[m][k] = *(const PG8_LAS bf16x8*)(lds + PG8_SA(b, h) + aoff + m * 2048 + k * 1024); } while (0)
#define PG8_LDB(dst, b, h) do { _Pragma("unroll") for (int n = 0; n < 2; ++n) _Pragma("unroll") for (int k = 0; k < 2; ++k) dst[n][k] = *(const PG8_LAS bf16x8*)(lds + PG8_SB(b, h) + boff + n * 2048 + k * 1024); } while (0)
#define PG8_MMA(ai, bj, At, Bt) do { __builtin_amdgcn_s_setprio(1); _Pragma("unroll") for (int m = 0; m < 4; ++m) _Pragma("unroll") for (int n = 0; n < 2; ++n) _Pragma("unroll") for (int k = 0; k < 2; ++k) \
        acc[ai][bj][m][n] = __builtin_amdgcn_mfma_f32_16x16x32_bf16(Bt[n][k], At[m][k], acc[ai][bj][m][n], 0, 0, 0); __builtin_amdgcn_s_setprio(0); } while (0)
#define PG8_WAIT_V(n) asm volatile("s_waitcnt vmcnt(" #n ")" ::: "memory")
#define PG8_WAIT_L(n) asm volatile("s_waitcnt lgkmcnt(" #n ")" ::: "memory")
#define PG8_BAR __builtin_amdgcn_s_barrier()
#define PG8_SCHED __builtin_amdgcn_sched_barrier(0)
    Unit cur, nxt; int ui = 0;
    if (!S.next(0, cur)) return;
    f32x4 acc[2][2][4][2];
#pragma unroll
    for (int a = 0; a < 2; ++a)
#pragma unroll
        for (int b = 0; b < 2; ++b)
#pragma unroll
            for (int m = 0; m < 4; ++m)
#pragma unroll
                for (int n = 0; n < 2; ++n) acc[a][b][m][n] = (f32x4){0.f, 0.f, 0.f, 0.f};
    bf16x8 At[4][2], B0[2][2], B1[2][2];
    const char* cA = (const char*)g.A + (size_t)cur.pm * tstep; const char* cB = (const char*)g.Bt + (size_t)cur.pn * tstep;
    S.a_ready(cur);
    if constexpr (SP2) {
        PG8_STAGE(PG8_SB(0, 0), cB, voffB); PG8_STAGE(PG8_SB(0, 1), cB + hstep, voffB); PG8_STAGE(PG8_SA(0, 0), cA, voffA); PG8_STAGE(PG8_SA(0, 1), cA + hstep, voffA);
        if (wr == 1) PG8_BAR;
        PG8_WAIT_V(2); PG8_BAR;
        PG8_STAGE(PG8_SB(1, 0), cB + kstep, voffB); PG8_STAGE(PG8_SA(1, 0), cA + kstep, voffA); PG8_STAGE(PG8_SB(1, 1), cB + hstep + kstep, voffB);
        PG8_WAIT_V(6); PG8_BAR;
    } else {
        PG8_STAGE(PG8_SB(0, 0), cB, voffB); PG8_STAGE(PG8_SA(0, 0), cA, voffA); PG8_STAGE(PG8_SB(0, 1), cB + hstep, voffB); PG8_STAGE(PG8_SA(0, 1), cA + hstep, voffA);
        if (wr == 1) PG8_BAR;
        PG8_WAIT_V(4); PG8_BAR;
        PG8_STAGE(PG8_SB(1, 0), cB + kstep, voffB); PG8_STAGE(PG8_SA(1, 0), cA + kstep, voffA); PG8_STAGE(PG8_SB(1, 1), cB + hstep + kstep, voffB);
        PG8_WAIT_V(6); PG8_BAR;
    }
    for (;;) {
        const bool has_next = S.next(ui + 1, nxt);
        const char* nA = has_next ? (const char*)g.A + (size_t)nxt.pm * tstep : cA; const char* nB = has_next ? (const char*)g.Bt + (size_t)nxt.pn * tstep : cB;
        for (int t = 0; t < nt; t += 2) {
            const bool last = (t == nt - 2);
            const char* a1 = cA + (size_t)(t + 1) * kstep;
            const char* a2 = last ? nA : cA + (size_t)(t + 2) * kstep; const char* b2 = last ? nB : cB + (size_t)(t + 2) * kstep;
            const char* a3 = a2 + kstep; const char* b3 = b2 + kstep;
            if (last && has_next) S.a_ready(nxt);
            if constexpr (SP2) {
            PG8_LDB(B0, 0, 0); PG8_LDB(B1, 0, 1); PG8_SCHED; PG8_LDA(At, 0, 0); PG8_STAGE(PG8_SA(1, 1), a1 + hstep, voffA);
            PG8_WAIT_V(8); PG8_WAIT_L(0); PG8_BAR; PG8_MMA(0, 0, At, B0); PG8_MMA(0, 1, At, B1); PG8_BAR; PG8_SCHED;
            PG8_LDA(At, 0, 1); PG8_STAGE(PG8_SB(0, 0), b2, voffB); PG8_STAGE(PG8_SB(0, 1), b2 + hstep, voffB); PG8_STAGE(PG8_SA(0, 0), a2, voffA);
            PG8_WAIT_V(8); PG8_WAIT_L(0); PG8_BAR; PG8_MMA(1, 0, At, B0); PG8_MMA(1, 1, At, B1); PG8_BAR; PG8_SCHED;
            PG8_LDB(B0, 1, 0); PG8_LDB(B1, 1, 1); PG8_SCHED; PG8_LDA(At, 1, 0); PG8_STAGE(PG8_SA(0, 1), a2 + hstep, voffA);
            PG8_WAIT_V(8); PG8_WAIT_L(0); PG8_BAR; PG8_MMA(0, 0, At, B0); PG8_MMA(0, 1, At, B1); PG8_BAR; PG8_SCHED;
            PG8_LDA(At, 1, 1); PG8_STAGE(PG8_SB(1, 0), b3, voffB); PG8_STAGE(PG8_SB(1, 1), b3 + hstep, voffB); PG8_STAGE(PG8_SA(1, 0), a3, voffA);
            PG8_WAIT_V(8); PG8_WAIT_L(0); PG8_BAR; PG8_MMA(1, 0, At, B0); PG8_MMA(1, 1, At, B1); PG8_BAR; PG8_SCHED;
            } else {
            PG8_LDB(B0, 0, 0); PG8_SCHED; PG8_LDA(At, 0, 0); PG8_STAGE(PG8_SA(1, 1), a1 + hstep, voffA);
            PG8_WAIT_L(8); PG8_BAR; PG8_WAIT_L(0); PG8_MMA(0, 0, At, B0); PG8_BAR; PG8_SCHED;
            PG8_LDB(B1, 0, 1); PG8_STAGE(PG8_SB(0, 0), b2, voffB);
            PG8_BAR; PG8_WAIT_L(0); PG8_MMA(0, 1, At, B1); PG8_BAR;
            PG8_LDA(At, 0, 1); PG8_STAGE(PG8_SA(0, 0), a2, voffA);
            PG8_BAR; PG8_WAIT_L(0); PG8_MMA(1, 0, At, B0); PG8_BAR; PG8_SCHED;
            PG8_STAGE(PG8_SB(0, 1), b2 + hstep, voffB);
            PG8_WAIT_V(6); PG8_BAR; PG8_MMA(1, 1, At, B1); PG8_BAR;
            PG8_LDB(B0, 1, 0); PG8_SCHED; PG8_LDA(At, 1, 0); PG8_STAGE(PG8_SA(0, 1), a2 + hstep, voffA);
            PG8_WAIT_L(8); PG8_BAR; PG8_WAIT_L(0); PG8_MMA(0, 0, At, B0); PG8_BAR; PG8_SCHED;
            PG8_LDB(B1, 1, 1); PG8_STAGE(PG8_SB(1, 0), b3, voffB);
            PG8_BAR; PG8_WAIT_L(0); PG8_MMA(0, 1, At, B1); PG8_BAR;
            PG8_LDA(At, 1, 1); PG8_STAGE(PG8_SA(1, 0), a3, voffA);
            PG8_BAR; PG8_WAIT_L(0); PG8_MMA(1, 0, At, B0); PG8_BAR; PG8_SCHED;
            PG8_STAGE(PG8_SB(1, 1), b3 + hstep, voffB);
            PG8_WAIT_V(6); PG8_BAR; PG8_MMA(1, 1, At, B1); PG8_BAR;
            }
        }
        if constexpr (ALIGN_EPI) { if (wr == 0) PG8_BAR; }
        if constexpr (!Epi::AFTER_DRAIN) { E(acc, cur, wr, wc, fr, fq); S.done(cur); }
        if (!has_next) break;
#pragma unroll
        for (int a = 0; a < 2; ++a)
#pragma unroll
            for (int b = 0; b < 2; ++b)
#pragma unroll
                for (int m = 0; m < 4; ++m)
#pragma unroll
                    for (int n = 0; n < 2; ++n) acc[a][b][m][n] = (f32x4){0.f, 0.f, 0.f, 0.f};
        cur = nxt; cA = nA; cB = nB; ++ui;
        if constexpr (ALIGN_EPI) { if (wr == 1) PG8_BAR; }
    }
    PG8_WAIT_V(0);
    if constexpr (!ALIGN_EPI) { if (wr == 0) PG8_BAR; }
    PG8_BAR;
    if constexpr (Epi::AFTER_DRAIN) { E.fused(acc, cur, wr, wc, fr, fq, lds, wid, lane); S.done(cur); }
#undef PG8_SA
#undef PG8_SB
#undef PG8_STAGE
#undef PG8_LDA
#undef PG8_LDB
#undef PG8_MMA
#undef PG8_WAIT_V
#undef PG8_WAIT_L
#undef PG8_BAR
#undef PG8_SCHED
}
}

constexpr int NWAVES = 8;
constexpr int DM = 2048, DFF = 8192, NTOK = 49152, GM = 16384, NGRP = 3, NLAYER = 2, INW = 8224, ZW = 8192;
constexpr int ZC_GQ = 0, ZC_GK = 512, ZC_GV = 1024, ZC_GOG = 2048, ZC_HQ = 3072, ZC_HFF = 4096, ZC_HFB = 5120, ZC_HI = 6144, ZC_HOG = 7168;
constexpr float LN_EPS = 1e-5f, RMS_EPS = 1e-6f, ALPHA = 1.41421356237f, LOG2E = 1.44269504089f;
constexpr int NCHUNK = GM / 64;
constexpr int ST_CHUNK = 524288;
constexpr size_t MiB = 1u << 20;
constexpr size_t WS_CTL = 0, CTL_ZERO_BYTES = 1 * MiB;
constexpr size_t WS_WIN = 2 * MiB, WS_WOUT = 66 * MiB, WS_WUP = 82 * MiB, WS_WDN = 146 * MiB, WS_WGLR = 210 * MiB;
constexpr size_t WS_HB = 212 * MiB;
constexpr size_t WS_Z = 276 * MiB;
constexpr size_t WS_BG = 532 * MiB;
constexpr size_t WS_O = 596 * MiB;
constexpr size_t WS_ST = 660 * MiB;
constexpr size_t WS_TOT = 916 * MiB;
constexpr size_t WS_STS = 920 * MiB;
constexpr size_t WS_TOTS = 984 * MiB;
constexpr size_t WS_END = 985 * MiB;
constexpr int CW_BAR = 4096;
constexpr int RING_BYTES = 131072;
constexpr int LDS_BYTES = 160 * 1024, MISC_OFF = LDS_BYTES - 256;
constexpr int L_B32 = 0, L_KR = 33792, L_QR = 51200, L_QH = 68608, L_V = 86016, L_P = 119808, L_RED = 129024;
constexpr int B32_STR = 528, K_STR = 272, P_STR = 144, KT_STR = 144;
constexpr int NSC = GM / 256;
constexpr int SV_KT = 135168, KTW_BYTES = 2560;

#define GAS __attribute__((address_space(1)))
#define LAS __attribute__((address_space(3)))
typedef unsigned short bf16;
typedef unsigned v4u __attribute__((ext_vector_type(4)));
typedef float f32x4 __attribute__((ext_vector_type(4)));
typedef short bf16x8 __attribute__((ext_vector_type(8)));
typedef GAS unsigned gu32;
typedef GAS unsigned long long gu64;
#define RLX_AGENT __ATOMIC_RELAXED, __HIP_MEMORY_SCOPE_AGENT
#define LDS_WAIT() asm volatile("s_waitcnt lgkmcnt(0)" ::: "memory")
#define VM_WAIT() asm volatile("s_waitcnt vmcnt(0)" ::: "memory")
__device__ __forceinline__ unsigned long long rt() { return __builtin_amdgcn_s_memrealtime(); }
__device__ __forceinline__ unsigned f2bf(float f) { unsigned u = __builtin_bit_cast(unsigned, f); return (u + 0x7fffu + ((u >> 16) & 1u)) >> 16; }
__device__ __forceinline__ unsigned pk2(float lo, float hi) { return f2bf(lo) | (f2bf(hi) << 16); }

#define XB_TMO      128
#define XB_XCNT(j)  (256  + 64 * (j))
#define XB_XSUB(j)  (1280 + 64 * (j))
#define XB_XGEN(j)  (2304 + 64 * (j))
#define XB_TOP      3328
#define XB_TOPGEN   3392
#define XCD_BAR_WORDS 3456
#define XB_SPIN_CAP (1u << 18)

__device__ __forceinline__ unsigned xb_ld(unsigned* p)              { return __hip_atomic_load(p, __ATOMIC_RELAXED, __HIP_MEMORY_SCOPE_AGENT); }
__device__ __forceinline__ unsigned xb_add(unsigned* p, unsigned v) { return __hip_atomic_fetch_add(p, v, __ATOMIC_RELAXED, __HIP_MEMORY_SCOPE_AGENT); }
__device__ __forceinline__ unsigned xb_xcc_id() { return (unsigned)__builtin_amdgcn_s_getreg((3 << 11) | 20) & 0xFu; }
#define XB_SPIN(cond, bar) do { unsigned _sp = 0; while (cond) { __builtin_amdgcn_s_sleep(1); \
    if ((++_sp & 255u) == 0u) { if (xb_ld(&(bar)[XB_TMO])) break; if (_sp > XB_SPIN_CAP) { atomicAdd(&(bar)[XB_TMO], 1u); break; } } } } while (0)

struct XcdBarrier {
    unsigned* bar; unsigned x;
    volatile LAS unsigned* st;
};

__device__ __forceinline__ XcdBarrier xcd_barrier_post(unsigned* bar, volatile LAS unsigned* st) {
    XcdBarrier b; b.bar = bar; b.x = xb_xcc_id(); b.st = st;
    if (threadIdx.x == 0) (void)xb_add(&bar[XB_XCNT(b.x)], 1u);
    return b;
}
__device__ __forceinline__ void xcd_barrier_complete(unsigned* bar, unsigned x, unsigned& nloc, unsigned& nx) {
    const unsigned G = gridDim.x * gridDim.y * gridDim.z;
    unsigned sum, cnt, mine, sp = 0u;
    for (;;) {
        sum = 0u; cnt = 0u; mine = 0u;
#pragma unroll
        for (unsigned j = 0; j < 16; ++j) { const unsigned c = xb_ld(&bar[XB_XCNT(j)]); sum += c; cnt += (c > 0u) ? 1u : 0u; mine = (j == x) ? c : mine; }
        if (sum == G) break;
        __builtin_amdgcn_s_sleep(1);
        if ((++sp & 255u) == 0u) { if (xb_ld(&bar[XB_TMO])) break; if (sp > XB_SPIN_CAP) { atomicAdd(&bar[XB_TMO], 1u); break; } }
    }
    nloc = mine > 0u ? mine : 1u; nx = cnt > 0u ? cnt : 1u;
}

__device__ __forceinline__ void xcd_barrier(const XcdBarrier& b) {
    asm volatile("s_waitcnt vmcnt(0)" ::: "memory");
    __syncthreads();
    if (threadIdx.x == 0) {
        unsigned* bar = b.bar;
        __builtin_amdgcn_s_waitcnt(0);
        unsigned nloc = b.st[0], nx = b.st[1];
        if (nloc == 0u) { xcd_barrier_complete(bar, b.x, nloc, nx); b.st[0] = nloc; b.st[1] = nx; }
        const unsigned old = xb_add(&bar[XB_XSUB(b.x)], 1u);
        const unsigned gen = old / nloc;
        if (old + 1u == (gen + 1u) * nloc) {
            __builtin_amdgcn_fence(__ATOMIC_RELEASE, "agent");
            asm volatile("s_waitcnt vmcnt(0)" ::: "memory");
            const unsigned og = xb_add(&bar[XB_TOP], 1u);
            const unsigned tg = og / nx;
            if (og + 1u == (tg + 1u) * nx) xb_add(&bar[XB_TOPGEN], 1u);
            else XB_SPIN(xb_ld(&bar[XB_TOPGEN]) == tg, bar);
            __builtin_amdgcn_fence(__ATOMIC_ACQUIRE, "agent");
            xb_add(&bar[XB_XGEN(b.x)], 1u);
            asm volatile("s_waitcnt vmcnt(0)" ::: "memory");
        } else {
            XB_SPIN(xb_ld(&bar[XB_XGEN(b.x)]) == gen, bar);
            __builtin_amdgcn_fence(__ATOMIC_ACQUIRE, "agent");
            asm volatile("s_waitcnt vmcnt(0)" ::: "memory");
        }
    }
    __syncthreads();
}

typedef short s16x4 __attribute__((ext_vector_type(4)));
typedef float f32x2 __attribute__((ext_vector_type(2)));
typedef unsigned v2u __attribute__((ext_vector_type(2)));
__device__ __forceinline__ unsigned pkbf(float lo, float hi) { return pg8::cvt_pk_bf16(lo, hi); }
__device__ __forceinline__ float wave_sum(float v) {
#pragma unroll
    for (int o = 1; o < 64; o <<= 1) v += __shfl_xor(v, o);
    return v;
}
template <int CTRL, int RM> __device__ __forceinline__ float dpp_add(float v) {
    return v + __builtin_bit_cast(float, __builtin_amdgcn_update_dpp(0, __builtin_bit_cast(int, v), CTRL, RM, 0xf, true));
}
__device__ __forceinline__ float wave_scan_incl(float v, int) {
    v = dpp_add<0x111, 0xf>(v); v = dpp_add<0x112, 0xf>(v); v = dpp_add<0x114, 0xf>(v); v = dpp_add<0x118, 0xf>(v);
    v = dpp_add<0x142, 0xa>(v); v = dpp_add<0x143, 0xc>(v); return v;
}
#define DPP16(CTL) "v_add_f32_dpp %0, %0, %0 " CTL "\n\t" "v_add_f32_dpp %1, %1, %1 " CTL "\n\t" "v_add_f32_dpp %2, %2, %2 " CTL "\n\t" "v_add_f32_dpp %3, %3, %3 " CTL "\n\t" "v_add_f32_dpp %4, %4, %4 " CTL "\n\t" "v_add_f32_dpp %5, %5, %5 " CTL "\n\t" "v_add_f32_dpp %6, %6, %6 " CTL "\n\t" "v_add_f32_dpp %7, %7, %7 " CTL "\n\t" "v_add_f32_dpp %8, %8, %8 " CTL "\n\t" "v_add_f32_dpp %9, %9, %9 " CTL "\n\t" "v_add_f32_dpp %10, %10, %10 " CTL "\n\t" "v_add_f32_dpp %11, %11, %11 " CTL "\n\t" "v_add_f32_dpp %12, %12, %12 " CTL "\n\t" "v_add_f32_dpp %13, %13, %13 " CTL "\n\t" "v_add_f32_dpp %14, %14, %14 " CTL "\n\t" "v_add_f32_dpp %15, %15, %15 " CTL "\n\t"
__device__ __forceinline__ void wave_scan16(float* v) {
    asm volatile("s_nop 1\n\t"
        DPP16("row_shr:1 row_mask:0xf bank_mask:0xf") DPP16("row_shr:2 row_mask:0xf bank_mask:0xf") DPP16("row_shr:4 row_mask:0xf bank_mask:0xf") DPP16("row_shr:8 row_mask:0xf bank_mask:0xf")
        DPP16("row_bcast:15 row_mask:0xa bank_mask:0xf") DPP16("row_bcast:31 row_mask:0xc bank_mask:0xf") "s_nop 1"
        : "+v"(v[0]), "+v"(v[1]), "+v"(v[2]), "+v"(v[3]), "+v"(v[4]), "+v"(v[5]), "+v"(v[6]), "+v"(v[7]), "+v"(v[8]), "+v"(v[9]), "+v"(v[10]), "+v"(v[11]), "+v"(v[12]), "+v"(v[13]), "+v"(v[14]), "+v"(v[15]));
}
__device__ __forceinline__ void unpack8(const v4u v, float* f) {
    f[0] = __uint_as_float(v.x << 16); f[1] = __uint_as_float(v.x & 0xffff0000u); f[2] = __uint_as_float(v.y << 16); f[3] = __uint_as_float(v.y & 0xffff0000u);
    f[4] = __uint_as_float(v.z << 16); f[5] = __uint_as_float(v.z & 0xffff0000u); f[6] = __uint_as_float(v.w << 16); f[7] = __uint_as_float(v.w & 0xffff0000u);
}
__device__ __forceinline__ v4u pack8(const float* f) { v4u o; o.x = pkbf(f[0], f[1]); o.y = pkbf(f[2], f[3]); o.z = pkbf(f[4], f[5]); o.w = pkbf(f[6], f[7]); return o; }
__device__ __forceinline__ s16x4 lds_tr(LAS const unsigned char* p) { return __builtin_bit_cast(s16x4, __builtin_amdgcn_ds_read_tr16_b64_v4i16((LAS s16x4*)p)); }
__device__ __forceinline__ bf16x8 tr_pair(LAS const unsigned char* p0, LAS const unsigned char* p1) {
    const s16x4 a = lds_tr(p0), b = lds_tr(p1); return __builtin_shufflevector(a, b, 0, 1, 2, 3, 4, 5, 6, 7);
}
__device__ __forceinline__ float fexp2(float x) { return __builtin_amdgcn_exp2f(x); }
__device__ __forceinline__ float frcp(float x) { return __builtin_amdgcn_rcpf(x); }
__device__ __forceinline__ float lane63(float v) { return __builtin_bit_cast(float, __builtin_amdgcn_readlane(__builtin_bit_cast(int, v), 63)); }
__device__ __forceinline__ float flog2(float x) { return __builtin_amdgcn_logf(x); }

constexpr size_t ZB_GQ = (size_t)GM * 4096, ZB_GK = ZB_GQ + (size_t)GM * 512, ZB_HQ = ZB_GK + (size_t)GM * 512, ZB_HFF = ZB_HQ + (size_t)GM * 1024, ZB_HFB = ZB_HFF + (size_t)GM * 1024;
constexpr int ZRW = 4096, ZR_GV = 0, ZR_GOG = 1024, ZR_HI = 2048, ZR_HOG = 3072;
__device__ __forceinline__ size_t blk_off(int chunk, int H, int hh, int w) { return (size_t)((chunk * H + hh) * 8 + w) * 1024; }
struct Ctx {
    const float *x_prompt, *x_sample, *w_in, *w_lr2, *b_lr, *gla_g, *hg_g, *lowb, *w_out, *ln1_g, *ln1_b, *w_up, *w_down, *ln2_g, *ln2_b;
    float* out;
    bf16 *Win_t, *Wout_t, *Wup_t, *Wdn_t, *Wglr_t, *HB, *Z, *O, *ST;
    float *BG, *TOT, *TOTS; bf16 *STS, *MF;
};

__device__ __forceinline__ void transpose_item(const float* W, int N, int kb, int nb, bf16* dst, int K, LAS float* scr, int lane) {
    const int k0 = 64 * kb, n0 = 32 * nb;
#pragma unroll 8
    for (int i = 0; i < 32; ++i) { const int kk = 2 * i + (lane >> 5); scr[kk * 33 + (lane & 31)] = W[(size_t)(k0 + kk) * N + n0 + (lane & 31)]; }
    LDS_WAIT(); asm volatile("" ::: "memory");
    const int c = lane & 7;
#pragma unroll
    for (int j = 0; j < 4; ++j) { const int n = (lane >> 3) + 8 * j; const LAS float* s = scr + (8 * c) * 33 + n;
        v4u o; o.x = pkbf(s[0 * 33], s[1 * 33]); o.y = pkbf(s[2 * 33], s[3 * 33]); o.z = pkbf(s[4 * 33], s[5 * 33]); o.w = pkbf(s[6 * 33], s[7 * 33]);
        *(GAS v4u*)(dst + (size_t)n * K + k0 + 8 * c) = o; }
    LDS_WAIT(); asm volatile("" ::: "memory");
}
__device__ __forceinline__ void prologue_weights(const Ctx& X, LAS unsigned char* lds, int gw, int NGW, int wave, int lane) {
    LAS float* scr = (LAS float*)(lds + wave * 16384);
    constexpr int I_IN = 32 * 257, I_OUT = 32 * 64, I_UP = 32 * 256, I_DN = 128 * 64, I_L = I_IN + I_OUT + I_UP + I_DN;
    for (int it = gw; it < NLAYER * I_L; it += NGW) {
        const int l = it / I_L; int r = it % I_L;
        if (r < I_IN) { const int kb = r / 257, nb = r % 257;
            bf16* dst = (nb < 96) ? X.Win_t + ((size_t)l * ZW + 32 * nb) * DM : (nb == 96) ? X.Wglr_t + (size_t)l * 32 * DM : X.Win_t + ((size_t)l * ZW + 32 * (nb - 1)) * DM;
            transpose_item(X.w_in + (size_t)l * DM * INW, INW, kb, nb, dst, DM, scr, lane); continue; }
        r -= I_IN;
        if (r < I_OUT) { const int kb = r / 64, nb = r % 64; transpose_item(X.w_out + (size_t)l * DM * DM, DM, kb, nb, X.Wout_t + ((size_t)l * DM + 32 * nb) * DM, DM, scr, lane); continue; }
        r -= I_OUT;
        if (r < I_UP) { const int kb = r / 256, nb = r % 256; transpose_item(X.w_up + (size_t)l * DM * DFF, DFF, kb, nb, X.Wup_t + ((size_t)l * DFF + 32 * nb) * DM, DM, scr, lane); continue; }
        r -= I_UP;
        { const int kb = r / 64, nb = r % 64; transpose_item(X.w_down + (size_t)l * DFF * DM, DM, kb, nb, X.Wdn_t + ((size_t)l * DM + 32 * nb) * DFF, DFF, scr, lane); }
    }
}
__device__ __forceinline__ void cvt_group(const float* xg, bf16* HB, int gtid, int NT) {
    for (int i = gtid; i < GM * DM / 8; i += NT) {
        const f32x4 a = ((const GAS f32x4*)xg)[2 * i], b = ((const GAS f32x4*)xg)[2 * i + 1];
        v4u o; o.x = pkbf(a.x, a.y); o.y = pkbf(a.z, a.w); o.z = pkbf(b.x, b.y); o.w = pkbf(b.z, b.w);
        ((GAS v4u*)HB)[i] = o; }
}
template <bool RES_F32, bool OUT_F32>
__device__ __forceinline__ void ln_phase(const void* res, const bf16* mf, const float* gam, const float* bet, float* H, bf16* HB, int gw, int NGW, int lane) {
    for (int m = gw; m < GM; m += NGW) {
        f32x4 v[8]; float s = 0.f;
        const GAS v2u* mr = (const GAS v2u*)(mf + (size_t)m * DM) + lane;
#pragma unroll
        for (int j = 0; j < 8; ++j) { f32x4 r;
            if (RES_F32) r = ((const GAS f32x4*)((const float*)res + (size_t)m * DM) + lane)[64 * j];
            else { const v2u w = ((const GAS v2u*)((const bf16*)res + (size_t)m * DM) + lane)[64 * j];
                r = (f32x4){__uint_as_float(w.x << 16), __uint_as_float(w.x & 0xffff0000u), __uint_as_float(w.y << 16), __uint_as_float(w.y & 0xffff0000u)}; }
            const v2u w = mr[64 * j];
            const f32x4 f = (f32x4){__uint_as_float(w.x << 16), __uint_as_float(w.x & 0xffff0000u), __uint_as_float(w.y << 16), __uint_as_float(w.y & 0xffff0000u)};
            v[j] = r * ALPHA + f; s += (v[j].x + v[j].y) + (v[j].z + v[j].w); }
        const float mean = wave_sum(s) * (1.f / DM); float s2 = 0.f;
#pragma unroll
        for (int j = 0; j < 8; ++j) { v[j] = v[j] - mean; s2 += (v[j].x * v[j].x + v[j].y * v[j].y) + (v[j].z * v[j].z + v[j].w * v[j].w); }
        const float rstd = 1.f / sqrtf(wave_sum(s2) * (1.f / DM) + LN_EPS);
#pragma unroll
        for (int j = 0; j < 8; ++j) { const f32x4 g4 = ((const GAS f32x4*)gam)[lane + 64 * j], b4 = ((const GAS f32x4*)bet)[lane + 64 * j];
            const f32x4 o = v[j] * rstd * g4 + b4;
            if (OUT_F32) ((GAS f32x4*)(H + (size_t)m * DM) + lane)[64 * j] = o;
            else { v2u w; w.x = pkbf(o.x, o.y); w.y = pkbf(o.z, o.w); ((GAS v2u*)(HB + (size_t)m * DM) + lane)[64 * j] = w; } }
    }
}

__device__ __forceinline__ void gate_unit(const Ctx& X, int l, int chunk, LAS unsigned char* lds, int tid, int lane, int wave) {
    const int fr = lane & 15, fq = lane >> 4;
    const bf16* A = X.HB + (size_t)chunk * 64 * DM; const bf16* Bw = X.Wglr_t + (size_t)l * 32 * DM;
    f32x4 acc[4][2];
#pragma unroll
    for (int m = 0; m < 4; ++m)
#pragma unroll
        for (int n = 0; n < 2; ++n) acc[m][n] = (f32x4){0.f, 0.f, 0.f, 0.f};
#pragma unroll 2
    for (int ks = 0; ks < 8; ++ks) { const int k0 = 256 * wave + 32 * ks + 8 * fq;
        bf16x8 a[4], b[2];
#pragma unroll
        for (int m = 0; m < 4; ++m) a[m] = *(const GAS bf16x8*)(A + (size_t)(16 * m + fr) * DM + k0);
#pragma unroll
        for (int n = 0; n < 2; ++n) b[n] = *(const GAS bf16x8*)(Bw + (size_t)(16 * n + fr) * DM + k0);
#pragma unroll
        for (int m = 0; m < 4; ++m)
#pragma unroll
            for (int n = 0; n < 2; ++n) acc[m][n] = __builtin_amdgcn_mfma_f32_16x16x32_bf16(a[m], b[n], acc[m][n], 0, 0, 0); }
    LAS float* part = (LAS float*)lds;
#pragma unroll
    for (int m = 0; m < 4; ++m)
#pragma unroll
        for (int n = 0; n < 2; ++n)
#pragma unroll
            for (int j = 0; j < 4; ++j) part[(wave * 64 + 16 * m + 4 * fq + j) * 33 + 16 * n + fr] = acc[m][n][j];
    __syncthreads();
    LAS float* glr = (LAS float*)(lds + 8 * 64 * 33 * 4);
#pragma unroll
    for (int k = 0; k < 4; ++k) { const int idx = tid + 512 * k, t = idx >> 5, n = idx & 31; float s = 0.f;
#pragma unroll
        for (int w = 0; w < 8; ++w) s += part[(w * 64 + t) * 33 + n];
        glr[t * 36 + n] = s; }
    __syncthreads();
    const int dir = wave >> 2;
    const float* w2 = X.w_lr2 + (size_t)(l * 2 + dir) * 16 * 512; const float* bl = X.b_lr + (size_t)(l * 2 + dir) * 512;
    for (int cb = 0; cb < 2; ++cb) { const int c = 128 * (wave & 3) + 64 * cb + lane;
        float w[16];
#pragma unroll
        for (int r = 0; r < 16; ++r) w[r] = w2[r * 512 + c];
        const float bias = bl[c]; float run = 0.f;
        float* bgcol = X.BG + ((size_t)(((chunk * 4 + (c >> 7)) * 8 + ((c & 127) >> 4)) * 2 + dir) * 64) * 16 + (c & 15);
#pragma unroll 4
        for (int tt = 0; tt < 64; ++tt) { const int t = dir ? 63 - tt : tt;
            const LAS f32x4* gr = (const LAS f32x4*)(glr + t * 36 + dir * 16); const f32x4 g0 = gr[0], g1 = gr[1], g2 = gr[2], g3 = gr[3];
            float pre = bias;
            pre += g0.x * w[0] + g0.y * w[1] + g0.z * w[2] + g0.w * w[3]; pre += g1.x * w[4] + g1.y * w[5] + g1.z * w[6] + g1.w * w[7];
            pre += g2.x * w[8] + g2.y * w[9] + g2.z * w[10] + g2.w * w[11]; pre += g3.x * w[12] + g3.y * w[13] + g3.z * w[14] + g3.w * w[15];
            run += (fminf(pre, 0.f) - __logf(1.f + __expf(-fabsf(pre)))) * (LOG2E / 16.f);
            bgcol[(size_t)t * 16] = run; } }
    __syncthreads();
}

__device__ __forceinline__ size_t st_slot(int chunk, bool hgt, int h, int dir) { return (size_t)chunk * ST_CHUNK + (hgt ? 262144 + (h * 2 + dir) * 16384 : (h * 2 + dir) * 32768); }

template <bool HGT> struct RawIn { f32x4 b[4]; v4u k[2]; };
template <> struct RawIn<true> { v4u k[2]; };
template <bool HGT>
__device__ __forceinline__ RawIn<HGT> pass_s_load(const Ctx& X, int chunk, int h, int dir, int lane, int c0) {
    RawIn<HGT> r; const int rt = dir ? 63 - lane : lane, w = c0 >> 4;
    if constexpr (!HGT) { const GAS f32x4* bg = (const GAS f32x4*)(X.BG + ((size_t)(((chunk * 4 + h) * 8 + w) * 2 + dir) * 64 + rt) * 16);
#pragma unroll
        for (int i = 0; i < 4; ++i) r.b[i] = bg[i];
        const GAS v4u* kp = (const GAS v4u*)(X.Z + ZB_GK + blk_off(chunk, 4, h, w) + rt * 16); r.k[0] = kp[0]; r.k[1] = kp[1];
    } else { const GAS v4u* zp = (const GAS v4u*)(X.Z + (dir ? ZB_HFB : ZB_HFF) + blk_off(chunk, 8, h, w) + rt * 16); r.k[0] = zp[0]; r.k[1] = zp[1]; }
    return r;
}
template <bool HGT, bool STORE>
__device__ __forceinline__ void pass_s_unit(const Ctx& X, int l, int sc, int h, LAS unsigned char* lds, int tid, int lane, int wave) {
    constexpr int DV = HGT ? 128 : 256, VSTR = DV * 2 + 16, NE = DV / 16, PPR = DV / 8, UNR_D = HGT ? 2 : 1, UNR_C = HGT ? 4 : 1;
    const int fr = lane & 15, fq = lane >> 4, qq = fr >> 2, p4 = fr & 3, c0 = 16 * wave;
    RawIn<HGT> cur = pass_s_load<HGT>(X, sc * 4, h, 0, lane, c0);
    RawIn<HGT> rq[HGT ? 4 : 1];
    { const int vcol = HGT ? ZR_HI + h * 128 : ZR_GV + h * 256;
#pragma unroll 4
      for (int k = 0; k < 256 * PPR / 512; ++k) { const int idx = tid + 512 * k, row = idx / PPR, pc = idx % PPR;
        const v4u v = *(const GAS v4u*)(X.Z + (size_t)(sc * 256 + row) * ZRW + vcol + pc * 8);
        *(LAS v4u*)(lds + row * VSTR + pc * 16) = v; } }
    __syncthreads();
    LAS unsigned char* kt = lds + SV_KT + wave * KTW_BYTES;
    for (int dir = 0; dir < 2; ++dir) {
        const int hd = HGT ? 8 + h * 2 + dir : h * 2 + dir;
        if constexpr (HGT) {
#pragma unroll
            for (int q4 = 0; q4 < 4; ++q4) rq[q4] = pass_s_load<HGT>(X, sc * 4 + (dir ? 3 - q4 : q4), h, dir, lane, c0); }
        float lbv[16];
        if (HGT) {
#pragma unroll
            for (int i = 0; i < 16; ++i) lbv[i] = 0.f;
            if (l != 0) { const float* lp = X.lowb + (size_t)dir * 2 * 1024 + h * 128 + c0;
#pragma unroll
                for (int i = 0; i < 16; ++i) lbv[i] = frcp(1.f + __expf(lp[i] - lp[1024 + i])); } }
        f32x4 acc[NE];
        if (STORE) { const bf16* sin = X.STS + st_slot(sc, HGT, h, dir);
#pragma unroll
            for (int et = 0; et < NE; ++et) { const v2u w = *(const GAS v2u*)(sin + (size_t)((et * 4 + (wave >> 1)) * 64 + fr + 16 * (2 * (wave & 1) + (fq >> 1))) * 8 + 4 * (fq & 1));
                acc[et] = (f32x4){__uint_as_float(w.x << 16), __uint_as_float(w.x & 0xffff0000u), __uint_as_float(w.y << 16), __uint_as_float(w.y & 0xffff0000u)}; }
        } else {
#pragma unroll
            for (int et = 0; et < NE; ++et) acc[et] = (f32x4){0.f, 0.f, 0.f, 0.f}; }
        float run[16];
#pragma unroll
        for (int i = 0; i < 16; ++i) run[i] = 0.f;
#pragma unroll UNR_C
        for (int cc = 0; cc < 4; ++cc) { const int ci = dir ? 3 - cc : cc, chunk = sc * 4 + ci;
            RawIn<HGT> nxt = cur;
            if constexpr (HGT) cur = rq[cc];
            else { if (cc < 3) nxt = pass_s_load<HGT>(X, sc * 4 + (dir ? 2 - cc : cc + 1), h, dir, lane, c0);
                   else if (dir == 0) nxt = pass_s_load<HGT>(X, sc * 4 + 3, h, 1, lane, c0); }
            float bc[16], kr[16];
            if constexpr (!HGT) {
#pragma unroll
                for (int i = 0; i < 4; ++i) { bc[4 * i] = cur.b[i].x; bc[4 * i + 1] = cur.b[i].y; bc[4 * i + 2] = cur.b[i].z; bc[4 * i + 3] = cur.b[i].w; }
                unpack8(cur.k[0], kr); unpack8(cur.k[1], kr + 8);
            } else {
                float zf[16]; unpack8(cur.k[0], zf); unpack8(cur.k[1], zf + 8);
#pragma unroll
                for (int i = 0; i < 16; ++i) {
                    const float z = __builtin_amdgcn_fmed3f(zf[i], -60.f, 60.f), e = fexp2(z * -LOG2E), sig = frcp(1.f + e), oml = 1.f - lbv[i];
                    kr[i] = oml - oml * sig;
                    bc[i] = flog2(lbv[i] + oml * sig); }
                wave_scan16(bc);
            }
            if (STORE) { bf16* slot = X.ST + st_slot(chunk, HGT, h, dir);
#pragma unroll
                for (int et = 0; et < NE; ++et) { v2u w; w.x = pkbf(acc[et][0], acc[et][1]); w.y = pkbf(acc[et][2], acc[et][3]);
                    *(GAS v2u*)(slot + (size_t)((et * 4 + (wave >> 1)) * 64 + fr + 16 * (2 * (wave & 1) + (fq >> 1))) * 8 + 4 * (fq & 1)) = w; }
                if (cc == 3) { cur = nxt; break; } }
            float kh[16];
#pragma unroll
            for (int i = 0; i < 16; ++i) { const float bl = lane63(bc[i]); kh[i] = kr[i] * fexp2(bl - bc[i]); run[i] += bl; }
            { const v4u k0 = pack8(kh), k1 = pack8(kh + 8); const unsigned kw[8] = {k0.x, k0.y, k0.z, k0.w, k1.x, k1.y, k1.z, k1.w};
#pragma unroll
              for (int i = 0; i < 16; ++i) *(LAS unsigned short*)(kt + i * KT_STR + lane * 2) = (unsigned short)((i & 1) ? (kw[i >> 1] >> 16) : (kw[i >> 1] & 0xffffu)); }
            if (lane == 63) {
#pragma unroll
                for (int i = 0; i < 4; ++i) ((LAS f32x4*)(kt + 2304))[i] = (f32x4){bc[4 * i], bc[4 * i + 1], bc[4 * i + 2], bc[4 * i + 3]}; }
            asm volatile("s_waitcnt lgkmcnt(0)" ::: "memory");
            const f32x4 dl = *(const LAS f32x4*)(kt + 2304 + 16 * fq);
            const f32x4 dec = (f32x4){fexp2(dl.x), fexp2(dl.y), fexp2(dl.z), fexp2(dl.w)};
            bf16x8 afr[2];
#pragma unroll
            for (int ks = 0; ks < 2; ++ks) afr[ks] = *(const LAS bf16x8*)(kt + fr * KT_STR + (32 * ks + 8 * fq) * 2);
#pragma unroll
            for (int et = 0; et < NE; ++et) acc[et] = acc[et] * dec;
            { constexpr int NB = 2 * NE / 4;
              LAS const unsigned char* vb[2][2];
#pragma unroll
              for (int ks = 0; ks < 2; ++ks) { const int r0 = 32 * ks + 8 * fq + qq, r1 = r0 + 4;
                  vb[ks][0] = lds + (ci * 64 + (dir ? 63 - r0 : r0)) * VSTR + 8 * p4; vb[ks][1] = lds + (ci * 64 + (dir ? 63 - r1 : r1)) * VSTR + 8 * p4; }
              bf16x8 bb[2][4];
#pragma unroll
              for (int j = 0; j < 4; ++j) bb[0][j] = tr_pair(vb[0][0] + 32 * j, vb[0][1] + 32 * j);
#pragma unroll
              for (int b = 0; b < NB; ++b) {
                  if (b + 1 < NB) { const int ks1 = (b + 1) / (NE / 4), e1 = 4 * ((b + 1) % (NE / 4));
#pragma unroll
                      for (int j = 0; j < 4; ++j) bb[(b + 1) & 1][j] = tr_pair(vb[ks1][0] + 32 * (e1 + j), vb[ks1][1] + 32 * (e1 + j)); }
                  const int ks0 = b / (NE / 4), e0 = 4 * (b % (NE / 4));
#pragma unroll
                  for (int j = 0; j < 4; ++j) acc[e0 + j] = __builtin_amdgcn_mfma_f32_16x16x32_bf16(afr[ks0], bb[b & 1][j], acc[e0 + j], 0, 0, 0);
                  __builtin_amdgcn_sched_group_barrier(0x100, 8, 0); __builtin_amdgcn_sched_group_barrier(0x008, 4, 0); } }
            asm volatile("s_waitcnt lgkmcnt(0)" ::: "memory");
            cur = nxt;
        }
        if (!STORE) { bf16* sout = X.STS + st_slot(sc, HGT, h, dir);
#pragma unroll
            for (int et = 0; et < NE; ++et) { v2u w; w.x = pkbf(acc[et][0], acc[et][1]); w.y = pkbf(acc[et][2], acc[et][3]);
                *(GAS v2u*)(sout + (size_t)((et * 4 + (wave >> 1)) * 64 + fr + 16 * (2 * (wave & 1) + (fq >> 1))) * 8 + 4 * (fq & 1)) = w; }
            if (lane == 0) { float* tp = X.TOTS + ((size_t)sc * 24 + hd) * 128 + c0;
#pragma unroll
                for (int i = 0; i < 4; ++i) ((GAS f32x4*)tp)[i] = (f32x4){run[4 * i], run[4 * i + 1], run[4 * i + 2], run[4 * i + 3]}; } }
    }
    __syncthreads();
}
__device__ __forceinline__ void pass_b_super(const Ctx& X, int g, int gtid, int NT) {
    const int ns = (g == 0) ? 1 : 2, nc = NSC / ns;
    for (int v = gtid; v < ns * (ST_CHUNK / 8); v += NT) {
        const int s = v / (ST_CHUNK / 8), idx = (v % (ST_CHUNK / 8)) * 8;
        const int hd = idx < 262144 ? idx / 32768 : 8 + (idx - 262144) / 16384, db = hd & 1;
        const int d0 = 32 * ((idx >> 9) & 3) + 8 * ((idx >> 7) & 3);
        float S[8];
#pragma unroll
        for (int i = 0; i < 8; ++i) S[i] = 0.f;
        for (int cc = 0; cc < nc; cc += 8) {
            v4u x[8]; f32x4 t0[8], t1[8];
#pragma unroll
            for (int u = 0; u < 8; ++u) { const int c = s * nc + (db ? nc - 1 - (cc + u) : cc + u);
                x[u] = *(const GAS v4u*)(X.STS + (size_t)c * ST_CHUNK + idx);
                const GAS f32x4* tp = (const GAS f32x4*)(X.TOTS + ((size_t)c * 24 + hd) * 128 + d0); t0[u] = tp[0]; t1[u] = tp[1]; }
#pragma unroll
            for (int u = 0; u < 8; ++u) { const int c = s * nc + (db ? nc - 1 - (cc + u) : cc + u);
                *(GAS v4u*)(X.STS + (size_t)c * ST_CHUNK + idx) = pack8(S);
                float dx[8]; unpack8(x[u], dx);
                const float dec[8] = {fexp2(t0[u].x), fexp2(t0[u].y), fexp2(t0[u].z), fexp2(t0[u].w), fexp2(t1[u].x), fexp2(t1[u].y), fexp2(t1[u].z), fexp2(t1[u].w)};
#pragma unroll
                for (int i = 0; i < 8; ++i) S[i] = dec[i] * S[i] + dx[i]; }
        }
    }
}

constexpr int C2_DIR = 63488, C2_QD = 0, C2_KD = 17408, C2_QH = 34816, C2_P = 52224, C2_BT = 61440, C2_V = 126976, C2_RED = 160768;
template <bool HGT>
__device__ __forceinline__ void c2_stage(const Ctx& X, int l, int chunk, int h, int dir, LAS unsigned char* ld, int lane, int wave) {
    const int r = lane, rt = dir ? 63 - r : r, c0 = 16 * wave;
    float bc[16], kr[16], qv[16];
    if (!HGT) {
        const GAS f32x4* bg = (const GAS f32x4*)(X.BG + ((size_t)(((chunk * 4 + h) * 8 + wave) * 2 + dir) * 64 + rt) * 16);
#pragma unroll
        for (int i = 0; i < 4; ++i) { const f32x4 t = bg[i]; bc[4 * i] = t.x; bc[4 * i + 1] = t.y; bc[4 * i + 2] = t.z; bc[4 * i + 3] = t.w; }
        const GAS v4u* kp = (const GAS v4u*)(X.Z + ZB_GK + blk_off(chunk, 4, h, wave) + rt * 16); unpack8(kp[0], kr); unpack8(kp[1], kr + 8);
        const GAS v4u* qp = (const GAS v4u*)(X.Z + ZB_GQ + blk_off(chunk, 4, h, wave) + rt * 16); unpack8(qp[0], qv); unpack8(qp[1], qv + 8);
#pragma unroll
        for (int i = 0; i < 16; ++i) qv[i] *= 0.08838834764831845f;
    } else {
        float zf[16];
        const GAS v4u* zp = (const GAS v4u*)(X.Z + (dir ? ZB_HFB : ZB_HFF) + blk_off(chunk, 8, h, wave) + rt * 16); unpack8(zp[0], zf); unpack8(zp[1], zf + 8);
        const GAS v4u* qp = (const GAS v4u*)(X.Z + ZB_HQ + blk_off(chunk, 8, h, wave) + rt * 16); unpack8(qp[0], qv); unpack8(qp[1], qv + 8);
        float lbv[16];
        if (l == 0) {
#pragma unroll
            for (int i = 0; i < 16; ++i) lbv[i] = 0.f;
        } else { const float* lp = X.lowb + (size_t)dir * 2 * 1024 + h * 128 + c0;
#pragma unroll
            for (int i = 0; i < 16; ++i) lbv[i] = frcp(1.f + __expf(lp[i] - lp[1024 + i])); }
#pragma unroll
        for (int i = 0; i < 16; ++i) {
            const float z = __builtin_amdgcn_fmed3f(zf[i], -60.f, 60.f), e = fexp2(z * -LOG2E), sig = frcp(1.f + e), oml = 1.f - lbv[i];
            kr[i] = oml - oml * sig;
            bc[i] = flog2(lbv[i] + oml * sig); }
        wave_scan16(bc);
    }
    float qd[16], kd[16], qh[16];
#pragma unroll
    for (int i = 0; i < 16; ++i) {
        const float beta = __builtin_bit_cast(float, __builtin_amdgcn_update_dpp(0, __builtin_bit_cast(int, bc[i]), 0x142, 0xe, 0xf, false));
        qd[i] = qv[i] * fexp2(bc[i] - beta); kd[i] = kr[i] * fexp2(__builtin_amdgcn_fmed3f(beta - bc[i], 0.f, 80.f)); qh[i] = qv[i] * fexp2(bc[i]); }
    LAS unsigned char* p = ld + r * K_STR + c0 * 2;
    ((LAS v4u*)(p + C2_QD))[0] = pack8(qd); ((LAS v4u*)(p + C2_QD))[1] = pack8(qd + 8);
    ((LAS v4u*)(p + C2_KD))[0] = pack8(kd); ((LAS v4u*)(p + C2_KD))[1] = pack8(kd + 8);
    ((LAS v4u*)(p + C2_QH))[0] = pack8(qh); ((LAS v4u*)(p + C2_QH))[1] = pack8(qh + 8);
    if ((lane & 15) == 15) { LAS f32x4* bt = (LAS f32x4*)(ld + C2_BT + (((lane >> 4) + 1) & 3) * 512 + c0 * 4);
        const bool z = lane == 63;
#pragma unroll
        for (int i = 0; i < 4; ++i) bt[i] = z ? (f32x4){0.f, 0.f, 0.f, 0.f} : (f32x4){bc[4 * i], bc[4 * i + 1], bc[4 * i + 2], bc[4 * i + 3]}; }
}
template <bool HGT>
__device__ __forceinline__ void pass_c2_unit(const Ctx& X, int l, int chunk, int h, LAS unsigned char* lds, int tid, int lane, int wave) {
    constexpr int DV = HGT ? 128 : 256, VSTR = DV * 2 + 16, NET = DV / 128, PPR = DV / 8;
    const int fr = lane & 15, fq = lane >> 4, qq = fr >> 2, p4 = fr & 3;
    { const int vcol = HGT ? ZR_HI + h * 128 : ZR_GV + h * 256;
#pragma unroll
      for (int k = 0; k < 64 * PPR / 512; ++k) { const int idx = tid + 512 * k, row = idx / PPR, pc = idx % PPR;
        const v4u v = *(const GAS v4u*)(X.Z + (size_t)(chunk * 64 + row) * ZRW + vcol + pc * 8);
        *(LAS v4u*)(lds + C2_V + row * VSTR + pc * 16) = v; } }
    c2_stage<HGT>(X, l, chunk, h, 0, lds, lane, wave);
    c2_stage<HGT>(X, l, chunk, h, 1, lds + C2_DIR, lane, wave);
    bf16x8 sfr[2][NET][4];
#pragma unroll
    for (int dir = 0; dir < 2; ++dir) { const bf16* slot = X.ST + st_slot(chunk, HGT, h, dir);
#pragma unroll
        for (int et = 0; et < NET; ++et)
#pragma unroll
            for (int ks = 0; ks < 4; ++ks) sfr[dir][et][ks] = *(const GAS bf16x8*)(slot + (size_t)(((wave * NET + et) * 4 + ks) * 64 + lane) * 8); }
    __syncthreads();
    { const int a = wave & 3; LAS unsigned char* ld = lds + (wave >> 2) * C2_DIR;
      const unsigned lst = (a == 0) ? 0xff002010u : (a == 1) ? 0xff113021u : (a == 2) ? 0xffff2231u : 0xffff3332u;
      const unsigned zls = (a == 0) ? 0xffff0201u : (a == 1) ? 0xffff1203u : (a == 2) ? 0xffffff13u : 0xffffff23u;
      for (int t = 0; t < 3; ++t) { const unsigned code = (lst >> (8 * t)) & 0xffu; if (code == 0xffu) break;
          const int I = (int)(code >> 4), J = (int)(code & 15u);
          f32x4 sc = (f32x4){0.f, 0.f, 0.f, 0.f};
#pragma unroll
          for (int ks = 0; ks < 4; ++ks) { const int dc = 32 * ks + 8 * fq;
              v4u ka = *(const LAS v4u*)(ld + C2_KD + (16 * J + fr) * K_STR + dc * 2);
              const bf16x8 qb = *(const LAS bf16x8*)(ld + C2_QD + (16 * I + fr) * K_STR + dc * 2);
              if (J < I) { const LAS f32x4* bi = (const LAS f32x4*)(ld + C2_BT + I * 512 + dc * 4); const LAS f32x4* bj = (const LAS f32x4*)(ld + C2_BT + J * 512 + dc * 4);
                  const f32x4 d0 = bi[0] - bj[0], d1 = bi[1] - bj[1]; float kf[8]; unpack8(ka, kf);
                  kf[0] *= fexp2(d0.x); kf[1] *= fexp2(d0.y); kf[2] *= fexp2(d0.z); kf[3] *= fexp2(d0.w); kf[4] *= fexp2(d1.x); kf[5] *= fexp2(d1.y); kf[6] *= fexp2(d1.z); kf[7] *= fexp2(d1.w);
                  ka = pack8(kf); }
              sc = __builtin_amdgcn_mfma_f32_16x16x32_bf16(__builtin_bit_cast(bf16x8, ka), qb, sc, 0, 0, 0); }
          if (J == I) {
#pragma unroll
              for (int u = 0; u < 4; ++u) if (4 * fq + u > fr) sc[u] = 0.f; }
          v2u w; w.x = pkbf(sc[0], sc[1]); w.y = pkbf(sc[2], sc[3]);
          *(LAS v2u*)(ld + C2_P + (16 * I + fr) * P_STR + (16 * J + 4 * fq) * 2) = w; }
      for (int t = 0; t < 2; ++t) { const unsigned code = (zls >> (8 * t)) & 0xffu; if (code == 0xffu) break;
          const int I = (int)(code >> 4), J = (int)(code & 15u);
          *(LAS v2u*)(ld + C2_P + (16 * I + fr) * P_STR + (16 * J + 4 * fq) * 2) = (v2u){0u, 0u}; } }
    __syncthreads();
    f32x4 oacc[NET][4];
#pragma unroll
    for (int et = 0; et < NET; ++et)
#pragma unroll
        for (int it = 0; it < 4; ++it) oacc[et][it] = (f32x4){0.f, 0.f, 0.f, 0.f};
#pragma unroll
    for (int dir = 0; dir < 2; ++dir) { LAS const unsigned char* ld = lds + dir * C2_DIR;
        bf16x8 vfr[NET][2];
#pragma unroll
        for (int ks = 0; ks < 2; ++ks) { const int r0 = 32 * ks + 8 * fq + qq, r1 = r0 + 4, v0 = dir ? 63 - r0 : r0, v1 = dir ? 63 - r1 : r1;
#pragma unroll
            for (int et = 0; et < NET; ++et) { const int col = (16 * (wave * NET + et) + 4 * p4) * 2;
                vfr[et][ks] = tr_pair(lds + C2_V + v0 * VSTR + col, lds + C2_V + v1 * VSTR + col); } }
#pragma unroll
        for (int it = 0; it < 4; ++it) { const int trow = 16 * it + fr, ip = dir ? 63 - trow : trow;
            bf16x8 bo[6];
#pragma unroll
            for (int ks = 0; ks < 4; ++ks) bo[ks] = *(const LAS bf16x8*)(ld + C2_QH + ip * K_STR + (32 * ks + 8 * fq) * 2);
#pragma unroll
            for (int ks = 0; ks < 2; ++ks) bo[4 + ks] = *(const LAS bf16x8*)(ld + C2_P + ip * P_STR + (32 * ks + 8 * fq) * 2);
#pragma unroll
            for (int ks = 0; ks < 4; ++ks)
#pragma unroll
                for (int et = 0; et < NET; ++et) oacc[et][it] = __builtin_amdgcn_mfma_f32_16x16x32_bf16(sfr[dir][et][ks], bo[ks], oacc[et][it], 0, 0, 0);
#pragma unroll
            for (int ks = 0; ks < 2; ++ks)
#pragma unroll
                for (int et = 0; et < NET; ++et) oacc[et][it] = __builtin_amdgcn_mfma_f32_16x16x32_bf16(vfr[et][ks], bo[4 + ks], oacc[et][it], 0, 0, 0); } }
    LAS float* red = (LAS float*)(lds + C2_RED);
#pragma unroll
    for (int it = 0; it < 4; ++it) { float sq = 0.f;
#pragma unroll
        for (int et = 0; et < NET; ++et) { const f32x4 o = oacc[et][it]; sq += (o.x * o.x + o.y * o.y) + (o.z * o.z + o.w * o.w); }
        sq += __shfl_xor(sq, 16); sq += __shfl_xor(sq, 32);
        if (fq == 0) red[wave * 64 + 16 * it + fr] = sq; }
    __syncthreads();
    const float* ng = (HGT ? X.hg_g + (size_t)l * 128 : X.gla_g + (size_t)l * 256);
    const int ogcol = HGT ? ZR_HOG + h * 128 : ZR_GOG + h * 256, ocol = HGT ? 1024 + h * 128 : h * 256;
#pragma unroll
    for (int it = 0; it < 4; ++it) { float tot = 0.f;
#pragma unroll
        for (int w = 0; w < 8; ++w) tot += red[w * 64 + 16 * it + fr];
        const float rstd = __builtin_amdgcn_rsqf(tot * (1.f / DV) + RMS_EPS);
        const int tok = chunk * 64 + 16 * it + fr;
#pragma unroll
        for (int et = 0; et < NET; ++et) { const int e0 = 16 * (wave * NET + et) + 4 * fq;
            const v2u ogp = *(const GAS v2u*)(X.Z + (size_t)tok * ZRW + ogcol + e0);
            const float og[4] = {__uint_as_float(ogp.x << 16), __uint_as_float(ogp.x & 0xffff0000u), __uint_as_float(ogp.y << 16), __uint_as_float(ogp.y & 0xffff0000u)};
            const f32x4 g4 = *(const GAS f32x4*)(ng + e0); float rr[4];
#pragma unroll
            for (int u = 0; u < 4; ++u) { const float z = og[u]; rr[u] = oacc[et][it][u] * rstd * g4[u] * (z * frcp(1.f + fexp2(z * -LOG2E))); }
            v2u w; w.x = pkbf(rr[0], rr[1]); w.y = pkbf(rr[2], rr[3]);
            *(GAS v2u*)(X.O + (size_t)tok * DM + ocol + e0) = w; } }
}

struct Args { const float* in[15]; float* out; unsigned char* ws; int mode, pad; };
#define PHASE_IDS() int tid = threadIdx.x; asm volatile("" : "+v"(tid)); const int lane = tid & 63, wave = __builtin_amdgcn_readfirstlane(tid >> 6); \
    const int gw = bx * NWAVES + wave, NGW = G * NWAVES, gtid = bx * (NWAVES * 64) + tid, NT = G * NWAVES * 64; (void)lane; (void)wave; (void)gw; (void)NGW; (void)gtid; (void)NT
__device__ __forceinline__ Ctx make_ctx(const Args& args) {
    Ctx X; unsigned char* ws = args.ws;
    X.x_prompt = args.in[0]; X.x_sample = args.in[1]; X.w_in = args.in[2]; X.w_lr2 = args.in[3]; X.b_lr = args.in[4]; X.gla_g = args.in[5]; X.hg_g = args.in[6]; X.lowb = args.in[7];
    X.w_out = args.in[8]; X.ln1_g = args.in[9]; X.ln1_b = args.in[10]; X.w_up = args.in[11]; X.w_down = args.in[12]; X.ln2_g = args.in[13]; X.ln2_b = args.in[14]; X.out = args.out;
    X.Win_t = (bf16*)(ws + WS_WIN); X.Wout_t = (bf16*)(ws + WS_WOUT); X.Wup_t = (bf16*)(ws + WS_WUP); X.Wdn_t = (bf16*)(ws + WS_WDN); X.Wglr_t = (bf16*)(ws + WS_WGLR);
    X.HB = (bf16*)(ws + WS_HB); X.Z = (bf16*)(ws + WS_Z); X.O = (bf16*)(ws + WS_O); X.ST = (bf16*)(ws + WS_ST);
    X.BG = (float*)(ws + WS_BG); X.MF = (bf16*)(ws + WS_ST); X.TOT = (float*)(ws + WS_TOT); X.TOTS = (float*)(ws + WS_TOTS); X.STS = (bf16*)(ws + WS_STS);
    return X;
}
__global__ void __launch_bounds__(NWAVES * 64, 2) fwd_kernel(Args args) {
    extern __shared__ __attribute__((aligned(16))) unsigned char lds_raw[];
    LAS unsigned char* lds = (LAS unsigned char*)lds_raw;
    const int G = gridDim.x, bx = blockIdx.x;
    volatile LAS unsigned* MISC = (volatile LAS unsigned*)(lds + MISC_OFF);
    if (threadIdx.x < 32) MISC[threadIdx.x] = 0u;
    __syncthreads();
    XcdBarrier bar = xcd_barrier_post((unsigned*)(args.ws + WS_CTL) + CW_BAR, MISC + 8);

    { PHASE_IDS(); const Ctx X = make_ctx(args); prologue_weights(X, lds, gw, NGW, wave, lane); }
    for (int g = 0; g < NGRP; ++g) {
        { PHASE_IDS(); const Ctx X = make_ctx(args); cvt_group((g == 0) ? X.x_prompt : X.x_sample + (size_t)(g - 1) * GM * DM, X.HB, gtid, NT); }
        xcd_barrier(bar);
        for (int l = 0; l < NLAYER; ++l) {
            { PHASE_IDS(); const Ctx X = make_ctx(args); for (int c = bx; c < NCHUNK; c += G) gate_unit(X, l, c, lds, tid, lane, wave); }
            { const Ctx X = make_ctx(args); pg8::Gemm gm{X.HB, X.Win_t + (size_t)l * ZW * DM, GM, ZW, DM}; pg8::StaticOrder S; S.init(GM, ZW, G, bx);
              pg8::EpiZ E{X.Z};
              pg8::gemm_phase<pg8::EpiZ, pg8::StaticOrder, false, true>(lds, gm, S, E); }
            xcd_barrier(bar);
            {
            { PHASE_IDS(); const Ctx X = make_ctx(args);
              for (int u = bx; u < NSC * 12; u += G) { const int sc = u / 12, hh = u % 12;
                if (hh < 4) pass_s_unit<false, false>(X, l, sc, hh, lds, tid, lane, wave); else pass_s_unit<true, false>(X, l, sc, hh - 4, lds, tid, lane, wave); } }
            xcd_barrier(bar);
            { PHASE_IDS(); const Ctx X = make_ctx(args); pass_b_super(X, g, gtid, NT); }
            xcd_barrier(bar);
            { PHASE_IDS(); const Ctx X = make_ctx(args);
              for (int u = bx; u < NSC * 12; u += G) { const int sc = u / 12, hh = u % 12;
                if (hh < 4) pass_s_unit<false, true>(X, l, sc, hh, lds, tid, lane, wave); else pass_s_unit<true, true>(X, l, sc, hh - 4, lds, tid, lane, wave); } }
            xcd_barrier(bar);
            { PHASE_IDS(); const Ctx X = make_ctx(args);
              for (int u = bx; u < NCHUNK * 12; u += G) { const int c = u / 12, hh = u % 12;
                if (hh < 4) pass_c2_unit<false>(X, l, c, hh, lds, tid, lane, wave); else pass_c2_unit<true>(X, l, c, hh - 4, lds, tid, lane, wave); } }
            xcd_barrier(bar);
            }
            { const Ctx X = make_ctx(args); pg8::Gemm gm{X.O, X.Wout_t + (size_t)l * DM * DM, GM, DM, DM}; pg8::StaticOrder S; S.init(GM, DM, G, bx);
              pg8::EpiBf16<0> E{X.MF, DM};
              pg8::gemm_phase<pg8::EpiBf16<0>, pg8::StaticOrder, false, true>(lds, gm, S, E); }
            xcd_barrier(bar);
            { PHASE_IDS(); const Ctx X = make_ctx(args);
              if (l == 0) ln_phase<true, false>((g == 0) ? X.x_prompt : X.x_sample + (size_t)(g - 1) * GM * DM, X.MF, X.ln1_g, X.ln1_b, nullptr, X.HB, gw, NGW, lane);
              else ln_phase<false, false>(X.HB, X.MF, X.ln1_g + (size_t)l * DM, X.ln1_b + (size_t)l * DM, nullptr, X.HB, gw, NGW, lane); }
            xcd_barrier(bar);
            { const Ctx X = make_ctx(args); pg8::Gemm gm{X.HB, X.Wup_t + (size_t)l * DFF * DM, GM, DFF, DM}; pg8::StaticOrder S; S.init(GM, DFF, G, bx);
              pg8::EpiBf16<1> E{X.Z, DFF};
              pg8::gemm_phase<pg8::EpiBf16<1>, pg8::StaticOrder, false, true>(lds, gm, S, E); }
            xcd_barrier(bar);
            { const Ctx X = make_ctx(args); pg8::Gemm gm{X.Z, X.Wdn_t + (size_t)l * DM * DFF, GM, DM, DFF}; pg8::StaticOrder S; S.init(GM, DM, G, bx);
              pg8::EpiBf16<0> E{X.MF, DM};
              pg8::gemm_phase<pg8::EpiBf16<0>, pg8::StaticOrder, false, true>(lds, gm, S, E); }
            xcd_barrier(bar);
            { PHASE_IDS(); const Ctx X = make_ctx(args);
              if (l == NLAYER - 1) ln_phase<false, true>(X.HB, X.MF, X.ln2_g + (size_t)l * DM, X.ln2_b + (size_t)l * DM, X.out + (size_t)g * GM * DM, nullptr, gw, NGW, lane);
              else ln_phase<false, false>(X.HB, X.MF, X.ln2_g + (size_t)l * DM, X.ln2_b + (size_t)l * DM, nullptr, X.HB, gw, NGW, lane); }
            xcd_barrier(bar);
        }
    }
}

extern "C" void kernel_launch(void* const* d_in, const int* in_sizes, int n_in, void* d_out, int out_size, void* d_ws, size_t ws_size, hipStream_t stream) {
    static int grid = 0;
    if (grid == 0) {
        if (n_in != 15 || out_size != NTOK * DM || ws_size < WS_END) { fprintf(stderr, "kernel_launch: unexpected shapes (n_in %d, out %d, ws %zu)\n", n_in, out_size, ws_size); grid = -1; return; }
        int dev = 0, cus = 0;
        if (hipGetDevice(&dev) != hipSuccess || hipDeviceGetAttribute(&cus, hipDeviceAttributeMultiprocessorCount, dev) != hipSuccess) { grid = -1; return; }
        if (hipFuncSetAttribute((const void*)fwd_kernel, hipFuncAttributeMaxDynamicSharedMemorySize, LDS_BYTES) != hipSuccess) { fprintf(stderr, "kernel_launch: hipFuncSetAttribute failed\n"); grid = -1; return; }
        int per_cu = 0;
        if (hipOccupancyMaxActiveBlocksPerMultiprocessor(&per_cu, (const void*)fwd_kernel, NWAVES * 64, LDS_BYTES) != hipSuccess || per_cu < 1) { fprintf(stderr, "kernel_launch: occupancy query says %d\n", per_cu); }
        (void)hipGetLastError();
        grid = cus;
    }
    if (grid < 0) return;
    if (hipMemsetAsync((char*)d_ws + WS_CTL, 0, CTL_ZERO_BYTES, stream) != hipSuccess) return;
    Args a{};
    for (int i = 0; i < 15; ++i) a.in[i] = (const float*)d_in[i];
    a.out = (float*)d_out; a.ws = (unsigned char*)d_ws; a.mode = KMODE; a.pad = 0;
    hipLaunchKernelGGL(fwd_kernel, dim3(grid), dim3(NWAVES * 64), LDS_BYTES, stream, a);
}
```

```cpp
#include <hip/hip_runtime.h>
#include <cstdio>
#include <cstdint>
#ifndef KMODE
#define KMODE 0
#endif
namespace pg8 {
#define PG8_LAS __attribute__((address_space(3)))
typedef unsigned short bf16_t;
typedef short bf16x8 __attribute__((ext_vector_type(8)));
typedef float f32x4 __attribute__((ext_vector_type(4)));
typedef unsigned u32x4 __attribute__((ext_vector_type(4)));
constexpr int BM = 256, BK = 64, HALF = 128, HTB = HALF * BK * 2  , STAGE_BYTES = 8 * HTB, NXCD = 8, WGM = 4;

__host__ __device__ __forceinline__ int lds_byte(int r, int c) { const int st = (r >> 4) * 2 + (c >> 5), rr = r & 15, cc = c & 31, ob = rr * 64 + cc * 2; return st * 1024 + (ob ^ (((ob >> 9) & 1) << 5)); }
__host__ __device__ __forceinline__ void stage_rc(int b, int& R, int& C) { const int st = b / 1024, sb = b % 1024, swz = sb ^ (((sb >> 9) & 1) << 5); R = (st >> 1) * 16 + swz / 64; C = (st & 1) * 32 + (swz % 64) / 2; }
__host__ __device__ __forceinline__ int perm32(int rho) { const int n = rho >> 4, i = rho & 15; return 8 * (i >> 2) + 4 * n + (i & 3); }

struct Unit { int pm, pn; };
struct Gemm { const bf16_t* A; const bf16_t* Bt; int M, N, K; };

struct StaticOrder {
    int nM, nN, nwg, G, c;
    __host__ __device__ void init(int M, int N, int G_, int c_) { nM = M / BM; nN = N / BM; nwg = nM * nN; G = G_; c = c_; }
    __host__ __device__ bool next(int i, Unit& u) const {
        const long L = (long)i * G + c; if (L >= nwg) return false;
        int wgid = (int)L; { const int q = nwg / NXCD, r = nwg % NXCD, xcd = wgid % NXCD, off = wgid / NXCD; wgid = (xcd < r ? xcd * (q + 1) : r * (q + 1) + (xcd - r) * q) + off; }
        const int nig = WGM * nN, gid = wgid / nig, fm = gid * WGM, gsz = (nM - fm) < WGM ? (nM - fm) : WGM;
        u.pm = fm + ((wgid % nig) % gsz); u.pn = (wgid % nig) / gsz; return true;
    }
    __device__ __forceinline__ void a_ready(const Unit&) const {}
    __device__ __forceinline__ void done(const Unit&) const {}
};


__device__ __forceinline__ unsigned cvt_pk_bf16(float lo, float hi) { unsigned r; asm volatile("v_cvt_pk_bf16_f32 %0, %1, %2" : "=v"(r) : "v"(lo), "v"(hi)); return r; }

template <int ACT  > struct EpiBf16 {
    static constexpr bool PERM = true, AFTER_DRAIN = false;
    bf16_t* O; int ldc;
    __device__ __forceinline__ void operator()(const f32x4 (&acc)[2][2][4][2], const Unit& u, int wr, int wc, int fr, int fq) const {
        const int row0 = u.pm * BM + wr * 64 + fr; const int col0 = u.pn * BM + wc * 32 + 8 * fq;
#pragma unroll
        for (int ai = 0; ai < 2; ++ai)
#pragma unroll
            for (int m = 0; m < 4; ++m) { bf16_t* rowp = O + (size_t)(row0 + ai * HALF + m * 16) * ldc + col0;
#pragma unroll
                for (int bj = 0; bj < 2; ++bj) { f32x4 v0 = acc[ai][bj][m][0], v1 = acc[ai][bj][m][1];
                    if (ACT == 1) {
#pragma unroll
                        for (int j = 0; j < 4; ++j) { const float a = fmaxf(v0[j], 0.f), b = fmaxf(v1[j], 0.f); v0[j] = a * a; v1[j] = b * b; } }
                    u32x4 w; w.x = cvt_pk_bf16(v0[0], v0[1]); w.y = cvt_pk_bf16(v0[2], v0[3]); w.z = cvt_pk_bf16(v1[0], v1[1]); w.w = cvt_pk_bf16(v1[2], v1[3]);
                    *(u32x4*)(rowp + bj * HALF) = w; } }
    }
};
struct EpiF32 {
    static constexpr bool PERM = false, AFTER_DRAIN = false;
    float* C; int ldc;
    __device__ __forceinline__ void operator()(const f32x4 (&acc)[2][2][4][2], const Unit& u, int wr, int wc, int fr, int fq) const {
        const int row0 = u.pm * BM + wr * 64 + fr, col0 = u.pn * BM + wc * 32 + 4 * fq;
#pragma unroll
        for (int ai = 0; ai < 2; ++ai)
#pragma unroll
            for (int m = 0; m < 4; ++m) { float* rowp = C + (size_t)(row0 + ai * HALF + m * 16) * ldc + col0;
#pragma unroll
                for (int bj = 0; bj < 2; ++bj)
#pragma unroll
                    for (int n = 0; n < 2; ++n) *(f32x4*)(rowp + bj * HALF + n * 16) = acc[ai][bj][m][n]; }
    }
};

struct EpiZ {
    static constexpr bool PERM = true, AFTER_DRAIN = false;
    bf16_t* Z;
    __device__ __forceinline__ void operator()(const f32x4 (&acc)[2][2][4][2], const Unit& u, int wr, int wc, int fr, int fq) const {
        const int pn = u.pn; const size_t Mr = 16384;
        bool blocked; int H = 4, c0; bf16_t* base;
        if (pn < 2) { blocked = true; H = 4; base = Z + Mr * 4096; c0 = pn * 256; }
        else if (pn < 4) { blocked = true; H = 4; base = Z + Mr * 4096 + Mr * 512; c0 = (pn - 2) * 256; }
        else if (pn < 8) { blocked = false; base = Z; c0 = (pn - 4) * 256; }
        else if (pn < 12) { blocked = false; base = Z; c0 = 1024 + (pn - 8) * 256; }
        else if (pn < 24) { blocked = true; H = 8; base = Z + Mr * 4096 + Mr * 1024 + (size_t)((pn - 12) >> 2) * Mr * 1024; c0 = ((pn - 12) & 3) * 256; }
        else if (pn < 28) { blocked = false; base = Z; c0 = 2048 + (pn - 24) * 256; }
        else { blocked = false; base = Z; c0 = 3072 + (pn - 28) * 256; }
        const int row0 = u.pm * BM + wr * 64 + fr, cl = c0 + wc * 32 + 8 * fq;
#pragma unroll
        for (int ai = 0; ai < 2; ++ai)
#pragma unroll
            for (int m = 0; m < 4; ++m) { const int row = row0 + ai * HALF + m * 16;
#pragma unroll
                for (int bj = 0; bj < 2; ++bj) { const f32x4 v0 = acc[ai][bj][m][0], v1 = acc[ai][bj][m][1]; const int c = cl + bj * HALF;
                    u32x4 w; w.x = cvt_pk_bf16(v0[0], v0[1]); w.y = cvt_pk_bf16(v0[2], v0[3]); w.z = cvt_pk_bf16(v1[0], v1[1]); w.w = cvt_pk_bf16(v1[2], v1[3]);
                    bf16_t* p = blocked ? base + ((size_t)((((row >> 6) * H + (c >> 7)) * 8 + ((c >> 4) & 7)) * 64 + (row & 63))) * 16 + (c & 15)
                                        : base + (size_t)row * 4096 + c;
                    *(u32x4*)p = w; } }
    }
};

template <class Epi, class Sched, bool ALIGN_EPI = false, bool SP2 = false>
__device__ __forceinline__ void gemm_phase(PG8_LAS unsigned char* lds, const Gemm g, const Sched& S, const Epi& E) {
    int tid_o = threadIdx.x; asm volatile("" : "+v"(tid_o));
    const int tid = tid_o, wid = __builtin_amdgcn_readfirstlane(tid >> 6), lane = tid & 63, wr = wid >> 2, wc = wid & 3, fr = lane & 15, fq = lane >> 4;
    const int K = g.K, nt = K / BK;
    unsigned voffA[2], voffB[2];
#pragma unroll
    for (int i = 0; i < 2; ++i) { int R, C; stage_rc(tid * 16 + i * 8192, R, C); const int Rb = Epi::PERM ? ((R & ~31) + perm32(R & 31)) : R;
        voffA[i] = (unsigned)(R * K + C) * 2u; voffB[i] = (unsigned)(Rb * K + C) * 2u; }
    const size_t kstep = (size_t)(BK * 2);
    const size_t hstep = (size_t)HALF * K * 2;
    const size_t tstep = 2 * hstep;
    const unsigned ldsw = (unsigned)wid * 1024u;
    const int aoff = lds_byte(wr * 64 + fr, fq * 8), boff = lds_byte(wc * 32 + fr, fq * 8);
#define PG8_SA(b, h) (((b) * 2 + (h)) * HTB)
#define PG8_SB(b, h) ((4 + (b) * 2 + (h)) * HTB)
#define PG8_STAGE(bufoff, gbase, voff) do { _Pragma("unroll") for (int _i = 0; _i < 2; ++_i) \
        __builtin_amdgcn_global_load_lds((const unsigned*)((const char*)(gbase) + (voff)[_i]), (PG8_LAS unsigned*)(lds + (bufoff) + ldsw + _i * 8192), 16, 0, 0); } while (0)
#define PG8_LDA(dst, b, h) do { _Pragma("unroll") for (int m = 0; m < 4; ++m) _Pragma("unroll") for (int k = 0; k < 2; ++k) dst[m][k] = *(const PG8_LAS bf16x8*)(lds + PG8_SA(b, h) + aoff + m * 2048 + k * 1024); } while (0)
#define PG8_LDB(dst, b, h) do { _Pragma("unroll") for (int n = 0; n < 2; ++n) _Pragma("unroll") for (int k = 0; k < 2; ++k) dst[n][k] = *(const PG8_LAS bf16x8*)(lds + PG8_SB(b, h) + boff + n * 2048 + k * 1024); } while (0)
#define PG8_MMA(ai, bj, At, Bt) do { __builtin_amdgcn_s_setprio(1); _Pragma("unroll") for (int m = 0; m < 4; ++m) _Pragma("unroll") for (int n = 0; n < 2; ++n) _Pragma("unroll") for (int k = 0; k < 2; ++k) \
        acc[ai][bj][m][n] = __builtin_amdgcn_mfma_f32_16x16x32_bf16(Bt[n][k], At[m][k], acc[ai][bj][m][n], 0, 0, 0); __builtin_amdgcn_s_setprio(0); } while (0)
#define PG8_WAIT_V(n) asm volatile("s_waitcnt vmcnt(" #n ")" ::: "memory")
#define PG8_WAIT_L(n) asm volatile("s_waitcnt lgkmcnt(" #n ")" ::: "memory")
#define PG8_BAR __builtin_amdgcn_s_barrier()
#define PG8_SCHED __builtin_amdgcn_sched_barrier(0)
    Unit cur, nxt; int ui = 0;
    if (!S.next(0, cur)) return;
    f32x4 acc[2][2][4][2];
#pragma unroll
    for (int a = 0; a < 2; ++a)
#pragma unroll
        for (int b = 0; b < 2; ++b)
#pragma unroll
            for (int m = 0; m < 4; ++m)
#pragma unroll
                for (int n = 0; n < 2; ++n) acc[a][b][m][n] = (f32x4){0.f, 0.f, 0.f, 0.f};
    bf16x8 At[4][2], B0[2][2], B1[2][2];
    const char* cA = (const char*)g.A + (size_t)cur.pm * tstep; const char* cB = (const char*)g.Bt + (size_t)cur.pn * tstep;
    S.a_ready(cur);
    if constexpr (SP2) {
        PG8_STAGE(PG8_SB(0, 0), cB, voffB); PG8_STAGE(PG8_SB(0, 1), cB + hstep, voffB); PG8_STAGE(PG8_SA(0, 0), cA, voffA); PG8_STAGE(PG8_SA(0, 1), cA + hstep, voffA);
        if (wr == 1) PG8_BAR;
        PG8_WAIT_V(2); PG8_BAR;
        PG8_STAGE(PG8_SB(1, 0), cB + kstep, voffB); PG8_STAGE(PG8_SA(1, 0), cA + kstep, voffA); PG8_STAGE(PG8_SB(1, 1), cB + hstep + kstep, voffB);
        PG8_WAIT_V(6); PG8_BAR;
    } else {
        PG8_STAGE(PG8_SB(0, 0), cB, voffB); PG8_STAGE(PG8_SA(0, 0), cA, voffA); PG8_STAGE(PG8_SB(0, 1), cB + hstep, voffB); PG8_STAGE(PG8_SA(0, 1), cA + hstep, voffA);
        if (wr == 1) PG8_BAR;
        PG8_WAIT_V(4); PG8_BAR;
        PG8_STAGE(PG8_SB(1, 0), cB + kstep, voffB); PG8_STAGE(PG8_SA(1, 0), cA + kstep, voffA); PG8_STAGE(PG8_SB(1, 1), cB + hstep + kstep, voffB);
        PG8_WAIT_V(6); PG8_BAR;
    }
    for (;;) {
        const bool has_next = S.next(ui + 1, nxt);
        const char* nA = has_next ? (const char*)g.A + (size_t)nxt.pm * tstep : cA; const char* nB = has_next ? (const char*)g.Bt + (size_t)nxt.pn * tstep : cB;
        for (int t = 0; t < nt; t += 2) {
            const bool last = (t == nt - 2);
            const char* a1 = cA + (size_t)(t + 1) * kstep;
            const char* a2 = last ? nA : cA + (size_t)(t + 2) * kstep; const char* b2 = last ? nB : cB + (size_t)(t + 2) * kstep;
            const char* a3 = a2 + kstep; const char* b3 = b2 + kstep;
            if (last && has_next) S.a_ready(nxt);
            if constexpr (SP2) {
            PG8_LDB(B0, 0, 0); PG8_LDB(B1, 0, 1); PG8_SCHED; PG8_LDA(At, 0, 0); PG8_STAGE(PG8_SA(1, 1), a1 + hstep, voffA);
            PG8_WAIT_V(8); PG8_WAIT_L(0); PG8_BAR; PG8_MMA(0, 0, At, B0); PG8_MMA(0, 1, At, B1); PG8_BAR; PG8_SCHED;
            PG8_LDA(At, 0, 1); PG8_STAGE(PG8_SB(0, 0), b2, voffB); PG8_STAGE(PG8_SB(0, 1), b2 + hstep, voffB); PG8_STAGE(PG8_SA(0, 0), a2, voffA);
            PG8_WAIT_V(8); PG8_WAIT_L(0); PG8_BAR; PG8_MMA(1, 0, At, B0); PG8_MMA(1, 1, At, B1); PG8_BAR; PG8_SCHED;
            PG8_LDB(B0, 1, 0); PG8_LDB(B1, 1, 1); PG8_SCHED; PG8_LDA(At, 1, 0); PG8_STAGE(PG8_SA(0, 1), a2 + hstep, voffA);
            PG8_WAIT_V(8); PG8_WAIT_L(0); PG8_BAR; PG8_MMA(0, 0, At, B0); PG8_MMA(0, 1, At, B1); PG8_BAR; PG8_SCHED;
            PG8_LDA(At, 1, 1); PG8_STAGE(PG8_SB(1, 0), b3, voffB); PG8_STAGE(PG8_SB(1, 1), b3 + hstep, voffB); PG8_STAGE(PG8_SA(1, 0), a3, voffA);
            PG8_WAIT_V(8); PG8_WAIT_L(0); PG8_BAR; PG8_MMA(1, 0, At, B0); PG8_MMA(1, 1, At, B1); PG8_BAR; PG8_SCHED;
            } else {
            PG8_LDB(B0, 0, 0); PG8_SCHED; PG8_LDA(At, 0, 0); PG8_STAGE(PG8_SA(1, 1), a1 + hstep, voffA);
            PG8_WAIT_L(8); PG8_BAR; PG8_WAIT_L(0); PG8_MMA(0, 0, At, B0); PG8_BAR; PG8_SCHED;
            PG8_LDB(B1, 0, 1); PG8_STAGE(PG8_SB(0, 0), b2, voffB);
            PG8_BAR; PG8_WAIT_L(0); PG8_MMA(0, 1, At, B1); PG8_BAR;
            PG8_LDA(At, 0, 1); PG8_STAGE(PG8_SA(0, 0), a2, voffA);
            PG8_BAR; PG8_WAIT_L(0); PG8_MMA(1, 0, At, B0); PG8_BAR; PG8_SCHED;
            PG8_STAGE(PG8_SB(0, 1), b2 + hstep, voffB);
            PG8_WAIT_V(6); PG8_BAR; PG8_MMA(1, 1, At, B1); PG8_BAR;
            PG8_LDB(B0, 1, 0); PG8_SCHED; PG8_LDA(At, 1, 0); PG8_STAGE(PG8_SA(0, 1), a2 + hstep, voffA);
            PG8_WAIT_L(8); PG8_BAR; PG8_WAIT_L(0); PG8_MMA(0, 0, At, B0); PG8_BAR; PG8_SCHED;
            PG8_LDB(B1, 1, 1); PG8_STAGE(PG8_SB(1, 0), b3, voffB);
            PG8_BAR; PG8_WAIT_L(0); PG8_MMA(0, 1, At, B1); PG8_BAR;
            PG8_LDA(At, 1, 1); PG8_STAGE(PG8_SA(1, 0), a3, voffA);
            PG8_BAR; PG8_WAIT_L(0); PG8_MMA(1, 0, At, B0); PG8_BAR; PG8_SCHED;
            PG8_STAGE(PG8_SB(1, 1), b3 + hstep, voffB);
            PG8_WAIT_V(6); PG8_BAR; PG8_MMA(1, 1, At, B1); PG8_BAR;
            }
        }
        if constexpr (ALIGN_EPI) { if (wr == 0) PG8_BAR; }
        if constexpr (!Epi::AFTER_DRAIN) { E(acc, cur, wr, wc, fr, fq); S.done(cur); }
        if (!has_next) break;
#pragma unroll
        for (int a = 0; a < 2; ++a)
#pragma unroll
            for (int b = 0; b < 2; ++b)
#pragma unroll
                for (int m = 0; m < 4; ++m)
#pragma unroll
                    for (int n = 0; n < 2; ++n) acc[a][b][m][n] = (f32x4){0.f, 0.f, 0.f, 0.f};
        cur = nxt; cA = nA; cB = nB; ++ui;
        if constexpr (ALIGN_EPI) { if (wr == 1) PG8_BAR; }
    }
    PG8_WAIT_V(0);
    if constexpr (!ALIGN_EPI) { if (wr == 0) PG8_BAR; }
    PG8_BAR;
    if constexpr (Epi::AFTER_DRAIN) { E.fused(acc, cur, wr, wc, fr, fq, lds, wid, lane); S.done(cur); }
#undef PG8_SA
#undef PG8_SB
#undef PG8_STAGE
#undef PG8_LDA
#undef PG8_LDB
#undef PG8_MMA
#undef PG8_WAIT_V
#undef PG8_WAIT_L
#undef PG8_BAR
#undef PG8_SCHED
}
}

constexpr int NWAVES = 8;
constexpr int DM = 2048, DFF = 8192, NTOK = 49152, GM = 16384, NGRP = 3, NLAYER = 2, INW = 8224, ZW = 8192;
constexpr int ZC_GQ = 0, ZC_GK = 512, ZC_GV = 1024, ZC_GOG = 2048, ZC_HQ = 3072, ZC_HFF = 4096, ZC_HFB = 5120, ZC_HI = 6144, ZC_HOG = 7168;
constexpr float LN_EPS = 1e-5f, RMS_EPS = 1e-6f, ALPHA = 1.41421356237f, LOG2E = 1.44269504089f;
constexpr int NCHUNK = GM / 64;
constexpr int ST_CHUNK = 524288;
constexpr size_t MiB = 1u << 20;
constexpr size_t WS_CTL = 0, CTL_ZERO_BYTES = 1 * MiB;
constexpr size_t WS_WIN = 2 * MiB, WS_WOUT = 66 * MiB, WS_WUP = 82 * MiB, WS_WDN = 146 * MiB, WS_WGLR = 210 * MiB;
constexpr size_t WS_HB = 212 * MiB;
constexpr size_t WS_Z = 276 * MiB;
constexpr size_t WS_BG = 532 * MiB;
constexpr size_t WS_O = 596 * MiB;
constexpr size_t WS_ST = 660 * MiB;
constexpr size_t WS_TOT = 916 * MiB;
constexpr size_t WS_STS = 920 * MiB;
constexpr size_t WS_TOTS = 984 * MiB;
constexpr size_t WS_END = 985 * MiB;
constexpr int CW_BAR = 4096;
constexpr int RING_BYTES = 131072;
constexpr int LDS_BYTES = 160 * 1024, MISC_OFF = LDS_BYTES - 256;
constexpr int L_B32 = 0, L_KR = 33792, L_QR = 51200, L_QH = 68608, L_V = 86016, L_P = 119808, L_RED = 129024;
constexpr int B32_STR = 528, K_STR = 272, P_STR = 144, KT_STR = 144;
constexpr int NSC = GM / 256;
constexpr int SV_KT = 135168, KTW_BYTES = 2560;

#define GAS __attribute__((address_space(1)))
#define LAS __attribute__((address_space(3)))
typedef unsigned short bf16;
typedef unsigned v4u __attribute__((ext_vector_type(4)));
typedef float f32x4 __attribute__((ext_vector_type(4)));
typedef short bf16x8 __attribute__((ext_vector_type(8)));
typedef GAS unsigned gu32;
typedef GAS unsigned long long gu64;
#define RLX_AGENT __ATOMIC_RELAXED, __HIP_MEMORY_SCOPE_AGENT
#define LDS_WAIT() asm volatile("s_waitcnt lgkmcnt(0)" ::: "memory")
#define VM_WAIT() asm volatile("s_waitcnt vmcnt(0)" ::: "memory")
__device__ __forceinline__ unsigned long long rt() { return __builtin_amdgcn_s_memrealtime(); }
__device__ __forceinline__ unsigned f2bf(float f) { unsigned u = __builtin_bit_cast(unsigned, f); return (u + 0x7fffu + ((u >> 16) & 1u)) >> 16; }
__device__ __forceinline__ unsigned pk2(float lo, float hi) { return f2bf(lo) | (f2bf(hi) << 16); }

#define XB_TMO      128
#define XB_XCNT(j)  (256  + 64 * (j))
#define XB_XSUB(j)  (1280 + 64 * (j))
#define XB_XGEN(j)  (2304 + 64 * (j))
#define XB_TOP      3328
#define XB_TOPGEN   3392
#define XCD_BAR_WORDS 3456
#define XB_SPIN_CAP (1u << 18)

__device__ __forceinline__ unsigned xb_ld(unsigned* p)              { return __hip_atomic_load(p, __ATOMIC_RELAXED, __HIP_MEMORY_SCOPE_AGENT); }
__device__ __forceinline__ unsigned xb_add(unsigned* p, unsigned v) { return __hip_atomic_fetch_add(p, v, __ATOMIC_RELAXED, __HIP_MEMORY_SCOPE_AGENT); }
__device__ __forceinline__ unsigned xb_xcc_id() { return (unsigned)__builtin_amdgcn_s_getreg((3 << 11) | 20) & 0xFu; }
#define XB_SPIN(cond, bar) do { unsigned _sp = 0; while (cond) { __builtin_amdgcn_s_sleep(1); \
    if ((++_sp & 255u) == 0u) { if (xb_ld(&(bar)[XB_TMO])) break; if (_sp > XB_SPIN_CAP) { atomicAdd(&(bar)[XB_TMO], 1u); break; } } } } while (0)

struct XcdBarrier {
    unsigned* bar; unsigned x;
    volatile LAS unsigned* st;
};

__device__ __forceinline__ XcdBarrier xcd_barrier_post(unsigned* bar, volatile LAS unsigned* st) {
    XcdBarrier b; b.bar = bar; b.x = xb_xcc_id(); b.st = st;
    if (threadIdx.x == 0) (void)xb_add(&bar[XB_XCNT(b.x)], 1u);
    return b;
}
__device__ __forceinline__ void xcd_barrier_complete(unsigned* bar, unsigned x, unsigned& nloc, unsigned& nx) {
    const unsigned G = gridDim.x * gridDim.y * gridDim.z;
    unsigned sum, cnt, mine, sp = 0u;
    for (;;) {
        sum = 0u; cnt = 0u; mine = 0u;
#pragma unroll
        for (unsigned j = 0; j < 16; ++j) { const unsigned c = xb_ld(&bar[XB_XCNT(j)]); sum += c; cnt += (c > 0u) ? 1u : 0u; mine = (j == x) ? c : mine; }
        if (sum == G) break;
        __builtin_amdgcn_s_sleep(1);
        if ((++sp & 255u) == 0u) { if (xb_ld(&bar[XB_TMO])) break; if (sp > XB_SPIN_CAP) { atomicAdd(&bar[XB_TMO], 1u); break; } }
    }
    nloc = mine > 0u ? mine : 1u; nx = cnt > 0u ? cnt : 1u;
}

__device__ __forceinline__ void xcd_barrier(const XcdBarrier& b) {
    asm volatile("s_waitcnt vmcnt(0)" ::: "memory");
    __syncthreads();
    if (threadIdx.x == 0) {
        unsigned* bar = b.bar;
        __builtin_amdgcn_s_waitcnt(0);
        unsigned nloc = b.st[0], nx = b.st[1];
        if (nloc == 0u) { xcd_barrier_complete(bar, b.x, nloc, nx); b.st[0] = nloc; b.st[1] = nx; }
        const unsigned old = xb_add(&bar[XB_XSUB(b.x)], 1u);
        const unsigned gen = old / nloc;
        if (old + 1u == (gen + 1u) * nloc) {
            __builtin_amdgcn_fence(__ATOMIC_RELEASE, "agent");
            asm volatile("s_waitcnt vmcnt(0)" ::: "memory");
            const unsigned og = xb_add(&bar[XB_TOP], 1u);
            const unsigned tg = og / nx;
            if (og + 1u == (tg + 1u) * nx) xb_add(&bar[XB_TOPGEN], 1u);
            else XB_SPIN(xb_ld(&bar[XB_TOPGEN]) == tg, bar);
            __builtin_amdgcn_fence(__ATOMIC_ACQUIRE, "agent");
            xb_add(&bar[XB_XGEN(b.x)], 1u);
            asm volatile("s_waitcnt vmcnt(0)" ::: "memory");
        } else {
            XB_SPIN(xb_ld(&bar[XB_XGEN(b.x)]) == gen, bar);
            __builtin_amdgcn_fence(__ATOMIC_ACQUIRE, "agent");
            asm volatile("s_waitcnt vmcnt(0)" ::: "memory");
        }
    }
    __syncthreads();
}

typedef short s16x4 __attribute__((ext_vector_type(4)));
typedef float f32x2 __attribute__((ext_vector_type(2)));
typedef unsigned v2u __attribute__((ext_vector_type(2)));
__device__ __forceinline__ unsigned pkbf(float lo, float hi) { return pg8::cvt_pk_bf16(lo, hi); }
__device__ __forceinline__ float wave_sum(float v) {
#pragma unroll
    for (int o = 1; o < 64; o <<= 1) v += __shfl_xor(v, o);
    return v;
}
template <int CTRL, int RM> __device__ __forceinline__ float dpp_add(float v) {
    return v + __builtin_bit_cast(float, __builtin_amdgcn_update_dpp(0, __builtin_bit_cast(int, v), CTRL, RM, 0xf, true));
}
__device__ __forceinline__ float wave_scan_incl(float v, int) {
    v = dpp_add<0x111, 0xf>(v); v = dpp_add<0x112, 0xf>(v); v = dpp_add<0x114, 0xf>(v); v = dpp_add<0x118, 0xf>(v);
    v = dpp_add<0x142, 0xa>(v); v = dpp_add<0x143, 0xc>(v); return v;
}
#define DPP16(CTL) "v_add_f32_dpp %0, %0, %0 " CTL "\n\t" "v_add_f32_dpp %1, %1, %1 " CTL "\n\t" "v_add_f32_dpp %2, %2, %2 " CTL "\n\t" "v_add_f32_dpp %3, %3, %3 " CTL "\n\t" "v_add_f32_dpp %4, %4, %4 " CTL "\n\t" "v_add_f32_dpp %5, %5, %5 " CTL "\n\t" "v_add_f32_dpp %6, %6, %6 " CTL "\n\t" "v_add_f32_dpp %7, %7, %7 " CTL "\n\t" "v_add_f32_dpp %8, %8, %8 " CTL "\n\t" "v_add_f32_dpp %9, %9, %9 " CTL "\n\t" "v_add_f32_dpp %10, %10, %10 " CTL "\n\t" "v_add_f32_dpp %11, %11, %11 " CTL "\n\t" "v_add_f32_dpp %12, %12, %12 " CTL "\n\t" "v_add_f32_dpp %13, %13, %13 " CTL "\n\t" "v_add_f32_dpp %14, %14, %14 " CTL "\n\t" "v_add_f32_dpp %15, %15, %15 " CTL "\n\t"
__device__ __forceinline__ void wave_scan16(float* v) {
    asm volatile("s_nop 1\n\t"
        DPP16("row_shr:1 row_mask:0xf bank_mask:0xf") DPP16("row_shr:2 row_mask:0xf bank_mask:0xf") DPP16("row_shr:4 row_mask:0xf bank_mask:0xf") DPP16("row_shr:8 row_mask:0xf bank_mask:0xf")
        DPP16("row_bcast:15 row_mask:0xa bank_mask:0xf") DPP16("row_bcast:31 row_mask:0xc bank_mask:0xf") "s_nop 1"
        : "+v"(v[0]), "+v"(v[1]), "+v"(v[2]), "+v"(v[3]), "+v"(v[4]), "+v"(v[5]), "+v"(v[6]), "+v"(v[7]), "+v"(v[8]), "+v"(v[9]), "+v"(v[10]), "+v"(v[11]), "+v"(v[12]), "+v"(v[13]), "+v"(v[14]), "+v"(v[15]));
}
__device__ __forceinline__ void unpack8(const v4u v, float* f) {
    f[0] = __uint_as_float(v.x << 16); f[1] = __uint_as_float(v.x & 0xffff0000u); f[2] = __uint_as_float(v.y << 16); f[3] = __uint_as_float(v.y & 0xffff0000u);
    f[4] = __uint_as_float(v.z << 16); f[5] = __uint_as_float(v.z & 0xffff0000u); f[6] = __uint_as_float(v.w << 16); f[7] = __uint_as_float(v.w & 0xffff0000u);
}
__device__ __forceinline__ v4u pack8(const float* f) { v4u o; o.x = pkbf(f[0], f[1]); o.y = pkbf(f[2], f[3]); o.z = pkbf(f[4], f[5]); o.w = pkbf(f[6], f[7]); return o; }
__device__ __forceinline__ s16x4 lds_tr(LAS const unsigned char* p) { return __builtin_bit_cast(s16x4, __builtin_amdgcn_ds_read_tr16_b64_v4i16((LAS s16x4*)p)); }
__device__ __forceinline__ bf16x8 tr_pair(LAS const unsigned char* p0, LAS const unsigned char* p1) {
    const s16x4 a = lds_tr(p0), b = lds_tr(p1); return __builtin_shufflevector(a, b, 0, 1, 2, 3, 4, 5, 6, 7);
}
__device__ __forceinline__ float fexp2(float x) { return __builtin_amdgcn_exp2f(x); }
__device__ __forceinline__ float frcp(float x) { return __builtin_amdgcn_rcpf(x); }
__device__ __forceinline__ float lane63(float v) { return __builtin_bit_cast(float, __builtin_amdgcn_readlane(__builtin_bit_cast(int, v), 63)); }
__device__ __forceinline__ float flog2(float x) { return __builtin_amdgcn_logf(x); }

constexpr size_t ZB_GQ = (size_t)GM * 4096, ZB_GK = ZB_GQ + (size_t)GM * 512, ZB_HQ = ZB_GK + (size_t)GM * 512, ZB_HFF = ZB_HQ + (size_t)GM * 1024, ZB_HFB = ZB_HFF + (size_t)GM * 1024;
constexpr int ZRW = 4096, ZR_GV = 0, ZR_GOG = 1024, ZR_HI = 2048, ZR_HOG = 3072;
__device__ __forceinline__ size_t blk_off(int chunk, int H, int hh, int w) { return (size_t)((chunk * H + hh) * 8 + w) * 1024; }
struct Ctx {
    const float *x_prompt, *x_sample, *w_in, *w_lr2, *b_lr, *gla_g, *hg_g, *lowb, *w_out, *ln1_g, *ln1_b, *w_up, *w_down, *ln2_g, *ln2_b;
    float* out;
    bf16 *Win_t, *Wout_t, *Wup_t, *Wdn_t, *Wglr_t, *HB, *Z, *O, *ST;
    float *BG, *TOT, *TOTS; bf16 *STS, *MF;
};

__device__ __forceinline__ void transpose_item(const float* W, int N, int kb, int nb, bf16* dst, int K, LAS float* scr, int lane) {
    const int k0 = 64 * kb, n0 = 32 * nb;
#pragma unroll 8
    for (int i = 0; i < 32; ++i) { const int kk = 2 * i + (lane >> 5); scr[kk * 33 + (lane & 31)] = W[(size_t)(k0 + kk) * N + n0 + (lane & 31)]; }
    LDS_WAIT(); asm volatile("" ::: "memory");
    const int c = lane & 7;
#pragma unroll
    for (int j = 0; j < 4; ++j) { const int n = (lane >> 3) + 8 * j; const LAS float* s = scr + (8 * c) * 33 + n;
        v4u o; o.x = pkbf(s[0 * 33], s[1 * 33]); o.y = pkbf(s[2 * 33], s[3 * 33]); o.z = pkbf(s[4 * 33], s[5 * 33]); o.w = pkbf(s[6 * 33], s[7 * 33]);
        *(GAS v4u*)(dst + (size_t)n * K + k0 + 8 * c) = o; }
    LDS_WAIT(); asm volatile("" ::: "memory");
}
__device__ __forceinline__ void prologue_weights(const Ctx& X, LAS unsigned char* lds, int gw, int NGW, int wave, int lane) {
    LAS float* scr = (LAS float*)(lds + wave * 16384);
    constexpr int I_IN = 32 * 257, I_OUT = 32 * 64, I_UP = 32 * 256, I_DN = 128 * 64, I_L = I_IN + I_OUT + I_UP + I_DN;
    for (int it = gw; it < NLAYER * I_L; it += NGW) {
        const int l = it / I_L; int r = it % I_L;
        if (r < I_IN) { const int kb = r / 257, nb = r % 257;
            bf16* dst = (nb < 96) ? X.Win_t + ((size_t)l * ZW + 32 * nb) * DM : (nb == 96) ? X.Wglr_t + (size_t)l * 32 * DM : X.Win_t + ((size_t)l * ZW + 32 * (nb - 1)) * DM;
            transpose_item(X.w_in + (size_t)l * DM * INW, INW, kb, nb, dst, DM, scr, lane); continue; }
        r -= I_IN;
        if (r < I_OUT) { const int kb = r / 64, nb = r % 64; transpose_item(X.w_out + (size_t)l * DM * DM, DM, kb, nb, X.Wout_t + ((size_t)l * DM + 32 * nb) * DM, DM, scr, lane); continue; }
        r -= I_OUT;
        if (r < I_UP) { const int kb = r / 256, nb = r % 256; transpose_item(X.w_up + (size_t)l * DM * DFF, DFF, kb, nb, X.Wup_t + ((size_t)l * DFF + 32 * nb) * DM, DM, scr, lane); continue; }
        r -= I_UP;
        { const int kb = r / 64, nb = r % 64; transpose_item(X.w_down + (size_t)l * DFF * DM, DM, kb, nb, X.Wdn_t + ((size_t)l * DM + 32 * nb) * DFF, DFF, scr, lane); }
    }
}
__device__ __forceinline__ void cvt_group(const float* xg, bf16* HB, int gtid, int NT) {
    for (int i = gtid; i < GM * DM / 8; i += NT) {
        const f32x4 a = ((const GAS f32x4*)xg)[2 * i], b = ((const GAS f32x4*)xg)[2 * i + 1];
        v4u o; o.x = pkbf(a.x, a.y); o.y = pkbf(a.z, a.w); o.z = pkbf(b.x, b.y); o.w = pkbf(b.z, b.w);
        ((GAS v4u*)HB)[i] = o; }
}
template <bool RES_F32, bool OUT_F32>
__device__ __forceinline__ void ln_phase(const void* res, const bf16* mf, const float* gam, const float* bet, float* H, bf16* HB, int gw, int NGW, int lane) {
    for (int m = gw; m < GM; m += NGW) {
        f32x4 v[8]; float s = 0.f;
        const GAS v2u* mr = (const GAS v2u*)(mf + (size_t)m * DM) + lane;
#pragma unroll
        for (int j = 0; j < 8; ++j) { f32x4 r;
            if (RES_F32) r = ((const GAS f32x4*)((const float*)res + (size_t)m * DM) + lane)[64 * j];
            else { const v2u w = ((const GAS v2u*)((const bf16*)res + (size_t)m * DM) + lane)[64 * j];
                r = (f32x4){__uint_as_float(w.x << 16), __uint_as_float(w.x & 0xffff0000u), __uint_as_float(w.y << 16), __uint_as_float(w.y & 0xffff0000u)}; }
            const v2u w = mr[64 * j];
            const f32x4 f = (f32x4){__uint_as_float(w.x << 16), __uint_as_float(w.x & 0xffff0000u), __uint_as_float(w.y << 16), __uint_as_float(w.y & 0xffff0000u)};
            v[j] = r * ALPHA + f; s += (v[j].x + v[j].y) + (v[j].z + v[j].w); }
        const float mean = wave_sum(s) * (1.f / DM); float s2 = 0.f;
#pragma unroll
        for (int j = 0; j < 8; ++j) { v[j] = v[j] - mean; s2 += (v[j].x * v[j].x + v[j].y * v[j].y) + (v[j].z * v[j].z + v[j].w * v[j].w); }
        const float rstd = 1.f / sqrtf(wave_sum(s2) * (1.f / DM) + LN_EPS);
#pragma unroll
        for (int j = 0; j < 8; ++j) { const f32x4 g4 = ((const GAS f32x4*)gam)[lane + 64 * j], b4 = ((const GAS f32x4*)bet)[lane + 64 * j];
            const f32x4 o = v[j] * rstd * g4 + b4;
            if (OUT_F32) ((GAS f32x4*)(H + (size_t)m * DM) + lane)[64 * j] = o;
            else { v2u w; w.x = pkbf(o.x, o.y); w.y = pkbf(o.z, o.w); ((GAS v2u*)(HB + (size_t)m * DM) + lane)[64 * j] = w; } }
    }
}

__device__ __forceinline__ void gate_unit(const Ctx& X, int l, int chunk, LAS unsigned char* lds, int tid, int lane, int wave) {
    const int fr = lane & 15, fq = lane >> 4;
    const bf16* A = X.HB + (size_t)chunk * 64 * DM; const bf16* Bw = X.Wglr_t + (size_t)l * 32 * DM;
    f32x4 acc[4][2];
#pragma unroll
    for (int m = 0; m < 4; ++m)
#pragma unroll
        for (int n = 0; n < 2; ++n) acc[m][n] = (f32x4){0.f, 0.f, 0.f, 0.f};
#pragma unroll 2
    for (int ks = 0; ks < 8; ++ks) { const int k0 = 256 * wave + 32 * ks + 8 * fq;
        bf16x8 a[4], b[2];
#pragma unroll
        for (int m = 0; m < 4; ++m) a[m] = *(const GAS bf16x8*)(A + (size_t)(16 * m + fr) * DM + k0);
#pragma unroll
        for (int n = 0; n < 2; ++n) b[n] = *(const GAS bf16x8*)(Bw + (size_t)(16 * n + fr) * DM + k0);
#pragma unroll
        for (int m = 0; m < 4; ++m)
#pragma unroll
            for (int n = 0; n < 2; ++n) acc[m][n] = __builtin_amdgcn_mfma_f32_16x16x32_bf16(a[m], b[n], acc[m][n], 0, 0, 0); }
    LAS float* part = (LAS float*)lds;
#pragma unroll
    for (int m = 0; m < 4; ++m)
#pragma unroll
        for (int n = 0; n < 2; ++n)
#pragma unroll
            for (int j = 0; j < 4; ++j) part[(wave * 64 + 16 * m + 4 * fq + j) * 33 + 16 * n + fr] = acc[m][n][j];
    __syncthreads();
    LAS float* glr = (LAS float*)(lds + 8 * 64 * 33 * 4);
#pragma unroll
    for (int k = 0; k < 4; ++k) { const int idx = tid + 512 * k, t = idx >> 5, n = idx & 31; float s = 0.f;
#pragma unroll
        for (int w = 0; w < 8; ++w) s += part[(w * 64 + t) * 33 + n];
        glr[t * 36 + n] = s; }
    __syncthreads();
    const int dir = wave >> 2;
    const float* w2 = X.w_lr2 + (size_t)(l * 2 + dir) * 16 * 512; const float* bl = X.b_lr + (size_t)(l * 2 + dir) * 512;
    for (int cb = 0; cb < 2; ++cb) { const int c = 128 * (wave & 3) + 64 * cb + lane;
        float w[16];
#pragma unroll
        for (int r = 0; r < 16; ++r) w[r] = w2[r * 512 + c];
        const float bias = bl[c];
        bf16* bgcol = (bf16*)X.BG + ((size_t)(((chunk * 4 + (c >> 7)) * 8 + ((c & 127) >> 4)) * 2 + dir) * 64) * 16 + (c & 15);
#pragma unroll 4
        for (int tt = 0; tt < 64; ++tt) { const int t = dir ? 63 - tt : tt;
            const LAS f32x4* gr = (const LAS f32x4*)(glr + t * 36 + dir * 16); const f32x4 g0 = gr[0], g1 = gr[1], g2 = gr[2], g3 = gr[3];
            float pre = bias;
            pre += g0.x * w[0] + g0.y * w[1] + g0.z * w[2] + g0.w * w[3]; pre += g1.x * w[4] + g1.y * w[5] + g1.z * w[6] + g1.w * w[7];
            pre += g2.x * w[8] + g2.y * w[9] + g2.z * w[10] + g2.w * w[11]; pre += g3.x * w[12] + g3.y * w[13] + g3.z * w[14] + g3.w * w[15];
            const float gl = (fminf(pre, 0.f) - __logf(1.f + __expf(-fabsf(pre)))) * (LOG2E / 16.f);
            bgcol[(size_t)t * 16] = (bf16)(pkbf(gl, gl) & 0xffffu); } }
    __syncthreads();
}

__device__ __forceinline__ size_t st_slot(int chunk, bool hgt, int h, int dir) { return (size_t)chunk * ST_CHUNK + (hgt ? 262144 + (h * 2 + dir) * 16384 : (h * 2 + dir) * 32768); }

template <bool HGT> struct RawIn { v4u b[2]; v4u k[2]; };
template <> struct RawIn<true> { v4u k[2]; };
template <bool HGT>
__device__ __forceinline__ RawIn<HGT> pass_s_load(const Ctx& X, int chunk, int h, int dir, int lane, int c0) {
    RawIn<HGT> r; const int rt = dir ? 63 - lane : lane, w = c0 >> 4;
    if constexpr (!HGT) { const GAS v4u* bg = (const GAS v4u*)((const bf16*)X.BG + ((size_t)(((chunk * 4 + h) * 8 + w) * 2 + dir) * 64 + rt) * 16);
        r.b[0] = bg[0]; r.b[1] = bg[1];
        const GAS v4u* kp = (const GAS v4u*)(X.Z + ZB_GK + blk_off(chunk, 4, h, w) + rt * 16); r.k[0] = kp[0]; r.k[1] = kp[1];
    } else { const GAS v4u* zp = (const GAS v4u*)(X.Z + (dir ? ZB_HFB : ZB_HFF) + blk_off(chunk, 8, h, w) + rt * 16); r.k[0] = zp[0]; r.k[1] = zp[1]; }
    return r;
}
template <bool HGT, bool STORE>
__device__ __forceinline__ void pass_s_unit(const Ctx& X, int l, int sc, int h, LAS unsigned char* lds, int tid, int lane, int wave) {
    constexpr int DV = HGT ? 128 : 256, VSTR = DV * 2 + 16, NE = DV / 16, PPR = DV / 8, UNR_D = HGT ? 2 : 1, UNR_C = HGT ? 4 : 1;
    const int fr = lane & 15, fq = lane >> 4, qq = fr >> 2, p4 = fr & 3, c0 = 16 * wave;
    RawIn<HGT> cur = pass_s_load<HGT>(X, sc * 4, h, 0, lane, c0);
    RawIn<HGT> rq[HGT ? 4 : 1];
    { const int vcol = HGT ? ZR_HI + h * 128 : ZR_GV + h * 256;
#pragma unroll 4
      for (int k = 0; k < 256 * PPR / 512; ++k) { const int idx = tid + 512 * k, row = idx / PPR, pc = idx % PPR;
        const v4u v = *(const GAS v4u*)(X.Z + (size_t)(sc * 256 + row) * ZRW + vcol + pc * 8);
        *(LAS v4u*)(lds + row * VSTR + pc * 16) = v; } }
    __syncthreads();
    LAS unsigned char* kt = lds + SV_KT + wave * KTW_BYTES;
    for (int dir = 0; dir < 2; ++dir) {
        const int hd = HGT ? 8 + h * 2 + dir : h * 2 + dir;
        if constexpr (HGT) {
#pragma unroll
            for (int q4 = 0; q4 < 4; ++q4) rq[q4] = pass_s_load<HGT>(X, sc * 4 + (dir ? 3 - q4 : q4), h, dir, lane, c0); }
        float lbv[16];
        if (HGT) {
#pragma unroll
            for (int i = 0; i < 16; ++i) lbv[i] = 0.f;
            if (l != 0) { const float* lp = X.lowb + (size_t)dir * 2 * 1024 + h * 128 + c0;
#pragma unroll
                for (int i = 0; i < 16; ++i) lbv[i] = frcp(1.f + __expf(lp[i] - lp[1024 + i])); } }
        f32x4 acc[NE];
        if (STORE) { const bf16* sin = X.STS + st_slot(sc, HGT, h, dir);
#pragma unroll
            for (int et = 0; et < NE; ++et) { const v2u w = *(const GAS v2u*)(sin + (size_t)((et * 4 + (wave >> 1)) * 64 + fr + 16 * (2 * (wave & 1) + (fq >> 1))) * 8 + 4 * (fq & 1));
                acc[et] = (f32x4){__uint_as_float(w.x << 16), __uint_as_float(w.x & 0xffff0000u), __uint_as_float(w.y << 16), __uint_as_float(w.y & 0xffff0000u)}; }
        } else {
#pragma unroll
            for (int et = 0; et < NE; ++et) acc[et] = (f32x4){0.f, 0.f, 0.f, 0.f}; }
        float run[16];
#pragma unroll
        for (int i = 0; i < 16; ++i) run[i] = 0.f;
#pragma unroll UNR_C
        for (int cc = 0; cc < 4; ++cc) { const int ci = dir ? 3 - cc : cc, chunk = sc * 4 + ci;
            RawIn<HGT> nxt = cur;
            if constexpr (HGT) cur = rq[cc];
            else { if (cc < 3) nxt = pass_s_load<HGT>(X, sc * 4 + (dir ? 2 - cc : cc + 1), h, dir, lane, c0);
                   else if (dir == 0) nxt = pass_s_load<HGT>(X, sc * 4 + 3, h, 1, lane, c0); }
            float bc[16], kr[16];
            if constexpr (!HGT) {
                unpack8(cur.b[0], bc); unpack8(cur.b[1], bc + 8); wave_scan16(bc);
                unpack8(cur.k[0], kr); unpack8(cur.k[1], kr + 8);
            } else {
                float zf[16]; unpack8(cur.k[0], zf); unpack8(cur.k[1], zf + 8);
#pragma unroll
                for (int i = 0; i < 16; ++i) {
                    const float z = __builtin_amdgcn_fmed3f(zf[i], -60.f, 60.f), e = fexp2(z * -LOG2E), sig = frcp(1.f + e), oml = 1.f - lbv[i];
                    kr[i] = oml - oml * sig;
                    bc[i] = flog2(lbv[i] + oml * sig); }
                wave_scan16(bc);
            }
            if (STORE) { bf16* slot = X.ST + st_slot(chunk, HGT, h, dir);
#pragma unroll
                for (int et = 0; et < NE; ++et) { v2u w; w.x = pkbf(acc[et][0], acc[et][1]); w.y = pkbf(acc[et][2], acc[et][3]);
                    *(GAS v2u*)(slot + (size_t)((et * 4 + (wave >> 1)) * 64 + fr + 16 * (2 * (wave & 1) + (fq >> 1))) * 8 + 4 * (fq & 1)) = w; }
                if (cc == 3) { cur = nxt; break; } }
            float kh[16];
#pragma unroll
            for (int i = 0; i < 16; ++i) { const float bl = lane63(bc[i]); kh[i] = kr[i] * fexp2(bl - bc[i]); run[i] += bl; }
            { const v4u k0 = pack8(kh), k1 = pack8(kh + 8); const unsigned kw[8] = {k0.x, k0.y, k0.z, k0.w, k1.x, k1.y, k1.z, k1.w};
#pragma unroll
              for (int i = 0; i < 16; ++i) *(LAS unsigned short*)(kt + i * KT_STR + lane * 2) = (unsigned short)((i & 1) ? (kw[i >> 1] >> 16) : (kw[i >> 1] & 0xffffu)); }
            if (lane == 63) {
#pragma unroll
                for (int i = 0; i < 4; ++i) ((LAS f32x4*)(kt + 2304))[i] = (f32x4){bc[4 * i], bc[4 * i + 1], bc[4 * i + 2], bc[4 * i + 3]}; }
            asm volatile("s_waitcnt lgkmcnt(0)" ::: "memory");
            const f32x4 dl = *(const LAS f32x4*)(kt + 2304 + 16 * fq);
            const f32x4 dec = (f32x4){fexp2(dl.x), fexp2(dl.y), fexp2(dl.z), fexp2(dl.w)};
            bf16x8 afr[2];
#pragma unroll
            for (int ks = 0; ks < 2; ++ks) afr[ks] = *(const LAS bf16x8*)(kt + fr * KT_STR + (32 * ks + 8 * fq) * 2);
#pragma unroll
            for (int et = 0; et < NE; ++et) acc[et] = acc[et] * dec;
            { constexpr int NB = 2 * NE / 4;
              LAS const unsigned char* vb[2][2];
#pragma unroll
              for (int ks = 0; ks < 2; ++ks) { const int r0 = 32 * ks + 8 * fq + qq, r1 = r0 + 4;
                  vb[ks][0] = lds + (ci * 64 + (dir ? 63 - r0 : r0)) * VSTR + 8 * p4; vb[ks][1] = lds + (ci * 64 + (dir ? 63 - r1 : r1)) * VSTR + 8 * p4; }
              bf16x8 bb[2][4];
#pragma unroll
              for (int j = 0; j < 4; ++j) bb[0][j] = tr_pair(vb[0][0] + 32 * j, vb[0][1] + 32 * j);
#pragma unroll
              for (int b = 0; b < NB; ++b) {
                  if (b + 1 < NB) { const int ks1 = (b + 1) / (NE / 4), e1 = 4 * ((b + 1) % (NE / 4));
#pragma unroll
                      for (int j = 0; j < 4; ++j) bb[(b + 1) & 1][j] = tr_pair(vb[ks1][0] + 32 * (e1 + j), vb[ks1][1] + 32 * (e1 + j)); }
                  const int ks0 = b / (NE / 4), e0 = 4 * (b % (NE / 4));
#pragma unroll
                  for (int j = 0; j < 4; ++j) acc[e0 + j] = __builtin_amdgcn_mfma_f32_16x16x32_bf16(afr[ks0], bb[b & 1][j], acc[e0 + j], 0, 0, 0);
                  __builtin_amdgcn_sched_group_barrier(0x100, 8, 0); __builtin_amdgcn_sched_group_barrier(0x008, 4, 0); } }
            asm volatile("s_waitcnt lgkmcnt(0)" ::: "memory");
            cur = nxt;
        }
        if (!STORE) { bf16* sout = X.STS + st_slot(sc, HGT, h, dir);
#pragma unroll
            for (int et = 0; et < NE; ++et) { v2u w; w.x = pkbf(acc[et][0], acc[et][1]); w.y = pkbf(acc[et][2], acc[et][3]);
                *(GAS v2u*)(sout + (size_t)((et * 4 + (wave >> 1)) * 64 + fr + 16 * (2 * (wave & 1) + (fq >> 1))) * 8 + 4 * (fq & 1)) = w; }
            if (lane == 0) { float* tp = X.TOTS + ((size_t)sc * 24 + hd) * 128 + c0;
#pragma unroll
                for (int i = 0; i < 4; ++i) ((GAS f32x4*)tp)[i] = (f32x4){run[4 * i], run[4 * i + 1], run[4 * i + 2], run[4 * i + 3]}; } }
    }
    __syncthreads();
}
__device__ __forceinline__ void pass_b_super(const Ctx& X, int g, int gtid, int NT) {
    const int ns = (g == 0) ? 1 : 2, nc = NSC / ns;
    for (int v = gtid; v < ns * (ST_CHUNK / 8); v += NT) {
        const int s = v / (ST_CHUNK / 8), idx = (v % (ST_CHUNK / 8)) * 8;
        const int hd = idx < 262144 ? idx / 32768 : 8 + (idx - 262144) / 16384, db = hd & 1;
        const int d0 = 32 * ((idx >> 9) & 3) + 8 * ((idx >> 7) & 3);
        float S[8];
#pragma unroll
        for (int i = 0; i < 8; ++i) S[i] = 0.f;
        for (int cc = 0; cc < nc; cc += 8) {
            v4u x[8]; f32x4 t0[8], t1[8];
#pragma unroll
            for (int u = 0; u < 8; ++u) { const int c = s * nc + (db ? nc - 1 - (cc + u) : cc + u);
                x[u] = *(const GAS v4u*)(X.STS + (size_t)c * ST_CHUNK + idx);
                const GAS f32x4* tp = (const GAS f32x4*)(X.TOTS + ((size_t)c * 24 + hd) * 128 + d0); t0[u] = tp[0]; t1[u] = tp[1]; }
#pragma unroll
            for (int u = 0; u < 8; ++u) { const int c = s * nc + (db ? nc - 1 - (cc + u) : cc + u);
                *(GAS v4u*)(X.STS + (size_t)c * ST_CHUNK + idx) = pack8(S);
                float dx[8]; unpack8(x[u], dx);
                const float dec[8] = {fexp2(t0[u].x), fexp2(t0[u].y), fexp2(t0[u].z), fexp2(t0[u].w), fexp2(t1[u].x), fexp2(t1[u].y), fexp2(t1[u].z), fexp2(t1[u].w)};
#pragma unroll
                for (int i = 0; i < 8; ++i) S[i] = dec[i] * S[i] + dx[i]; }
        }
    }
}

constexpr int C2_DIR = 63488, C2_QD = 0, C2_KD = 17408, C2_QH = 34816, C2_P = 52224, C2_BT = 61440, C2_V = 126976, C2_RED = 160768;
template <bool HGT>
__device__ __forceinline__ void c2_stage(const Ctx& X, int l, int chunk, int h, int dir, LAS unsigned char* ld, int lane, int wave) {
    const int r = lane, rt = dir ? 63 - r : r, c0 = 16 * wave;
    float bc[16], kr[16], qv[16];
    if (!HGT) {
        const GAS v4u* bg = (const GAS v4u*)((const bf16*)X.BG + ((size_t)(((chunk * 4 + h) * 8 + wave) * 2 + dir) * 64 + rt) * 16);
        unpack8(bg[0], bc); unpack8(bg[1], bc + 8); wave_scan16(bc);
        const GAS v4u* kp = (const GAS v4u*)(X.Z + ZB_GK + blk_off(chunk, 4, h, wave) + rt * 16); unpack8(kp[0], kr); unpack8(kp[1], kr + 8);
        const GAS v4u* qp = (const GAS v4u*)(X.Z + ZB_GQ + blk_off(chunk, 4, h, wave) + rt * 16); unpack8(qp[0], qv); unpack8(qp[1], qv + 8);
#pragma unroll
        for (int i = 0; i < 16; ++i) qv[i] *= 0.08838834764831845f;
    } else {
        float zf[16];
        const GAS v4u* zp = (const GAS v4u*)(X.Z + (dir ? ZB_HFB : ZB_HFF) + blk_off(chunk, 8, h, wave) + rt * 16); unpack8(zp[0], zf); unpack8(zp[1], zf + 8);
        const GAS v4u* qp = (const GAS v4u*)(X.Z + ZB_HQ + blk_off(chunk, 8, h, wave) + rt * 16); unpack8(qp[0], qv); unpack8(qp[1], qv + 8);
        float lbv[16];
        if (l == 0) {
#pragma unroll
            for (int i = 0; i < 16; ++i) lbv[i] = 0.f;
        } else { const float* lp = X.lowb + (size_t)dir * 2 * 1024 + h * 128 + c0;
#pragma unroll
            for (int i = 0; i < 16; ++i) lbv[i] = frcp(1.f + __expf(lp[i] - lp[1024 + i])); }
#pragma unroll
        for (int i = 0; i < 16; ++i) {
            const float z = __builtin_amdgcn_fmed3f(zf[i], -60.f, 60.f), e = fexp2(z * -LOG2E), sig = frcp(1.f + e), oml = 1.f - lbv[i];
            kr[i] = oml - oml * sig;
            bc[i] = flog2(lbv[i] + oml * sig); }
        wave_scan16(bc);
    }
    float qd[16], kd[16], qh[16];
#pragma unroll
    for (int i = 0; i < 16; ++i) {
        const float beta = __builtin_bit_cast(float, __builtin_amdgcn_update_dpp(0, __builtin_bit_cast(int, bc[i]), 0x142, 0xe, 0xf, false));
        qd[i] = qv[i] * fexp2(bc[i] - beta); kd[i] = kr[i] * fexp2(__builtin_amdgcn_fmed3f(beta - bc[i], 0.f, 80.f)); qh[i] = qv[i] * fexp2(bc[i]); }
    LAS unsigned char* p = ld + r * K_STR + c0 * 2;
    ((LAS v4u*)(p + C2_QD))[0] = pack8(qd); ((LAS v4u*)(p + C2_QD))[1] = pack8(qd + 8);
    ((LAS v4u*)(p + C2_KD))[0] = pack8(kd); ((LAS v4u*)(p + C2_KD))[1] = pack8(kd + 8);
    ((LAS v4u*)(p + C2_QH))[0] = pack8(qh); ((LAS v4u*)(p + C2_QH))[1] = pack8(qh + 8);
    if ((lane & 15) == 15) { LAS f32x4* bt = (LAS f32x4*)(ld + C2_BT + (((lane >> 4) + 1) & 3) * 512 + c0 * 4);
        const bool z = lane == 63;
#pragma unroll
        for (int i = 0; i < 4; ++i) bt[i] = z ? (f32x4){0.f, 0.f, 0.f, 0.f} : (f32x4){bc[4 * i], bc[4 * i + 1], bc[4 * i + 2], bc[4 * i + 3]}; }
}
template <bool HGT>
__device__ __forceinline__ void pass_c2_unit(const Ctx& X, int l, int chunk, int h, LAS unsigned char* lds, int tid, int lane, int wave) {
    constexpr int DV = HGT ? 128 : 256, VSTR = DV * 2 + 16, NET = DV / 128, PPR = DV / 8;
    const int fr = lane & 15, fq = lane >> 4, qq = fr >> 2, p4 = fr & 3;
    { const int vcol = HGT ? ZR_HI + h * 128 : ZR_GV + h * 256;
#pragma unroll
      for (int k = 0; k < 64 * PPR / 512; ++k) { const int idx = tid + 512 * k, row = idx / PPR, pc = idx % PPR;
        const v4u v = *(const GAS v4u*)(X.Z + (size_t)(chunk * 64 + row) * ZRW + vcol + pc * 8);
        *(LAS v4u*)(lds + C2_V + row * VSTR + pc * 16) = v; } }
    c2_stage<HGT>(X, l, chunk, h, 0, lds, lane, wave);
    c2_stage<HGT>(X, l, chunk, h, 1, lds + C2_DIR, lane, wave);
    bf16x8 sfr[2][NET][4];
#pragma unroll
    for (int dir = 0; dir < 2; ++dir) { const bf16* slot = X.ST + st_slot(chunk, HGT, h, dir);
#pragma unroll
        for (int et = 0; et < NET; ++et)
#pragma unroll
            for (int ks = 0; ks < 4; ++ks) sfr[dir][et][ks] = *(const GAS bf16x8*)(slot + (size_t)(((wave * NET + et) * 4 + ks) * 64 + lane) * 8); }
    __syncthreads();
    { const int a = wave & 3; LAS unsigned char* ld = lds + (wave >> 2) * C2_DIR;
      const unsigned lst = (a == 0) ? 0xff002010u : (a == 1) ? 0xff113021u : (a == 2) ? 0xffff2231u : 0xffff3332u;
      const unsigned zls = (a == 0) ? 0xffff0201u : (a == 1) ? 0xffff1203u : (a == 2) ? 0xffffff13u : 0xffffff23u;
      for (int t = 0; t < 3; ++t) { const unsigned code = (lst >> (8 * t)) & 0xffu; if (code == 0xffu) break;
          const int I = (int)(code >> 4), J = (int)(code & 15u);
          f32x4 sc = (f32x4){0.f, 0.f, 0.f, 0.f};
#pragma unroll
          for (int ks = 0; ks < 4; ++ks) { const int dc = 32 * ks + 8 * fq;
              v4u ka = *(const LAS v4u*)(ld + C2_KD + (16 * J + fr) * K_STR + dc * 2);
              const bf16x8 qb = *(const LAS bf16x8*)(ld + C2_QD + (16 * I + fr) * K_STR + dc * 2);
              if (J < I) { const LAS f32x4* bi = (const LAS f32x4*)(ld + C2_BT + I * 512 + dc * 4); const LAS f32x4* bj = (const LAS f32x4*)(ld + C2_BT + J * 512 + dc * 4);
                  const f32x4 d0 = bi[0] - bj[0], d1 = bi[1] - bj[1]; float kf[8]; unpack8(ka, kf);
                  kf[0] *= fexp2(d0.x); kf[1] *= fexp2(d0.y); kf[2] *= fexp2(d0.z); kf[3] *= fexp2(d0.w); kf[4] *= fexp2(d1.x); kf[5] *= fexp2(d1.y); kf[6] *= fexp2(d1.z); kf[7] *= fexp2(d1.w);
                  ka = pack8(kf); }
              sc = __builtin_amdgcn_mfma_f32_16x16x32_bf16(__builtin_bit_cast(bf16x8, ka), qb, sc, 0, 0, 0); }
          if (J == I) {
#pragma unroll
              for (int u = 0; u < 4; ++u) if (4 * fq + u > fr) sc[u] = 0.f; }
          v2u w; w.x = pkbf(sc[0], sc[1]); w.y = pkbf(sc[2], sc[3]);
          *(LAS v2u*)(ld + C2_P + (16 * I + fr) * P_STR + (16 * J + 4 * fq) * 2) = w; }
      for (int t = 0; t < 2; ++t) { const unsigned code = (zls >> (8 * t)) & 0xffu; if (code == 0xffu) break;
          const int I = (int)(code >> 4), J = (int)(code & 15u);
          *(LAS v2u*)(ld + C2_P + (16 * I + fr) * P_STR + (16 * J + 4 * fq) * 2) = (v2u){0u, 0u}; } }
    __syncthreads();
    f32x4 oacc[NET][4];
#pragma unroll
    for (int et = 0; et < NET; ++et)
#pragma unroll
        for (int it = 0; it < 4; ++it) oacc[et][it] = (f32x4){0.f, 0.f, 0.f, 0.f};
#pragma unroll
    for (int dir = 0; dir < 2; ++dir) { LAS const unsigned char* ld = lds + dir * C2_DIR;
        bf16x8 vfr[NET][2];
#pragma unroll
        for (int ks = 0; ks < 2; ++ks) { const int r0 = 32 * ks + 8 * fq + qq, r1 = r0 + 4, v0 = dir ? 63 - r0 : r0, v1 = dir ? 63 - r1 : r1;
#pragma unroll
            for (int et = 0; et < NET; ++et) { const int col = (16 * (wave * NET + et) + 4 * p4) * 2;
                vfr[et][ks] = tr_pair(lds + C2_V + v0 * VSTR + col, lds + C2_V + v1 * VSTR + col); } }
#pragma unroll
        for (int it = 0; it < 4; ++it) { const int trow = 16 * it + fr, ip = dir ? 63 - trow : trow;
            bf16x8 bo[6];
#pragma unroll
            for (int ks = 0; ks < 4; ++ks) bo[ks] = *(const LAS bf16x8*)(ld + C2_QH + ip * K_STR + (32 * ks + 8 * fq) * 2);
#pragma unroll
            for (int ks = 0; ks < 2; ++ks) bo[4 + ks] = *(const LAS bf16x8*)(ld + C2_P + ip * P_STR + (32 * ks + 8 * fq) * 2);
#pragma unroll
            for (int ks = 0; ks < 4; ++ks)
#pragma unroll
                for (int et = 0; et < NET; ++et) oacc[et][it] = __builtin_amdgcn_mfma_f32_16x16x32_bf16(sfr[dir][et][ks], bo[ks], oacc[et][it], 0, 0, 0);
#pragma unroll
            for (int ks = 0; ks < 2; ++ks)
#pragma unroll
                for (int et = 0; et < NET; ++et) oacc[et][it] = __builtin_amdgcn_mfma_f32_16x16x32_bf16(vfr[et][ks], bo[4 + ks], oacc[et][it], 0, 0, 0); } }
    LAS float* red = (LAS float*)(lds + C2_RED);
#pragma unroll
    for (int it = 0; it < 4; ++it) { float sq = 0.f;
#pragma unroll
        for (int et = 0; et < NET; ++et) { const f32x4 o = oacc[et][it]; sq += (o.x * o.x + o.y * o.y) + (o.z * o.z + o.w * o.w); }
        sq += __shfl_xor(sq, 16); sq += __shfl_xor(sq, 32);
        if (fq == 0) red[wave * 64 + 16 * it + fr] = sq; }
    __syncthreads();
    const float* ng = (HGT ? X.hg_g + (size_t)l * 128 : X.gla_g + (size_t)l * 256);
    const int ogcol = HGT ? ZR_HOG + h * 128 : ZR_GOG + h * 256, ocol = HGT ? 1024 + h * 128 : h * 256;
#pragma unroll
    for (int it = 0; it < 4; ++it) { float tot = 0.f;
#pragma unroll
        for (int w = 0; w < 8; ++w) tot += red[w * 64 + 16 * it + fr];
        const float rstd = __builtin_amdgcn_rsqf(tot * (1.f / DV) + RMS_EPS);
        const int tok = chunk * 64 + 16 * it + fr;
#pragma unroll
        for (int et = 0; et < NET; ++et) { const int e0 = 16 * (wave * NET + et) + 4 * fq;
            const v2u ogp = *(const GAS v2u*)(X.Z + (size_t)tok * ZRW + ogcol + e0);
            const float og[4] = {__uint_as_float(ogp.x << 16), __uint_as_float(ogp.x & 0xffff0000u), __uint_as_float(ogp.y << 16), __uint_as_float(ogp.y & 0xffff0000u)};
            const f32x4 g4 = *(const GAS f32x4*)(ng + e0); float rr[4];
#pragma unroll
            for (int u = 0; u < 4; ++u) { const float z = og[u]; rr[u] = oacc[et][it][u] * rstd * g4[u] * (z * frcp(1.f + fexp2(z * -LOG2E))); }
            v2u w; w.x = pkbf(rr[0], rr[1]); w.y = pkbf(rr[2], rr[3]);
            *(GAS v2u*)(X.O + (size_t)tok * DM + ocol + e0) = w; } }
}

struct Args { const float* in[15]; float* out; unsigned char* ws; int mode, pad; };
#define PHASE_IDS() int tid = threadIdx.x; asm volatile("" : "+v"(tid)); const int lane = tid & 63, wave = __builtin_amdgcn_readfirstlane(tid >> 6); \
    const int gw = bx * NWAVES + wave, NGW = G * NWAVES, gtid = bx * (NWAVES * 64) + tid, NT = G * NWAVES * 64; (void)lane; (void)wave; (void)gw; (void)NGW; (void)gtid; (void)NT
__device__ __forceinline__ Ctx make_ctx(const Args& args) {
    Ctx X; unsigned char* ws = args.ws;
    X.x_prompt = args.in[0]; X.x_sample = args.in[1]; X.w_in = args.in[2]; X.w_lr2 = args.in[3]; X.b_lr = args.in[4]; X.gla_g = args.in[5]; X.hg_g = args.in[6]; X.lowb = args.in[7];
    X.w_out = args.in[8]; X.ln1_g = args.in[9]; X.ln1_b = args.in[10]; X.w_up = args.in[11]; X.w_down = args.in[12]; X.ln2_g = args.in[13]; X.ln2_b = args.in[14]; X.out = args.out;
    X.Win_t = (bf16*)(ws + WS_WIN); X.Wout_t = (bf16*)(ws + WS_WOUT); X.Wup_t = (bf16*)(ws + WS_WUP); X.Wdn_t = (bf16*)(ws + WS_WDN); X.Wglr_t = (bf16*)(ws + WS_WGLR);
    X.HB = (bf16*)(ws + WS_HB); X.Z = (bf16*)(ws + WS_Z); X.O = (bf16*)(ws + WS_O); X.ST = (bf16*)(ws + WS_ST);
    X.BG = (float*)(ws + WS_BG); X.MF = (bf16*)(ws + WS_ST); X.TOT = (float*)(ws + WS_TOT); X.TOTS = (float*)(ws + WS_TOTS); X.STS = (bf16*)(ws + WS_STS);
    return X;
}
__global__ void __launch_bounds__(NWAVES * 64, 2) fwd_kernel(Args args) {
    extern __shared__ __attribute__((aligned(16))) unsigned char lds_raw[];
    LAS unsigned char* lds = (LAS unsigned char*)lds_raw;
    const int G = gridDim.x, bx = blockIdx.x;
    volatile LAS unsigned* MISC = (volatile LAS unsigned*)(lds + MISC_OFF);
    if (threadIdx.x < 32) MISC[threadIdx.x] = 0u;
    __syncthreads();
    XcdBarrier bar = xcd_barrier_post((unsigned*)(args.ws + WS_CTL) + CW_BAR, MISC + 8);

    { PHASE_IDS(); const Ctx X = make_ctx(args); prologue_weights(X, lds, gw, NGW, wave, lane); }
    for (int g = 0; g < NGRP; ++g) {
        { PHASE_IDS(); const Ctx X = make_ctx(args); cvt_group((g == 0) ? X.x_prompt : X.x_sample + (size_t)(g - 1) * GM * DM, X.HB, gtid, NT); }
        xcd_barrier(bar);
        for (int l = 0; l < NLAYER; ++l) {
            { PHASE_IDS(); const Ctx X = make_ctx(args); for (int c = bx; c < NCHUNK; c += G) gate_unit(X, l, c, lds, tid, lane, wave); }
            { const Ctx X = make_ctx(args); pg8::Gemm gm{X.HB, X.Win_t + (size_t)l * ZW * DM, GM, ZW, DM}; pg8::StaticOrder S; S.init(GM, ZW, G, bx);
              pg8::EpiZ E{X.Z};
              pg8::gemm_phase<pg8::EpiZ, pg8::StaticOrder, false, true>(lds, gm, S, E); }
            xcd_barrier(bar);
            {
            { PHASE_IDS(); const Ctx X = make_ctx(args);
              for (int u = bx; u < NSC * 12; u += G) { const int sc = u / 12, hh = u % 12;
                if (hh < 4) pass_s_unit<false, false>(X, l, sc, hh, lds, tid, lane, wave); else pass_s_unit<true, false>(X, l, sc, hh - 4, lds, tid, lane, wave); } }
            xcd_barrier(bar);
            { PHASE_IDS(); const Ctx X = make_ctx(args); pass_b_super(X, g, gtid, NT); }
            xcd_barrier(bar);
            { PHASE_IDS(); const Ctx X = make_ctx(args);
              for (int u = bx; u < NSC * 12; u += G) { const int sc = u / 12, hh = u % 12;
                if (hh < 4) pass_s_unit<false, true>(X, l, sc, hh, lds, tid, lane, wave); else pass_s_unit<true, true>(X, l, sc, hh - 4, lds, tid, lane, wave); } }
            xcd_barrier(bar);
            { PHASE_IDS(); const Ctx X = make_ctx(args);
              for (int u = bx; u < NCHUNK * 12; u += G) { const int c = u / 12, hh = u % 12;
                if (hh < 4) pass_c2_unit<false>(X, l, c, hh, lds, tid, lane, wave); else pass_c2_unit<true>(X, l, c, hh - 4, lds, tid, lane, wave); } }
            xcd_barrier(bar);
            }
            { const Ctx X = make_ctx(args); pg8::Gemm gm{X.O, X.Wout_t + (size_t)l * DM * DM, GM, DM, DM}; pg8::StaticOrder S; S.init(GM, DM, G, bx);
              pg8::EpiBf16<0> E{X.MF, DM};
              pg8::gemm_phase<pg8::EpiBf16<0>, pg8::StaticOrder, false, true>(lds, gm, S, E); }
            xcd_barrier(bar);
            { PHASE_IDS(); const Ctx X = make_ctx(args);
              if (l == 0) ln_phase<true, false>((g == 0) ? X.x_prompt : X.x_sample + (size_t)(g - 1) * GM * DM, X.MF, X.ln1_g, X.ln1_b, nullptr, X.HB, gw, NGW, lane);
              else ln_phase<false, false>(X.HB, X.MF, X.ln1_g + (size_t)l * DM, X.ln1_b + (size_t)l * DM, nullptr, X.HB, gw, NGW, lane); }
            xcd_barrier(bar);
            { const Ctx X = make_ctx(args); pg8::Gemm gm{X.HB, X.Wup_t + (size_t)l * DFF * DM, GM, DFF, DM}; pg8::StaticOrder S; S.init(GM, DFF, G, bx);
              pg8::EpiBf16<1> E{X.Z, DFF};
              pg8::gemm_phase<pg8::EpiBf16<1>, pg8::StaticOrder, false, true>(lds, gm, S, E); }
            xcd_barrier(bar);
            { const Ctx X = make_ctx(args); pg8::Gemm gm{X.Z, X.Wdn_t + (size_t)l * DM * DFF, GM, DM, DFF}; pg8::StaticOrder S; S.init(GM, DM, G, bx);
              pg8::EpiBf16<0> E{X.MF, DM};
              pg8::gemm_phase<pg8::EpiBf16<0>, pg8::StaticOrder, false, true>(lds, gm, S, E); }
            xcd_barrier(bar);
            { PHASE_IDS(); const Ctx X = make_ctx(args);
              if (l == NLAYER - 1) ln_phase<false, true>(X.HB, X.MF, X.ln2_g + (size_t)l * DM, X.ln2_b + (size_t)l * DM, X.out + (size_t)g * GM * DM, nullptr, gw, NGW, lane);
              else ln_phase<false, false>(X.HB, X.MF, X.ln2_g + (size_t)l * DM, X.ln2_b + (size_t)l * DM, nullptr, X.HB, gw, NGW, lane); }
            xcd_barrier(bar);
        }
    }
}

extern "C" void kernel_launch(void* const* d_in, const int* in_sizes, int n_in, void* d_out, int out_size, void* d_ws, size_t ws_size, hipStream_t stream) {
    static int grid = 0;
    if (grid == 0) {
        if (n_in != 15 || out_size != NTOK * DM || ws_size < WS_END) { fprintf(stderr, "kernel_launch: unexpected shapes (n_in %d, out %d, ws %zu)\n", n_in, out_size, ws_size); grid = -1; return; }
        int dev = 0, cus = 0;
        if (hipGetDevice(&dev) != hipSuccess || hipDeviceGetAttribute(&cus, hipDeviceAttributeMultiprocessorCount, dev) != hipSuccess) { grid = -1; return; }
        if (hipFuncSetAttribute((const void*)fwd_kernel, hipFuncAttributeMaxDynamicSharedMemorySize, LDS_BYTES) != hipSuccess) { fprintf(stderr, "kernel_launch: hipFuncSetAttribute failed\n"); grid = -1; return; }
        int per_cu = 0;
        if (hipOccupancyMaxActiveBlocksPerMultiprocessor(&per_cu, (const void*)fwd_kernel, NWAVES * 64, LDS_BYTES) != hipSuccess || per_cu < 1) { fprintf(stderr, "kernel_launch: occupancy query says %d\n", per_cu); }
        (void)hipGetLastError();
        grid = cus;
    }
    if (grid < 0) return;
    if (hipMemsetAsync((char*)d_ws + WS_CTL, 0, CTL_ZERO_BYTES, stream) != hipSuccess) return;
    Args a{};
    for (int i = 0; i < 15; ++i) a.in[i] = (const float*)d_in[i];
    a.out = (float*)d_out; a.ws = (unsigned char*)d_ws; a.mode = KMODE; a.pad = 0;
    hipLaunchKernelGGL(fwd_kernel, dim3(grid), dim3(NWAVES * 64), LDS_BYTES, stream, a);
}
```

```cpp
#include <hip/hip_runtime.h>
#include <cstdio>
#include <cstdint>
#ifndef KMODE
#define KMODE 0
#endif
namespace pg8 {
#define PG8_LAS __attribute__((address_space(3)))
typedef unsigned short bf16_t;
typedef short bf16x8 __attribute__((ext_vector_type(8)));
typedef float f32x4 __attribute__((ext_vector_type(4)));
typedef unsigned u32x4 __attribute__((ext_vector_type(4)));
constexpr int BM = 256, BK = 64, HALF = 128, HTB = HALF * BK * 2  , STAGE_BYTES = 8 * HTB, NXCD = 8, WGM = 4;

__host__ __device__ __forceinline__ int lds_byte(int r, int c) { const int st = (r >> 4) * 2 + (c >> 5), rr = r & 15, cc = c & 31, ob = rr * 64 + cc * 2; return st * 1024 + (ob ^ (((ob >> 9) & 1) << 5)); }
__host__ __device__ __forceinline__ void stage_rc(int b, int& R, int& C) { const int st = b / 1024, sb = b % 1024, swz = sb ^ (((sb >> 9) & 1) << 5); R = (st >> 1) * 16 + swz / 64; C = (st & 1) * 32 + (swz % 64) / 2; }
__host__ __device__ __forceinline__ int perm32(int rho) { const int n = rho >> 4, i = rho & 15; return 8 * (i >> 2) + 4 * n + (i & 3); }

struct Unit { int pm, pn; };
struct Gemm { const bf16_t* A; const bf16_t* Bt; int M, N, K; };

struct StaticOrder {
    int nM, nN, nwg, G, c;
    __host__ __device__ void init(int M, int N, int G_, int c_) { nM = M / BM; nN = N / BM; nwg = nM * nN; G = G_; c = c_; }
    __host__ __device__ bool next(int i, Unit& u) const {
        const long L = (long)i * G + c; if (L >= nwg) return false;
        int wgid = (int)L; { const int q = nwg / NXCD, r = nwg % NXCD, xcd = wgid % NXCD, off = wgid / NXCD; wgid = (xcd < r ? xcd * (q + 1) : r * (q + 1) + (xcd - r) * q) + off; }
        const int nig = WGM * nN, gid = wgid / nig, fm = gid * WGM, gsz = (nM - fm) < WGM ? (nM - fm) : WGM;
        u.pm = fm + ((wgid % nig) % gsz); u.pn = (wgid % nig) / gsz; return true;
    }
    __device__ __forceinline__ void a_ready(const Unit&) const {}
    __device__ __forceinline__ void done(const Unit&) const {}
};


__device__ __forceinline__ unsigned cvt_pk_bf16(float lo, float hi) { unsigned r; asm volatile("v_cvt_pk_bf16_f32 %0, %1, %2" : "=v"(r) : "v"(lo), "v"(hi)); return r; }

template <int ACT  > struct EpiBf16 {
    static constexpr bool PERM = true, AFTER_DRAIN = false;
    bf16_t* O; int ldc;
    __device__ __forceinline__ void operator()(const f32x4 (&acc)[2][2][4][2], const Unit& u, int wr, int wc, int fr, int fq) const {
        const int row0 = u.pm * BM + wr * 64 + fr; const int col0 = u.pn * BM + wc * 32 + 8 * fq;
#pragma unroll
        for (int ai = 0; ai < 2; ++ai)
#pragma unroll
            for (int m = 0; m < 4; ++m) { bf16_t* rowp = O + (size_t)(row0 + ai * HALF + m * 16) * ldc + col0;
#pragma unroll
                for (int bj = 0; bj < 2; ++bj) { f32x4 v0 = acc[ai][bj][m][0], v1 = acc[ai][bj][m][1];
                    if (ACT == 1) {
#pragma unroll
                        for (int j = 0; j < 4; ++j) { const float a = fmaxf(v0[j], 0.f), b = fmaxf(v1[j], 0.f); v0[j] = a * a; v1[j] = b * b; } }
                    u32x4 w; w.x = cvt_pk_bf16(v0[0], v0[1]); w.y = cvt_pk_bf16(v0[2], v0[3]); w.z = cvt_pk_bf16(v1[0], v1[1]); w.w = cvt_pk_bf16(v1[2], v1[3]);
                    *(u32x4*)(rowp + bj * HALF) = w; } }
    }
};
struct EpiF32 {
    static constexpr bool PERM = false, AFTER_DRAIN = false;
    float* C; int ldc;
    __device__ __forceinline__ void operator()(const f32x4 (&acc)[2][2][4][2], const Unit& u, int wr, int wc, int fr, int fq) const {
        const int row0 = u.pm * BM + wr * 64 + fr, col0 = u.pn * BM + wc * 32 + 4 * fq;
#pragma unroll
        for (int ai = 0; ai < 2; ++ai)
#pragma unroll
            for (int m = 0; m < 4; ++m) { float* rowp = C + (size_t)(row0 + ai * HALF + m * 16) * ldc + col0;
#pragma unroll
                for (int bj = 0; bj < 2; ++bj)
#pragma unroll
                    for (int n = 0; n < 2; ++n) *(f32x4*)(rowp + bj * HALF + n * 16) = acc[ai][bj][m][n]; }
    }
};

struct EpiZ {
    static constexpr bool PERM = true, AFTER_DRAIN = false;
    bf16_t* Z;
    __device__ __forceinline__ void operator()(const f32x4 (&acc)[2][2][4][2], const Unit& u, int wr, int wc, int fr, int fq) const {
        const int pn = u.pn; const size_t Mr = 16384;
        bool blocked; int H = 4, c0; bf16_t* base;
        if (pn < 2) { blocked = true; H = 4; base = Z + Mr * 4096; c0 = pn * 256; }
        else if (pn < 4) { blocked = true; H = 4; base = Z + Mr * 4096 + Mr * 512; c0 = (pn - 2) * 256; }
        else if (pn < 8) { blocked = false; base = Z; c0 = (pn - 4) * 256; }
        else if (pn < 12) { blocked = false; base = Z; c0 = 1024 + (pn - 8) * 256; }
        else if (pn < 24) { blocked = true; H = 8; base = Z + Mr * 4096 + Mr * 1024 + (size_t)((pn - 12) >> 2) * Mr * 1024; c0 = ((pn - 12) & 3) * 256; }
        else if (pn < 28) { blocked = false; base = Z; c0 = 2048 + (pn - 24) * 256; }
        else { blocked = false; base = Z; c0 = 3072 + (pn - 28) * 256; }
        const int row0 = u.pm * BM + wr * 64 + fr, cl = c0 + wc * 32 + 8 * fq;
#pragma unroll
        for (int ai = 0; ai < 2; ++ai)
#pragma unroll
            for (int m = 0; m < 4; ++m) { const int row = row0 + ai * HALF + m * 16;
#pragma unroll
                for (int bj = 0; bj < 2; ++bj) { const f32x4 v0 = acc[ai][bj][m][0], v1 = acc[ai][bj][m][1]; const int c = cl + bj * HALF;
                    u32x4 w; w.x = cvt_pk_bf16(v0[0], v0[1]); w.y = cvt_pk_bf16(v0[2], v0[3]); w.z = cvt_pk_bf16(v1[0], v1[1]); w.w = cvt_pk_bf16(v1[2], v1[3]);
                    bf16_t* p = blocked ? base + ((size_t)((((row >> 6) * H + (c >> 7)) * 8 + ((c >> 4) & 7)) * 64 + (row & 63))) * 16 + (c & 15)
                                        : base + (size_t)row * 4096 + c;
                    *(u32x4*)p = w; } }
    }
};

template <class Epi, class Sched, bool ALIGN_EPI = false, bool SP2 = false>
__device__ __forceinline__ void gemm_phase(PG8_LAS unsigned char* lds, const Gemm g, const Sched& S, const Epi& E) {
    int tid_o = threadIdx.x; asm volatile("" : "+v"(tid_o));
    const int tid = tid_o, wid = __builtin_amdgcn_readfirstlane(tid >> 6), lane = tid & 63, wr = wid >> 2, wc = wid & 3, fr = lane & 15, fq = lane >> 4;
    const int K = g.K, nt = K / BK;
    unsigned voffA[2], voffB[2];
#pragma unroll
    for (int i = 0; i < 2; ++i) { int R, C; stage_rc(tid * 16 + i * 8192, R, C); const int Rb = Epi::PERM ? ((R & ~31) + perm32(R & 31)) : R;
        voffA[i] = (unsigned)(R * K + C) * 2u; voffB[i] = (unsigned)(Rb * K + C) * 2u; }
    const size_t kstep = (size_t)(BK * 2);
    const size_t hstep = (size_t)HALF * K * 2;
    const size_t tstep = 2 * hstep;
    const unsigned ldsw = (unsigned)wid * 1024u;
    const int aoff = lds_byte(wr * 64 + fr, fq * 8), boff = lds_byte(wc * 32 + fr, fq * 8);
#define PG8_SA(b, h) (((b) * 2 + (h)) * HTB)
#define PG8_SB(b, h) ((4 + (b) * 2 + (h)) * HTB)
#define PG8_STAGE(bufoff, gbase, voff) do { _Pragma("unroll") for (int _i = 0; _i < 2; ++_i) \
        __builtin_amdgcn_global_load_lds((const unsigned*)((const char*)(gbase) + (voff)[_i]), (PG8_LAS unsigned*)(lds + (bufoff) + ldsw + _i * 8192), 16, 0, 0); } while (0)
#define PG8_LDA(dst, b, h) do { _Pragma("unroll") for (int m = 0; m < 4; ++m) _Pragma("unroll") for (int k = 0; k < 2; ++k) dst[m][k] = *(const PG8_LAS bf16x8*)(lds + PG8_SA(b, h) + aoff + m * 2048 + k * 1024); } while (0)
#define PG8_LDB(dst, b, h) do { _Pragma("unroll") for (int n = 0; n < 2; ++n) _Pragma("unroll") for (int k = 0; k < 2; ++k) dst[n][k] = *(const PG8_LAS bf16x8*)(lds + PG8_SB(b, h) + boff + n * 2048 + k * 1024); } while (0)
#define PG8_MMA(ai, bj, At, Bt) do { __builtin_amdgcn_s_setprio(1); _Pragma("unroll") for (int m = 0; m < 4; ++m) _Pragma("unroll") for (int n = 0; n < 2; ++n) _Pragma("unroll") for (int k = 0; k < 2; ++k) \
        acc[ai][bj][m][n] = __builtin_amdgcn_mfma_f32_16x16x32_bf16(Bt[n][k], At[m][k], acc[ai][bj][m][n], 0, 0, 0); __builtin_amdgcn_s_setprio(0); } while (0)
#define PG8_WAIT_V(n) asm volatile("s_waitcnt vmcnt(" #n ")" ::: "memory")
#define PG8_WAIT_L(n) asm volatile("s_waitcnt lgkmcnt(" #n ")" ::: "memory")
#define PG8_BAR __builtin_amdgcn_s_barrier()
#define PG8_SCHED __builtin_amdgcn_sched_barrier(0)
    Unit cur, nxt; int ui = 0;
    if (!S.next(0, cur)) return;
    f32x4 acc[2][2][4][2];
#pragma unroll
    for (int a = 0; a < 2; ++a)
#pragma unroll
        for (int b = 0; b < 2; ++b)
#pragma unroll
            for (int m = 0; m < 4; ++m)
#pragma unroll
                for (int n = 0; n < 2; ++n) acc[a][b][m][n] = (f32x4){0.f, 0.f, 0.f, 0.f};
    bf16x8 At[4][2], B0[2][2], B1[2][2];
    const char* cA = (const char*)g.A + (size_t)cur.pm * tstep; const char* cB = (const char*)g.Bt + (size_t)cur.pn * tstep;
    S.a_ready(cur);
    if constexpr (SP2) {
        PG8_STAGE(PG8_SB(0, 0), cB, voffB); PG8_STAGE(PG8_SB(0, 1), cB + hstep, voffB); PG8_STAGE(PG8_SA(0, 0), cA, voffA); PG8_STAGE(PG8_SA(0, 1), cA + hstep, voffA);
        if (wr == 1) PG8_BAR;
        PG8_WAIT_V(2); PG8_BAR;
        PG8_STAGE(PG8_SB(1, 0), cB + kstep, voffB); PG8_STAGE(PG8_SA(1, 0), cA + kstep, voffA); PG8_STAGE(PG8_SB(1, 1), cB + hstep + kstep, voffB);
        PG8_WAIT_V(6); PG8_BAR;
    } else {
        PG8_STAGE(PG8_SB(0, 0), cB, voffB); PG8_STAGE(PG8_SA(0, 0), cA, voffA); PG8_STAGE(PG8_SB(0, 1), cB + hstep, voffB); PG8_STAGE(PG8_SA(0, 1), cA + hstep, voffA);
        if (wr == 1) PG8_BAR;
        PG8_WAIT_V(4); PG8_BAR;
        PG8_STAGE(PG8_SB(1, 0), cB + kstep, voffB); PG8_STAGE(PG8_SA(1, 0), cA + kstep, voffA); PG8_STAGE(PG8_SB(1, 1), cB + hstep + kstep, voffB);
        PG8_WAIT_V(6); PG8_BAR;
    }
    for (;;) {
        const bool has_next = S.next(ui + 1, nxt);
        const char* nA = has_next ? (const char*)g.A + (size_t)nxt.pm * tstep : cA; const char* nB = has_next ? (const char*)g.Bt + (size_t)nxt.pn * tstep : cB;
        for (int t = 0; t < nt; t += 2) {
            const bool last = (t == nt - 2);
            const char* a1 = cA + (size_t)(t + 1) * kstep;
            const char* a2 = last ? nA : cA + (size_t)(t + 2) * kstep; const char* b2 = last ? nB : cB + (size_t)(t + 2) * kstep;
            const char* a3 = a2 + kstep; const char* b3 = b2 + kstep;
            if (last && has_next) S.a_ready(nxt);
            if constexpr (SP2) {
            PG8_LDB(B0, 0, 0); PG8_LDB(B1, 0, 1); PG8_SCHED; PG8_LDA(At, 0, 0); PG8_STAGE(PG8_SA(1, 1), a1 + hstep, voffA);
            PG8_WAIT_V(8); PG8_WAIT_L(0); PG8_BAR; PG8_MMA(0, 0, At, B0); PG8_MMA(0, 1, At, B1); PG8_BAR; PG8_SCHED;
            PG8_LDA(At, 0, 1); PG8_STAGE(PG8_SB(0, 0), b2, voffB); PG8_STAGE(PG8_SB(0, 1), b2 + hstep, voffB); PG8_STAGE(PG8_SA(0, 0), a2, voffA);
            PG8_WAIT_V(8); PG8_WAIT_L(0); PG8_BAR; PG8_MMA(1, 0, At, B0); PG8_MMA(1, 1, At, B1); PG8_BAR; PG8_SCHED;
            PG8_LDB(B0, 1, 0); PG8_LDB(B1, 1, 1); PG8_SCHED; PG8_LDA(At, 1, 0); PG8_STAGE(PG8_SA(0, 1), a2 + hstep, voffA);
            PG8_WAIT_V(8); PG8_WAIT_L(0); PG8_BAR; PG8_MMA(0, 0, At, B0); PG8_MMA(0, 1, At, B1); PG8_BAR; PG8_SCHED;
            PG8_LDA(At, 1, 1); PG8_STAGE(PG8_SB(1, 0), b3, voffB); PG8_STAGE(PG8_SB(1, 1), b3 + hstep, voffB); PG8_STAGE(PG8_SA(1, 0), a3, voffA);
            PG8_WAIT_V(8); PG8_WAIT_L(0); PG8_BAR; PG8_MMA(1, 0, At, B0); PG8_MMA(1, 1, At, B1); PG8_BAR; PG8_SCHED;
            } else {
            PG8_LDB(B0, 0, 0); PG8_SCHED; PG8_LDA(At, 0, 0); PG8_STAGE(PG8_SA(1, 1), a1 + hstep, voffA);
            PG8_WAIT_L(8); PG8_BAR; PG8_WAIT_L(0); PG8_MMA(0, 0, At, B0); PG8_BAR; PG8_SCHED;
            PG8_LDB(B1, 0, 1); PG8_STAGE(PG8_SB(0, 0), b2, voffB);
            PG8_BAR; PG8_WAIT_L(0); PG8_MMA(0, 1, At, B1); PG8_BAR;
            PG8_LDA(At, 0, 1); PG8_STAGE(PG8_SA(0, 0), a2, voffA);
            PG8_BAR; PG8_WAIT_L(0); PG8_MMA(1, 0, At, B0); PG8_BAR; PG8_SCHED;
            PG8_STAGE(PG8_SB(0, 1), b2 + hstep, voffB);
            PG8_WAIT_V(6); PG8_BAR; PG8_MMA(1, 1, At, B1); PG8_BAR;
            PG8_LDB(B0, 1, 0); PG8_SCHED; PG8_LDA(At, 1, 0); PG8_STAGE(PG8_SA(0, 1), a2 + hstep, voffA);
            PG8_WAIT_L(8); PG8_BAR; PG8_WAIT_L(0); PG8_MMA(0, 0, At, B0); PG8_BAR; PG8_SCHED;
            PG8_LDB(B1, 1, 1); PG8_STAGE(PG8_SB(1, 0), b3, voffB);
            PG8_BAR; PG8_WAIT_L(0); PG8_MMA(0, 1, At, B1); PG8_BAR;
            PG8_LDA(At, 1, 1); PG8_STAGE(PG8_SA(1, 0), a3, voffA);
            PG8_BAR; PG8_WAIT_L(0); PG8_MMA(1, 0, At, B0); PG8_BAR; PG8_SCHED;
            PG8_STAGE(PG8_SB(1, 1), b3 + hstep, voffB);
            PG8_WAIT_V(6); PG8_BAR; PG8_MMA(1, 1, At, B1); PG8_BAR;
            }
        }
        if constexpr (ALIGN_EPI) { if (wr == 0) PG8_BAR; }
        if constexpr (!Epi::AFTER_DRAIN) { E(acc, cur, wr, wc, fr, fq); S.done(cur); }
        if (!has_next) break;
#pragma unroll
        for (int a = 0; a < 2; ++a)
#pragma unroll
            for (int b = 0; b < 2; ++b)
#pragma unroll
                for (int m = 0; m < 4; ++m)
#pragma unroll
                    for (int n = 0; n < 2; ++n) acc[a][b][m][n] = (f32x4){0.f, 0.f, 0.f, 0.f};
        cur = nxt; cA = nA; cB = nB; ++ui;
        if constexpr (ALIGN_EPI) { if (wr == 1) PG8_BAR; }
    }
    PG8_WAIT_V(0);
    if constexpr (!ALIGN_EPI) { if (wr == 0) PG8_BAR; }
    PG8_BAR;
    if constexpr (Epi::AFTER_DRAIN) { E.fused(acc, cur, wr, wc, fr, fq, lds, wid, lane); S.done(cur); }
#undef PG8_SA
#undef PG8_SB
#undef PG8_STAGE
#undef PG8_LDA
#undef PG8_LDB
#undef PG8_MMA
#undef PG8_WAIT_V
#undef PG8_WAIT_L
#undef PG8_BAR
#undef PG8_SCHED
}
}

constexpr int NWAVES = 8;
constexpr int DM = 2048, DFF = 8192, NTOK = 49152, GM = 16384, NGRP = 3, NLAYER = 2, INW = 8224, ZW = 8192;
constexpr int ZC_GQ = 0, ZC_GK = 512, ZC_GV = 1024, ZC_GOG = 2048, ZC_HQ = 3072, ZC_HFF = 4096, ZC_HFB = 5120, ZC_HI = 6144, ZC_HOG = 7168;
constexpr float LN_EPS = 1e-5f, RMS_EPS = 1e-6f, ALPHA = 1.41421356237f, LOG2E = 1.44269504089f;
constexpr int NCHUNK = GM / 64;
constexpr int ST_CHUNK = 524288;
constexpr size_t MiB = 1u << 20;
constexpr size_t WS_CTL = 0, CTL_ZERO_BYTES = 1 * MiB;
constexpr size_t WS_WIN = 2 * MiB, WS_WOUT = 66 * MiB, WS_WUP = 82 * MiB, WS_WDN = 146 * MiB, WS_WGLR = 210 * MiB;
constexpr size_t WS_HB = 212 * MiB;
constexpr size_t WS_Z = 276 * MiB;
constexpr size_t WS_BG = 532 * MiB;
constexpr size_t WS_O = 596 * MiB;
constexpr size_t WS_ST = 660 * MiB;
constexpr size_t WS_TOT = 916 * MiB;
constexpr size_t WS_STS = 920 * MiB;
constexpr size_t WS_TOTS = 984 * MiB;
constexpr size_t WS_END = 985 * MiB;
constexpr int CW_BAR = 4096;
constexpr int RING_BYTES = 131072;
constexpr int LDS_BYTES = 160 * 1024, MISC_OFF = LDS_BYTES - 256;
constexpr int L_B32 = 0, L_KR = 33792, L_QR = 51200, L_QH = 68608, L_V = 86016, L_P = 119808, L_RED = 129024;
constexpr int B32_STR = 528, K_STR = 272, P_STR = 144, KT_STR = 144;
constexpr int NSC = GM / 256;
constexpr int SV_KT = 135168, KTW_BYTES = 2560;

#define GAS __attribute__((address_space(1)))
#define LAS __attribute__((address_space(3)))
typedef unsigned short bf16;
typedef unsigned v4u __attribute__((ext_vector_type(4)));
typedef float f32x4 __attribute__((ext_vector_type(4)));
typedef short bf16x8 __attribute__((ext_vector_type(8)));
typedef GAS unsigned gu32;
typedef GAS unsigned long long gu64;
#define RLX_AGENT __ATOMIC_RELAXED, __HIP_MEMORY_SCOPE_AGENT
#define LDS_WAIT() asm volatile("s_waitcnt lgkmcnt(0)" ::: "memory")
#define VM_WAIT() asm volatile("s_waitcnt vmcnt(0)" ::: "memory")
__device__ __forceinline__ unsigned long long rt() { return __builtin_amdgcn_s_memrealtime(); }
__device__ __forceinline__ unsigned f2bf(float f) { unsigned u = __builtin_bit_cast(unsigned, f); return (u + 0x7fffu + ((u >> 16) & 1u)) >> 16; }
__device__ __forceinline__ unsigned pk2(float lo, float hi) { return f2bf(lo) | (f2bf(hi) << 16); }

#define XB_TMO      128
#define XB_XCNT(j)  (256  + 64 * (j))
#define XB_XSUB(j)  (1280 + 64 * (j))
#define XB_XGEN(j)  (2304 + 64 * (j))
#define XB_TOP      3328
#define XB_TOPGEN   3392
#define XCD_BAR_WORDS 3456
#define XB_SPIN_CAP (1u << 18)

__device__ __forceinline__ unsigned xb_ld(unsigned* p)              { return __hip_atomic_load(p, __ATOMIC_RELAXED, __HIP_MEMORY_SCOPE_AGENT); }
__device__ __forceinline__ unsigned xb_add(unsigned* p, unsigned v) { return __hip_atomic_fetch_add(p, v, __ATOMIC_RELAXED, __HIP_MEMORY_SCOPE_AGENT); }
__device__ __forceinline__ unsigned xb_xcc_id() { return (unsigned)__builtin_amdgcn_s_getreg((3 << 11) | 20) & 0xFu; }
#define XB_SPIN(cond, bar) do { unsigned _sp = 0; while (cond) { __builtin_amdgcn_s_sleep(1); \
    if ((++_sp & 255u) == 0u) { if (xb_ld(&(bar)[XB_TMO])) break; if (_sp > XB_SPIN_CAP) { atomicAdd(&(bar)[XB_TMO], 1u); break; } } } } while (0)

struct XcdBarrier {
    unsigned* bar; unsigned x;
    volatile LAS unsigned* st;
};

__device__ __forceinline__ XcdBarrier xcd_barrier_post(unsigned* bar, volatile LAS unsigned* st) {
    XcdBarrier b; b.bar = bar; b.x = xb_xcc_id(); b.st = st;
    if (threadIdx.x == 0) (void)xb_add(&bar[XB_XCNT(b.x)], 1u);
    return b;
}
__device__ __forceinline__ void xcd_barrier_complete(unsigned* bar, unsigned x, unsigned& nloc, unsigned& nx) {
    const unsigned G = gridDim.x * gridDim.y * gridDim.z;
    unsigned sum, cnt, mine, sp = 0u;
    for (;;) {
        sum = 0u; cnt = 0u; mine = 0u;
#pragma unroll
        for (unsigned j = 0; j < 16; ++j) { const unsigned c = xb_ld(&bar[XB_XCNT(j)]); sum += c; cnt += (c > 0u) ? 1u : 0u; mine = (j == x) ? c : mine; }
        if (sum == G) break;
        __builtin_amdgcn_s_sleep(1);
        if ((++sp & 255u) == 0u) { if (xb_ld(&bar[XB_TMO])) break; if (sp > XB_SPIN_CAP) { atomicAdd(&bar[XB_TMO], 1u); break; } }
    }
    nloc = mine > 0u ? mine : 1u; nx = cnt > 0u ? cnt : 1u;
}

__device__ __forceinline__ void xcd_barrier(const XcdBarrier& b) {
    asm volatile("s_waitcnt vmcnt(0)" ::: "memory");
    __syncthreads();
    if (threadIdx.x == 0) {
        unsigned* bar = b.bar;
        __builtin_amdgcn_s_waitcnt(0);
        unsigned nloc = b.st[0], nx = b.st[1];
        if (nloc == 0u) { xcd_barrier_complete(bar, b.x, nloc, nx); b.st[0] = nloc; b.st[1] = nx; }
        const unsigned old = xb_add(&bar[XB_XSUB(b.x)], 1u);
        const unsigned gen = old / nloc;
        if (old + 1u == (gen + 1u) * nloc) {
            __builtin_amdgcn_fence(__ATOMIC_RELEASE, "agent");
            asm volatile("s_waitcnt vmcnt(0)" ::: "memory");
            const unsigned og = xb_add(&bar[XB_TOP], 1u);
            const unsigned tg = og / nx;
            if (og + 1u == (tg + 1u) * nx) xb_add(&bar[XB_TOPGEN], 1u);
            else XB_SPIN(xb_ld(&bar[XB_TOPGEN]) == tg, bar);
            __builtin_amdgcn_fence(__ATOMIC_ACQUIRE, "agent");
            xb_add(&bar[XB_XGEN(b.x)], 1u);
            asm volatile("s_waitcnt vmcnt(0)" ::: "memory");
        } else {
            XB_SPIN(xb_ld(&bar[XB_XGEN(b.x)]) == gen, bar);
            __builtin_amdgcn_fence(__ATOMIC_ACQUIRE, "agent");
            asm volatile("s_waitcnt vmcnt(0)" ::: "memory");
        }
    }
    __syncthreads();
}

typedef short s16x4 __attribute__((ext_vector_type(4)));
typedef float f32x2 __attribute__((ext_vector_type(2)));
typedef unsigned v2u __attribute__((ext_vector_type(2)));
__device__ __forceinline__ unsigned pkbf(float lo, float hi) { return pg8::cvt_pk_bf16(lo, hi); }
__device__ __forceinline__ float wave_sum(float v) {
#pragma unroll
    for (int o = 1; o < 64; o <<= 1) v += __shfl_xor(v, o);
    return v;
}
template <int CTRL, int RM> __device__ __forceinline__ float dpp_add(float v) {
    return v + __builtin_bit_cast(float, __builtin_amdgcn_update_dpp(0, __builtin_bit_cast(int, v), CTRL, RM, 0xf, true));
}
__device__ __forceinline__ float wave_scan_incl(float v, int) {
    v = dpp_add<0x111, 0xf>(v); v = dpp_add<0x112, 0xf>(v); v = dpp_add<0x114, 0xf>(v); v = dpp_add<0x118, 0xf>(v);
    v = dpp_add<0x142, 0xa>(v); v = dpp_add<0x143, 0xc>(v); return v;
}
#define DPP16(CTL) "v_add_f32_dpp %0, %0, %0 " CTL "\n\t" "v_add_f32_dpp %1, %1, %1 " CTL "\n\t" "v_add_f32_dpp %2, %2, %2 " CTL "\n\t" "v_add_f32_dpp %3, %3, %3 " CTL "\n\t" "v_add_f32_dpp %4, %4, %4 " CTL "\n\t" "v_add_f32_dpp %5, %5, %5 " CTL "\n\t" "v_add_f32_dpp %6, %6, %6 " CTL "\n\t" "v_add_f32_dpp %7, %7, %7 " CTL "\n\t" "v_add_f32_dpp %8, %8, %8 " CTL "\n\t" "v_add_f32_dpp %9, %9, %9 " CTL "\n\t" "v_add_f32_dpp %10, %10, %10 " CTL "\n\t" "v_add_f32_dpp %11, %11, %11 " CTL "\n\t" "v_add_f32_dpp %12, %12, %12 " CTL "\n\t" "v_add_f32_dpp %13, %13, %13 " CTL "\n\t" "v_add_f32_dpp %14, %14, %14 " CTL "\n\t" "v_add_f32_dpp %15, %15, %15 " CTL "\n\t"
__device__ __forceinline__ void wave_scan16(float* v) {
    asm volatile("s_nop 1\n\t"
        DPP16("row_shr:1 row_mask:0xf bank_mask:0xf") DPP16("row_shr:2 row_mask:0xf bank_mask:0xf") DPP16("row_shr:4 row_mask:0xf bank_mask:0xf") DPP16("row_shr:8 row_mask:0xf bank_mask:0xf")
        DPP16("row_bcast:15 row_mask:0xa bank_mask:0xf") DPP16("row_bcast:31 row_mask:0xc bank_mask:0xf") "s_nop 1"
        : "+v"(v[0]), "+v"(v[1]), "+v"(v[2]), "+v"(v[3]), "+v"(v[4]), "+v"(v[5]), "+v"(v[6]), "+v"(v[7]), "+v"(v[8]), "+v"(v[9]), "+v"(v[10]), "+v"(v[11]), "+v"(v[12]), "+v"(v[13]), "+v"(v[14]), "+v"(v[15]));
}
__device__ __forceinline__ void unpack8(const v4u v, float* f) {
    f[0] = __uint_as_float(v.x << 16); f[1] = __uint_as_float(v.x & 0xffff0000u); f[2] = __uint_as_float(v.y << 16); f[3] = __uint_as_float(v.y & 0xffff0000u);
    f[4] = __uint_as_float(v.z << 16); f[5] = __uint_as_float(v.z & 0xffff0000u); f[6] = __uint_as_float(v.w << 16); f[7] = __uint_as_float(v.w & 0xffff0000u);
}
__device__ __forceinline__ v4u pack8(const float* f) { v4u o; o.x = pkbf(f[0], f[1]); o.y = pkbf(f[2], f[3]); o.z = pkbf(f[4], f[5]); o.w = pkbf(f[6], f[7]); return o; }
__device__ __forceinline__ s16x4 lds_tr(LAS const unsigned char* p) { return __builtin_bit_cast(s16x4, __builtin_amdgcn_ds_read_tr16_b64_v4i16((LAS s16x4*)p)); }
__device__ __forceinline__ bf16x8 tr_pair(LAS const unsigned char* p0, LAS const unsigned char* p1) {
    const s16x4 a = lds_tr(p0), b = lds_tr(p1); return __builtin_shufflevector(a, b, 0, 1, 2, 3, 4, 5, 6, 7);
}
__device__ __forceinline__ float fexp2(float x) { return __builtin_amdgcn_exp2f(x); }
__device__ __forceinline__ float frcp(float x) { return __builtin_amdgcn_rcpf(x); }
__device__ __forceinline__ float lane63(float v) { return __builtin_bit_cast(float, __builtin_amdgcn_readlane(__builtin_bit_cast(int, v), 63)); }
__device__ __forceinline__ float flog2(float x) { return __builtin_amdgcn_logf(x); }

constexpr size_t ZB_GQ = (size_t)GM * 4096, ZB_GK = ZB_GQ + (size_t)GM * 512, ZB_HQ = ZB_GK + (size_t)GM * 512, ZB_HFF = ZB_HQ + (size_t)GM * 1024, ZB_HFB = ZB_HFF + (size_t)GM * 1024;
constexpr int ZRW = 4096, ZR_GV = 0, ZR_GOG = 1024, ZR_HI = 2048, ZR_HOG = 3072;
__device__ __forceinline__ size_t blk_off(int chunk, int H, int hh, int w) { return (size_t)((chunk * H + hh) * 8 + w) * 1024; }
struct Ctx {
    const float *x_prompt, *x_sample, *w_in, *w_lr2, *b_lr, *gla_g, *hg_g, *lowb, *w_out, *ln1_g, *ln1_b, *w_up, *w_down, *ln2_g, *ln2_b;
    float* out;
    bf16 *Win_t, *Wout_t, *Wup_t, *Wdn_t, *Wglr_t, *HB, *Z, *O, *ST;
    float *BG, *TOT, *TOTS; bf16 *STS, *MF;
};

__device__ __forceinline__ void transpose_item(const float* W, int N, int kb, int nb, bf16* dst, int K, LAS float* scr, int lane) {
    const int k0 = 64 * kb, n0 = 32 * nb;
#pragma unroll 8
    for (int i = 0; i < 32; ++i) { const int kk = 2 * i + (lane >> 5); scr[kk * 33 + (lane & 31)] = W[(size_t)(k0 + kk) * N + n0 + (lane & 31)]; }
    LDS_WAIT(); asm volatile("" ::: "memory");
    const int c = lane & 7;
#pragma unroll
    for (int j = 0; j < 4; ++j) { const int n = (lane >> 3) + 8 * j; const LAS float* s = scr + (8 * c) * 33 + n;
        v4u o; o.x = pkbf(s[0 * 33], s[1 * 33]); o.y = pkbf(s[2 * 33], s[3 * 33]); o.z = pkbf(s[4 * 33], s[5 * 33]); o.w = pkbf(s[6 * 33], s[7 * 33]);
        *(GAS v4u*)(dst + (size_t)n * K + k0 + 8 * c) = o; }
    LDS_WAIT(); asm volatile("" ::: "memory");
}
__device__ __forceinline__ void prologue_weights(const Ctx& X, LAS unsigned char* lds, int gw, int NGW, int wave, int lane) {
    LAS float* scr = (LAS float*)(lds + wave * 16384);
    constexpr int I_IN = 32 * 257, I_OUT = 32 * 64, I_UP = 32 * 256, I_DN = 128 * 64, I_L = I_IN + I_OUT + I_UP + I_DN;
    for (int it = gw; it < NLAYER * I_L; it += NGW) {
        const int l = it / I_L; int r = it % I_L;
        if (r < I_IN) { const int kb = r / 257, nb = r % 257;
            bf16* dst = (nb < 96) ? X.Win_t + ((size_t)l * ZW + 32 * nb) * DM : (nb == 96) ? X.Wglr_t + (size_t)l * 32 * DM : X.Win_t + ((size_t)l * ZW + 32 * (nb - 1)) * DM;
            transpose_item(X.w_in + (size_t)l * DM * INW, INW, kb, nb, dst, DM, scr, lane); continue; }
        r -= I_IN;
        if (r < I_OUT) { const int kb = r / 64, nb = r % 64; transpose_item(X.w_out + (size_t)l * DM * DM, DM, kb, nb, X.Wout_t + ((size_t)l * DM + 32 * nb) * DM, DM, scr, lane); continue; }
        r -= I_OUT;
        if (r < I_UP) { const int kb = r / 256, nb = r % 256; transpose_item(X.w_up + (size_t)l * DM * DFF, DFF, kb, nb, X.Wup_t + ((size_t)l * DFF + 32 * nb) * DM, DM, scr, lane); continue; }
        r -= I_UP;
        { const int kb = r / 64, nb = r % 64; transpose_item(X.w_down + (size_t)l * DFF * DM, DM, kb, nb, X.Wdn_t + ((size_t)l * DM + 32 * nb) * DFF, DFF, scr, lane); }
    }
}
__device__ __forceinline__ void cvt_group(const float* xg, bf16* HB, int gtid, int NT) {
    for (int i = gtid; i < GM * DM / 8; i += NT) {
        const f32x4 a = ((const GAS f32x4*)xg)[2 * i], b = ((const GAS f32x4*)xg)[2 * i + 1];
        v4u o; o.x = pkbf(a.x, a.y); o.y = pkbf(a.z, a.w); o.z = pkbf(b.x, b.y); o.w = pkbf(b.z, b.w);
        ((GAS v4u*)HB)[i] = o; }
}
template <bool RES_F32, bool OUT_F32>
__device__ __forceinline__ void ln_phase(const void* res, const bf16* mf, const float* gam, const float* bet, float* H, bf16* HB, int gw, int NGW, int lane) {
    for (int m = gw; m < GM; m += NGW) {
        f32x4 v[8]; float s = 0.f;
        const GAS v2u* mr = (const GAS v2u*)(mf + (size_t)m * DM) + lane;
#pragma unroll
        for (int j = 0; j < 8; ++j) { f32x4 r;
            if (RES_F32) r = ((const GAS f32x4*)((const float*)res + (size_t)m * DM) + lane)[64 * j];
            else { const v2u w = ((const GAS v2u*)((const bf16*)res + (size_t)m * DM) + lane)[64 * j];
                r = (f32x4){__uint_as_float(w.x << 16), __uint_as_float(w.x & 0xffff0000u), __uint_as_float(w.y << 16), __uint_as_float(w.y & 0xffff0000u)}; }
            const v2u w = mr[64 * j];
            const f32x4 f = (f32x4){__uint_as_float(w.x << 16), __uint_as_float(w.x & 0xffff0000u), __uint_as_float(w.y << 16), __uint_as_float(w.y & 0xffff0000u)};
            v[j] = r * ALPHA + f; s += (v[j].x + v[j].y) + (v[j].z + v[j].w); }
        const float mean = wave_sum(s) * (1.f / DM); float s2 = 0.f;
#pragma unroll
        for (int j = 0; j < 8; ++j) { v[j] = v[j] - mean; s2 += (v[j].x * v[j].x + v[j].y * v[j].y) + (v[j].z * v[j].z + v[j].w * v[j].w); }
        const float rstd = 1.f / sqrtf(wave_sum(s2) * (1.f / DM) + LN_EPS);
#pragma unroll
        for (int j = 0; j < 8; ++j) { const f32x4 g4 = ((const GAS f32x4*)gam)[lane + 64 * j], b4 = ((const GAS f32x4*)bet)[lane + 64 * j];
            const f32x4 o = v[j] * rstd * g4 + b4;
            if (OUT_F32) ((GAS f32x4*)(H + (size_t)m * DM) + lane)[64 * j] = o;
            else { v2u w; w.x = pkbf(o.x, o.y); w.y = pkbf(o.z, o.w); ((GAS v2u*)(HB + (size_t)m * DM) + lane)[64 * j] = w; } }
    }
}

__device__ __forceinline__ void gate_unit(const Ctx& X, int l, int chunk, LAS unsigned char* lds, int tid, int lane, int wave) {
    const int fr = lane & 15, fq = lane >> 4;
    const bf16* A = X.HB + (size_t)chunk * 64 * DM; const bf16* Bw = X.Wglr_t + (size_t)l * 32 * DM;
    f32x4 acc[4][2];
#pragma unroll
    for (int m = 0; m < 4; ++m)
#pragma unroll
        for (int n = 0; n < 2; ++n) acc[m][n] = (f32x4){0.f, 0.f, 0.f, 0.f};
#pragma unroll 2
    for (int ks = 0; ks < 8; ++ks) { const int k0 = 256 * wave + 32 * ks + 8 * fq;
        bf16x8 a[4], b[2];
#pragma unroll
        for (int m = 0; m < 4; ++m) a[m] = *(const GAS bf16x8*)(A + (size_t)(16 * m + fr) * DM + k0);
#pragma unroll
        for (int n = 0; n < 2; ++n) b[n] = *(const GAS bf16x8*)(Bw + (size_t)(16 * n + fr) * DM + k0);
#pragma unroll
        for (int m = 0; m < 4; ++m)
#pragma unroll
            for (int n = 0; n < 2; ++n) acc[m][n] = __builtin_amdgcn_mfma_f32_16x16x32_bf16(a[m], b[n], acc[m][n], 0, 0, 0); }
    LAS float* part = (LAS float*)lds;
#pragma unroll
    for (int m = 0; m < 4; ++m)
#pragma unroll
        for (int n = 0; n < 2; ++n)
#pragma unroll
            for (int j = 0; j < 4; ++j) part[(wave * 64 + 16 * m + 4 * fq + j) * 33 + 16 * n + fr] = acc[m][n][j];
    __syncthreads();
    LAS float* glr = (LAS float*)(lds + 8 * 64 * 33 * 4);
#pragma unroll
    for (int k = 0; k < 4; ++k) { const int idx = tid + 512 * k, t = idx >> 5, n = idx & 31; float s = 0.f;
#pragma unroll
        for (int w = 0; w < 8; ++w) s += part[(w * 64 + t) * 33 + n];
        glr[t * 36 + n] = s; }
    __syncthreads();
    const int dir = wave >> 2;
    const float* w2 = X.w_lr2 + (size_t)(l * 2 + dir) * 16 * 512; const float* bl = X.b_lr + (size_t)(l * 2 + dir) * 512;
    for (int cb = 0; cb < 2; ++cb) { const int c = 128 * (wave & 3) + 64 * cb + lane;
        float w[16];
#pragma unroll
        for (int r = 0; r < 16; ++r) w[r] = w2[r * 512 + c];
        const float bias = bl[c];
        bf16* bgcol = (bf16*)X.BG + ((size_t)(((chunk * 4 + (c >> 7)) * 8 + ((c & 127) >> 4)) * 2 + dir) * 64) * 16 + (c & 15);
#pragma unroll 4
        for (int tt = 0; tt < 64; ++tt) { const int t = dir ? 63 - tt : tt;
            const LAS f32x4* gr = (const LAS f32x4*)(glr + t * 36 + dir * 16); const f32x4 g0 = gr[0], g1 = gr[1], g2 = gr[2], g3 = gr[3];
            float pre = bias;
            pre += g0.x * w[0] + g0.y * w[1] + g0.z * w[2] + g0.w * w[3]; pre += g1.x * w[4] + g1.y * w[5] + g1.z * w[6] + g1.w * w[7];
            pre += g2.x * w[8] + g2.y * w[9] + g2.z * w[10] + g2.w * w[11]; pre += g3.x * w[12] + g3.y * w[13] + g3.z * w[14] + g3.w * w[15];
            const float gl = (fminf(pre, 0.f) - __logf(1.f + __expf(-fabsf(pre)))) * (LOG2E / 16.f);
            bgcol[(size_t)t * 16] = (bf16)(pkbf(gl, gl) & 0xffffu); } }
    __syncthreads();
}

__device__ __forceinline__ size_t st_slot(int chunk, bool hgt, int h, int dir) { return (size_t)chunk * ST_CHUNK + (hgt ? 262144 + (h * 2 + dir) * 16384 : (h * 2 + dir) * 32768); }

template <bool HGT> struct RawIn { v4u b[2]; v4u k[2]; };
template <> struct RawIn<true> { v4u k[2]; };
template <bool HGT>
__device__ __forceinline__ RawIn<HGT> pass_s_load(const Ctx& X, int chunk, int h, int dir, int lane, int c0) {
    RawIn<HGT> r; const int rt = dir ? 63 - lane : lane, w = c0 >> 4;
    if constexpr (!HGT) { const GAS v4u* bg = (const GAS v4u*)((const bf16*)X.BG + ((size_t)(((chunk * 4 + h) * 8 + w) * 2 + dir) * 64 + rt) * 16);
        r.b[0] = bg[0]; r.b[1] = bg[1];
        const GAS v4u* kp = (const GAS v4u*)(X.Z + ZB_GK + blk_off(chunk, 4, h, w) + rt * 16); r.k[0] = kp[0]; r.k[1] = kp[1];
    } else { const GAS v4u* zp = (const GAS v4u*)(X.Z + (dir ? ZB_HFB : ZB_HFF) + blk_off(chunk, 8, h, w) + rt * 16); r.k[0] = zp[0]; r.k[1] = zp[1]; }
    return r;
}
template <bool HGT, bool STORE>
__device__ __forceinline__ void pass_s_unit(const Ctx& X, int l, int sc, int h, LAS unsigned char* lds, int tid, int lane, int wave) {
    constexpr int DV = HGT ? 128 : 256, VSTR = DV * 2 + 16, NE = DV / 16, PPR = DV / 8, UNR_D = HGT ? 2 : 1, UNR_C = HGT ? 4 : 1;
    const int fr = lane & 15, fq = lane >> 4, qq = fr >> 2, p4 = fr & 3, c0 = 16 * wave;
    RawIn<HGT> cur = pass_s_load<HGT>(X, sc * 4, h, 0, lane, c0);
    RawIn<HGT> rq[HGT ? 4 : 1];
    { const int vcol = HGT ? ZR_HI + h * 128 : ZR_GV + h * 256;
#pragma unroll 4
      for (int k = 0; k < 256 * PPR / 512; ++k) { const int idx = tid + 512 * k, row = idx / PPR, pc = idx % PPR;
        const v4u v = *(const GAS v4u*)(X.Z + (size_t)(sc * 256 + row) * ZRW + vcol + pc * 8);
        *(LAS v4u*)(lds + row * VSTR + pc * 16) = v; } }
    __syncthreads();
    LAS unsigned char* kt = lds + SV_KT + wave * KTW_BYTES;
    for (int dir = 0; dir < 2; ++dir) {
        const int hd = HGT ? 8 + h * 2 + dir : h * 2 + dir;
        if constexpr (HGT) {
#pragma unroll
            for (int q4 = 0; q4 < 4; ++q4) rq[q4] = pass_s_load<HGT>(X, sc * 4 + (dir ? 3 - q4 : q4), h, dir, lane, c0); }
        float lbv[16];
        if (HGT) {
#pragma unroll
            for (int i = 0; i < 16; ++i) lbv[i] = 0.f;
            if (l != 0) { const float* lp = X.lowb + (size_t)dir * 2 * 1024 + h * 128 + c0;
#pragma unroll
                for (int i = 0; i < 16; ++i) lbv[i] = frcp(1.f + __expf(lp[i] - lp[1024 + i])); } }
        f32x4 acc[NE];
        if (STORE) { const bf16* sin = X.STS + st_slot(sc, HGT, h, dir);
#pragma unroll
            for (int et = 0; et < NE; ++et) { const v2u w = *(const GAS v2u*)(sin + (size_t)((et * 4 + (wave >> 1)) * 64 + fr + 16 * (2 * (wave & 1) + (fq >> 1))) * 8 + 4 * (fq & 1));
                acc[et] = (f32x4){__uint_as_float(w.x << 16), __uint_as_float(w.x & 0xffff0000u), __uint_as_float(w.y << 16), __uint_as_float(w.y & 0xffff0000u)}; }
        } else {
#pragma unroll
            for (int et = 0; et < NE; ++et) acc[et] = (f32x4){0.f, 0.f, 0.f, 0.f}; }
        float run[16];
#pragma unroll
        for (int i = 0; i < 16; ++i) run[i] = 0.f;
#pragma unroll UNR_C
        for (int cc = 0; cc < 4; ++cc) { const int ci = dir ? 3 - cc : cc, chunk = sc * 4 + ci;
            RawIn<HGT> nxt = cur;
            if constexpr (HGT) cur = rq[cc];
            else { if (cc < 3) nxt = pass_s_load<HGT>(X, sc * 4 + (dir ? 2 - cc : cc + 1), h, dir, lane, c0);
                   else if (dir == 0) nxt = pass_s_load<HGT>(X, sc * 4 + 3, h, 1, lane, c0); }
            float bc[16], kr[16];
            if constexpr (!HGT) {
                unpack8(cur.b[0], bc); unpack8(cur.b[1], bc + 8); wave_scan16(bc);
                unpack8(cur.k[0], kr); unpack8(cur.k[1], kr + 8);
            } else {
                float zf[16]; unpack8(cur.k[0], zf); unpack8(cur.k[1], zf + 8);
#pragma unroll
                for (int i = 0; i < 16; ++i) {
                    const float z = __builtin_amdgcn_fmed3f(zf[i], -60.f, 60.f), e = fexp2(z * -LOG2E), sig = frcp(1.f + e), oml = 1.f - lbv[i];
                    kr[i] = oml - oml * sig;
                    bc[i] = flog2(lbv[i] + oml * sig); }
                wave_scan16(bc);
            }
            if (STORE) { bf16* slot = X.ST + st_slot(chunk, HGT, h, dir);
#pragma unroll
                for (int et = 0; et < NE; ++et) { v2u w; w.x = pkbf(acc[et][0], acc[et][1]); w.y = pkbf(acc[et][2], acc[et][3]);
                    *(GAS v2u*)(slot + (size_t)((et * 4 + (wave >> 1)) * 64 + fr + 16 * (2 * (wave & 1) + (fq >> 1))) * 8 + 4 * (fq & 1)) = w; }
                if (cc == 3) { cur = nxt; break; } }
            float kh[16];
#pragma unroll
            for (int i = 0; i < 16; ++i) { const float bl = lane63(bc[i]); kh[i] = kr[i] * fexp2(bl - bc[i]); run[i] += bl; }
            { const v4u k0 = pack8(kh), k1 = pack8(kh + 8); const unsigned kw[8] = {k0.x, k0.y, k0.z, k0.w, k1.x, k1.y, k1.z, k1.w};
#pragma unroll
              for (int i = 0; i < 16; ++i) *(LAS unsigned short*)(kt + i * KT_STR + lane * 2) = (unsigned short)((i & 1) ? (kw[i >> 1] >> 16) : (kw[i >> 1] & 0xffffu)); }
            if (lane == 63) {
#pragma unroll
                for (int i = 0; i < 4; ++i) ((LAS f32x4*)(kt + 2304))[i] = (f32x4){bc[4 * i], bc[4 * i + 1], bc[4 * i + 2], bc[4 * i + 3]}; }
            asm volatile("s_waitcnt lgkmcnt(0)" ::: "memory");
            const f32x4 dl = *(const LAS f32x4*)(kt + 2304 + 16 * fq);
            const f32x4 dec = (f32x4){fexp2(dl.x), fexp2(dl.y), fexp2(dl.z), fexp2(dl.w)};
            bf16x8 afr[2];
#pragma unroll
            for (int ks = 0; ks < 2; ++ks) afr[ks] = *(const LAS bf16x8*)(kt + fr * KT_STR + (32 * ks + 8 * fq) * 2);
#pragma unroll
            for (int et = 0; et < NE; ++et) acc[et] = acc[et] * dec;
            { constexpr int NB = 2 * NE / 4;
              LAS const unsigned char* vb[2][2];
#pragma unroll
              for (int ks = 0; ks < 2; ++ks) { const int r0 = 32 * ks + 8 * fq + qq, r1 = r0 + 4;
                  vb[ks][0] = lds + (ci * 64 + (dir ? 63 - r0 : r0)) * VSTR + 8 * p4; vb[ks][1] = lds + (ci * 64 + (dir ? 63 - r1 : r1)) * VSTR + 8 * p4; }
              bf16x8 bb[2][4];
#pragma unroll
              for (int j = 0; j < 4; ++j) bb[0][j] = tr_pair(vb[0][0] + 32 * j, vb[0][1] + 32 * j);
#pragma unroll
              for (int b = 0; b < NB; ++b) {
                  if (b + 1 < NB) { const int ks1 = (b + 1) / (NE / 4), e1 = 4 * ((b + 1) % (NE / 4));
#pragma unroll
                      for (int j = 0; j < 4; ++j) bb[(b + 1) & 1][j] = tr_pair(vb[ks1][0] + 32 * (e1 + j), vb[ks1][1] + 32 * (e1 + j)); }
                  const int ks0 = b / (NE / 4), e0 = 4 * (b % (NE / 4));
#pragma unroll
                  for (int j = 0; j < 4; ++j) acc[e0 + j] = __builtin_amdgcn_mfma_f32_16x16x32_bf16(afr[ks0], bb[b & 1][j], acc[e0 + j], 0, 0, 0);
                  __builtin_amdgcn_sched_group_barrier(0x100, 8, 0); __builtin_amdgcn_sched_group_barrier(0x008, 4, 0); } }
            asm volatile("s_waitcnt lgkmcnt(0)" ::: "memory");
            cur = nxt;
        }
        if (!STORE) { bf16* sout = X.STS + st_slot(sc, HGT, h, dir);
#pragma unroll
            for (int et = 0; et < NE; ++et) { v2u w; w.x = pkbf(acc[et][0], acc[et][1]); w.y = pkbf(acc[et][2], acc[et][3]);
                *(GAS v2u*)(sout + (size_t)((et * 4 + (wave >> 1)) * 64 + fr + 16 * (2 * (wave & 1) + (fq >> 1))) * 8 + 4 * (fq & 1)) = w; }
            if (lane == 0) { float* tp = X.TOTS + ((size_t)sc * 24 + hd) * 128 + c0;
#pragma unroll
                for (int i = 0; i < 4; ++i) ((GAS f32x4*)tp)[i] = (f32x4){run[4 * i], run[4 * i + 1], run[4 * i + 2], run[4 * i + 3]}; } }
    }
    __syncthreads();
}
__device__ __forceinline__ void pass_b_super(const Ctx& X, int g, int gtid, int NT) {
    const int ns = (g == 0) ? 1 : 2, nc = NSC / ns;
    for (int v = gtid; v < ns * (ST_CHUNK / 8); v += NT) {
        const int s = v / (ST_CHUNK / 8), idx = (v % (ST_CHUNK / 8)) * 8;
        const int hd = idx < 262144 ? idx / 32768 : 8 + (idx - 262144) / 16384, db = hd & 1;
        const int d0 = 32 * ((idx >> 9) & 3) + 8 * ((idx >> 7) & 3);
        float S[8];
#pragma unroll
        for (int i = 0; i < 8; ++i) S[i] = 0.f;
        for (int cc = 0; cc < nc; cc += 8) {
            v4u x[8]; f32x4 t0[8], t1[8];
#pragma unroll
            for (int u = 0; u < 8; ++u) { const int c = s * nc + (db ? nc - 1 - (cc + u) : cc + u);
                x[u] = *(const GAS v4u*)(X.STS + (size_t)c * ST_CHUNK + idx);
                const GAS f32x4* tp = (const GAS f32x4*)(X.TOTS + ((size_t)c * 24 + hd) * 128 + d0); t0[u] = tp[0]; t1[u] = tp[1]; }
#pragma unroll
            for (int u = 0; u < 8; ++u) { const int c = s * nc + (db ? nc - 1 - (cc + u) : cc + u);
                *(GAS v4u*)(X.STS + (size_t)c * ST_CHUNK + idx) = pack8(S);
                float dx[8]; unpack8(x[u], dx);
                const float dec[8] = {fexp2(t0[u].x), fexp2(t0[u].y), fexp2(t0[u].z), fexp2(t0[u].w), fexp2(t1[u].x), fexp2(t1[u].y), fexp2(t1[u].z), fexp2(t1[u].w)};
#pragma unroll
                for (int i = 0; i < 8; ++i) S[i] = dec[i] * S[i] + dx[i]; }
        }
    }
}

constexpr int C2_DIR = 63488, C2_QD = 0, C2_KD = 17408, C2_QH = 34816, C2_P = 52224, C2_BT = 61440, C2_V = 126976, C2_RED = 160768;
template <bool HGT>
__device__ __forceinline__ void c2_stage(const Ctx& X, int l, int chunk, int h, int dir, LAS unsigned char* ld, int lane, int wave) {
    const int r = lane, rt = dir ? 63 - r : r, c0 = 16 * wave;
    float bc[16], kr[16], qv[16];
    if (!HGT) {
        const GAS v4u* bg = (const GAS v4u*)((const bf16*)X.BG + ((size_t)(((chunk * 4 + h) * 8 + wave) * 2 + dir) * 64 + rt) * 16);
        unpack8(bg[0], bc); unpack8(bg[1], bc + 8); wave_scan16(bc);
        const GAS v4u* kp = (const GAS v4u*)(X.Z + ZB_GK + blk_off(chunk, 4, h, wave) + rt * 16); unpack8(kp[0], kr); unpack8(kp[1], kr + 8);
        const GAS v4u* qp = (const GAS v4u*)(X.Z + ZB_GQ + blk_off(chunk, 4, h, wave) + rt * 16); unpack8(qp[0], qv); unpack8(qp[1], qv + 8);
#pragma unroll
        for (int i = 0; i < 16; ++i) qv[i] *= 0.08838834764831845f;
    } else {
        float zf[16];
        const GAS v4u* zp = (const GAS v4u*)(X.Z + (dir ? ZB_HFB : ZB_HFF) + blk_off(chunk, 8, h, wave) + rt * 16); unpack8(zp[0], zf); unpack8(zp[1], zf + 8);
        const GAS v4u* qp = (const GAS v4u*)(X.Z + ZB_HQ + blk_off(chunk, 8, h, wave) + rt * 16); unpack8(qp[0], qv); unpack8(qp[1], qv + 8);
        float lbv[16];
        if (l == 0) {
#pragma unroll
            for (int i = 0; i < 16; ++i) lbv[i] = 0.f;
        } else { const float* lp = X.lowb + (size_t)dir * 2 * 1024 + h * 128 + c0;
#pragma unroll
            for (int i = 0; i < 16; ++i) lbv[i] = frcp(1.f + __expf(lp[i] - lp[1024 + i])); }
#pragma unroll
        for (int i = 0; i < 16; ++i) {
            const float z = __builtin_amdgcn_fmed3f(zf[i], -60.f, 60.f), e = fexp2(z * -LOG2E), sig = frcp(1.f + e), oml = 1.f - lbv[i];
            kr[i] = oml - oml * sig;
            bc[i] = flog2(lbv[i] + oml * sig); }
        wave_scan16(bc);
    }
    float qd[16], kd[16], qh[16];
#pragma unroll
    for (int i = 0; i < 16; ++i) {
        const float beta = __builtin_bit_cast(float, __builtin_amdgcn_update_dpp(0, __builtin_bit_cast(int, bc[i]), 0x142, 0xe, 0xf, false));
        qd[i] = qv[i] * fexp2(bc[i] - beta); kd[i] = kr[i] * fexp2(__builtin_amdgcn_fmed3f(beta - bc[i], 0.f, 80.f)); qh[i] = qv[i] * fexp2(bc[i]); }
    LAS unsigned char* p = ld + r * K_STR + c0 * 2;
    ((LAS v4u*)(p + C2_QD))[0] = pack8(qd); ((LAS v4u*)(p + C2_QD))[1] = pack8(qd + 8);
    ((LAS v4u*)(p + C2_KD))[0] = pack8(kd); ((LAS v4u*)(p + C2_KD))[1] = pack8(kd + 8);
    ((LAS v4u*)(p + C2_QH))[0] = pack8(qh); ((LAS v4u*)(p + C2_QH))[1] = pack8(qh + 8);
    if ((lane & 15) == 15) { LAS f32x4* bt = (LAS f32x4*)(ld + C2_BT + (((lane >> 4) + 1) & 3) * 512 + c0 * 4);
        const bool z = lane == 63;
#pragma unroll
        for (int i = 0; i < 4; ++i) bt[i] = z ? (f32x4){0.f, 0.f, 0.f, 0.f} : (f32x4){bc[4 * i], bc[4 * i + 1], bc[4 * i + 2], bc[4 * i + 3]}; }
}
template <bool HGT>
__device__ __forceinline__ void pass_c2_unit(const Ctx& X, int l, int chunk, int h, LAS unsigned char* lds, int tid, int lane, int wave) {
    constexpr int DV = HGT ? 128 : 256, VSTR = DV * 2 + 16, NET = DV / 128, PPR = DV / 8;
    const int fr = lane & 15, fq = lane >> 4, qq = fr >> 2, p4 = fr & 3;
    { const int vcol = HGT ? ZR_HI + h * 128 : ZR_GV + h * 256;
#pragma unroll
      for (int k = 0; k < 64 * PPR / 512; ++k) { const int idx = tid + 512 * k, row = idx / PPR, pc = idx % PPR;
        const v4u v = *(const GAS v4u*)(X.Z + (size_t)(chunk * 64 + row) * ZRW + vcol + pc * 8);
        *(LAS v4u*)(lds + C2_V + row * VSTR + pc * 16) = v; } }
    c2_stage<HGT>(X, l, chunk, h, 0, lds, lane, wave);
    c2_stage<HGT>(X, l, chunk, h, 1, lds + C2_DIR, lane, wave);
    bf16x8 sfr[2][NET][4];
#pragma unroll
    for (int dir = 0; dir < 2; ++dir) { const bf16* slot = X.ST + st_slot(chunk, HGT, h, dir);
#pragma unroll
        for (int et = 0; et < NET; ++et)
#pragma unroll
            for (int ks = 0; ks < 4; ++ks) sfr[dir][et][ks] = *(const GAS bf16x8*)(slot + (size_t)(((wave * NET + et) * 4 + ks) * 64 + lane) * 8); }
    __syncthreads();
    { const int a = wave & 3; LAS unsigned char* ld = lds + (wave >> 2) * C2_DIR;
      const unsigned lst = (a == 0) ? 0xff002010u : (a == 1) ? 0xff113021u : (a == 2) ? 0xffff2231u : 0xffff3332u;
      const unsigned zls = (a == 0) ? 0xffff0201u : (a == 1) ? 0xffff1203u : (a == 2) ? 0xffffff13u : 0xffffff23u;
      for (int t = 0; t < 3; ++t) { const unsigned code = (lst >> (8 * t)) & 0xffu; if (code == 0xffu) break;
          const int I = (int)(code >> 4), J = (int)(code & 15u);
          f32x4 sc = (f32x4){0.f, 0.f, 0.f, 0.f};
#pragma unroll
          for (int ks = 0; ks < 4; ++ks) { const int dc = 32 * ks + 8 * fq;
              v4u ka = *(const LAS v4u*)(ld + C2_KD + (16 * J + fr) * K_STR + dc * 2);
              const bf16x8 qb = *(const LAS bf16x8*)(ld + C2_QD + (16 * I + fr) * K_STR + dc * 2);
              if (J < I) { const LAS f32x4* bi = (const LAS f32x4*)(ld + C2_BT + I * 512 + dc * 4); const LAS f32x4* bj = (const LAS f32x4*)(ld + C2_BT + J * 512 + dc * 4);
                  const f32x4 d0 = bi[0] - bj[0], d1 = bi[1] - bj[1]; float kf[8]; unpack8(ka, kf);
                  kf[0] *= fexp2(d0.x); kf[1] *= fexp2(d0.y); kf[2] *= fexp2(d0.z); kf[3] *= fexp2(d0.w); kf[4] *= fexp2(d1.x); kf[5] *= fexp2(d1.y); kf[6] *= fexp2(d1.z); kf[7] *= fexp2(d1.w);
                  ka = pack8(kf); }
              sc = __builtin_amdgcn_mfma_f32_16x16x32_bf16(__builtin_bit_cast(bf16x8, ka), qb, sc, 0, 0, 0); }
          if (J == I) {
#pragma unroll
              for (int u = 0; u < 4; ++u) if (4 * fq + u > fr) sc[u] = 0.f; }
          v2u w; w.x = pkbf(sc[0], sc[1]); w.y = pkbf(sc[2], sc[3]);
          *(LAS v2u*)(ld + C2_P + (16 * I + fr) * P_STR + (16 * J + 4 * fq) * 2) = w; }
      for (int t = 0; t < 2; ++t) { const unsigned code = (zls >> (8 * t)) & 0xffu; if (code == 0xffu) break;
          const int I = (int)(code >> 4), J = (int)(code & 15u);
          *(LAS v2u*)(ld + C2_P + (16 * I + fr) * P_STR + (16 * J + 4 * fq) * 2) = (v2u){0u, 0u}; } }
    __syncthreads();
    f32x4 oacc[NET][4];
#pragma unroll
    for (int et = 0; et < NET; ++et)
#pragma unroll
        for (int it = 0; it < 4; ++it) oacc[et][it] = (f32x4){0.f, 0.f, 0.f, 0.f};
#pragma unroll
    for (int dir = 0; dir < 2; ++dir) { LAS const unsigned char* ld = lds + dir * C2_DIR;
        bf16x8 vfr[NET][2];
#pragma unroll
        for (int ks = 0; ks < 2; ++ks) { const int r0 = 32 * ks + 8 * fq + qq, r1 = r0 + 4, v0 = dir ? 63 - r0 : r0, v1 = dir ? 63 - r1 : r1;
#pragma unroll
            for (int et = 0; et < NET; ++et) { const int col = (16 * (wave * NET + et) + 4 * p4) * 2;
                vfr[et][ks] = tr_pair(lds + C2_V + v0 * VSTR + col, lds + C2_V + v1 * VSTR + col); } }
#pragma unroll
        for (int it = 0; it < 4; ++it) { const int trow = 16 * it + fr, ip = dir ? 63 - trow : trow;
            bf16x8 bo[6];
#pragma unroll
            for (int ks = 0; ks < 4; ++ks) bo[ks] = *(const LAS bf16x8*)(ld + C2_QH + ip * K_STR + (32 * ks + 8 * fq) * 2);
#pragma unroll
            for (int ks = 0; ks < 2; ++ks) bo[4 + ks] = *(const LAS bf16x8*)(ld + C2_P + ip * P_STR + (32 * ks + 8 * fq) * 2);
#pragma unroll
            for (int ks = 0; ks < 4; ++ks)
#pragma unroll
                for (int et = 0; et < NET; ++et) oacc[et][it] = __builtin_amdgcn_mfma_f32_16x16x32_bf16(sfr[dir][et][ks], bo[ks], oacc[et][it], 0, 0, 0);
#pragma unroll
            for (int ks = 0; ks < 2; ++ks)
#pragma unroll
                for (int et = 0; et < NET; ++et) oacc[et][it] = __builtin_amdgcn_mfma_f32_16x16x32_bf16(vfr[et][ks], bo[4 + ks], oacc[et][it], 0, 0, 0); } }
    LAS float* red = (LAS float*)(lds + C2_RED);
#pragma unroll
    for (int it = 0; it < 4; ++it) { float sq = 0.f;
#pragma unroll
        for (int et = 0; et < NET; ++et) { const f32x4 o = oacc[et][it]; sq += (o.x * o.x + o.y * o.y) + (o.z * o.z + o.w * o.w); }
        sq += __shfl_xor(sq, 16); sq += __shfl_xor(sq, 32);
        if (fq == 0) red[wave * 64 + 16 * it + fr] = sq; }
    __syncthreads();
    const float* ng = (HGT ? X.hg_g + (size_t)l * 128 : X.gla_g + (size_t)l * 256);
    const int ogcol = HGT ? ZR_HOG + h * 128 : ZR_GOG + h * 256, ocol = HGT ? 1024 + h * 128 : h * 256;
#pragma unroll
    for (int it = 0; it < 4; ++it) { float tot = 0.f;
#pragma unroll
        for (int w = 0; w < 8; ++w) tot += red[w * 64 + 16 * it + fr];
        const float rstd = __builtin_amdgcn_rsqf(tot * (1.f / DV) + RMS_EPS);
        const int tok = chunk * 64 + 16 * it + fr;
#pragma unroll
        for (int et = 0; et < NET; ++et) { const int e0 = 16 * (wave * NET + et) + 4 * fq;
            const v2u ogp = *(const GAS v2u*)(X.Z + (size_t)tok * ZRW + ogcol + e0);
            const float og[4] = {__uint_as_float(ogp.x << 16), __uint_as_float(ogp.x & 0xffff0000u), __uint_as_float(ogp.y << 16), __uint_as_float(ogp.y & 0xffff0000u)};
            const f32x4 g4 = *(const GAS f32x4*)(ng + e0); float rr[4];
#pragma unroll
            for (int u = 0; u < 4; ++u) { const float z = og[u]; rr[u] = oacc[et][it][u] * rstd * g4[u] * (z * frcp(1.f + fexp2(z * -LOG2E))); }
            v2u w; w.x = pkbf(rr[0], rr[1]); w.y = pkbf(rr[2], rr[3]);
            *(GAS v2u*)(X.O + (size_t)tok * DM + ocol + e0) = w; } }
}

struct Args { const float* in[15]; float* out; unsigned char* ws; int mode, pad; };
#define PHASE_IDS() int tid = threadIdx.x; asm volatile("" : "+v"(tid)); const int lane = tid & 63, wave = __builtin_amdgcn_readfirstlane(tid >> 6); \
    const int gw = bx * NWAVES + wave, NGW = G * NWAVES, gtid = bx * (NWAVES * 64) + tid, NT = G * NWAVES * 64; (void)lane; (void)wave; (void)gw; (void)NGW; (void)gtid; (void)NT
__device__ __forceinline__ Ctx make_ctx(const Args& args) {
    Ctx X; unsigned char* ws = args.ws;
    X.x_prompt = args.in[0]; X.x_sample = args.in[1]; X.w_in = args.in[2]; X.w_lr2 = args.in[3]; X.b_lr = args.in[4]; X.gla_g = args.in[5]; X.hg_g = args.in[6]; X.lowb = args.in[7];
    X.w_out = args.in[8]; X.ln1_g = args.in[9]; X.ln1_b = args.in[10]; X.w_up = args.in[11]; X.w_down = args.in[12]; X.ln2_g = args.in[13]; X.ln2_b = args.in[14]; X.out = args.out;
    X.Win_t = (bf16*)(ws + WS_WIN); X.Wout_t = (bf16*)(ws + WS_WOUT); X.Wup_t = (bf16*)(ws + WS_WUP); X.Wdn_t = (bf16*)(ws + WS_WDN); X.Wglr_t = (bf16*)(ws + WS_WGLR);
    X.HB = (bf16*)(ws + WS_HB); X.Z = (bf16*)(ws + WS_Z); X.O = (bf16*)(ws + WS_O); X.ST = (bf16*)(ws + WS_ST);
    X.BG = (float*)(ws + WS_BG); X.MF = (bf16*)(ws + WS_ST); X.TOT = (float*)(ws + WS_TOT); X.TOTS = (float*)(ws + WS_TOTS); X.STS = (bf16*)(ws + WS_STS);
    return X;
}
__global__ void __launch_bounds__(NWAVES * 64, 2) fwd_kernel(Args args) {
    extern __shared__ __attribute__((aligned(16))) unsigned char lds_raw[];
    LAS unsigned char* lds = (LAS unsigned char*)lds_raw;
    const int G = gridDim.x, bx = blockIdx.x;
    volatile LAS unsigned* MISC = (volatile LAS unsigned*)(lds + MISC_OFF);
    if (threadIdx.x < 32) MISC[threadIdx.x] = 0u;
    __syncthreads();
    XcdBarrier bar = xcd_barrier_post((unsigned*)(args.ws + WS_CTL) + CW_BAR, MISC + 8);

    { PHASE_IDS(); const Ctx X = make_ctx(args); prologue_weights(X, lds, gw, NGW, wave, lane); }
    for (int g = 0; g < NGRP; ++g) {
        { PHASE_IDS(); const Ctx X = make_ctx(args); cvt_group((g == 0) ? X.x_prompt : X.x_sample + (size_t)(g - 1) * GM * DM, X.HB, gtid, NT); }
        xcd_barrier(bar);
        for (int l = 0; l < NLAYER; ++l) {
            { PHASE_IDS(); const Ctx X = make_ctx(args); for (int c = bx; c < NCHUNK; c += G) gate_unit(X, l, c, lds, tid, lane, wave); }
            { const Ctx X = make_ctx(args); pg8::Gemm gm{X.HB, X.Win_t + (size_t)l * ZW * DM, GM, ZW, DM}; pg8::StaticOrder S; S.init(GM, ZW, G, bx);
              pg8::EpiZ E{X.Z};
              pg8::gemm_phase<pg8::EpiZ, pg8::StaticOrder, false, true>(lds, gm, S, E); }
            xcd_barrier(bar);
            {
            { PHASE_IDS(); const Ctx X = make_ctx(args);
              for (int u = bx; u < NSC * 12; u += G) { const int sc = u / 12, hh = u % 12;
                if (hh < 4) pass_s_unit<false, false>(X, l, sc, hh, lds, tid, lane, wave); else pass_s_unit<true, false>(X, l, sc, hh - 4, lds, tid, lane, wave); } }
            xcd_barrier(bar);
            { PHASE_IDS(); const Ctx X = make_ctx(args); pass_b_super(X, g, gtid, NT); }
            xcd_barrier(bar);
            for (int u = bx; u < NSC * 12; u += G) { const int sc = u / 12, hh = u % 12;
                { PHASE_IDS(); const Ctx X = make_ctx(args);
                  if (hh < 4) pass_s_unit<false, true>(X, l, sc, hh, lds, tid, lane, wave); else pass_s_unit<true, true>(X, l, sc, hh - 4, lds, tid, lane, wave); }
                asm volatile("s_waitcnt vmcnt(0)" ::: "memory"); __syncthreads();
                { PHASE_IDS(); const Ctx X = make_ctx(args);
                  if (hh < 4) {
#pragma unroll 1
                      for (int ci = 0; ci < 4; ++ci) pass_c2_unit<false>(X, l, sc * 4 + ci, hh, lds, tid, lane, wave);
                  } else {
#pragma unroll 1
                      for (int ci = 0; ci < 4; ++ci) pass_c2_unit<true>(X, l, sc * 4 + ci, hh - 4, lds, tid, lane, wave); } }
                __syncthreads(); }
            xcd_barrier(bar);
            }
            { const Ctx X = make_ctx(args); pg8::Gemm gm{X.O, X.Wout_t + (size_t)l * DM * DM, GM, DM, DM}; pg8::StaticOrder S; S.init(GM, DM, G, bx);
              pg8::EpiBf16<0> E{X.MF, DM};
              pg8::gemm_phase<pg8::EpiBf16<0>, pg8::StaticOrder, false, true>(lds, gm, S, E); }
            xcd_barrier(bar);
            { PHASE_IDS(); const Ctx X = make_ctx(args);
              if (l == 0) ln_phase<true, false>((g == 0) ? X.x_prompt : X.x_sample + (size_t)(g - 1) * GM * DM, X.MF, X.ln1_g, X.ln1_b, nullptr, X.HB, gw, NGW, lane);
              else ln_phase<false, false>(X.HB, X.MF, X.ln1_g + (size_t)l * DM, X.ln1_b + (size_t)l * DM, nullptr, X.HB, gw, NGW, lane); }
            xcd_barrier(bar);
            { const Ctx X = make_ctx(args); pg8::Gemm gm{X.HB, X.Wup_t + (size_t)l * DFF * DM, GM, DFF, DM}; pg8::StaticOrder S; S.init(GM, DFF, G, bx);
              pg8::EpiBf16<1> E{X.Z, DFF};
              pg8::gemm_phase<pg8::EpiBf16<1>, pg8::StaticOrder, false, true>(lds, gm, S, E); }
            xcd_barrier(bar);
            { const Ctx X = make_ctx(args); pg8::Gemm gm{X.Z, X.Wdn_t + (size_t)l * DM * DFF, GM, DM, DFF}; pg8::StaticOrder S; S.init(GM, DM, G, bx);
              pg8::EpiBf16<0> E{X.MF, DM};
              pg8::gemm_phase<pg8::EpiBf16<0>, pg8::StaticOrder, false, true>(lds, gm, S, E); }
            xcd_barrier(bar);
            { PHASE_IDS(); const Ctx X = make_ctx(args);
              if (l == NLAYER - 1) ln_phase<false, true>(X.HB, X.MF, X.ln2_g + (size_t)l * DM, X.ln2_b + (size_t)l * DM, X.out + (size_t)g * GM * DM, nullptr, gw, NGW, lane);
              else ln_phase<false, false>(X.HB, X.MF, X.ln2_g + (size_t)l * DM, X.ln2_b + (size_t)l * DM, nullptr, X.HB, gw, NGW, lane); }
            xcd_barrier(bar);
        }
    }
}

extern "C" void kernel_launch(void* const* d_in, const int* in_sizes, int n_in, void* d_out, int out_size, void* d_ws, size_t ws_size, hipStream_t stream) {
    static int grid = 0;
    if (grid == 0) {
        if (n_in != 15 || out_size != NTOK * DM || ws_size < WS_END) { fprintf(stderr, "kernel_launch: unexpected shapes (n_in %d, out %d, ws %zu)\n", n_in, out_size, ws_size); grid = -1; return; }
        int dev = 0, cus = 0;
        if (hipGetDevice(&dev) != hipSuccess || hipDeviceGetAttribute(&cus, hipDeviceAttributeMultiprocessorCount, dev) != hipSuccess) { grid = -1; return; }
        if (hipFuncSetAttribute((const void*)fwd_kernel, hipFuncAttributeMaxDynamicSharedMemorySize, LDS_BYTES) != hipSuccess) { fprintf(stderr, "kernel_launch: hipFuncSetAttribute failed\n"); grid = -1; return; }
        int per_cu = 0;
        if (hipOccupancyMaxActiveBlocksPerMultiprocessor(&per_cu, (const void*)fwd_kernel, NWAVES * 64, LDS_BYTES) != hipSuccess || per_cu < 1) { fprintf(stderr, "kernel_launch: occupancy query says %d\n", per_cu); }
        (void)hipGetLastError();
        grid = cus;
    }
    if (grid < 0) return;
    if (hipMemsetAsync((char*)d_ws + WS_CTL, 0, CTL_ZERO_BYTES, stream) != hipSuccess) return;
    Args a{};
    for (int i = 0; i < 15; ++i) a.in[i] = (const float*)d_in[i];
    a.out = (float*)d_out; a.ws = (unsigned char*)d_ws; a.mode = KMODE; a.pad = 0;
    hipLaunchKernelGGL(fwd_kernel, dim3(grid), dim3(NWAVES * 64), LDS_BYTES, stream, a);
}
```

```cpp
#include <hip/hip_runtime.h>
#include <cstdio>
#include <cstdint>
#ifndef KMODE
#define KMODE 0
#endif
namespace pg8 {
#define PG8_LAS __attribute__((address_space(3)))
typedef unsigned short bf16_t;
typedef short bf16x8 __attribute__((ext_vector_type(8)));
typedef float f32x4 __attribute__((ext_vector_type(4)));
typedef unsigned u32x4 __attribute__((ext_vector_type(4)));
constexpr int BM = 256, BK = 64, HALF = 128, HTB = HALF * BK * 2  , STAGE_BYTES = 8 * HTB, NXCD = 8, WGM = 4;

__host__ __device__ __forceinline__ int lds_byte(int r, int c) { const int st = (r >> 4) * 2 + (c >> 5), rr = r & 15, cc = c & 31, ob = rr * 64 + cc * 2; return st * 1024 + (ob ^ (((ob >> 9) & 1) << 5)); }
__host__ __device__ __forceinline__ void stage_rc(int b, int& R, int& C) { const int st = b / 1024, sb = b % 1024, swz = sb ^ (((sb >> 9) & 1) << 5); R = (st >> 1) * 16 + swz / 64; C = (st & 1) * 32 + (swz % 64) / 2; }
__host__ __device__ __forceinline__ int perm32(int rho) { const int n = rho >> 4, i = rho & 15; return 8 * (i >> 2) + 4 * n + (i & 3); }

struct Unit { int pm, pn; };
struct Gemm { const bf16_t* A; const bf16_t* Bt; int M, N, K; };

struct StaticOrder {
    int nM, nN, nwg, G, c;
    __host__ __device__ void init(int M, int N, int G_, int c_) { nM = M / BM; nN = N / BM; nwg = nM * nN; G = G_; c = c_; }
    __host__ __device__ bool next(int i, Unit& u) const {
        const long L = (long)i * G + c; if (L >= nwg) return false;
        int wgid = (int)L; { const int q = nwg / NXCD, r = nwg % NXCD, xcd = wgid % NXCD, off = wgid / NXCD; wgid = (xcd < r ? xcd * (q + 1) : r * (q + 1) + (xcd - r) * q) + off; }
        const int nig = WGM * nN, gid = wgid / nig, fm = gid * WGM, gsz = (nM - fm) < WGM ? (nM - fm) : WGM;
        u.pm = fm + ((wgid % nig) % gsz); u.pn = (wgid % nig) / gsz; return true;
    }
    __device__ __forceinline__ void a_ready(const Unit&) const {}
    __device__ __forceinline__ void done(const Unit&) const {}
};
struct ReverseOrder : StaticOrder {
    __host__ __device__ bool next(int i, Unit& u) const { const int rounds = nwg / G; if (i >= rounds) return false; return StaticOrder::next(rounds - 1 - i, u); }
};


__device__ __forceinline__ unsigned cvt_pk_bf16(float lo, float hi) { unsigned r; asm volatile("v_cvt_pk_bf16_f32 %0, %1, %2" : "=v"(r) : "v"(lo), "v"(hi)); return r; }

template <int ACT  > struct EpiBf16 {
    static constexpr bool PERM = true, AFTER_DRAIN = false;
    bf16_t* O; int ldc;
    __device__ __forceinline__ void operator()(const f32x4 (&acc)[2][2][4][2], const Unit& u, int wr, int wc, int fr, int fq) const {
        const int row0 = u.pm * BM + wr * 64 + fr; const int col0 = u.pn * BM + wc * 32 + 8 * fq;
#pragma unroll
        for (int ai = 0; ai < 2; ++ai)
#pragma unroll
            for (int m = 0; m < 4; ++m) { bf16_t* rowp = O + (size_t)(row0 + ai * HALF + m * 16) * ldc + col0;
#pragma unroll
                for (int bj = 0; bj < 2; ++bj) { f32x4 v0 = acc[ai][bj][m][0], v1 = acc[ai][bj][m][1];
                    if (ACT == 1) {
#pragma unroll
                        for (int j = 0; j < 4; ++j) { const float a = fmaxf(v0[j], 0.f), b = fmaxf(v1[j], 0.f); v0[j] = a * a; v1[j] = b * b; } }
                    u32x4 w; w.x = cvt_pk_bf16(v0[0], v0[1]); w.y = cvt_pk_bf16(v0[2], v0[3]); w.z = cvt_pk_bf16(v1[0], v1[1]); w.w = cvt_pk_bf16(v1[2], v1[3]);
                    *(u32x4*)(rowp + bj * HALF) = w; } }
    }
};
struct EpiF32 {
    static constexpr bool PERM = false, AFTER_DRAIN = false;
    float* C; int ldc;
    __device__ __forceinline__ void operator()(const f32x4 (&acc)[2][2][4][2], const Unit& u, int wr, int wc, int fr, int fq) const {
        const int row0 = u.pm * BM + wr * 64 + fr, col0 = u.pn * BM + wc * 32 + 4 * fq;
#pragma unroll
        for (int ai = 0; ai < 2; ++ai)
#pragma unroll
            for (int m = 0; m < 4; ++m) { float* rowp = C + (size_t)(row0 + ai * HALF + m * 16) * ldc + col0;
#pragma unroll
                for (int bj = 0; bj < 2; ++bj)
#pragma unroll
                    for (int n = 0; n < 2; ++n) *(f32x4*)(rowp + bj * HALF + n * 16) = acc[ai][bj][m][n]; }
    }
};

struct EpiZ {
    static constexpr bool PERM = true, AFTER_DRAIN = false;
    bf16_t* Z;
    __device__ __forceinline__ void operator()(const f32x4 (&acc)[2][2][4][2], const Unit& u, int wr, int wc, int fr, int fq) const {
        const int pn = u.pn; const size_t Mr = 16384;
        bool blocked; int H = 4, c0; bf16_t* base;
        if (pn < 2) { blocked = true; H = 4; base = Z + Mr * 4096; c0 = pn * 256; }
        else if (pn < 4) { blocked = true; H = 4; base = Z + Mr * 4096 + Mr * 512; c0 = (pn - 2) * 256; }
        else if (pn < 8) { blocked = false; base = Z; c0 = (pn - 4) * 256; }
        else if (pn < 12) { blocked = false; base = Z; c0 = 1024 + (pn - 8) * 256; }
        else if (pn < 24) { blocked = true; H = 8; base = Z + Mr * 4096 + Mr * 1024 + (size_t)((pn - 12) >> 2) * Mr * 1024; c0 = ((pn - 12) & 3) * 256; }
        else if (pn < 28) { blocked = false; base = Z; c0 = 2048 + (pn - 24) * 256; }
        else { blocked = false; base = Z; c0 = 3072 + (pn - 28) * 256; }
        const int row0 = u.pm * BM + wr * 64 + fr, cl = c0 + wc * 32 + 8 * fq;
#pragma unroll
        for (int ai = 0; ai < 2; ++ai)
#pragma unroll
            for (int m = 0; m < 4; ++m) { const int row = row0 + ai * HALF + m * 16;
#pragma unroll
                for (int bj = 0; bj < 2; ++bj) { const f32x4 v0 = acc[ai][bj][m][0], v1 = acc[ai][bj][m][1]; const int c = cl + bj * HALF;
                    u32x4 w; w.x = cvt_pk_bf16(v0[0], v0[1]); w.y = cvt_pk_bf16(v0[2], v0[3]); w.z = cvt_pk_bf16(v1[0], v1[1]); w.w = cvt_pk_bf16(v1[2], v1[3]);
                    bf16_t* p = blocked ? base + ((size_t)((((row >> 6) * H + (c >> 7)) * 8 + ((c >> 4) & 7)) * 64 + (row & 63))) * 16 + (c & 15)
                                        : base + (size_t)row * 4096 + c;
                    *(u32x4*)p = w; } }
    }
};

template <class Epi, class Sched, bool ALIGN_EPI = false, bool SP2 = false>
__device__ __forceinline__ void gemm_phase(PG8_LAS unsigned char* lds, const Gemm g, const Sched& S, const Epi& E) {
    int tid_o = threadIdx.x; asm volatile("" : "+v"(tid_o));
    const int tid = tid_o, wid = __builtin_amdgcn_readfirstlane(tid >> 6), lane = tid & 63, wr = wid >> 2, wc = wid & 3, fr = lane & 15, fq = lane >> 4;
    const int K = g.K, nt = K / BK;
    unsigned voffA[2], voffB[2];
#pragma unroll
    for (int i = 0; i < 2; ++i) { int R, C; stage_rc(tid * 16 + i * 8192, R, C); const int Rb = Epi::PERM ? ((R & ~31) + perm32(R & 31)) : R;
        voffA[i] = (unsigned)(R * K + C) * 2u; voffB[i] = (unsigned)(Rb * K + C) * 2u; }
    const size_t kstep = (size_t)(BK * 2);
    const size_t hstep = (size_t)HALF * K * 2;
    const size_t tstep = 2 * hstep;
    const unsigned ldsw = (unsigned)wid * 1024u;
    const int aoff = lds_byte(wr * 64 + fr, fq * 8), boff = lds_byte(wc * 32 + fr, fq * 8);
#define PG8_SA(b, h) (((b) * 2 + (h)) * HTB)
#define PG8_SB(b, h) ((4 + (b) * 2 + (h)) * HTB)
#define PG8_STAGE(bufoff, gbase, voff) do { _Pragma("unroll") for (int _i = 0; _i < 2; ++_i) \
        __builtin_amdgcn_global_load_lds((const unsigned*)((const char*)(gbase) + (voff)[_i]), (PG8_LAS unsigned*)(lds + (bufoff) + ldsw + _i * 8192), 16, 0, 0); } while (0)
#define PG8_LDA(dst, b, h) do { _Pragma("unroll") for (int m = 0; m < 4; ++m) _Pragma("unroll") for (int k = 0; k < 2; ++k) dst[m][k] = *(const PG8_LAS bf16x8*)(lds + PG8_SA(b, h) + aoff + m * 2048 + k * 1024); } while (0)
#define PG8_LDB(dst, b, h) do { _Pragma("unroll") for (int n = 0; n < 2; ++n) _Pragma("unroll") for (int k = 0; k < 2; ++k) dst[n][k] = *(const PG8_LAS bf16x8*)(lds + PG8_SB(b, h) + boff + n * 2048 + k * 1024); } while (0)
#define PG8_MMA(ai, bj, At, Bt) do { __builtin_amdgcn_s_setprio(1); _Pragma("unroll") for (int m = 0; m < 4; ++m) _Pragma("unroll") for (int n = 0; n < 2; ++n) _Pragma("unroll") for (int k = 0; k < 2; ++k) \
        acc[ai][bj][m][n] = __builtin_amdgcn_mfma_f32_16x16x32_bf16(Bt[n][k], At[m][k], acc[ai][bj][m][n], 0, 0, 0); __builtin_amdgcn_s_setprio(0); } while (0)
#define PG8_WAIT_V(n) asm volatile("s_waitcnt vmcnt(" #n ")" ::: "memory")
#define PG8_WAIT_L(n) asm volatile("s_waitcnt lgkmcnt(" #n ")" ::: "memory")
#define PG8_BAR __builtin_amdgcn_s_barrier()
#define PG8_SCHED __builtin_amdgcn_sched_barrier(0)
    Unit cur, nxt; int ui = 0;
    if (!S.next(0, cur)) return;
    f32x4 acc[2][2][4][2];
#pragma unroll
    for (int a = 0; a < 2; ++a)
#pragma unroll
        for (int b = 0; b < 2; ++b)
#pragma unroll
            for (int m = 0; m < 4; ++m)
#pragma unroll
                for (int n = 0; n < 2; ++n) acc[a][b][m][n] = (f32x4){0.f, 0.f, 0.f, 0.f};
    bf16x8 At[4][2], B0[2][2], B1[2][2];
    const char* cA = (const char*)g.A + (size_t)cur.pm * tstep; const char* cB = (const char*)g.Bt + (size_t)cur.pn * tstep;
    S.a_ready(cur);
    if constexpr (SP2) {
        PG8_STAGE(PG8_SB(0, 0), cB, voffB); PG8_STAGE(PG8_SB(0, 1), cB + hstep, voffB); PG8_STAGE(PG8_SA(0, 0), cA, voffA); PG8_STAGE(PG8_SA(0, 1), cA + hstep, voffA);
        if (wr == 1) PG8_BAR;
        PG8_WAIT_V(2); PG8_BAR;
        PG8_STAGE(PG8_SB(1, 0), cB + kstep, voffB); PG8_STAGE(PG8_SA(1, 0), cA + kstep, voffA); PG8_STAGE(PG8_SB(1, 1), cB + hstep + kstep, voffB);
        PG8_WAIT_V(6); PG8_BAR;
    } else {
        PG8_STAGE(PG8_SB(0, 0), cB, voffB); PG8_STAGE(PG8_SA(0, 0), cA, voffA); PG8_STAGE(PG8_SB(0, 1), cB + hstep, voffB); PG8_STAGE(PG8_SA(0, 1), cA + hstep, voffA);
        if (wr == 1) PG8_BAR;
        PG8_WAIT_V(4); PG8_BAR;
        PG8_STAGE(PG8_SB(1, 0), cB + kstep, voffB); PG8_STAGE(PG8_SA(1, 0), cA + kstep, voffA); PG8_STAGE(PG8_SB(1, 1), cB + hstep + kstep, voffB);
        PG8_WAIT_V(6); PG8_BAR;
    }
    for (;;) {
        const bool has_next = S.next(ui + 1, nxt);
        const char* nA = has_next ? (const char*)g.A + (size_t)nxt.pm * tstep : cA; const char* nB = has_next ? (const char*)g.Bt + (size_t)nxt.pn * tstep : cB;
        for (int t = 0; t < nt; t += 2) {
            const bool last = (t == nt - 2);
            const char* a1 = cA + (size_t)(t + 1) * kstep;
            const char* a2 = last ? nA : cA + (size_t)(t + 2) * kstep; const char* b2 = last ? nB : cB + (size_t)(t + 2) * kstep;
            const char* a3 = a2 + kstep; const char* b3 = b2 + kstep;
            if (last && has_next) S.a_ready(nxt);
            if constexpr (SP2) {
            PG8_LDB(B0, 0, 0); PG8_LDB(B1, 0, 1); PG8_SCHED; PG8_LDA(At, 0, 0); PG8_STAGE(PG8_SA(1, 1), a1 + hstep, voffA);
            PG8_WAIT_V(8); PG8_WAIT_L(0); PG8_BAR; PG8_MMA(0, 0, At, B0); PG8_MMA(0, 1, At, B1); PG8_BAR; PG8_SCHED;
            PG8_LDA(At, 0, 1); PG8_STAGE(PG8_SB(0, 0), b2, voffB); PG8_STAGE(PG8_SB(0, 1), b2 + hstep, voffB); PG8_STAGE(PG8_SA(0, 0), a2, voffA);
            PG8_WAIT_V(8); PG8_WAIT_L(0); PG8_BAR; PG8_MMA(1, 0, At, B0); PG8_MMA(1, 1, At, B1); PG8_BAR; PG8_SCHED;
            PG8_LDB(B0, 1, 0); PG8_LDB(B1, 1, 1); PG8_SCHED; PG8_LDA(At, 1, 0); PG8_STAGE(PG8_SA(0, 1), a2 + hstep, voffA);
            PG8_WAIT_V(8); PG8_WAIT_L(0); PG8_BAR; PG8_MMA(0, 0, At, B0); PG8_MMA(0, 1, At, B1); PG8_BAR; PG8_SCHED;
            PG8_LDA(At, 1, 1); PG8_STAGE(PG8_SB(1, 0), b3, voffB); PG8_STAGE(PG8_SB(1, 1), b3 + hstep, voffB); PG8_STAGE(PG8_SA(1, 0), a3, voffA);
            PG8_WAIT_V(8); PG8_WAIT_L(0); PG8_BAR; PG8_MMA(1, 0, At, B0); PG8_MMA(1, 1, At, B1); PG8_BAR; PG8_SCHED;
            } else {
            PG8_LDB(B0, 0, 0); PG8_SCHED; PG8_LDA(At, 0, 0); PG8_STAGE(PG8_SA(1, 1), a1 + hstep, voffA);
            PG8_WAIT_L(8); PG8_BAR; PG8_WAIT_L(0); PG8_MMA(0, 0, At, B0); PG8_BAR; PG8_SCHED;
            PG8_LDB(B1, 0, 1); PG8_STAGE(PG8_SB(0, 0), b2, voffB);
            PG8_BAR; PG8_WAIT_L(0); PG8_MMA(0, 1, At, B1); PG8_BAR;
            PG8_LDA(At, 0, 1); PG8_STAGE(PG8_SA(0, 0), a2, voffA);
            PG8_BAR; PG8_WAIT_L(0); PG8_MMA(1, 0, At, B0); PG8_BAR; PG8_SCHED;
            PG8_STAGE(PG8_SB(0, 1), b2 + hstep, voffB);
            PG8_WAIT_V(6); PG8_BAR; PG8_MMA(1, 1, At, B1); PG8_BAR;
            PG8_LDB(B0, 1, 0); PG8_SCHED; PG8_LDA(At, 1, 0); PG8_STAGE(PG8_SA(0, 1), a2 + hstep, voffA);
            PG8_WAIT_L(8); PG8_BAR; PG8_WAIT_L(0); PG8_MMA(0, 0, At, B0); PG8_BAR; PG8_SCHED;
            PG8_LDB(B1, 1, 1); PG8_STAGE(PG8_SB(1, 0), b3, voffB);
            PG8_BAR; PG8_WAIT_L(0); PG8_MMA(0, 1, At, B1); PG8_BAR;
            PG8_LDA(At, 1, 1); PG8_STAGE(PG8_SA(1, 0), a3, voffA);
            PG8_BAR; PG8_WAIT_L(0); PG8_MMA(1, 0, At, B0); PG8_BAR; PG8_SCHED;
            PG8_STAGE(PG8_SB(1, 1), b3 + hstep, voffB);
            PG8_WAIT_V(6); PG8_BAR; PG8_MMA(1, 1, At, B1); PG8_BAR;
            }
        }
        if constexpr (ALIGN_EPI) { if (wr == 0) PG8_BAR; }
        if constexpr (!Epi::AFTER_DRAIN) { E(acc, cur, wr, wc, fr, fq); S.done(cur); }
        if (!has_next) break;
#pragma unroll
        for (int a = 0; a < 2; ++a)
#pragma unroll
            for (int b = 0; b < 2; ++b)
#pragma unroll
                for (int m = 0; m < 4; ++m)
#pragma unroll
                    for (int n = 0; n < 2; ++n) acc[a][b][m][n] = (f32x4){0.f, 0.f, 0.f, 0.f};
        cur = nxt; cA = nA; cB = nB; ++ui;
        if constexpr (ALIGN_EPI) { if (wr == 1) PG8_BAR; }
    }
    PG8_WAIT_V(0);
    if constexpr (!ALIGN_EPI) { if (wr == 0) PG8_BAR; }
    PG8_BAR;
    if constexpr (Epi::AFTER_DRAIN) { E.fused(acc, cur, wr, wc, fr, fq, lds, wid, lane); S.done(cur); }
#undef PG8_SA
#undef PG8_SB
#undef PG8_STAGE
#undef PG8_LDA
#undef PG8_LDB
#undef PG8_MMA
#undef PG8_WAIT_V
#undef PG8_WAIT_L
#undef PG8_BAR
#undef PG8_SCHED
}
}

constexpr int NWAVES = 8;
constexpr int DM = 2048, DFF = 8192, NTOK = 49152, GM = 16384, NGRP = 3, NLAYER = 2, INW = 8224, ZW = 8192;
constexpr int ZC_GQ = 0, ZC_GK = 512, ZC_GV = 1024, ZC_GOG = 2048, ZC_HQ = 3072, ZC_HFF = 4096, ZC_HFB = 5120, ZC_HI = 6144, ZC_HOG = 7168;
constexpr float LN_EPS = 1e-5f, RMS_EPS = 1e-6f, ALPHA = 1.41421356237f, LOG2E = 1.44269504089f;
constexpr int NCHUNK = GM / 64;
constexpr int ST_CHUNK = 524288;
constexpr size_t MiB = 1u << 20;
constexpr size_t WS_CTL = 0, CTL_ZERO_BYTES = 1 * MiB;
constexpr size_t WS_WIN = 2 * MiB, WS_WOUT = 66 * MiB, WS_WUP = 82 * MiB, WS_WDN = 146 * MiB, WS_WGLR = 210 * MiB;
constexpr size_t WS_HB = 212 * MiB;
constexpr size_t WS_Z = 276 * MiB;
constexpr size_t WS_BG = 532 * MiB;
constexpr size_t WS_O = 596 * MiB;
constexpr size_t WS_ST = 660 * MiB;
constexpr size_t WS_TOT = 916 * MiB;
constexpr size_t WS_STS = 920 * MiB;
constexpr size_t WS_TOTS = 984 * MiB;
constexpr size_t WS_END = 985 * MiB;
constexpr int CW_BAR = 4096;
constexpr int RING_BYTES = 131072;
constexpr int LDS_BYTES = 160 * 1024, MISC_OFF = LDS_BYTES - 256;
constexpr int L_B32 = 0, L_KR = 33792, L_QR = 51200, L_QH = 68608, L_V = 86016, L_P = 119808, L_RED = 129024;
constexpr int B32_STR = 528, K_STR = 272, P_STR = 144, KT_STR = 144;
constexpr int NSC = GM / 256;
__host__ __device__ __forceinline__ int sc_order(int s) { return s < 32 ? (s >> 2) * 8 + 4 + (s & 3) : ((s - 32) >> 2) * 8 + (s & 3); }
constexpr int SV_KT = 135168, KTW_BYTES = 2560;

#define GAS __attribute__((address_space(1)))
#define LAS __attribute__((address_space(3)))
typedef unsigned short bf16;
typedef unsigned v4u __attribute__((ext_vector_type(4)));
typedef float f32x4 __attribute__((ext_vector_type(4)));
typedef short bf16x8 __attribute__((ext_vector_type(8)));
typedef GAS unsigned gu32;
typedef GAS unsigned long long gu64;
#define RLX_AGENT __ATOMIC_RELAXED, __HIP_MEMORY_SCOPE_AGENT
#define LDS_WAIT() asm volatile("s_waitcnt lgkmcnt(0)" ::: "memory")
#define VM_WAIT() asm volatile("s_waitcnt vmcnt(0)" ::: "memory")
__device__ __forceinline__ unsigned long long rt() { return __builtin_amdgcn_s_memrealtime(); }
__device__ __forceinline__ unsigned f2bf(float f) { unsigned u = __builtin_bit_cast(unsigned, f); return (u + 0x7fffu + ((u >> 16) & 1u)) >> 16; }
__device__ __forceinline__ unsigned pk2(float lo, float hi) { return f2bf(lo) | (f2bf(hi) << 16); }

#define XB_TMO      128
#define XB_XCNT(j)  (256  + 64 * (j))
#define XB_XSUB(j)  (1280 + 64 * (j))
#define XB_XGEN(j)  (2304 + 64 * (j))
#define XB_TOP      3328
#define XB_TOPGEN   3392
#define XCD_BAR_WORDS 3456
#define XB_SPIN_CAP (1u << 18)

__device__ __forceinline__ unsigned xb_ld(unsigned* p)              { return __hip_atomic_load(p, __ATOMIC_RELAXED, __HIP_MEMORY_SCOPE_AGENT); }
__device__ __forceinline__ unsigned xb_add(unsigned* p, unsigned v) { return __hip_atomic_fetch_add(p, v, __ATOMIC_RELAXED, __HIP_MEMORY_SCOPE_AGENT); }
__device__ __forceinline__ unsigned xb_xcc_id() { return (unsigned)__builtin_amdgcn_s_getreg((3 << 11) | 20) & 0xFu; }
#define XB_SPIN(cond, bar) do { unsigned _sp = 0; while (cond) { __builtin_amdgcn_s_sleep(1); \
    if ((++_sp & 255u) == 0u) { if (xb_ld(&(bar)[XB_TMO])) break; if (_sp > XB_SPIN_CAP) { atomicAdd(&(bar)[XB_TMO], 1u); break; } } } } while (0)

struct XcdBarrier {
    unsigned* bar; unsigned x;
    volatile LAS unsigned* st;
};

__device__ __forceinline__ XcdBarrier xcd_barrier_post(unsigned* bar, volatile LAS unsigned* st) {
    XcdBarrier b; b.bar = bar; b.x = xb_xcc_id(); b.st = st;
    if (threadIdx.x == 0) (void)xb_add(&bar[XB_XCNT(b.x)], 1u);
    return b;
}
__device__ __forceinline__ void xcd_barrier_complete(unsigned* bar, unsigned x, unsigned& nloc, unsigned& nx) {
    const unsigned G = gridDim.x * gridDim.y * gridDim.z;
    unsigned sum, cnt, mine, sp = 0u;
    for (;;) {
        sum = 0u; cnt = 0u; mine = 0u;
#pragma unroll
        for (unsigned j = 0; j < 16; ++j) { const unsigned c = xb_ld(&bar[XB_XCNT(j)]); sum += c; cnt += (c > 0u) ? 1u : 0u; mine = (j == x) ? c : mine; }
        if (sum == G) break;
        __builtin_amdgcn_s_sleep(1);
        if ((++sp & 255u) == 0u) { if (xb_ld(&bar[XB_TMO])) break; if (sp > XB_SPIN_CAP) { atomicAdd(&bar[XB_TMO], 1u); break; } }
    }
    nloc = mine > 0u ? mine : 1u; nx = cnt > 0u ? cnt : 1u;
}

__device__ __forceinline__ void xcd_barrier(const XcdBarrier& b) {
    asm volatile("s_waitcnt vmcnt(0)" ::: "memory");
    __syncthreads();
    if (threadIdx.x == 0) {
        unsigned* bar = b.bar;
        __builtin_amdgcn_s_waitcnt(0);
        unsigned nloc = b.st[0], nx = b.st[1];
        if (nloc == 0u) { xcd_barrier_complete(bar, b.x, nloc, nx); b.st[0] = nloc; b.st[1] = nx; }
        const unsigned old = xb_add(&bar[XB_XSUB(b.x)], 1u);
        const unsigned gen = old / nloc;
        if (old + 1u == (gen + 1u) * nloc) {
            __builtin_amdgcn_fence(__ATOMIC_RELEASE, "agent");
            asm volatile("s_waitcnt vmcnt(0)" ::: "memory");
            const unsigned og = xb_add(&bar[XB_TOP], 1u);
            const unsigned tg = og / nx;
            if (og + 1u == (tg + 1u) * nx) xb_add(&bar[XB_TOPGEN], 1u);
            else XB_SPIN(xb_ld(&bar[XB_TOPGEN]) == tg, bar);
            __builtin_amdgcn_fence(__ATOMIC_ACQUIRE, "agent");
            xb_add(&bar[XB_XGEN(b.x)], 1u);
            asm volatile("s_waitcnt vmcnt(0)" ::: "memory");
        } else {
            XB_SPIN(xb_ld(&bar[XB_XGEN(b.x)]) == gen, bar);
            __builtin_amdgcn_fence(__ATOMIC_ACQUIRE, "agent");
            asm volatile("s_waitcnt vmcnt(0)" ::: "memory");
        }
    }
    __syncthreads();
}

typedef short s16x4 __attribute__((ext_vector_type(4)));
typedef float f32x2 __attribute__((ext_vector_type(2)));
typedef unsigned v2u __attribute__((ext_vector_type(2)));
__device__ __forceinline__ unsigned pkbf(float lo, float hi) { return pg8::cvt_pk_bf16(lo, hi); }
__device__ __forceinline__ float wave_sum(float v) {
#pragma unroll
    for (int o = 1; o < 64; o <<= 1) v += __shfl_xor(v, o);
    return v;
}
template <int CTRL, int RM> __device__ __forceinline__ float dpp_add(float v) {
    return v + __builtin_bit_cast(float, __builtin_amdgcn_update_dpp(0, __builtin_bit_cast(int, v), CTRL, RM, 0xf, true));
}
__device__ __forceinline__ float wave_scan_incl(float v, int) {
    v = dpp_add<0x111, 0xf>(v); v = dpp_add<0x112, 0xf>(v); v = dpp_add<0x114, 0xf>(v); v = dpp_add<0x118, 0xf>(v);
    v = dpp_add<0x142, 0xa>(v); v = dpp_add<0x143, 0xc>(v); return v;
}
#define DPP16(CTL) "v_add_f32_dpp %0, %0, %0 " CTL "\n\t" "v_add_f32_dpp %1, %1, %1 " CTL "\n\t" "v_add_f32_dpp %2, %2, %2 " CTL "\n\t" "v_add_f32_dpp %3, %3, %3 " CTL "\n\t" "v_add_f32_dpp %4, %4, %4 " CTL "\n\t" "v_add_f32_dpp %5, %5, %5 " CTL "\n\t" "v_add_f32_dpp %6, %6, %6 " CTL "\n\t" "v_add_f32_dpp %7, %7, %7 " CTL "\n\t" "v_add_f32_dpp %8, %8, %8 " CTL "\n\t" "v_add_f32_dpp %9, %9, %9 " CTL "\n\t" "v_add_f32_dpp %10, %10, %10 " CTL "\n\t" "v_add_f32_dpp %11, %11, %11 " CTL "\n\t" "v_add_f32_dpp %12, %12, %12 " CTL "\n\t" "v_add_f32_dpp %13, %13, %13 " CTL "\n\t" "v_add_f32_dpp %14, %14, %14 " CTL "\n\t" "v_add_f32_dpp %15, %15, %15 " CTL "\n\t"
__device__ __forceinline__ void wave_scan16(float* v) {
    asm volatile("s_nop 1\n\t"
        DPP16("row_shr:1 row_mask:0xf bank_mask:0xf") DPP16("row_shr:2 row_mask:0xf bank_mask:0xf") DPP16("row_shr:4 row_mask:0xf bank_mask:0xf") DPP16("row_shr:8 row_mask:0xf bank_mask:0xf")
        DPP16("row_bcast:15 row_mask:0xa bank_mask:0xf") DPP16("row_bcast:31 row_mask:0xc bank_mask:0xf") "s_nop 1"
        : "+v"(v[0]), "+v"(v[1]), "+v"(v[2]), "+v"(v[3]), "+v"(v[4]), "+v"(v[5]), "+v"(v[6]), "+v"(v[7]), "+v"(v[8]), "+v"(v[9]), "+v"(v[10]), "+v"(v[11]), "+v"(v[12]), "+v"(v[13]), "+v"(v[14]), "+v"(v[15]));
}
__device__ __forceinline__ void unpack8(const v4u v, float* f) {
    f[0] = __uint_as_float(v.x << 16); f[1] = __uint_as_float(v.x & 0xffff0000u); f[2] = __uint_as_float(v.y << 16); f[3] = __uint_as_float(v.y & 0xffff0000u);
    f[4] = __uint_as_float(v.z << 16); f[5] = __uint_as_float(v.z & 0xffff0000u); f[6] = __uint_as_float(v.w << 16); f[7] = __uint_as_float(v.w & 0xffff0000u);
}
__device__ __forceinline__ v4u pack8(const float* f) { v4u o; o.x = pkbf(f[0], f[1]); o.y = pkbf(f[2], f[3]); o.z = pkbf(f[4], f[5]); o.w = pkbf(f[6], f[7]); return o; }
__device__ __forceinline__ s16x4 lds_tr(LAS const unsigned char* p) { return __builtin_bit_cast(s16x4, __builtin_amdgcn_ds_read_tr16_b64_v4i16((LAS s16x4*)p)); }
__device__ __forceinline__ bf16x8 tr_pair(LAS const unsigned char* p0, LAS const unsigned char* p1) {
    const s16x4 a = lds_tr(p0), b = lds_tr(p1); return __builtin_shufflevector(a, b, 0, 1, 2, 3, 4, 5, 6, 7);
}
__device__ __forceinline__ float fexp2(float x) { return __builtin_amdgcn_exp2f(x); }
__device__ __forceinline__ float frcp(float x) { return __builtin_amdgcn_rcpf(x); }
__device__ __forceinline__ float lane63(float v) { return __builtin_bit_cast(float, __builtin_amdgcn_readlane(__builtin_bit_cast(int, v), 63)); }
__device__ __forceinline__ float flog2(float x) { return __builtin_amdgcn_logf(x); }

constexpr size_t ZB_GQ = (size_t)GM * 4096, ZB_GK = ZB_GQ + (size_t)GM * 512, ZB_HQ = ZB_GK + (size_t)GM * 512, ZB_HFF = ZB_HQ + (size_t)GM * 1024, ZB_HFB = ZB_HFF + (size_t)GM * 1024;
constexpr int ZRW = 4096, ZR_GV = 0, ZR_GOG = 1024, ZR_HI = 2048, ZR_HOG = 3072;
__device__ __forceinline__ size_t blk_off(int chunk, int H, int hh, int w) { return (size_t)((chunk * H + hh) * 8 + w) * 1024; }
struct Ctx {
    const float *x_prompt, *x_sample, *w_in, *w_lr2, *b_lr, *gla_g, *hg_g, *lowb, *w_out, *ln1_g, *ln1_b, *w_up, *w_down, *ln2_g, *ln2_b;
    float* out;
    bf16 *Win_t, *Wout_t, *Wup_t, *Wdn_t, *Wglr_t, *HB, *Z, *O, *ST;
    float *BG, *TOT, *TOTS; bf16 *STS, *MF;
};

__device__ __forceinline__ void transpose_item(const float* W, int N, int kb, int nb, bf16* dst, int K, LAS float* scr, int lane) {
    const int k0 = 64 * kb, n0 = 32 * nb;
#pragma unroll 8
    for (int i = 0; i < 32; ++i) { const int kk = 2 * i + (lane >> 5); scr[kk * 33 + (lane & 31)] = W[(size_t)(k0 + kk) * N + n0 + (lane & 31)]; }
    LDS_WAIT(); asm volatile("" ::: "memory");
    const int c = lane & 7;
#pragma unroll
    for (int j = 0; j < 4; ++j) { const int n = (lane >> 3) + 8 * j; const LAS float* s = scr + (8 * c) * 33 + n;
        v4u o; o.x = pkbf(s[0 * 33], s[1 * 33]); o.y = pkbf(s[2 * 33], s[3 * 33]); o.z = pkbf(s[4 * 33], s[5 * 33]); o.w = pkbf(s[6 * 33], s[7 * 33]);
        *(GAS v4u*)(dst + (size_t)n * K + k0 + 8 * c) = o; }
    LDS_WAIT(); asm volatile("" ::: "memory");
}
__device__ __forceinline__ void prologue_weights(const Ctx& X, LAS unsigned char* lds, int gw, int NGW, int wave, int lane) {
    LAS float* scr = (LAS float*)(lds + wave * 16384);
    constexpr int I_IN = 32 * 257, I_OUT = 32 * 64, I_UP = 32 * 256, I_DN = 128 * 64, I_L = I_IN + I_OUT + I_UP + I_DN;
    for (int it = gw; it < NLAYER * I_L; it += NGW) {
        const int l = it / I_L; int r = it % I_L;
        if (r < I_IN) { const int kb = r / 257, nb = r % 257;
            bf16* dst = (nb < 96) ? X.Win_t + ((size_t)l * ZW + 32 * nb) * DM : (nb == 96) ? X.Wglr_t + (size_t)l * 32 * DM : X.Win_t + ((size_t)l * ZW + 32 * (nb - 1)) * DM;
            transpose_item(X.w_in + (size_t)l * DM * INW, INW, kb, nb, dst, DM, scr, lane); continue; }
        r -= I_IN;
        if (r < I_OUT) { const int kb = r / 64, nb = r % 64; transpose_item(X.w_out + (size_t)l * DM * DM, DM, kb, nb, X.Wout_t + ((size_t)l * DM + 32 * nb) * DM, DM, scr, lane); continue; }
        r -= I_OUT;
        if (r < I_UP) { const int kb = r / 256, nb = r % 256; transpose_item(X.w_up + (size_t)l * DM * DFF, DFF, kb, nb, X.Wup_t + ((size_t)l * DFF + 32 * nb) * DM, DM, scr, lane); continue; }
        r -= I_UP;
        { const int kb = r / 64, nb = r % 64; transpose_item(X.w_down + (size_t)l * DFF * DM, DM, kb, nb, X.Wdn_t + ((size_t)l * DM + 32 * nb) * DFF, DFF, scr, lane); }
    }
}
__device__ __forceinline__ void cvt_group(const float* xg, bf16* HB, int gtid, int NT) {
    for (int i = gtid; i < GM * DM / 8; i += NT) {
        const f32x4 a = ((const GAS f32x4*)xg)[2 * i], b = ((const GAS f32x4*)xg)[2 * i + 1];
        v4u o; o.x = pkbf(a.x, a.y); o.y = pkbf(a.z, a.w); o.z = pkbf(b.x, b.y); o.w = pkbf(b.z, b.w);
        ((GAS v4u*)HB)[i] = o; }
}
template <bool RES_F32, bool OUT_F32>
__device__ __forceinline__ void ln_phase(const void* res, const bf16* mf, const float* gam, const float* bet, float* H, bf16* HB, int gw, int NGW, int lane) {
    for (int m = gw; m < GM; m += NGW) {
        f32x4 v[8]; float s = 0.f;
        const GAS v2u* mr = (const GAS v2u*)(mf + (size_t)m * DM) + lane;
#pragma unroll
        for (int j = 0; j < 8; ++j) { f32x4 r;
            if (RES_F32) r = ((const GAS f32x4*)((const float*)res + (size_t)m * DM) + lane)[64 * j];
            else { const v2u w = ((const GAS v2u*)((const bf16*)res + (size_t)m * DM) + lane)[64 * j];
                r = (f32x4){__uint_as_float(w.x << 16), __uint_as_float(w.x & 0xffff0000u), __uint_as_float(w.y << 16), __uint_as_float(w.y & 0xffff0000u)}; }
            const v2u w = mr[64 * j];
            const f32x4 f = (f32x4){__uint_as_float(w.x << 16), __uint_as_float(w.x & 0xffff0000u), __uint_as_float(w.y << 16), __uint_as_float(w.y & 0xffff0000u)};
            v[j] = r * ALPHA + f; s += (v[j].x + v[j].y) + (v[j].z + v[j].w); }
        const float mean = wave_sum(s) * (1.f / DM); float s2 = 0.f;
#pragma unroll
        for (int j = 0; j < 8; ++j) { v[j] = v[j] - mean; s2 += (v[j].x * v[j].x + v[j].y * v[j].y) + (v[j].z * v[j].z + v[j].w * v[j].w); }
        const float rstd = 1.f / sqrtf(wave_sum(s2) * (1.f / DM) + LN_EPS);
#pragma unroll
        for (int j = 0; j < 8; ++j) { const f32x4 g4 = ((const GAS f32x4*)gam)[lane + 64 * j], b4 = ((const GAS f32x4*)bet)[lane + 64 * j];
            const f32x4 o = v[j] * rstd * g4 + b4;
            if (OUT_F32) ((GAS f32x4*)(H + (size_t)m * DM) + lane)[64 * j] = o;
            else { v2u w; w.x = pkbf(o.x, o.y); w.y = pkbf(o.z, o.w); ((GAS v2u*)(HB + (size_t)m * DM) + lane)[64 * j] = w; } }
    }
}

__device__ __forceinline__ void gate_unit(const Ctx& X, int l, int chunk, LAS unsigned char* lds, int tid, int lane, int wave) {
    const int fr = lane & 15, fq = lane >> 4;
    const bf16* A = X.HB + (size_t)chunk * 64 * DM; const bf16* Bw = X.Wglr_t + (size_t)l * 32 * DM;
    f32x4 acc[4][2];
#pragma unroll
    for (int m = 0; m < 4; ++m)
#pragma unroll
        for (int n = 0; n < 2; ++n) acc[m][n] = (f32x4){0.f, 0.f, 0.f, 0.f};
#pragma unroll 2
    for (int ks = 0; ks < 8; ++ks) { const int k0 = 256 * wave + 32 * ks + 8 * fq;
        bf16x8 a[4], b[2];
#pragma unroll
        for (int m = 0; m < 4; ++m) a[m] = *(const GAS bf16x8*)(A + (size_t)(16 * m + fr) * DM + k0);
#pragma unroll
        for (int n = 0; n < 2; ++n) b[n] = *(const GAS bf16x8*)(Bw + (size_t)(16 * n + fr) * DM + k0);
#pragma unroll
        for (int m = 0; m < 4; ++m)
#pragma unroll
            for (int n = 0; n < 2; ++n) acc[m][n] = __builtin_amdgcn_mfma_f32_16x16x32_bf16(a[m], b[n], acc[m][n], 0, 0, 0); }
    LAS float* part = (LAS float*)lds;
#pragma unroll
    for (int m = 0; m < 4; ++m)
#pragma unroll
        for (int n = 0; n < 2; ++n)
#pragma unroll
            for (int j = 0; j < 4; ++j) part[(wave * 64 + 16 * m + 4 * fq + j) * 33 + 16 * n + fr] = acc[m][n][j];
    __syncthreads();
    LAS float* glr = (LAS float*)(lds + 8 * 64 * 33 * 4);
#pragma unroll
    for (int k = 0; k < 4; ++k) { const int idx = tid + 512 * k, t = idx >> 5, n = idx & 31; float s = 0.f;
#pragma unroll
        for (int w = 0; w < 8; ++w) s += part[(w * 64 + t) * 33 + n];
        glr[t * 36 + n] = s; }
    __syncthreads();
    const int dir = wave >> 2;
    const float* w2 = X.w_lr2 + (size_t)(l * 2 + dir) * 16 * 512; const float* bl = X.b_lr + (size_t)(l * 2 + dir) * 512;
    for (int cb = 0; cb < 2; ++cb) { const int c = 128 * (wave & 3) + 64 * cb + lane;
        float w[16];
#pragma unroll
        for (int r = 0; r < 16; ++r) w[r] = w2[r * 512 + c];
        const float bias = bl[c];
        bf16* bgcol = (bf16*)X.BG + ((size_t)(((chunk * 4 + (c >> 7)) * 8 + ((c & 127) >> 4)) * 2 + dir) * 64) * 16 + (c & 15);
#pragma unroll 4
        for (int tt = 0; tt < 64; ++tt) { const int t = dir ? 63 - tt : tt;
            const LAS f32x4* gr = (const LAS f32x4*)(glr + t * 36 + dir * 16); const f32x4 g0 = gr[0], g1 = gr[1], g2 = gr[2], g3 = gr[3];
            float pre = bias;
            pre += g0.x * w[0] + g0.y * w[1] + g0.z * w[2] + g0.w * w[3]; pre += g1.x * w[4] + g1.y * w[5] + g1.z * w[6] + g1.w * w[7];
            pre += g2.x * w[8] + g2.y * w[9] + g2.z * w[10] + g2.w * w[11]; pre += g3.x * w[12] + g3.y * w[13] + g3.z * w[14] + g3.w * w[15];
            const float gl = (fminf(pre, 0.f) - __logf(1.f + __expf(-fabsf(pre)))) * (LOG2E / 16.f);
            bgcol[(size_t)t * 16] = (bf16)(pkbf(gl, gl) & 0xffffu); } }
    __syncthreads();
}

__device__ __forceinline__ size_t st_slot(int chunk, bool hgt, int h, int dir) { return (size_t)chunk * ST_CHUNK + (hgt ? 262144 + (h * 2 + dir) * 16384 : (h * 2 + dir) * 32768); }

template <bool HGT> struct RawIn { v4u b[2]; v4u k[2]; };
template <> struct RawIn<true> { v4u k[2]; };
template <bool HGT>
__device__ __forceinline__ RawIn<HGT> pass_s_load(const Ctx& X, int chunk, int h, int dir, int lane, int c0) {
    RawIn<HGT> r; const int rt = dir ? 63 - lane : lane, w = c0 >> 4;
    if constexpr (!HGT) { const GAS v4u* bg = (const GAS v4u*)((const bf16*)X.BG + ((size_t)(((chunk * 4 + h) * 8 + w) * 2 + dir) * 64 + rt) * 16);
        r.b[0] = bg[0]; r.b[1] = bg[1];
        const GAS v4u* kp = (const GAS v4u*)(X.Z + ZB_GK + blk_off(chunk, 4, h, w) + rt * 16); r.k[0] = kp[0]; r.k[1] = kp[1];
    } else { const GAS v4u* zp = (const GAS v4u*)(X.Z + (dir ? ZB_HFB : ZB_HFF) + blk_off(chunk, 8, h, w) + rt * 16); r.k[0] = zp[0]; r.k[1] = zp[1]; }
    return r;
}
template <bool HGT, bool STORE>
__device__ __forceinline__ void pass_s_unit(const Ctx& X, int l, int sc, int h, LAS unsigned char* lds, int tid, int lane, int wave) {
    constexpr int DV = HGT ? 128 : 256, VSTR = DV * 2 + 16, NE = DV / 16, PPR = DV / 8, UNR_D = HGT ? 2 : 1, UNR_C = HGT ? 4 : 1;
    const int fr = lane & 15, fq = lane >> 4, qq = fr >> 2, p4 = fr & 3, c0 = 16 * wave;
    RawIn<HGT> cur = pass_s_load<HGT>(X, sc * 4, h, 0, lane, c0);
    RawIn<HGT> rq[HGT ? 4 : 1];
    { const int vcol = HGT ? ZR_HI + h * 128 : ZR_GV + h * 256;
#pragma unroll 4
      for (int k = 0; k < 256 * PPR / 512; ++k) { const int idx = tid + 512 * k, row = idx / PPR, pc = idx % PPR;
        const v4u v = *(const GAS v4u*)(X.Z + (size_t)(sc * 256 + row) * ZRW + vcol + pc * 8);
        *(LAS v4u*)(lds + row * VSTR + pc * 16) = v; } }
    __syncthreads();
    LAS unsigned char* kt = lds + SV_KT + wave * KTW_BYTES;
    for (int dir = 0; dir < 2; ++dir) {
        const int hd = HGT ? 8 + h * 2 + dir : h * 2 + dir;
        if constexpr (HGT) {
#pragma unroll
            for (int q4 = 0; q4 < 4; ++q4) rq[q4] = pass_s_load<HGT>(X, sc * 4 + (dir ? 3 - q4 : q4), h, dir, lane, c0); }
        float lbv[16];
        if (HGT) {
#pragma unroll
            for (int i = 0; i < 16; ++i) lbv[i] = 0.f;
            if (l != 0) { const float* lp = X.lowb + (size_t)dir * 2 * 1024 + h * 128 + c0;
#pragma unroll
                for (int i = 0; i < 16; ++i) lbv[i] = frcp(1.f + __expf(lp[i] - lp[1024 + i])); } }
        f32x4 acc[NE];
        if (STORE) { const bf16* sin = X.STS + st_slot(sc, HGT, h, dir);
#pragma unroll
            for (int et = 0; et < NE; ++et) { const v2u w = *(const GAS v2u*)(sin + (size_t)((et * 4 + (wave >> 1)) * 64 + fr + 16 * (2 * (wave & 1) + (fq >> 1))) * 8 + 4 * (fq & 1));
                acc[et] = (f32x4){__uint_as_float(w.x << 16), __uint_as_float(w.x & 0xffff0000u), __uint_as_float(w.y << 16), __uint_as_float(w.y & 0xffff0000u)}; }
        } else {
#pragma unroll
            for (int et = 0; et < NE; ++et) acc[et] = (f32x4){0.f, 0.f, 0.f, 0.f}; }
        float run[16];
#pragma unroll
        for (int i = 0; i < 16; ++i) run[i] = 0.f;
#pragma unroll UNR_C
        for (int cc = 0; cc < 4; ++cc) { const int ci = dir ? 3 - cc : cc, chunk = sc * 4 + ci;
            RawIn<HGT> nxt = cur;
            if constexpr (HGT) cur = rq[cc];
            else { if (cc < 3) nxt = pass_s_load<HGT>(X, sc * 4 + (dir ? 2 - cc : cc + 1), h, dir, lane, c0);
                   else if (dir == 0) nxt = pass_s_load<HGT>(X, sc * 4 + 3, h, 1, lane, c0); }
            float bc[16], kr[16];
            if constexpr (!HGT) {
                unpack8(cur.b[0], bc); unpack8(cur.b[1], bc + 8); wave_scan16(bc);
                unpack8(cur.k[0], kr); unpack8(cur.k[1], kr + 8);
            } else {
                float zf[16]; unpack8(cur.k[0], zf); unpack8(cur.k[1], zf + 8);
#pragma unroll
                for (int i = 0; i < 16; ++i) {
                    const float z = __builtin_amdgcn_fmed3f(zf[i], -60.f, 60.f), e = fexp2(z * -LOG2E), sig = frcp(1.f + e), oml = 1.f - lbv[i];
                    kr[i] = oml - oml * sig;
                    bc[i] = flog2(lbv[i] + oml * sig); }
                wave_scan16(bc);
            }
            if (STORE) { bf16* slot = X.ST + st_slot(chunk, HGT, h, dir);
#pragma unroll
                for (int et = 0; et < NE; ++et) { v2u w; w.x = pkbf(acc[et][0], acc[et][1]); w.y = pkbf(acc[et][2], acc[et][3]);
                    *(GAS v2u*)(slot + (size_t)((et * 4 + (wave >> 1)) * 64 + fr + 16 * (2 * (wave & 1) + (fq >> 1))) * 8 + 4 * (fq & 1)) = w; }
                if (cc == 3) { cur = nxt; break; } }
            float kh[16];
#pragma unroll
            for (int i = 0; i < 16; ++i) { const float bl = lane63(bc[i]); kh[i] = kr[i] * fexp2(bl - bc[i]); run[i] += bl; }
            { const v4u k0 = pack8(kh), k1 = pack8(kh + 8); const unsigned kw[8] = {k0.x, k0.y, k0.z, k0.w, k1.x, k1.y, k1.z, k1.w};
#pragma unroll
              for (int i = 0; i < 16; ++i) *(LAS unsigned short*)(kt + i * KT_STR + lane * 2) = (unsigned short)((i & 1) ? (kw[i >> 1] >> 16) : (kw[i >> 1] & 0xffffu)); }
            if (lane == 63) {
#pragma unroll
                for (int i = 0; i < 4; ++i) ((LAS f32x4*)(kt + 2304))[i] = (f32x4){bc[4 * i], bc[4 * i + 1], bc[4 * i + 2], bc[4 * i + 3]}; }
            asm volatile("s_waitcnt lgkmcnt(0)" ::: "memory");
            const f32x4 dl = *(const LAS f32x4*)(kt + 2304 + 16 * fq);
            const f32x4 dec = (f32x4){fexp2(dl.x), fexp2(dl.y), fexp2(dl.z), fexp2(dl.w)};
            bf16x8 afr[2];
#pragma unroll
            for (int ks = 0; ks < 2; ++ks) afr[ks] = *(const LAS bf16x8*)(kt + fr * KT_STR + (32 * ks + 8 * fq) * 2);
#pragma unroll
            for (int et = 0; et < NE; ++et) acc[et] = acc[et] * dec;
            { constexpr int NB = 2 * NE / 4;
              LAS const unsigned char* vb[2][2];
#pragma unroll
              for (int ks = 0; ks < 2; ++ks) { const int r0 = 32 * ks + 8 * fq + qq, r1 = r0 + 4;
                  vb[ks][0] = lds + (ci * 64 + (dir ? 63 - r0 : r0)) * VSTR + 8 * p4; vb[ks][1] = lds + (ci * 64 + (dir ? 63 - r1 : r1)) * VSTR + 8 * p4; }
              bf16x8 bb[2][4];
#pragma unroll
              for (int j = 0; j < 4; ++j) bb[0][j] = tr_pair(vb[0][0] + 32 * j, vb[0][1] + 32 * j);
#pragma unroll
              for (int b = 0; b < NB; ++b) {
                  if (b + 1 < NB) { const int ks1 = (b + 1) / (NE / 4), e1 = 4 * ((b + 1) % (NE / 4));
#pragma unroll
                      for (int j = 0; j < 4; ++j) bb[(b + 1) & 1][j] = tr_pair(vb[ks1][0] + 32 * (e1 + j), vb[ks1][1] + 32 * (e1 + j)); }
                  const int ks0 = b / (NE / 4), e0 = 4 * (b % (NE / 4));
#pragma unroll
                  for (int j = 0; j < 4; ++j) acc[e0 + j] = __builtin_amdgcn_mfma_f32_16x16x32_bf16(afr[ks0], bb[b & 1][j], acc[e0 + j], 0, 0, 0);
                  __builtin_amdgcn_sched_group_barrier(0x100, 8, 0); __builtin_amdgcn_sched_group_barrier(0x008, 4, 0); } }
            asm volatile("s_waitcnt lgkmcnt(0)" ::: "memory");
            cur = nxt;
        }
        if (!STORE) { bf16* sout = X.STS + st_slot(sc, HGT, h, dir);
#pragma unroll
            for (int et = 0; et < NE; ++et) { v2u w; w.x = pkbf(acc[et][0], acc[et][1]); w.y = pkbf(acc[et][2], acc[et][3]);
                *(GAS v2u*)(sout + (size_t)((et * 4 + (wave >> 1)) * 64 + fr + 16 * (2 * (wave & 1) + (fq >> 1))) * 8 + 4 * (fq & 1)) = w; }
            if (lane == 0) { float* tp = X.TOTS + ((size_t)sc * 24 + hd) * 128 + c0;
#pragma unroll
                for (int i = 0; i < 4; ++i) ((GAS f32x4*)tp)[i] = (f32x4){run[4 * i], run[4 * i + 1], run[4 * i + 2], run[4 * i + 3]}; } }
    }
    __syncthreads();
}
__device__ __forceinline__ void pass_b_super(const Ctx& X, int g, int gtid, int NT) {
    const int ns = (g == 0) ? 1 : 2, nc = NSC / ns;
    for (int v = gtid; v < ns * (ST_CHUNK / 8); v += NT) {
        const int s = v / (ST_CHUNK / 8), idx = (v % (ST_CHUNK / 8)) * 8;
        const int hd = idx < 262144 ? idx / 32768 : 8 + (idx - 262144) / 16384, db = hd & 1;
        const int d0 = 32 * ((idx >> 9) & 3) + 8 * ((idx >> 7) & 3);
        float S[8];
#pragma unroll
        for (int i = 0; i < 8; ++i) S[i] = 0.f;
        for (int cc = 0; cc < nc; cc += 8) {
            v4u x[8]; f32x4 t0[8], t1[8];
#pragma unroll
            for (int u = 0; u < 8; ++u) { const int c = s * nc + (db ? nc - 1 - (cc + u) : cc + u);
                x[u] = *(const GAS v4u*)(X.STS + (size_t)c * ST_CHUNK + idx);
                const GAS f32x4* tp = (const GAS f32x4*)(X.TOTS + ((size_t)c * 24 + hd) * 128 + d0); t0[u] = tp[0]; t1[u] = tp[1]; }
#pragma unroll
            for (int u = 0; u < 8; ++u) { const int c = s * nc + (db ? nc - 1 - (cc + u) : cc + u);
                *(GAS v4u*)(X.STS + (size_t)c * ST_CHUNK + idx) = pack8(S);
                float dx[8]; unpack8(x[u], dx);
                const float dec[8] = {fexp2(t0[u].x), fexp2(t0[u].y), fexp2(t0[u].z), fexp2(t0[u].w), fexp2(t1[u].x), fexp2(t1[u].y), fexp2(t1[u].z), fexp2(t1[u].w)};
#pragma unroll
                for (int i = 0; i < 8; ++i) S[i] = dec[i] * S[i] + dx[i]; }
        }
    }
}

constexpr int C2_DIR = 63488, C2_QD = 0, C2_KD = 17408, C2_QH = 34816, C2_P = 52224, C2_BT = 61440, C2_V = 126976, C2_RED = 160768;
template <bool HGT>
__device__ __forceinline__ void c2_stage(const Ctx& X, int l, int chunk, int h, int dir, LAS unsigned char* ld, int lane, int wave) {
    const int r = lane, rt = dir ? 63 - r : r, c0 = 16 * wave;
    float bc[16], kr[16], qv[16];
    if (!HGT) {
        const GAS v4u* bg = (const GAS v4u*)((const bf16*)X.BG + ((size_t)(((chunk * 4 + h) * 8 + wave) * 2 + dir) * 64 + rt) * 16);
        unpack8(bg[0], bc); unpack8(bg[1], bc + 8); wave_scan16(bc);
        const GAS v4u* kp = (const GAS v4u*)(X.Z + ZB_GK + blk_off(chunk, 4, h, wave) + rt * 16); unpack8(kp[0], kr); unpack8(kp[1], kr + 8);
        const GAS v4u* qp = (const GAS v4u*)(X.Z + ZB_GQ + blk_off(chunk, 4, h, wave) + rt * 16); unpack8(qp[0], qv); unpack8(qp[1], qv + 8);
#pragma unroll
        for (int i = 0; i < 16; ++i) qv[i] *= 0.08838834764831845f;
    } else {
        float zf[16];
        const GAS v4u* zp = (const GAS v4u*)(X.Z + (dir ? ZB_HFB : ZB_HFF) + blk_off(chunk, 8, h, wave) + rt * 16); unpack8(zp[0], zf); unpack8(zp[1], zf + 8);
        const GAS v4u* qp = (const GAS v4u*)(X.Z + ZB_HQ + blk_off(chunk, 8, h, wave) + rt * 16); unpack8(qp[0], qv); unpack8(qp[1], qv + 8);
        float lbv[16];
        if (l == 0) {
#pragma unroll
            for (int i = 0; i < 16; ++i) lbv[i] = 0.f;
        } else { const float* lp = X.lowb + (size_t)dir * 2 * 1024 + h * 128 + c0;
#pragma unroll
            for (int i = 0; i < 16; ++i) lbv[i] = frcp(1.f + __expf(lp[i] - lp[1024 + i])); }
#pragma unroll
        for (int i = 0; i < 16; ++i) {
            const float z = __builtin_amdgcn_fmed3f(zf[i], -60.f, 60.f), e = fexp2(z * -LOG2E), sig = frcp(1.f + e), oml = 1.f - lbv[i];
            kr[i] = oml - oml * sig;
            bc[i] = flog2(lbv[i] + oml * sig); }
        wave_scan16(bc);
    }
    float qd[16], kd[16], qh[16];
#pragma unroll
    for (int i = 0; i < 16; ++i) {
        const float beta = __builtin_bit_cast(float, __builtin_amdgcn_update_dpp(0, __builtin_bit_cast(int, bc[i]), 0x142, 0xe, 0xf, false));
        qd[i] = qv[i] * fexp2(bc[i] - beta); kd[i] = kr[i] * fexp2(__builtin_amdgcn_fmed3f(beta - bc[i], 0.f, 80.f)); qh[i] = qv[i] * fexp2(bc[i]); }
    LAS unsigned char* p = ld + r * K_STR + c0 * 2;
    ((LAS v4u*)(p + C2_QD))[0] = pack8(qd); ((LAS v4u*)(p + C2_QD))[1] = pack8(qd + 8);
    ((LAS v4u*)(p + C2_KD))[0] = pack8(kd); ((LAS v4u*)(p + C2_KD))[1] = pack8(kd + 8);
    ((LAS v4u*)(p + C2_QH))[0] = pack8(qh); ((LAS v4u*)(p + C2_QH))[1] = pack8(qh + 8);
    if ((lane & 15) == 15) { LAS f32x4* bt = (LAS f32x4*)(ld + C2_BT + (((lane >> 4) + 1) & 3) * 512 + c0 * 4);
        const bool z = lane == 63;
#pragma unroll
        for (int i = 0; i < 4; ++i) bt[i] = z ? (f32x4){0.f, 0.f, 0.f, 0.f} : (f32x4){bc[4 * i], bc[4 * i + 1], bc[4 * i + 2], bc[4 * i + 3]}; }
}
template <bool HGT>
__device__ __forceinline__ void pass_c2_unit(const Ctx& X, int l, int chunk, int h, LAS unsigned char* lds, int tid, int lane, int wave) {
    constexpr int DV = HGT ? 128 : 256, VSTR = DV * 2 + 16, NET = DV / 128, PPR = DV / 8;
    const int fr = lane & 15, fq = lane >> 4, qq = fr >> 2, p4 = fr & 3;
    { const int vcol = HGT ? ZR_HI + h * 128 : ZR_GV + h * 256;
#pragma unroll
      for (int k = 0; k < 64 * PPR / 512; ++k) { const int idx = tid + 512 * k, row = idx / PPR, pc = idx % PPR;
        const v4u v = *(const GAS v4u*)(X.Z + (size_t)(chunk * 64 + row) * ZRW + vcol + pc * 8);
        *(LAS v4u*)(lds + C2_V + row * VSTR + pc * 16) = v; } }
    c2_stage<HGT>(X, l, chunk, h, 0, lds, lane, wave);
    c2_stage<HGT>(X, l, chunk, h, 1, lds + C2_DIR, lane, wave);
    bf16x8 sfr[2][NET][4];
#pragma unroll
    for (int dir = 0; dir < 2; ++dir) { const bf16* slot = X.ST + st_slot(chunk, HGT, h, dir);
#pragma unroll
        for (int et = 0; et < NET; ++et)
#pragma unroll
            for (int ks = 0; ks < 4; ++ks) sfr[dir][et][ks] = *(const GAS bf16x8*)(slot + (size_t)(((wave * NET + et) * 4 + ks) * 64 + lane) * 8); }
    __syncthreads();
    { const int a = wave & 3; LAS unsigned char* ld = lds + (wave >> 2) * C2_DIR;
      const unsigned lst = (a == 0) ? 0xff002010u : (a == 1) ? 0xff113021u : (a == 2) ? 0xffff2231u : 0xffff3332u;
      const unsigned zls = (a == 0) ? 0xffff0201u : (a == 1) ? 0xffff1203u : (a == 2) ? 0xffffff13u : 0xffffff23u;
      for (int t = 0; t < 3; ++t) { const unsigned code = (lst >> (8 * t)) & 0xffu; if (code == 0xffu) break;
          const int I = (int)(code >> 4), J = (int)(code & 15u);
          f32x4 sc = (f32x4){0.f, 0.f, 0.f, 0.f};
#pragma unroll
          for (int ks = 0; ks < 4; ++ks) { const int dc = 32 * ks + 8 * fq;
              v4u ka = *(const LAS v4u*)(ld + C2_KD + (16 * J + fr) * K_STR + dc * 2);
              const bf16x8 qb = *(const LAS bf16x8*)(ld + C2_QD + (16 * I + fr) * K_STR + dc * 2);
              if (J < I) { const LAS f32x4* bi = (const LAS f32x4*)(ld + C2_BT + I * 512 + dc * 4); const LAS f32x4* bj = (const LAS f32x4*)(ld + C2_BT + J * 512 + dc * 4);
                  const f32x4 d0 = bi[0] - bj[0], d1 = bi[1] - bj[1]; float kf[8]; unpack8(ka, kf);
                  kf[0] *= fexp2(d0.x); kf[1] *= fexp2(d0.y); kf[2] *= fexp2(d0.z); kf[3] *= fexp2(d0.w); kf[4] *= fexp2(d1.x); kf[5] *= fexp2(d1.y); kf[6] *= fexp2(d1.z); kf[7] *= fexp2(d1.w);
                  ka = pack8(kf); }
              sc = __builtin_amdgcn_mfma_f32_16x16x32_bf16(__builtin_bit_cast(bf16x8, ka), qb, sc, 0, 0, 0); }
          if (J == I) {
#pragma unroll
              for (int u = 0; u < 4; ++u) if (4 * fq + u > fr) sc[u] = 0.f; }
          v2u w; w.x = pkbf(sc[0], sc[1]); w.y = pkbf(sc[2], sc[3]);
          *(LAS v2u*)(ld + C2_P + (16 * I + fr) * P_STR + (16 * J + 4 * fq) * 2) = w; }
      for (int t = 0; t < 2; ++t) { const unsigned code = (zls >> (8 * t)) & 0xffu; if (code == 0xffu) break;
          const int I = (int)(code >> 4), J = (int)(code & 15u);
          *(LAS v2u*)(ld + C2_P + (16 * I + fr) * P_STR + (16 * J + 4 * fq) * 2) = (v2u){0u, 0u}; } }
    __syncthreads();
    f32x4 oacc[NET][4];
#pragma unroll
    for (int et = 0; et < NET; ++et)
#pragma unroll
        for (int it = 0; it < 4; ++it) oacc[et][it] = (f32x4){0.f, 0.f, 0.f, 0.f};
#pragma unroll
    for (int dir = 0; dir < 2; ++dir) { LAS const unsigned char* ld = lds + dir * C2_DIR;
        bf16x8 vfr[NET][2];
#pragma unroll
        for (int ks = 0; ks < 2; ++ks) { const int r0 = 32 * ks + 8 * fq + qq, r1 = r0 + 4, v0 = dir ? 63 - r0 : r0, v1 = dir ? 63 - r1 : r1;
#pragma unroll
            for (int et = 0; et < NET; ++et) { const int col = (16 * (wave * NET + et) + 4 * p4) * 2;
                vfr[et][ks] = tr_pair(lds + C2_V + v0 * VSTR + col, lds + C2_V + v1 * VSTR + col); } }
#pragma unroll
        for (int it = 0; it < 4; ++it) { const int trow = 16 * it + fr, ip = dir ? 63 - trow : trow;
            bf16x8 bo[6];
#pragma unroll
            for (int ks = 0; ks < 4; ++ks) bo[ks] = *(const LAS bf16x8*)(ld + C2_QH + ip * K_STR + (32 * ks + 8 * fq) * 2);
#pragma unroll
            for (int ks = 0; ks < 2; ++ks) bo[4 + ks] = *(const LAS bf16x8*)(ld + C2_P + ip * P_STR + (32 * ks + 8 * fq) * 2);
#pragma unroll
            for (int ks = 0; ks < 4; ++ks)
#pragma unroll
                for (int et = 0; et < NET; ++et) oacc[et][it] = __builtin_amdgcn_mfma_f32_16x16x32_bf16(sfr[dir][et][ks], bo[ks], oacc[et][it], 0, 0, 0);
#pragma unroll
            for (int ks = 0; ks < 2; ++ks)
#pragma unroll
                for (int et = 0; et < NET; ++et) oacc[et][it] = __builtin_amdgcn_mfma_f32_16x16x32_bf16(vfr[et][ks], bo[4 + ks], oacc[et][it], 0, 0, 0); } }
    LAS float* red = (LAS float*)(lds + C2_RED);
#pragma unroll
    for (int it = 0; it < 4; ++it) { float sq = 0.f;
#pragma unroll
        for (int et = 0; et < NET; ++et) { const f32x4 o = oacc[et][it]; sq += (o.x * o.x + o.y * o.y) + (o.z * o.z + o.w * o.w); }
        sq += __shfl_xor(sq, 16); sq += __shfl_xor(sq, 32);
        if (fq == 0) red[wave * 64 + 16 * it + fr] = sq; }
    __syncthreads();
    const float* ng = (HGT ? X.hg_g + (size_t)l * 128 : X.gla_g + (size_t)l * 256);
    const int ogcol = HGT ? ZR_HOG + h * 128 : ZR_GOG + h * 256, ocol = HGT ? 1024 + h * 128 : h * 256;
#pragma unroll
    for (int it = 0; it < 4; ++it) { float tot = 0.f;
#pragma unroll
        for (int w = 0; w < 8; ++w) tot += red[w * 64 + 16 * it + fr];
        const float rstd = __builtin_amdgcn_rsqf(tot * (1.f / DV) + RMS_EPS);
        const int tok = chunk * 64 + 16 * it + fr;
#pragma unroll
        for (int et = 0; et < NET; ++et) { const int e0 = 16 * (wave * NET + et) + 4 * fq;
            const v2u ogp = *(const GAS v2u*)(X.Z + (size_t)tok * ZRW + ogcol + e0);
            const float og[4] = {__uint_as_float(ogp.x << 16), __uint_as_float(ogp.x & 0xffff0000u), __uint_as_float(ogp.y << 16), __uint_as_float(ogp.y & 0xffff0000u)};
            const f32x4 g4 = *(const GAS f32x4*)(ng + e0); float rr[4];
#pragma unroll
            for (int u = 0; u < 4; ++u) { const float z = og[u]; rr[u] = oacc[et][it][u] * rstd * g4[u] * (z * frcp(1.f + fexp2(z * -LOG2E))); }
            v2u w; w.x = pkbf(rr[0], rr[1]); w.y = pkbf(rr[2], rr[3]);
            *(GAS v2u*)(X.O + (size_t)tok * DM + ocol + e0) = w; } }
}

struct Args { const float* in[15]; float* out; unsigned char* ws; int mode, pad; };
#define PHASE_IDS() int tid = threadIdx.x; asm volatile("" : "+v"(tid)); const int lane = tid & 63, wave = __builtin_amdgcn_readfirstlane(tid >> 6); \
    const int gw = bx * NWAVES + wave, NGW = G * NWAVES, gtid = bx * (NWAVES * 64) + tid, NT = G * NWAVES * 64; (void)lane; (void)wave; (void)gw; (void)NGW; (void)gtid; (void)NT
__device__ __forceinline__ Ctx make_ctx(const Args& args) {
    Ctx X; unsigned char* ws = args.ws;
    X.x_prompt = args.in[0]; X.x_sample = args.in[1]; X.w_in = args.in[2]; X.w_lr2 = args.in[3]; X.b_lr = args.in[4]; X.gla_g = args.in[5]; X.hg_g = args.in[6]; X.lowb = args.in[7];
    X.w_out = args.in[8]; X.ln1_g = args.in[9]; X.ln1_b = args.in[10]; X.w_up = args.in[11]; X.w_down = args.in[12]; X.ln2_g = args.in[13]; X.ln2_b = args.in[14]; X.out = args.out;
    X.Win_t = (bf16*)(ws + WS_WIN); X.Wout_t = (bf16*)(ws + WS_WOUT); X.Wup_t = (bf16*)(ws + WS_WUP); X.Wdn_t = (bf16*)(ws + WS_WDN); X.Wglr_t = (bf16*)(ws + WS_WGLR);
    X.HB = (bf16*)(ws + WS_HB); X.Z = (bf16*)(ws + WS_Z); X.O = (bf16*)(ws + WS_O); X.ST = (bf16*)(ws + WS_ST);
    X.BG = (float*)(ws + WS_BG); X.MF = (bf16*)(ws + WS_ST); X.TOT = (float*)(ws + WS_TOT); X.TOTS = (float*)(ws + WS_TOTS); X.STS = (bf16*)(ws + WS_STS);
    return X;
}
__global__ void __launch_bounds__(NWAVES * 64, 2) fwd_kernel(Args args) {
    extern __shared__ __attribute__((aligned(16))) unsigned char lds_raw[];
    LAS unsigned char* lds = (LAS unsigned char*)lds_raw;
    const int G = gridDim.x, bx = blockIdx.x;
    volatile LAS unsigned* MISC = (volatile LAS unsigned*)(lds + MISC_OFF);
    if (threadIdx.x < 32) MISC[threadIdx.x] = 0u;
    __syncthreads();
    XcdBarrier bar = xcd_barrier_post((unsigned*)(args.ws + WS_CTL) + CW_BAR, MISC + 8);

    { PHASE_IDS(); const Ctx X = make_ctx(args); prologue_weights(X, lds, gw, NGW, wave, lane); }
    for (int g = 0; g < NGRP; ++g) {
        { PHASE_IDS(); const Ctx X = make_ctx(args); cvt_group((g == 0) ? X.x_prompt : X.x_sample + (size_t)(g - 1) * GM * DM, X.HB, gtid, NT); }
        xcd_barrier(bar);
        for (int l = 0; l < NLAYER; ++l) {
            { PHASE_IDS(); const Ctx X = make_ctx(args); for (int c = bx; c < NCHUNK; c += G) gate_unit(X, l, c, lds, tid, lane, wave); }
            { const Ctx X = make_ctx(args); pg8::Gemm gm{X.HB, X.Win_t + (size_t)l * ZW * DM, GM, ZW, DM}; pg8::StaticOrder S; S.init(GM, ZW, G, bx);
              pg8::EpiZ E{X.Z};
              pg8::gemm_phase<pg8::EpiZ, pg8::StaticOrder, false, true>(lds, gm, S, E); }
            xcd_barrier(bar);
            {
            { PHASE_IDS(); const Ctx X = make_ctx(args);
              for (int u = bx; u < NSC * 12; u += G) { const int sc = sc_order(u / 12), hh = u % 12;
                if (hh < 4) pass_s_unit<false, false>(X, l, sc, hh, lds, tid, lane, wave); else pass_s_unit<true, false>(X, l, sc, hh - 4, lds, tid, lane, wave); } }
            xcd_barrier(bar);
            { PHASE_IDS(); const Ctx X = make_ctx(args); pass_b_super(X, g, gtid, NT); }
            xcd_barrier(bar);
            for (int u = bx + ((NSC * 12 - 1 - bx) / G) * G; u >= bx; u -= G) { const int sc = sc_order(u / 12), hh = u % 12;
                { PHASE_IDS(); const Ctx X = make_ctx(args);
                  if (hh < 4) pass_s_unit<false, true>(X, l, sc, hh, lds, tid, lane, wave); else pass_s_unit<true, true>(X, l, sc, hh - 4, lds, tid, lane, wave); }
                asm volatile("s_waitcnt vmcnt(0)" ::: "memory"); __syncthreads();
                { PHASE_IDS(); const Ctx X = make_ctx(args);
                  if (hh < 4) {
#pragma unroll 1
                      for (int ci = 0; ci < 4; ++ci) pass_c2_unit<false>(X, l, sc * 4 + ci, hh, lds, tid, lane, wave);
                  } else {
#pragma unroll 1
                      for (int ci = 0; ci < 4; ++ci) pass_c2_unit<true>(X, l, sc * 4 + ci, hh - 4, lds, tid, lane, wave); } }
                __syncthreads(); }
            xcd_barrier(bar);
            }
            { const Ctx X = make_ctx(args); pg8::Gemm gm{X.O, X.Wout_t + (size_t)l * DM * DM, GM, DM, DM}; pg8::StaticOrder S; S.init(GM, DM, G, bx);
              pg8::EpiBf16<0> E{X.MF, DM};
              pg8::gemm_phase<pg8::EpiBf16<0>, pg8::StaticOrder, false, true>(lds, gm, S, E); }
            xcd_barrier(bar);
            { PHASE_IDS(); const Ctx X = make_ctx(args);
              if (l == 0) ln_phase<true, false>((g == 0) ? X.x_prompt : X.x_sample + (size_t)(g - 1) * GM * DM, X.MF, X.ln1_g, X.ln1_b, nullptr, X.HB, gw, NGW, lane);
              else ln_phase<false, false>(X.HB, X.MF, X.ln1_g + (size_t)l * DM, X.ln1_b + (size_t)l * DM, nullptr, X.HB, gw, NGW, lane); }
            xcd_barrier(bar);
            { const Ctx X = make_ctx(args); pg8::Gemm gm{X.HB, X.Wup_t + (size_t)l * DFF * DM, GM, DFF, DM}; pg8::StaticOrder S; S.init(GM, DFF, G, bx);
              pg8::EpiBf16<1> E{X.Z, DFF};
              pg8::gemm_phase<pg8::EpiBf16<1>, pg8::StaticOrder, false, true>(lds, gm, S, E); }
            xcd_barrier(bar);
            { const Ctx X = make_ctx(args); pg8::Gemm gm{X.Z, X.Wdn_t + (size_t)l * DM * DFF, GM, DM, DFF}; pg8::ReverseOrder S; S.init(GM, DM, G, bx);
              pg8::EpiBf16<0> E{X.MF, DM};
              pg8::gemm_phase<pg8::EpiBf16<0>, pg8::ReverseOrder, false, true>(lds, gm, S, E); }
            xcd_barrier(bar);
            { PHASE_IDS(); const Ctx X = make_ctx(args);
              if (l == NLAYER - 1) ln_phase<false, true>(X.HB, X.MF, X.ln2_g + (size_t)l * DM, X.ln2_b + (size_t)l * DM, X.out + (size_t)g * GM * DM, nullptr, gw, NGW, lane);
              else ln_phase<false, false>(X.HB, X.MF, X.ln2_g + (size_t)l * DM, X.ln2_b + (size_t)l * DM, nullptr, X.HB, gw, NGW, lane); }
            xcd_barrier(bar);
        }
    }
}

extern "C" void kernel_launch(void* const* d_in, const int* in_sizes, int n_in, void* d_out, int out_size, void* d_ws, size_t ws_size, hipStream_t stream) {
    static int grid = 0;
    if (grid == 0) {
        if (n_in != 15 || out_size != NTOK * DM || ws_size < WS_END) { fprintf(stderr, "kernel_launch: unexpected shapes (n_in %d, out %d, ws %zu)\n", n_in, out_size, ws_size); grid = -1; return; }
        int dev = 0, cus = 0;
        if (hipGetDevice(&dev) != hipSuccess || hipDeviceGetAttribute(&cus, hipDeviceAttributeMultiprocessorCount, dev) != hipSuccess) { grid = -1; return; }
        if (hipFuncSetAttribute((const void*)fwd_kernel, hipFuncAttributeMaxDynamicSharedMemorySize, LDS_BYTES) != hipSuccess) { fprintf(stderr, "kernel_launch: hipFuncSetAttribute failed\n"); grid = -1; return; }
        int per_cu = 0;
        if (hipOccupancyMaxActiveBlocksPerMultiprocessor(&per_cu, (const void*)fwd_kernel, NWAVES * 64, LDS_BYTES) != hipSuccess || per_cu < 1) { fprintf(stderr, "kernel_launch: occupancy query says %d\n", per_cu); }
        (void)hipGetLastError();
        grid = cus;
    }
    if (grid < 0) return;
    if (hipMemsetAsync((char*)d_ws + WS_CTL, 0, CTL_ZERO_BYTES, stream) != hipSuccess) return;
    Args a{};
    for (int i = 0; i < 15; ++i) a.in[i] = (const float*)d_in[i];
    a.out = (float*)d_out; a.ws = (unsigned char*)d_ws; a.mode = KMODE; a.pad = 0;
    hipLaunchKernelGGL(fwd_kernel, dim3(grid), dim3(NWAVES * 64), LDS_BYTES, stream, a);
}
```

```cpp
#include <hip/hip_runtime.h>
#include <cstdio>
#include <cstdint>
#ifndef KMODE
#define KMODE 0
#endif
namespace pg8 {
#define PG8_LAS __attribute__((address_space(3)))
typedef unsigned short bf16_t;
typedef short bf16x8 __attribute__((ext_vector_type(8)));
typedef float f32x4 __attribute__((ext_vector_type(4)));
typedef unsigned u32x4 __attribute__((ext_vector_type(4)));
constexpr int BM = 256, BK = 64, HALF = 128, HTB = HALF * BK * 2  , STAGE_BYTES = 8 * HTB, NXCD = 8, WGM = 4;

__host__ __device__ __forceinline__ int lds_byte(int r, int c) { const int st = (r >> 4) * 2 + (c >> 5), rr = r & 15, cc = c & 31, ob = rr * 64 + cc * 2; return st * 1024 + (ob ^ (((ob >> 9) & 1) << 5)); }
__host__ __device__ __forceinline__ void stage_rc(int b, int& R, int& C) { const int st = b / 1024, sb = b % 1024, swz = sb ^ (((sb >> 9) & 1) << 5); R = (st >> 1) * 16 + swz / 64; C = (st & 1) * 32 + (swz % 64) / 2; }
__host__ __device__ __forceinline__ int perm32(int rho) { const int n = rho >> 4, i = rho & 15; return 8 * (i >> 2) + 4 * n + (i & 3); }

struct Unit { int pm, pn; };
struct Gemm { const bf16_t* A; const bf16_t* Bt; int M, N, K; };

struct StaticOrder {
    int nM, nN, nwg, G, c;
    __host__ __device__ void init(int M, int N, int G_, int c_) { nM = M / BM; nN = N / BM; nwg = nM * nN; G = G_; c = c_; }
    __host__ __device__ bool next(int i, Unit& u) const {
        const long L = (long)i * G + c; if (L >= nwg) return false;
        int wgid = (int)L; { const int q = nwg / NXCD, r = nwg % NXCD, xcd = wgid % NXCD, off = wgid / NXCD; wgid = (xcd < r ? xcd * (q + 1) : r * (q + 1) + (xcd - r) * q) + off; }
        const int nig = WGM * nN, gid = wgid / nig, fm = gid * WGM, gsz = (nM - fm) < WGM ? (nM - fm) : WGM;
        u.pm = fm + ((wgid % nig) % gsz); u.pn = (wgid % nig) / gsz; return true;
    }
    __device__ __forceinline__ void a_ready(const Unit&) const {}
    __device__ __forceinline__ void done(const Unit&) const {}
};
struct ReverseOrder : StaticOrder {
    __host__ __device__ bool next(int i, Unit& u) const { const int rounds = nwg / G; if (i >= rounds) return false; return StaticOrder::next(rounds - 1 - i, u); }
};


__device__ __forceinline__ unsigned cvt_pk_bf16(float lo, float hi) { unsigned r; asm volatile("v_cvt_pk_bf16_f32 %0, %1, %2" : "=v"(r) : "v"(lo), "v"(hi)); return r; }

template <int ACT  > struct EpiBf16 {
    static constexpr bool PERM = true, AFTER_DRAIN = false;
    bf16_t* O; int ldc;
    __device__ __forceinline__ void operator()(const f32x4 (&acc)[2][2][4][2], const Unit& u, int wr, int wc, int fr, int fq) const {
        const int row0 = u.pm * BM + wr * 64 + fr; const int col0 = u.pn * BM + wc * 32 + 8 * fq;
#pragma unroll
        for (int ai = 0; ai < 2; ++ai)
#pragma unroll
            for (int m = 0; m < 4; ++m) { bf16_t* rowp = O + (size_t)(row0 + ai * HALF + m * 16) * ldc + col0;
#pragma unroll
                for (int bj = 0; bj < 2; ++bj) { f32x4 v0 = acc[ai][bj][m][0], v1 = acc[ai][bj][m][1];
                    if (ACT == 1) {
#pragma unroll
                        for (int j = 0; j < 4; ++j) { const float a = fmaxf(v0[j], 0.f), b = fmaxf(v1[j], 0.f); v0[j] = a * a; v1[j] = b * b; } }
                    u32x4 w; w.x = cvt_pk_bf16(v0[0], v0[1]); w.y = cvt_pk_bf16(v0[2], v0[3]); w.z = cvt_pk_bf16(v1[0], v1[1]); w.w = cvt_pk_bf16(v1[2], v1[3]);
                    *(u32x4*)(rowp + bj * HALF) = w; } }
    }
};
struct EpiF32 {
    static constexpr bool PERM = false, AFTER_DRAIN = false;
    float* C; int ldc;
    __device__ __forceinline__ void operator()(const f32x4 (&acc)[2][2][4][2], const Unit& u, int wr, int wc, int fr, int fq) const {
        const int row0 = u.pm * BM + wr * 64 + fr, col0 = u.pn * BM + wc * 32 + 4 * fq;
#pragma unroll
        for (int ai = 0; ai < 2; ++ai)
#pragma unroll
            for (int m = 0; m < 4; ++m) { float* rowp = C + (size_t)(row0 + ai * HALF + m * 16) * ldc + col0;
#pragma unroll
                for (int bj = 0; bj < 2; ++bj)
#pragma unroll
                    for (int n = 0; n < 2; ++n) *(f32x4*)(rowp + bj * HALF + n * 16) = acc[ai][bj][m][n]; }
    }
};

struct EpiZ {
    static constexpr bool PERM = true, AFTER_DRAIN = false;
    bf16_t* Z;
    __device__ __forceinline__ void operator()(const f32x4 (&acc)[2][2][4][2], const Unit& u, int wr, int wc, int fr, int fq) const {
        const int pn = u.pn; const size_t Mr = 16384;
        bool blocked; int H = 4, c0; bf16_t* base;
        if (pn < 2) { blocked = true; H = 4; base = Z + Mr * 4096; c0 = pn * 256; }
        else if (pn < 4) { blocked = true; H = 4; base = Z + Mr * 4096 + Mr * 512; c0 = (pn - 2) * 256; }
        else if (pn < 8) { blocked = false; base = Z; c0 = (pn - 4) * 256; }
        else if (pn < 12) { blocked = false; base = Z; c0 = 1024 + (pn - 8) * 256; }
        else if (pn < 24) { blocked = true; H = 8; base = Z + Mr * 4096 + Mr * 1024 + (size_t)((pn - 12) >> 2) * Mr * 1024; c0 = ((pn - 12) & 3) * 256; }
        else if (pn < 28) { blocked = false; base = Z; c0 = 2048 + (pn - 24) * 256; }
        else { blocked = false; base = Z; c0 = 3072 + (pn - 28) * 256; }
        const int row0 = u.pm * BM + wr * 64 + fr, cl = c0 + wc * 32 + 8 * fq;
#pragma unroll
        for (int ai = 0; ai < 2; ++ai)
#pragma unroll
            for (int m = 0; m < 4; ++m) { const int row = row0 + ai * HALF + m * 16;
#pragma unroll
                for (int bj = 0; bj < 2; ++bj) { const f32x4 v0 = acc[ai][bj][m][0], v1 = acc[ai][bj][m][1]; const int c = cl + bj * HALF;
                    u32x4 w; w.x = cvt_pk_bf16(v0[0], v0[1]); w.y = cvt_pk_bf16(v0[2], v0[3]); w.z = cvt_pk_bf16(v1[0], v1[1]); w.w = cvt_pk_bf16(v1[2], v1[3]);
                    bf16_t* p = blocked ? base + ((size_t)((((row >> 6) * H + (c >> 7)) * 8 + ((c >> 4) & 7)) * 64 + (row & 63))) * 16 + (c & 15)
                                        : base + (size_t)row * 4096 + c;
                    *(u32x4*)p = w; } }
    }
};

template <class Epi, class Sched, bool ALIGN_EPI = false, bool SP2 = false>
__device__ __forceinline__ void gemm_phase(PG8_LAS unsigned char* lds, const Gemm g, const Sched& S, const Epi& E) {
    int tid_o = threadIdx.x; asm volatile("" : "+v"(tid_o));
    const int tid = tid_o, wid = __builtin_amdgcn_readfirstlane(tid >> 6), lane = tid & 63, wr = wid >> 2, wc = wid & 3, fr = lane & 15, fq = lane >> 4;
    const int K = g.K, nt = K / BK;
    unsigned voffA[2], voffB[2];
#pragma unroll
    for (int i = 0; i < 2; ++i) { int R, C; stage_rc(tid * 16 + i * 8192, R, C); const int Rb = Epi::PERM ? ((R & ~31) + perm32(R & 31)) : R;
        voffA[i] = (unsigned)(R * K + C) * 2u; voffB[i] = (unsigned)(Rb * K + C) * 2u; }
    const size_t kstep = (size_t)(BK * 2);
    const size_t hstep = (size_t)HALF * K * 2;
    const size_t tstep = 2 * hstep;
    const unsigned ldsw = (unsigned)wid * 1024u;
    const int aoff = lds_byte(wr * 64 + fr, fq * 8), boff = lds_byte(wc * 32 + fr, fq * 8);
#define PG8_SA(b, h) (((b) * 2 + (h)) * HTB)
#define PG8_SB(b, h) ((4 + (b) * 2 + (h)) * HTB)
#define PG8_STAGE(bufoff, gbase, voff) do { _Pragma("unroll") for (int _i = 0; _i < 2; ++_i) \
        __builtin_amdgcn_global_load_lds((const unsigned*)((const char*)(gbase) + (voff)[_i]), (PG8_LAS unsigned*)(lds + (bufoff) + ldsw + _i * 8192), 16, 0, 0); } while (0)
#define PG8_LDA(dst, b, h) do { _Pragma("unroll") for (int m = 0; m < 4; ++m) _Pragma("unroll") for (int k = 0; k < 2; ++k) dst[m][k] = *(const PG8_LAS bf16x8*)(lds + PG8_SA(b, h) + aoff + m * 2048 + k * 1024); } while (0)
#define PG8_LDB(dst, b, h) do { _Pragma("unroll") for (int n = 0; n < 2; ++n) _Pragma("unroll") for (int k = 0; k < 2; ++k) dst[n][k] = *(const PG8_LAS bf16x8*)(lds + PG8_SB(b, h) + boff + n * 2048 + k * 1024); } while (0)
#define PG8_MMA(ai, bj, At, Bt) do { __builtin_amdgcn_s_setprio(1); _Pragma("unroll") for (int m = 0; m < 4; ++m) _Pragma("unroll") for (int n = 0; n < 2; ++n) _Pragma("unroll") for (int k = 0; k < 2; ++k) \
        acc[ai][bj][m][n] = __builtin_amdgcn_mfma_f32_16x16x32_bf16(Bt[n][k], At[m][k], acc[ai][bj][m][n], 0, 0, 0); __builtin_amdgcn_s_setprio(0); } while (0)
#define PG8_WAIT_V(n) asm volatile("s_waitcnt vmcnt(" #n ")" ::: "memory")
#define PG8_WAIT_L(n) asm volatile("s_waitcnt lgkmcnt(" #n ")" ::: "memory")
#define PG8_BAR __builtin_amdgcn_s_barrier()
#define PG8_SCHED __builtin_amdgcn_sched_barrier(0)
    Unit cur, nxt; int ui = 0;
    if (!S.next(0, cur)) return;
    f32x4 acc[2][2][4][2];
#pragma unroll
    for (int a = 0; a < 2; ++a)
#pragma unroll
        for (int b = 0; b < 2; ++b)
#pragma unroll
            for (int m = 0; m < 4; ++m)
#pragma unroll
                for (int n = 0; n < 2; ++n) acc[a][b][m][n] = (f32x4){0.f, 0.f, 0.f, 0.f};
    bf16x8 At[4][2], B0[2][2], B1[2][2];
    const char* cA = (const char*)g.A + (size_t)cur.pm * tstep; const char* cB = (const char*)g.Bt + (size_t)cur.pn * tstep;
    S.a_ready(cur);
    if constexpr (SP2) {
        PG8_STAGE(PG8_SB(0, 0), cB, voffB); PG8_STAGE(PG8_SB(0, 1), cB + hstep, voffB); PG8_STAGE(PG8_SA(0, 0), cA, voffA); PG8_STAGE(PG8_SA(0, 1), cA + hstep, voffA);
        if (wr == 1) PG8_BAR;
        PG8_WAIT_V(2); PG8_BAR;
        PG8_STAGE(PG8_SB(1, 0), cB + kstep, voffB); PG8_STAGE(PG8_SA(1, 0), cA + kstep, voffA); PG8_STAGE(PG8_SB(1, 1), cB + hstep + kstep, voffB);
        PG8_WAIT_V(6); PG8_BAR;
    } else {
        PG8_STAGE(PG8_SB(0, 0), cB, voffB); PG8_STAGE(PG8_SA(0, 0), cA, voffA); PG8_STAGE(PG8_SB(0, 1), cB + hstep, voffB); PG8_STAGE(PG8_SA(0, 1), cA + hstep, voffA);
        if (wr == 1) PG8_BAR;
        PG8_WAIT_V(4); PG8_BAR;
        PG8_STAGE(PG8_SB(1, 0), cB + kstep, voffB); PG8_STAGE(PG8_SA(1, 0), cA + kstep, voffA); PG8_STAGE(PG8_SB(1, 1), cB + hstep + kstep, voffB);
        PG8_WAIT_V(6); PG8_BAR;
    }
    for (;;) {
        const bool has_next = S.next(ui + 1, nxt);
        const char* nA = has_next ? (const char*)g.A + (size_t)nxt.pm * tstep : cA; const char* nB = has_next ? (const char*)g.Bt + (size_t)nxt.pn * tstep : cB;
        for (int t = 0; t < nt; t += 2) {
            const bool last = (t == nt - 2);
            const char* a1 = cA + (size_t)(t + 1) * kstep;
            const char* a2 = last ? nA : cA + (size_t)(t + 2) * kstep; const char* b2 = last ? nB : cB + (size_t)(t + 2) * kstep;
            const char* a3 = a2 + kstep; const char* b3 = b2 + kstep;
            if (last && has_next) S.a_ready(nxt);
            if constexpr (SP2) {
            PG8_LDB(B0, 0, 0); PG8_LDB(B1, 0, 1); PG8_SCHED; PG8_LDA(At, 0, 0); PG8_STAGE(PG8_SA(1, 1), a1 + hstep, voffA);
            PG8_WAIT_V(8); PG8_WAIT_L(0); PG8_BAR; PG8_MMA(0, 0, At, B0); PG8_MMA(0, 1, At, B1); PG8_BAR; PG8_SCHED;
            PG8_LDA(At, 0, 1); PG8_STAGE(PG8_SB(0, 0), b2, voffB); PG8_STAGE(PG8_SB(0, 1), b2 + hstep, voffB); PG8_STAGE(PG8_SA(0, 0), a2, voffA);
            PG8_WAIT_V(8); PG8_WAIT_L(0); PG8_BAR; PG8_MMA(1, 0, At, B0); PG8_MMA(1, 1, At, B1); PG8_BAR; PG8_SCHED;
            PG8_LDB(B0, 1, 0); PG8_LDB(B1, 1, 1); PG8_SCHED; PG8_LDA(At, 1, 0); PG8_STAGE(PG8_SA(0, 1), a2 + hstep, voffA);
            PG8_WAIT_V(8); PG8_WAIT_L(0); PG8_BAR; PG8_MMA(0, 0, At, B0); PG8_MMA(0, 1, At, B1); PG8_BAR; PG8_SCHED;
            PG8_LDA(At, 1, 1); PG8_STAGE(PG8_SB(1, 0), b3, voffB); PG8_STAGE(PG8_SB(1, 1), b3 + hstep, voffB); PG8_STAGE(PG8_SA(1, 0), a3, voffA);
            PG8_WAIT_V(8); PG8_WAIT_L(0); PG8_BAR; PG8_MMA(1, 0, At, B0); PG8_MMA(1, 1, At, B1); PG8_BAR; PG8_SCHED;
            } else {
            PG8_LDB(B0, 0, 0); PG8_SCHED; PG8_LDA(At, 0, 0); PG8_STAGE(PG8_SA(1, 1), a1 + hstep, voffA);
            PG8_WAIT_L(8); PG8_BAR; PG8_WAIT_L(0); PG8_MMA(0, 0, At, B0); PG8_BAR; PG8_SCHED;
            PG8_LDB(B1, 0, 1); PG8_STAGE(PG8_SB(0, 0), b2, voffB);
            PG8_BAR; PG8_WAIT_L(0); PG8_MMA(0, 1, At, B1); PG8_BAR;
            PG8_LDA(At, 0, 1); PG8_STAGE(PG8_SA(0, 0), a2, voffA);
            PG8_BAR; PG8_WAIT_L(0); PG8_MMA(1, 0, At, B0); PG8_BAR; PG8_SCHED;
            PG8_STAGE(PG8_SB(0, 1), b2 + hstep, voffB);
            PG8_WAIT_V(6); PG8_BAR; PG8_MMA(1, 1, At, B1); PG8_BAR;
            PG8_LDB(B0, 1, 0); PG8_SCHED; PG8_LDA(At, 1, 0); PG8_STAGE(PG8_SA(0, 1), a2 + hstep, voffA);
            PG8_WAIT_L(8); PG8_BAR; PG8_WAIT_L(0); PG8_MMA(0, 0, At, B0); PG8_BAR; PG8_SCHED;
            PG8_LDB(B1, 1, 1); PG8_STAGE(PG8_SB(1, 0), b3, voffB);
            PG8_BAR; PG8_WAIT_L(0); PG8_MMA(0, 1, At, B1); PG8_BAR;
            PG8_LDA(At, 1, 1); PG8_STAGE(PG8_SA(1, 0), a3, voffA);
            PG8_BAR; PG8_WAIT_L(0); PG8_MMA(1, 0, At, B0); PG8_BAR; PG8_SCHED;
            PG8_STAGE(PG8_SB(1, 1), b3 + hstep, voffB);
            PG8_WAIT_V(6); PG8_BAR; PG8_MMA(1, 1, At, B1); PG8_BAR;
            }
        }
        if constexpr (ALIGN_EPI) { if (wr == 0) PG8_BAR; }
        if constexpr (!Epi::AFTER_DRAIN) { E(acc, cur, wr, wc, fr, fq); S.done(cur); }
        if (!has_next) break;
#pragma unroll
        for (int a = 0; a < 2; ++a)
#pragma unroll
            for (int b = 0; b < 2; ++b)
#pragma unroll
                for (int m = 0; m < 4; ++m)
#pragma unroll
                    for (int n = 0; n < 2; ++n) acc[a][b][m][n] = (f32x4){0.f, 0.f, 0.f, 0.f};
        cur = nxt; cA = nA; cB = nB; ++ui;
        if constexpr (ALIGN_EPI) { if (wr == 1) PG8_BAR; }
    }
    PG8_WAIT_V(0);
    if constexpr (!ALIGN_EPI) { if (wr == 0) PG8_BAR; }
    PG8_BAR;
    if constexpr (Epi::AFTER_DRAIN) { E.fused(acc, cur, wr, wc, fr, fq, lds, wid, lane); S.done(cur); }
#undef PG8_SA
#undef PG8_SB
#undef PG8_STAGE
#undef PG8_LDA
#undef PG8_LDB
#undef PG8_MMA
#undef PG8_WAIT_V
#undef PG8_WAIT_L
#undef PG8_BAR
#undef PG8_SCHED
}
}

constexpr int NWAVES = 8;
constexpr int DM = 2048, DFF = 8192, NTOK = 49152, GM = 16384, NGRP = 3, NLAYER = 2, INW = 8224, ZW = 8192;
constexpr int ZC_GQ = 0, ZC_GK = 512, ZC_GV = 1024, ZC_GOG = 2048, ZC_HQ = 3072, ZC_HFF = 4096, ZC_HFB = 5120, ZC_HI = 6144, ZC_HOG = 7168;
constexpr float LN_EPS = 1e-5f, RMS_EPS = 1e-6f, ALPHA = 1.41421356237f, LOG2E = 1.44269504089f;
constexpr int NCHUNK = GM / 64;
constexpr int ST_CHUNK = 524288;
constexpr size_t MiB = 1u << 20;
constexpr size_t WS_CTL = 0, CTL_ZERO_BYTES = 1 * MiB;
constexpr size_t WS_WIN = 2 * MiB, WS_WOUT = 66 * MiB, WS_WUP = 82 * MiB, WS_WDN = 146 * MiB, WS_WGLR = 210 * MiB;
constexpr size_t WS_HB = 212 * MiB;
constexpr size_t WS_Z = 276 * MiB;
constexpr size_t WS_BG = 532 * MiB;
constexpr size_t WS_O = 596 * MiB;
constexpr size_t WS_ST = 660 * MiB;
constexpr size_t WS_TOT = 916 * MiB;
constexpr size_t WS_STS = 920 * MiB;
constexpr size_t WS_TOTS = 984 * MiB;
constexpr size_t WS_END = 985 * MiB;
constexpr int CW_BAR = 4096;
constexpr int RING_BYTES = 131072;
constexpr int LDS_BYTES = 160 * 1024, MISC_OFF = LDS_BYTES - 256;
constexpr int L_B32 = 0, L_KR = 33792, L_QR = 51200, L_QH = 68608, L_V = 86016, L_P = 119808, L_RED = 129024;
constexpr int B32_STR = 528, K_STR = 272, P_STR = 144, KT_STR = 144;
constexpr int NSC = GM / 256;
__host__ __device__ __forceinline__ int sc_order(int s) { return s < 32 ? (s >> 2) * 8 + 4 + (s & 3) : ((s - 32) >> 2) * 8 + (s & 3); }
constexpr int SV_KT = 135168, KTW_BYTES = 2560;

#define GAS __attribute__((address_space(1)))
#define LAS __attribute__((address_space(3)))
typedef unsigned short bf16;
typedef unsigned v4u __attribute__((ext_vector_type(4)));
typedef float f32x4 __attribute__((ext_vector_type(4)));
typedef short bf16x8 __attribute__((ext_vector_type(8)));
typedef GAS unsigned gu32;
typedef GAS unsigned long long gu64;
#define RLX_AGENT __ATOMIC_RELAXED, __HIP_MEMORY_SCOPE_AGENT
#define LDS_WAIT() asm volatile("s_waitcnt lgkmcnt(0)" ::: "memory")
#define VM_WAIT() asm volatile("s_waitcnt vmcnt(0)" ::: "memory")
__device__ __forceinline__ unsigned long long rt() { return __builtin_amdgcn_s_memrealtime(); }
__device__ __forceinline__ unsigned f2bf(float f) { unsigned u = __builtin_bit_cast(unsigned, f); return (u + 0x7fffu + ((u >> 16) & 1u)) >> 16; }
__device__ __forceinline__ unsigned pk2(float lo, float hi) { return f2bf(lo) | (f2bf(hi) << 16); }

#define XB_TMO      128
#define XB_XCNT(j)  (256  + 64 * (j))
#define XB_XSUB(j)  (1280 + 64 * (j))
#define XB_XGEN(j)  (2304 + 64 * (j))
#define XB_TOP      3328
#define XB_TOPGEN   3392
#define XCD_BAR_WORDS 3456
#define XB_SPIN_CAP (1u << 18)

__device__ __forceinline__ unsigned xb_ld(unsigned* p)              { return __hip_atomic_load(p, __ATOMIC_RELAXED, __HIP_MEMORY_SCOPE_AGENT); }
__device__ __forceinline__ unsigned xb_add(unsigned* p, unsigned v) { return __hip_atomic_fetch_add(p, v, __ATOMIC_RELAXED, __HIP_MEMORY_SCOPE_AGENT); }
__device__ __forceinline__ unsigned xb_xcc_id() { return (unsigned)__builtin_amdgcn_s_getreg((3 << 11) | 20) & 0xFu; }
#define XB_SPIN(cond, bar) do { unsigned _sp = 0; while (cond) { __builtin_amdgcn_s_sleep(1); \
    if ((++_sp & 255u) == 0u) { if (xb_ld(&(bar)[XB_TMO])) break; if (_sp > XB_SPIN_CAP) { atomicAdd(&(bar)[XB_TMO], 1u); break; } } } } while (0)

struct XcdBarrier {
    unsigned* bar; unsigned x;
    volatile LAS unsigned* st;
};

__device__ __forceinline__ XcdBarrier xcd_barrier_post(unsigned* bar, volatile LAS unsigned* st) {
    XcdBarrier b; b.bar = bar; b.x = xb_xcc_id(); b.st = st;
    if (threadIdx.x == 0) (void)xb_add(&bar[XB_XCNT(b.x)], 1u);
    return b;
}
__device__ __forceinline__ void xcd_barrier_complete(unsigned* bar, unsigned x, unsigned& nloc, unsigned& nx) {
    const unsigned G = gridDim.x * gridDim.y * gridDim.z;
    unsigned sum, cnt, mine, sp = 0u;
    for (;;) {
        sum = 0u; cnt = 0u; mine = 0u;
#pragma unroll
        for (unsigned j = 0; j < 16; ++j) { const unsigned c = xb_ld(&bar[XB_XCNT(j)]); sum += c; cnt += (c > 0u) ? 1u : 0u; mine = (j == x) ? c : mine; }
        if (sum == G) break;
        __builtin_amdgcn_s_sleep(1);
        if ((++sp & 255u) == 0u) { if (xb_ld(&bar[XB_TMO])) break; if (sp > XB_SPIN_CAP) { atomicAdd(&bar[XB_TMO], 1u); break; } }
    }
    nloc = mine > 0u ? mine : 1u; nx = cnt > 0u ? cnt : 1u;
}

__device__ __forceinline__ void xcd_barrier(const XcdBarrier& b) {
    asm volatile("s_waitcnt vmcnt(0)" ::: "memory");
    __syncthreads();
    if (threadIdx.x == 0) {
        unsigned* bar = b.bar;
        __builtin_amdgcn_s_waitcnt(0);
        unsigned nloc = b.st[0], nx = b.st[1];
        if (nloc == 0u) { xcd_barrier_complete(bar, b.x, nloc, nx); b.st[0] = nloc; b.st[1] = nx; }
        const unsigned old = xb_add(&bar[XB_XSUB(b.x)], 1u);
        const unsigned gen = old / nloc;
        if (old + 1u == (gen + 1u) * nloc) {
            __builtin_amdgcn_fence(__ATOMIC_RELEASE, "agent");
            asm volatile("s_waitcnt vmcnt(0)" ::: "memory");
            const unsigned og = xb_add(&bar[XB_TOP], 1u);
            const unsigned tg = og / nx;
            if (og + 1u == (tg + 1u) * nx) xb_add(&bar[XB_TOPGEN], 1u);
            else XB_SPIN(xb_ld(&bar[XB_TOPGEN]) == tg, bar);
            __builtin_amdgcn_fence(__ATOMIC_ACQUIRE, "agent");
            xb_add(&bar[XB_XGEN(b.x)], 1u);
            asm volatile("s_waitcnt vmcnt(0)" ::: "memory");
        } else {
            XB_SPIN(xb_ld(&bar[XB_XGEN(b.x)]) == gen, bar);
            __builtin_amdgcn_fence(__ATOMIC_ACQUIRE, "agent");
            asm volatile("s_waitcnt vmcnt(0)" ::: "memory");
        }
    }
    __syncthreads();
}

typedef short s16x4 __attribute__((ext_vector_type(4)));
typedef float f32x2 __attribute__((ext_vector_type(2)));
typedef unsigned v2u __attribute__((ext_vector_type(2)));
__device__ __forceinline__ unsigned pkbf(float lo, float hi) { return pg8::cvt_pk_bf16(lo, hi); }
__device__ __forceinline__ float wave_sum(float v) {
#pragma unroll
    for (int o = 1; o < 64; o <<= 1) v += __shfl_xor(v, o);
    return v;
}
template <int CTRL, int RM> __device__ __forceinline__ float dpp_add(float v) {
    return v + __builtin_bit_cast(float, __builtin_amdgcn_update_dpp(0, __builtin_bit_cast(int, v), CTRL, RM, 0xf, true));
}
__device__ __forceinline__ float wave_scan_incl(float v, int) {
    v = dpp_add<0x111, 0xf>(v); v = dpp_add<0x112, 0xf>(v); v = dpp_add<0x114, 0xf>(v); v = dpp_add<0x118, 0xf>(v);
    v = dpp_add<0x142, 0xa>(v); v = dpp_add<0x143, 0xc>(v); return v;
}
#define DPP16(CTL) "v_add_f32_dpp %0, %0, %0 " CTL "\n\t" "v_add_f32_dpp %1, %1, %1 " CTL "\n\t" "v_add_f32_dpp %2, %2, %2 " CTL "\n\t" "v_add_f32_dpp %3, %3, %3 " CTL "\n\t" "v_add_f32_dpp %4, %4, %4 " CTL "\n\t" "v_add_f32_dpp %5, %5, %5 " CTL "\n\t" "v_add_f32_dpp %6, %6, %6 " CTL "\n\t" "v_add_f32_dpp %7, %7, %7 " CTL "\n\t" "v_add_f32_dpp %8, %8, %8 " CTL "\n\t" "v_add_f32_dpp %9, %9, %9 " CTL "\n\t" "v_add_f32_dpp %10, %10, %10 " CTL "\n\t" "v_add_f32_dpp %11, %11, %11 " CTL "\n\t" "v_add_f32_dpp %12, %12, %12 " CTL "\n\t" "v_add_f32_dpp %13, %13, %13 " CTL "\n\t" "v_add_f32_dpp %14, %14, %14 " CTL "\n\t" "v_add_f32_dpp %15, %15, %15 " CTL "\n\t"
__device__ __forceinline__ void wave_scan16(float* v) {
    asm volatile("s_nop 1\n\t"
        DPP16("row_shr:1 row_mask:0xf bank_mask:0xf") DPP16("row_shr:2 row_mask:0xf bank_mask:0xf") DPP16("row_shr:4 row_mask:0xf bank_mask:0xf") DPP16("row_shr:8 row_mask:0xf bank_mask:0xf")
        DPP16("row_bcast:15 row_mask:0xa bank_mask:0xf") DPP16("row_bcast:31 row_mask:0xc bank_mask:0xf") "s_nop 1"
        : "+v"(v[0]), "+v"(v[1]), "+v"(v[2]), "+v"(v[3]), "+v"(v[4]), "+v"(v[5]), "+v"(v[6]), "+v"(v[7]), "+v"(v[8]), "+v"(v[9]), "+v"(v[10]), "+v"(v[11]), "+v"(v[12]), "+v"(v[13]), "+v"(v[14]), "+v"(v[15]));
}
__device__ __forceinline__ void unpack8(const v4u v, float* f) {
    f[0] = __uint_as_float(v.x << 16); f[1] = __uint_as_float(v.x & 0xffff0000u); f[2] = __uint_as_float(v.y << 16); f[3] = __uint_as_float(v.y & 0xffff0000u);
    f[4] = __uint_as_float(v.z << 16); f[5] = __uint_as_float(v.z & 0xffff0000u); f[6] = __uint_as_float(v.w << 16); f[7] = __uint_as_float(v.w & 0xffff0000u);
}
__device__ __forceinline__ v4u pack8(const float* f) { v4u o; o.x = pkbf(f[0], f[1]); o.y = pkbf(f[2], f[3]); o.z = pkbf(f[4], f[5]); o.w = pkbf(f[6], f[7]); return o; }
__device__ __forceinline__ s16x4 lds_tr(LAS const unsigned char* p) { return __builtin_bit_cast(s16x4, __builtin_amdgcn_ds_read_tr16_b64_v4i16((LAS s16x4*)p)); }
__device__ __forceinline__ bf16x8 tr_pair(LAS const unsigned char* p0, LAS const unsigned char* p1) {
    const s16x4 a = lds_tr(p0), b = lds_tr(p1); return __builtin_shufflevector(a, b, 0, 1, 2, 3, 4, 5, 6, 7);
}
__device__ __forceinline__ float fexp2(float x) { return __builtin_amdgcn_exp2f(x); }
__device__ __forceinline__ float frcp(float x) { return __builtin_amdgcn_rcpf(x); }
__device__ __forceinline__ float lane63(float v) { return __builtin_bit_cast(float, __builtin_amdgcn_readlane(__builtin_bit_cast(int, v), 63)); }
__device__ __forceinline__ float flog2(float x) { return __builtin_amdgcn_logf(x); }

constexpr size_t ZB_GQ = (size_t)GM * 4096, ZB_GK = ZB_GQ + (size_t)GM * 512, ZB_HQ = ZB_GK + (size_t)GM * 512, ZB_HFF = ZB_HQ + (size_t)GM * 1024, ZB_HFB = ZB_HFF + (size_t)GM * 1024;
constexpr int ZRW = 4096, ZR_GV = 0, ZR_GOG = 1024, ZR_HI = 2048, ZR_HOG = 3072;
__device__ __forceinline__ size_t blk_off(int chunk, int H, int hh, int w) { return (size_t)((chunk * H + hh) * 8 + w) * 1024; }
struct Ctx {
    const float *x_prompt, *x_sample, *w_in, *w_lr2, *b_lr, *gla_g, *hg_g, *lowb, *w_out, *ln1_g, *ln1_b, *w_up, *w_down, *ln2_g, *ln2_b;
    float* out;
    bf16 *Win_t, *Wout_t, *Wup_t, *Wdn_t, *Wglr_t, *HB, *Z, *O, *ST;
    float *BG, *TOT, *TOTS; bf16 *STS, *MF;
};

__device__ __forceinline__ void transpose_item(const float* W, int N, int kb, int nb, bf16* dst, int K, LAS float* scr, int lane) {
    const int k0 = 64 * kb, n0 = 32 * nb;
#pragma unroll 8
    for (int i = 0; i < 32; ++i) { const int kk = 2 * i + (lane >> 5); scr[kk * 33 + (lane & 31)] = W[(size_t)(k0 + kk) * N + n0 + (lane & 31)]; }
    LDS_WAIT(); asm volatile("" ::: "memory");
    const int c = lane & 7;
#pragma unroll
    for (int j = 0; j < 4; ++j) { const int n = (lane >> 3) + 8 * j; const LAS float* s = scr + (8 * c) * 33 + n;
        v4u o; o.x = pkbf(s[0 * 33], s[1 * 33]); o.y = pkbf(s[2 * 33], s[3 * 33]); o.z = pkbf(s[4 * 33], s[5 * 33]); o.w = pkbf(s[6 * 33], s[7 * 33]);
        *(GAS v4u*)(dst + (size_t)n * K + k0 + 8 * c) = o; }
    LDS_WAIT(); asm volatile("" ::: "memory");
}
__device__ __forceinline__ void prologue_weights(const Ctx& X, LAS unsigned char* lds, int gw, int NGW, int wave, int lane) {
    LAS float* scr = (LAS float*)(lds + wave * 16384);
    constexpr int I_IN = 32 * 257, I_OUT = 32 * 64, I_UP = 32 * 256, I_DN = 128 * 64, I_L = I_IN + I_OUT + I_UP + I_DN;
    for (int it = gw; it < NLAYER * I_L; it += NGW) {
        const int l = it / I_L; int r = it % I_L;
        if (r < I_IN) { const int kb = r / 257, nb = r % 257;
            bf16* dst = (nb < 96) ? X.Win_t + ((size_t)l * ZW + 32 * nb) * DM : (nb == 96) ? X.Wglr_t + (size_t)l * 32 * DM : X.Win_t + ((size_t)l * ZW + 32 * (nb - 1)) * DM;
            transpose_item(X.w_in + (size_t)l * DM * INW, INW, kb, nb, dst, DM, scr, lane); continue; }
        r -= I_IN;
        if (r < I_OUT) { const int kb = r / 64, nb = r % 64; transpose_item(X.w_out + (size_t)l * DM * DM, DM, kb, nb, X.Wout_t + ((size_t)l * DM + 32 * nb) * DM, DM, scr, lane); continue; }
        r -= I_OUT;
        if (r < I_UP) { const int kb = r / 256, nb = r % 256; transpose_item(X.w_up + (size_t)l * DM * DFF, DFF, kb, nb, X.Wup_t + ((size_t)l * DFF + 32 * nb) * DM, DM, scr, lane); continue; }
        r -= I_UP;
        { const int kb = r / 64, nb = r % 64; transpose_item(X.w_down + (size_t)l * DFF * DM, DM, kb, nb, X.Wdn_t + ((size_t)l * DM + 32 * nb) * DFF, DFF, scr, lane); }
    }
}
__device__ __forceinline__ void cvt_group(const float* xg, bf16* HB, int gtid, int NT) {
    for (int i = gtid; i < GM * DM / 8; i += NT) {
        const f32x4 a = ((const GAS f32x4*)xg)[2 * i], b = ((const GAS f32x4*)xg)[2 * i + 1];
        v4u o; o.x = pkbf(a.x, a.y); o.y = pkbf(a.z, a.w); o.z = pkbf(b.x, b.y); o.w = pkbf(b.z, b.w);
        ((GAS v4u*)HB)[i] = o; }
}
template <bool RES_F32, bool OUT_F32>
__device__ __forceinline__ void ln_phase(const void* res, const bf16* mf, const float* gam, const float* bet, float* H, bf16* HB, int gw, int NGW, int lane) {
    for (int m = gw; m < GM; m += NGW) {
        f32x4 v[8]; float s = 0.f;
        const GAS v2u* mr = (const GAS v2u*)(mf + (size_t)m * DM) + lane;
#pragma unroll
        for (int j = 0; j < 8; ++j) { f32x4 r;
            if (RES_F32) r = ((const GAS f32x4*)((const float*)res + (size_t)m * DM) + lane)[64 * j];
            else { const v2u w = ((const GAS v2u*)((const bf16*)res + (size_t)m * DM) + lane)[64 * j];
                r = (f32x4){__uint_as_float(w.x << 16), __uint_as_float(w.x & 0xffff0000u), __uint_as_float(w.y << 16), __uint_as_float(w.y & 0xffff0000u)}; }
            const v2u w = mr[64 * j];
            const f32x4 f = (f32x4){__uint_as_float(w.x << 16), __uint_as_float(w.x & 0xffff0000u), __uint_as_float(w.y << 16), __uint_as_float(w.y & 0xffff0000u)};
            v[j] = r * ALPHA + f; s += (v[j].x + v[j].y) + (v[j].z + v[j].w); }
        const float mean = wave_sum(s) * (1.f / DM); float s2 = 0.f;
#pragma unroll
        for (int j = 0; j < 8; ++j) { v[j] = v[j] - mean; s2 += (v[j].x * v[j].x + v[j].y * v[j].y) + (v[j].z * v[j].z + v[j].w * v[j].w); }
        const float rstd = 1.f / sqrtf(wave_sum(s2) * (1.f / DM) + LN_EPS);
#pragma unroll
        for (int j = 0; j < 8; ++j) { const f32x4 g4 = ((const GAS f32x4*)gam)[lane + 64 * j], b4 = ((const GAS f32x4*)bet)[lane + 64 * j];
            const f32x4 o = v[j] * rstd * g4 + b4;
            if (OUT_F32) ((GAS f32x4*)(H + (size_t)m * DM) + lane)[64 * j] = o;
            else { v2u w; w.x = pkbf(o.x, o.y); w.y = pkbf(o.z, o.w); ((GAS v2u*)(HB + (size_t)m * DM) + lane)[64 * j] = w; } }
    }
}

__device__ __forceinline__ void gate_unit(const Ctx& X, int l, int chunk, LAS unsigned char* lds, int tid, int lane, int wave) {
    const int fr = lane & 15, fq = lane >> 4;
    const bf16* A = X.HB + (size_t)chunk * 64 * DM; const bf16* Bw = X.Wglr_t + (size_t)l * 32 * DM;
    f32x4 acc[4][2];
#pragma unroll
    for (int m = 0; m < 4; ++m)
#pragma unroll
        for (int n = 0; n < 2; ++n) acc[m][n] = (f32x4){0.f, 0.f, 0.f, 0.f};
#pragma unroll 2
    for (int ks = 0; ks < 8; ++ks) { const int k0 = 256 * wave + 32 * ks + 8 * fq;
        bf16x8 a[4], b[2];
#pragma unroll
        for (int m = 0; m < 4; ++m) a[m] = *(const GAS bf16x8*)(A + (size_t)(16 * m + fr) * DM + k0);
#pragma unroll
        for (int n = 0; n < 2; ++n) b[n] = *(const GAS bf16x8*)(Bw + (size_t)(16 * n + fr) * DM + k0);
#pragma unroll
        for (int m = 0; m < 4; ++m)
#pragma unroll
            for (int n = 0; n < 2; ++n) acc[m][n] = __builtin_amdgcn_mfma_f32_16x16x32_bf16(a[m], b[n], acc[m][n], 0, 0, 0); }
    LAS float* part = (LAS float*)lds;
#pragma unroll
    for (int m = 0; m < 4; ++m)
#pragma unroll
        for (int n = 0; n < 2; ++n)
#pragma unroll
            for (int j = 0; j < 4; ++j) part[(wave * 64 + 16 * m + 4 * fq + j) * 33 + 16 * n + fr] = acc[m][n][j];
    __syncthreads();
    LAS float* glr = (LAS float*)(lds + 8 * 64 * 33 * 4);
#pragma unroll
    for (int k = 0; k < 4; ++k) { const int idx = tid + 512 * k, t = idx >> 5, n = idx & 31; float s = 0.f;
#pragma unroll
        for (int w = 0; w < 8; ++w) s += part[(w * 64 + t) * 33 + n];
        glr[t * 36 + n] = s; }
    __syncthreads();
    const int dir = wave >> 2;
    const float* w2 = X.w_lr2 + (size_t)(l * 2 + dir) * 16 * 512; const float* bl = X.b_lr + (size_t)(l * 2 + dir) * 512;
    for (int cb = 0; cb < 2; ++cb) { const int c = 128 * (wave & 3) + 64 * cb + lane;
        float w[16];
#pragma unroll
        for (int r = 0; r < 16; ++r) w[r] = w2[r * 512 + c];
        const float bias = bl[c];
        bf16* bgcol = (bf16*)X.BG + ((size_t)(((chunk * 4 + (c >> 7)) * 8 + ((c & 127) >> 4)) * 2 + dir) * 64) * 16 + (c & 15);
#pragma unroll 4
        for (int tt = 0; tt < 64; ++tt) { const int t = dir ? 63 - tt : tt;
            const LAS f32x4* gr = (const LAS f32x4*)(glr + t * 36 + dir * 16); const f32x4 g0 = gr[0], g1 = gr[1], g2 = gr[2], g3 = gr[3];
            float pre = bias;
            pre += g0.x * w[0] + g0.y * w[1] + g0.z * w[2] + g0.w * w[3]; pre += g1.x * w[4] + g1.y * w[5] + g1.z * w[6] + g1.w * w[7];
            pre += g2.x * w[8] + g2.y * w[9] + g2.z * w[10] + g2.w * w[11]; pre += g3.x * w[12] + g3.y * w[13] + g3.z * w[14] + g3.w * w[15];
            const float gl = (fminf(pre, 0.f) - __logf(1.f + __expf(-fabsf(pre)))) * (LOG2E / 16.f);
            bgcol[(size_t)t * 16] = (bf16)(pkbf(gl, gl) & 0xffffu); } }
    __syncthreads();
}

__device__ __forceinline__ size_t st_slot(int chunk, bool hgt, int h, int dir) { return (size_t)chunk * ST_CHUNK + (hgt ? 262144 + (h * 2 + dir) * 16384 : (h * 2 + dir) * 32768); }

template <bool HGT> struct RawIn { v4u b[2]; v4u k[2]; };
template <> struct RawIn<true> { v4u k[2]; };
template <bool HGT>
__device__ __forceinline__ RawIn<HGT> pass_s_load(const Ctx& X, int chunk, int h, int dir, int lane, int c0) {
    RawIn<HGT> r; const int rt = dir ? 63 - lane : lane, w = c0 >> 4;
    if constexpr (!HGT) { const GAS v4u* bg = (const GAS v4u*)((const bf16*)X.BG + ((size_t)(((chunk * 4 + h) * 8 + w) * 2 + dir) * 64 + rt) * 16);
        r.b[0] = bg[0]; r.b[1] = bg[1];
        const GAS v4u* kp = (const GAS v4u*)(X.Z + ZB_GK + blk_off(chunk, 4, h, w) + rt * 16); r.k[0] = kp[0]; r.k[1] = kp[1];
    } else { const GAS v4u* zp = (const GAS v4u*)(X.Z + (dir ? ZB_HFB : ZB_HFF) + blk_off(chunk, 8, h, w) + rt * 16); r.k[0] = zp[0]; r.k[1] = zp[1]; }
    return r;
}
template <bool HGT, bool STORE>
__device__ __forceinline__ void pass_s_unit(const Ctx& X, int l, int sc, int h, LAS unsigned char* lds, int tid, int lane, int wave) {
    constexpr int DV = HGT ? 128 : 256, VSTR = DV * 2 + 16, NE = DV / 16, PPR = DV / 8, UNR_D = HGT ? 2 : 1, UNR_C = HGT ? 4 : 1;
    const int fr = lane & 15, fq = lane >> 4, qq = fr >> 2, p4 = fr & 3, c0 = 16 * wave;
    RawIn<HGT> cur = pass_s_load<HGT>(X, sc * 4, h, 0, lane, c0);
    RawIn<HGT> rq[HGT ? 4 : 1];
    { const int vcol = HGT ? ZR_HI + h * 128 : ZR_GV + h * 256;
#pragma unroll 4
      for (int k = 0; k < 256 * PPR / 512; ++k) { const int idx = tid + 512 * k, row = idx / PPR, pc = idx % PPR;
        const v4u v = *(const GAS v4u*)(X.Z + (size_t)(sc * 256 + row) * ZRW + vcol + pc * 8);
        *(LAS v4u*)(lds + row * VSTR + pc * 16) = v; } }
    __syncthreads();
    LAS unsigned char* kt = lds + SV_KT + wave * KTW_BYTES;
    for (int dir = 0; dir < 2; ++dir) {
        const int hd = HGT ? 8 + h * 2 + dir : h * 2 + dir;
        if constexpr (HGT) {
#pragma unroll
            for (int q4 = 0; q4 < 4; ++q4) rq[q4] = pass_s_load<HGT>(X, sc * 4 + (dir ? 3 - q4 : q4), h, dir, lane, c0); }
        float lbv[16];
        if (HGT) {
#pragma unroll
            for (int i = 0; i < 16; ++i) lbv[i] = 0.f;
            if (l != 0) { const float* lp = X.lowb + (size_t)dir * 2 * 1024 + h * 128 + c0;
#pragma unroll
                for (int i = 0; i < 16; ++i) lbv[i] = frcp(1.f + __expf(lp[i] - lp[1024 + i])); } }
        f32x4 acc[NE];
        if (STORE) { const bf16* sin = X.STS + st_slot(sc, HGT, h, dir);
#pragma unroll
            for (int et = 0; et < NE; ++et) { const v2u w = *(const GAS v2u*)(sin + (size_t)((et * 4 + (wave >> 1)) * 64 + fr + 16 * (2 * (wave & 1) + (fq >> 1))) * 8 + 4 * (fq & 1));
                acc[et] = (f32x4){__uint_as_float(w.x << 16), __uint_as_float(w.x & 0xffff0000u), __uint_as_float(w.y << 16), __uint_as_float(w.y & 0xffff0000u)}; }
        } else {
#pragma unroll
            for (int et = 0; et < NE; ++et) acc[et] = (f32x4){0.f, 0.f, 0.f, 0.f}; }
        float run[16];
#pragma unroll
        for (int i = 0; i < 16; ++i) run[i] = 0.f;
#pragma unroll UNR_C
        for (int cc = 0; cc < 4; ++cc) { const int ci = dir ? 3 - cc : cc, chunk = sc * 4 + ci;
            RawIn<HGT> nxt = cur;
            if constexpr (HGT) cur = rq[cc];
            else { if (cc < 3) nxt = pass_s_load<HGT>(X, sc * 4 + (dir ? 2 - cc : cc + 1), h, dir, lane, c0);
                   else if (dir == 0) nxt = pass_s_load<HGT>(X, sc * 4 + 3, h, 1, lane, c0); }
            float bc[16], kr[16];
            if constexpr (!HGT) {
                unpack8(cur.b[0], bc); unpack8(cur.b[1], bc + 8); wave_scan16(bc);
                unpack8(cur.k[0], kr); unpack8(cur.k[1], kr + 8);
            } else {
                float zf[16]; unpack8(cur.k[0], zf); unpack8(cur.k[1], zf + 8);
#pragma unroll
                for (int i = 0; i < 16; ++i) {
                    const float z = __builtin_amdgcn_fmed3f(zf[i], -60.f, 60.f), e = fexp2(z * -LOG2E), sig = frcp(1.f + e), oml = 1.f - lbv[i];
                    kr[i] = oml - oml * sig;
                    bc[i] = flog2(lbv[i] + oml * sig); }
                wave_scan16(bc);
            }
            if (STORE) { bf16* slot = X.ST + st_slot(chunk, HGT, h, dir);
#pragma unroll
                for (int et = 0; et < NE; ++et) { v2u w; w.x = pkbf(acc[et][0], acc[et][1]); w.y = pkbf(acc[et][2], acc[et][3]);
                    *(GAS v2u*)(slot + (size_t)((et * 4 + (wave >> 1)) * 64 + fr + 16 * (2 * (wave & 1) + (fq >> 1))) * 8 + 4 * (fq & 1)) = w; }
                if (cc == 3) { cur = nxt; break; } }
            float kh[16];
#pragma unroll
            for (int i = 0; i < 16; ++i) { const float bl = lane63(bc[i]); kh[i] = kr[i] * fexp2(bl - bc[i]); run[i] += bl; }
            { const v4u k0 = pack8(kh), k1 = pack8(kh + 8); const unsigned kw[8] = {k0.x, k0.y, k0.z, k0.w, k1.x, k1.y, k1.z, k1.w};
#pragma unroll
              for (int i = 0; i < 16; ++i) *(LAS unsigned short*)(kt + i * KT_STR + lane * 2) = (unsigned short)((i & 1) ? (kw[i >> 1] >> 16) : (kw[i >> 1] & 0xffffu)); }
            if (lane == 63) {
#pragma unroll
                for (int i = 0; i < 4; ++i) ((LAS f32x4*)(kt + 2304))[i] = (f32x4){bc[4 * i], bc[4 * i + 1], bc[4 * i + 2], bc[4 * i + 3]}; }
            asm volatile("s_waitcnt lgkmcnt(0)" ::: "memory");
            const f32x4 dl = *(const LAS f32x4*)(kt + 2304 + 16 * fq);
            const f32x4 dec = (f32x4){fexp2(dl.x), fexp2(dl.y), fexp2(dl.z), fexp2(dl.w)};
            bf16x8 afr[2];
#pragma unroll
            for (int ks = 0; ks < 2; ++ks) afr[ks] = *(const LAS bf16x8*)(kt + fr * KT_STR + (32 * ks + 8 * fq) * 2);
#pragma unroll
            for (int et = 0; et < NE; ++et) acc[et] = acc[et] * dec;
            { constexpr int NB = 2 * NE / 4;
              LAS const unsigned char* vb[2][2];
#pragma unroll
              for (int ks = 0; ks < 2; ++ks) { const int r0 = 32 * ks + 8 * fq + qq, r1 = r0 + 4;
                  vb[ks][0] = lds + (ci * 64 + (dir ? 63 - r0 : r0)) * VSTR + 8 * p4; vb[ks][1] = lds + (ci * 64 + (dir ? 63 - r1 : r1)) * VSTR + 8 * p4; }
              bf16x8 bb[2][4];
#pragma unroll
              for (int j = 0; j < 4; ++j) bb[0][j] = tr_pair(vb[0][0] + 32 * j, vb[0][1] + 32 * j);
#pragma unroll
              for (int b = 0; b < NB; ++b) {
                  if (b + 1 < NB) { const int ks1 = (b + 1) / (NE / 4), e1 = 4 * ((b + 1) % (NE / 4));
#pragma unroll
                      for (int j = 0; j < 4; ++j) bb[(b + 1) & 1][j] = tr_pair(vb[ks1][0] + 32 * (e1 + j), vb[ks1][1] + 32 * (e1 + j)); }
                  const int ks0 = b / (NE / 4), e0 = 4 * (b % (NE / 4));
#pragma unroll
                  for (int j = 0; j < 4; ++j) acc[e0 + j] = __builtin_amdgcn_mfma_f32_16x16x32_bf16(afr[ks0], bb[b & 1][j], acc[e0 + j], 0, 0, 0);
                  __builtin_amdgcn_sched_group_barrier(0x100, 8, 0); __builtin_amdgcn_sched_group_barrier(0x008, 4, 0); } }
            asm volatile("s_waitcnt lgkmcnt(0)" ::: "memory");
            cur = nxt;
        }
        if (!STORE) { bf16* sout = X.STS + st_slot(sc, HGT, h, dir);
#pragma unroll
            for (int et = 0; et < NE; ++et) { v2u w; w.x = pkbf(acc[et][0], acc[et][1]); w.y = pkbf(acc[et][2], acc[et][3]);
                *(GAS v2u*)(sout + (size_t)((et * 4 + (wave >> 1)) * 64 + fr + 16 * (2 * (wave & 1) + (fq >> 1))) * 8 + 4 * (fq & 1)) = w; }
            if (lane == 0) { float* tp = X.TOTS + ((size_t)sc * 24 + hd) * 128 + c0;
#pragma unroll
                for (int i = 0; i < 4; ++i) ((GAS f32x4*)tp)[i] = (f32x4){run[4 * i], run[4 * i + 1], run[4 * i + 2], run[4 * i + 3]}; } }
    }
    __syncthreads();
}
__device__ __forceinline__ void pass_b_super(const Ctx& X, int g, int gtid, int NT) {
    const int ns = (g == 0) ? 1 : 2, nc = NSC / ns;
    for (int v = gtid; v < ns * (ST_CHUNK / 8); v += NT) {
        const int s = v / (ST_CHUNK / 8), idx = (v % (ST_CHUNK / 8)) * 8;
        const int hd = idx < 262144 ? idx / 32768 : 8 + (idx - 262144) / 16384, db = hd & 1;
        const int d0 = 32 * ((idx >> 9) & 3) + 8 * ((idx >> 7) & 3);
        float S[8];
#pragma unroll
        for (int i = 0; i < 8; ++i) S[i] = 0.f;
        for (int cc = 0; cc < nc; cc += 8) {
            v4u x[8]; f32x4 t0[8], t1[8];
#pragma unroll
            for (int u = 0; u < 8; ++u) { const int c = s * nc + (db ? nc - 1 - (cc + u) : cc + u);
                x[u] = *(const GAS v4u*)(X.STS + (size_t)c * ST_CHUNK + idx);
                const GAS f32x4* tp = (const GAS f32x4*)(X.TOTS + ((size_t)c * 24 + hd) * 128 + d0); t0[u] = tp[0]; t1[u] = tp[1]; }
#pragma unroll
            for (int u = 0; u < 8; ++u) { const int c = s * nc + (db ? nc - 1 - (cc + u) : cc + u);
                *(GAS v4u*)(X.STS + (size_t)c * ST_CHUNK + idx) = pack8(S);
                float dx[8]; unpack8(x[u], dx);
                const float dec[8] = {fexp2(t0[u].x), fexp2(t0[u].y), fexp2(t0[u].z), fexp2(t0[u].w), fexp2(t1[u].x), fexp2(t1[u].y), fexp2(t1[u].z), fexp2(t1[u].w)};
#pragma unroll
                for (int i = 0; i < 8; ++i) S[i] = dec[i] * S[i] + dx[i]; }
        }
    }
}

constexpr int C2_DIR = 63488, C2_QD = 0, C2_KD = 17408, C2_QH = 34816, C2_P = 52224, C2_BT = 61440, C2_V = 126976, C2_RED = 160768;
template <bool HGT>
__device__ __forceinline__ void c2_stage(const Ctx& X, int l, int chunk, int h, int dir, LAS unsigned char* ld, int lane, int wave) {
    const int r = lane, rt = dir ? 63 - r : r, c0 = 16 * wave;
    float bc[16], kr[16], qv[16];
    if (!HGT) {
        const GAS v4u* bg = (const GAS v4u*)((const bf16*)X.BG + ((size_t)(((chunk * 4 + h) * 8 + wave) * 2 + dir) * 64 + rt) * 16);
        unpack8(bg[0], bc); unpack8(bg[1], bc + 8); wave_scan16(bc);
        const GAS v4u* kp = (const GAS v4u*)(X.Z + ZB_GK + blk_off(chunk, 4, h, wave) + rt * 16); unpack8(kp[0], kr); unpack8(kp[1], kr + 8);
        const GAS v4u* qp = (const GAS v4u*)(X.Z + ZB_GQ + blk_off(chunk, 4, h, wave) + rt * 16); unpack8(qp[0], qv); unpack8(qp[1], qv + 8);
#pragma unroll
        for (int i = 0; i < 16; ++i) qv[i] *= 0.08838834764831845f;
    } else {
        float zf[16];
        const GAS v4u* zp = (const GAS v4u*)(X.Z + (dir ? ZB_HFB : ZB_HFF) + blk_off(chunk, 8, h, wave) + rt * 16); unpack8(zp[0], zf); unpack8(zp[1], zf + 8);
        const GAS v4u* qp = (const GAS v4u*)(X.Z + ZB_HQ + blk_off(chunk, 8, h, wave) + rt * 16); unpack8(qp[0], qv); unpack8(qp[1], qv + 8);
        float lbv[16];
        if (l == 0) {
#pragma unroll
            for (int i = 0; i < 16; ++i) lbv[i] = 0.f;
        } else { const float* lp = X.lowb + (size_t)dir * 2 * 1024 + h * 128 + c0;
#pragma unroll
            for (int i = 0; i < 16; ++i) lbv[i] = frcp(1.f + __expf(lp[i] - lp[1024 + i])); }
#pragma unroll
        for (int i = 0; i < 16; ++i) {
            const float z = __builtin_amdgcn_fmed3f(zf[i], -60.f, 60.f), e = fexp2(z * -LOG2E), sig = frcp(1.f + e), oml = 1.f - lbv[i];
            kr[i] = oml - oml * sig;
            bc[i] = flog2(lbv[i] + oml * sig); }
        wave_scan16(bc);
    }
    float qd[16], kd[16], qh[16];
#pragma unroll
    for (int i = 0; i < 16; ++i) {
        const float beta = __builtin_bit_cast(float, __builtin_amdgcn_update_dpp(0, __builtin_bit_cast(int, bc[i]), 0x142, 0xe, 0xf, false));
        qd[i] = qv[i] * fexp2(bc[i] - beta); kd[i] = kr[i] * fexp2(__builtin_amdgcn_fmed3f(beta - bc[i], 0.f, 80.f)); qh[i] = qv[i] * fexp2(bc[i]); }
    LAS unsigned char* p = ld + r * K_STR + c0 * 2;
    ((LAS v4u*)(p + C2_QD))[0] = pack8(qd); ((LAS v4u*)(p + C2_QD))[1] = pack8(qd + 8);
    ((LAS v4u*)(p + C2_KD))[0] = pack8(kd); ((LAS v4u*)(p + C2_KD))[1] = pack8(kd + 8);
    ((LAS v4u*)(p + C2_QH))[0] = pack8(qh); ((LAS v4u*)(p + C2_QH))[1] = pack8(qh + 8);
    if ((lane & 15) == 15) { LAS f32x4* bt = (LAS f32x4*)(ld + C2_BT + (((lane >> 4) + 1) & 3) * 512 + c0 * 4);
        const bool z = lane == 63;
#pragma unroll
        for (int i = 0; i < 4; ++i) bt[i] = z ? (f32x4){0.f, 0.f, 0.f, 0.f} : (f32x4){bc[4 * i], bc[4 * i + 1], bc[4 * i + 2], bc[4 * i + 3]}; }
}
template <bool HGT>
__device__ __forceinline__ void pass_c2_unit(const Ctx& X, int l, int chunk, int h, LAS unsigned char* lds, int tid, int lane, int wave) {
    constexpr int DV = HGT ? 128 : 256, VSTR = DV * 2 + 16, NET = DV / 128, PPR = DV / 8;
    const int fr = lane & 15, fq = lane >> 4, qq = fr >> 2, p4 = fr & 3;
    { const int vcol = HGT ? ZR_HI + h * 128 : ZR_GV + h * 256;
#pragma unroll
      for (int k = 0; k < 64 * PPR / 512; ++k) { const int idx = tid + 512 * k, row = idx / PPR, pc = idx % PPR;
        const v4u v = *(const GAS v4u*)(X.Z + (size_t)(chunk * 64 + row) * ZRW + vcol + pc * 8);
        *(LAS v4u*)(lds + C2_V + row * VSTR + pc * 16) = v; } }
    c2_stage<HGT>(X, l, chunk, h, 0, lds, lane, wave);
    c2_stage<HGT>(X, l, chunk, h, 1, lds + C2_DIR, lane, wave);
    bf16x8 sfr[2][NET][4];
#pragma unroll
    for (int dir = 0; dir < 2; ++dir) { const bf16* slot = X.ST + st_slot(chunk, HGT, h, dir);
#pragma unroll
        for (int et = 0; et < NET; ++et)
#pragma unroll
            for (int ks = 0; ks < 4; ++ks) sfr[dir][et][ks] = *(const GAS bf16x8*)(slot + (size_t)(((wave * NET + et) * 4 + ks) * 64 + lane) * 8); }
    __syncthreads();
    { const int a = wave & 3; LAS unsigned char* ld = lds + (wave >> 2) * C2_DIR;
      const unsigned lst = (a == 0) ? 0xff002010u : (a == 1) ? 0xff113021u : (a == 2) ? 0xffff2231u : 0xffff3332u;
      const unsigned zls = (a == 0) ? 0xffff0201u : (a == 1) ? 0xffff1203u : (a == 2) ? 0xffffff13u : 0xffffff23u;
      for (int t = 0; t < 3; ++t) { const unsigned code = (lst >> (8 * t)) & 0xffu; if (code == 0xffu) break;
          const int I = (int)(code >> 4), J = (int)(code & 15u);
          f32x4 sc = (f32x4){0.f, 0.f, 0.f, 0.f};
#pragma unroll
          for (int ks = 0; ks < 4; ++ks) { const int dc = 32 * ks + 8 * fq;
              v4u ka = *(const LAS v4u*)(ld + C2_KD + (16 * J + fr) * K_STR + dc * 2);
              const bf16x8 qb = *(const LAS bf16x8*)(ld + C2_QD + (16 * I + fr) * K_STR + dc * 2);
              if (J < I) { const LAS f32x4* bi = (const LAS f32x4*)(ld + C2_BT + I * 512 + dc * 4); const LAS f32x4* bj = (const LAS f32x4*)(ld + C2_BT + J * 512 + dc * 4);
                  const f32x4 d0 = bi[0] - bj[0], d1 = bi[1] - bj[1]; float kf[8]; unpack8(ka, kf);
                  kf[0] *= fexp2(d0.x); kf[1] *= fexp2(d0.y); kf[2] *= fexp2(d0.z); kf[3] *= fexp2(d0.w); kf[4] *= fexp2(d1.x); kf[5] *= fexp2(d1.y); kf[6] *= fexp2(d1.z); kf[7] *= fexp2(d1.w);
                  ka = pack8(kf); }
              sc = __builtin_amdgcn_mfma_f32_16x16x32_bf16(__builtin_bit_cast(bf16x8, ka), qb, sc, 0, 0, 0); }
          if (J == I) {
#pragma unroll
              for (int u = 0; u < 4; ++u) if (4 * fq + u > fr) sc[u] = 0.f; }
          v2u w; w.x = pkbf(sc[0], sc[1]); w.y = pkbf(sc[2], sc[3]);
          *(LAS v2u*)(ld + C2_P + (16 * I + fr) * P_STR + (16 * J + 4 * fq) * 2) = w; }
      for (int t = 0; t < 2; ++t) { const unsigned code = (zls >> (8 * t)) & 0xffu; if (code == 0xffu) break;
          const int I = (int)(code >> 4), J = (int)(code & 15u);
          *(LAS v2u*)(ld + C2_P + (16 * I + fr) * P_STR + (16 * J + 4 * fq) * 2) = (v2u){0u, 0u}; } }
    __syncthreads();
    f32x4 oacc[NET][4];
#pragma unroll
    for (int et = 0; et < NET; ++et)
#pragma unroll
        for (int it = 0; it < 4; ++it) oacc[et][it] = (f32x4){0.f, 0.f, 0.f, 0.f};
#pragma unroll
    for (int dir = 0; dir < 2; ++dir) { LAS const unsigned char* ld = lds + dir * C2_DIR;
        bf16x8 vfr[NET][2];
#pragma unroll
        for (int ks = 0; ks < 2; ++ks) { const int r0 = 32 * ks + 8 * fq + qq, r1 = r0 + 4, v0 = dir ? 63 - r0 : r0, v1 = dir ? 63 - r1 : r1;
#pragma unroll
            for (int et = 0; et < NET; ++et) { const int col = (16 * (wave * NET + et) + 4 * p4) * 2;
                vfr[et][ks] = tr_pair(lds + C2_V + v0 * VSTR + col, lds + C2_V + v1 * VSTR + col); } }
#pragma unroll
        for (int it = 0; it < 4; ++it) { const int trow = 16 * it + fr, ip = dir ? 63 - trow : trow;
            bf16x8 bo[6];
#pragma unroll
            for (int ks = 0; ks < 4; ++ks) bo[ks] = *(const LAS bf16x8*)(ld + C2_QH + ip * K_STR + (32 * ks + 8 * fq) * 2);
#pragma unroll
            for (int ks = 0; ks < 2; ++ks) bo[4 + ks] = *(const LAS bf16x8*)(ld + C2_P + ip * P_STR + (32 * ks + 8 * fq) * 2);
#pragma unroll
            for (int ks = 0; ks < 4; ++ks)
#pragma unroll
                for (int et = 0; et < NET; ++et) oacc[et][it] = __builtin_amdgcn_mfma_f32_16x16x32_bf16(sfr[dir][et][ks], bo[ks], oacc[et][it], 0, 0, 0);
#pragma unroll
            for (int ks = 0; ks < 2; ++ks)
#pragma unroll
                for (int et = 0; et < NET; ++et) oacc[et][it] = __builtin_amdgcn_mfma_f32_16x16x32_bf16(vfr[et][ks], bo[4 + ks], oacc[et][it], 0, 0, 0); } }
    LAS float* red = (LAS float*)(lds + C2_RED);
#pragma unroll
    for (int it = 0; it < 4; ++it) { float sq = 0.f;
#pragma unroll
        for (int et = 0; et < NET; ++et) { const f32x4 o = oacc[et][it]; sq += (o.x * o.x + o.y * o.y) + (o.z * o.z + o.w * o.w); }
        sq += __shfl_xor(sq, 16); sq += __shfl_xor(sq, 32);
        if (fq == 0) red[wave * 64 + 16 * it + fr] = sq; }
    __syncthreads();
    const float* ng = (HGT ? X.hg_g + (size_t)l * 128 : X.gla_g + (size_t)l * 256);
    const int ogcol = HGT ? ZR_HOG + h * 128 : ZR_GOG + h * 256, ocol = HGT ? 1024 + h * 128 : h * 256;
#pragma unroll
    for (int it = 0; it < 4; ++it) { float tot = 0.f;
#pragma unroll
        for (int w = 0; w < 8; ++w) tot += red[w * 64 + 16 * it + fr];
        const float rstd = __builtin_amdgcn_rsqf(tot * (1.f / DV) + RMS_EPS);
        const int tok = chunk * 64 + 16 * it + fr;
#pragma unroll
        for (int et = 0; et < NET; ++et) { const int e0 = 16 * (wave * NET + et) + 4 * fq;
            const v2u ogp = *(const GAS v2u*)(X.Z + (size_t)tok * ZRW + ogcol + e0);
            const float og[4] = {__uint_as_float(ogp.x << 16), __uint_as_float(ogp.x & 0xffff0000u), __uint_as_float(ogp.y << 16), __uint_as_float(ogp.y & 0xffff0000u)};
            const f32x4 g4 = *(const GAS f32x4*)(ng + e0); float rr[4];
#pragma unroll
            for (int u = 0; u < 4; ++u) { const float z = og[u]; rr[u] = oacc[et][it][u] * rstd * g4[u] * (z * frcp(1.f + fexp2(z * -LOG2E))); }
            v2u w; w.x = pkbf(rr[0], rr[1]); w.y = pkbf(rr[2], rr[3]);
            *(GAS v2u*)(X.O + (size_t)tok * DM + ocol + e0) = w; } }
}

constexpr int F_QD = 0, F_KD = 17408, F_QH = 34816, F_P = 52224, F_BT = 61440, F_KT = 63488, F_DEC = 81920, F_V = 82432, F_RED = 116224;
template <bool HGT>
__device__ __forceinline__ void f_stage(const Ctx& X, int l, int chunk, int h, int dir, LAS unsigned char* ld, int lane, int wave) {
    const int r = lane, rt = dir ? 63 - r : r, c0 = 16 * wave;
    float bc[16], kr[16], qv[16];
    if (!HGT) {
        const GAS v4u* bg = (const GAS v4u*)((const bf16*)X.BG + ((size_t)(((chunk * 4 + h) * 8 + wave) * 2 + dir) * 64 + rt) * 16);
        unpack8(bg[0], bc); unpack8(bg[1], bc + 8); wave_scan16(bc);
        const GAS v4u* kp = (const GAS v4u*)(X.Z + ZB_GK + blk_off(chunk, 4, h, wave) + rt * 16); unpack8(kp[0], kr); unpack8(kp[1], kr + 8);
        const GAS v4u* qp = (const GAS v4u*)(X.Z + ZB_GQ + blk_off(chunk, 4, h, wave) + rt * 16); unpack8(qp[0], qv); unpack8(qp[1], qv + 8);
#pragma unroll
        for (int i = 0; i < 16; ++i) qv[i] *= 0.08838834764831845f;
    } else {
        float zf[16];
        const GAS v4u* zp = (const GAS v4u*)(X.Z + (dir ? ZB_HFB : ZB_HFF) + blk_off(chunk, 8, h, wave) + rt * 16); unpack8(zp[0], zf); unpack8(zp[1], zf + 8);
        const GAS v4u* qp = (const GAS v4u*)(X.Z + ZB_HQ + blk_off(chunk, 8, h, wave) + rt * 16); unpack8(qp[0], qv); unpack8(qp[1], qv + 8);
        float lbv[16];
        if (l == 0) {
#pragma unroll
            for (int i = 0; i < 16; ++i) lbv[i] = 0.f;
        } else { const float* lp = X.lowb + (size_t)dir * 2 * 1024 + h * 128 + c0;
#pragma unroll
            for (int i = 0; i < 16; ++i) lbv[i] = frcp(1.f + __expf(lp[i] - lp[1024 + i])); }
#pragma unroll
        for (int i = 0; i < 16; ++i) {
            const float z = __builtin_amdgcn_fmed3f(zf[i], -60.f, 60.f), e = fexp2(z * -LOG2E), sig = frcp(1.f + e), oml = 1.f - lbv[i];
            kr[i] = oml - oml * sig;
            bc[i] = flog2(lbv[i] + oml * sig); }
        wave_scan16(bc);
    }
    float qd[16], kd[16], qh[16], kh[16], tl[16];
#pragma unroll
    for (int i = 0; i < 16; ++i) {
        const float beta = __builtin_bit_cast(float, __builtin_amdgcn_update_dpp(0, __builtin_bit_cast(int, bc[i]), 0x142, 0xe, 0xf, false));
        tl[i] = lane63(bc[i]);
        qd[i] = qv[i] * fexp2(bc[i] - beta); kd[i] = kr[i] * fexp2(__builtin_amdgcn_fmed3f(beta - bc[i], 0.f, 80.f)); qh[i] = qv[i] * fexp2(bc[i]); kh[i] = kr[i] * fexp2(tl[i] - bc[i]); }
    LAS unsigned char* p = ld + r * K_STR + c0 * 2;
    ((LAS v4u*)(p + F_QD))[0] = pack8(qd); ((LAS v4u*)(p + F_QD))[1] = pack8(qd + 8);
    ((LAS v4u*)(p + F_KD))[0] = pack8(kd); ((LAS v4u*)(p + F_KD))[1] = pack8(kd + 8);
    { const v4u q0 = pack8(qh), q1 = pack8(qh + 8);
      LAS unsigned char* pq = ld + F_QH + r * K_STR + (wave >> 1) * 64 + (wave & 1) * 8;
      *(LAS v2u*)(pq) = (v2u){q0.x, q0.y}; *(LAS v2u*)(pq + 16) = (v2u){q0.z, q0.w}; *(LAS v2u*)(pq + 32) = (v2u){q1.x, q1.y}; *(LAS v2u*)(pq + 48) = (v2u){q1.z, q1.w}; }
    { const v4u k0 = pack8(kh), k1 = pack8(kh + 8); const unsigned kw[8] = {k0.x, k0.y, k0.z, k0.w, k1.x, k1.y, k1.z, k1.w};
#pragma unroll
      for (int i = 0; i < 16; ++i) *(LAS unsigned short*)(ld + F_KT + (c0 + i) * KT_STR + lane * 2) = (unsigned short)((i & 1) ? (kw[i >> 1] >> 16) : (kw[i >> 1] & 0xffffu)); }
    if ((lane & 15) == 15) { LAS f32x4* bt = (LAS f32x4*)(ld + F_BT + (((lane >> 4) + 1) & 3) * 512 + c0 * 4);
        const bool z = lane == 63;
#pragma unroll
        for (int i = 0; i < 4; ++i) bt[i] = z ? (f32x4){0.f, 0.f, 0.f, 0.f} : (f32x4){bc[4 * i], bc[4 * i + 1], bc[4 * i + 2], bc[4 * i + 3]};
        if (z) { LAS f32x4* dc = (LAS f32x4*)(ld + F_DEC + c0 * 4);
#pragma unroll
            for (int i = 0; i < 4; ++i) dc[i] = (f32x4){fexp2(tl[4 * i]), fexp2(tl[4 * i + 1]), fexp2(tl[4 * i + 2]), fexp2(tl[4 * i + 3])}; } }
}
template <bool HGT>
__device__ __forceinline__ void pass_f_unit(const Ctx& X, int l, int sc, int h, float* scr, LAS unsigned char* lds, int tid_, int lane_, int wave) {
    constexpr int DV = HGT ? 128 : 256, VSTR = DV * 2 + 16, NET = DV / 128, PPR = DV / 8;
    if (tid_ < 384) { const int tid = tid_; const int tile = tid >> 6, row = (tid >> 2) & 15, part = tid & 3;
        const unsigned code = (tile < 4) ? (0x12030201u >> (8 * tile)) & 0xffu : (0x2313u >> (8 * (tile - 4))) & 0xffu;
        *(LAS v2u*)(lds + F_P + (16 * (int)(code >> 4) + row) * P_STR + (16 * (int)(code & 15u) + 4 * part) * 2) = (v2u){0u, 0u}; }
    const float* ng = (HGT ? X.hg_g + (size_t)l * 128 : X.gla_g + (size_t)l * 256);
    const int ogcol = HGT ? ZR_HOG + h * 128 : ZR_GOG + h * 256, ocol = HGT ? 1024 + h * 128 : h * 256;
#pragma unroll 1
    for (int sw = 0; sw < 2; ++sw) { const int dir = 1 - sw;
        f32x4 S[8][NET];
        { const bf16* sin = X.STS + st_slot(sc, HGT, h, dir); const int fr = lane_ & 15, fq = lane_ >> 4;
#pragma unroll
          for (int T = 0; T < 8; ++T)
#pragma unroll
            for (int et = 0; et < NET; ++et) { const v2u w = *(const GAS v2u*)(sin + (size_t)(((wave * NET + et) * 4 + (T >> 1)) * 64 + fr + 16 * (2 * (T & 1) + (fq >> 1))) * 8 + 4 * (fq & 1));
                S[T][et] = (f32x4){__uint_as_float(w.x << 16), __uint_as_float(w.x & 0xffff0000u), __uint_as_float(w.y << 16), __uint_as_float(w.y & 0xffff0000u)}; } }
#pragma unroll 1
        for (int cc = 0; cc < 4; ++cc) { const int ci = dir ? 3 - cc : cc, chunk = sc * 4 + ci;
            int tq = tid_; asm volatile("" : "+v"(tq));
            const int tid = tq, lane = tq & 63, fr = lane & 15, fq = lane >> 4, qq = fr >> 2, p4 = fr & 3;
            { const int vcol = HGT ? ZR_HI + h * 128 : ZR_GV + h * 256;
#pragma unroll
              for (int k = 0; k < 64 * PPR / 512; ++k) { const int idx = tid + 512 * k, row = idx / PPR, pc = idx % PPR;
                const v4u v = *(const GAS v4u*)(X.Z + (size_t)(chunk * 64 + row) * ZRW + vcol + pc * 8);
                *(LAS v4u*)(lds + F_V + row * VSTR + pc * 16) = v; } }
            f_stage<HGT>(X, l, chunk, h, dir, lds, lane, wave);
            float* sp = scr + (size_t)((ci * 8 + wave) * (NET * 4)) * 256 + lane * 4;
            f32x4 oacc[NET][4];
#pragma unroll
            for (int et = 0; et < NET; ++et)
#pragma unroll
                for (int it = 0; it < 4; ++it) oacc[et][it] = (f32x4){0.f, 0.f, 0.f, 0.f};
            __syncthreads();
            { const unsigned lst = (wave < 6) ? 0xff00u | (unsigned)((0x323130212010ull >> (8 * wave)) & 0xffull) : (wave == 6 ? 0x1100u : 0x3322u);
              for (int t = 0; t < 2; ++t) { const unsigned code = (lst >> (8 * t)) & 0xffu; if (code == 0xffu) break;
                  const int I = (int)(code >> 4), J = (int)(code & 15u);
                  f32x4 scv = (f32x4){0.f, 0.f, 0.f, 0.f};
#pragma unroll
                  for (int ks = 0; ks < 4; ++ks) { const int dc = 32 * ks + 8 * fq;
                      v4u ka = *(const LAS v4u*)(lds + F_KD + (16 * J + fr) * K_STR + dc * 2);
                      const bf16x8 qb = *(const LAS bf16x8*)(lds + F_QD + (16 * I + fr) * K_STR + dc * 2);
                      if (J < I) { const LAS f32x4* bi = (const LAS f32x4*)(lds + F_BT + I * 512 + dc * 4); const LAS f32x4* bj = (const LAS f32x4*)(lds + F_BT + J * 512 + dc * 4);
                          const f32x4 d0 = bi[0] - bj[0], d1 = bi[1] - bj[1]; float kf[8]; unpack8(ka, kf);
                          kf[0] *= fexp2(d0.x); kf[1] *= fexp2(d0.y); kf[2] *= fexp2(d0.z); kf[3] *= fexp2(d0.w); kf[4] *= fexp2(d1.x); kf[5] *= fexp2(d1.y); kf[6] *= fexp2(d1.z); kf[7] *= fexp2(d1.w);
                          ka = pack8(kf); }
                      scv = __builtin_amdgcn_mfma_f32_16x16x32_bf16(__builtin_bit_cast(bf16x8, ka), qb, scv, 0, 0, 0); }
                  if (J == I) {
#pragma unroll
                      for (int u = 0; u < 4; ++u) if (4 * fq + u > fr) scv[u] = 0.f; }
                  v2u w; w.x = pkbf(scv[0], scv[1]); w.y = pkbf(scv[2], scv[3]);
                  *(LAS v2u*)(lds + F_P + (16 * I + fr) * P_STR + (16 * J + 4 * fq) * 2) = w; } }
            __syncthreads();
            bf16x8 vfr[NET][2];
#pragma unroll
            for (int ks = 0; ks < 2; ++ks) { const int r0 = 32 * ks + 8 * fq + qq, r1 = r0 + 4, v0 = dir ? 63 - r0 : r0, v1 = dir ? 63 - r1 : r1;
#pragma unroll
                for (int et = 0; et < NET; ++et) { const int col = (16 * (wave * NET + et) + 4 * p4) * 2;
                    vfr[et][ks] = tr_pair(lds + F_V + v0 * VSTR + col, lds + F_V + v1 * VSTR + col); } }
            f32x4 part[NET][4];
            if (!dir) {
#pragma unroll
                for (int et = 0; et < NET; ++et)
#pragma unroll
                    for (int it = 0; it < 4; ++it) part[et][it] = *(const GAS f32x4*)(sp + (et * 4 + it) * 256); }
            {
#pragma unroll
              for (int ks = 0; ks < 4; ++ks) { bf16x8 sfr[NET];
#pragma unroll
                for (int et = 0; et < NET; ++et) { v4u a; a.x = pkbf(S[2 * ks][et][0], S[2 * ks][et][1]); a.y = pkbf(S[2 * ks][et][2], S[2 * ks][et][3]);
                    a.z = pkbf(S[2 * ks + 1][et][0], S[2 * ks + 1][et][1]); a.w = pkbf(S[2 * ks + 1][et][2], S[2 * ks + 1][et][3]); sfr[et] = __builtin_bit_cast(bf16x8, a); }
#pragma unroll
                for (int it = 0; it < 4; ++it) { const int trow = 16 * it + fr, ip = dir ? 63 - trow : trow;
                    const bf16x8 bo = *(const LAS bf16x8*)(lds + F_QH + ip * K_STR + (32 * ks + 8 * fq) * 2);
#pragma unroll
                    for (int et = 0; et < NET; ++et) oacc[et][it] = __builtin_amdgcn_mfma_f32_16x16x32_bf16(sfr[et], bo, oacc[et][it], 0, 0, 0); } }
#pragma unroll
              for (int ks = 0; ks < 2; ++ks)
#pragma unroll
                for (int it = 0; it < 4; ++it) { const int trow = 16 * it + fr, ip = dir ? 63 - trow : trow;
                    const bf16x8 bo = *(const LAS bf16x8*)(lds + F_P + ip * P_STR + (32 * ks + 8 * fq) * 2);
#pragma unroll
                    for (int et = 0; et < NET; ++et) oacc[et][it] = __builtin_amdgcn_mfma_f32_16x16x32_bf16(vfr[et][ks], bo, oacc[et][it], 0, 0, 0); } }
            if (!dir) {
#pragma unroll
                for (int et = 0; et < NET; ++et)
#pragma unroll
                    for (int it = 0; it < 4; ++it) oacc[et][it] += part[et][it]; }
            if (cc < 3) {
#pragma unroll
                for (int T = 0; T < 8; ++T) { const f32x4 dc = *(const LAS f32x4*)(lds + F_DEC + (16 * T + 4 * fq) * 4);
                    const bf16x8 a0 = *(const LAS bf16x8*)(lds + F_KT + (16 * T + fr) * KT_STR + (8 * fq) * 2), a1 = *(const LAS bf16x8*)(lds + F_KT + (16 * T + fr) * KT_STR + (32 + 8 * fq) * 2);
#pragma unroll
                    for (int et = 0; et < NET; ++et) { S[T][et] = S[T][et] * dc;
                        S[T][et] = __builtin_amdgcn_mfma_f32_16x16x32_bf16(a0, vfr[et][0], S[T][et], 0, 0, 0); S[T][et] = __builtin_amdgcn_mfma_f32_16x16x32_bf16(a1, vfr[et][1], S[T][et], 0, 0, 0); } } }
            if (dir) {
#pragma unroll
                for (int et = 0; et < NET; ++et)
#pragma unroll
                    for (int it = 0; it < 4; ++it) *(GAS f32x4*)(sp + (et * 4 + it) * 256) = oacc[et][it];
                __syncthreads();
            } else {
                LAS float* red = (LAS float*)(lds + F_RED);
#pragma unroll
                for (int it = 0; it < 4; ++it) { float sq = 0.f;
#pragma unroll
                    for (int et = 0; et < NET; ++et) { const f32x4 o = oacc[et][it]; sq += (o.x * o.x + o.y * o.y) + (o.z * o.z + o.w * o.w); }
                    sq += __shfl_xor(sq, 16); sq += __shfl_xor(sq, 32);
                    if (fq == 0) red[wave * 64 + 16 * it + fr] = sq; }
                __syncthreads();
#pragma unroll
                for (int it = 0; it < 4; ++it) { float tot = 0.f;
#pragma unroll
                    for (int w = 0; w < 8; ++w) tot += red[w * 64 + 16 * it + fr];
                    const float rstd = __builtin_amdgcn_rsqf(tot * (1.f / DV) + RMS_EPS);
                    const int tok = chunk * 64 + 16 * it + fr;
#pragma unroll
                    for (int et = 0; et < NET; ++et) { const int e0 = 16 * (wave * NET + et) + 4 * fq;
                        const v2u ogp = *(const GAS v2u*)(X.Z + (size_t)tok * ZRW + ogcol + e0);
                        const float og[4] = {__uint_as_float(ogp.x << 16), __uint_as_float(ogp.x & 0xffff0000u), __uint_as_float(ogp.y << 16), __uint_as_float(ogp.y & 0xffff0000u)};
                        const f32x4 g4 = *(const GAS f32x4*)(ng + e0); float rr[4];
#pragma unroll
                        for (int u = 0; u < 4; ++u) { const float z = og[u]; rr[u] = oacc[et][it][u] * rstd * g4[u] * (z * frcp(1.f + fexp2(z * -LOG2E))); }
                        v2u w; w.x = pkbf(rr[0], rr[1]); w.y = pkbf(rr[2], rr[3]);
                        *(GAS v2u*)(X.O + (size_t)tok * DM + ocol + e0) = w; } }
            }
        }
        asm volatile("s_waitcnt vmcnt(0)" ::: "memory");
    }
}

struct Args { const float* in[15]; float* out; unsigned char* ws; int mode, pad; };
#define PHASE_IDS() int tid = threadIdx.x; asm volatile("" : "+v"(tid)); const int lane = tid & 63, wave = __builtin_amdgcn_readfirstlane(tid >> 6); \
    const int gw = bx * NWAVES + wave, NGW = G * NWAVES, gtid = bx * (NWAVES * 64) + tid, NT = G * NWAVES * 64; (void)lane; (void)wave; (void)gw; (void)NGW; (void)gtid; (void)NT
__device__ __forceinline__ Ctx make_ctx(const Args& args) {
    Ctx X; unsigned char* ws = args.ws;
    X.x_prompt = args.in[0]; X.x_sample = args.in[1]; X.w_in = args.in[2]; X.w_lr2 = args.in[3]; X.b_lr = args.in[4]; X.gla_g = args.in[5]; X.hg_g = args.in[6]; X.lowb = args.in[7];
    X.w_out = args.in[8]; X.ln1_g = args.in[9]; X.ln1_b = args.in[10]; X.w_up = args.in[11]; X.w_down = args.in[12]; X.ln2_g = args.in[13]; X.ln2_b = args.in[14]; X.out = args.out;
    X.Win_t = (bf16*)(ws + WS_WIN); X.Wout_t = (bf16*)(ws + WS_WOUT); X.Wup_t = (bf16*)(ws + WS_WUP); X.Wdn_t = (bf16*)(ws + WS_WDN); X.Wglr_t = (bf16*)(ws + WS_WGLR);
    X.HB = (bf16*)(ws + WS_HB); X.Z = (bf16*)(ws + WS_Z); X.O = (bf16*)(ws + WS_O); X.ST = (bf16*)(ws + WS_ST);
    X.BG = (float*)(ws + WS_BG); X.MF = (bf16*)(ws + WS_ST); X.TOT = (float*)(ws + WS_TOT); X.TOTS = (float*)(ws + WS_TOTS); X.STS = (bf16*)(ws + WS_STS);
    return X;
}
__global__ void __launch_bounds__(NWAVES * 64, 2) fwd_kernel(Args args) {
    extern __shared__ __attribute__((aligned(16))) unsigned char lds_raw[];
    LAS unsigned char* lds = (LAS unsigned char*)lds_raw;
    const int G = gridDim.x, bx = blockIdx.x;
    volatile LAS unsigned* MISC = (volatile LAS unsigned*)(lds + MISC_OFF);
    if (threadIdx.x < 32) MISC[threadIdx.x] = 0u;
    __syncthreads();
    XcdBarrier bar = xcd_barrier_post((unsigned*)(args.ws + WS_CTL) + CW_BAR, MISC + 8);

    { PHASE_IDS(); const Ctx X = make_ctx(args); prologue_weights(X, lds, gw, NGW, wave, lane); }
    for (int g = 0; g < NGRP; ++g) {
        { PHASE_IDS(); const Ctx X = make_ctx(args); cvt_group((g == 0) ? X.x_prompt : X.x_sample + (size_t)(g - 1) * GM * DM, X.HB, gtid, NT); }
        xcd_barrier(bar);
        for (int l = 0; l < NLAYER; ++l) {
            { PHASE_IDS(); const Ctx X = make_ctx(args); for (int c = bx; c < NCHUNK; c += G) gate_unit(X, l, c, lds, tid, lane, wave); }
            { const Ctx X = make_ctx(args); pg8::Gemm gm{X.HB, X.Win_t + (size_t)l * ZW * DM, GM, ZW, DM}; pg8::StaticOrder S; S.init(GM, ZW, G, bx);
              pg8::EpiZ E{X.Z};
              pg8::gemm_phase<pg8::EpiZ, pg8::StaticOrder, false, true>(lds, gm, S, E); }
            xcd_barrier(bar);
            {
            { PHASE_IDS(); const Ctx X = make_ctx(args);
              for (int u = bx; u < NSC * 12; u += G) { const int sc = sc_order(u / 12), hh = u % 12;
                if (hh < 4) pass_s_unit<false, false>(X, l, sc, hh, lds, tid, lane, wave); else pass_s_unit<true, false>(X, l, sc, hh - 4, lds, tid, lane, wave); } }
            xcd_barrier(bar);
            { PHASE_IDS(); const Ctx X = make_ctx(args); pass_b_super(X, g, gtid, NT); }
            xcd_barrier(bar);
            for (int u = bx + ((NSC * 12 - 1 - bx) / G) * G; u >= bx; u -= G) { const int sc = sc_order(u / 12), hh = u % 12;
                { PHASE_IDS(); const Ctx X = make_ctx(args); float* scr = (float*)X.ST + (size_t)bx * 65536;
                  if (hh < 4) pass_f_unit<false>(X, l, sc, hh, scr, lds, tid, lane, wave); else pass_f_unit<true>(X, l, sc, hh - 4, scr, lds, tid, lane, wave); }
                __syncthreads(); }
            xcd_barrier(bar);
            }
            { const Ctx X = make_ctx(args); pg8::Gemm gm{X.O, X.Wout_t + (size_t)l * DM * DM, GM, DM, DM}; pg8::StaticOrder S; S.init(GM, DM, G, bx);
              pg8::EpiBf16<0> E{X.MF, DM};
              pg8::gemm_phase<pg8::EpiBf16<0>, pg8::StaticOrder, false, true>(lds, gm, S, E); }
            xcd_barrier(bar);
            { PHASE_IDS(); const Ctx X = make_ctx(args);
              if (l == 0) ln_phase<true, false>((g == 0) ? X.x_prompt : X.x_sample + (size_t)(g - 1) * GM * DM, X.MF, X.ln1_g, X.ln1_b, nullptr, X.HB, gw, NGW, lane);
              else ln_phase<false, false>(X.HB, X.MF, X.ln1_g + (size_t)l * DM, X.ln1_b + (size_t)l * DM, nullptr, X.HB, gw, NGW, lane); }
            xcd_barrier(bar);
            { const Ctx X = make_ctx(args); pg8::Gemm gm{X.HB, X.Wup_t + (size_t)l * DFF * DM, GM, DFF, DM}; pg8::StaticOrder S; S.init(GM, DFF, G, bx);
              pg8::EpiBf16<1> E{X.Z, DFF};
              pg8::gemm_phase<pg8::EpiBf16<1>, pg8::StaticOrder, false, true>(lds, gm, S, E); }
            xcd_barrier(bar);
            { const Ctx X = make_ctx(args); pg8::Gemm gm{X.Z, X.Wdn_t + (size_t)l * DM * DFF, GM, DM, DFF}; pg8::ReverseOrder S; S.init(GM, DM, G, bx);
              pg8::EpiBf16<0> E{X.MF, DM};
              pg8::gemm_phase<pg8::EpiBf16<0>, pg8::ReverseOrder, false, true>(lds, gm, S, E); }
            xcd_barrier(bar);
            { PHASE_IDS(); const Ctx X = make_ctx(args);
              if (l == NLAYER - 1) ln_phase<false, true>(X.HB, X.MF, X.ln2_g + (size_t)l * DM, X.ln2_b + (size_t)l * DM, X.out + (size_t)g * GM * DM, nullptr, gw, NGW, lane);
              else ln_phase<false, false>(X.HB, X.MF, X.ln2_g + (size_t)l * DM, X.ln2_b + (size_t)l * DM, nullptr, X.HB, gw, NGW, lane); }
            xcd_barrier(bar);
        }
    }
}

extern "C" void kernel_launch(void* const* d_in, const int* in_sizes, int n_in, void* d_out, int out_size, void* d_ws, size_t ws_size, hipStream_t stream) {
    static int grid = 0;
    if (grid == 0) {
        if (n_in != 15 || out_size != NTOK * DM || ws_size < WS_END) { fprintf(stderr, "kernel_launch: unexpected shapes (n_in %d, out %d, ws %zu)\n", n_in, out_size, ws_size); grid = -1; return; }
        int dev = 0, cus = 0;
        if (hipGetDevice(&dev) != hipSuccess || hipDeviceGetAttribute(&cus, hipDeviceAttributeMultiprocessorCount, dev) != hipSuccess) { grid = -1; return; }
        if (hipFuncSetAttribute((const void*)fwd_kernel, hipFuncAttributeMaxDynamicSharedMemorySize, LDS_BYTES) != hipSuccess) { fprintf(stderr, "kernel_launch: hipFuncSetAttribute failed\n"); grid = -1; return; }
        int per_cu = 0;
        if (hipOccupancyMaxActiveBlocksPerMultiprocessor(&per_cu, (const void*)fwd_kernel, NWAVES * 64, LDS_BYTES) != hipSuccess || per_cu < 1) { fprintf(stderr, "kernel_launch: occupancy query says %d\n", per_cu); }
        (void)hipGetLastError();
        grid = cus;
    }
    if (grid < 0) return;
    if (hipMemsetAsync((char*)d_ws + WS_CTL, 0, CTL_ZERO_BYTES, stream) != hipSuccess) return;
    Args a{};
    for (int i = 0; i < 15; ++i) a.in[i] = (const float*)d_in[i];
    a.out = (float*)d_out; a.ws = (unsigned char*)d_ws; a.mode = KMODE; a.pad = 0;
    hipLaunchKernelGGL(fwd_kernel, dim3(grid), dim3(NWAVES * 64), LDS_BYTES, stream, a);
}
```

```cpp
#include <hip/hip_runtime.h>
#include <cstdio>
#include <cstdint>
#ifndef KMODE
#define KMODE 0
#endif
namespace pg8 {
#define PG8_LAS __attribute__((address_space(3)))
typedef unsigned short bf16_t;
typedef short bf16x8 __attribute__((ext_vector_type(8)));
typedef float f32x4 __attribute__((ext_vector_type(4)));
typedef unsigned u32x4 __attribute__((ext_vector_type(4)));
constexpr int BM = 256, BK = 64, HALF = 128, HTB = HALF * BK * 2  , STAGE_BYTES = 8 * HTB, NXCD = 8, WGM = 4;

__host__ __device__ __forceinline__ int lds_byte(int r, int c) { const int st = (r >> 4) * 2 + (c >> 5), rr = r & 15, cc = c & 31, ob = rr * 64 + cc * 2; return st * 1024 + (ob ^ (((ob >> 9) & 1) << 5)); }
__host__ __device__ __forceinline__ void stage_rc(int b, int& R, int& C) { const int st = b / 1024, sb = b % 1024, swz = sb ^ (((sb >> 9) & 1) << 5); R = (st >> 1) * 16 + swz / 64; C = (st & 1) * 32 + (swz % 64) / 2; }
__host__ __device__ __forceinline__ int perm32(int rho) { const int n = rho >> 4, i = rho & 15; return 8 * (i >> 2) + 4 * n + (i & 3); }

struct Unit { int pm, pn; };
struct Gemm { const bf16_t* A; const bf16_t* Bt; int M, N, K; };

struct StaticOrder {
    int nM, nN, nwg, G, c;
    __host__ __device__ void init(int M, int N, int G_, int c_) { nM = M / BM; nN = N / BM; nwg = nM * nN; G = G_; c = c_; }
    __host__ __device__ bool next(int i, Unit& u) const {
        const long L = (long)i * G + c; if (L >= nwg) return false;
        int wgid = (int)L; { const int q = nwg / NXCD, r = nwg % NXCD, xcd = wgid % NXCD, off = wgid / NXCD; wgid = (xcd < r ? xcd * (q + 1) : r * (q + 1) + (xcd - r) * q) + off; }
        const int nig = WGM * nN, gid = wgid / nig, fm = gid * WGM, gsz = (nM - fm) < WGM ? (nM - fm) : WGM;
        u.pm = fm + ((wgid % nig) % gsz); u.pn = (wgid % nig) / gsz; return true;
    }
    __device__ __forceinline__ void a_ready(const Unit&) const {}
    __device__ __forceinline__ void done(const Unit&) const {}
};
struct ReverseOrder : StaticOrder {
    __host__ __device__ bool next(int i, Unit& u) const { const int rounds = nwg / G; if (i >= rounds) return false; return StaticOrder::next(rounds - 1 - i, u); }
};


__device__ __forceinline__ unsigned cvt_pk_bf16(float lo, float hi) { unsigned r; asm volatile("v_cvt_pk_bf16_f32 %0, %1, %2" : "=v"(r) : "v"(lo), "v"(hi)); return r; }

template <int ACT  > struct EpiBf16 {
    static constexpr bool PERM = true, AFTER_DRAIN = false;
    bf16_t* O; int ldc;
    __device__ __forceinline__ void operator()(const f32x4 (&acc)[2][2][4][2], const Unit& u, int wr, int wc, int fr, int fq) const {
        const int row0 = u.pm * BM + wr * 64 + fr; const int col0 = u.pn * BM + wc * 32 + 8 * fq;
#pragma unroll
        for (int ai = 0; ai < 2; ++ai)
#pragma unroll
            for (int m = 0; m < 4; ++m) { bf16_t* rowp = O + (size_t)(row0 + ai * HALF + m * 16) * ldc + col0;
#pragma unroll
                for (int bj = 0; bj < 2; ++bj) { f32x4 v0 = acc[ai][bj][m][0], v1 = acc[ai][bj][m][1];
                    if (ACT == 1) {
#pragma unroll
                        for (int j = 0; j < 4; ++j) { const float a = fmaxf(v0[j], 0.f), b = fmaxf(v1[j], 0.f); v0[j] = a * a; v1[j] = b * b; } }
                    u32x4 w; w.x = cvt_pk_bf16(v0[0], v0[1]); w.y = cvt_pk_bf16(v0[2], v0[3]); w.z = cvt_pk_bf16(v1[0], v1[1]); w.w = cvt_pk_bf16(v1[2], v1[3]);
                    *(u32x4*)(rowp + bj * HALF) = w; } }
    }
};
struct EpiF32 {
    static constexpr bool PERM = false, AFTER_DRAIN = false;
    float* C; int ldc;
    __device__ __forceinline__ void operator()(const f32x4 (&acc)[2][2][4][2], const Unit& u, int wr, int wc, int fr, int fq) const {
        const int row0 = u.pm * BM + wr * 64 + fr, col0 = u.pn * BM + wc * 32 + 4 * fq;
#pragma unroll
        for (int ai = 0; ai < 2; ++ai)
#pragma unroll
            for (int m = 0; m < 4; ++m) { float* rowp = C + (size_t)(row0 + ai * HALF + m * 16) * ldc + col0;
#pragma unroll
                for (int bj = 0; bj < 2; ++bj)
#pragma unroll
                    for (int n = 0; n < 2; ++n) *(f32x4*)(rowp + bj * HALF + n * 16) = acc[ai][bj][m][n]; }
    }
};

struct EpiZ {
    static constexpr bool PERM = true, AFTER_DRAIN = false;
    bf16_t* Z;
    __device__ __forceinline__ void operator()(const f32x4 (&acc)[2][2][4][2], const Unit& u, int wr, int wc, int fr, int fq) const {
        const int pn = u.pn; const size_t Mr = 16384;
        bool blocked; int H = 4, c0; bf16_t* base;
        if (pn < 2) { blocked = true; H = 4; base = Z + Mr * 4096; c0 = pn * 256; }
        else if (pn < 4) { blocked = true; H = 4; base = Z + Mr * 4096 + Mr * 512; c0 = (pn - 2) * 256; }
        else if (pn < 8) { blocked = false; base = Z; c0 = (pn - 4) * 256; }
        else if (pn < 12) { blocked = false; base = Z; c0 = 1024 + (pn - 8) * 256; }
        else if (pn < 24) { blocked = true; H = 8; base = Z + Mr * 4096 + Mr * 1024 + (size_t)((pn - 12) >> 2) * Mr * 1024; c0 = ((pn - 12) & 3) * 256; }
        else if (pn < 28) { blocked = false; base = Z; c0 = 2048 + (pn - 24) * 256; }
        else { blocked = false; base = Z; c0 = 3072 + (pn - 28) * 256; }
        const int row0 = u.pm * BM + wr * 64 + fr, cl = c0 + wc * 32 + 8 * fq;
#pragma unroll
        for (int ai = 0; ai < 2; ++ai)
#pragma unroll
            for (int m = 0; m < 4; ++m) { const int row = row0 + ai * HALF + m * 16;
#pragma unroll
                for (int bj = 0; bj < 2; ++bj) { const f32x4 v0 = acc[ai][bj][m][0], v1 = acc[ai][bj][m][1]; const int c = cl + bj * HALF;
                    u32x4 w; w.x = cvt_pk_bf16(v0[0], v0[1]); w.y = cvt_pk_bf16(v0[2], v0[3]); w.z = cvt_pk_bf16(v1[0], v1[1]); w.w = cvt_pk_bf16(v1[2], v1[3]);
                    bf16_t* p = blocked ? base + ((size_t)((((row >> 6) * H + (c >> 7)) * 8 + ((c >> 4) & 7)) * 64 + (row & 63))) * 16 + (c & 15)
                                        : base + (size_t)row * 4096 + c;
                    *(u32x4*)p = w; } }
    }
};

template <class Epi, class Sched, bool ALIGN_EPI = false, bool SP2 = false>
__device__ __forceinline__ void gemm_phase(PG8_LAS unsigned char* lds, const Gemm g, const Sched& S, const Epi& E) {
    int tid_o = threadIdx.x; asm volatile("" : "+v"(tid_o));
    const int tid = tid_o, wid = __builtin_amdgcn_readfirstlane(tid >> 6), lane = tid & 63, wr = wid >> 2, wc = wid & 3, fr = lane & 15, fq = lane >> 4;
    const int K = g.K, nt = K / BK;
    unsigned voffA[2], voffB[2];
#pragma unroll
    for (int i = 0; i < 2; ++i) { int R, C; stage_rc(tid * 16 + i * 8192, R, C); const int Rb = Epi::PERM ? ((R & ~31) + perm32(R & 31)) : R;
        voffA[i] = (unsigned)(R * K + C) * 2u; voffB[i] = (unsigned)(Rb * K + C) * 2u; }
    const size_t kstep = (size_t)(BK * 2);
    const size_t hstep = (size_t)HALF * K * 2;
    const size_t tstep = 2 * hstep;
    const unsigned ldsw = (unsigned)wid * 1024u;
    const int aoff = lds_byte(wr * 64 + fr, fq * 8), boff = lds_byte(wc * 32 + fr, fq * 8);
#define PG8_SA(b, h) (((b) * 2 + (h)) * HTB)
#define PG8_SB(b, h) ((4 + (b) * 2 + (h)) * HTB)
#define PG8_STAGE(bufoff, gbase, voff) do { _Pragma("unroll") for (int _i = 0; _i < 2; ++_i) \
        __builtin_amdgcn_global_load_lds((const unsigned*)((const char*)(gbase) + (voff)[_i]), (PG8_LAS unsigned*)(lds + (bufoff) + ldsw + _i * 8192), 16, 0, 0); } while (0)
#define PG8_LDA(dst, b, h) do { _Pragma("unroll") for (int m = 0; m < 4; ++m) _Pragma("unroll") for (int k = 0; k < 2; ++k) dst[m][k] = *(const PG8_LAS bf16x8*)(lds + PG8_SA(b, h) + aoff + m * 2048 + k * 1024); } while (0)
#define PG8_LDB(dst, b, h) do { _Pragma("unroll") for (int n = 0; n < 2; ++n) _Pragma("unroll") for (int k = 0; k < 2; ++k) dst[n][k] = *(const PG8_LAS bf16x8*)(lds + PG8_SB(b, h) + boff + n * 2048 + k * 1024); } while (0)
#define PG8_MMA(ai, bj, At, Bt) do { __builtin_amdgcn_s_setprio(1); _Pragma("unroll") for (int m = 0; m < 4; ++m) _Pragma("unroll") for (int n = 0; n < 2; ++n) _Pragma("unroll") for (int k = 0; k < 2; ++k) \
        acc[ai][bj][m][n] = __builtin_amdgcn_mfma_f32_16x16x32_bf16(Bt[n][k], At[m][k], acc[ai][bj][m][n], 0, 0, 0); __builtin_amdgcn_s_setprio(0); } while (0)
#define PG8_WAIT_V(n) asm volatile("s_waitcnt vmcnt(" #n ")" ::: "memory")
#define PG8_WAIT_L(n) asm volatile("s_waitcnt lgkmcnt(" #n ")" ::: "memory")
#define PG8_BAR __builtin_amdgcn_s_barrier()
#define PG8_SCHED __builtin_amdgcn_sched_barrier(0)
    Unit cur, nxt; int ui = 0;
    if (!S.next(0, cur)) return;
    f32x4 acc[2][2][4][2];
#pragma unroll
    for (int a = 0; a < 2; ++a)
#pragma unroll
        for (int b = 0; b < 2; ++b)
#pragma unroll
            for (int m = 0; m < 4; ++m)
#pragma unroll
                for (int n = 0; n < 2; ++n) acc[a][b][m][n] = (f32x4){0.f, 0.f, 0.f, 0.f};
    bf16x8 At[4][2], B0[2][2], B1[2][2];
    const char* cA = (const char*)g.A + (size_t)cur.pm * tstep; const char* cB = (const char*)g.Bt + (size_t)cur.pn * tstep;
    S.a_ready(cur);
    if constexpr (SP2) {
        PG8_STAGE(PG8_SB(0, 0), cB, voffB); PG8_STAGE(PG8_SB(0, 1), cB + hstep, voffB); PG8_STAGE(PG8_SA(0, 0), cA, voffA); PG8_STAGE(PG8_SA(0, 1), cA + hstep, voffA);
        if (wr == 1) PG8_BAR;
        PG8_WAIT_V(2); PG8_BAR;
        PG8_STAGE(PG8_SB(1, 0), cB + kstep, voffB); PG8_STAGE(PG8_SA(1, 0), cA + kstep, voffA); PG8_STAGE(PG8_SB(1, 1), cB + hstep + kstep, voffB);
        PG8_WAIT_V(6); PG8_BAR;
    } else {
        PG8_STAGE(PG8_SB(0, 0), cB, voffB); PG8_STAGE(PG8_SA(0, 0), cA, voffA); PG8_STAGE(PG8_SB(0, 1), cB + hstep, voffB); PG8_STAGE(PG8_SA(0, 1), cA + hstep, voffA);
        if (wr == 1) PG8_BAR;
        PG8_WAIT_V(4); PG8_BAR;
        PG8_STAGE(PG8_SB(1, 0), cB + kstep, voffB); PG8_STAGE(PG8_SA(1, 0), cA + kstep, voffA); PG8_STAGE(PG8_SB(1, 1), cB + hstep + kstep, voffB);
        PG8_WAIT_V(6); PG8_BAR;
    }
    for (;;) {
        const bool has_next = S.next(ui + 1, nxt);
        const char* nA = has_next ? (const char*)g.A + (size_t)nxt.pm * tstep : cA; const char* nB = has_next ? (const char*)g.Bt + (size_t)nxt.pn * tstep : cB;
        for (int t = 0; t < nt; t += 2) {
            const bool last = (t == nt - 2);
            const char* a1 = cA + (size_t)(t + 1) * kstep;
            const char* a2 = last ? nA : cA + (size_t)(t + 2) * kstep; const char* b2 = last ? nB : cB + (size_t)(t + 2) * kstep;
            const char* a3 = a2 + kstep; const char* b3 = b2 + kstep;
            if (last && has_next) S.a_ready(nxt);
            if constexpr (SP2) {
            PG8_LDB(B0, 0, 0); PG8_LDB(B1, 0, 1); PG8_SCHED; PG8_LDA(At, 0, 0); PG8_STAGE(PG8_SA(1, 1), a1 + hstep, voffA);
            PG8_WAIT_V(8); PG8_WAIT_L(0); PG8_BAR; PG8_MMA(0, 0, At, B0); PG8_MMA(0, 1, At, B1); PG8_BAR; PG8_SCHED;
            PG8_LDA(At, 0, 1); PG8_STAGE(PG8_SB(0, 0), b2, voffB); PG8_STAGE(PG8_SB(0, 1), b2 + hstep, voffB); PG8_STAGE(PG8_SA(0, 0), a2, voffA);
            PG8_WAIT_V(8); PG8_WAIT_L(0); PG8_BAR; PG8_MMA(1, 0, At, B0); PG8_MMA(1, 1, At, B1); PG8_BAR; PG8_SCHED;
            PG8_LDB(B0, 1, 0); PG8_LDB(B1, 1, 1); PG8_SCHED; PG8_LDA(At, 1, 0); PG8_STAGE(PG8_SA(0, 1), a2 + hstep, voffA);
            PG8_WAIT_V(8); PG8_WAIT_L(0); PG8_BAR; PG8_MMA(0, 0, At, B0); PG8_MMA(0, 1, At, B1); PG8_BAR; PG8_SCHED;
            PG8_LDA(At, 1, 1); PG8_STAGE(PG8_SB(1, 0), b3, voffB); PG8_STAGE(PG8_SB(1, 1), b3 + hstep, voffB); PG8_STAGE(PG8_SA(1, 0), a3, voffA);
            PG8_WAIT_V(8); PG8_WAIT_L(0); PG8_BAR; PG8_MMA(1, 0, At, B0); PG8_MMA(1, 1, At, B1); PG8_BAR; PG8_SCHED;
            } else {
            PG8_LDB(B0, 0, 0); PG8_SCHED; PG8_LDA(At, 0, 0); PG8_STAGE(PG8_SA(1, 1), a1 + hstep, voffA);
            PG8_WAIT_L(8); PG8_BAR; PG8_WAIT_L(0); PG8_MMA(0, 0, At, B0); PG8_BAR; PG8_SCHED;
            PG8_LDB(B1, 0, 1); PG8_STAGE(PG8_SB(0, 0), b2, voffB);
            PG8_BAR; PG8_WAIT_L(0); PG8_MMA(0, 1, At, B1); PG8_BAR;
            PG8_LDA(At, 0, 1); PG8_STAGE(PG8_SA(0, 0), a2, voffA);
            PG8_BAR; PG8_WAIT_L(0); PG8_MMA(1, 0, At, B0); PG8_BAR; PG8_SCHED;
            PG8_STAGE(PG8_SB(0, 1), b2 + hstep, voffB);
            PG8_WAIT_V(6); PG8_BAR; PG8_MMA(1, 1, At, B1); PG8_BAR;
            PG8_LDB(B0, 1, 0); PG8_SCHED; PG8_LDA(At, 1, 0); PG8_STAGE(PG8_SA(0, 1), a2 + hstep, voffA);
            PG8_WAIT_L(8); PG8_BAR; PG8_WAIT_L(0); PG8_MMA(0, 0, At, B0); PG8_BAR; PG8_SCHED;
            PG8_LDB(B1, 1, 1); PG8_STAGE(PG8_SB(1, 0), b3, voffB);
            PG8_BAR; PG8_WAIT_L(0); PG8_MMA(0, 1, At, B1); PG8_BAR;
            PG8_LDA(At, 1, 1); PG8_STAGE(PG8_SA(1, 0), a3, voffA);
            PG8_BAR; PG8_WAIT_L(0); PG8_MMA(1, 0, At, B0); PG8_BAR; PG8_SCHED;
            PG8_STAGE(PG8_SB(1, 1), b3 + hstep, voffB);
            PG8_WAIT_V(6); PG8_BAR; PG8_MMA(1, 1, At, B1); PG8_BAR;
            }
        }
        if constexpr (ALIGN_EPI) { if (wr == 0) PG8_BAR; }
        if constexpr (!Epi::AFTER_DRAIN) { E(acc, cur, wr, wc, fr, fq); S.done(cur); }
        if (!has_next) break;
#pragma unroll
        for (int a = 0; a < 2; ++a)
#pragma unroll
            for (int b = 0; b < 2; ++b)
#pragma unroll
                for (int m = 0; m < 4; ++m)
#pragma unroll
                    for (int n = 0; n < 2; ++n) acc[a][b][m][n] = (f32x4){0.f, 0.f, 0.f, 0.f};
        cur = nxt; cA = nA; cB = nB; ++ui;
        if constexpr (ALIGN_EPI) { if (wr == 1) PG8_BAR; }
    }
    PG8_WAIT_V(0);
    if constexpr (!ALIGN_EPI) { if (wr == 0) PG8_BAR; }
    PG8_BAR;
    if constexpr (Epi::AFTER_DRAIN) { E.fused(acc, cur, wr, wc, fr, fq, lds, wid, lane); S.done(cur); }
#undef PG8_SA
#undef PG8_SB
#undef PG8_STAGE
#undef PG8_LDA
#undef PG8_LDB
#undef PG8_MMA
#undef PG8_WAIT_V
#undef PG8_WAIT_L
#undef PG8_BAR
#undef PG8_SCHED
}
}

constexpr int NWAVES = 8;
constexpr int DM = 2048, DFF = 8192, NTOK = 49152, GM = 16384, NGRP = 3, NLAYER = 2, INW = 8224, ZW = 8192;
constexpr int ZC_GQ = 0, ZC_GK = 512, ZC_GV = 1024, ZC_GOG = 2048, ZC_HQ = 3072, ZC_HFF = 4096, ZC_HFB = 5120, ZC_HI = 6144, ZC_HOG = 7168;
constexpr float LN_EPS = 1e-5f, RMS_EPS = 1e-6f, ALPHA = 1.41421356237f, LOG2E = 1.44269504089f;
constexpr int NCHUNK = GM / 64;
constexpr int ST_CHUNK = 524288;
constexpr size_t MiB = 1u << 20;
constexpr size_t WS_CTL = 0, CTL_ZERO_BYTES = 1 * MiB;
constexpr size_t WS_WIN = 2 * MiB, WS_WOUT = 66 * MiB, WS_WUP = 82 * MiB, WS_WDN = 146 * MiB, WS_WGLR = 210 * MiB;
constexpr size_t WS_HB = 212 * MiB;
constexpr size_t WS_Z = 276 * MiB;
constexpr size_t WS_BG = 532 * MiB;
constexpr size_t WS_O = 596 * MiB;
constexpr size_t WS_ST = 660 * MiB;
constexpr size_t WS_TOT = 916 * MiB;
constexpr size_t WS_STS = 920 * MiB;
constexpr size_t WS_TOTS = 984 * MiB;
constexpr size_t WS_END = 985 * MiB;
constexpr int CW_BAR = 4096;
constexpr int RING_BYTES = 131072;
constexpr int LDS_BYTES = 160 * 1024, MISC_OFF = LDS_BYTES - 256;
constexpr int L_B32 = 0, L_KR = 33792, L_QR = 51200, L_QH = 68608, L_V = 86016, L_P = 119808, L_RED = 129024;
constexpr int B32_STR = 528, K_STR = 272, P_STR = 144, KT_STR = 144;
constexpr int NSC = GM / 256;
__host__ __device__ __forceinline__ int sc_order(int s) { return s < 32 ? (s >> 2) * 8 + 4 + (s & 3) : ((s - 32) >> 2) * 8 + (s & 3); }
constexpr int SV_KT = 135168, KTW_BYTES = 2560;

#define GAS __attribute__((address_space(1)))
#define LAS __attribute__((address_space(3)))
typedef unsigned short bf16;
typedef unsigned v4u __attribute__((ext_vector_type(4)));
typedef float f32x4 __attribute__((ext_vector_type(4)));
typedef short bf16x8 __attribute__((ext_vector_type(8)));
typedef GAS unsigned gu32;
typedef GAS unsigned long long gu64;
#define RLX_AGENT __ATOMIC_RELAXED, __HIP_MEMORY_SCOPE_AGENT
#define LDS_WAIT() asm volatile("s_waitcnt lgkmcnt(0)" ::: "memory")
#define VM_WAIT() asm volatile("s_waitcnt vmcnt(0)" ::: "memory")
__device__ __forceinline__ unsigned long long rt() { return __builtin_amdgcn_s_memrealtime(); }
__device__ __forceinline__ unsigned f2bf(float f) { unsigned u = __builtin_bit_cast(unsigned, f); return (u + 0x7fffu + ((u >> 16) & 1u)) >> 16; }
__device__ __forceinline__ unsigned pk2(float lo, float hi) { return f2bf(lo) | (f2bf(hi) << 16); }

#define XB_TMO      128
#define XB_XCNT(j)  (256  + 64 * (j))
#define XB_XSUB(j)  (1280 + 64 * (j))
#define XB_XGEN(j)  (2304 + 64 * (j))
#define XB_TOP      3328
#define XB_TOPGEN   3392
#define XCD_BAR_WORDS 3456
#define XB_SPIN_CAP (1u << 18)

__device__ __forceinline__ unsigned xb_ld(unsigned* p)              { return __hip_atomic_load(p, __ATOMIC_RELAXED, __HIP_MEMORY_SCOPE_AGENT); }
__device__ __forceinline__ unsigned xb_add(unsigned* p, unsigned v) { return __hip_atomic_fetch_add(p, v, __ATOMIC_RELAXED, __HIP_MEMORY_SCOPE_AGENT); }
__device__ __forceinline__ unsigned xb_xcc_id() { return (unsigned)__builtin_amdgcn_s_getreg((3 << 11) | 20) & 0xFu; }
#define XB_SPIN(cond, bar) do { unsigned _sp = 0; while (cond) { __builtin_amdgcn_s_sleep(1); \
    if ((++_sp & 255u) == 0u) { if (xb_ld(&(bar)[XB_TMO])) break; if (_sp > XB_SPIN_CAP) { atomicAdd(&(bar)[XB_TMO], 1u); break; } } } } while (0)

struct XcdBarrier {
    unsigned* bar; unsigned x;
    volatile LAS unsigned* st;
};

__device__ __forceinline__ XcdBarrier xcd_barrier_post(unsigned* bar, volatile LAS unsigned* st) {
    XcdBarrier b; b.bar = bar; b.x = xb_xcc_id(); b.st = st;
    if (threadIdx.x == 0) (void)xb_add(&bar[XB_XCNT(b.x)], 1u);
    return b;
}
__device__ __forceinline__ void xcd_barrier_complete(unsigned* bar, unsigned x, unsigned& nloc, unsigned& nx) {
    const unsigned G = gridDim.x * gridDim.y * gridDim.z;
    unsigned sum, cnt, mine, sp = 0u;
    for (;;) {
        sum = 0u; cnt = 0u; mine = 0u;
#pragma unroll
        for (unsigned j = 0; j < 16; ++j) { const unsigned c = xb_ld(&bar[XB_XCNT(j)]); sum += c; cnt += (c > 0u) ? 1u : 0u; mine = (j == x) ? c : mine; }
        if (sum == G) break;
        __builtin_amdgcn_s_sleep(1);
        if ((++sp & 255u) == 0u) { if (xb_ld(&bar[XB_TMO])) break; if (sp > XB_SPIN_CAP) { atomicAdd(&bar[XB_TMO], 1u); break; } }
    }
    nloc = mine > 0u ? mine : 1u; nx = cnt > 0u ? cnt : 1u;
}

__device__ __forceinline__ void xcd_barrier(const XcdBarrier& b) {
    asm volatile("s_waitcnt vmcnt(0)" ::: "memory");
    __syncthreads();
    if (threadIdx.x == 0) {
        unsigned* bar = b.bar;
        __builtin_amdgcn_s_waitcnt(0);
        unsigned nloc = b.st[0], nx = b.st[1];
        if (nloc == 0u) { xcd_barrier_complete(bar, b.x, nloc, nx); b.st[0] = nloc; b.st[1] = nx; }
        const unsigned old = xb_add(&bar[XB_XSUB(b.x)], 1u);
        const unsigned gen = old / nloc;
        if (old + 1u == (gen + 1u) * nloc) {
            __builtin_amdgcn_fence(__ATOMIC_RELEASE, "agent");
            asm volatile("s_waitcnt vmcnt(0)" ::: "memory");
            const unsigned og = xb_add(&bar[XB_TOP], 1u);
            const unsigned tg = og / nx;
            if (og + 1u == (tg + 1u) * nx) xb_add(&bar[XB_TOPGEN], 1u);
            else XB_SPIN(xb_ld(&bar[XB_TOPGEN]) == tg, bar);
            __builtin_amdgcn_fence(__ATOMIC_ACQUIRE, "agent");
            xb_add(&bar[XB_XGEN(b.x)], 1u);
            asm volatile("s_waitcnt vmcnt(0)" ::: "memory");
        } else {
            XB_SPIN(xb_ld(&bar[XB_XGEN(b.x)]) == gen, bar);
            __builtin_amdgcn_fence(__ATOMIC_ACQUIRE, "agent");
            asm volatile("s_waitcnt vmcnt(0)" ::: "memory");
        }
    }
    __syncthreads();
}

typedef short s16x4 __attribute__((ext_vector_type(4)));
typedef float f32x2 __attribute__((ext_vector_type(2)));
typedef unsigned v2u __attribute__((ext_vector_type(2)));
__device__ __forceinline__ unsigned pkbf(float lo, float hi) { return pg8::cvt_pk_bf16(lo, hi); }
__device__ __forceinline__ float wave_sum(float v) {
#pragma unroll
    for (int o = 1; o < 64; o <<= 1) v += __shfl_xor(v, o);
    return v;
}
template <int CTRL, int RM> __device__ __forceinline__ float dpp_add(float v) {
    return v + __builtin_bit_cast(float, __builtin_amdgcn_update_dpp(0, __builtin_bit_cast(int, v), CTRL, RM, 0xf, true));
}
__device__ __forceinline__ float wave_scan_incl(float v, int) {
    v = dpp_add<0x111, 0xf>(v); v = dpp_add<0x112, 0xf>(v); v = dpp_add<0x114, 0xf>(v); v = dpp_add<0x118, 0xf>(v);
    v = dpp_add<0x142, 0xa>(v); v = dpp_add<0x143, 0xc>(v); return v;
}
#define DPP16(CTL) "v_add_f32_dpp %0, %0, %0 " CTL "\n\t" "v_add_f32_dpp %1, %1, %1 " CTL "\n\t" "v_add_f32_dpp %2, %2, %2 " CTL "\n\t" "v_add_f32_dpp %3, %3, %3 " CTL "\n\t" "v_add_f32_dpp %4, %4, %4 " CTL "\n\t" "v_add_f32_dpp %5, %5, %5 " CTL "\n\t" "v_add_f32_dpp %6, %6, %6 " CTL "\n\t" "v_add_f32_dpp %7, %7, %7 " CTL "\n\t" "v_add_f32_dpp %8, %8, %8 " CTL "\n\t" "v_add_f32_dpp %9, %9, %9 " CTL "\n\t" "v_add_f32_dpp %10, %10, %10 " CTL "\n\t" "v_add_f32_dpp %11, %11, %11 " CTL "\n\t" "v_add_f32_dpp %12, %12, %12 " CTL "\n\t" "v_add_f32_dpp %13, %13, %13 " CTL "\n\t" "v_add_f32_dpp %14, %14, %14 " CTL "\n\t" "v_add_f32_dpp %15, %15, %15 " CTL "\n\t"
__device__ __forceinline__ void wave_scan16(float* v) {
    asm volatile("s_nop 1\n\t"
        DPP16("row_shr:1 row_mask:0xf bank_mask:0xf") DPP16("row_shr:2 row_mask:0xf bank_mask:0xf") DPP16("row_shr:4 row_mask:0xf bank_mask:0xf") DPP16("row_shr:8 row_mask:0xf bank_mask:0xf")
        DPP16("row_bcast:15 row_mask:0xa bank_mask:0xf") DPP16("row_bcast:31 row_mask:0xc bank_mask:0xf") "s_nop 1"
        : "+v"(v[0]), "+v"(v[1]), "+v"(v[2]), "+v"(v[3]), "+v"(v[4]), "+v"(v[5]), "+v"(v[6]), "+v"(v[7]), "+v"(v[8]), "+v"(v[9]), "+v"(v[10]), "+v"(v[11]), "+v"(v[12]), "+v"(v[13]), "+v"(v[14]), "+v"(v[15]));
}
__device__ __forceinline__ void unpack8(const v4u v, float* f) {
    f[0] = __uint_as_float(v.x << 16); f[1] = __uint_as_float(v.x & 0xffff0000u); f[2] = __uint_as_float(v.y << 16); f[3] = __uint_as_float(v.y & 0xffff0000u);
    f[4] = __uint_as_float(v.z << 16); f[5] = __uint_as_float(v.z & 0xffff0000u); f[6] = __uint_as_float(v.w << 16); f[7] = __uint_as_float(v.w & 0xffff0000u);
}
__device__ __forceinline__ v4u pack8(const float* f) { v4u o; o.x = pkbf(f[0], f[1]); o.y = pkbf(f[2], f[3]); o.z = pkbf(f[4], f[5]); o.w = pkbf(f[6], f[7]); return o; }
__device__ __forceinline__ s16x4 lds_tr(LAS const unsigned char* p) { return __builtin_bit_cast(s16x4, __builtin_amdgcn_ds_read_tr16_b64_v4i16((LAS s16x4*)p)); }
__device__ __forceinline__ bf16x8 tr_pair(LAS const unsigned char* p0, LAS const unsigned char* p1) {
    const s16x4 a = lds_tr(p0), b = lds_tr(p1); return __builtin_shufflevector(a, b, 0, 1, 2, 3, 4, 5, 6, 7);
}
__device__ __forceinline__ float fexp2(float x) { return __builtin_amdgcn_exp2f(x); }
__device__ __forceinline__ float frcp(float x) { return __builtin_amdgcn_rcpf(x); }
__device__ __forceinline__ float lane63(float v) { return __builtin_bit_cast(float, __builtin_amdgcn_readlane(__builtin_bit_cast(int, v), 63)); }
__device__ __forceinline__ float flog2(float x) { return __builtin_amdgcn_logf(x); }

constexpr size_t ZB_GQ = (size_t)GM * 4096, ZB_GK = ZB_GQ + (size_t)GM * 512, ZB_HQ = ZB_GK + (size_t)GM * 512, ZB_HFF = ZB_HQ + (size_t)GM * 1024, ZB_HFB = ZB_HFF + (size_t)GM * 1024;
constexpr int ZRW = 4096, ZR_GV = 0, ZR_GOG = 1024, ZR_HI = 2048, ZR_HOG = 3072;
__device__ __forceinline__ size_t blk_off(int chunk, int H, int hh, int w) { return (size_t)((chunk * H + hh) * 8 + w) * 1024; }
struct Ctx {
    const float *x_prompt, *x_sample, *w_in, *w_lr2, *b_lr, *gla_g, *hg_g, *lowb, *w_out, *ln1_g, *ln1_b, *w_up, *w_down, *ln2_g, *ln2_b;
    float* out;
    bf16 *Win_t, *Wout_t, *Wup_t, *Wdn_t, *Wglr_t, *HB, *Z, *O, *ST;
    float *BG, *TOT, *TOTS; bf16 *STS, *MF;
};

__device__ __forceinline__ void transpose_item(const float* W, int N, int kb, int nb, bf16* dst, int K, LAS float* scr, int lane) {
    const int k0 = 64 * kb, n0 = 32 * nb;
#pragma unroll 8
    for (int i = 0; i < 32; ++i) { const int kk = 2 * i + (lane >> 5); scr[kk * 33 + (lane & 31)] = W[(size_t)(k0 + kk) * N + n0 + (lane & 31)]; }
    LDS_WAIT(); asm volatile("" ::: "memory");
    const int c = lane & 7;
#pragma unroll
    for (int j = 0; j < 4; ++j) { const int n = (lane >> 3) + 8 * j; const LAS float* s = scr + (8 * c) * 33 + n;
        v4u o; o.x = pkbf(s[0 * 33], s[1 * 33]); o.y = pkbf(s[2 * 33], s[3 * 33]); o.z = pkbf(s[4 * 33], s[5 * 33]); o.w = pkbf(s[6 * 33], s[7 * 33]);
        *(GAS v4u*)(dst + (size_t)n * K + k0 + 8 * c) = o; }
    LDS_WAIT(); asm volatile("" ::: "memory");
}
__device__ __forceinline__ void prologue_weights(const Ctx& X, LAS unsigned char* lds, int gw, int NGW, int wave, int lane) {
    LAS float* scr = (LAS float*)(lds + wave * 16384);
    constexpr int I_IN = 32 * 257, I_OUT = 32 * 64, I_UP = 32 * 256, I_DN = 128 * 64, I_L = I_IN + I_OUT + I_UP + I_DN;
    for (int it = gw; it < NLAYER * I_L; it += NGW) {
        const int l = it / I_L; int r = it % I_L;
        if (r < I_IN) { const int kb = r / 257, nb = r % 257;
            bf16* dst = (nb < 96) ? X.Win_t + ((size_t)l * ZW + 32 * nb) * DM : (nb == 96) ? X.Wglr_t + (size_t)l * 32 * DM : X.Win_t + ((size_t)l * ZW + 32 * (nb - 1)) * DM;
            transpose_item(X.w_in + (size_t)l * DM * INW, INW, kb, nb, dst, DM, scr, lane); continue; }
        r -= I_IN;
        if (r < I_OUT) { const int kb = r / 64, nb = r % 64; transpose_item(X.w_out + (size_t)l * DM * DM, DM, kb, nb, X.Wout_t + ((size_t)l * DM + 32 * nb) * DM, DM, scr, lane); continue; }
        r -= I_OUT;
        if (r < I_UP) { const int kb = r / 256, nb = r % 256; transpose_item(X.w_up + (size_t)l * DM * DFF, DFF, kb, nb, X.Wup_t + ((size_t)l * DFF + 32 * nb) * DM, DM, scr, lane); continue; }
        r -= I_UP;
        { const int kb = r / 64, nb = r % 64; transpose_item(X.w_down + (size_t)l * DFF * DM, DM, kb, nb, X.Wdn_t + ((size_t)l * DM + 32 * nb) * DFF, DFF, scr, lane); }
    }
}
__device__ __forceinline__ void cvt_group(const float* xg, bf16* HB, int gtid, int NT) {
    for (int i = gtid; i < GM * DM / 8; i += NT) {
        const f32x4 a = ((const GAS f32x4*)xg)[2 * i], b = ((const GAS f32x4*)xg)[2 * i + 1];
        v4u o; o.x = pkbf(a.x, a.y); o.y = pkbf(a.z, a.w); o.z = pkbf(b.x, b.y); o.w = pkbf(b.z, b.w);
        ((GAS v4u*)HB)[i] = o; }
}
template <bool RES_F32, bool OUT_F32>
__device__ __forceinline__ void ln_phase(const void* res, const bf16* mf, const float* gam, const float* bet, float* H, bf16* HB, int gw, int NGW, int lane) {
    for (int m = gw; m < GM; m += NGW) {
        f32x4 v[8]; float s = 0.f;
        const GAS v2u* mr = (const GAS v2u*)(mf + (size_t)m * DM) + lane;
#pragma unroll
        for (int j = 0; j < 8; ++j) { f32x4 r;
            if (RES_F32) r = ((const GAS f32x4*)((const float*)res + (size_t)m * DM) + lane)[64 * j];
            else { const v2u w = ((const GAS v2u*)((const bf16*)res + (size_t)m * DM) + lane)[64 * j];
                r = (f32x4){__uint_as_float(w.x << 16), __uint_as_float(w.x & 0xffff0000u), __uint_as_float(w.y << 16), __uint_as_float(w.y & 0xffff0000u)}; }
            const v2u w = mr[64 * j];
            const f32x4 f = (f32x4){__uint_as_float(w.x << 16), __uint_as_float(w.x & 0xffff0000u), __uint_as_float(w.y << 16), __uint_as_float(w.y & 0xffff0000u)};
            v[j] = r * ALPHA + f; s += (v[j].x + v[j].y) + (v[j].z + v[j].w); }
        const float mean = wave_sum(s) * (1.f / DM); float s2 = 0.f;
#pragma unroll
        for (int j = 0; j < 8; ++j) { v[j] = v[j] - mean; s2 += (v[j].x * v[j].x + v[j].y * v[j].y) + (v[j].z * v[j].z + v[j].w * v[j].w); }
        const float rstd = 1.f / sqrtf(wave_sum(s2) * (1.f / DM) + LN_EPS);
#pragma unroll
        for (int j = 0; j < 8; ++j) { const f32x4 g4 = ((const GAS f32x4*)gam)[lane + 64 * j], b4 = ((const GAS f32x4*)bet)[lane + 64 * j];
            const f32x4 o = v[j] * rstd * g4 + b4;
            if (OUT_F32) ((GAS f32x4*)(H + (size_t)m * DM) + lane)[64 * j] = o;
            else { v2u w; w.x = pkbf(o.x, o.y); w.y = pkbf(o.z, o.w); ((GAS v2u*)(HB + (size_t)m * DM) + lane)[64 * j] = w; } }
    }
}

__device__ __forceinline__ void gate_unit(const Ctx& X, int l, int chunk, LAS unsigned char* lds, int tid, int lane, int wave) {
    const int fr = lane & 15, fq = lane >> 4;
    const bf16* A = X.HB + (size_t)chunk * 64 * DM; const bf16* Bw = X.Wglr_t + (size_t)l * 32 * DM;
    f32x4 acc[4][2];
#pragma unroll
    for (int m = 0; m < 4; ++m)
#pragma unroll
        for (int n = 0; n < 2; ++n) acc[m][n] = (f32x4){0.f, 0.f, 0.f, 0.f};
#pragma unroll 2
    for (int ks = 0; ks < 8; ++ks) { const int k0 = 256 * wave + 32 * ks + 8 * fq;
        bf16x8 a[4], b[2];
#pragma unroll
        for (int m = 0; m < 4; ++m) a[m] = *(const GAS bf16x8*)(A + (size_t)(16 * m + fr) * DM + k0);
#pragma unroll
        for (int n = 0; n < 2; ++n) b[n] = *(const GAS bf16x8*)(Bw + (size_t)(16 * n + fr) * DM + k0);
#pragma unroll
        for (int m = 0; m < 4; ++m)
#pragma unroll
            for (int n = 0; n < 2; ++n) acc[m][n] = __builtin_amdgcn_mfma_f32_16x16x32_bf16(a[m], b[n], acc[m][n], 0, 0, 0); }
    LAS float* part = (LAS float*)lds;
#pragma unroll
    for (int m = 0; m < 4; ++m)
#pragma unroll
        for (int n = 0; n < 2; ++n)
#pragma unroll
            for (int j = 0; j < 4; ++j) part[(wave * 64 + 16 * m + 4 * fq + j) * 33 + 16 * n + fr] = acc[m][n][j];
    __syncthreads();
    LAS float* glr = (LAS float*)(lds + 8 * 64 * 33 * 4);
#pragma unroll
    for (int k = 0; k < 4; ++k) { const int idx = tid + 512 * k, t = idx >> 5, n = idx & 31; float s = 0.f;
#pragma unroll
        for (int w = 0; w < 8; ++w) s += part[(w * 64 + t) * 33 + n];
        glr[t * 36 + n] = s; }
    __syncthreads();
    const int dir = wave >> 2;
    const float* w2 = X.w_lr2 + (size_t)(l * 2 + dir) * 16 * 512; const float* bl = X.b_lr + (size_t)(l * 2 + dir) * 512;
    for (int cb = 0; cb < 2; ++cb) { const int c = 128 * (wave & 3) + 64 * cb + lane;
        float w[16];
#pragma unroll
        for (int r = 0; r < 16; ++r) w[r] = w2[r * 512 + c];
        const float bias = bl[c];
        bf16* bgcol = (bf16*)X.BG + ((size_t)(((chunk * 4 + (c >> 7)) * 8 + ((c & 127) >> 4)) * 2 + dir) * 64) * 16 + (c & 15);
#pragma unroll 4
        for (int tt = 0; tt < 64; ++tt) { const int t = dir ? 63 - tt : tt;
            const LAS f32x4* gr = (const LAS f32x4*)(glr + t * 36 + dir * 16); const f32x4 g0 = gr[0], g1 = gr[1], g2 = gr[2], g3 = gr[3];
            float pre = bias;
            pre += g0.x * w[0] + g0.y * w[1] + g0.z * w[2] + g0.w * w[3]; pre += g1.x * w[4] + g1.y * w[5] + g1.z * w[6] + g1.w * w[7];
            pre += g2.x * w[8] + g2.y * w[9] + g2.z * w[10] + g2.w * w[11]; pre += g3.x * w[12] + g3.y * w[13] + g3.z * w[14] + g3.w * w[15];
            const float gl = (fminf(pre, 0.f) - __logf(1.f + __expf(-fabsf(pre)))) * (LOG2E / 16.f);
            bgcol[(size_t)t * 16] = (bf16)(pkbf(gl, gl) & 0xffffu); } }
    __syncthreads();
}

__device__ __forceinline__ size_t st_slot(int chunk, bool hgt, int h, int dir) { return (size_t)chunk * ST_CHUNK + (hgt ? 262144 + (h * 2 + dir) * 16384 : (h * 2 + dir) * 32768); }

template <bool HGT> struct RawIn { v4u b[2]; v4u k[2]; };
template <> struct RawIn<true> { v4u k[2]; };
template <bool HGT>
__device__ __forceinline__ RawIn<HGT> pass_s_load(const Ctx& X, int chunk, int h, int dir, int lane, int c0) {
    RawIn<HGT> r; const int rt = dir ? 63 - lane : lane, w = c0 >> 4;
    if constexpr (!HGT) { const GAS v4u* bg = (const GAS v4u*)((const bf16*)X.BG + ((size_t)(((chunk * 4 + h) * 8 + w) * 2 + dir) * 64 + rt) * 16);
        r.b[0] = bg[0]; r.b[1] = bg[1];
        const GAS v4u* kp = (const GAS v4u*)(X.Z + ZB_GK + blk_off(chunk, 4, h, w) + rt * 16); r.k[0] = kp[0]; r.k[1] = kp[1];
    } else { const GAS v4u* zp = (const GAS v4u*)(X.Z + (dir ? ZB_HFB : ZB_HFF) + blk_off(chunk, 8, h, w) + rt * 16); r.k[0] = zp[0]; r.k[1] = zp[1]; }
    return r;
}
template <bool HGT, bool STORE>
__device__ __forceinline__ void pass_s_unit(const Ctx& X, int l, int sc, int h, LAS unsigned char* lds, int tid, int lane, int wave) {
    constexpr int DV = HGT ? 128 : 256, VSTR = DV * 2 + 16, NE = DV / 16, PPR = DV / 8, UNR_D = HGT ? 2 : 1, UNR_C = HGT ? 4 : 1;
    const int fr = lane & 15, fq = lane >> 4, qq = fr >> 2, p4 = fr & 3, c0 = 16 * wave;
    RawIn<HGT> cur = pass_s_load<HGT>(X, sc * 4, h, 0, lane, c0);
    RawIn<HGT> rq[HGT ? 4 : 1];
    { const int vcol = HGT ? ZR_HI + h * 128 : ZR_GV + h * 256;
#pragma unroll 4
      for (int k = 0; k < 256 * PPR / 512; ++k) { const int idx = tid + 512 * k, row = idx / PPR, pc = idx % PPR;
        const v4u v = *(const GAS v4u*)(X.Z + (size_t)(sc * 256 + row) * ZRW + vcol + pc * 8);
        *(LAS v4u*)(lds + row * VSTR + pc * 16) = v; } }
    __syncthreads();
    LAS unsigned char* kt = lds + SV_KT + wave * KTW_BYTES;
    for (int dir = 0; dir < 2; ++dir) {
        const int hd = HGT ? 8 + h * 2 + dir : h * 2 + dir;
        if constexpr (HGT) {
#pragma unroll
            for (int q4 = 0; q4 < 4; ++q4) rq[q4] = pass_s_load<HGT>(X, sc * 4 + (dir ? 3 - q4 : q4), h, dir, lane, c0); }
        float lbv[16];
        if (HGT) {
#pragma unroll
            for (int i = 0; i < 16; ++i) lbv[i] = 0.f;
            if (l != 0) { const float* lp = X.lowb + (size_t)dir * 2 * 1024 + h * 128 + c0;
#pragma unroll
                for (int i = 0; i < 16; ++i) lbv[i] = frcp(1.f + __expf(lp[i] - lp[1024 + i])); } }
        f32x4 acc[NE];
        if (STORE) { const bf16* sin = X.STS + st_slot(sc, HGT, h, dir);
#pragma unroll
            for (int et = 0; et < NE; ++et) { const v2u w = *(const GAS v2u*)(sin + (size_t)((et * 4 + (wave >> 1)) * 64 + fr + 16 * (2 * (wave & 1) + (fq >> 1))) * 8 + 4 * (fq & 1));
                acc[et] = (f32x4){__uint_as_float(w.x << 16), __uint_as_float(w.x & 0xffff0000u), __uint_as_float(w.y << 16), __uint_as_float(w.y & 0xffff0000u)}; }
        } else {
#pragma unroll
            for (int et = 0; et < NE; ++et) acc[et] = (f32x4){0.f, 0.f, 0.f, 0.f}; }
        float run[16];
#pragma unroll
        for (int i = 0; i < 16; ++i) run[i] = 0.f;
#pragma unroll UNR_C
        for (int cc = 0; cc < 4; ++cc) { const int ci = dir ? 3 - cc : cc, chunk = sc * 4 + ci;
            RawIn<HGT> nxt = cur;
            if constexpr (HGT) cur = rq[cc];
            else { if (cc < 3) nxt = pass_s_load<HGT>(X, sc * 4 + (dir ? 2 - cc : cc + 1), h, dir, lane, c0);
                   else if (dir == 0) nxt = pass_s_load<HGT>(X, sc * 4 + 3, h, 1, lane, c0); }
            float bc[16], kr[16];
            if constexpr (!HGT) {
                unpack8(cur.b[0], bc); unpack8(cur.b[1], bc + 8); wave_scan16(bc);
                unpack8(cur.k[0], kr); unpack8(cur.k[1], kr + 8);
            } else {
                float zf[16]; unpack8(cur.k[0], zf); unpack8(cur.k[1], zf + 8);
#pragma unroll
                for (int i = 0; i < 16; ++i) {
                    const float z = __builtin_amdgcn_fmed3f(zf[i], -60.f, 60.f), e = fexp2(z * -LOG2E), sig = frcp(1.f + e), oml = 1.f - lbv[i];
                    kr[i] = oml - oml * sig;
                    bc[i] = flog2(lbv[i] + oml * sig); }
                wave_scan16(bc);
            }
            if (STORE) { bf16* slot = X.ST + st_slot(chunk, HGT, h, dir);
#pragma unroll
                for (int et = 0; et < NE; ++et) { v2u w; w.x = pkbf(acc[et][0], acc[et][1]); w.y = pkbf(acc[et][2], acc[et][3]);
                    *(GAS v2u*)(slot + (size_t)((et * 4 + (wave >> 1)) * 64 + fr + 16 * (2 * (wave & 1) + (fq >> 1))) * 8 + 4 * (fq & 1)) = w; }
                if (cc == 3) { cur = nxt; break; } }
            float kh[16];
#pragma unroll
            for (int i = 0; i < 16; ++i) { const float bl = lane63(bc[i]); kh[i] = kr[i] * fexp2(bl - bc[i]); run[i] += bl; }
            { const v4u k0 = pack8(kh), k1 = pack8(kh + 8); const unsigned kw[8] = {k0.x, k0.y, k0.z, k0.w, k1.x, k1.y, k1.z, k1.w};
#pragma unroll
              for (int i = 0; i < 16; ++i) *(LAS unsigned short*)(kt + i * KT_STR + lane * 2) = (unsigned short)((i & 1) ? (kw[i >> 1] >> 16) : (kw[i >> 1] & 0xffffu)); }
            if (lane == 63) {
#pragma unroll
                for (int i = 0; i < 4; ++i) ((LAS f32x4*)(kt + 2304))[i] = (f32x4){bc[4 * i], bc[4 * i + 1], bc[4 * i + 2], bc[4 * i + 3]}; }
            asm volatile("s_waitcnt lgkmcnt(0)" ::: "memory");
            const f32x4 dl = *(const LAS f32x4*)(kt + 2304 + 16 * fq);
            const f32x4 dec = (f32x4){fexp2(dl.x), fexp2(dl.y), fexp2(dl.z), fexp2(dl.w)};
            bf16x8 afr[2];
#pragma unroll
            for (int ks = 0; ks < 2; ++ks) afr[ks] = *(const LAS bf16x8*)(kt + fr * KT_STR + (32 * ks + 8 * fq) * 2);
#pragma unroll
            for (int et = 0; et < NE; ++et) acc[et] = acc[et] * dec;
            { constexpr int NB = 2 * NE / 4;
              LAS const unsigned char* vb[2][2];
#pragma unroll
              for (int ks = 0; ks < 2; ++ks) { const int r0 = 32 * ks + 8 * fq + qq, r1 = r0 + 4;
                  vb[ks][0] = lds + (ci * 64 + (dir ? 63 - r0 : r0)) * VSTR + 8 * p4; vb[ks][1] = lds + (ci * 64 + (dir ? 63 - r1 : r1)) * VSTR + 8 * p4; }
              bf16x8 bb[2][4];
#pragma unroll
              for (int j = 0; j < 4; ++j) bb[0][j] = tr_pair(vb[0][0] + 32 * j, vb[0][1] + 32 * j);
#pragma unroll
              for (int b = 0; b < NB; ++b) {
                  if (b + 1 < NB) { const int ks1 = (b + 1) / (NE / 4), e1 = 4 * ((b + 1) % (NE / 4));
#pragma unroll
                      for (int j = 0; j < 4; ++j) bb[(b + 1) & 1][j] = tr_pair(vb[ks1][0] + 32 * (e1 + j), vb[ks1][1] + 32 * (e1 + j)); }
                  const int ks0 = b / (NE / 4), e0 = 4 * (b % (NE / 4));
#pragma unroll
                  for (int j = 0; j < 4; ++j) acc[e0 + j] = __builtin_amdgcn_mfma_f32_16x16x32_bf16(afr[ks0], bb[b & 1][j], acc[e0 + j], 0, 0, 0);
                  __builtin_amdgcn_sched_group_barrier(0x100, 8, 0); __builtin_amdgcn_sched_group_barrier(0x008, 4, 0); } }
            asm volatile("s_waitcnt lgkmcnt(0)" ::: "memory");
            cur = nxt;
        }
        if (!STORE) { bf16* sout = X.STS + st_slot(sc, HGT, h, dir);
#pragma unroll
            for (int et = 0; et < NE; ++et) { v2u w; w.x = pkbf(acc[et][0], acc[et][1]); w.y = pkbf(acc[et][2], acc[et][3]);
                *(GAS v2u*)(sout + (size_t)((et * 4 + (wave >> 1)) * 64 + fr + 16 * (2 * (wave & 1) + (fq >> 1))) * 8 + 4 * (fq & 1)) = w; }
            if (lane == 0) { float* tp = X.TOTS + ((size_t)sc * 24 + hd) * 128 + c0;
#pragma unroll
                for (int i = 0; i < 4; ++i) ((GAS f32x4*)tp)[i] = (f32x4){run[4 * i], run[4 * i + 1], run[4 * i + 2], run[4 * i + 3]}; } }
    }
    __syncthreads();
}
__device__ __forceinline__ void pass_b_super(const Ctx& X, int g, int gtid, int NT) {
    const int ns = (g == 0) ? 1 : 2, nc = NSC / ns;
    for (int v = gtid; v < ns * (ST_CHUNK / 8); v += NT) {
        const int s = v / (ST_CHUNK / 8), idx = (v % (ST_CHUNK / 8)) * 8;
        const int hd = idx < 262144 ? idx / 32768 : 8 + (idx - 262144) / 16384, db = hd & 1;
        const int d0 = 32 * ((idx >> 9) & 3) + 8 * ((idx >> 7) & 3);
        float S[8];
#pragma unroll
        for (int i = 0; i < 8; ++i) S[i] = 0.f;
        for (int cc = 0; cc < nc; cc += 8) {
            v4u x[8]; f32x4 t0[8], t1[8];
#pragma unroll
            for (int u = 0; u < 8; ++u) { const int c = s * nc + (db ? nc - 1 - (cc + u) : cc + u);
                x[u] = *(const GAS v4u*)(X.STS + (size_t)c * ST_CHUNK + idx);
                const GAS f32x4* tp = (const GAS f32x4*)(X.TOTS + ((size_t)c * 24 + hd) * 128 + d0); t0[u] = tp[0]; t1[u] = tp[1]; }
#pragma unroll
            for (int u = 0; u < 8; ++u) { const int c = s * nc + (db ? nc - 1 - (cc + u) : cc + u);
                *(GAS v4u*)(X.STS + (size_t)c * ST_CHUNK + idx) = pack8(S);
                float dx[8]; unpack8(x[u], dx);
                const float dec[8] = {fexp2(t0[u].x), fexp2(t0[u].y), fexp2(t0[u].z), fexp2(t0[u].w), fexp2(t1[u].x), fexp2(t1[u].y), fexp2(t1[u].z), fexp2(t1[u].w)};
#pragma unroll
                for (int i = 0; i < 8; ++i) S[i] = dec[i] * S[i] + dx[i]; }
        }
    }
}

constexpr int C2_DIR = 63488, C2_QD = 0, C2_KD = 17408, C2_QH = 34816, C2_P = 52224, C2_BT = 61440, C2_V = 126976, C2_RED = 160768;
template <bool HGT>
__device__ __forceinline__ void c2_stage(const Ctx& X, int l, int chunk, int h, int dir, LAS unsigned char* ld, int lane, int wave) {
    const int r = lane, rt = dir ? 63 - r : r, c0 = 16 * wave;
    float bc[16], kr[16], qv[16];
    if (!HGT) {
        const GAS v4u* bg = (const GAS v4u*)((const bf16*)X.BG + ((size_t)(((chunk * 4 + h) * 8 + wave) * 2 + dir) * 64 + rt) * 16);
        unpack8(bg[0], bc); unpack8(bg[1], bc + 8); wave_scan16(bc);
        const GAS v4u* kp = (const GAS v4u*)(X.Z + ZB_GK + blk_off(chunk, 4, h, wave) + rt * 16); unpack8(kp[0], kr); unpack8(kp[1], kr + 8);
        const GAS v4u* qp = (const GAS v4u*)(X.Z + ZB_GQ + blk_off(chunk, 4, h, wave) + rt * 16); unpack8(qp[0], qv); unpack8(qp[1], qv + 8);
#pragma unroll
        for (int i = 0; i < 16; ++i) qv[i] *= 0.08838834764831845f;
    } else {
        float zf[16];
        const GAS v4u* zp = (const GAS v4u*)(X.Z + (dir ? ZB_HFB : ZB_HFF) + blk_off(chunk, 8, h, wave) + rt * 16); unpack8(zp[0], zf); unpack8(zp[1], zf + 8);
        const GAS v4u* qp = (const GAS v4u*)(X.Z + ZB_HQ + blk_off(chunk, 8, h, wave) + rt * 16); unpack8(qp[0], qv); unpack8(qp[1], qv + 8);
        float lbv[16];
        if (l == 0) {
#pragma unroll
            for (int i = 0; i < 16; ++i) lbv[i] = 0.f;
        } else { const float* lp = X.lowb + (size_t)dir * 2 * 1024 + h * 128 + c0;
#pragma unroll
            for (int i = 0; i < 16; ++i) lbv[i] = frcp(1.f + __expf(lp[i] - lp[1024 + i])); }
#pragma unroll
        for (int i = 0; i < 16; ++i) {
            const float z = __builtin_amdgcn_fmed3f(zf[i], -60.f, 60.f), e = fexp2(z * -LOG2E), sig = frcp(1.f + e), oml = 1.f - lbv[i];
            kr[i] = oml - oml * sig;
            bc[i] = flog2(lbv[i] + oml * sig); }
        wave_scan16(bc);
    }
    float qd[16], kd[16], qh[16];
#pragma unroll
    for (int i = 0; i < 16; ++i) {
        const float beta = __builtin_bit_cast(float, __builtin_amdgcn_update_dpp(0, __builtin_bit_cast(int, bc[i]), 0x142, 0xe, 0xf, false));
        qd[i] = qv[i] * fexp2(bc[i] - beta); kd[i] = kr[i] * fexp2(__builtin_amdgcn_fmed3f(beta - bc[i], 0.f, 80.f)); qh[i] = qv[i] * fexp2(bc[i]); }
    LAS unsigned char* p = ld + r * K_STR + c0 * 2;
    ((LAS v4u*)(p + C2_QD))[0] = pack8(qd); ((LAS v4u*)(p + C2_QD))[1] = pack8(qd + 8);
    ((LAS v4u*)(p + C2_KD))[0] = pack8(kd); ((LAS v4u*)(p + C2_KD))[1] = pack8(kd + 8);
    ((LAS v4u*)(p + C2_QH))[0] = pack8(qh); ((LAS v4u*)(p + C2_QH))[1] = pack8(qh + 8);
    if ((lane & 15) == 15) { LAS f32x4* bt = (LAS f32x4*)(ld + C2_BT + (((lane >> 4) + 1) & 3) * 512 + c0 * 4);
        const bool z = lane == 63;
#pragma unroll
        for (int i = 0; i < 4; ++i) bt[i] = z ? (f32x4){0.f, 0.f, 0.f, 0.f} : (f32x4){bc[4 * i], bc[4 * i + 1], bc[4 * i + 2], bc[4 * i + 3]}; }
}
template <bool HGT>
__device__ __forceinline__ void pass_c2_unit(const Ctx& X, int l, int chunk, int h, LAS unsigned char* lds, int tid, int lane, int wave) {
    constexpr int DV = HGT ? 128 : 256, VSTR = DV * 2 + 16, NET = DV / 128, PPR = DV / 8;
    const int fr = lane & 15, fq = lane >> 4, qq = fr >> 2, p4 = fr & 3;
    { const int vcol = HGT ? ZR_HI + h * 128 : ZR_GV + h * 256;
#pragma unroll
      for (int k = 0; k < 64 * PPR / 512; ++k) { const int idx = tid + 512 * k, row = idx / PPR, pc = idx % PPR;
        const v4u v = *(const GAS v4u*)(X.Z + (size_t)(chunk * 64 + row) * ZRW + vcol + pc * 8);
        *(LAS v4u*)(lds + C2_V + row * VSTR + pc * 16) = v; } }
    c2_stage<HGT>(X, l, chunk, h, 0, lds, lane, wave);
    c2_stage<HGT>(X, l, chunk, h, 1, lds + C2_DIR, lane, wave);
    bf16x8 sfr[2][NET][4];
#pragma unroll
    for (int dir = 0; dir < 2; ++dir) { const bf16* slot = X.ST + st_slot(chunk, HGT, h, dir);
#pragma unroll
        for (int et = 0; et < NET; ++et)
#pragma unroll
            for (int ks = 0; ks < 4; ++ks) sfr[dir][et][ks] = *(const GAS bf16x8*)(slot + (size_t)(((wave * NET + et) * 4 + ks) * 64 + lane) * 8); }
    __syncthreads();
    { const int a = wave & 3; LAS unsigned char* ld = lds + (wave >> 2) * C2_DIR;
      const unsigned lst = (a == 0) ? 0xff002010u : (a == 1) ? 0xff113021u : (a == 2) ? 0xffff2231u : 0xffff3332u;
      const unsigned zls = (a == 0) ? 0xffff0201u : (a == 1) ? 0xffff1203u : (a == 2) ? 0xffffff13u : 0xffffff23u;
      for (int t = 0; t < 3; ++t) { const unsigned code = (lst >> (8 * t)) & 0xffu; if (code == 0xffu) break;
          const int I = (int)(code >> 4), J = (int)(code & 15u);
          f32x4 sc = (f32x4){0.f, 0.f, 0.f, 0.f};
#pragma unroll
          for (int ks = 0; ks < 4; ++ks) { const int dc = 32 * ks + 8 * fq;
              v4u ka = *(const LAS v4u*)(ld + C2_KD + (16 * J + fr) * K_STR + dc * 2);
              const bf16x8 qb = *(const LAS bf16x8*)(ld + C2_QD + (16 * I + fr) * K_STR + dc * 2);
              if (J < I) { const LAS f32x4* bi = (const LAS f32x4*)(ld + C2_BT + I * 512 + dc * 4); const LAS f32x4* bj = (const LAS f32x4*)(ld + C2_BT + J * 512 + dc * 4);
                  const f32x4 d0 = bi[0] - bj[0], d1 = bi[1] - bj[1]; float kf[8]; unpack8(ka, kf);
                  kf[0] *= fexp2(d0.x); kf[1] *= fexp2(d0.y); kf[2] *= fexp2(d0.z); kf[3] *= fexp2(d0.w); kf[4] *= fexp2(d1.x); kf[5] *= fexp2(d1.y); kf[6] *= fexp2(d1.z); kf[7] *= fexp2(d1.w);
                  ka = pack8(kf); }
              sc = __builtin_amdgcn_mfma_f32_16x16x32_bf16(__builtin_bit_cast(bf16x8, ka), qb, sc, 0, 0, 0); }
          if (J == I) {
#pragma unroll
              for (int u = 0; u < 4; ++u) if (4 * fq + u > fr) sc[u] = 0.f; }
          v2u w; w.x = pkbf(sc[0], sc[1]); w.y = pkbf(sc[2], sc[3]);
          *(LAS v2u*)(ld + C2_P + (16 * I + fr) * P_STR + (16 * J + 4 * fq) * 2) = w; }
      for (int t = 0; t < 2; ++t) { const unsigned code = (zls >> (8 * t)) & 0xffu; if (code == 0xffu) break;
          const int I = (int)(code >> 4), J = (int)(code & 15u);
          *(LAS v2u*)(ld + C2_P + (16 * I + fr) * P_STR + (16 * J + 4 * fq) * 2) = (v2u){0u, 0u}; } }
    __syncthreads();
    f32x4 oacc[NET][4];
#pragma unroll
    for (int et = 0; et < NET; ++et)
#pragma unroll
        for (int it = 0; it < 4; ++it) oacc[et][it] = (f32x4){0.f, 0.f, 0.f, 0.f};
#pragma unroll
    for (int dir = 0; dir < 2; ++dir) { LAS const unsigned char* ld = lds + dir * C2_DIR;
        bf16x8 vfr[NET][2];
#pragma unroll
        for (int ks = 0; ks < 2; ++ks) { const int r0 = 32 * ks + 8 * fq + qq, r1 = r0 + 4, v0 = dir ? 63 - r0 : r0, v1 = dir ? 63 - r1 : r1;
#pragma unroll
            for (int et = 0; et < NET; ++et) { const int col = (16 * (wave * NET + et) + 4 * p4) * 2;
                vfr[et][ks] = tr_pair(lds + C2_V + v0 * VSTR + col, lds + C2_V + v1 * VSTR + col); } }
#pragma unroll
        for (int it = 0; it < 4; ++it) { const int trow = 16 * it + fr, ip = dir ? 63 - trow : trow;
            bf16x8 bo[6];
#pragma unroll
            for (int ks = 0; ks < 4; ++ks) bo[ks] = *(const LAS bf16x8*)(ld + C2_QH + ip * K_STR + (32 * ks + 8 * fq) * 2);
#pragma unroll
            for (int ks = 0; ks < 2; ++ks) bo[4 + ks] = *(const LAS bf16x8*)(ld + C2_P + ip * P_STR + (32 * ks + 8 * fq) * 2);
#pragma unroll
            for (int ks = 0; ks < 4; ++ks)
#pragma unroll
                for (int et = 0; et < NET; ++et) oacc[et][it] = __builtin_amdgcn_mfma_f32_16x16x32_bf16(sfr[dir][et][ks], bo[ks], oacc[et][it], 0, 0, 0);
#pragma unroll
            for (int ks = 0; ks < 2; ++ks)
#pragma unroll
                for (int et = 0; et < NET; ++et) oacc[et][it] = __builtin_amdgcn_mfma_f32_16x16x32_bf16(vfr[et][ks], bo[4 + ks], oacc[et][it], 0, 0, 0); } }
    LAS float* red = (LAS float*)(lds + C2_RED);
#pragma unroll
    for (int it = 0; it < 4; ++it) { float sq = 0.f;
#pragma unroll
        for (int et = 0; et < NET; ++et) { const f32x4 o = oacc[et][it]; sq += (o.x * o.x + o.y * o.y) + (o.z * o.z + o.w * o.w); }
        sq += __shfl_xor(sq, 16); sq += __shfl_xor(sq, 32);
        if (fq == 0) red[wave * 64 + 16 * it + fr] = sq; }
    __syncthreads();
    const float* ng = (HGT ? X.hg_g + (size_t)l * 128 : X.gla_g + (size_t)l * 256);
    const int ogcol = HGT ? ZR_HOG + h * 128 : ZR_GOG + h * 256, ocol = HGT ? 1024 + h * 128 : h * 256;
#pragma unroll
    for (int it = 0; it < 4; ++it) { float tot = 0.f;
#pragma unroll
        for (int w = 0; w < 8; ++w) tot += red[w * 64 + 16 * it + fr];
        const float rstd = __builtin_amdgcn_rsqf(tot * (1.f / DV) + RMS_EPS);
        const int tok = chunk * 64 + 16 * it + fr;
#pragma unroll
        for (int et = 0; et < NET; ++et) { const int e0 = 16 * (wave * NET + et) + 4 * fq;
            const v2u ogp = *(const GAS v2u*)(X.Z + (size_t)tok * ZRW + ogcol + e0);
            const float og[4] = {__uint_as_float(ogp.x << 16), __uint_as_float(ogp.x & 0xffff0000u), __uint_as_float(ogp.y << 16), __uint_as_float(ogp.y & 0xffff0000u)};
            const f32x4 g4 = *(const GAS f32x4*)(ng + e0); float rr[4];
#pragma unroll
            for (int u = 0; u < 4; ++u) { const float z = og[u]; rr[u] = oacc[et][it][u] * rstd * g4[u] * (z * frcp(1.f + fexp2(z * -LOG2E))); }
            v2u w; w.x = pkbf(rr[0], rr[1]); w.y = pkbf(rr[2], rr[3]);
            *(GAS v2u*)(X.O + (size_t)tok * DM + ocol + e0) = w; } }
}

constexpr int F_QD = 0, F_KD = 17408, F_QH = 34816, F_P = 52224, F_BT = 61440, F_KT = 63488, F_DEC = 81920, F_V = 82432, F_RED = 116224;
template <bool HGT> struct RawF { v4u x[HGT ? 4 : 6]; v4u v[HGT ? 2 : 4]; };
template <bool HGT>
__device__ __forceinline__ RawF<HGT> f_load(const Ctx& X, int chunk, int h, int dir, int tid, int lane, int wave) {
    constexpr int DV = HGT ? 128 : 256, PPR = DV / 8;
    RawF<HGT> R; const int rt = dir ? 63 - lane : lane;
    if constexpr (!HGT) {
        const GAS v4u* bg = (const GAS v4u*)((const bf16*)X.BG + ((size_t)(((chunk * 4 + h) * 8 + wave) * 2 + dir) * 64 + rt) * 16); R.x[0] = bg[0]; R.x[1] = bg[1];
        const GAS v4u* kp = (const GAS v4u*)(X.Z + ZB_GK + blk_off(chunk, 4, h, wave) + rt * 16); R.x[2] = kp[0]; R.x[3] = kp[1];
        const GAS v4u* qp = (const GAS v4u*)(X.Z + ZB_GQ + blk_off(chunk, 4, h, wave) + rt * 16); R.x[4] = qp[0]; R.x[5] = qp[1];
    } else {
        const GAS v4u* zp = (const GAS v4u*)(X.Z + (dir ? ZB_HFB : ZB_HFF) + blk_off(chunk, 8, h, wave) + rt * 16); R.x[0] = zp[0]; R.x[1] = zp[1];
        const GAS v4u* qp = (const GAS v4u*)(X.Z + ZB_HQ + blk_off(chunk, 8, h, wave) + rt * 16); R.x[2] = qp[0]; R.x[3] = qp[1]; }
    const int vcol = HGT ? ZR_HI + h * 128 : ZR_GV + h * 256;
#pragma unroll
    for (int k = 0; k < 64 * PPR / 512; ++k) { const int idx = tid + 512 * k, row = idx / PPR, pc = idx % PPR;
        R.v[k] = *(const GAS v4u*)(X.Z + (size_t)(chunk * 64 + row) * ZRW + vcol + pc * 8); }
    return R;
}
template <bool HGT>
__device__ __forceinline__ void f_stage(const Ctx& X, int l, const RawF<HGT>& R, int h, int dir, LAS unsigned char* ld, int lane, int wave) {
    const int r = lane, c0 = 16 * wave;
    float bc[16], kr[16], qv[16];
    if constexpr (!HGT) {
        unpack8(R.x[0], bc); unpack8(R.x[1], bc + 8); wave_scan16(bc);
        unpack8(R.x[2], kr); unpack8(R.x[3], kr + 8);
        unpack8(R.x[4], qv); unpack8(R.x[5], qv + 8);
#pragma unroll
        for (int i = 0; i < 16; ++i) qv[i] *= 0.08838834764831845f;
    } else {
        float zf[16];
        unpack8(R.x[0], zf); unpack8(R.x[1], zf + 8);
        unpack8(R.x[2], qv); unpack8(R.x[3], qv + 8);
        float lbv[16];
        if (l == 0) {
#pragma unroll
            for (int i = 0; i < 16; ++i) lbv[i] = 0.f;
        } else { const float* lp = X.lowb + (size_t)dir * 2 * 1024 + h * 128 + c0;
#pragma unroll
            for (int i = 0; i < 16; ++i) lbv[i] = frcp(1.f + __expf(lp[i] - lp[1024 + i])); }
#pragma unroll
        for (int i = 0; i < 16; ++i) {
            const float z = __builtin_amdgcn_fmed3f(zf[i], -60.f, 60.f), e = fexp2(z * -LOG2E), sig = frcp(1.f + e), oml = 1.f - lbv[i];
            kr[i] = oml - oml * sig;
            bc[i] = flog2(lbv[i] + oml * sig); }
        wave_scan16(bc);
    }
    float qd[16], kd[16], qh[16], kh[16], tl[16];
#pragma unroll
    for (int i = 0; i < 16; ++i) {
        const float beta = __builtin_bit_cast(float, __builtin_amdgcn_update_dpp(0, __builtin_bit_cast(int, bc[i]), 0x142, 0xe, 0xf, false));
        tl[i] = lane63(bc[i]);
        qd[i] = qv[i] * fexp2(bc[i] - beta); kd[i] = kr[i] * fexp2(__builtin_amdgcn_fmed3f(beta - bc[i], 0.f, 80.f)); qh[i] = qv[i] * fexp2(bc[i]); kh[i] = kr[i] * fexp2(tl[i] - bc[i]); }
    LAS unsigned char* p = ld + r * K_STR + c0 * 2;
    ((LAS v4u*)(p + F_QD))[0] = pack8(qd); ((LAS v4u*)(p + F_QD))[1] = pack8(qd + 8);
    ((LAS v4u*)(p + F_KD))[0] = pack8(kd); ((LAS v4u*)(p + F_KD))[1] = pack8(kd + 8);
    { const v4u q0 = pack8(qh), q1 = pack8(qh + 8);
      LAS unsigned char* pq = ld + F_QH + r * K_STR + (wave >> 1) * 64 + (wave & 1) * 8;
      *(LAS v2u*)(pq) = (v2u){q0.x, q0.y}; *(LAS v2u*)(pq + 16) = (v2u){q0.z, q0.w}; *(LAS v2u*)(pq + 32) = (v2u){q1.x, q1.y}; *(LAS v2u*)(pq + 48) = (v2u){q1.z, q1.w}; }
    { const v4u k0 = pack8(kh), k1 = pack8(kh + 8); const unsigned kw[8] = {k0.x, k0.y, k0.z, k0.w, k1.x, k1.y, k1.z, k1.w};
#pragma unroll
      for (int i = 0; i < 16; ++i) *(LAS unsigned short*)(ld + F_KT + (c0 + i) * KT_STR + lane * 2) = (unsigned short)((i & 1) ? (kw[i >> 1] >> 16) : (kw[i >> 1] & 0xffffu)); }
    if ((lane & 15) == 15) { LAS f32x4* bt = (LAS f32x4*)(ld + F_BT + (((lane >> 4) + 1) & 3) * 512 + c0 * 4);
        const bool z = lane == 63;
#pragma unroll
        for (int i = 0; i < 4; ++i) bt[i] = z ? (f32x4){0.f, 0.f, 0.f, 0.f} : (f32x4){bc[4 * i], bc[4 * i + 1], bc[4 * i + 2], bc[4 * i + 3]};
        if (z) { LAS f32x4* dc = (LAS f32x4*)(ld + F_DEC + c0 * 4);
#pragma unroll
            for (int i = 0; i < 4; ++i) dc[i] = (f32x4){fexp2(tl[4 * i]), fexp2(tl[4 * i + 1]), fexp2(tl[4 * i + 2]), fexp2(tl[4 * i + 3])}; } }
}
template <bool HGT>
__device__ __forceinline__ void pass_f_unit(const Ctx& X, int l, int sc, int h, float* scr, LAS unsigned char* lds, int tid_, int lane_, int wave) {
    constexpr int DV = HGT ? 128 : 256, VSTR = DV * 2 + 16, NET = DV / 128, PPR = DV / 8;
    if (tid_ < 384) { const int tid = tid_; const int tile = tid >> 6, row = (tid >> 2) & 15, part = tid & 3;
        const unsigned code = (tile < 4) ? (0x12030201u >> (8 * tile)) & 0xffu : (0x2313u >> (8 * (tile - 4))) & 0xffu;
        const unsigned zz = (unsigned)tid >> 20;
        *(LAS v2u*)(lds + F_P + (16 * (int)(code >> 4) + row) * P_STR + (16 * (int)(code & 15u) + 4 * part) * 2) = (v2u){zz, zz}; }
    const float* ng = (HGT ? X.hg_g + (size_t)l * 128 : X.gla_g + (size_t)l * 256);
    const int ogcol = HGT ? ZR_HOG + h * 128 : ZR_GOG + h * 256, ocol = HGT ? 1024 + h * 128 : h * 256;
    RawF<HGT> raw = f_load<HGT>(X, sc * 4 + 3, h, 1, tid_, lane_, wave);
#pragma unroll 1
    for (int sw = 0; sw < 2; ++sw) { const int dir = 1 - sw;
        f32x4 S[8][NET];
        { const bf16* sin = X.STS + st_slot(sc, HGT, h, dir); const int fr = lane_ & 15, fq = lane_ >> 4;
#pragma unroll
          for (int T = 0; T < 8; ++T)
#pragma unroll
            for (int et = 0; et < NET; ++et) { const v2u w = *(const GAS v2u*)(sin + (size_t)(((wave * NET + et) * 4 + (T >> 1)) * 64 + fr + 16 * (2 * (T & 1) + (fq >> 1))) * 8 + 4 * (fq & 1));
                S[T][et] = (f32x4){__uint_as_float(w.x << 16), __uint_as_float(w.x & 0xffff0000u), __uint_as_float(w.y << 16), __uint_as_float(w.y & 0xffff0000u)}; } }
#pragma unroll 1
        for (int cc = 0; cc < 4; ++cc) { const int ci = dir ? 3 - cc : cc, chunk = sc * 4 + ci;
            int tq = tid_; asm volatile("" : "+v"(tq));
            const int tid = tq, lane = tq & 63, fr = lane & 15, fq = lane >> 4, qq = fr >> 2, p4 = fr & 3;
            {
#pragma unroll
              for (int k = 0; k < 64 * PPR / 512; ++k) { const int idx = tid + 512 * k, row = idx / PPR, pc = idx % PPR;
                *(LAS v4u*)(lds + F_V + row * VSTR + pc * 16) = raw.v[k]; } }
            f_stage<HGT>(X, l, raw, h, dir, lds, lane, wave);
            if (cc < 3) raw = f_load<HGT>(X, sc * 4 + (dir ? 2 - cc : cc + 1), h, dir, tid, lane, wave);
            else if (dir) raw = f_load<HGT>(X, sc * 4, h, 0, tid, lane, wave);
            float* sp = scr + (size_t)((ci * 8 + wave) * (NET * 4)) * 256 + lane * 4;
            f32x4 oacc[NET][4];
#pragma unroll
            for (int et = 0; et < NET; ++et)
#pragma unroll
                for (int it = 0; it < 4; ++it) oacc[et][it] = (f32x4){0.f, 0.f, 0.f, 0.f};
            __syncthreads();
            if (!dir) {
#pragma unroll
                for (int et = 0; et < NET; ++et)
#pragma unroll
                    for (int it = 0; it < 4; ++it) oacc[et][it] = *(const GAS f32x4*)(sp + (et * 4 + it) * 256); }
            { const unsigned lst = (wave < 6) ? 0xff00u | (unsigned)((0x323130212010ull >> (8 * wave)) & 0xffull) : (wave == 6 ? 0x1100u : 0x3322u);
              for (int t = 0; t < 2; ++t) { const unsigned code = (lst >> (8 * t)) & 0xffu; if (code == 0xffu) break;
                  const int I = (int)(code >> 4), J = (int)(code & 15u);
                  f32x4 scv = (f32x4){0.f, 0.f, 0.f, 0.f};
#pragma unroll
                  for (int ks = 0; ks < 4; ++ks) { const int dc = 32 * ks + 8 * fq;
                      v4u ka = *(const LAS v4u*)(lds + F_KD + (16 * J + fr) * K_STR + dc * 2);
                      const bf16x8 qb = *(const LAS bf16x8*)(lds + F_QD + (16 * I + fr) * K_STR + dc * 2);
                      if (J < I) { const LAS f32x4* bi = (const LAS f32x4*)(lds + F_BT + I * 512 + dc * 4); const LAS f32x4* bj = (const LAS f32x4*)(lds + F_BT + J * 512 + dc * 4);
                          const f32x4 d0 = bi[0] - bj[0], d1 = bi[1] - bj[1]; float kf[8]; unpack8(ka, kf);
                          kf[0] *= fexp2(d0.x); kf[1] *= fexp2(d0.y); kf[2] *= fexp2(d0.z); kf[3] *= fexp2(d0.w); kf[4] *= fexp2(d1.x); kf[5] *= fexp2(d1.y); kf[6] *= fexp2(d1.z); kf[7] *= fexp2(d1.w);
                          ka = pack8(kf); }
                      scv = __builtin_amdgcn_mfma_f32_16x16x32_bf16(__builtin_bit_cast(bf16x8, ka), qb, scv, 0, 0, 0); }
                  if (J == I) {
#pragma unroll
                      for (int u = 0; u < 4; ++u) if (4 * fq + u > fr) scv[u] = 0.f; }
                  v2u w; w.x = pkbf(scv[0], scv[1]); w.y = pkbf(scv[2], scv[3]);
                  *(LAS v2u*)(lds + F_P + (16 * I + fr) * P_STR + (16 * J + 4 * fq) * 2) = w; } }
            __syncthreads();
            bf16x8 vfr[NET][2];
#pragma unroll
            for (int ks = 0; ks < 2; ++ks) { const int r0 = 32 * ks + 8 * fq + qq, r1 = r0 + 4, v0 = dir ? 63 - r0 : r0, v1 = dir ? 63 - r1 : r1;
#pragma unroll
                for (int et = 0; et < NET; ++et) { const int col = (16 * (wave * NET + et) + 4 * p4) * 2;
                    vfr[et][ks] = tr_pair(lds + F_V + v0 * VSTR + col, lds + F_V + v1 * VSTR + col); } }
            {
#pragma unroll
              for (int ks = 0; ks < 4; ++ks) { bf16x8 sfr[NET];
#pragma unroll
                for (int et = 0; et < NET; ++et) { v4u a; a.x = pkbf(S[2 * ks][et][0], S[2 * ks][et][1]); a.y = pkbf(S[2 * ks][et][2], S[2 * ks][et][3]);
                    a.z = pkbf(S[2 * ks + 1][et][0], S[2 * ks + 1][et][1]); a.w = pkbf(S[2 * ks + 1][et][2], S[2 * ks + 1][et][3]); sfr[et] = __builtin_bit_cast(bf16x8, a); }
#pragma unroll
                for (int it = 0; it < 4; ++it) { const int trow = 16 * it + fr, ip = dir ? 63 - trow : trow;
                    const bf16x8 bo = *(const LAS bf16x8*)(lds + F_QH + ip * K_STR + (32 * ks + 8 * fq) * 2);
#pragma unroll
                    for (int et = 0; et < NET; ++et) oacc[et][it] = __builtin_amdgcn_mfma_f32_16x16x32_bf16(sfr[et], bo, oacc[et][it], 0, 0, 0); } }
#pragma unroll
              for (int ks = 0; ks < 2; ++ks)
#pragma unroll
                for (int it = 0; it < 4; ++it) { const int trow = 16 * it + fr, ip = dir ? 63 - trow : trow;
                    const bf16x8 bo = *(const LAS bf16x8*)(lds + F_P + ip * P_STR + (32 * ks + 8 * fq) * 2);
#pragma unroll
                    for (int et = 0; et < NET; ++et) oacc[et][it] = __builtin_amdgcn_mfma_f32_16x16x32_bf16(vfr[et][ks], bo, oacc[et][it], 0, 0, 0); } }
            v2u ogp[NET][4];
            if (HGT && !dir) {
#pragma unroll
                for (int et = 0; et < NET; ++et)
#pragma unroll
                    for (int it = 0; it < 4; ++it) {
                        ogp[et][it] = *(const GAS v2u*)(X.Z + (size_t)(chunk * 64 + 16 * it + fr) * ZRW + ogcol + 16 * (wave * NET + et) + 4 * fq); } }
            if (cc < 3) {
#pragma unroll
                for (int T = 0; T < 8; ++T) { if ((T & 1) == 0) __builtin_amdgcn_sched_barrier(0);
                    const f32x4 dc = *(const LAS f32x4*)(lds + F_DEC + (16 * T + 4 * fq) * 4);
                    const bf16x8 a0 = *(const LAS bf16x8*)(lds + F_KT + (16 * T + fr) * KT_STR + (8 * fq) * 2), a1 = *(const LAS bf16x8*)(lds + F_KT + (16 * T + fr) * KT_STR + (32 + 8 * fq) * 2);
#pragma unroll
                    for (int et = 0; et < NET; ++et) { S[T][et] = S[T][et] * dc;
                        S[T][et] = __builtin_amdgcn_mfma_f32_16x16x32_bf16(a0, vfr[et][0], S[T][et], 0, 0, 0); S[T][et] = __builtin_amdgcn_mfma_f32_16x16x32_bf16(a1, vfr[et][1], S[T][et], 0, 0, 0); } } }
            if (dir) {
#pragma unroll
                for (int et = 0; et < NET; ++et)
#pragma unroll
                    for (int it = 0; it < 4; ++it) *(GAS f32x4*)(sp + (et * 4 + it) * 256) = oacc[et][it];
                __syncthreads();
            } else {
                LAS float* red = (LAS float*)(lds + F_RED);
#pragma unroll
                for (int it = 0; it < 4; ++it) { float sq = 0.f;
#pragma unroll
                    for (int et = 0; et < NET; ++et) { const f32x4 o = oacc[et][it]; sq += (o.x * o.x + o.y * o.y) + (o.z * o.z + o.w * o.w); }
                    sq += __shfl_xor(sq, 16); sq += __shfl_xor(sq, 32);
                    if (fq == 0) red[wave * 64 + 16 * it + fr] = sq; }
                __syncthreads();
#pragma unroll
                for (int it = 0; it < 4; ++it) { float tot = 0.f;
#pragma unroll
                    for (int w = 0; w < 8; ++w) tot += red[w * 64 + 16 * it + fr];
                    const float rstd = __builtin_amdgcn_rsqf(tot * (1.f / DV) + RMS_EPS);
                    const int tok = chunk * 64 + 16 * it + fr;
#pragma unroll
                    for (int et = 0; et < NET; ++et) { const int e0 = 16 * (wave * NET + et) + 4 * fq;
                        const v2u og2 = HGT ? ogp[et][it] : *(const GAS v2u*)(X.Z + (size_t)tok * ZRW + ogcol + e0);
                        const float og[4] = {__uint_as_float(og2.x << 16), __uint_as_float(og2.x & 0xffff0000u), __uint_as_float(og2.y << 16), __uint_as_float(og2.y & 0xffff0000u)};
                        const f32x4 g4 = *(const GAS f32x4*)(ng + e0); float rr[4];
#pragma unroll
                        for (int u = 0; u < 4; ++u) { const float z = og[u]; rr[u] = oacc[et][it][u] * rstd * g4[u] * (z * frcp(1.f + fexp2(z * -LOG2E))); }
                        v2u w; w.x = pkbf(rr[0], rr[1]); w.y = pkbf(rr[2], rr[3]);
                        *(GAS v2u*)(X.O + (size_t)tok * DM + ocol + e0) = w; } }
            }
        }
        asm volatile("s_waitcnt vmcnt(0)" ::: "memory");
    }
}

struct Args { const float* in[15]; float* out; unsigned char* ws; int mode, pad; };
#define PHASE_IDS() int tid = threadIdx.x; asm volatile("" : "+v"(tid)); const int lane = tid & 63, wave = __builtin_amdgcn_readfirstlane(tid >> 6); \
    const int gw = bx * NWAVES + wave, NGW = G * NWAVES, gtid = bx * (NWAVES * 64) + tid, NT = G * NWAVES * 64; (void)lane; (void)wave; (void)gw; (void)NGW; (void)gtid; (void)NT
__device__ __forceinline__ Ctx make_ctx(const Args& args) {
    Ctx X; unsigned char* ws = args.ws;
    X.x_prompt = args.in[0]; X.x_sample = args.in[1]; X.w_in = args.in[2]; X.w_lr2 = args.in[3]; X.b_lr = args.in[4]; X.gla_g = args.in[5]; X.hg_g = args.in[6]; X.lowb = args.in[7];
    X.w_out = args.in[8]; X.ln1_g = args.in[9]; X.ln1_b = args.in[10]; X.w_up = args.in[11]; X.w_down = args.in[12]; X.ln2_g = args.in[13]; X.ln2_b = args.in[14]; X.out = args.out;
    X.Win_t = (bf16*)(ws + WS_WIN); X.Wout_t = (bf16*)(ws + WS_WOUT); X.Wup_t = (bf16*)(ws + WS_WUP); X.Wdn_t = (bf16*)(ws + WS_WDN); X.Wglr_t = (bf16*)(ws + WS_WGLR);
    X.HB = (bf16*)(ws + WS_HB); X.Z = (bf16*)(ws + WS_Z); X.O = (bf16*)(ws + WS_O); X.ST = (bf16*)(ws + WS_ST);
    X.BG = (float*)(ws + WS_BG); X.MF = (bf16*)(ws + WS_ST); X.TOT = (float*)(ws + WS_TOT); X.TOTS = (float*)(ws + WS_TOTS); X.STS = (bf16*)(ws + WS_STS);
    return X;
}
__global__ void __launch_bounds__(NWAVES * 64, 2) fwd_kernel(Args args) {
    extern __shared__ __attribute__((aligned(16))) unsigned char lds_raw[];
    LAS unsigned char* lds = (LAS unsigned char*)lds_raw;
    const int G = gridDim.x, bx = blockIdx.x;
    volatile LAS unsigned* MISC = (volatile LAS unsigned*)(lds + MISC_OFF);
    if (threadIdx.x < 32) MISC[threadIdx.x] = 0u;
    __syncthreads();
    XcdBarrier bar = xcd_barrier_post((unsigned*)(args.ws + WS_CTL) + CW_BAR, MISC + 8);

    { PHASE_IDS(); const Ctx X = make_ctx(args); prologue_weights(X, lds, gw, NGW, wave, lane); }
    for (int g = 0; g < NGRP; ++g) {
        { PHASE_IDS(); const Ctx X = make_ctx(args); cvt_group((g == 0) ? X.x_prompt : X.x_sample + (size_t)(g - 1) * GM * DM, X.HB, gtid, NT); }
        xcd_barrier(bar);
        for (int l = 0; l < NLAYER; ++l) {
            { PHASE_IDS(); const Ctx X = make_ctx(args); for (int c = bx; c < NCHUNK; c += G) gate_unit(X, l, c, lds, tid, lane, wave); }
            { const Ctx X = make_ctx(args); pg8::Gemm gm{X.HB, X.Win_t + (size_t)l * ZW * DM, GM, ZW, DM}; pg8::StaticOrder S; S.init(GM, ZW, G, bx);
              pg8::EpiZ E{X.Z};
              pg8::gemm_phase<pg8::EpiZ, pg8::StaticOrder, false, true>(lds, gm, S, E); }
            xcd_barrier(bar);
            {
            { PHASE_IDS(); const Ctx X = make_ctx(args);
              for (int u = bx; u < NSC * 12; u += G) { const int sc = sc_order(u / 12), hh = u % 12;
                if (hh < 4) pass_s_unit<false, false>(X, l, sc, hh, lds, tid, lane, wave); else pass_s_unit<true, false>(X, l, sc, hh - 4, lds, tid, lane, wave); } }
            xcd_barrier(bar);
            { PHASE_IDS(); const Ctx X = make_ctx(args); pass_b_super(X, g, gtid, NT); }
            xcd_barrier(bar);
            for (int u = bx + ((NSC * 12 - 1 - bx) / G) * G; u >= bx; u -= G) { const int sc = sc_order(u / 12), hh = u % 12;
                { PHASE_IDS(); const Ctx X = make_ctx(args); float* scr = (float*)X.ST + (size_t)bx * 65536;
                  if (hh < 4) pass_f_unit<false>(X, l, sc, hh, scr, lds, tid, lane, wave); else pass_f_unit<true>(X, l, sc, hh - 4, scr, lds, tid, lane, wave); }
                __syncthreads(); }
            xcd_barrier(bar);
            }
            { const Ctx X = make_ctx(args); pg8::Gemm gm{X.O, X.Wout_t + (size_t)l * DM * DM, GM, DM, DM}; pg8::StaticOrder S; S.init(GM, DM, G, bx);
              pg8::EpiBf16<0> E{X.MF, DM};
              pg8::gemm_phase<pg8::EpiBf16<0>, pg8::StaticOrder, false, true>(lds, gm, S, E); }
            xcd_barrier(bar);
            { PHASE_IDS(); const Ctx X = make_ctx(args);
              if (l == 0) ln_phase<true, false>((g == 0) ? X.x_prompt : X.x_sample + (size_t)(g - 1) * GM * DM, X.MF, X.ln1_g, X.ln1_b, nullptr, X.HB, gw, NGW, lane);
              else ln_phase<false, false>(X.HB, X.MF, X.ln1_g + (size_t)l * DM, X.ln1_b + (size_t)l * DM, nullptr, X.HB, gw, NGW, lane); }
            xcd_barrier(bar);
            { const Ctx X = make_ctx(args); pg8::Gemm gm{X.HB, X.Wup_t + (size_t)l * DFF * DM, GM, DFF, DM}; pg8::StaticOrder S; S.init(GM, DFF, G, bx);
              pg8::EpiBf16<1> E{X.Z, DFF};
              pg8::gemm_phase<pg8::EpiBf16<1>, pg8::StaticOrder, false, true>(lds, gm, S, E); }
            xcd_barrier(bar);
            { const Ctx X = make_ctx(args); pg8::Gemm gm{X.Z, X.Wdn_t + (size_t)l * DM * DFF, GM, DM, DFF}; pg8::ReverseOrder S; S.init(GM, DM, G, bx);
              pg8::EpiBf16<0> E{X.MF, DM};
              pg8::gemm_phase<pg8::EpiBf16<0>, pg8::ReverseOrder, false, true>(lds, gm, S, E); }
            xcd_barrier(bar);
            { PHASE_IDS(); const Ctx X = make_ctx(args);
              if (l == NLAYER - 1) ln_phase<false, true>(X.HB, X.MF, X.ln2_g + (size_t)l * DM, X.ln2_b + (size_t)l * DM, X.out + (size_t)g * GM * DM, nullptr, gw, NGW, lane);
              else ln_phase<false, false>(X.HB, X.MF, X.ln2_g + (size_t)l * DM, X.ln2_b + (size_t)l * DM, nullptr, X.HB, gw, NGW, lane); }
            xcd_barrier(bar);
        }
    }
}

extern "C" void kernel_launch(void* const* d_in, const int* in_sizes, int n_in, void* d_out, int out_size, void* d_ws, size_t ws_size, hipStream_t stream) {
    static int grid = 0;
    if (grid == 0) {
        if (n_in != 15 || out_size != NTOK * DM || ws_size < WS_END) { fprintf(stderr, "kernel_launch: unexpected shapes (n_in %d, out %d, ws %zu)\n", n_in, out_size, ws_size); grid = -1; return; }
        int dev = 0, cus = 0;
        if (hipGetDevice(&dev) != hipSuccess || hipDeviceGetAttribute(&cus, hipDeviceAttributeMultiprocessorCount, dev) != hipSuccess) { grid = -1; return; }
        if (hipFuncSetAttribute((const void*)fwd_kernel, hipFuncAttributeMaxDynamicSharedMemorySize, LDS_BYTES) != hipSuccess) { fprintf(stderr, "kernel_launch: hipFuncSetAttribute failed\n"); grid = -1; return; }
        int per_cu = 0;
        if (hipOccupancyMaxActiveBlocksPerMultiprocessor(&per_cu, (const void*)fwd_kernel, NWAVES * 64, LDS_BYTES) != hipSuccess || per_cu < 1) { fprintf(stderr, "kernel_launch: occupancy query says %d\n", per_cu); }
        (void)hipGetLastError();
        grid = cus;
    }
    if (grid < 0) return;
    if (hipMemsetAsync((char*)d_ws + WS_CTL, 0, CTL_ZERO_BYTES, stream) != hipSuccess) return;
    Args a{};
    for (int i = 0; i < 15; ++i) a.in[i] = (const float*)d_in[i];
    a.out = (float*)d_out; a.ws = (unsigned char*)d_ws; a.mode = KMODE; a.pad = 0;
    hipLaunchKernelGGL(fwd_kernel, dim3(grid), dim3(NWAVES * 64), LDS_BYTES, stream, a);
}
```

```cpp
#include <hip/hip_runtime.h>
#include <cstdio>
#include <cstdint>
#ifndef KMODE
#define KMODE 0
#endif
namespace pg8 {
#define PG8_LAS __attribute__((address_space(3)))
typedef unsigned short bf16_t;
typedef short bf16x8 __attribute__((ext_vector_type(8)));
typedef float f32x4 __attribute__((ext_vector_type(4)));
typedef unsigned u32x4 __attribute__((ext_vector_type(4)));
constexpr int BM = 256, BK = 64, HALF = 128, HTB = HALF * BK * 2  , STAGE_BYTES = 8 * HTB, NXCD = 8, WGM = 4;

__host__ __device__ __forceinline__ int lds_byte(int r, int c) { const int st = (r >> 4) * 2 + (c >> 5), rr = r & 15, cc = c & 31, ob = rr * 64 + cc * 2; return st * 1024 + (ob ^ (((ob >> 9) & 1) << 5)); }
__host__ __device__ __forceinline__ void stage_rc(int b, int& R, int& C) { const int st = b / 1024, sb = b % 1024, swz = sb ^ (((sb >> 9) & 1) << 5); R = (st >> 1) * 16 + swz / 64; C = (st & 1) * 32 + (swz % 64) / 2; }
__host__ __device__ __forceinline__ int perm32(int rho) { const int n = rho >> 4, i = rho & 15; return 8 * (i >> 2) + 4 * n + (i & 3); }

struct Unit { int pm, pn; };
struct Gemm { const bf16_t* A; const bf16_t* Bt; int M, N, K; };

struct StaticOrder {
    int nM, nN, nwg, G, c;
    __host__ __device__ void init(int M, int N, int G_, int c_) { nM = M / BM; nN = N / BM; nwg = nM * nN; G = G_; c = c_; }
    __host__ __device__ bool next(int i, Unit& u) const {
        const long L = (long)i * G + c; if (L >= nwg) return false;
        int wgid = (int)L; { const int q = nwg / NXCD, r = nwg % NXCD, xcd = wgid % NXCD, off = wgid / NXCD; wgid = (xcd < r ? xcd * (q + 1) : r * (q + 1) + (xcd - r) * q) + off; }
        const int nig = WGM * nN, gid = wgid / nig, fm = gid * WGM, gsz = (nM - fm) < WGM ? (nM - fm) : WGM;
        u.pm = fm + ((wgid % nig) % gsz); u.pn = (wgid % nig) / gsz; return true;
    }
    __device__ __forceinline__ void a_ready(const Unit&) const {}
    __device__ __forceinline__ void done(const Unit&) const {}
};
struct ReverseOrder : StaticOrder {
    __host__ __device__ bool next(int i, Unit& u) const { const int rounds = nwg / G; if (i >= rounds) return false; return StaticOrder::next(rounds - 1 - i, u); }
};


__device__ __forceinline__ unsigned cvt_pk_bf16(float lo, float hi) { unsigned r; asm volatile("v_cvt_pk_bf16_f32 %0, %1, %2" : "=v"(r) : "v"(lo), "v"(hi)); return r; }

template <int ACT  > struct EpiBf16 {
    static constexpr bool PERM = true, AFTER_DRAIN = false;
    bf16_t* O; int ldc;
    __device__ __forceinline__ void operator()(const f32x4 (&acc)[2][2][4][2], const Unit& u, int wr, int wc, int fr, int fq) const {
        const int row0 = u.pm * BM + wr * 64 + fr; const int col0 = u.pn * BM + wc * 32 + 8 * fq;
#pragma unroll
        for (int ai = 0; ai < 2; ++ai)
#pragma unroll
            for (int m = 0; m < 4; ++m) { bf16_t* rowp = O + (size_t)(row0 + ai * HALF + m * 16) * ldc + col0;
#pragma unroll
                for (int bj = 0; bj < 2; ++bj) { f32x4 v0 = acc[ai][bj][m][0], v1 = acc[ai][bj][m][1];
                    if (ACT == 1) {
#pragma unroll
                        for (int j = 0; j < 4; ++j) { const float a = fmaxf(v0[j], 0.f), b = fmaxf(v1[j], 0.f); v0[j] = a * a; v1[j] = b * b; } }
                    u32x4 w; w.x = cvt_pk_bf16(v0[0], v0[1]); w.y = cvt_pk_bf16(v0[2], v0[3]); w.z = cvt_pk_bf16(v1[0], v1[1]); w.w = cvt_pk_bf16(v1[2], v1[3]);
                    *(u32x4*)(rowp + bj * HALF) = w; } }
    }
};
struct EpiF32 {
    static constexpr bool PERM = false, AFTER_DRAIN = false;
    float* C; int ldc;
    __device__ __forceinline__ void operator()(const f32x4 (&acc)[2][2][4][2], const Unit& u, int wr, int wc, int fr, int fq) const {
        const int row0 = u.pm * BM + wr * 64 + fr, col0 = u.pn * BM + wc * 32 + 4 * fq;
#pragma unroll
        for (int ai = 0; ai < 2; ++ai)
#pragma unroll
            for (int m = 0; m < 4; ++m) { float* rowp = C + (size_t)(row0 + ai * HALF + m * 16) * ldc + col0;
#pragma unroll
                for (int bj = 0; bj < 2; ++bj)
#pragma unroll
                    for (int n = 0; n < 2; ++n) *(f32x4*)(rowp + bj * HALF + n * 16) = acc[ai][bj][m][n]; }
    }
};

struct EpiZ {
    static constexpr bool PERM = true, AFTER_DRAIN = false;
    bf16_t* Z;
    __device__ __forceinline__ void operator()(const f32x4 (&acc)[2][2][4][2], const Unit& u, int wr, int wc, int fr, int fq) const {
        const int pn = u.pn; const size_t Mr = 16384;
        bool blocked; int H = 4, c0; bf16_t* base;
        if (pn < 2) { blocked = true; H = 4; base = Z + Mr * 4096; c0 = pn * 256; }
        else if (pn < 4) { blocked = true; H = 4; base = Z + Mr * 4096 + Mr * 512; c0 = (pn - 2) * 256; }
        else if (pn < 8) { blocked = false; base = Z; c0 = (pn - 4) * 256; }
        else if (pn < 12) { blocked = false; base = Z; c0 = 1024 + (pn - 8) * 256; }
        else if (pn < 24) { blocked = true; H = 8; base = Z + Mr * 4096 + Mr * 1024 + (size_t)((pn - 12) >> 2) * Mr * 1024; c0 = ((pn - 12) & 3) * 256; }
        else if (pn < 28) { blocked = false; base = Z; c0 = 2048 + (pn - 24) * 256; }
        else { blocked = false; base = Z; c0 = 3072 + (pn - 28) * 256; }
        const int row0 = u.pm * BM + wr * 64 + fr, cl = c0 + wc * 32 + 8 * fq;
#pragma unroll
        for (int ai = 0; ai < 2; ++ai)
#pragma unroll
            for (int m = 0; m < 4; ++m) { const int row = row0 + ai * HALF + m * 16;
#pragma unroll
                for (int bj = 0; bj < 2; ++bj) { const f32x4 v0 = acc[ai][bj][m][0], v1 = acc[ai][bj][m][1]; const int c = cl + bj * HALF;
                    u32x4 w; w.x = cvt_pk_bf16(v0[0], v0[1]); w.y = cvt_pk_bf16(v0[2], v0[3]); w.z = cvt_pk_bf16(v1[0], v1[1]); w.w = cvt_pk_bf16(v1[2], v1[3]);
                    bf16_t* p = blocked ? base + ((size_t)((((row >> 6) * H + (c >> 7)) * 8 + ((c >> 4) & 7)) * 64 + (row & 63))) * 16 + (c & 15)
                                        : base + (size_t)row * 4096 + c;
                    *(u32x4*)p = w; } }
    }
};

template <class Epi, class Sched, bool ALIGN_EPI = false, bool SP2 = false>
__device__ __forceinline__ void gemm_phase(PG8_LAS unsigned char* lds, const Gemm g, const Sched& S, const Epi& E) {
    int tid_o = threadIdx.x; asm volatile("" : "+v"(tid_o));
    const int tid = tid_o, wid = __builtin_amdgcn_readfirstlane(tid >> 6), lane = tid & 63, wr = wid >> 2, wc = wid & 3, fr = lane & 15, fq = lane >> 4;
    const int K = g.K, nt = K / BK;
    unsigned voffA[2], voffB[2];
#pragma unroll
    for (int i = 0; i < 2; ++i) { int R, C; stage_rc(tid * 16 + i * 8192, R, C); const int Rb = Epi::PERM ? ((R & ~31) + perm32(R & 31)) : R;
        voffA[i] = (unsigned)(R * K + C) * 2u; voffB[i] = (unsigned)(Rb * K + C) * 2u; }
    const size_t kstep = (size_t)(BK * 2);
    const size_t hstep = (size_t)HALF * K * 2;
    const size_t tstep = 2 * hstep;
    const unsigned ldsw = (unsigned)wid * 1024u;
    const int aoff = lds_byte(wr * 64 + fr, fq * 8), boff = lds_byte(wc * 32 + fr, fq * 8);
#define PG8_SA(b, h) (((b) * 2 + (h)) * HTB)
#define PG8_SB(b, h) ((4 + (b) * 2 + (h)) * HTB)
#define PG8_STAGE(bufoff, gbase, voff) do { _Pragma("unroll") for (int _i = 0; _i < 2; ++_i) \
        __builtin_amdgcn_global_load_lds((const unsigned*)((const char*)(gbase) + (voff)[_i]), (PG8_LAS unsigned*)(lds + (bufoff) + ldsw + _i * 8192), 16, 0, 0); } while (0)
#define PG8_LDA(dst, b, h) do { _Pragma("unroll") for (int m = 0; m < 4; ++m) _Pragma("unroll") for (int k = 0; k < 2; ++k) dst[m][k] = *(const PG8_LAS bf16x8*)(lds + PG8_SA(b, h) + aoff + m * 2048 + k * 1024); } while (0)
#define PG8_LDB(dst, b, h) do { _Pragma("unroll") for (int n = 0; n < 2; ++n) _Pragma("unroll") for (int k = 0; k < 2; ++k) dst[n][k] = *(const PG8_LAS bf16x8*)(lds + PG8_SB(b, h) + boff + n * 2048 + k * 1024); } while (0)
#define PG8_MMA(ai, bj, At, Bt) do { __builtin_amdgcn_s_setprio(1); _Pragma("unroll") for (int m = 0; m < 4; ++m) _Pragma("unroll") for (int n = 0; n < 2; ++n) _Pragma("unroll") for (int k = 0; k < 2; ++k) \
        acc[ai][bj][m][n] = __builtin_amdgcn_mfma_f32_16x16x32_bf16(Bt[n][k], At[m][k], acc[ai][bj][m][n], 0, 0, 0); __builtin_amdgcn_s_setprio(0); } while (0)
#define PG8_WAIT_V(n) asm volatile("s_waitcnt vmcnt(" #n ")" ::: "memory")
#define PG8_WAIT_L(n) asm volatile("s_waitcnt lgkmcnt(" #n ")" ::: "memory")
#define PG8_BAR __builtin_amdgcn_s_barrier()
#define PG8_SCHED __builtin_amdgcn_sched_barrier(0)
    Unit cur, nxt; int ui = 0;
    if (!S.next(0, cur)) return;
    f32x4 acc[2][2][4][2];
#pragma unroll
    for (int a = 0; a < 2; ++a)
#pragma unroll
        for (int b = 0; b < 2; ++b)
#pragma unroll
            for (int m = 0; m < 4; ++m)
#pragma unroll
                for (int n = 0; n < 2; ++n) acc[a][b][m][n] = (f32x4){0.f, 0.f, 0.f, 0.f};
    bf16x8 At[4][2], B0[2][2], B1[2][2];
    const char* cA = (const char*)g.A + (size_t)cur.pm * tstep; const char* cB = (const char*)g.Bt + (size_t)cur.pn * tstep;
    S.a_ready(cur);
    if constexpr (SP2) {
        PG8_STAGE(PG8_SB(0, 0), cB, voffB); PG8_STAGE(PG8_SB(0, 1), cB + hstep, voffB); PG8_STAGE(PG8_SA(0, 0), cA, voffA); PG8_STAGE(PG8_SA(0, 1), cA + hstep, voffA);
        if (wr == 1) PG8_BAR;
        PG8_WAIT_V(2); PG8_BAR;
        PG8_STAGE(PG8_SB(1, 0), cB + kstep, voffB); PG8_STAGE(PG8_SA(1, 0), cA + kstep, voffA); PG8_STAGE(PG8_SB(1, 1), cB + hstep + kstep, voffB);
        PG8_WAIT_V(6); PG8_BAR;
    } else {
        PG8_STAGE(PG8_SB(0, 0), cB, voffB); PG8_STAGE(PG8_SA(0, 0), cA, voffA); PG8_STAGE(PG8_SB(0, 1), cB + hstep, voffB); PG8_STAGE(PG8_SA(0, 1), cA + hstep, voffA);
        if (wr == 1) PG8_BAR;
        PG8_WAIT_V(4); PG8_BAR;
        PG8_STAGE(PG8_SB(1, 0), cB + kstep, voffB); PG8_STAGE(PG8_SA(1, 0), cA + kstep, voffA); PG8_STAGE(PG8_SB(1, 1), cB + hstep + kstep, voffB);
        PG8_WAIT_V(6); PG8_BAR;
    }
    for (;;) {
        const bool has_next = S.next(ui + 1, nxt);
        const char* nA = has_next ? (const char*)g.A + (size_t)nxt.pm * tstep : cA; const char* nB = has_next ? (const char*)g.Bt + (size_t)nxt.pn * tstep : cB;
        for (int t = 0; t < nt; t += 2) {
            const bool last = (t == nt - 2);
            const char* a1 = cA + (size_t)(t + 1) * kstep;
            const char* a2 = last ? nA : cA + (size_t)(t + 2) * kstep; const char* b2 = last ? nB : cB + (size_t)(t + 2) * kstep;
            const char* a3 = a2 + kstep; const char* b3 = b2 + kstep;
            if (last && has_next) S.a_ready(nxt);
            if constexpr (SP2) {
            PG8_LDB(B0, 0, 0); PG8_LDB(B1, 0, 1); PG8_SCHED; PG8_LDA(At, 0, 0); PG8_STAGE(PG8_SA(1, 1), a1 + hstep, voffA);
            PG8_WAIT_V(8); PG8_WAIT_L(0); PG8_BAR; PG8_MMA(0, 0, At, B0); PG8_MMA(0, 1, At, B1); PG8_BAR; PG8_SCHED;
            PG8_LDA(At, 0, 1); PG8_STAGE(PG8_SB(0, 0), b2, voffB); PG8_STAGE(PG8_SB(0, 1), b2 + hstep, voffB); PG8_STAGE(PG8_SA(0, 0), a2, voffA);
            PG8_WAIT_V(8); PG8_WAIT_L(0); PG8_BAR; PG8_MMA(1, 0, At, B0); PG8_MMA(1, 1, At, B1); PG8_BAR; PG8_SCHED;
            PG8_LDB(B0, 1, 0); PG8_LDB(B1, 1, 1); PG8_SCHED; PG8_LDA(At, 1, 0); PG8_STAGE(PG8_SA(0, 1), a2 + hstep, voffA);
            PG8_WAIT_V(8); PG8_WAIT_L(0); PG8_BAR; PG8_MMA(0, 0, At, B0); PG8_MMA(0, 1, At, B1); PG8_BAR; PG8_SCHED;
            PG8_LDA(At, 1, 1); PG8_STAGE(PG8_SB(1, 0), b3, voffB); PG8_STAGE(PG8_SB(1, 1), b3 + hstep, voffB); PG8_STAGE(PG8_SA(1, 0), a3, voffA);
            PG8_WAIT_V(8); PG8_WAIT_L(0); PG8_BAR; PG8_MMA(1, 0, At, B0); PG8_MMA(1, 1, At, B1); PG8_BAR; PG8_SCHED;
            } else {
            PG8_LDB(B0, 0, 0); PG8_SCHED; PG8_LDA(At, 0, 0); PG8_STAGE(PG8_SA(1, 1), a1 + hstep, voffA);
            PG8_WAIT_L(8); PG8_BAR; PG8_WAIT_L(0); PG8_MMA(0, 0, At, B0); PG8_BAR; PG8_SCHED;
            PG8_LDB(B1, 0, 1); PG8_STAGE(PG8_SB(0, 0), b2, voffB);
            PG8_BAR; PG8_WAIT_L(0); PG8_MMA(0, 1, At, B1); PG8_BAR;
            PG8_LDA(At, 0, 1); PG8_STAGE(PG8_SA(0, 0), a2, voffA);
            PG8_BAR; PG8_WAIT_L(0); PG8_MMA(1, 0, At, B0); PG8_BAR; PG8_SCHED;
            PG8_STAGE(PG8_SB(0, 1), b2 + hstep, voffB);
            PG8_WAIT_V(6); PG8_BAR; PG8_MMA(1, 1, At, B1); PG8_BAR;
            PG8_LDB(B0, 1, 0); PG8_SCHED; PG8_LDA(At, 1, 0); PG8_STAGE(PG8_SA(0, 1), a2 + hstep, voffA);
            PG8_WAIT_L(8); PG8_BAR; PG8_WAIT_L(0); PG8_MMA(0, 0, At, B0); PG8_BAR; PG8_SCHED;
            PG8_LDB(B1, 1, 1); PG8_STAGE(PG8_SB(1, 0), b3, voffB);
            PG8_BAR; PG8_WAIT_L(0); PG8_MMA(0, 1, At, B1); PG8_BAR;
            PG8_LDA(At, 1, 1); PG8_STAGE(PG8_SA(1, 0), a3, voffA);
            PG8_BAR; PG8_WAIT_L(0); PG8_MMA(1, 0, At, B0); PG8_BAR; PG8_SCHED;
            PG8_STAGE(PG8_SB(1, 1), b3 + hstep, voffB);
            PG8_WAIT_V(6); PG8_BAR; PG8_MMA(1, 1, At, B1); PG8_BAR;
            }
        }
        if constexpr (ALIGN_EPI) { if (wr == 0) PG8_BAR; }
        if constexpr (!Epi::AFTER_DRAIN) { E(acc, cur, wr, wc, fr, fq); S.done(cur); }
        if (!has_next) break;
#pragma unroll
        for (int a = 0; a < 2; ++a)
#pragma unroll
            for (int b = 0; b < 2; ++b)
#pragma unroll
                for (int m = 0; m < 4; ++m)
#pragma unroll
                    for (int n = 0; n < 2; ++n) acc[a][b][m][n] = (f32x4){0.f, 0.f, 0.f, 0.f};
        cur = nxt; cA = nA; cB = nB; ++ui;
        if constexpr (ALIGN_EPI) { if (wr == 1) PG8_BAR; }
    }
    PG8_WAIT_V(0);
    if constexpr (!ALIGN_EPI) { if (wr == 0) PG8_BAR; }
    PG8_BAR;
    if constexpr (Epi::AFTER_DRAIN) { E.fused(acc, cur, wr, wc, fr, fq, lds, wid, lane); S.done(cur); }
#undef PG8_SA
#undef PG8_SB
#undef PG8_STAGE
#undef PG8_LDA
#undef PG8_LDB
#undef PG8_MMA
#undef PG8_WAIT_V
#undef PG8_WAIT_L
#undef PG8_BAR
#undef PG8_SCHED
}
}

constexpr int NWAVES = 8;
constexpr int DM = 2048, DFF = 8192, NTOK = 49152, GM = 16384, NGRP = 3, NLAYER = 2, INW = 8224, ZW = 8192;
constexpr int ZC_GQ = 0, ZC_GK = 512, ZC_GV = 1024, ZC_GOG = 2048, ZC_HQ = 3072, ZC_HFF = 4096, ZC_HFB = 5120, ZC_HI = 6144, ZC_HOG = 7168;
constexpr float LN_EPS = 1e-5f, RMS_EPS = 1e-6f, ALPHA = 1.41421356237f, LOG2E = 1.44269504089f;
constexpr int NCHUNK = GM / 64;
constexpr int ST_CHUNK = 524288;
constexpr size_t MiB = 1u << 20;
constexpr size_t WS_CTL = 0, CTL_ZERO_BYTES = 1 * MiB;
constexpr size_t WS_WIN = 2 * MiB, WS_WOUT = 66 * MiB, WS_WUP = 82 * MiB, WS_WDN = 146 * MiB, WS_WGLR = 210 * MiB;
constexpr size_t WS_HB = 212 * MiB;
constexpr size_t WS_Z = 276 * MiB;
constexpr size_t WS_BG = 532 * MiB;
constexpr size_t WS_O = 596 * MiB;
constexpr size_t WS_ST = 660 * MiB;
constexpr size_t WS_TOT = 916 * MiB;
constexpr size_t WS_STS = 920 * MiB;
constexpr size_t WS_TOTS = 984 * MiB;
constexpr size_t WS_END = 985 * MiB;
constexpr int CW_BAR = 4096;
constexpr int RING_BYTES = 131072;
constexpr int LDS_BYTES = 160 * 1024, MISC_OFF = LDS_BYTES - 256;
constexpr int L_B32 = 0, L_KR = 33792, L_QR = 51200, L_QH = 68608, L_V = 86016, L_P = 119808, L_RED = 129024;
constexpr int B32_STR = 528, K_STR = 272, P_STR = 144, KT_STR = 144;
constexpr int NSC = GM / 256;
__host__ __device__ __forceinline__ int sc_order(int s) { return s < 32 ? (s >> 2) * 8 + 4 + (s & 3) : ((s - 32) >> 2) * 8 + (s & 3); }
constexpr int SV_KT = 135168, KTW_BYTES = 2560;

#define GAS __attribute__((address_space(1)))
#define LAS __attribute__((address_space(3)))
typedef unsigned short bf16;
typedef unsigned v4u __attribute__((ext_vector_type(4)));
typedef float f32x4 __attribute__((ext_vector_type(4)));
typedef short bf16x8 __attribute__((ext_vector_type(8)));
typedef GAS unsigned gu32;
typedef GAS unsigned long long gu64;
#define RLX_AGENT __ATOMIC_RELAXED, __HIP_MEMORY_SCOPE_AGENT
#define LDS_WAIT() asm volatile("s_waitcnt lgkmcnt(0)" ::: "memory")
#define VM_WAIT() asm volatile("s_waitcnt vmcnt(0)" ::: "memory")
__device__ __forceinline__ unsigned long long rt() { return __builtin_amdgcn_s_memrealtime(); }
__device__ __forceinline__ unsigned f2bf(float f) { unsigned u = __builtin_bit_cast(unsigned, f); return (u + 0x7fffu + ((u >> 16) & 1u)) >> 16; }
__device__ __forceinline__ unsigned pk2(float lo, float hi) { return f2bf(lo) | (f2bf(hi) << 16); }

#define XB_TMO      128
#define XB_XCNT(j)  (256  + 64 * (j))
#define XB_XSUB(j)  (1280 + 64 * (j))
#define XB_XGEN(j)  (2304 + 64 * (j))
#define XB_TOP      3328
#define XB_TOPGEN   3392
#define XCD_BAR_WORDS 3456
#define XB_SPIN_CAP (1u << 18)

__device__ __forceinline__ unsigned xb_ld(unsigned* p)              { return __hip_atomic_load(p, __ATOMIC_RELAXED, __HIP_MEMORY_SCOPE_AGENT); }
__device__ __forceinline__ unsigned xb_add(unsigned* p, unsigned v) { return __hip_atomic_fetch_add(p, v, __ATOMIC_RELAXED, __HIP_MEMORY_SCOPE_AGENT); }
__device__ __forceinline__ unsigned xb_xcc_id() { return (unsigned)__builtin_amdgcn_s_getreg((3 << 11) | 20) & 0xFu; }
#define XB_SPIN(cond, bar) do { unsigned _sp = 0; while (cond) { __builtin_amdgcn_s_sleep(1); \
    if ((++_sp & 255u) == 0u) { if (xb_ld(&(bar)[XB_TMO])) break; if (_sp > XB_SPIN_CAP) { atomicAdd(&(bar)[XB_TMO], 1u); break; } } } } while (0)

struct XcdBarrier {
    unsigned* bar; unsigned x;
    volatile LAS unsigned* st;
};

__device__ __forceinline__ XcdBarrier xcd_barrier_post(unsigned* bar, volatile LAS unsigned* st) {
    XcdBarrier b; b.bar = bar; b.x = xb_xcc_id(); b.st = st;
    if (threadIdx.x == 0) (void)xb_add(&bar[XB_XCNT(b.x)], 1u);
    return b;
}
__device__ __forceinline__ void xcd_barrier_complete(unsigned* bar, unsigned x, unsigned& nloc, unsigned& nx) {
    const unsigned G = gridDim.x * gridDim.y * gridDim.z;
    unsigned sum, cnt, mine, sp = 0u;
    for (;;) {
        sum = 0u; cnt = 0u; mine = 0u;
#pragma unroll
        for (unsigned j = 0; j < 16; ++j) { const unsigned c = xb_ld(&bar[XB_XCNT(j)]); sum += c; cnt += (c > 0u) ? 1u : 0u; mine = (j == x) ? c : mine; }
        if (sum == G) break;
        __builtin_amdgcn_s_sleep(1);
        if ((++sp & 255u) == 0u) { if (xb_ld(&bar[XB_TMO])) break; if (sp > XB_SPIN_CAP) { atomicAdd(&bar[XB_TMO], 1u); break; } }
    }
    nloc = mine > 0u ? mine : 1u; nx = cnt > 0u ? cnt : 1u;
}

__device__ __forceinline__ void xcd_barrier(const XcdBarrier& b) {
    asm volatile("s_waitcnt vmcnt(0)" ::: "memory");
    __syncthreads();
    if (threadIdx.x == 0) {
        unsigned* bar = b.bar;
        __builtin_amdgcn_s_waitcnt(0);
        unsigned nloc = b.st[0], nx = b.st[1];
        if (nloc == 0u) { xcd_barrier_complete(bar, b.x, nloc, nx); b.st[0] = nloc; b.st[1] = nx; }
        const unsigned old = xb_add(&bar[XB_XSUB(b.x)], 1u);
        const unsigned gen = old / nloc;
        if (old + 1u == (gen + 1u) * nloc) {
            __builtin_amdgcn_fence(__ATOMIC_RELEASE, "agent");
            asm volatile("s_waitcnt vmcnt(0)" ::: "memory");
            const unsigned og = xb_add(&bar[XB_TOP], 1u);
            const unsigned tg = og / nx;
            if (og + 1u == (tg + 1u) * nx) xb_add(&bar[XB_TOPGEN], 1u);
            else XB_SPIN(xb_ld(&bar[XB_TOPGEN]) == tg, bar);
            __builtin_amdgcn_fence(__ATOMIC_ACQUIRE, "agent");
            xb_add(&bar[XB_XGEN(b.x)], 1u);
            asm volatile("s_waitcnt vmcnt(0)" ::: "memory");
        } else {
            XB_SPIN(xb_ld(&bar[XB_XGEN(b.x)]) == gen, bar);
            __builtin_amdgcn_fence(__ATOMIC_ACQUIRE, "agent");
            asm volatile("s_waitcnt vmcnt(0)" ::: "memory");
        }
    }
    __syncthreads();
}

typedef short s16x4 __attribute__((ext_vector_type(4)));
typedef float f32x2 __attribute__((ext_vector_type(2)));
typedef unsigned v2u __attribute__((ext_vector_type(2)));
__device__ __forceinline__ unsigned pkbf(float lo, float hi) { return pg8::cvt_pk_bf16(lo, hi); }
__device__ __forceinline__ float wave_sum(float v) {
#pragma unroll
    for (int o = 1; o < 64; o <<= 1) v += __shfl_xor(v, o);
    return v;
}
template <int CTRL, int RM> __device__ __forceinline__ float dpp_add(float v) {
    return v + __builtin_bit_cast(float, __builtin_amdgcn_update_dpp(0, __builtin_bit_cast(int, v), CTRL, RM, 0xf, true));
}
__device__ __forceinline__ float wave_scan_incl(float v, int) {
    v = dpp_add<0x111, 0xf>(v); v = dpp_add<0x112, 0xf>(v); v = dpp_add<0x114, 0xf>(v); v = dpp_add<0x118, 0xf>(v);
    v = dpp_add<0x142, 0xa>(v); v = dpp_add<0x143, 0xc>(v); return v;
}
#define DPP16(CTL) "v_add_f32_dpp %0, %0, %0 " CTL "\n\t" "v_add_f32_dpp %1, %1, %1 " CTL "\n\t" "v_add_f32_dpp %2, %2, %2 " CTL "\n\t" "v_add_f32_dpp %3, %3, %3 " CTL "\n\t" "v_add_f32_dpp %4, %4, %4 " CTL "\n\t" "v_add_f32_dpp %5, %5, %5 " CTL "\n\t" "v_add_f32_dpp %6, %6, %6 " CTL "\n\t" "v_add_f32_dpp %7, %7, %7 " CTL "\n\t" "v_add_f32_dpp %8, %8, %8 " CTL "\n\t" "v_add_f32_dpp %9, %9, %9 " CTL "\n\t" "v_add_f32_dpp %10, %10, %10 " CTL "\n\t" "v_add_f32_dpp %11, %11, %11 " CTL "\n\t" "v_add_f32_dpp %12, %12, %12 " CTL "\n\t" "v_add_f32_dpp %13, %13, %13 " CTL "\n\t" "v_add_f32_dpp %14, %14, %14 " CTL "\n\t" "v_add_f32_dpp %15, %15, %15 " CTL "\n\t"
__device__ __forceinline__ void wave_scan16(float* v) {
    asm volatile("s_nop 1\n\t"
        DPP16("row_shr:1 row_mask:0xf bank_mask:0xf") DPP16("row_shr:2 row_mask:0xf bank_mask:0xf") DPP16("row_shr:4 row_mask:0xf bank_mask:0xf") DPP16("row_shr:8 row_mask:0xf bank_mask:0xf")
        DPP16("row_bcast:15 row_mask:0xa bank_mask:0xf") DPP16("row_bcast:31 row_mask:0xc bank_mask:0xf") "s_nop 1"
        : "+v"(v[0]), "+v"(v[1]), "+v"(v[2]), "+v"(v[3]), "+v"(v[4]), "+v"(v[5]), "+v"(v[6]), "+v"(v[7]), "+v"(v[8]), "+v"(v[9]), "+v"(v[10]), "+v"(v[11]), "+v"(v[12]), "+v"(v[13]), "+v"(v[14]), "+v"(v[15]));
}
__device__ __forceinline__ void unpack8(const v4u v, float* f) {
    f[0] = __uint_as_float(v.x << 16); f[1] = __uint_as_float(v.x & 0xffff0000u); f[2] = __uint_as_float(v.y << 16); f[3] = __uint_as_float(v.y & 0xffff0000u);
    f[4] = __uint_as_float(v.z << 16); f[5] = __uint_as_float(v.z & 0xffff0000u); f[6] = __uint_as_float(v.w << 16); f[7] = __uint_as_float(v.w & 0xffff0000u);
}
__device__ __forceinline__ v4u pack8(const float* f) { v4u o; o.x = pkbf(f[0], f[1]); o.y = pkbf(f[2], f[3]); o.z = pkbf(f[4], f[5]); o.w = pkbf(f[6], f[7]); return o; }
__device__ __forceinline__ s16x4 lds_tr(LAS const unsigned char* p) { return __builtin_bit_cast(s16x4, __builtin_amdgcn_ds_read_tr16_b64_v4i16((LAS s16x4*)p)); }
__device__ __forceinline__ bf16x8 tr_pair(LAS const unsigned char* p0, LAS const unsigned char* p1) {
    const s16x4 a = lds_tr(p0), b = lds_tr(p1); return __builtin_shufflevector(a, b, 0, 1, 2, 3, 4, 5, 6, 7);
}
__device__ __forceinline__ float fexp2(float x) { return __builtin_amdgcn_exp2f(x); }
__device__ __forceinline__ float frcp(float x) { return __builtin_amdgcn_rcpf(x); }
__device__ __forceinline__ float lane63(float v) { return __builtin_bit_cast(float, __builtin_amdgcn_readlane(__builtin_bit_cast(int, v), 63)); }
__device__ __forceinline__ float flog2(float x) { return __builtin_amdgcn_logf(x); }

constexpr size_t ZB_GQ = (size_t)GM * 4096, ZB_GK = ZB_GQ + (size_t)GM * 512, ZB_HQ = ZB_GK + (size_t)GM * 512, ZB_HFF = ZB_HQ + (size_t)GM * 1024, ZB_HFB = ZB_HFF + (size_t)GM * 1024;
constexpr int ZRW = 4096, ZR_GV = 0, ZR_GOG = 1024, ZR_HI = 2048, ZR_HOG = 3072;
__device__ __forceinline__ size_t blk_off(int chunk, int H, int hh, int w) { return (size_t)((chunk * H + hh) * 8 + w) * 1024; }
struct Ctx {
    const float *x_prompt, *x_sample, *w_in, *w_lr2, *b_lr, *gla_g, *hg_g, *lowb, *w_out, *ln1_g, *ln1_b, *w_up, *w_down, *ln2_g, *ln2_b;
    float* out;
    bf16 *Win_t, *Wout_t, *Wup_t, *Wdn_t, *Wglr_t, *HB, *Z, *O, *ST;
    float *BG, *TOT, *TOTS; bf16 *STS, *MF;
};

__device__ __forceinline__ void transpose_item(const float* W, int N, int kb, int nb, bf16* dst, int K, LAS float* scr, int lane) {
    const int k0 = 64 * kb, n0 = 32 * nb;
#pragma unroll 8
    for (int i = 0; i < 32; ++i) { const int kk = 2 * i + (lane >> 5); scr[kk * 33 + (lane & 31)] = W[(size_t)(k0 + kk) * N + n0 + (lane & 31)]; }
    LDS_WAIT(); asm volatile("" ::: "memory");
    const int c = lane & 7;
#pragma unroll
    for (int j = 0; j < 4; ++j) { const int n = (lane >> 3) + 8 * j; const LAS float* s = scr + (8 * c) * 33 + n;
        v4u o; o.x = pkbf(s[0 * 33], s[1 * 33]); o.y = pkbf(s[2 * 33], s[3 * 33]); o.z = pkbf(s[4 * 33], s[5 * 33]); o.w = pkbf(s[6 * 33], s[7 * 33]);
        *(GAS v4u*)(dst + (size_t)n * K + k0 + 8 * c) = o; }
    LDS_WAIT(); asm volatile("" ::: "memory");
}
__device__ __forceinline__ void prologue_weights(const Ctx& X, LAS unsigned char* lds, int gw, int NGW, int wave, int lane) {
    LAS float* scr = (LAS float*)(lds + wave * 16384);
    constexpr int I_IN = 32 * 257, I_OUT = 32 * 64, I_UP = 32 * 256, I_DN = 128 * 64, I_L = I_IN + I_OUT + I_UP + I_DN;
    for (int it = gw; it < NLAYER * I_L; it += NGW) {
        const int l = it / I_L; int r = it % I_L;
        if (r < I_IN) { const int kb = r / 257, nb = r % 257;
            bf16* dst = (nb < 96) ? X.Win_t + ((size_t)l * ZW + 32 * nb) * DM : (nb == 96) ? X.Wglr_t + (size_t)l * 32 * DM : X.Win_t + ((size_t)l * ZW + 32 * (nb - 1)) * DM;
            transpose_item(X.w_in + (size_t)l * DM * INW, INW, kb, nb, dst, DM, scr, lane); continue; }
        r -= I_IN;
        if (r < I_OUT) { const int kb = r / 64, nb = r % 64; transpose_item(X.w_out + (size_t)l * DM * DM, DM, kb, nb, X.Wout_t + ((size_t)l * DM + 32 * nb) * DM, DM, scr, lane); continue; }
        r -= I_OUT;
        if (r < I_UP) { const int kb = r / 256, nb = r % 256; transpose_item(X.w_up + (size_t)l * DM * DFF, DFF, kb, nb, X.Wup_t + ((size_t)l * DFF + 32 * nb) * DM, DM, scr, lane); continue; }
        r -= I_UP;
        { const int kb = r / 64, nb = r % 64; transpose_item(X.w_down + (size_t)l * DFF * DM, DM, kb, nb, X.Wdn_t + ((size_t)l * DM + 32 * nb) * DFF, DFF, scr, lane); }
    }
}
__device__ __forceinline__ void cvt_group(const float* xg, bf16* HB, int gtid, int NT) {
    for (int i = gtid; i < GM * DM / 8; i += NT) {
        const f32x4 a = ((const GAS f32x4*)xg)[2 * i], b = ((const GAS f32x4*)xg)[2 * i + 1];
        v4u o; o.x = pkbf(a.x, a.y); o.y = pkbf(a.z, a.w); o.z = pkbf(b.x, b.y); o.w = pkbf(b.z, b.w);
        ((GAS v4u*)HB)[i] = o; }
}
template <bool RES_F32, bool OUT_F32>
__device__ __forceinline__ void ln_phase(const void* res, const bf16* mf, const float* gam, const float* bet, float* H, bf16* HB, int gw, int NGW, int lane) {
    for (int m = gw; m < GM; m += NGW) {
        f32x4 v[8]; float s = 0.f;
        const GAS v2u* mr = (const GAS v2u*)(mf + (size_t)m * DM) + lane;
#pragma unroll
        for (int j = 0; j < 8; ++j) { f32x4 r;
            if (RES_F32) r = ((const GAS f32x4*)((const float*)res + (size_t)m * DM) + lane)[64 * j];
            else { const v2u w = ((const GAS v2u*)((const bf16*)res + (size_t)m * DM) + lane)[64 * j];
                r = (f32x4){__uint_as_float(w.x << 16), __uint_as_float(w.x & 0xffff0000u), __uint_as_float(w.y << 16), __uint_as_float(w.y & 0xffff0000u)}; }
            const v2u w = mr[64 * j];
            const f32x4 f = (f32x4){__uint_as_float(w.x << 16), __uint_as_float(w.x & 0xffff0000u), __uint_as_float(w.y << 16), __uint_as_float(w.y & 0xffff0000u)};
            v[j] = r * ALPHA + f; s += (v[j].x + v[j].y) + (v[j].z + v[j].w); }
        const float mean = wave_sum(s) * (1.f / DM); float s2 = 0.f;
#pragma unroll
        for (int j = 0; j < 8; ++j) { v[j] = v[j] - mean; s2 += (v[j].x * v[j].x + v[j].y * v[j].y) + (v[j].z * v[j].z + v[j].w * v[j].w); }
        const float rstd = 1.f / sqrtf(wave_sum(s2) * (1.f / DM) + LN_EPS);
#pragma unroll
        for (int j = 0; j < 8; ++j) { const f32x4 g4 = ((const GAS f32x4*)gam)[lane + 64 * j], b4 = ((const GAS f32x4*)bet)[lane + 64 * j];
            const f32x4 o = v[j] * rstd * g4 + b4;
            if (OUT_F32) ((GAS f32x4*)(H + (size_t)m * DM) + lane)[64 * j] = o;
            else { v2u w; w.x = pkbf(o.x, o.y); w.y = pkbf(o.z, o.w); ((GAS v2u*)(HB + (size_t)m * DM) + lane)[64 * j] = w; } }
    }
}

__device__ __forceinline__ void gate_unit(const Ctx& X, int l, int chunk, LAS unsigned char* lds, int tid, int lane, int wave) {
    const int fr = lane & 15, fq = lane >> 4;
    const bf16* A = X.HB + (size_t)chunk * 64 * DM; const bf16* Bw = X.Wglr_t + (size_t)l * 32 * DM;
    f32x4 acc[4][2];
#pragma unroll
    for (int m = 0; m < 4; ++m)
#pragma unroll
        for (int n = 0; n < 2; ++n) acc[m][n] = (f32x4){0.f, 0.f, 0.f, 0.f};
#pragma unroll 2
    for (int ks = 0; ks < 8; ++ks) { const int k0 = 256 * wave + 32 * ks + 8 * fq;
        bf16x8 a[4], b[2];
#pragma unroll
        for (int m = 0; m < 4; ++m) a[m] = *(const GAS bf16x8*)(A + (size_t)(16 * m + fr) * DM + k0);
#pragma unroll
        for (int n = 0; n < 2; ++n) b[n] = *(const GAS bf16x8*)(Bw + (size_t)(16 * n + fr) * DM + k0);
#pragma unroll
        for (int m = 0; m < 4; ++m)
#pragma unroll
            for (int n = 0; n < 2; ++n) acc[m][n] = __builtin_amdgcn_mfma_f32_16x16x32_bf16(a[m], b[n], acc[m][n], 0, 0, 0); }
    LAS float* part = (LAS float*)lds;
#pragma unroll
    for (int m = 0; m < 4; ++m)
#pragma unroll
        for (int n = 0; n < 2; ++n)
#pragma unroll
            for (int j = 0; j < 4; ++j) part[(wave * 64 + 16 * m + 4 * fq + j) * 33 + 16 * n + fr] = acc[m][n][j];
    __syncthreads();
    LAS float* glr = (LAS float*)(lds + 8 * 64 * 33 * 4);
#pragma unroll
    for (int k = 0; k < 4; ++k) { const int idx = tid + 512 * k, t = idx >> 5, n = idx & 31; float s = 0.f;
#pragma unroll
        for (int w = 0; w < 8; ++w) s += part[(w * 64 + t) * 33 + n];
        glr[t * 36 + n] = s; }
    __syncthreads();
    const int dir = wave >> 2;
    const float* w2 = X.w_lr2 + (size_t)(l * 2 + dir) * 16 * 512; const float* bl = X.b_lr + (size_t)(l * 2 + dir) * 512;
    for (int cb = 0; cb < 2; ++cb) { const int c = 128 * (wave & 3) + 64 * cb + lane;
        float w[16];
#pragma unroll
        for (int r = 0; r < 16; ++r) w[r] = w2[r * 512 + c];
        const float bias = bl[c];
        bf16* bgcol = (bf16*)X.BG + ((size_t)(((chunk * 4 + (c >> 7)) * 8 + ((c & 127) >> 4)) * 2 + dir) * 64) * 16 + (c & 15);
#pragma unroll 4
        for (int tt = 0; tt < 64; ++tt) { const int t = dir ? 63 - tt : tt;
            const LAS f32x4* gr = (const LAS f32x4*)(glr + t * 36 + dir * 16); const f32x4 g0 = gr[0], g1 = gr[1], g2 = gr[2], g3 = gr[3];
            float pre = bias;
            pre += g0.x * w[0] + g0.y * w[1] + g0.z * w[2] + g0.w * w[3]; pre += g1.x * w[4] + g1.y * w[5] + g1.z * w[6] + g1.w * w[7];
            pre += g2.x * w[8] + g2.y * w[9] + g2.z * w[10] + g2.w * w[11]; pre += g3.x * w[12] + g3.y * w[13] + g3.z * w[14] + g3.w * w[15];
            const float gl = (fminf(pre, 0.f) - __logf(1.f + __expf(-fabsf(pre)))) * (LOG2E / 16.f);
            bgcol[(size_t)t * 16] = (bf16)(pkbf(gl, gl) & 0xffffu); } }
    __syncthreads();
}

__device__ __forceinline__ size_t st_slot(int chunk, bool hgt, int h, int dir) { return (size_t)chunk * ST_CHUNK + (hgt ? 262144 + (h * 2 + dir) * 16384 : (h * 2 + dir) * 32768); }

template <bool HGT> struct RawIn { v4u b[2]; v4u k[2]; };
template <> struct RawIn<true> { v4u k[2]; };
template <bool HGT>
__device__ __forceinline__ RawIn<HGT> pass_s_load(const Ctx& X, int chunk, int h, int dir, int lane, int c0) {
    RawIn<HGT> r; const int rt = dir ? 63 - lane : lane, w = c0 >> 4;
    if constexpr (!HGT) { const GAS v4u* bg = (const GAS v4u*)((const bf16*)X.BG + ((size_t)(((chunk * 4 + h) * 8 + w) * 2 + dir) * 64 + rt) * 16);
        r.b[0] = bg[0]; r.b[1] = bg[1];
        const GAS v4u* kp = (const GAS v4u*)(X.Z + ZB_GK + blk_off(chunk, 4, h, w) + rt * 16); r.k[0] = kp[0]; r.k[1] = kp[1];
    } else { const GAS v4u* zp = (const GAS v4u*)(X.Z + (dir ? ZB_HFB : ZB_HFF) + blk_off(chunk, 8, h, w) + rt * 16); r.k[0] = zp[0]; r.k[1] = zp[1]; }
    return r;
}
template <bool HGT, bool STORE>
__device__ __forceinline__ void pass_s_unit(const Ctx& X, int l, int sc, int h, LAS unsigned char* lds, int tid, int lane, int wave) {
    constexpr int DV = HGT ? 128 : 256, VSTR = DV * 2 + 16, NE = DV / 16, PPR = DV / 8, UNR_D = HGT ? 2 : 1, UNR_C = HGT ? 4 : 1;
    const int fr = lane & 15, fq = lane >> 4, qq = fr >> 2, p4 = fr & 3, c0 = 16 * wave;
    RawIn<HGT> cur = pass_s_load<HGT>(X, sc * 4, h, 0, lane, c0);
    RawIn<HGT> rq[HGT ? 4 : 1];
    { const int vcol = HGT ? ZR_HI + h * 128 : ZR_GV + h * 256;
#pragma unroll 4
      for (int k = 0; k < 256 * PPR / 512; ++k) { const int idx = tid + 512 * k, row = idx / PPR, pc = idx % PPR;
        const v4u v = *(const GAS v4u*)(X.Z + (size_t)(sc * 256 + row) * ZRW + vcol + pc * 8);
        *(LAS v4u*)(lds + row * VSTR + pc * 16) = v; } }
    __syncthreads();
    LAS unsigned char* kt = lds + SV_KT + wave * KTW_BYTES;
    for (int dir = 0; dir < 2; ++dir) {
        const int hd = HGT ? 8 + h * 2 + dir : h * 2 + dir;
        if constexpr (HGT) {
#pragma unroll
            for (int q4 = 0; q4 < 4; ++q4) rq[q4] = pass_s_load<HGT>(X, sc * 4 + (dir ? 3 - q4 : q4), h, dir, lane, c0); }
        float lbv[16];
        if (HGT) {
#pragma unroll
            for (int i = 0; i < 16; ++i) lbv[i] = 0.f;
            if (l != 0) { const float* lp = X.lowb + (size_t)dir * 2 * 1024 + h * 128 + c0;
#pragma unroll
                for (int i = 0; i < 16; ++i) lbv[i] = frcp(1.f + __expf(lp[i] - lp[1024 + i])); } }
        f32x4 acc[NE];
        if (STORE) { const bf16* sin = X.STS + st_slot(sc, HGT, h, dir);
#pragma unroll
            for (int et = 0; et < NE; ++et) { const v2u w = *(const GAS v2u*)(sin + (size_t)((et * 4 + (wave >> 1)) * 64 + fr + 16 * (2 * (wave & 1) + (fq >> 1))) * 8 + 4 * (fq & 1));
                acc[et] = (f32x4){__uint_as_float(w.x << 16), __uint_as_float(w.x & 0xffff0000u), __uint_as_float(w.y << 16), __uint_as_float(w.y & 0xffff0000u)}; }
        } else {
#pragma unroll
            for (int et = 0; et < NE; ++et) acc[et] = (f32x4){0.f, 0.f, 0.f, 0.f}; }
        float run[16];
#pragma unroll
        for (int i = 0; i < 16; ++i) run[i] = 0.f;
#pragma unroll UNR_C
        for (int cc = 0; cc < 4; ++cc) { const int ci = dir ? 3 - cc : cc, chunk = sc * 4 + ci;
            RawIn<HGT> nxt = cur;
            if constexpr (HGT) cur = rq[cc];
            else { if (cc < 3) nxt = pass_s_load<HGT>(X, sc * 4 + (dir ? 2 - cc : cc + 1), h, dir, lane, c0);
                   else if (dir == 0) nxt = pass_s_load<HGT>(X, sc * 4 + 3, h, 1, lane, c0); }
            float bc[16], kr[16];
            if constexpr (!HGT) {
                unpack8(cur.b[0], bc); unpack8(cur.b[1], bc + 8); wave_scan16(bc);
                unpack8(cur.k[0], kr); unpack8(cur.k[1], kr + 8);
            } else {
                float zf[16]; unpack8(cur.k[0], zf); unpack8(cur.k[1], zf + 8);
#pragma unroll
                for (int i = 0; i < 16; ++i) {
                    const float z = __builtin_amdgcn_fmed3f(zf[i], -60.f, 60.f), e = fexp2(z * -LOG2E), sig = frcp(1.f + e), oml = 1.f - lbv[i];
                    kr[i] = oml - oml * sig;
                    bc[i] = flog2(lbv[i] + oml * sig); }
                wave_scan16(bc);
            }
            if (STORE) { bf16* slot = X.ST + st_slot(chunk, HGT, h, dir);
#pragma unroll
                for (int et = 0; et < NE; ++et) { v2u w; w.x = pkbf(acc[et][0], acc[et][1]); w.y = pkbf(acc[et][2], acc[et][3]);
                    *(GAS v2u*)(slot + (size_t)((et * 4 + (wave >> 1)) * 64 + fr + 16 * (2 * (wave & 1) + (fq >> 1))) * 8 + 4 * (fq & 1)) = w; }
                if (cc == 3) { cur = nxt; break; } }
            float kh[16];
#pragma unroll
            for (int i = 0; i < 16; ++i) { const float bl = lane63(bc[i]); kh[i] = kr[i] * fexp2(bl - bc[i]); run[i] += bl; }
            { const v4u k0 = pack8(kh), k1 = pack8(kh + 8); const unsigned kw[8] = {k0.x, k0.y, k0.z, k0.w, k1.x, k1.y, k1.z, k1.w};
#pragma unroll
              for (int i = 0; i < 16; ++i) *(LAS unsigned short*)(kt + i * KT_STR + lane * 2) = (unsigned short)((i & 1) ? (kw[i >> 1] >> 16) : (kw[i >> 1] & 0xffffu)); }
            if (lane == 63) {
#pragma unroll
                for (int i = 0; i < 4; ++i) ((LAS f32x4*)(kt + 2304))[i] = (f32x4){bc[4 * i], bc[4 * i + 1], bc[4 * i + 2], bc[4 * i + 3]}; }
            asm volatile("s_waitcnt lgkmcnt(0)" ::: "memory");
            const f32x4 dl = *(const LAS f32x4*)(kt + 2304 + 16 * fq);
            const f32x4 dec = (f32x4){fexp2(dl.x), fexp2(dl.y), fexp2(dl.z), fexp2(dl.w)};
            bf16x8 afr[2];
#pragma unroll
            for (int ks = 0; ks < 2; ++ks) afr[ks] = *(const LAS bf16x8*)(kt + fr * KT_STR + (32 * ks + 8 * fq) * 2);
#pragma unroll
            for (int et = 0; et < NE; ++et) acc[et] = acc[et] * dec;
            { constexpr int NB = 2 * NE / 4;
              LAS const unsigned char* vb[2][2];
#pragma unroll
              for (int ks = 0; ks < 2; ++ks) { const int r0 = 32 * ks + 8 * fq + qq, r1 = r0 + 4;
                  vb[ks][0] = lds + (ci * 64 + (dir ? 63 - r0 : r0)) * VSTR + 8 * p4; vb[ks][1] = lds + (ci * 64 + (dir ? 63 - r1 : r1)) * VSTR + 8 * p4; }
              bf16x8 bb[2][4];
#pragma unroll
              for (int j = 0; j < 4; ++j) bb[0][j] = tr_pair(vb[0][0] + 32 * j, vb[0][1] + 32 * j);
#pragma unroll
              for (int b = 0; b < NB; ++b) {
                  if (b + 1 < NB) { const int ks1 = (b + 1) / (NE / 4), e1 = 4 * ((b + 1) % (NE / 4));
#pragma unroll
                      for (int j = 0; j < 4; ++j) bb[(b + 1) & 1][j] = tr_pair(vb[ks1][0] + 32 * (e1 + j), vb[ks1][1] + 32 * (e1 + j)); }
                  const int ks0 = b / (NE / 4), e0 = 4 * (b % (NE / 4));
#pragma unroll
                  for (int j = 0; j < 4; ++j) acc[e0 + j] = __builtin_amdgcn_mfma_f32_16x16x32_bf16(afr[ks0], bb[b & 1][j], acc[e0 + j], 0, 0, 0);
                  __builtin_amdgcn_sched_group_barrier(0x100, 8, 0); __builtin_amdgcn_sched_group_barrier(0x008, 4, 0); } }
            asm volatile("s_waitcnt lgkmcnt(0)" ::: "memory");
            cur = nxt;
        }
        if (!STORE) { bf16* sout = X.STS + st_slot(sc, HGT, h, dir);
#pragma unroll
            for (int et = 0; et < NE; ++et) { v2u w; w.x = pkbf(acc[et][0], acc[et][1]); w.y = pkbf(acc[et][2], acc[et][3]);
                *(GAS v2u*)(sout + (size_t)((et * 4 + (wave >> 1)) * 64 + fr + 16 * (2 * (wave & 1) + (fq >> 1))) * 8 + 4 * (fq & 1)) = w; }
            if (lane == 0) { float* tp = X.TOTS + ((size_t)sc * 24 + hd) * 128 + c0;
#pragma unroll
                for (int i = 0; i < 4; ++i) ((GAS f32x4*)tp)[i] = (f32x4){run[4 * i], run[4 * i + 1], run[4 * i + 2], run[4 * i + 3]}; } }
    }
    __syncthreads();
}
__device__ __forceinline__ void pass_b_super(const Ctx& X, int g, int gtid, int NT) {
    const int ns = (g == 0) ? 1 : 2, nc = NSC / ns;
    for (int v = gtid; v < ns * (ST_CHUNK / 8); v += NT) {
        const int s = v / (ST_CHUNK / 8), idx = (v % (ST_CHUNK / 8)) * 8;
        const int hd = idx < 262144 ? idx / 32768 : 8 + (idx - 262144) / 16384, db = hd & 1;
        const int d0 = 32 * ((idx >> 9) & 3) + 8 * ((idx >> 7) & 3);
        float S[8];
#pragma unroll
        for (int i = 0; i < 8; ++i) S[i] = 0.f;
        for (int cc = 0; cc < nc; cc += 8) {
            v4u x[8]; f32x4 t0[8], t1[8];
#pragma unroll
            for (int u = 0; u < 8; ++u) { const int c = s * nc + (db ? nc - 1 - (cc + u) : cc + u);
                x[u] = *(const GAS v4u*)(X.STS + (size_t)c * ST_CHUNK + idx);
                const GAS f32x4* tp = (const GAS f32x4*)(X.TOTS + ((size_t)c * 24 + hd) * 128 + d0); t0[u] = tp[0]; t1[u] = tp[1]; }
#pragma unroll
            for (int u = 0; u < 8; ++u) { const int c = s * nc + (db ? nc - 1 - (cc + u) : cc + u);
                *(GAS v4u*)(X.STS + (size_t)c * ST_CHUNK + idx) = pack8(S);
                float dx[8]; unpack8(x[u], dx);
                const float dec[8] = {fexp2(t0[u].x), fexp2(t0[u].y), fexp2(t0[u].z), fexp2(t0[u].w), fexp2(t1[u].x), fexp2(t1[u].y), fexp2(t1[u].z), fexp2(t1[u].w)};
#pragma unroll
                for (int i = 0; i < 8; ++i) S[i] = dec[i] * S[i] + dx[i]; }
        }
    }
}

constexpr int C2_DIR = 63488, C2_QD = 0, C2_KD = 17408, C2_QH = 34816, C2_P = 52224, C2_BT = 61440, C2_V = 126976, C2_RED = 160768;
template <bool HGT>
__device__ __forceinline__ void c2_stage(const Ctx& X, int l, int chunk, int h, int dir, LAS unsigned char* ld, int lane, int wave) {
    const int r = lane, rt = dir ? 63 - r : r, c0 = 16 * wave;
    float bc[16], kr[16], qv[16];
    if (!HGT) {
        const GAS v4u* bg = (const GAS v4u*)((const bf16*)X.BG + ((size_t)(((chunk * 4 + h) * 8 + wave) * 2 + dir) * 64 + rt) * 16);
        unpack8(bg[0], bc); unpack8(bg[1], bc + 8); wave_scan16(bc);
        const GAS v4u* kp = (const GAS v4u*)(X.Z + ZB_GK + blk_off(chunk, 4, h, wave) + rt * 16); unpack8(kp[0], kr); unpack8(kp[1], kr + 8);
        const GAS v4u* qp = (const GAS v4u*)(X.Z + ZB_GQ + blk_off(chunk, 4, h, wave) + rt * 16); unpack8(qp[0], qv); unpack8(qp[1], qv + 8);
#pragma unroll
        for (int i = 0; i < 16; ++i) qv[i] *= 0.08838834764831845f;
    } else {
        float zf[16];
        const GAS v4u* zp = (const GAS v4u*)(X.Z + (dir ? ZB_HFB : ZB_HFF) + blk_off(chunk, 8, h, wave) + rt * 16); unpack8(zp[0], zf); unpack8(zp[1], zf + 8);
        const GAS v4u* qp = (const GAS v4u*)(X.Z + ZB_HQ + blk_off(chunk, 8, h, wave) + rt * 16); unpack8(qp[0], qv); unpack8(qp[1], qv + 8);
        float lbv[16];
        if (l == 0) {
#pragma unroll
            for (int i = 0; i < 16; ++i) lbv[i] = 0.f;
        } else { const float* lp = X.lowb + (size_t)dir * 2 * 1024 + h * 128 + c0;
#pragma unroll
            for (int i = 0; i < 16; ++i) lbv[i] = frcp(1.f + __expf(lp[i] - lp[1024 + i])); }
#pragma unroll
        for (int i = 0; i < 16; ++i) {
            const float z = __builtin_amdgcn_fmed3f(zf[i], -60.f, 60.f), e = fexp2(z * -LOG2E), sig = frcp(1.f + e), oml = 1.f - lbv[i];
            kr[i] = oml - oml * sig;
            bc[i] = flog2(lbv[i] + oml * sig); }
        wave_scan16(bc);
    }
    float qd[16], kd[16], qh[16];
#pragma unroll
    for (int i = 0; i < 16; ++i) {
        const float beta = __builtin_bit_cast(float, __builtin_amdgcn_update_dpp(0, __builtin_bit_cast(int, bc[i]), 0x142, 0xe, 0xf, false));
        qd[i] = qv[i] * fexp2(bc[i] - beta); kd[i] = kr[i] * fexp2(__builtin_amdgcn_fmed3f(beta - bc[i], 0.f, 80.f)); qh[i] = qv[i] * fexp2(bc[i]); }
    LAS unsigned char* p = ld + r * K_STR + c0 * 2;
    ((LAS v4u*)(p + C2_QD))[0] = pack8(qd); ((LAS v4u*)(p + C2_QD))[1] = pack8(qd + 8);
    ((LAS v4u*)(p + C2_KD))[0] = pack8(kd); ((LAS v4u*)(p + C2_KD))[1] = pack8(kd + 8);
    ((LAS v4u*)(p + C2_QH))[0] = pack8(qh); ((LAS v4u*)(p + C2_QH))[1] = pack8(qh + 8);
    if ((lane & 15) == 15) { LAS f32x4* bt = (LAS f32x4*)(ld + C2_BT + (((lane >> 4) + 1) & 3) * 512 + c0 * 4);
        const bool z = lane == 63;
#pragma unroll
        for (int i = 0; i < 4; ++i) bt[i] = z ? (f32x4){0.f, 0.f, 0.f, 0.f} : (f32x4){bc[4 * i], bc[4 * i + 1], bc[4 * i + 2], bc[4 * i + 3]}; }
}
template <bool HGT>
__device__ __forceinline__ void pass_c2_unit(const Ctx& X, int l, int chunk, int h, LAS unsigned char* lds, int tid, int lane, int wave) {
    constexpr int DV = HGT ? 128 : 256, VSTR = DV * 2 + 16, NET = DV / 128, PPR = DV / 8;
    const int fr = lane & 15, fq = lane >> 4, qq = fr >> 2, p4 = fr & 3;
    { const int vcol = HGT ? ZR_HI + h * 128 : ZR_GV + h * 256;
#pragma unroll
      for (int k = 0; k < 64 * PPR / 512; ++k) { const int idx = tid + 512 * k, row = idx / PPR, pc = idx % PPR;
        const v4u v = *(const GAS v4u*)(X.Z + (size_t)(chunk * 64 + row) * ZRW + vcol + pc * 8);
        *(LAS v4u*)(lds + C2_V + row * VSTR + pc * 16) = v; } }
    c2_stage<HGT>(X, l, chunk, h, 0, lds, lane, wave);
    c2_stage<HGT>(X, l, chunk, h, 1, lds + C2_DIR, lane, wave);
    bf16x8 sfr[2][NET][4];
#pragma unroll
    for (int dir = 0; dir < 2; ++dir) { const bf16* slot = X.ST + st_slot(chunk, HGT, h, dir);
#pragma unroll
        for (int et = 0; et < NET; ++et)
#pragma unroll
            for (int ks = 0; ks < 4; ++ks) sfr[dir][et][ks] = *(const GAS bf16x8*)(slot + (size_t)(((wave * NET + et) * 4 + ks) * 64 + lane) * 8); }
    __syncthreads();
    { const int a = wave & 3; LAS unsigned char* ld = lds + (wave >> 2) * C2_DIR;
      const unsigned lst = (a == 0) ? 0xff002010u : (a == 1) ? 0xff113021u : (a == 2) ? 0xffff2231u : 0xffff3332u;
      const unsigned zls = (a == 0) ? 0xffff0201u : (a == 1) ? 0xffff1203u : (a == 2) ? 0xffffff13u : 0xffffff23u;
      for (int t = 0; t < 3; ++t) { const unsigned code = (lst >> (8 * t)) & 0xffu; if (code == 0xffu) break;
          const int I = (int)(code >> 4), J = (int)(code & 15u);
          f32x4 sc = (f32x4){0.f, 0.f, 0.f, 0.f};
#pragma unroll
          for (int ks = 0; ks < 4; ++ks) { const int dc = 32 * ks + 8 * fq;
              v4u ka = *(const LAS v4u*)(ld + C2_KD + (16 * J + fr) * K_STR + dc * 2);
              const bf16x8 qb = *(const LAS bf16x8*)(ld + C2_QD + (16 * I + fr) * K_STR + dc * 2);
              if (J < I) { const LAS f32x4* bi = (const LAS f32x4*)(ld + C2_BT + I * 512 + dc * 4); const LAS f32x4* bj = (const LAS f32x4*)(ld + C2_BT + J * 512 + dc * 4);
                  const f32x4 d0 = bi[0] - bj[0], d1 = bi[1] - bj[1]; float kf[8]; unpack8(ka, kf);
                  kf[0] *= fexp2(d0.x); kf[1] *= fexp2(d0.y); kf[2] *= fexp2(d0.z); kf[3] *= fexp2(d0.w); kf[4] *= fexp2(d1.x); kf[5] *= fexp2(d1.y); kf[6] *= fexp2(d1.z); kf[7] *= fexp2(d1.w);
                  ka = pack8(kf); }
              sc = __builtin_amdgcn_mfma_f32_16x16x32_bf16(__builtin_bit_cast(bf16x8, ka), qb, sc, 0, 0, 0); }
          if (J == I) {
#pragma unroll
              for (int u = 0; u < 4; ++u) if (4 * fq + u > fr) sc[u] = 0.f; }
          v2u w; w.x = pkbf(sc[0], sc[1]); w.y = pkbf(sc[2], sc[3]);
          *(LAS v2u*)(ld + C2_P + (16 * I + fr) * P_STR + (16 * J + 4 * fq) * 2) = w; }
      for (int t = 0; t < 2; ++t) { const unsigned code = (zls >> (8 * t)) & 0xffu; if (code == 0xffu) break;
          const int I = (int)(code >> 4), J = (int)(code & 15u);
          *(LAS v2u*)(ld + C2_P + (16 * I + fr) * P_STR + (16 * J + 4 * fq) * 2) = (v2u){0u, 0u}; } }
    __syncthreads();
    f32x4 oacc[NET][4];
#pragma unroll
    for (int et = 0; et < NET; ++et)
#pragma unroll
        for (int it = 0; it < 4; ++it) oacc[et][it] = (f32x4){0.f, 0.f, 0.f, 0.f};
#pragma unroll
    for (int dir = 0; dir < 2; ++dir) { LAS const unsigned char* ld = lds + dir * C2_DIR;
        bf16x8 vfr[NET][2];
#pragma unroll
        for (int ks = 0; ks < 2; ++ks) { const int r0 = 32 * ks + 8 * fq + qq, r1 = r0 + 4, v0 = dir ? 63 - r0 : r0, v1 = dir ? 63 - r1 : r1;
#pragma unroll
            for (int et = 0; et < NET; ++et) { const int col = (16 * (wave * NET + et) + 4 * p4) * 2;
                vfr[et][ks] = tr_pair(lds + C2_V + v0 * VSTR + col, lds + C2_V + v1 * VSTR + col); } }
#pragma unroll
        for (int it = 0; it < 4; ++it) { const int trow = 16 * it + fr, ip = dir ? 63 - trow : trow;
            bf16x8 bo[6];
#pragma unroll
            for (int ks = 0; ks < 4; ++ks) bo[ks] = *(const LAS bf16x8*)(ld + C2_QH + ip * K_STR + (32 * ks + 8 * fq) * 2);
#pragma unroll
            for (int ks = 0; ks < 2; ++ks) bo[4 + ks] = *(const LAS bf16x8*)(ld + C2_P + ip * P_STR + (32 * ks + 8 * fq) * 2);
#pragma unroll
            for (int ks = 0; ks < 4; ++ks)
#pragma unroll
                for (int et = 0; et < NET; ++et) oacc[et][it] = __builtin_amdgcn_mfma_f32_16x16x32_bf16(sfr[dir][et][ks], bo[ks], oacc[et][it], 0, 0, 0);
#pragma unroll
            for (int ks = 0; ks < 2; ++ks)
#pragma unroll
                for (int et = 0; et < NET; ++et) oacc[et][it] = __builtin_amdgcn_mfma_f32_16x16x32_bf16(vfr[et][ks], bo[4 + ks], oacc[et][it], 0, 0, 0); } }
    LAS float* red = (LAS float*)(lds + C2_RED);
#pragma unroll
    for (int it = 0; it < 4; ++it) { float sq = 0.f;
#pragma unroll
        for (int et = 0; et < NET; ++et) { const f32x4 o = oacc[et][it]; sq += (o.x * o.x + o.y * o.y) + (o.z * o.z + o.w * o.w); }
        sq += __shfl_xor(sq, 16); sq += __shfl_xor(sq, 32);
        if (fq == 0) red[wave * 64 + 16 * it + fr] = sq; }
    __syncthreads();
    const float* ng = (HGT ? X.hg_g + (size_t)l * 128 : X.gla_g + (size_t)l * 256);
    const int ogcol = HGT ? ZR_HOG + h * 128 : ZR_GOG + h * 256, ocol = HGT ? 1024 + h * 128 : h * 256;
#pragma unroll
    for (int it = 0; it < 4; ++it) { float tot = 0.f;
#pragma unroll
        for (int w = 0; w < 8; ++w) tot += red[w * 64 + 16 * it + fr];
        const float rstd = __builtin_amdgcn_rsqf(tot * (1.f / DV) + RMS_EPS);
        const int tok = chunk * 64 + 16 * it + fr;
#pragma unroll
        for (int et = 0; et < NET; ++et) { const int e0 = 16 * (wave * NET + et) + 4 * fq;
            const v2u ogp = *(const GAS v2u*)(X.Z + (size_t)tok * ZRW + ogcol + e0);
            const float og[4] = {__uint_as_float(ogp.x << 16), __uint_as_float(ogp.x & 0xffff0000u), __uint_as_float(ogp.y << 16), __uint_as_float(ogp.y & 0xffff0000u)};
            const f32x4 g4 = *(const GAS f32x4*)(ng + e0); float rr[4];
#pragma unroll
            for (int u = 0; u < 4; ++u) { const float z = og[u]; rr[u] = oacc[et][it][u] * rstd * g4[u] * (z * frcp(1.f + fexp2(z * -LOG2E))); }
            v2u w; w.x = pkbf(rr[0], rr[1]); w.y = pkbf(rr[2], rr[3]);
            *(GAS v2u*)(X.O + (size_t)tok * DM + ocol + e0) = w; } }
}

constexpr int F_QD = 0, F_KD = 17408, F_QH = 34816, F_P = 52224, F_BT = 61440, F_KT = 63488, F_DEC = 81920, F_V = 82432, F_RED = 116224;
template <bool HGT> struct RawF { v4u x[HGT ? 4 : 6]; v4u v[HGT ? 2 : 4]; };
template <bool HGT>
__device__ __forceinline__ RawF<HGT> f_load(const Ctx& X, int chunk, int h, int dir, int tid, int lane, int wave) {
    constexpr int DV = HGT ? 128 : 256, PPR = DV / 8;
    RawF<HGT> R; const int rt = dir ? 63 - lane : lane;
    if constexpr (!HGT) {
        const GAS v4u* bg = (const GAS v4u*)((const bf16*)X.BG + ((size_t)(((chunk * 4 + h) * 8 + wave) * 2 + dir) * 64 + rt) * 16); R.x[0] = bg[0]; R.x[1] = bg[1];
        const GAS v4u* kp = (const GAS v4u*)(X.Z + ZB_GK + blk_off(chunk, 4, h, wave) + rt * 16); R.x[2] = kp[0]; R.x[3] = kp[1];
        const GAS v4u* qp = (const GAS v4u*)(X.Z + ZB_GQ + blk_off(chunk, 4, h, wave) + rt * 16); R.x[4] = qp[0]; R.x[5] = qp[1];
    } else {
        const GAS v4u* zp = (const GAS v4u*)(X.Z + (dir ? ZB_HFB : ZB_HFF) + blk_off(chunk, 8, h, wave) + rt * 16); R.x[0] = zp[0]; R.x[1] = zp[1];
        const GAS v4u* qp = (const GAS v4u*)(X.Z + ZB_HQ + blk_off(chunk, 8, h, wave) + rt * 16); R.x[2] = qp[0]; R.x[3] = qp[1]; }
    const int vcol = HGT ? ZR_HI + h * 128 : ZR_GV + h * 256;
#pragma unroll
    for (int k = 0; k < 64 * PPR / 512; ++k) { const int idx = tid + 512 * k, row = idx / PPR, pc = idx % PPR;
        R.v[k] = *(const GAS v4u*)(X.Z + (size_t)(chunk * 64 + row) * ZRW + vcol + pc * 8); }
    return R;
}
template <bool HGT>
__device__ __forceinline__ void f_stage(const Ctx& X, int l, const RawF<HGT>& R, int h, int dir, LAS unsigned char* ld, int lane, int wave) {
    const int r = lane, c0 = 16 * wave;
    float bc[16], kr[16], qv[16];
    if constexpr (!HGT) {
        unpack8(R.x[0], bc); unpack8(R.x[1], bc + 8); wave_scan16(bc);
        unpack8(R.x[2], kr); unpack8(R.x[3], kr + 8);
        unpack8(R.x[4], qv); unpack8(R.x[5], qv + 8);
#pragma unroll
        for (int i = 0; i < 16; ++i) qv[i] *= 0.08838834764831845f;
    } else {
        float zf[16];
        unpack8(R.x[0], zf); unpack8(R.x[1], zf + 8);
        unpack8(R.x[2], qv); unpack8(R.x[3], qv + 8);
        float lbv[16];
        if (l == 0) {
#pragma unroll
            for (int i = 0; i < 16; ++i) lbv[i] = 0.f;
        } else { const float* lp = X.lowb + (size_t)dir * 2 * 1024 + h * 128 + c0;
#pragma unroll
            for (int i = 0; i < 16; ++i) lbv[i] = frcp(1.f + __expf(lp[i] - lp[1024 + i])); }
#pragma unroll
        for (int i = 0; i < 16; ++i) {
            const float z = __builtin_amdgcn_fmed3f(zf[i], -60.f, 60.f), e = fexp2(z * -LOG2E), sig = frcp(1.f + e), oml = 1.f - lbv[i];
            kr[i] = oml - oml * sig;
            bc[i] = flog2(lbv[i] + oml * sig); }
        wave_scan16(bc);
    }
    float qd[16], kd[16], qh[16], kh[16], tl[16];
#pragma unroll
    for (int i = 0; i < 16; ++i) {
        const float beta = __builtin_bit_cast(float, __builtin_amdgcn_update_dpp(0, __builtin_bit_cast(int, bc[i]), 0x142, 0xe, 0xf, false));
        tl[i] = lane63(bc[i]);
        qd[i] = qv[i] * fexp2(bc[i] - beta); kd[i] = kr[i] * fexp2(__builtin_amdgcn_fmed3f(beta - bc[i], 0.f, 80.f)); qh[i] = qv[i] * fexp2(bc[i]); kh[i] = kr[i] * fexp2(tl[i] - bc[i]); }
    LAS unsigned char* p = ld + r * K_STR + c0 * 2;
    ((LAS v4u*)(p + F_QD))[0] = pack8(qd); ((LAS v4u*)(p + F_QD))[1] = pack8(qd + 8);
    ((LAS v4u*)(p + F_KD))[0] = pack8(kd); ((LAS v4u*)(p + F_KD))[1] = pack8(kd + 8);
    { const v4u q0 = pack8(qh), q1 = pack8(qh + 8);
      LAS unsigned char* pq = ld + F_QH + r * K_STR + (wave >> 1) * 64 + (wave & 1) * 8;
      *(LAS v2u*)(pq) = (v2u){q0.x, q0.y}; *(LAS v2u*)(pq + 16) = (v2u){q0.z, q0.w}; *(LAS v2u*)(pq + 32) = (v2u){q1.x, q1.y}; *(LAS v2u*)(pq + 48) = (v2u){q1.z, q1.w}; }
    { const v4u k0 = pack8(kh), k1 = pack8(kh + 8); const unsigned kw[8] = {k0.x, k0.y, k0.z, k0.w, k1.x, k1.y, k1.z, k1.w};
#pragma unroll
      for (int i = 0; i < 16; ++i) *(LAS unsigned short*)(ld + F_KT + (c0 + i) * KT_STR + lane * 2) = (unsigned short)((i & 1) ? (kw[i >> 1] >> 16) : (kw[i >> 1] & 0xffffu)); }
    if ((lane & 15) == 15) { LAS f32x4* bt = (LAS f32x4*)(ld + F_BT + (((lane >> 4) + 1) & 3) * 512 + c0 * 4);
        const bool z = lane == 63;
#pragma unroll
        for (int i = 0; i < 4; ++i) bt[i] = z ? (f32x4){0.f, 0.f, 0.f, 0.f} : (f32x4){bc[4 * i], bc[4 * i + 1], bc[4 * i + 2], bc[4 * i + 3]};
        if (z) { LAS f32x4* dc = (LAS f32x4*)(ld + F_DEC + c0 * 4);
#pragma unroll
            for (int i = 0; i < 4; ++i) dc[i] = (f32x4){fexp2(tl[4 * i]), fexp2(tl[4 * i + 1]), fexp2(tl[4 * i + 2]), fexp2(tl[4 * i + 3])}; } }
}
template <bool HGT>
__device__ __forceinline__ void pass_f_unit(const Ctx& X, int l, int sc, int h, float* scr, LAS unsigned char* lds, int tid_, int lane_, int wave) {
    constexpr int DV = HGT ? 128 : 256, VSTR = DV * 2 + 16, NET = DV / 128, PPR = DV / 8;
    if (tid_ < 384) { const int tid = tid_; const int tile = tid >> 6, row = (tid >> 2) & 15, part = tid & 3;
        const unsigned code = (tile < 4) ? (0x12030201u >> (8 * tile)) & 0xffu : (0x2313u >> (8 * (tile - 4))) & 0xffu;
        const unsigned zz = (unsigned)tid >> 20;
        *(LAS v2u*)(lds + F_P + (16 * (int)(code >> 4) + row) * P_STR + (16 * (int)(code & 15u) + 4 * part) * 2) = (v2u){zz, zz}; }
    const float* ng = (HGT ? X.hg_g + (size_t)l * 128 : X.gla_g + (size_t)l * 256);
    const int ogcol = HGT ? ZR_HOG + h * 128 : ZR_GOG + h * 256, ocol = HGT ? 1024 + h * 128 : h * 256;
    RawF<HGT> raw = f_load<HGT>(X, sc * 4 + 3, h, 1, tid_, lane_, wave);
#pragma unroll 1
    for (int sw = 0; sw < 2; ++sw) { const int dir = 1 - sw;
        f32x4 S[8][NET];
        { const bf16* sin = X.STS + st_slot(sc, HGT, h, dir); const int fr = lane_ & 15, fq = lane_ >> 4;
#pragma unroll
          for (int T = 0; T < 8; ++T)
#pragma unroll
            for (int et = 0; et < NET; ++et) { const v2u w = *(const GAS v2u*)(sin + (size_t)(((wave * NET + et) * 4 + (T >> 1)) * 64 + fr + 16 * (2 * (T & 1) + (fq >> 1))) * 8 + 4 * (fq & 1));
                S[T][et] = (f32x4){__uint_as_float(w.x << 16), __uint_as_float(w.x & 0xffff0000u), __uint_as_float(w.y << 16), __uint_as_float(w.y & 0xffff0000u)}; } }
#pragma unroll 1
        for (int cc = 0; cc < 4; ++cc) { const int ci = dir ? 3 - cc : cc, chunk = sc * 4 + ci;
            int tq = tid_; asm volatile("" : "+v"(tq));
            const int tid = tq, lane = tq & 63, fr = lane & 15, fq = lane >> 4, qq = fr >> 2, p4 = fr & 3;
            {
#pragma unroll
              for (int k = 0; k < 64 * PPR / 512; ++k) { const int idx = tid + 512 * k, row = idx / PPR, pc = idx % PPR;
                *(LAS v4u*)(lds + F_V + row * VSTR + pc * 16) = raw.v[k]; } }
            f_stage<HGT>(X, l, raw, h, dir, lds, lane, wave);
            if (cc < 3) raw = f_load<HGT>(X, sc * 4 + (dir ? 2 - cc : cc + 1), h, dir, tid, lane, wave);
            else if (dir) raw = f_load<HGT>(X, sc * 4, h, 0, tid, lane, wave);
            float* sp = scr + (size_t)((ci * 8 + wave) * (NET * 4)) * 256 + lane * 4;
            f32x4 oacc[NET][4];
#pragma unroll
            for (int et = 0; et < NET; ++et)
#pragma unroll
                for (int it = 0; it < 4; ++it) oacc[et][it] = (f32x4){0.f, 0.f, 0.f, 0.f};
            __syncthreads();
            if (!dir) {
#pragma unroll
                for (int et = 0; et < NET; ++et)
#pragma unroll
                    for (int it = 0; it < 4; ++it) oacc[et][it] = *(const GAS f32x4*)(sp + (et * 4 + it) * 256); }
            { const unsigned lst = (wave < 6) ? 0xff00u | (unsigned)((0x323130212010ull >> (8 * wave)) & 0xffull) : (wave == 6 ? 0x1100u : 0x3322u);
              for (int t = 0; t < 2; ++t) { const unsigned code = (lst >> (8 * t)) & 0xffu; if (code == 0xffu) break;
                  const int I = (int)(code >> 4), J = (int)(code & 15u);
                  f32x4 scv = (f32x4){0.f, 0.f, 0.f, 0.f};
#pragma unroll
                  for (int ks = 0; ks < 4; ++ks) { const int dc = 32 * ks + 8 * fq;
                      v4u ka = *(const LAS v4u*)(lds + F_KD + (16 * J + fr) * K_STR + dc * 2);
                      const bf16x8 qb = *(const LAS bf16x8*)(lds + F_QD + (16 * I + fr) * K_STR + dc * 2);
                      if (J < I) { const LAS f32x4* bi = (const LAS f32x4*)(lds + F_BT + I * 512 + dc * 4); const LAS f32x4* bj = (const LAS f32x4*)(lds + F_BT + J * 512 + dc * 4);
                          const f32x4 d0 = bi[0] - bj[0], d1 = bi[1] - bj[1]; float kf[8]; unpack8(ka, kf);
                          kf[0] *= fexp2(d0.x); kf[1] *= fexp2(d0.y); kf[2] *= fexp2(d0.z); kf[3] *= fexp2(d0.w); kf[4] *= fexp2(d1.x); kf[5] *= fexp2(d1.y); kf[6] *= fexp2(d1.z); kf[7] *= fexp2(d1.w);
                          ka = pack8(kf); }
                      scv = __builtin_amdgcn_mfma_f32_16x16x32_bf16(__builtin_bit_cast(bf16x8, ka), qb, scv, 0, 0, 0); }
                  if (J == I) {
#pragma unroll
                      for (int u = 0; u < 4; ++u) if (4 * fq + u > fr) scv[u] = 0.f; }
                  v2u w; w.x = pkbf(scv[0], scv[1]); w.y = pkbf(scv[2], scv[3]);
                  *(LAS v2u*)(lds + F_P + (16 * I + fr) * P_STR + (16 * J + 4 * fq) * 2) = w; } }
            __syncthreads();
            bf16x8 vfr[NET][2];
#pragma unroll
            for (int ks = 0; ks < 2; ++ks) { const int r0 = 32 * ks + 8 * fq + qq, r1 = r0 + 4, v0 = dir ? 63 - r0 : r0, v1 = dir ? 63 - r1 : r1;
#pragma unroll
                for (int et = 0; et < NET; ++et) { const int col = (16 * (wave * NET + et) + 4 * p4) * 2;
                    vfr[et][ks] = tr_pair(lds + F_V + v0 * VSTR + col, lds + F_V + v1 * VSTR + col); } }
            {
#pragma unroll
              for (int ks = 0; ks < 4; ++ks) { bf16x8 sfr[NET];
#pragma unroll
                for (int et = 0; et < NET; ++et) { v4u a; a.x = pkbf(S[2 * ks][et][0], S[2 * ks][et][1]); a.y = pkbf(S[2 * ks][et][2], S[2 * ks][et][3]);
                    a.z = pkbf(S[2 * ks + 1][et][0], S[2 * ks + 1][et][1]); a.w = pkbf(S[2 * ks + 1][et][2], S[2 * ks + 1][et][3]); sfr[et] = __builtin_bit_cast(bf16x8, a); }
#pragma unroll
                for (int it = 0; it < 4; ++it) { const int trow = 16 * it + fr, ip = dir ? 63 - trow : trow;
                    const bf16x8 bo = *(const LAS bf16x8*)(lds + F_QH + ip * K_STR + (32 * ks + 8 * fq) * 2);
#pragma unroll
                    for (int et = 0; et < NET; ++et) oacc[et][it] = __builtin_amdgcn_mfma_f32_16x16x32_bf16(sfr[et], bo, oacc[et][it], 0, 0, 0); } }
#pragma unroll
              for (int ks = 0; ks < 2; ++ks)
#pragma unroll
                for (int it = 0; it < 4; ++it) { const int trow = 16 * it + fr, ip = dir ? 63 - trow : trow;
                    const bf16x8 bo = *(const LAS bf16x8*)(lds + F_P + ip * P_STR + (32 * ks + 8 * fq) * 2);
#pragma unroll
                    for (int et = 0; et < NET; ++et) oacc[et][it] = __builtin_amdgcn_mfma_f32_16x16x32_bf16(vfr[et][ks], bo, oacc[et][it], 0, 0, 0); } }
            v2u ogp[NET][4];
            if (HGT && !dir) {
#pragma unroll
                for (int et = 0; et < NET; ++et)
#pragma unroll
                    for (int it = 0; it < 4; ++it) {
                        ogp[et][it] = *(const GAS v2u*)(X.Z + (size_t)(chunk * 64 + 16 * it + fr) * ZRW + ogcol + 16 * (wave * NET + et) + 4 * fq); } }
            if (cc < 3) {
#pragma unroll
                for (int T = 0; T < 8; ++T) { if ((T & 1) == 0) __builtin_amdgcn_sched_barrier(0);
                    const f32x4 dc = *(const LAS f32x4*)(lds + F_DEC + (16 * T + 4 * fq) * 4);
                    const bf16x8 a0 = *(const LAS bf16x8*)(lds + F_KT + (16 * T + fr) * KT_STR + (8 * fq) * 2), a1 = *(const LAS bf16x8*)(lds + F_KT + (16 * T + fr) * KT_STR + (32 + 8 * fq) * 2);
#pragma unroll
                    for (int et = 0; et < NET; ++et) { S[T][et] = S[T][et] * dc;
                        S[T][et] = __builtin_amdgcn_mfma_f32_16x16x32_bf16(a0, vfr[et][0], S[T][et], 0, 0, 0); S[T][et] = __builtin_amdgcn_mfma_f32_16x16x32_bf16(a1, vfr[et][1], S[T][et], 0, 0, 0); } } }
            if (!HGT && !dir) { __builtin_amdgcn_sched_barrier(0);
#pragma unroll
                for (int et = 0; et < NET; ++et)
#pragma unroll
                    for (int it = 0; it < 4; ++it) {
                        ogp[et][it] = *(const GAS v2u*)(X.Z + (size_t)(chunk * 64 + 16 * it + fr) * ZRW + ogcol + 16 * (wave * NET + et) + 4 * fq); } }
            if (dir) {
#pragma unroll
                for (int et = 0; et < NET; ++et)
#pragma unroll
                    for (int it = 0; it < 4; ++it) *(GAS f32x4*)(sp + (et * 4 + it) * 256) = oacc[et][it];
                __syncthreads();
            } else {
                LAS float* red = (LAS float*)(lds + F_RED);
#pragma unroll
                for (int it = 0; it < 4; ++it) { float sq = 0.f;
#pragma unroll
                    for (int et = 0; et < NET; ++et) { const f32x4 o = oacc[et][it]; sq += (o.x * o.x + o.y * o.y) + (o.z * o.z + o.w * o.w); }
                    sq += __shfl_xor(sq, 16); sq += __shfl_xor(sq, 32);
                    if (fq == 0) red[wave * 64 + 16 * it + fr] = sq; }
                __syncthreads();
#pragma unroll
                for (int it = 0; it < 4; ++it) { float tot = 0.f;
#pragma unroll
                    for (int w = 0; w < 8; ++w) tot += red[w * 64 + 16 * it + fr];
                    const float rstd = __builtin_amdgcn_rsqf(tot * (1.f / DV) + RMS_EPS);
                    const int tok = chunk * 64 + 16 * it + fr;
#pragma unroll
                    for (int et = 0; et < NET; ++et) { const int e0 = 16 * (wave * NET + et) + 4 * fq;
                        const v2u og2 = ogp[et][it];
                        const float og[4] = {__uint_as_float(og2.x << 16), __uint_as_float(og2.x & 0xffff0000u), __uint_as_float(og2.y << 16), __uint_as_float(og2.y & 0xffff0000u)};
                        const f32x4 g4 = *(const GAS f32x4*)(ng + e0); float rr[4];
#pragma unroll
                        for (int u = 0; u < 4; ++u) { const float z = og[u]; rr[u] = oacc[et][it][u] * rstd * g4[u] * (z * frcp(1.f + fexp2(z * -LOG2E))); }
                        v2u w; w.x = pkbf(rr[0], rr[1]); w.y = pkbf(rr[2], rr[3]);
                        *(GAS v2u*)(X.O + (size_t)tok * DM + ocol + e0) = w; } }
            }
        }
        asm volatile("s_waitcnt vmcnt(0)" ::: "memory");
    }
}

struct Args { const float* in[15]; float* out; unsigned char* ws; int mode, pad; };
#define PHASE_IDS() int tid = threadIdx.x; asm volatile("" : "+v"(tid)); const int lane = tid & 63, wave = __builtin_amdgcn_readfirstlane(tid >> 6); \
    const int gw = bx * NWAVES + wave, NGW = G * NWAVES, gtid = bx * (NWAVES * 64) + tid, NT = G * NWAVES * 64; (void)lane; (void)wave; (void)gw; (void)NGW; (void)gtid; (void)NT
__device__ __forceinline__ Ctx make_ctx(const Args& args) {
    Ctx X; unsigned char* ws = args.ws;
    X.x_prompt = args.in[0]; X.x_sample = args.in[1]; X.w_in = args.in[2]; X.w_lr2 = args.in[3]; X.b_lr = args.in[4]; X.gla_g = args.in[5]; X.hg_g = args.in[6]; X.lowb = args.in[7];
    X.w_out = args.in[8]; X.ln1_g = args.in[9]; X.ln1_b = args.in[10]; X.w_up = args.in[11]; X.w_down = args.in[12]; X.ln2_g = args.in[13]; X.ln2_b = args.in[14]; X.out = args.out;
    X.Win_t = (bf16*)(ws + WS_WIN); X.Wout_t = (bf16*)(ws + WS_WOUT); X.Wup_t = (bf16*)(ws + WS_WUP); X.Wdn_t = (bf16*)(ws + WS_WDN); X.Wglr_t = (bf16*)(ws + WS_WGLR);
    X.HB = (bf16*)(ws + WS_HB); X.Z = (bf16*)(ws + WS_Z); X.O = (bf16*)(ws + WS_O); X.ST = (bf16*)(ws + WS_ST);
    X.BG = (float*)(ws + WS_BG); X.MF = (bf16*)(ws + WS_ST); X.TOT = (float*)(ws + WS_TOT); X.TOTS = (float*)(ws + WS_TOTS); X.STS = (bf16*)(ws + WS_STS);
    return X;
}
__global__ void __launch_bounds__(NWAVES * 64, 2) fwd_kernel(Args args) {
    extern __shared__ __attribute__((aligned(16))) unsigned char lds_raw[];
    LAS unsigned char* lds = (LAS unsigned char*)lds_raw;
    const int G = gridDim.x, bx = blockIdx.x;
    volatile LAS unsigned* MISC = (volatile LAS unsigned*)(lds + MISC_OFF);
    if (threadIdx.x < 32) MISC[threadIdx.x] = 0u;
    __syncthreads();
    XcdBarrier bar = xcd_barrier_post((unsigned*)(args.ws + WS_CTL) + CW_BAR, MISC + 8);

    { PHASE_IDS(); const Ctx X = make_ctx(args); prologue_weights(X, lds, gw, NGW, wave, lane); }
    for (int g = 0; g < NGRP; ++g) {
        { PHASE_IDS(); const Ctx X = make_ctx(args); cvt_group((g == 0) ? X.x_prompt : X.x_sample + (size_t)(g - 1) * GM * DM, X.HB, gtid, NT); }
        xcd_barrier(bar);
        for (int l = 0; l < NLAYER; ++l) {
            { PHASE_IDS(); const Ctx X = make_ctx(args); for (int c = bx; c < NCHUNK; c += G) gate_unit(X, l, c, lds, tid, lane, wave); }
            { const Ctx X = make_ctx(args); pg8::Gemm gm{X.HB, X.Win_t + (size_t)l * ZW * DM, GM, ZW, DM}; pg8::StaticOrder S; S.init(GM, ZW, G, bx);
              pg8::EpiZ E{X.Z};
              pg8::gemm_phase<pg8::EpiZ, pg8::StaticOrder, false, true>(lds, gm, S, E); }
            xcd_barrier(bar);
            {
            { PHASE_IDS(); const Ctx X = make_ctx(args);
              for (int u = bx; u < NSC * 12; u += G) { const int sc = sc_order(u / 12), hh = u % 12;
                if (hh < 4) pass_s_unit<false, false>(X, l, sc, hh, lds, tid, lane, wave); else pass_s_unit<true, false>(X, l, sc, hh - 4, lds, tid, lane, wave); } }
            xcd_barrier(bar);
            { PHASE_IDS(); const Ctx X = make_ctx(args); pass_b_super(X, g, gtid, NT); }
            xcd_barrier(bar);
            for (int u = bx + ((NSC * 12 - 1 - bx) / G) * G; u >= bx; u -= G) { const int sc = sc_order(u / 12), hh = u % 12;
                { PHASE_IDS(); const Ctx X = make_ctx(args); float* scr = (float*)X.ST + (size_t)bx * 65536;
                  if (hh < 4) pass_f_unit<false>(X, l, sc, hh, scr, lds, tid, lane, wave); else pass_f_unit<true>(X, l, sc, hh - 4, scr, lds, tid, lane, wave); }
                __syncthreads(); }
            xcd_barrier(bar);
            }
            { const Ctx X = make_ctx(args); pg8::Gemm gm{X.O, X.Wout_t + (size_t)l * DM * DM, GM, DM, DM}; pg8::StaticOrder S; S.init(GM, DM, G, bx);
              pg8::EpiBf16<0> E{X.MF, DM};
              pg8::gemm_phase<pg8::EpiBf16<0>, pg8::StaticOrder, false, true>(lds, gm, S, E); }
            xcd_barrier(bar);
            { PHASE_IDS(); const Ctx X = make_ctx(args);
              ln_phase<false, false>(X.HB, X.MF, X.ln1_g + (size_t)l * DM, X.ln1_b + (size_t)l * DM, nullptr, X.HB, gw, NGW, lane); }
            xcd_barrier(bar);
            { const Ctx X = make_ctx(args); pg8::Gemm gm{X.HB, X.Wup_t + (size_t)l * DFF * DM, GM, DFF, DM}; pg8::StaticOrder S; S.init(GM, DFF, G, bx);
              pg8::EpiBf16<1> E{X.Z, DFF};
              pg8::gemm_phase<pg8::EpiBf16<1>, pg8::StaticOrder, false, true>(lds, gm, S, E); }
            xcd_barrier(bar);
            { const Ctx X = make_ctx(args); pg8::Gemm gm{X.Z, X.Wdn_t + (size_t)l * DM * DFF, GM, DM, DFF}; pg8::ReverseOrder S; S.init(GM, DM, G, bx);
              pg8::EpiBf16<0> E{X.MF, DM};
              pg8::gemm_phase<pg8::EpiBf16<0>, pg8::ReverseOrder, false, true>(lds, gm, S, E); }
            xcd_barrier(bar);
            { PHASE_IDS(); const Ctx X = make_ctx(args);
              if (l == NLAYER - 1) ln_phase<false, true>(X.HB, X.MF, X.ln2_g + (size_t)l * DM, X.ln2_b + (size_t)l * DM, X.out + (size_t)g * GM * DM, nullptr, gw, NGW, lane);
              else ln_phase<false, false>(X.HB, X.MF, X.ln2_g + (size_t)l * DM, X.ln2_b + (size_t)l * DM, nullptr, X.HB, gw, NGW, lane); }
            xcd_barrier(bar);
        }
    }
}

extern "C" void kernel_launch(void* const* d_in, const int* in_sizes, int n_in, void* d_out, int out_size, void* d_ws, size_t ws_size, hipStream_t stream) {
    static int grid = 0;
    if (grid == 0) {
        if (n_in != 15 || out_size != NTOK * DM || ws_size < WS_END) { fprintf(stderr, "kernel_launch: unexpected shapes (n_in %d, out %d, ws %zu)\n", n_in, out_size, ws_size); grid = -1; return; }
        int dev = 0, cus = 0;
        if (hipGetDevice(&dev) != hipSuccess || hipDeviceGetAttribute(&cus, hipDeviceAttributeMultiprocessorCount, dev) != hipSuccess) { grid = -1; return; }
        if (hipFuncSetAttribute((const void*)fwd_kernel, hipFuncAttributeMaxDynamicSharedMemorySize, LDS_BYTES) != hipSuccess) { fprintf(stderr, "kernel_launch: hipFuncSetAttribute failed\n"); grid = -1; return; }
        int per_cu = 0;
        if (hipOccupancyMaxActiveBlocksPerMultiprocessor(&per_cu, (const void*)fwd_kernel, NWAVES * 64, LDS_BYTES) != hipSuccess || per_cu < 1) { fprintf(stderr, "kernel_launch: occupancy query says %d\n", per_cu); }
        (void)hipGetLastError();
        grid = cus;
    }
    if (grid < 0) return;
    if (hipMemsetAsync((char*)d_ws + WS_CTL, 0, CTL_ZERO_BYTES, stream) != hipSuccess) return;
    Args a{};
    for (int i = 0; i < 15; ++i) a.in[i] = (const float*)d_in[i];
    a.out = (float*)d_out; a.ws = (unsigned char*)d_ws; a.mode = KMODE; a.pad = 0;
    hipLaunchKernelGGL(fwd_kernel, dim3(grid), dim3(NWAVES * 64), LDS_BYTES, stream, a);
}
```

```cpp
#include <hip/hip_runtime.h>
#include <cstdio>
#include <cstdint>
#ifndef KMODE
#define KMODE 0
#endif
namespace pg8 {
#define PG8_LAS __attribute__((address_space(3)))
typedef unsigned short bf16_t;
typedef short bf16x8 __attribute__((ext_vector_type(8)));
typedef float f32x4 __attribute__((ext_vector_type(4)));
typedef unsigned u32x4 __attribute__((ext_vector_type(4)));
constexpr int BM = 256, BK = 64, HALF = 128, HTB = HALF * BK * 2  , STAGE_BYTES = 8 * HTB, NXCD = 8, WGM = 4;

__host__ __device__ __forceinline__ int lds_byte(int r, int c) { const int st = (r >> 4) * 2 + (c >> 5), rr = r & 15, cc = c & 31, ob = rr * 64 + cc * 2; return st * 1024 + (ob ^ (((ob >> 9) & 1) << 5)); }
__host__ __device__ __forceinline__ void stage_rc(int b, int& R, int& C) { const int st = b / 1024, sb = b % 1024, swz = sb ^ (((sb >> 9) & 1) << 5); R = (st >> 1) * 16 + swz / 64; C = (st & 1) * 32 + (swz % 64) / 2; }
__host__ __device__ __forceinline__ int perm32(int rho) { const int n = rho >> 4, i = rho & 15; return 8 * (i >> 2) + 4 * n + (i & 3); }

struct Unit { int pm, pn; };
struct Gemm { const bf16_t* A; const bf16_t* Bt; int M, N, K; };

struct StaticOrder {
    int nM, nN, nwg, G, c;
    __host__ __device__ void init(int M, int N, int G_, int c_) { nM = M / BM; nN = N / BM; nwg = nM * nN; G = G_; c = c_; }
    __host__ __device__ bool next(int i, Unit& u) const {
        const long L = (long)i * G + c; if (L >= nwg) return false;
        int wgid = (int)L; { const int q = nwg / NXCD, r = nwg % NXCD, xcd = wgid % NXCD, off = wgid / NXCD; wgid = (xcd < r ? xcd * (q + 1) : r * (q + 1) + (xcd - r) * q) + off; }
        const int nig = WGM * nN, gid = wgid / nig, fm = gid * WGM, gsz = (nM - fm) < WGM ? (nM - fm) : WGM;
        u.pm = fm + ((wgid % nig) % gsz); u.pn = (wgid % nig) / gsz; return true;
    }
    __device__ __forceinline__ void a_ready(const Unit&) const {}
    __device__ __forceinline__ void done(const Unit&) const {}
};
struct ReverseOrder : StaticOrder {
    __host__ __device__ bool next(int i, Unit& u) const { const int rounds = nwg / G; if (i >= rounds) return false; return StaticOrder::next(rounds - 1 - i, u); }
};


__device__ __forceinline__ unsigned cvt_pk_bf16(float lo, float hi) { unsigned r; asm volatile("v_cvt_pk_bf16_f32 %0, %1, %2" : "=v"(r) : "v"(lo), "v"(hi)); return r; }

template <int ACT  > struct EpiBf16 {
    static constexpr bool PERM = true, AFTER_DRAIN = false;
    bf16_t* O; int ldc;
    __device__ __forceinline__ void operator()(const f32x4 (&acc)[2][2][4][2], const Unit& u, int wr, int wc, int fr, int fq) const {
        const int row0 = u.pm * BM + wr * 64 + fr; const int col0 = u.pn * BM + wc * 32 + 8 * fq;
#pragma unroll
        for (int ai = 0; ai < 2; ++ai)
#pragma unroll
            for (int m = 0; m < 4; ++m) { bf16_t* rowp = O + (size_t)(row0 + ai * HALF + m * 16) * ldc + col0;
#pragma unroll
                for (int bj = 0; bj < 2; ++bj) { f32x4 v0 = acc[ai][bj][m][0], v1 = acc[ai][bj][m][1];
                    if (ACT == 1) {
#pragma unroll
                        for (int j = 0; j < 4; ++j) { const float a = fmaxf(v0[j], 0.f), b = fmaxf(v1[j], 0.f); v0[j] = a * a; v1[j] = b * b; } }
                    u32x4 w; w.x = cvt_pk_bf16(v0[0], v0[1]); w.y = cvt_pk_bf16(v0[2], v0[3]); w.z = cvt_pk_bf16(v1[0], v1[1]); w.w = cvt_pk_bf16(v1[2], v1[3]);
                    *(u32x4*)(rowp + bj * HALF) = w; } }
    }
};
struct EpiF32 {
    static constexpr bool PERM = false, AFTER_DRAIN = false;
    float* C; int ldc;
    __device__ __forceinline__ void operator()(const f32x4 (&acc)[2][2][4][2], const Unit& u, int wr, int wc, int fr, int fq) const {
        const int row0 = u.pm * BM + wr * 64 + fr, col0 = u.pn * BM + wc * 32 + 4 * fq;
#pragma unroll
        for (int ai = 0; ai < 2; ++ai)
#pragma unroll
            for (int m = 0; m < 4; ++m) { float* rowp = C + (size_t)(row0 + ai * HALF + m * 16) * ldc + col0;
#pragma unroll
                for (int bj = 0; bj < 2; ++bj)
#pragma unroll
                    for (int n = 0; n < 2; ++n) *(f32x4*)(rowp + bj * HALF + n * 16) = acc[ai][bj][m][n]; }
    }
};

struct EpiZ {
    static constexpr bool PERM = true, AFTER_DRAIN = false;
    bf16_t* Z;
    const float* lowb; int layer;
    __device__ __forceinline__ void operator()(const f32x4 (&acc)[2][2][4][2], const Unit& u, int wr, int wc, int fr, int fq) const {
        const int pn = u.pn; const size_t Mr = 16384;
        if (pn >= 16 && pn < 24) { gate_tiles(acc, u, wr, wc, fr, fq); return; }
        bool blocked; int H = 4, c0; bf16_t* base;
        if (pn < 2) { blocked = true; H = 4; base = Z + Mr * 4096; c0 = pn * 256; }
        else if (pn < 4) { blocked = true; H = 4; base = Z + Mr * 4096 + Mr * 512; c0 = (pn - 2) * 256; }
        else if (pn < 8) { blocked = false; base = Z; c0 = (pn - 4) * 256; }
        else if (pn < 12) { blocked = false; base = Z; c0 = 1024 + (pn - 8) * 256; }
        else if (pn < 24) { blocked = true; H = 8; base = Z + Mr * 4096 + Mr * 1024 + (size_t)((pn - 12) >> 2) * Mr * 1024; c0 = ((pn - 12) & 3) * 256; }
        else if (pn < 28) { blocked = false; base = Z; c0 = 2048 + (pn - 24) * 256; }
        else { blocked = false; base = Z; c0 = 3072 + (pn - 28) * 256; }
        const int row0 = u.pm * BM + wr * 64 + fr, cl = c0 + wc * 32 + 8 * fq;
#pragma unroll
        for (int ai = 0; ai < 2; ++ai)
#pragma unroll
            for (int m = 0; m < 4; ++m) { const int row = row0 + ai * HALF + m * 16;
#pragma unroll
                for (int bj = 0; bj < 2; ++bj) { const f32x4 v0 = acc[ai][bj][m][0], v1 = acc[ai][bj][m][1]; const int c = cl + bj * HALF;
                    u32x4 w; w.x = cvt_pk_bf16(v0[0], v0[1]); w.y = cvt_pk_bf16(v0[2], v0[3]); w.z = cvt_pk_bf16(v1[0], v1[1]); w.w = cvt_pk_bf16(v1[2], v1[3]);
                    bf16_t* p = blocked ? base + ((size_t)((((row >> 6) * H + (c >> 7)) * 8 + ((c >> 4) & 7)) * 64 + (row & 63))) * 16 + (c & 15)
                                        : base + (size_t)row * 4096 + c;
                    *(u32x4*)p = w; } }
    }
    __device__ __forceinline__ void gate_tiles(const f32x4 (&acc)[2][2][4][2], const Unit& u, int wr, int wc, int fr, int fq) const {
        const int pn = u.pn, dir = (pn - 16) >> 2, c0 = ((pn - 16) & 3) * 256; const size_t Mr = 16384;
        bf16_t* base = Z + Mr * 4096 + Mr * 1024 + (size_t)(1 + dir) * Mr * 1024;
        const int row0 = u.pm * BM + wr * 64 + fr, cl = c0 + wc * 32 + 8 * fq;
        float lb[2][8];
#pragma unroll
        for (int bj = 0; bj < 2; ++bj)
#pragma unroll
            for (int j = 0; j < 8; ++j) { lb[bj][j] = 0.f;
                if (layer != 0) { const float* lp = lowb + (size_t)dir * 2048 + cl + bj * HALF + j; lb[bj][j] = __builtin_amdgcn_rcpf(1.f + __expf(lp[0] - lp[1024])); } }
#pragma unroll
        for (int ai = 0; ai < 2; ++ai)
#pragma unroll
            for (int m = 0; m < 4; ++m) { const int row = row0 + ai * HALF + m * 16;
#pragma unroll
                for (int bj = 0; bj < 2; ++bj) { const int c = cl + bj * HALF; float x[8];
#pragma unroll
                    for (int j = 0; j < 8; ++j) { const float zv = (j < 4) ? acc[ai][bj][m][0][j & 3] : acc[ai][bj][m][1][j & 3];
                        const float z = __builtin_amdgcn_fmed3f(zv, -60.f, 60.f), e = __builtin_amdgcn_exp2f(z * -1.44269504089f), sig = __builtin_amdgcn_rcpf(1.f + e), oml = 1.f - lb[bj][j];
                        x[j] = __builtin_amdgcn_logf(lb[bj][j] + oml * sig); }
                    u32x4 w; asm volatile("s_nop 0\n\tv_cvt_pk_bf16_f32 %0, %4, %5\n\tv_cvt_pk_bf16_f32 %1, %6, %7\n\tv_cvt_pk_bf16_f32 %2, %8, %9\n\tv_cvt_pk_bf16_f32 %3, %10, %11"
                        : "=&v"(w.x), "=&v"(w.y), "=&v"(w.z), "=&v"(w.w) : "v"(x[0]), "v"(x[1]), "v"(x[2]), "v"(x[3]), "v"(x[4]), "v"(x[5]), "v"(x[6]), "v"(x[7]));
                    bf16_t* p = base + ((size_t)((((row >> 6) * 8 + (c >> 7)) * 8 + ((c >> 4) & 7)) * 64 + (row & 63))) * 16 + (c & 15);
                    *(u32x4*)p = w; } }
    }
};

template <class Epi, class Sched, bool ALIGN_EPI = false, bool SP2 = false>
__device__ __forceinline__ void gemm_phase(PG8_LAS unsigned char* lds, const Gemm g, const Sched& S, const Epi& E) {
    int tid_o = threadIdx.x; asm volatile("" : "+v"(tid_o));
    const int tid = tid_o, wid = __builtin_amdgcn_readfirstlane(tid >> 6), lane = tid & 63, wr = wid >> 2, wc = wid & 3, fr = lane & 15, fq = lane >> 4;
    const int K = g.K, nt = K / BK;
    unsigned voffA[2], voffB[2];
#pragma unroll
    for (int i = 0; i < 2; ++i) { int R, C; stage_rc(tid * 16 + i * 8192, R, C); const int Rb = Epi::PERM ? ((R & ~31) + perm32(R & 31)) : R;
        voffA[i] = (unsigned)(R * K + C) * 2u; voffB[i] = (unsigned)(Rb * K + C) * 2u; }
    const size_t kstep = (size_t)(BK * 2);
    const size_t hstep = (size_t)HALF * K * 2;
    const size_t tstep = 2 * hstep;
    const unsigned ldsw = (unsigned)wid * 1024u;
    const int aoff = lds_byte(wr * 64 + fr, fq * 8), boff = lds_byte(wc * 32 + fr, fq * 8);
#define PG8_SA(b, h) (((b) * 2 + (h)) * HTB)
#define PG8_SB(b, h) ((4 + (b) * 2 + (h)) * HTB)
#define PG8_STAGE(bufoff, gbase, voff) do { _Pragma("unroll") for (int _i = 0; _i < 2; ++_i) \
        __builtin_amdgcn_global_load_lds((const unsigned*)((const char*)(gbase) + (voff)[_i]), (PG8_LAS unsigned*)(lds + (bufoff) + ldsw + _i * 8192), 16, 0, 0); } while (0)
#define PG8_LDA(dst, b, h) do { _Pragma("unroll") for (int m = 0; m < 4; ++m) _Pragma("unroll") for (int k = 0; k < 2; ++k) dst[m][k] = *(const PG8_LAS bf16x8*)(lds + PG8_SA(b, h) + aoff + m * 2048 + k * 1024); } while (0)
#define PG8_LDB(dst, b, h) do { _Pragma("unroll") for (int n = 0; n < 2; ++n) _Pragma("unroll") for (int k = 0; k < 2; ++k) dst[n][k] = *(const PG8_LAS bf16x8*)(lds + PG8_SB(b, h) + boff + n * 2048 + k * 1024); } while (0)
#define PG8_MMA(ai, bj, At, Bt) do { __builtin_amdgcn_s_setprio(1); _Pragma("unroll") for (int m = 0; m < 4; ++m) _Pragma("unroll") for (int n = 0; n < 2; ++n) _Pragma("unroll") for (int k = 0; k < 2; ++k) \
        acc[ai][bj][m][n] = __builtin_amdgcn_mfma_f32_16x16x32_bf16(Bt[n][k], At[m][k], acc[ai][bj][m][n], 0, 0, 0); __builtin_amdgcn_s_setprio(0); } while (0)
#define PG8_WAIT_V(n) asm volatile("s_waitcnt vmcnt(" #n ")" ::: "memory")
#define PG8_WAIT_L(n) asm volatile("s_waitcnt lgkmcnt(" #n ")" ::: "memory")
#define PG8_BAR __builtin_amdgcn_s_barrier()
#define PG8_SCHED __builtin_amdgcn_sched_barrier(0)
    Unit cur, nxt; int ui = 0;
    if (!S.next(0, cur)) return;
    f32x4 acc[2][2][4][2];
#pragma unroll
    for (int a = 0; a < 2; ++a)
#pragma unroll
        for (int b = 0; b < 2; ++b)
#pragma unroll
            for (int m = 0; m < 4; ++m)
#pragma unroll
                for (int n = 0; n < 2; ++n) acc[a][b][m][n] = (f32x4){0.f, 0.f, 0.f, 0.f};
    bf16x8 At[4][2], B0[2][2], B1[2][2];
    const char* cA = (const char*)g.A + (size_t)cur.pm * tstep; const char* cB = (const char*)g.Bt + (size_t)cur.pn * tstep;
    S.a_ready(cur);
    if constexpr (SP2) {
        PG8_STAGE(PG8_SB(0, 0), cB, voffB); PG8_STAGE(PG8_SB(0, 1), cB + hstep, voffB); PG8_STAGE(PG8_SA(0, 0), cA, voffA); PG8_STAGE(PG8_SA(0, 1), cA + hstep, voffA);
        if (wr == 1) PG8_BAR;
        PG8_WAIT_V(2); PG8_BAR;
        PG8_STAGE(PG8_SB(1, 0), cB + kstep, voffB); PG8_STAGE(PG8_SA(1, 0), cA + kstep, voffA); PG8_STAGE(PG8_SB(1, 1), cB + hstep + kstep, voffB);
        PG8_WAIT_V(6); PG8_BAR;
    } else {
        PG8_STAGE(PG8_SB(0, 0), cB, voffB); PG8_STAGE(PG8_SA(0, 0), cA, voffA); PG8_STAGE(PG8_SB(0, 1), cB + hstep, voffB); PG8_STAGE(PG8_SA(0, 1), cA + hstep, voffA);
        if (wr == 1) PG8_BAR;
        PG8_WAIT_V(4); PG8_BAR;
        PG8_STAGE(PG8_SB(1, 0), cB + kstep, voffB); PG8_STAGE(PG8_SA(1, 0), cA + kstep, voffA); PG8_STAGE(PG8_SB(1, 1), cB + hstep + kstep, voffB);
        PG8_WAIT_V(6); PG8_BAR;
    }
    for (;;) {
        const bool has_next = S.next(ui + 1, nxt);
        const char* nA = has_next ? (const char*)g.A + (size_t)nxt.pm * tstep : cA; const char* nB = has_next ? (const char*)g.Bt + (size_t)nxt.pn * tstep : cB;
        for (int t = 0; t < nt; t += 2) {
            const bool last = (t == nt - 2);
            const char* a1 = cA + (size_t)(t + 1) * kstep;
            const char* a2 = last ? nA : cA + (size_t)(t + 2) * kstep; const char* b2 = last ? nB : cB + (size_t)(t + 2) * kstep;
            const char* a3 = a2 + kstep; const char* b3 = b2 + kstep;
            if (last && has_next) S.a_ready(nxt);
            if constexpr (SP2) {
            PG8_LDB(B0, 0, 0); PG8_LDB(B1, 0, 1); PG8_SCHED; PG8_LDA(At, 0, 0); PG8_STAGE(PG8_SA(1, 1), a1 + hstep, voffA);
            PG8_WAIT_V(8); PG8_WAIT_L(0); PG8_BAR; PG8_MMA(0, 0, At, B0); PG8_MMA(0, 1, At, B1); PG8_BAR; PG8_SCHED;
            PG8_LDA(At, 0, 1); PG8_STAGE(PG8_SB(0, 0), b2, voffB); PG8_STAGE(PG8_SB(0, 1), b2 + hstep, voffB); PG8_STAGE(PG8_SA(0, 0), a2, voffA);
            PG8_WAIT_V(8); PG8_WAIT_L(0); PG8_BAR; PG8_MMA(1, 0, At, B0); PG8_MMA(1, 1, At, B1); PG8_BAR; PG8_SCHED;
            PG8_LDB(B0, 1, 0); PG8_LDB(B1, 1, 1); PG8_SCHED; PG8_LDA(At, 1, 0); PG8_STAGE(PG8_SA(0, 1), a2 + hstep, voffA);
            PG8_WAIT_V(8); PG8_WAIT_L(0); PG8_BAR; PG8_MMA(0, 0, At, B0); PG8_MMA(0, 1, At, B1); PG8_BAR; PG8_SCHED;
            PG8_LDA(At, 1, 1); PG8_STAGE(PG8_SB(1, 0), b3, voffB); PG8_STAGE(PG8_SB(1, 1), b3 + hstep, voffB); PG8_STAGE(PG8_SA(1, 0), a3, voffA);
            PG8_WAIT_V(8); PG8_WAIT_L(0); PG8_BAR; PG8_MMA(1, 0, At, B0); PG8_MMA(1, 1, At, B1); PG8_BAR; PG8_SCHED;
            } else {
            PG8_LDB(B0, 0, 0); PG8_SCHED; PG8_LDA(At, 0, 0); PG8_STAGE(PG8_SA(1, 1), a1 + hstep, voffA);
            PG8_WAIT_L(8); PG8_BAR; PG8_WAIT_L(0); PG8_MMA(0, 0, At, B0); PG8_BAR; PG8_SCHED;
            PG8_LDB(B1, 0, 1); PG8_STAGE(PG8_SB(0, 0), b2, voffB);
            PG8_BAR; PG8_WAIT_L(0); PG8_MMA(0, 1, At, B1); PG8_BAR;
            PG8_LDA(At, 0, 1); PG8_STAGE(PG8_SA(0, 0), a2, voffA);
            PG8_BAR; PG8_WAIT_L(0); PG8_MMA(1, 0, At, B0); PG8_BAR; PG8_SCHED;
            PG8_STAGE(PG8_SB(0, 1), b2 + hstep, voffB);
            PG8_WAIT_V(6); PG8_BAR; PG8_MMA(1, 1, At, B1); PG8_BAR;
            PG8_LDB(B0, 1, 0); PG8_SCHED; PG8_LDA(At, 1, 0); PG8_STAGE(PG8_SA(0, 1), a2 + hstep, voffA);
            PG8_WAIT_L(8); PG8_BAR; PG8_WAIT_L(0); PG8_MMA(0, 0, At, B0); PG8_BAR; PG8_SCHED;
            PG8_LDB(B1, 1, 1); PG8_STAGE(PG8_SB(1, 0), b3, voffB);
            PG8_BAR; PG8_WAIT_L(0); PG8_MMA(0, 1, At, B1); PG8_BAR;
            PG8_LDA(At, 1, 1); PG8_STAGE(PG8_SA(1, 0), a3, voffA);
            PG8_BAR; PG8_WAIT_L(0); PG8_MMA(1, 0, At, B0); PG8_BAR; PG8_SCHED;
            PG8_STAGE(PG8_SB(1, 1), b3 + hstep, voffB);
            PG8_WAIT_V(6); PG8_BAR; PG8_MMA(1, 1, At, B1); PG8_BAR;
            }
        }
        if constexpr (ALIGN_EPI) { if (wr == 0) PG8_BAR; }
        if constexpr (!Epi::AFTER_DRAIN) { E(acc, cur, wr, wc, fr, fq); S.done(cur); }
        if (!has_next) break;
#pragma unroll
        for (int a = 0; a < 2; ++a)
#pragma unroll
            for (int b = 0; b < 2; ++b)
#pragma unroll
                for (int m = 0; m < 4; ++m)
#pragma unroll
                    for (int n = 0; n < 2; ++n) acc[a][b][m][n] = (f32x4){0.f, 0.f, 0.f, 0.f};
        cur = nxt; cA = nA; cB = nB; ++ui;
        if constexpr (ALIGN_EPI) { if (wr == 1) PG8_BAR; }
    }
    PG8_WAIT_V(0);
    if constexpr (!ALIGN_EPI) { if (wr == 0) PG8_BAR; }
    PG8_BAR;
    if constexpr (Epi::AFTER_DRAIN) { E.fused(acc, cur, wr, wc, fr, fq, lds, wid, lane); S.done(cur); }
#undef PG8_SA
#undef PG8_SB
#undef PG8_STAGE
#undef PG8_LDA
#undef PG8_LDB
#undef PG8_MMA
#undef PG8_WAIT_V
#undef PG8_WAIT_L
#undef PG8_BAR
#undef PG8_SCHED
}
}

constexpr int NWAVES = 8;
constexpr int DM = 2048, DFF = 8192, NTOK = 49152, GM = 16384, NGRP = 3, NLAYER = 2, INW = 8224, ZW = 8192;
constexpr int ZC_GQ = 0, ZC_GK = 512, ZC_GV = 1024, ZC_GOG = 2048, ZC_HQ = 3072, ZC_HFF = 4096, ZC_HFB = 5120, ZC_HI = 6144, ZC_HOG = 7168;
constexpr float LN_EPS = 1e-5f, RMS_EPS = 1e-6f, ALPHA = 1.41421356237f, LOG2E = 1.44269504089f;
constexpr int NCHUNK = GM / 64;
constexpr int ST_CHUNK = 524288;
constexpr size_t MiB = 1u << 20;
constexpr size_t WS_CTL = 0, CTL_ZERO_BYTES = 1 * MiB;
constexpr size_t WS_WIN = 2 * MiB, WS_WOUT = 66 * MiB, WS_WUP = 82 * MiB, WS_WDN = 146 * MiB, WS_WGLR = 210 * MiB;
constexpr size_t WS_HB = 212 * MiB;
constexpr size_t WS_Z = 276 * MiB;
constexpr size_t WS_BG = 532 * MiB;
constexpr size_t WS_O = 596 * MiB;
constexpr size_t WS_ST = 660 * MiB;
constexpr size_t WS_TOT = 916 * MiB;
constexpr size_t WS_STS = 920 * MiB;
constexpr size_t WS_TOTS = 984 * MiB;
constexpr size_t WS_END = 985 * MiB;
constexpr int CW_BAR = 4096;
constexpr int RING_BYTES = 131072;
constexpr int LDS_BYTES = 160 * 1024, MISC_OFF = LDS_BYTES - 256;
constexpr int L_B32 = 0, L_KR = 33792, L_QR = 51200, L_QH = 68608, L_V = 86016, L_P = 119808, L_RED = 129024;
constexpr int B32_STR = 528, K_STR = 272, P_STR = 144, KT_STR = 144;
constexpr int NSC = GM / 256;
__host__ __device__ __forceinline__ int sc_order(int s) { return s < 32 ? (s >> 2) * 8 + 4 + (s & 3) : ((s - 32) >> 2) * 8 + (s & 3); }
constexpr int SV_KT = 135168, KTW_BYTES = 2560;

#define GAS __attribute__((address_space(1)))
#define LAS __attribute__((address_space(3)))
typedef unsigned short bf16;
typedef unsigned v4u __attribute__((ext_vector_type(4)));
typedef float f32x4 __attribute__((ext_vector_type(4)));
typedef short bf16x8 __attribute__((ext_vector_type(8)));
typedef GAS unsigned gu32;
typedef GAS unsigned long long gu64;
#define RLX_AGENT __ATOMIC_RELAXED, __HIP_MEMORY_SCOPE_AGENT
#define LDS_WAIT() asm volatile("s_waitcnt lgkmcnt(0)" ::: "memory")
#define VM_WAIT() asm volatile("s_waitcnt vmcnt(0)" ::: "memory")
__device__ __forceinline__ unsigned long long rt() { return __builtin_amdgcn_s_memrealtime(); }
__device__ __forceinline__ unsigned f2bf(float f) { unsigned u = __builtin_bit_cast(unsigned, f); return (u + 0x7fffu + ((u >> 16) & 1u)) >> 16; }
__device__ __forceinline__ unsigned pk2(float lo, float hi) { return f2bf(lo) | (f2bf(hi) << 16); }

#define XB_TMO      128
#define XB_XCNT(j)  (256  + 64 * (j))
#define XB_XSUB(j)  (1280 + 64 * (j))
#define XB_XGEN(j)  (2304 + 64 * (j))
#define XB_TOP      3328
#define XB_TOPGEN   3392
#define XCD_BAR_WORDS 3456
#define XB_SPIN_CAP (1u << 18)

__device__ __forceinline__ unsigned xb_ld(unsigned* p)              { return __hip_atomic_load(p, __ATOMIC_RELAXED, __HIP_MEMORY_SCOPE_AGENT); }
__device__ __forceinline__ unsigned xb_add(unsigned* p, unsigned v) { return __hip_atomic_fetch_add(p, v, __ATOMIC_RELAXED, __HIP_MEMORY_SCOPE_AGENT); }
__device__ __forceinline__ unsigned xb_xcc_id() { return (unsigned)__builtin_amdgcn_s_getreg((3 << 11) | 20) & 0xFu; }
#define XB_SPIN(cond, bar) do { unsigned _sp = 0; while (cond) { __builtin_amdgcn_s_sleep(1); \
    if ((++_sp & 255u) == 0u) { if (xb_ld(&(bar)[XB_TMO])) break; if (_sp > XB_SPIN_CAP) { atomicAdd(&(bar)[XB_TMO], 1u); break; } } } } while (0)

struct XcdBarrier {
    unsigned* bar; unsigned x;
    volatile LAS unsigned* st;
};

__device__ __forceinline__ XcdBarrier xcd_barrier_post(unsigned* bar, volatile LAS unsigned* st) {
    XcdBarrier b; b.bar = bar; b.x = xb_xcc_id(); b.st = st;
    if (threadIdx.x == 0) (void)xb_add(&bar[XB_XCNT(b.x)], 1u);
    return b;
}
__device__ __forceinline__ void xcd_barrier_complete(unsigned* bar, unsigned x, unsigned& nloc, unsigned& nx) {
    const unsigned G = gridDim.x * gridDim.y * gridDim.z;
    unsigned sum, cnt, mine, sp = 0u;
    for (;;) {
        sum = 0u; cnt = 0u; mine = 0u;
#pragma unroll
        for (unsigned j = 0; j < 16; ++j) { const unsigned c = xb_ld(&bar[XB_XCNT(j)]); sum += c; cnt += (c > 0u) ? 1u : 0u; mine = (j == x) ? c : mine; }
        if (sum == G) break;
        __builtin_amdgcn_s_sleep(1);
        if ((++sp & 255u) == 0u) { if (xb_ld(&bar[XB_TMO])) break; if (sp > XB_SPIN_CAP) { atomicAdd(&bar[XB_TMO], 1u); break; } }
    }
    nloc = mine > 0u ? mine : 1u; nx = cnt > 0u ? cnt : 1u;
}

__device__ __forceinline__ void xcd_barrier(const XcdBarrier& b) {
    asm volatile("s_waitcnt vmcnt(0)" ::: "memory");
    __syncthreads();
    if (threadIdx.x == 0) {
        unsigned* bar = b.bar;
        __builtin_amdgcn_s_waitcnt(0);
        unsigned nloc = b.st[0], nx = b.st[1];
        if (nloc == 0u) { xcd_barrier_complete(bar, b.x, nloc, nx); b.st[0] = nloc; b.st[1] = nx; }
        const unsigned old = xb_add(&bar[XB_XSUB(b.x)], 1u);
        const unsigned gen = old / nloc;
        if (old + 1u == (gen + 1u) * nloc) {
            __builtin_amdgcn_fence(__ATOMIC_RELEASE, "agent");
            asm volatile("s_waitcnt vmcnt(0)" ::: "memory");
            const unsigned og = xb_add(&bar[XB_TOP], 1u);
            const unsigned tg = og / nx;
            if (og + 1u == (tg + 1u) * nx) xb_add(&bar[XB_TOPGEN], 1u);
            else XB_SPIN(xb_ld(&bar[XB_TOPGEN]) == tg, bar);
            __builtin_amdgcn_fence(__ATOMIC_ACQUIRE, "agent");
            xb_add(&bar[XB_XGEN(b.x)], 1u);
            asm volatile("s_waitcnt vmcnt(0)" ::: "memory");
        } else {
            XB_SPIN(xb_ld(&bar[XB_XGEN(b.x)]) == gen, bar);
            __builtin_amdgcn_fence(__ATOMIC_ACQUIRE, "agent");
            asm volatile("s_waitcnt vmcnt(0)" ::: "memory");
        }
    }
    __syncthreads();
}

typedef short s16x4 __attribute__((ext_vector_type(4)));
typedef float f32x2 __attribute__((ext_vector_type(2)));
typedef unsigned v2u __attribute__((ext_vector_type(2)));
__device__ __forceinline__ unsigned pkbf(float lo, float hi) { return pg8::cvt_pk_bf16(lo, hi); }
__device__ __forceinline__ float wave_sum(float v) {
#pragma unroll
    for (int o = 1; o < 64; o <<= 1) v += __shfl_xor(v, o);
    return v;
}
template <int CTRL, int RM> __device__ __forceinline__ float dpp_add(float v) {
    return v + __builtin_bit_cast(float, __builtin_amdgcn_update_dpp(0, __builtin_bit_cast(int, v), CTRL, RM, 0xf, true));
}
__device__ __forceinline__ float wave_scan_incl(float v, int) {
    v = dpp_add<0x111, 0xf>(v); v = dpp_add<0x112, 0xf>(v); v = dpp_add<0x114, 0xf>(v); v = dpp_add<0x118, 0xf>(v);
    v = dpp_add<0x142, 0xa>(v); v = dpp_add<0x143, 0xc>(v); return v;
}
#define DPP16(CTL) "v_add_f32_dpp %0, %0, %0 " CTL "\n\t" "v_add_f32_dpp %1, %1, %1 " CTL "\n\t" "v_add_f32_dpp %2, %2, %2 " CTL "\n\t" "v_add_f32_dpp %3, %3, %3 " CTL "\n\t" "v_add_f32_dpp %4, %4, %4 " CTL "\n\t" "v_add_f32_dpp %5, %5, %5 " CTL "\n\t" "v_add_f32_dpp %6, %6, %6 " CTL "\n\t" "v_add_f32_dpp %7, %7, %7 " CTL "\n\t" "v_add_f32_dpp %8, %8, %8 " CTL "\n\t" "v_add_f32_dpp %9, %9, %9 " CTL "\n\t" "v_add_f32_dpp %10, %10, %10 " CTL "\n\t" "v_add_f32_dpp %11, %11, %11 " CTL "\n\t" "v_add_f32_dpp %12, %12, %12 " CTL "\n\t" "v_add_f32_dpp %13, %13, %13 " CTL "\n\t" "v_add_f32_dpp %14, %14, %14 " CTL "\n\t" "v_add_f32_dpp %15, %15, %15 " CTL "\n\t"
__device__ __forceinline__ void wave_scan16(float* v) {
    asm volatile("s_nop 1\n\t"
        DPP16("row_shr:1 row_mask:0xf bank_mask:0xf") DPP16("row_shr:2 row_mask:0xf bank_mask:0xf") DPP16("row_shr:4 row_mask:0xf bank_mask:0xf") DPP16("row_shr:8 row_mask:0xf bank_mask:0xf")
        DPP16("row_bcast:15 row_mask:0xa bank_mask:0xf") DPP16("row_bcast:31 row_mask:0xc bank_mask:0xf") "s_nop 1"
        : "+v"(v[0]), "+v"(v[1]), "+v"(v[2]), "+v"(v[3]), "+v"(v[4]), "+v"(v[5]), "+v"(v[6]), "+v"(v[7]), "+v"(v[8]), "+v"(v[9]), "+v"(v[10]), "+v"(v[11]), "+v"(v[12]), "+v"(v[13]), "+v"(v[14]), "+v"(v[15]));
}
__device__ __forceinline__ void unpack8(const v4u v, float* f) {
    f[0] = __uint_as_float(v.x << 16); f[1] = __uint_as_float(v.x & 0xffff0000u); f[2] = __uint_as_float(v.y << 16); f[3] = __uint_as_float(v.y & 0xffff0000u);
    f[4] = __uint_as_float(v.z << 16); f[5] = __uint_as_float(v.z & 0xffff0000u); f[6] = __uint_as_float(v.w << 16); f[7] = __uint_as_float(v.w & 0xffff0000u);
}
__device__ __forceinline__ v4u pack8(const float* f) { v4u o; o.x = pkbf(f[0], f[1]); o.y = pkbf(f[2], f[3]); o.z = pkbf(f[4], f[5]); o.w = pkbf(f[6], f[7]); return o; }
__device__ __forceinline__ s16x4 lds_tr(LAS const unsigned char* p) { return __builtin_bit_cast(s16x4, __builtin_amdgcn_ds_read_tr16_b64_v4i16((LAS s16x4*)p)); }
__device__ __forceinline__ bf16x8 tr_pair(LAS const unsigned char* p0, LAS const unsigned char* p1) {
    const s16x4 a = lds_tr(p0), b = lds_tr(p1); return __builtin_shufflevector(a, b, 0, 1, 2, 3, 4, 5, 6, 7);
}
__device__ __forceinline__ float fexp2(float x) { return __builtin_amdgcn_exp2f(x); }
__device__ __forceinline__ float frcp(float x) { return __builtin_amdgcn_rcpf(x); }
__device__ __forceinline__ float lane63(float v) { return __builtin_bit_cast(float, __builtin_amdgcn_readlane(__builtin_bit_cast(int, v), 63)); }
__device__ __forceinline__ float flog2(float x) { return __builtin_amdgcn_logf(x); }

constexpr size_t ZB_GQ = (size_t)GM * 4096, ZB_GK = ZB_GQ + (size_t)GM * 512, ZB_HQ = ZB_GK + (size_t)GM * 512, ZB_HFF = ZB_HQ + (size_t)GM * 1024, ZB_HFB = ZB_HFF + (size_t)GM * 1024;
constexpr int ZRW = 4096, ZR_GV = 0, ZR_GOG = 1024, ZR_HI = 2048, ZR_HOG = 3072;
__device__ __forceinline__ size_t blk_off(int chunk, int H, int hh, int w) { return (size_t)((chunk * H + hh) * 8 + w) * 1024; }
struct Ctx {
    const float *x_prompt, *x_sample, *w_in, *w_lr2, *b_lr, *gla_g, *hg_g, *lowb, *w_out, *ln1_g, *ln1_b, *w_up, *w_down, *ln2_g, *ln2_b;
    float* out;
    bf16 *Win_t, *Wout_t, *Wup_t, *Wdn_t, *Wglr_t, *HB, *Z, *O, *ST;
    float *BG, *TOT, *TOTS; bf16 *STS, *MF;
};

__device__ __forceinline__ void transpose_item(const float* W, int N, int kb, int nb, bf16* dst, int K, LAS float* scr, int lane) {
    const int k0 = 64 * kb, n0 = 32 * nb;
#pragma unroll 8
    for (int i = 0; i < 32; ++i) { const int kk = 2 * i + (lane >> 5); scr[kk * 33 + (lane & 31)] = W[(size_t)(k0 + kk) * N + n0 + (lane & 31)]; }
    LDS_WAIT(); asm volatile("" ::: "memory");
    const int c = lane & 7;
#pragma unroll
    for (int j = 0; j < 4; ++j) { const int n = (lane >> 3) + 8 * j; const LAS float* s = scr + (8 * c) * 33 + n;
        v4u o; o.x = pkbf(s[0 * 33], s[1 * 33]); o.y = pkbf(s[2 * 33], s[3 * 33]); o.z = pkbf(s[4 * 33], s[5 * 33]); o.w = pkbf(s[6 * 33], s[7 * 33]);
        *(GAS v4u*)(dst + (size_t)n * K + k0 + 8 * c) = o; }
    LDS_WAIT(); asm volatile("" ::: "memory");
}
__device__ __forceinline__ void prologue_weights(const Ctx& X, LAS unsigned char* lds, int gw, int NGW, int wave, int lane) {
    LAS float* scr = (LAS float*)(lds + wave * 16384);
    constexpr int I_IN = 32 * 257, I_OUT = 32 * 64, I_UP = 32 * 256, I_DN = 128 * 64, I_L = I_IN + I_OUT + I_UP + I_DN;
    for (int it = gw; it < NLAYER * I_L; it += NGW) {
        const int l = it / I_L; int r = it % I_L;
        if (r < I_IN) { const int kb = r / 257, nb = r % 257;
            bf16* dst = (nb < 96) ? X.Win_t + ((size_t)l * ZW + 32 * nb) * DM : (nb == 96) ? X.Wglr_t + (size_t)l * 32 * DM : X.Win_t + ((size_t)l * ZW + 32 * (nb - 1)) * DM;
            transpose_item(X.w_in + (size_t)l * DM * INW, INW, kb, nb, dst, DM, scr, lane); continue; }
        r -= I_IN;
        if (r < I_OUT) { const int kb = r / 64, nb = r % 64; transpose_item(X.w_out + (size_t)l * DM * DM, DM, kb, nb, X.Wout_t + ((size_t)l * DM + 32 * nb) * DM, DM, scr, lane); continue; }
        r -= I_OUT;
        if (r < I_UP) { const int kb = r / 256, nb = r % 256; transpose_item(X.w_up + (size_t)l * DM * DFF, DFF, kb, nb, X.Wup_t + ((size_t)l * DFF + 32 * nb) * DM, DM, scr, lane); continue; }
        r -= I_UP;
        { const int kb = r / 64, nb = r % 64; transpose_item(X.w_down + (size_t)l * DFF * DM, DM, kb, nb, X.Wdn_t + ((size_t)l * DM + 32 * nb) * DFF, DFF, scr, lane); }
    }
}
__device__ __forceinline__ void cvt_group(const float* xg, bf16* HB, int gtid, int NT) {
    for (int i = gtid; i < GM * DM / 8; i += NT) {
        const f32x4 a = ((const GAS f32x4*)xg)[2 * i], b = ((const GAS f32x4*)xg)[2 * i + 1];
        v4u o; o.x = pkbf(a.x, a.y); o.y = pkbf(a.z, a.w); o.z = pkbf(b.x, b.y); o.w = pkbf(b.z, b.w);
        ((GAS v4u*)HB)[i] = o; }
}
template <bool RES_F32, bool OUT_F32>
__device__ __forceinline__ void ln_phase(const void* res, const bf16* mf, const float* gam, const float* bet, float* H, bf16* HB, int gw, int NGW, int lane) {
    for (int m = gw; m < GM; m += NGW) {
        f32x4 v[8]; float s = 0.f;
        const GAS v2u* mr = (const GAS v2u*)(mf + (size_t)m * DM) + lane;
#pragma unroll
        for (int j = 0; j < 8; ++j) { f32x4 r;
            if (RES_F32) r = ((const GAS f32x4*)((const float*)res + (size_t)m * DM) + lane)[64 * j];
            else { const v2u w = ((const GAS v2u*)((const bf16*)res + (size_t)m * DM) + lane)[64 * j];
                r = (f32x4){__uint_as_float(w.x << 16), __uint_as_float(w.x & 0xffff0000u), __uint_as_float(w.y << 16), __uint_as_float(w.y & 0xffff0000u)}; }
            const v2u w = mr[64 * j];
            const f32x4 f = (f32x4){__uint_as_float(w.x << 16), __uint_as_float(w.x & 0xffff0000u), __uint_as_float(w.y << 16), __uint_as_float(w.y & 0xffff0000u)};
            v[j] = r * ALPHA + f; s += (v[j].x + v[j].y) + (v[j].z + v[j].w); }
        const float mean = wave_sum(s) * (1.f / DM); float s2 = 0.f;
#pragma unroll
        for (int j = 0; j < 8; ++j) { v[j] = v[j] - mean; s2 += (v[j].x * v[j].x + v[j].y * v[j].y) + (v[j].z * v[j].z + v[j].w * v[j].w); }
        const float rstd = 1.f / sqrtf(wave_sum(s2) * (1.f / DM) + LN_EPS);
#pragma unroll
        for (int j = 0; j < 8; ++j) { const f32x4 g4 = ((const GAS f32x4*)gam)[lane + 64 * j], b4 = ((const GAS f32x4*)bet)[lane + 64 * j];
            const f32x4 o = v[j] * rstd * g4 + b4;
            if (OUT_F32) ((GAS f32x4*)(H + (size_t)m * DM) + lane)[64 * j] = o;
            else { v2u w; w.x = pkbf(o.x, o.y); w.y = pkbf(o.z, o.w); ((GAS v2u*)(HB + (size_t)m * DM) + lane)[64 * j] = w; } }
    }
}

__device__ __forceinline__ void gate_unit(const Ctx& X, int l, int chunk, LAS unsigned char* lds, int tid, int lane, int wave) {
    const int fr = lane & 15, fq = lane >> 4;
    const bf16* A = X.HB + (size_t)chunk * 64 * DM; const bf16* Bw = X.Wglr_t + (size_t)l * 32 * DM;
    f32x4 acc[4][2];
#pragma unroll
    for (int m = 0; m < 4; ++m)
#pragma unroll
        for (int n = 0; n < 2; ++n) acc[m][n] = (f32x4){0.f, 0.f, 0.f, 0.f};
#pragma unroll 2
    for (int ks = 0; ks < 8; ++ks) { const int k0 = 256 * wave + 32 * ks + 8 * fq;
        bf16x8 a[4], b[2];
#pragma unroll
        for (int m = 0; m < 4; ++m) a[m] = *(const GAS bf16x8*)(A + (size_t)(16 * m + fr) * DM + k0);
#pragma unroll
        for (int n = 0; n < 2; ++n) b[n] = *(const GAS bf16x8*)(Bw + (size_t)(16 * n + fr) * DM + k0);
#pragma unroll
        for (int m = 0; m < 4; ++m)
#pragma unroll
            for (int n = 0; n < 2; ++n) acc[m][n] = __builtin_amdgcn_mfma_f32_16x16x32_bf16(a[m], b[n], acc[m][n], 0, 0, 0); }
    LAS float* part = (LAS float*)lds;
#pragma unroll
    for (int m = 0; m < 4; ++m)
#pragma unroll
        for (int n = 0; n < 2; ++n)
#pragma unroll
            for (int j = 0; j < 4; ++j) part[(wave * 64 + 16 * m + 4 * fq + j) * 33 + 16 * n + fr] = acc[m][n][j];
    __syncthreads();
    LAS float* glr = (LAS float*)(lds + 8 * 64 * 33 * 4);
#pragma unroll
    for (int k = 0; k < 4; ++k) { const int idx = tid + 512 * k, t = idx >> 5, n = idx & 31; float s = 0.f;
#pragma unroll
        for (int w = 0; w < 8; ++w) s += part[(w * 64 + t) * 33 + n];
        glr[t * 36 + n] = s; }
    __syncthreads();
    const int dir = wave >> 2;
    const float* w2 = X.w_lr2 + (size_t)(l * 2 + dir) * 16 * 512; const float* bl = X.b_lr + (size_t)(l * 2 + dir) * 512;
    for (int cb = 0; cb < 2; ++cb) { const int c = 128 * (wave & 3) + 64 * cb + lane;
        float w[16];
#pragma unroll
        for (int r = 0; r < 16; ++r) w[r] = w2[r * 512 + c];
        const float bias = bl[c];
        bf16* bgcol = (bf16*)X.BG + ((size_t)(((chunk * 4 + (c >> 7)) * 8 + ((c & 127) >> 4)) * 2 + dir) * 64) * 16 + (c & 15);
#pragma unroll 4
        for (int tt = 0; tt < 64; ++tt) { const int t = dir ? 63 - tt : tt;
            const LAS f32x4* gr = (const LAS f32x4*)(glr + t * 36 + dir * 16); const f32x4 g0 = gr[0], g1 = gr[1], g2 = gr[2], g3 = gr[3];
            float pre = bias;
            pre += g0.x * w[0] + g0.y * w[1] + g0.z * w[2] + g0.w * w[3]; pre += g1.x * w[4] + g1.y * w[5] + g1.z * w[6] + g1.w * w[7];
            pre += g2.x * w[8] + g2.y * w[9] + g2.z * w[10] + g2.w * w[11]; pre += g3.x * w[12] + g3.y * w[13] + g3.z * w[14] + g3.w * w[15];
            const float gl = (fminf(pre, 0.f) - __logf(1.f + __expf(-fabsf(pre)))) * (LOG2E / 16.f);
            bgcol[(size_t)t * 16] = (bf16)(pkbf(gl, gl) & 0xffffu); } }
    __syncthreads();
}

__device__ __forceinline__ size_t st_slot(int chunk, bool hgt, int h, int dir) { return (size_t)chunk * ST_CHUNK + (hgt ? 262144 + (h * 2 + dir) * 16384 : (h * 2 + dir) * 32768); }

template <bool HGT> struct RawIn { v4u b[2]; v4u k[2]; };
template <> struct RawIn<true> { v4u k[2]; };
template <bool HGT>
__device__ __forceinline__ RawIn<HGT> pass_s_load(const Ctx& X, int chunk, int h, int dir, int lane, int c0) {
    RawIn<HGT> r; const int rt = dir ? 63 - lane : lane, w = c0 >> 4;
    if constexpr (!HGT) { const GAS v4u* bg = (const GAS v4u*)((const bf16*)X.BG + ((size_t)(((chunk * 4 + h) * 8 + w) * 2 + dir) * 64 + rt) * 16);
        r.b[0] = bg[0]; r.b[1] = bg[1];
        const GAS v4u* kp = (const GAS v4u*)(X.Z + ZB_GK + blk_off(chunk, 4, h, w) + rt * 16); r.k[0] = kp[0]; r.k[1] = kp[1];
    } else { const GAS v4u* zp = (const GAS v4u*)(X.Z + (dir ? ZB_HFB : ZB_HFF) + blk_off(chunk, 8, h, w) + rt * 16); r.k[0] = zp[0]; r.k[1] = zp[1]; }
    return r;
}
template <bool HGT, bool STORE>
__device__ __forceinline__ void pass_s_unit(const Ctx& X, int l, int sc, int h, LAS unsigned char* lds, int tid, int lane, int wave) {
    constexpr int DV = HGT ? 128 : 256, VSTR = DV * 2 + 16, NE = DV / 16, PPR = DV / 8, UNR_D = HGT ? 2 : 1, UNR_C = HGT ? 4 : 1;
    const int fr = lane & 15, fq = lane >> 4, qq = fr >> 2, p4 = fr & 3, c0 = 16 * wave;
    RawIn<HGT> cur = pass_s_load<HGT>(X, sc * 4, h, 0, lane, c0);
    RawIn<HGT> rq[HGT ? 4 : 1];
    { const int vcol = HGT ? ZR_HI + h * 128 : ZR_GV + h * 256;
#pragma unroll 4
      for (int k = 0; k < 256 * PPR / 512; ++k) { const int idx = tid + 512 * k, row = idx / PPR, pc = idx % PPR;
        const v4u v = *(const GAS v4u*)(X.Z + (size_t)(sc * 256 + row) * ZRW + vcol + pc * 8);
        *(LAS v4u*)(lds + row * VSTR + pc * 16) = v; } }
    __syncthreads();
    LAS unsigned char* kt = lds + SV_KT + wave * KTW_BYTES;
    for (int dir = 0; dir < 2; ++dir) {
        const int hd = HGT ? 8 + h * 2 + dir : h * 2 + dir;
        if constexpr (HGT) {
#pragma unroll
            for (int q4 = 0; q4 < 4; ++q4) rq[q4] = pass_s_load<HGT>(X, sc * 4 + (dir ? 3 - q4 : q4), h, dir, lane, c0); }
        f32x4 acc[NE];
        if (STORE) { const bf16* sin = X.STS + st_slot(sc, HGT, h, dir);
#pragma unroll
            for (int et = 0; et < NE; ++et) { const v2u w = *(const GAS v2u*)(sin + (size_t)((et * 4 + (wave >> 1)) * 64 + fr + 16 * (2 * (wave & 1) + (fq >> 1))) * 8 + 4 * (fq & 1));
                acc[et] = (f32x4){__uint_as_float(w.x << 16), __uint_as_float(w.x & 0xffff0000u), __uint_as_float(w.y << 16), __uint_as_float(w.y & 0xffff0000u)}; }
        } else {
#pragma unroll
            for (int et = 0; et < NE; ++et) acc[et] = (f32x4){0.f, 0.f, 0.f, 0.f}; }
        float run[16];
#pragma unroll
        for (int i = 0; i < 16; ++i) run[i] = 0.f;
#pragma unroll UNR_C
        for (int cc = 0; cc < 4; ++cc) { const int ci = dir ? 3 - cc : cc, chunk = sc * 4 + ci;
            RawIn<HGT> nxt = cur;
            if constexpr (HGT) cur = rq[cc];
            else { if (cc < 3) nxt = pass_s_load<HGT>(X, sc * 4 + (dir ? 2 - cc : cc + 1), h, dir, lane, c0);
                   else if (dir == 0) nxt = pass_s_load<HGT>(X, sc * 4 + 3, h, 1, lane, c0); }
            float bc[16], kr[16];
            if constexpr (!HGT) {
                unpack8(cur.b[0], bc); unpack8(cur.b[1], bc + 8); wave_scan16(bc);
                unpack8(cur.k[0], kr); unpack8(cur.k[1], kr + 8);
            } else {
                unpack8(cur.k[0], bc); unpack8(cur.k[1], bc + 8);
#pragma unroll
                for (int i = 0; i < 16; ++i) kr[i] = 1.f - fexp2(bc[i]);
                wave_scan16(bc);
            }
            if (STORE) { bf16* slot = X.ST + st_slot(chunk, HGT, h, dir);
#pragma unroll
                for (int et = 0; et < NE; ++et) { v2u w; w.x = pkbf(acc[et][0], acc[et][1]); w.y = pkbf(acc[et][2], acc[et][3]);
                    *(GAS v2u*)(slot + (size_t)((et * 4 + (wave >> 1)) * 64 + fr + 16 * (2 * (wave & 1) + (fq >> 1))) * 8 + 4 * (fq & 1)) = w; }
                if (cc == 3) { cur = nxt; break; } }
            float kh[16];
#pragma unroll
            for (int i = 0; i < 16; ++i) { const float bl = lane63(bc[i]); kh[i] = kr[i] * fexp2(bl - bc[i]); run[i] += bl; }
            { const v4u k0 = pack8(kh), k1 = pack8(kh + 8); const unsigned kw[8] = {k0.x, k0.y, k0.z, k0.w, k1.x, k1.y, k1.z, k1.w};
#pragma unroll
              for (int i = 0; i < 16; ++i) *(LAS unsigned short*)(kt + i * KT_STR + lane * 2) = (unsigned short)((i & 1) ? (kw[i >> 1] >> 16) : (kw[i >> 1] & 0xffffu)); }
            if (lane == 63) {
#pragma unroll
                for (int i = 0; i < 4; ++i) ((LAS f32x4*)(kt + 2304))[i] = (f32x4){bc[4 * i], bc[4 * i + 1], bc[4 * i + 2], bc[4 * i + 3]}; }
            asm volatile("s_waitcnt lgkmcnt(0)" ::: "memory");
            const f32x4 dl = *(const LAS f32x4*)(kt + 2304 + 16 * fq);
            const f32x4 dec = (f32x4){fexp2(dl.x), fexp2(dl.y), fexp2(dl.z), fexp2(dl.w)};
            bf16x8 afr[2];
#pragma unroll
            for (int ks = 0; ks < 2; ++ks) afr[ks] = *(const LAS bf16x8*)(kt + fr * KT_STR + (32 * ks + 8 * fq) * 2);
#pragma unroll
            for (int et = 0; et < NE; ++et) acc[et] = acc[et] * dec;
            { constexpr int NB = 2 * NE / 4;
              LAS const unsigned char* vb[2][2];
#pragma unroll
              for (int ks = 0; ks < 2; ++ks) { const int r0 = 32 * ks + 8 * fq + qq, r1 = r0 + 4;
                  vb[ks][0] = lds + (ci * 64 + (dir ? 63 - r0 : r0)) * VSTR + 8 * p4; vb[ks][1] = lds + (ci * 64 + (dir ? 63 - r1 : r1)) * VSTR + 8 * p4; }
              bf16x8 bb[2][4];
#pragma unroll
              for (int j = 0; j < 4; ++j) bb[0][j] = tr_pair(vb[0][0] + 32 * j, vb[0][1] + 32 * j);
#pragma unroll
              for (int b = 0; b < NB; ++b) {
                  if (b + 1 < NB) { const int ks1 = (b + 1) / (NE / 4), e1 = 4 * ((b + 1) % (NE / 4));
#pragma unroll
                      for (int j = 0; j < 4; ++j) bb[(b + 1) & 1][j] = tr_pair(vb[ks1][0] + 32 * (e1 + j), vb[ks1][1] + 32 * (e1 + j)); }
                  const int ks0 = b / (NE / 4), e0 = 4 * (b % (NE / 4));
#pragma unroll
                  for (int j = 0; j < 4; ++j) acc[e0 + j] = __builtin_amdgcn_mfma_f32_16x16x32_bf16(afr[ks0], bb[b & 1][j], acc[e0 + j], 0, 0, 0);
                  __builtin_amdgcn_sched_group_barrier(0x100, 8, 0); __builtin_amdgcn_sched_group_barrier(0x008, 4, 0); } }
            asm volatile("s_waitcnt lgkmcnt(0)" ::: "memory");
            cur = nxt;
        }
        if (!STORE) { bf16* sout = X.STS + st_slot(sc, HGT, h, dir);
#pragma unroll
            for (int et = 0; et < NE; ++et) { v2u w; w.x = pkbf(acc[et][0], acc[et][1]); w.y = pkbf(acc[et][2], acc[et][3]);
                *(GAS v2u*)(sout + (size_t)((et * 4 + (wave >> 1)) * 64 + fr + 16 * (2 * (wave & 1) + (fq >> 1))) * 8 + 4 * (fq & 1)) = w; }
            if (lane == 0) { float* tp = X.TOTS + ((size_t)sc * 24 + hd) * 128 + c0;
#pragma unroll
                for (int i = 0; i < 4; ++i) ((GAS f32x4*)tp)[i] = (f32x4){run[4 * i], run[4 * i + 1], run[4 * i + 2], run[4 * i + 3]}; } }
    }
    __syncthreads();
}
__device__ __forceinline__ void pass_b_super(const Ctx& X, int g, int gtid, int NT) {
    const int ns = (g == 0) ? 1 : 2, nc = NSC / ns;
    for (int v = gtid; v < ns * (ST_CHUNK / 8); v += NT) {
        const int s = v / (ST_CHUNK / 8), idx = (v % (ST_CHUNK / 8)) * 8;
        const int hd = idx < 262144 ? idx / 32768 : 8 + (idx - 262144) / 16384, db = hd & 1;
        const int d0 = 32 * ((idx >> 9) & 3) + 8 * ((idx >> 7) & 3);
        float S[8];
#pragma unroll
        for (int i = 0; i < 8; ++i) S[i] = 0.f;
        for (int cc = 0; cc < nc; cc += 8) {
            v4u x[8]; f32x4 t0[8], t1[8];
#pragma unroll
            for (int u = 0; u < 8; ++u) { const int c = s * nc + (db ? nc - 1 - (cc + u) : cc + u);
                x[u] = *(const GAS v4u*)(X.STS + (size_t)c * ST_CHUNK + idx);
                const GAS f32x4* tp = (const GAS f32x4*)(X.TOTS + ((size_t)c * 24 + hd) * 128 + d0); t0[u] = tp[0]; t1[u] = tp[1]; }
#pragma unroll
            for (int u = 0; u < 8; ++u) { const int c = s * nc + (db ? nc - 1 - (cc + u) : cc + u);
                *(GAS v4u*)(X.STS + (size_t)c * ST_CHUNK + idx) = pack8(S);
                float dx[8]; unpack8(x[u], dx);
                const float dec[8] = {fexp2(t0[u].x), fexp2(t0[u].y), fexp2(t0[u].z), fexp2(t0[u].w), fexp2(t1[u].x), fexp2(t1[u].y), fexp2(t1[u].z), fexp2(t1[u].w)};
#pragma unroll
                for (int i = 0; i < 8; ++i) S[i] = dec[i] * S[i] + dx[i]; }
        }
    }
}

constexpr int F_QD = 0, F_KD = 17408, F_QH = 34816, F_P = 52224, F_BT = 61440, F_KT = 63488, F_DEC = 81920, F_V = 82432, F_RED = 116224;
template <bool HGT> struct RawF { v4u x[HGT ? 4 : 6]; v4u v[HGT ? 2 : 4]; };
template <bool HGT>
__device__ __forceinline__ RawF<HGT> f_load(const Ctx& X, int chunk, int h, int dir, int tid, int lane, int wave) {
    constexpr int DV = HGT ? 128 : 256, PPR = DV / 8;
    RawF<HGT> R; const int rt = dir ? 63 - lane : lane;
    if constexpr (!HGT) {
        const GAS v4u* bg = (const GAS v4u*)((const bf16*)X.BG + ((size_t)(((chunk * 4 + h) * 8 + wave) * 2 + dir) * 64 + rt) * 16); R.x[0] = bg[0]; R.x[1] = bg[1];
        const GAS v4u* kp = (const GAS v4u*)(X.Z + ZB_GK + blk_off(chunk, 4, h, wave) + rt * 16); R.x[2] = kp[0]; R.x[3] = kp[1];
        const GAS v4u* qp = (const GAS v4u*)(X.Z + ZB_GQ + blk_off(chunk, 4, h, wave) + rt * 16); R.x[4] = qp[0]; R.x[5] = qp[1];
    } else {
        const GAS v4u* zp = (const GAS v4u*)(X.Z + (dir ? ZB_HFB : ZB_HFF) + blk_off(chunk, 8, h, wave) + rt * 16); R.x[0] = zp[0]; R.x[1] = zp[1];
        const GAS v4u* qp = (const GAS v4u*)(X.Z + ZB_HQ + blk_off(chunk, 8, h, wave) + rt * 16); R.x[2] = qp[0]; R.x[3] = qp[1]; }
    const int vcol = HGT ? ZR_HI + h * 128 : ZR_GV + h * 256;
#pragma unroll
    for (int k = 0; k < 64 * PPR / 512; ++k) { const int idx = tid + 512 * k, row = idx / PPR, pc = idx % PPR;
        R.v[k] = *(const GAS v4u*)(X.Z + (size_t)(chunk * 64 + row) * ZRW + vcol + pc * 8); }
    return R;
}
template <bool HGT>
__device__ __forceinline__ void f_stage(const Ctx& X, int l, const RawF<HGT>& R, int h, int dir, LAS unsigned char* ld, int lane, int wave) {
    const int r = lane, c0 = 16 * wave;
    float bc[16], kr[16], qv[16];
    if constexpr (!HGT) {
        unpack8(R.x[0], bc); unpack8(R.x[1], bc + 8); wave_scan16(bc);
        unpack8(R.x[2], kr); unpack8(R.x[3], kr + 8);
        unpack8(R.x[4], qv); unpack8(R.x[5], qv + 8);
#pragma unroll
        for (int i = 0; i < 16; ++i) qv[i] *= 0.08838834764831845f;
    } else {
        unpack8(R.x[0], bc); unpack8(R.x[1], bc + 8);
        unpack8(R.x[2], qv); unpack8(R.x[3], qv + 8);
#pragma unroll
        for (int i = 0; i < 16; ++i) kr[i] = 1.f - fexp2(bc[i]);
        wave_scan16(bc);
    }
    float qd[16], kd[16], qh[16], kh[16], tl[16];
#pragma unroll
    for (int i = 0; i < 16; ++i) {
        const float beta = __builtin_bit_cast(float, __builtin_amdgcn_update_dpp(0, __builtin_bit_cast(int, bc[i]), 0x142, 0xe, 0xf, false));
        tl[i] = lane63(bc[i]);
        qd[i] = qv[i] * fexp2(bc[i] - beta); kd[i] = kr[i] * fexp2(__builtin_amdgcn_fmed3f(beta - bc[i], 0.f, 80.f)); qh[i] = qv[i] * fexp2(bc[i]); kh[i] = kr[i] * fexp2(tl[i] - bc[i]); }
    LAS unsigned char* p = ld + r * K_STR + c0 * 2;
    ((LAS v4u*)(p + F_QD))[0] = pack8(qd); ((LAS v4u*)(p + F_QD))[1] = pack8(qd + 8);
    ((LAS v4u*)(p + F_KD))[0] = pack8(kd); ((LAS v4u*)(p + F_KD))[1] = pack8(kd + 8);
    { const v4u q0 = pack8(qh), q1 = pack8(qh + 8);
      LAS unsigned char* pq = ld + F_QH + r * K_STR + (wave >> 1) * 64 + (wave & 1) * 8;
      *(LAS v2u*)(pq) = (v2u){q0.x, q0.y}; *(LAS v2u*)(pq + 16) = (v2u){q0.z, q0.w}; *(LAS v2u*)(pq + 32) = (v2u){q1.x, q1.y}; *(LAS v2u*)(pq + 48) = (v2u){q1.z, q1.w}; }
    { const v4u k0 = pack8(kh), k1 = pack8(kh + 8); const unsigned kw[8] = {k0.x, k0.y, k0.z, k0.w, k1.x, k1.y, k1.z, k1.w};
#pragma unroll
      for (int i = 0; i < 16; ++i) *(LAS unsigned short*)(ld + F_KT + (c0 + i) * KT_STR + lane * 2) = (unsigned short)((i & 1) ? (kw[i >> 1] >> 16) : (kw[i >> 1] & 0xffffu)); }
    if ((lane & 15) == 15) { LAS f32x4* bt = (LAS f32x4*)(ld + F_BT + (((lane >> 4) + 1) & 3) * 512 + c0 * 4);
        const bool z = lane == 63;
#pragma unroll
        for (int i = 0; i < 4; ++i) bt[i] = z ? (f32x4){0.f, 0.f, 0.f, 0.f} : (f32x4){bc[4 * i], bc[4 * i + 1], bc[4 * i + 2], bc[4 * i + 3]};
        if (z) { LAS f32x4* dc = (LAS f32x4*)(ld + F_DEC + c0 * 4);
#pragma unroll
            for (int i = 0; i < 4; ++i) dc[i] = (f32x4){fexp2(tl[4 * i]), fexp2(tl[4 * i + 1]), fexp2(tl[4 * i + 2]), fexp2(tl[4 * i + 3])}; } }
}
template <bool HGT>
__device__ __forceinline__ void pass_f_unit(const Ctx& X, int l, int sc, int h, float* scr, LAS unsigned char* lds, int tid_, int lane_, int wave) {
    constexpr int DV = HGT ? 128 : 256, VSTR = DV * 2 + 16, NET = DV / 128, PPR = DV / 8;
    if (tid_ < 384) { const int tid = tid_; const int tile = tid >> 6, row = (tid >> 2) & 15, part = tid & 3;
        const unsigned code = (tile < 4) ? (0x12030201u >> (8 * tile)) & 0xffu : (0x2313u >> (8 * (tile - 4))) & 0xffu;
        const unsigned zz = (unsigned)tid >> 20;
        *(LAS v2u*)(lds + F_P + (16 * (int)(code >> 4) + row) * P_STR + (16 * (int)(code & 15u) + 4 * part) * 2) = (v2u){zz, zz}; }
    const float* ng = (HGT ? X.hg_g + (size_t)l * 128 : X.gla_g + (size_t)l * 256);
    const int ogcol = HGT ? ZR_HOG + h * 128 : ZR_GOG + h * 256, ocol = HGT ? 1024 + h * 128 : h * 256;
    RawF<HGT> raw = f_load<HGT>(X, sc * 4 + 3, h, 1, tid_, lane_, wave);
#pragma unroll 1
    for (int sw = 0; sw < 2; ++sw) { const int dir = 1 - sw;
        f32x4 S[8][NET];
        { const bf16* sin = X.STS + st_slot(sc, HGT, h, dir); const int fr = lane_ & 15, fq = lane_ >> 4;
#pragma unroll
          for (int T = 0; T < 8; ++T)
#pragma unroll
            for (int et = 0; et < NET; ++et) { const v2u w = *(const GAS v2u*)(sin + (size_t)(((wave * NET + et) * 4 + (T >> 1)) * 64 + fr + 16 * (2 * (T & 1) + (fq >> 1))) * 8 + 4 * (fq & 1));
                S[T][et] = (f32x4){__uint_as_float(w.x << 16), __uint_as_float(w.x & 0xffff0000u), __uint_as_float(w.y << 16), __uint_as_float(w.y & 0xffff0000u)}; } }
#pragma unroll 1
        for (int cc = 0; cc < 4; ++cc) { const int ci = dir ? 3 - cc : cc, chunk = sc * 4 + ci;
            int tq = tid_; asm volatile("" : "+v"(tq));
            const int tid = tq, lane = tq & 63, fr = lane & 15, fq = lane >> 4, qq = fr >> 2, p4 = fr & 3;
            {
#pragma unroll
              for (int k = 0; k < 64 * PPR / 512; ++k) { const int idx = tid + 512 * k, row = idx / PPR, pc = idx % PPR;
                *(LAS v4u*)(lds + F_V + row * VSTR + pc * 16) = raw.v[k]; } }
            f_stage<HGT>(X, l, raw, h, dir, lds, lane, wave);
            if (cc < 3) raw = f_load<HGT>(X, sc * 4 + (dir ? 2 - cc : cc + 1), h, dir, tid, lane, wave);
            else if (dir) raw = f_load<HGT>(X, sc * 4, h, 0, tid, lane, wave);
            float* sp = scr + (size_t)((ci * 8 + wave) * (NET * 4)) * 256 + lane * 4;
            f32x4 oacc[NET][4];
#pragma unroll
            for (int et = 0; et < NET; ++et)
#pragma unroll
                for (int it = 0; it < 4; ++it) oacc[et][it] = (f32x4){0.f, 0.f, 0.f, 0.f};
            __syncthreads();
            if (!dir) {
#pragma unroll
                for (int et = 0; et < NET; ++et)
#pragma unroll
                    for (int it = 0; it < 4; ++it) oacc[et][it] = *(const GAS f32x4*)(sp + (et * 4 + it) * 256); }
            { const unsigned lst = (wave < 6) ? 0xff00u | (unsigned)((0x323130212010ull >> (8 * wave)) & 0xffull) : (wave == 6 ? 0x1100u : 0x3322u);
              for (int t = 0; t < 2; ++t) { const unsigned code = (lst >> (8 * t)) & 0xffu; if (code == 0xffu) break;
                  const int I = (int)(code >> 4), J = (int)(code & 15u);
                  f32x4 scv = (f32x4){0.f, 0.f, 0.f, 0.f};
#pragma unroll
                  for (int ks = 0; ks < 4; ++ks) { const int dc = 32 * ks + 8 * fq;
                      v4u ka = *(const LAS v4u*)(lds + F_KD + (16 * J + fr) * K_STR + dc * 2);
                      const bf16x8 qb = *(const LAS bf16x8*)(lds + F_QD + (16 * I + fr) * K_STR + dc * 2);
                      if (J < I) { const LAS f32x4* bi = (const LAS f32x4*)(lds + F_BT + I * 512 + dc * 4); const LAS f32x4* bj = (const LAS f32x4*)(lds + F_BT + J * 512 + dc * 4);
                          const f32x4 d0 = bi[0] - bj[0], d1 = bi[1] - bj[1]; float kf[8]; unpack8(ka, kf);
                          kf[0] *= fexp2(d0.x); kf[1] *= fexp2(d0.y); kf[2] *= fexp2(d0.z); kf[3] *= fexp2(d0.w); kf[4] *= fexp2(d1.x); kf[5] *= fexp2(d1.y); kf[6] *= fexp2(d1.z); kf[7] *= fexp2(d1.w);
                          ka = pack8(kf); }
                      scv = __builtin_amdgcn_mfma_f32_16x16x32_bf16(__builtin_bit_cast(bf16x8, ka), qb, scv, 0, 0, 0); }
                  if (J == I) {
#pragma unroll
                      for (int u = 0; u < 4; ++u) if (4 * fq + u > fr) scv[u] = 0.f; }
                  v2u w; w.x = pkbf(scv[0], scv[1]); w.y = pkbf(scv[2], scv[3]);
                  *(LAS v2u*)(lds + F_P + (16 * I + fr) * P_STR + (16 * J + 4 * fq) * 2) = w; } }
            __syncthreads();
            bf16x8 vfr[NET][2];
#pragma unroll
            for (int ks = 0; ks < 2; ++ks) { const int r0 = 32 * ks + 8 * fq + qq, r1 = r0 + 4, v0 = dir ? 63 - r0 : r0, v1 = dir ? 63 - r1 : r1;
#pragma unroll
                for (int et = 0; et < NET; ++et) { const int col = (16 * (wave * NET + et) + 4 * p4) * 2;
                    vfr[et][ks] = tr_pair(lds + F_V + v0 * VSTR + col, lds + F_V + v1 * VSTR + col); } }
            {
#pragma unroll
              for (int ks = 0; ks < 4; ++ks) { bf16x8 sfr[NET];
#pragma unroll
                for (int et = 0; et < NET; ++et) { v4u a; a.x = pkbf(S[2 * ks][et][0], S[2 * ks][et][1]); a.y = pkbf(S[2 * ks][et][2], S[2 * ks][et][3]);
                    a.z = pkbf(S[2 * ks + 1][et][0], S[2 * ks + 1][et][1]); a.w = pkbf(S[2 * ks + 1][et][2], S[2 * ks + 1][et][3]); sfr[et] = __builtin_bit_cast(bf16x8, a); }
#pragma unroll
                for (int it = 0; it < 4; ++it) { const int trow = 16 * it + fr, ip = dir ? 63 - trow : trow;
                    const bf16x8 bo = *(const LAS bf16x8*)(lds + F_QH + ip * K_STR + (32 * ks + 8 * fq) * 2);
#pragma unroll
                    for (int et = 0; et < NET; ++et) oacc[et][it] = __builtin_amdgcn_mfma_f32_16x16x32_bf16(sfr[et], bo, oacc[et][it], 0, 0, 0); } }
#pragma unroll
              for (int ks = 0; ks < 2; ++ks)
#pragma unroll
                for (int it = 0; it < 4; ++it) { const int trow = 16 * it + fr, ip = dir ? 63 - trow : trow;
                    const bf16x8 bo = *(const LAS bf16x8*)(lds + F_P + ip * P_STR + (32 * ks + 8 * fq) * 2);
#pragma unroll
                    for (int et = 0; et < NET; ++et) oacc[et][it] = __builtin_amdgcn_mfma_f32_16x16x32_bf16(vfr[et][ks], bo, oacc[et][it], 0, 0, 0); } }
            v2u ogp[NET][4];
            if (HGT && !dir) {
#pragma unroll
                for (int et = 0; et < NET; ++et)
#pragma unroll
                    for (int it = 0; it < 4; ++it) {
                        ogp[et][it] = *(const GAS v2u*)(X.Z + (size_t)(chunk * 64 + 16 * it + fr) * ZRW + ogcol + 16 * (wave * NET + et) + 4 * fq); } }
            if (cc < 3) {
#pragma unroll
                for (int T = 0; T < 8; ++T) { if ((T & 1) == 0) __builtin_amdgcn_sched_barrier(0);
                    const f32x4 dc = *(const LAS f32x4*)(lds + F_DEC + (16 * T + 4 * fq) * 4);
                    const bf16x8 a0 = *(const LAS bf16x8*)(lds + F_KT + (16 * T + fr) * KT_STR + (8 * fq) * 2), a1 = *(const LAS bf16x8*)(lds + F_KT + (16 * T + fr) * KT_STR + (32 + 8 * fq) * 2);
#pragma unroll
                    for (int et = 0; et < NET; ++et) { S[T][et] = S[T][et] * dc;
                        S[T][et] = __builtin_amdgcn_mfma_f32_16x16x32_bf16(a0, vfr[et][0], S[T][et], 0, 0, 0); S[T][et] = __builtin_amdgcn_mfma_f32_16x16x32_bf16(a1, vfr[et][1], S[T][et], 0, 0, 0); } } }
            if (!HGT && !dir) { __builtin_amdgcn_sched_barrier(0);
#pragma unroll
                for (int et = 0; et < NET; ++et)
#pragma unroll
                    for (int it = 0; it < 4; ++it) {
                        ogp[et][it] = *(const GAS v2u*)(X.Z + (size_t)(chunk * 64 + 16 * it + fr) * ZRW + ogcol + 16 * (wave * NET + et) + 4 * fq); } }
            if (dir) {
#pragma unroll
                for (int et = 0; et < NET; ++et)
#pragma unroll
                    for (int it = 0; it < 4; ++it) *(GAS f32x4*)(sp + (et * 4 + it) * 256) = oacc[et][it];
                __syncthreads();
            } else {
                LAS float* red = (LAS float*)(lds + F_RED);
#pragma unroll
                for (int it = 0; it < 4; ++it) { float sq = 0.f;
#pragma unroll
                    for (int et = 0; et < NET; ++et) { const f32x4 o = oacc[et][it]; sq += (o.x * o.x + o.y * o.y) + (o.z * o.z + o.w * o.w); }
                    sq += __shfl_xor(sq, 16); sq += __shfl_xor(sq, 32);
                    if (fq == 0) red[wave * 64 + 16 * it + fr] = sq; }
                __syncthreads();
#pragma unroll
                for (int it = 0; it < 4; ++it) { float tot = 0.f;
#pragma unroll
                    for (int w = 0; w < 8; ++w) tot += red[w * 64 + 16 * it + fr];
                    const float rstd = __builtin_amdgcn_rsqf(tot * (1.f / DV) + RMS_EPS);
                    const int tok = chunk * 64 + 16 * it + fr;
#pragma unroll
                    for (int et = 0; et < NET; ++et) { const int e0 = 16 * (wave * NET + et) + 4 * fq;
                        const v2u og2 = ogp[et][it];
                        const float og[4] = {__uint_as_float(og2.x << 16), __uint_as_float(og2.x & 0xffff0000u), __uint_as_float(og2.y << 16), __uint_as_float(og2.y & 0xffff0000u)};
                        const f32x4 g4 = *(const GAS f32x4*)(ng + e0); float rr[4];
#pragma unroll
                        for (int u = 0; u < 4; ++u) { const float z = og[u]; rr[u] = oacc[et][it][u] * rstd * g4[u] * (z * frcp(1.f + fexp2(z * -LOG2E))); }
                        v2u w; w.x = pkbf(rr[0], rr[1]); w.y = pkbf(rr[2], rr[3]);
                        *(GAS v2u*)(X.O + (size_t)tok * DM + ocol + e0) = w; } }
            }
        }
        asm volatile("s_waitcnt vmcnt(0)" ::: "memory");
    }
}

struct Args { const float* in[15]; float* out; unsigned char* ws; int mode, pad; };
#define PHASE_IDS() int tid = threadIdx.x; asm volatile("" : "+v"(tid)); const int lane = tid & 63, wave = __builtin_amdgcn_readfirstlane(tid >> 6); \
    const int gw = bx * NWAVES + wave, NGW = G * NWAVES, gtid = bx * (NWAVES * 64) + tid, NT = G * NWAVES * 64; (void)lane; (void)wave; (void)gw; (void)NGW; (void)gtid; (void)NT
__device__ __forceinline__ Ctx make_ctx(const Args& args) {
    Ctx X; unsigned char* ws = args.ws;
    X.x_prompt = args.in[0]; X.x_sample = args.in[1]; X.w_in = args.in[2]; X.w_lr2 = args.in[3]; X.b_lr = args.in[4]; X.gla_g = args.in[5]; X.hg_g = args.in[6]; X.lowb = args.in[7];
    X.w_out = args.in[8]; X.ln1_g = args.in[9]; X.ln1_b = args.in[10]; X.w_up = args.in[11]; X.w_down = args.in[12]; X.ln2_g = args.in[13]; X.ln2_b = args.in[14]; X.out = args.out;
    X.Win_t = (bf16*)(ws + WS_WIN); X.Wout_t = (bf16*)(ws + WS_WOUT); X.Wup_t = (bf16*)(ws + WS_WUP); X.Wdn_t = (bf16*)(ws + WS_WDN); X.Wglr_t = (bf16*)(ws + WS_WGLR);
    X.HB = (bf16*)(ws + WS_HB); X.Z = (bf16*)(ws + WS_Z); X.O = (bf16*)(ws + WS_O); X.ST = (bf16*)(ws + WS_ST);
    X.BG = (float*)(ws + WS_BG); X.MF = (bf16*)(ws + WS_ST); X.TOT = (float*)(ws + WS_TOT); X.TOTS = (float*)(ws + WS_TOTS); X.STS = (bf16*)(ws + WS_STS);
    return X;
}
__global__ void __launch_bounds__(NWAVES * 64, 2) fwd_kernel(Args args) {
    extern __shared__ __attribute__((aligned(16))) unsigned char lds_raw[];
    LAS unsigned char* lds = (LAS unsigned char*)lds_raw;
    const int G = gridDim.x, bx = blockIdx.x;
    volatile LAS unsigned* MISC = (volatile LAS unsigned*)(lds + MISC_OFF);
    if (threadIdx.x < 32) MISC[threadIdx.x] = 0u;
    __syncthreads();
    XcdBarrier bar = xcd_barrier_post((unsigned*)(args.ws + WS_CTL) + CW_BAR, MISC + 8);

    { PHASE_IDS(); const Ctx X = make_ctx(args); prologue_weights(X, lds, gw, NGW, wave, lane); }
    for (int g = 0; g < NGRP; ++g) {
        { PHASE_IDS(); const Ctx X = make_ctx(args); cvt_group((g == 0) ? X.x_prompt : X.x_sample + (size_t)(g - 1) * GM * DM, X.HB, gtid, NT); }
        xcd_barrier(bar);
        for (int l = 0; l < NLAYER; ++l) {
            { PHASE_IDS(); const Ctx X = make_ctx(args); for (int c = bx; c < NCHUNK; c += G) gate_unit(X, l, c, lds, tid, lane, wave); }
            { const Ctx X = make_ctx(args); pg8::Gemm gm{X.HB, X.Win_t + (size_t)l * ZW * DM, GM, ZW, DM}; pg8::StaticOrder S; S.init(GM, ZW, G, bx);
              pg8::EpiZ E{X.Z, X.lowb, l};
              pg8::gemm_phase<pg8::EpiZ, pg8::StaticOrder, false, true>(lds, gm, S, E); }
            xcd_barrier(bar);
            {
            { PHASE_IDS(); const Ctx X = make_ctx(args);
              for (int u = bx; u < NSC * 12; u += G) { const int sc = sc_order(u / 12), hh = u % 12;
                if (hh < 4) pass_s_unit<false, false>(X, l, sc, hh, lds, tid, lane, wave); else pass_s_unit<true, false>(X, l, sc, hh - 4, lds, tid, lane, wave); } }
            xcd_barrier(bar);
            { PHASE_IDS(); const Ctx X = make_ctx(args); pass_b_super(X, g, gtid, NT); }
            xcd_barrier(bar);
            for (int u = bx + ((NSC * 12 - 1 - bx) / G) * G; u >= bx; u -= G) { const int sc = sc_order(u / 12), hh = u % 12;
                { PHASE_IDS(); const Ctx X = make_ctx(args); float* scr = (float*)X.ST + (size_t)bx * 65536;
                  if (hh < 4) pass_f_unit<false>(X, l, sc, hh, scr, lds, tid, lane, wave); else pass_f_unit<true>(X, l, sc, hh - 4, scr, lds, tid, lane, wave); }
                __syncthreads(); }
            xcd_barrier(bar);
            }
            { const Ctx X = make_ctx(args); pg8::Gemm gm{X.O, X.Wout_t + (size_t)l * DM * DM, GM, DM, DM}; pg8::StaticOrder S; S.init(GM, DM, G, bx);
              pg8::EpiBf16<0> E{X.MF, DM};
              pg8::gemm_phase<pg8::EpiBf16<0>, pg8::StaticOrder, false, true>(lds, gm, S, E); }
            xcd_barrier(bar);
            { PHASE_IDS(); const Ctx X = make_ctx(args);
              ln_phase<false, false>(X.HB, X.MF, X.ln1_g + (size_t)l * DM, X.ln1_b + (size_t)l * DM, nullptr, X.HB, gw, NGW, lane); }
            xcd_barrier(bar);
            { const Ctx X = make_ctx(args); pg8::Gemm gm{X.HB, X.Wup_t + (size_t)l * DFF * DM, GM, DFF, DM}; pg8::StaticOrder S; S.init(GM, DFF, G, bx);
              pg8::EpiBf16<1> E{X.Z, DFF};
              pg8::gemm_phase<pg8::EpiBf16<1>, pg8::StaticOrder, false, true>(lds, gm, S, E); }
            xcd_barrier(bar);
            { const Ctx X = make_ctx(args); pg8::Gemm gm{X.Z, X.Wdn_t + (size_t)l * DM * DFF, GM, DM, DFF}; pg8::ReverseOrder S; S.init(GM, DM, G, bx);
              pg8::EpiBf16<0> E{X.MF, DM};
              pg8::gemm_phase<pg8::EpiBf16<0>, pg8::ReverseOrder, false, true>(lds, gm, S, E); }
            xcd_barrier(bar);
            { PHASE_IDS(); const Ctx X = make_ctx(args);
              if (l == NLAYER - 1) ln_phase<false, true>(X.HB, X.MF, X.ln2_g + (size_t)l * DM, X.ln2_b + (size_t)l * DM, X.out + (size_t)g * GM * DM, nullptr, gw, NGW, lane);
              else ln_phase<false, false>(X.HB, X.MF, X.ln2_g + (size_t)l * DM, X.ln2_b + (size_t)l * DM, nullptr, X.HB, gw, NGW, lane); }
            xcd_barrier(bar);
        }
    }
}

extern "C" void kernel_launch(void* const* d_in, const int* in_sizes, int n_in, void* d_out, int out_size, void* d_ws, size_t ws_size, hipStream_t stream) {
    static int grid = 0;
    if (grid == 0) {
        if (n_in != 15 || out_size != NTOK * DM || ws_size < WS_END) { fprintf(stderr, "kernel_launch: unexpected shapes (n_in %d, out %d, ws %zu)\n", n_in, out_size, ws_size); grid = -1; return; }
        int dev = 0, cus = 0;
        if (hipGetDevice(&dev) != hipSuccess || hipDeviceGetAttribute(&cus, hipDeviceAttributeMultiprocessorCount, dev) != hipSuccess) { grid = -1; return; }
        if (hipFuncSetAttribute((const void*)fwd_kernel, hipFuncAttributeMaxDynamicSharedMemorySize, LDS_BYTES) != hipSuccess) { fprintf(stderr, "kernel_launch: hipFuncSetAttribute failed\n"); grid = -1; return; }
        int per_cu = 0;
        if (hipOccupancyMaxActiveBlocksPerMultiprocessor(&per_cu, (const void*)fwd_kernel, NWAVES * 64, LDS_BYTES) != hipSuccess || per_cu < 1) { fprintf(stderr, "kernel_launch: occupancy query says %d\n", per_cu); }
        (void)hipGetLastError();
        grid = cus;
    }
    if (grid < 0) return;
    if (hipMemsetAsync((char*)d_ws + WS_CTL, 0, CTL_ZERO_BYTES, stream) != hipSuccess) return;
    Args a{};
    for (int i = 0; i < 15; ++i) a.in[i] = (const float*)d_in[i];
    a.out = (float*)d_out; a.ws = (unsigned char*)d_ws; a.mode = KMODE; a.pad = 0;
    hipLaunchKernelGGL(fwd_kernel, dim3(grid), dim3(NWAVES * 64), LDS_BYTES, stream, a);
}
```
